# Optimizing an MI355X kernel written in HIP

```python
import math
import jax
import jax.numpy as jnp
from jax import lax
import numpy as np

D_MODEL = 1024
BATCH = 8
SEQ = 4096
DEPTH = 4

GRID_W = 64
CTX_LEN = 256
N_MIXERS = 4
N_MOD = 6
Q_BLOCK = 128
ROPE_THETA = 10000.0
NORM_EPS = 1e-6

A_HEADS = 8
A_DK = 128
A_DV = D_MODEL // A_HEADS
A_WIDTH = A_HEADS * A_DK
A_CHUNK = 32
B_HEADS = 16
B_Q_RANK = 384
B_KV_RANK = 256
B_NOPE = 64
B_ROPE = 32
B_V = 64
C_HEADS = 8
C_KV_HEADS = 2
C_HEAD_DIM = 128
D_HEADS = 8
D_QK_DIM = 64
D_V_DIM = 2 * D_QK_DIM
FF_DIM = 3584
N_EXPERTS = 8
TOP_K = 2

kernel_name = "hybrid_latent_diffusion_block"


def rms_norm(x, g):
    xf = x.astype(jnp.float32)
    y = xf * lax.rsqrt(jnp.mean(xf * xf, axis=-1, keepdims=True) + NORM_EPS)
    return (y * g.astype(jnp.float32)).astype(x.dtype)


def modulate(x, shift, scale):
    return x * (1 + scale) + shift


def split_last(z, sizes):
    idx, acc = [], 0
    for s in sizes[:-1]:
        acc += s
        idx.append(acc)
    return jnp.split(z, idx, axis=-1)


def _rotate(x, pos):
    n = x.shape[-1]
    inv = ROPE_THETA ** (-jnp.arange(0, n, 2, dtype=jnp.float32) / n)
    ang = pos.astype(jnp.float32)[:, None] * inv[None, :]
    cos, sin = jnp.cos(ang).astype(x.dtype), jnp.sin(ang).astype(x.dtype)
    x1, x2 = x[..., : n // 2], x[..., n // 2:]
    return jnp.concatenate([x1 * cos - x2 * sin, x2 * cos + x1 * sin], axis=-1)


def axial_rope(x, pos_row, pos_col):
    half = x.shape[-1] // 2
    return jnp.concatenate([_rotate(x[..., :half], pos_row), _rotate(x[..., half:], pos_col)], axis=-1)


def attend(q, k, v, scale):
    s = jnp.einsum("bhgqd,bhkd->bhgqk", q, k, preferred_element_type=jnp.float32) * scale
    p = jax.nn.softmax(s, axis=-1).astype(v.dtype)
    return jnp.einsum("bhgqk,bhkv->bhgqv", p, v)


def blocked_attend(q, k, v, scale):
    b, hk, g, lq, dk = q.shape
    nb = lq // Q_BLOCK
    qb = jnp.moveaxis(q.reshape(b, hk, g, nb, Q_BLOCK, dk), 3, 0)
    ob = lax.map(lambda blk: attend(blk, k, v, scale), qb)
    return jnp.moveaxis(ob, 0, 3).reshape(b, hk, g, lq, v.shape[-1])


def merge_heads(o):
    b, hk, g, l, dv = o.shape
    return o.transpose(0, 3, 1, 2, 4).reshape(b, l, hk * g * dv)


def chunked_gla(q, k, v, log_f, s0, with_output):
    bsz, h, l, _ = k.shape
    dv = v.shape[-1]
    n = l // A_CHUNK

    def chunks(t):
        return jnp.moveaxis(t.reshape(bsz, h, n, A_CHUNK, t.shape[-1]), 2, 0)

    k, v, log_f = chunks(k), chunks(v), chunks(log_f)
    cum = jnp.cumsum(log_f, axis=3)
    cum_end = cum[:, :, :, -1:, :]
    k_to_end = k * jnp.exp(cum_end - cum)
    chunk_decay = jnp.exp(cum_end[:, :, :, 0, :])
    if with_output:
        q_dec = chunks(q) * jnp.exp(cum)
        att = jnp.einsum("nbhcd,nbhsd->nbhcs", q_dec, k * jnp.exp(-cum))
        mask = jnp.tril(jnp.ones((A_CHUNK, A_CHUNK), dtype=bool))
        o_intra = jnp.einsum("nbhcs,nbhsv->nbhcv", jnp.where(mask, att, 0.0), v)
        xs = (q_dec, k_to_end, v, chunk_decay)
    else:
        xs = (k_to_end, v, chunk_decay)

    def step(state, inp):
        if with_output:
            qd, kd, vv, dec = inp
            o = jnp.einsum("bhcd,bhdv->bhcv", qd, state)
        else:
            kd, vv, dec = inp
            o = None
        state = dec[..., None] * state + jnp.einsum("bhcd,bhcv->bhdv", kd, vv)
        return state, o

    s_final, o_inter = lax.scan(step, s0, xs)
    if not with_output:
        return None, s_final
    o = jnp.moveaxis(o_intra + o_inter, 0, 2).reshape(bsz, h, l, dv)
    return o, s_final


def hgrn2_mixer(u_lat, u_ctx, w_in, lb_fwd, lb_bwd, onorm_g, w_out, ctx_out):
    def project(u):
        bsz, l, _ = u.shape
        z = (u @ w_in).astype(jnp.float32)
        q, f_fwd, f_bwd, inp, gate = split_last(
            z, (A_WIDTH, A_WIDTH, A_WIDTH, A_HEADS * A_DV, A_HEADS * A_DV))

        def heads(t):
            return t.reshape(bsz, l, A_HEADS, -1).transpose(0, 2, 1, 3)

        dirs = []
        for f_raw, lb in ((f_fwd, lb_fwd), (f_bwd, lb_bwd)):
            f = lb + (1.0 - lb) * jax.nn.sigmoid(f_raw)
            dirs.append((heads(1.0 - f), heads(jnp.log(f))))
        return heads(q) * A_DK ** -0.5, dirs, heads(inp), gate

    def flip(t):
        return jnp.flip(t, axis=2)

    q_c, (fw_c, bw_c), v_c, gate_c = project(u_ctx)
    q_l, (fw_l, bw_l), v_l, gate_l = project(u_lat)
    s0 = jnp.zeros((u_ctx.shape[0], A_HEADS, A_DK, A_DV), jnp.float32)
    o_cf, s_cf = chunked_gla(q_c, fw_c[0], v_c, fw_c[1], s0, ctx_out)
    o_cb, s_cb = chunked_gla(flip(q_c), flip(bw_c[0]), flip(v_c), flip(bw_c[1]), s0, ctx_out)
    o_lf, _ = chunked_gla(q_l, fw_l[0], v_l, fw_l[1], s_cf, True)
    o_lb, _ = chunked_gla(flip(q_l), flip(bw_l[0]), flip(v_l), flip(bw_l[1]), s_cb, True)

    def readout(o, gate, dtype):
        bsz, _, l, _ = o.shape
        o = rms_norm(o, onorm_g).transpose(0, 2, 1, 3).reshape(bsz, l, A_HEADS * A_DV)
        return (o * jax.nn.silu(gate)).astype(dtype) @ w_out

    y_lat = readout(o_lf + flip(o_lb), gate_l, u_lat.dtype)
    y_ctx = readout(o_cf + flip(o_cb), gate_c, u_ctx.dtype) if ctx_out else None
    return y_lat, y_ctx


def mla_mixer(u_lat, u_ctx, w_in, qnorm_g, kvnorm_g, w_qb, w_kvb, w_out, pos_row, pos_col, ctx_out):
    def project(u, rotary):
        bsz, l, _ = u.shape
        c_q, c_kv, k_rope = split_last(u @ w_in, (B_Q_RANK, B_KV_RANK, B_ROPE))
        q = (rms_norm(c_q, qnorm_g) @ w_qb).reshape(bsz, l, B_HEADS, B_NOPE + B_ROPE).transpose(0, 2, 1, 3)
        kv = (rms_norm(c_kv, kvnorm_g) @ w_kvb).reshape(bsz, l, B_HEADS, B_NOPE + B_V).transpose(0, 2, 1, 3)
        q_nope, q_rope = q[..., :B_NOPE], q[..., B_NOPE:]
        k_nope, v = kv[..., :B_NOPE], kv[..., B_NOPE:]
        k_rope = k_rope[:, None]
        if rotary:
            q_rope = axial_rope(q_rope, pos_row, pos_col)
            k_rope = axial_rope(k_rope, pos_row, pos_col)
        q = jnp.concatenate([q_nope, q_rope], axis=-1)[:, :, None]
        k = jnp.concatenate([k_nope, jnp.broadcast_to(k_rope, k_nope.shape[:3] + (B_ROPE,))], axis=-1)
        return q, k, v

    scale = (B_NOPE + B_ROPE) ** -0.5
    q_c, k_c, v_c = project(u_ctx, False)
    q_l, k_l, v_l = project(u_lat, True)
    o_lat = blocked_attend(q_l, jnp.concatenate([k_c, k_l], axis=2), jnp.concatenate([v_c, v_l], axis=2), scale)
    y_lat = merge_heads(o_lat) @ w_out
    y_ctx = merge_heads(attend(q_c, k_c, v_c, scale)) @ w_out if ctx_out else None
    return y_lat, y_ctx


def gqa_mixer(u_lat, u_ctx, w_in, qnorm_g, knorm_g, w_out, pos_row, pos_col, ctx_out):
    group = C_HEADS // C_KV_HEADS

    def project(u, rotary):
        bsz, l, _ = u.shape
        q, k, v = split_last(u @ w_in, (C_HEADS * C_HEAD_DIM, C_KV_HEADS * C_HEAD_DIM, C_KV_HEADS * C_HEAD_DIM))
        q = rms_norm(q.reshape(bsz, l, C_KV_HEADS, group, C_HEAD_DIM), qnorm_g).transpose(0, 2, 3, 1, 4)
        k = rms_norm(k.reshape(bsz, l, C_KV_HEADS, C_HEAD_DIM), knorm_g).transpose(0, 2, 1, 3)
        v = v.reshape(bsz, l, C_KV_HEADS, C_HEAD_DIM).transpose(0, 2, 1, 3)
        if rotary:
            q = axial_rope(q, pos_row, pos_col)
            k = axial_rope(k, pos_row, pos_col)
        return q, k, v

    scale = C_HEAD_DIM ** -0.5
    q_c, k_c, v_c = project(u_ctx, False)
    q_l, k_l, v_l = project(u_lat, True)
    o_lat = blocked_attend(q_l, jnp.concatenate([k_c, k_l], axis=2), jnp.concatenate([v_c, v_l], axis=2), scale)
    y_lat = merge_heads(o_lat) @ w_out
    y_ctx = merge_heads(attend(q_c, k_c, v_c, scale)) @ w_out if ctx_out else None
    return y_lat, y_ctx


def diff_mixer(u_lat, u_ctx, w_in, lam, onorm_g, w_out, lambda_init, pos_row, pos_col, ctx_out):
    def project(u, rotary):
        bsz, l, _ = u.shape
        q, k, v = split_last(u @ w_in, (2 * D_HEADS * D_QK_DIM, 2 * D_HEADS * D_QK_DIM, D_HEADS * D_V_DIM))
        q = q.reshape(bsz, l, D_HEADS, 2, D_QK_DIM).transpose(0, 3, 2, 1, 4)
        k = k.reshape(bsz, l, D_HEADS, 2, D_QK_DIM).transpose(0, 3, 2, 1, 4)
        v = v.reshape(bsz, l, D_HEADS, D_V_DIM).transpose(0, 2, 1, 3)
        if rotary:
            q = axial_rope(q, pos_row, pos_col)
            k = axial_rope(k, pos_row, pos_col)
        return q, k, v

    lam = lam.astype(jnp.float32)
    lam_full = jnp.exp(jnp.sum(lam[0] * lam[1])) - jnp.exp(jnp.sum(lam[2] * lam[3])) + lambda_init
    scale = D_QK_DIM ** -0.5

    def diff_attn(q, k, v, attn):
        a1 = attn(q[:, 0, :, None], k[:, 0], v, scale)
        a2 = attn(q[:, 1, :, None], k[:, 1], v, scale)
        o = a1 - lam_full.astype(a1.dtype) * a2
        return merge_heads(rms_norm(o, onorm_g) * (1.0 - lambda_init)) @ w_out

    q_c, k_c, v_c = project(u_ctx, False)
    q_l, k_l, v_l = project(u_lat, True)
    y_lat = diff_attn(q_l, jnp.concatenate([k_c, k_l], axis=3), jnp.concatenate([v_c, v_l], axis=2), blocked_attend)
    y_ctx = diff_attn(q_c, k_c, v_c, attend) if ctx_out else None
    return y_lat, y_ctx


def swiglu(h, w_gu, w_down):
    gate, up = jnp.split(h @ w_gu, 2, axis=-1)
    return (jax.nn.silu(gate) * up) @ w_down


def moe_swiglu(h, router, w_gu, w_down):
    logits = jnp.einsum("...d,de->...e", h, router, preferred_element_type=jnp.float32)
    top_v, top_i = lax.top_k(logits, TOP_K)
    wts = jax.nn.softmax(top_v, axis=-1)
    combine = jnp.einsum("...k,...ke->...e", wts, jax.nn.one_hot(top_i, N_EXPERTS, dtype=jnp.float32)).astype(h.dtype)
    out = jnp.zeros_like(h)
    for e in range(N_EXPERTS):
        out = out + combine[..., e:e + 1] * swiglu(h, w_gu[e], w_down[e])
    return out


def setup_inputs(seed: int = 0) -> dict:
    key = jax.random.key(seed)
    ks = jax.random.split(key, 30)

    def nrm(k, shape, scale):
        return jax.random.normal(k, shape, jnp.float32) * scale

    d = D_MODEL
    n_a = len(range(0, DEPTH, N_MIXERS))
    n_b = len(range(1, DEPTH, N_MIXERS))
    n_c = len(range(2, DEPTH, N_MIXERS))
    n_d = len(range(3, DEPTH, N_MIXERS))
    n_dense = len(range(0, DEPTH, 2))
    n_moe = len(range(1, DEPTH, 2))
    a_in = 3 * A_WIDTH + 2 * A_HEADS * A_DV
    b_in = B_Q_RANK + B_KV_RANK + B_ROPE
    c_in = (C_HEADS + 2 * C_KV_HEADS) * C_HEAD_DIM
    d_in = 4 * D_HEADS * D_QK_DIM + D_HEADS * D_V_DIM
    return {
        "x": nrm(ks[0], (BATCH, SEQ, d), 1.0),
        "c": nrm(ks[1], (BATCH, d), 1.0),
        "ctx": nrm(ks[2], (BATCH, CTX_LEN, d), 1.0),
        "c_ctx": nrm(ks[3], (d,), 1.0),
        "mod_w": nrm(ks[4], (DEPTH, d, N_MOD * d), 0.2 * d ** -0.5),
        "mod_b": nrm(ks[5], (DEPTH, N_MOD * d), 0.02),
        "norm_g": 1.0 + nrm(ks[6], (DEPTH, 4, d), 0.05),
        "a_w_in": nrm(ks[7], (n_a, d, a_in), d ** -0.5),
        "a_lb": nrm(ks[8], (2, DEPTH + 1, A_WIDTH), 0.1),
        "a_onorm_g": 1.0 + nrm(ks[9], (n_a, A_DV), 0.05),
        "a_w_out": nrm(ks[10], (n_a, A_HEADS * A_DV, d), (A_HEADS * A_DV) ** -0.5),
        "b_w_in": nrm(ks[11], (n_b, d, b_in), d ** -0.5),
        "b_qnorm_g": 1.0 + nrm(ks[12], (n_b, B_Q_RANK), 0.05),
        "b_kvnorm_g": 1.0 + nrm(ks[13], (n_b, B_KV_RANK), 0.05),
        "b_w_qb": nrm(ks[14], (n_b, B_Q_RANK, B_HEADS * (B_NOPE + B_ROPE)), B_Q_RANK ** -0.5),
        "b_w_kvb": nrm(ks[15], (n_b, B_KV_RANK, B_HEADS * (B_NOPE + B_V)), B_KV_RANK ** -0.5),
        "b_w_out": nrm(ks[16], (n_b, B_HEADS * B_V, d), (B_HEADS * B_V) ** -0.5),
        "c_w_in": nrm(ks[17], (n_c, d, c_in), d ** -0.5),
        "c_qnorm_g": 1.0 + nrm(ks[18], (n_c, C_HEAD_DIM), 0.05),
        "c_knorm_g": 1.0 + nrm(ks[19], (n_c, C_HEAD_DIM), 0.05),
        "c_w_out": nrm(ks[20], (n_c, C_HEADS * C_HEAD_DIM, d), (C_HEADS * C_HEAD_DIM) ** -0.5),
        "d_w_in": nrm(ks[21], (n_d, d, d_in), d ** -0.5),
        "d_lambda": nrm(ks[22], (n_d, 4, D_QK_DIM), 0.1),
        "d_onorm_g": 1.0 + nrm(ks[23], (n_d, D_V_DIM), 0.05),
        "d_w_out": nrm(ks[24], (n_d, D_HEADS * D_V_DIM, d), (D_HEADS * D_V_DIM) ** -0.5),
        "ffn_w_gu": nrm(ks[25], (n_dense, d, 2 * FF_DIM), d ** -0.5),
        "ffn_w_down": nrm(ks[26], (n_dense, FF_DIM, d), FF_DIM ** -0.5),
        "moe_router": nrm(ks[27], (n_moe, d, N_EXPERTS), d ** -0.5),
        "moe_w_gu": nrm(ks[28], (n_moe, N_EXPERTS, d, 2 * FF_DIM), d ** -0.5),
        "moe_w_down": nrm(ks[29], (n_moe, N_EXPERTS, FF_DIM, d), FF_DIM ** -0.5),
    }


def reference(x, c, ctx, c_ctx, mod_w, mod_b, norm_g,
              a_w_in, a_lb, a_onorm_g, a_w_out,
              b_w_in, b_qnorm_g, b_kvnorm_g, b_w_qb, b_w_kvb, b_w_out,
              c_w_in, c_qnorm_g, c_knorm_g, c_w_out,
              d_w_in, d_lambda, d_onorm_g, d_w_out,
              ffn_w_gu, ffn_w_down, moe_router, moe_w_gu, moe_w_down):
    seq_len = x.shape[1]
    rows = seq_len // GRID_W
    pos_row = jnp.repeat(jnp.arange(rows, dtype=jnp.int32), GRID_W)
    pos_col = jnp.arange(rows * GRID_W, dtype=jnp.int32) % GRID_W
    cond_lat = jax.nn.silu(c)
    cond_ctx = jax.nn.silu(c_ctx)
    lower_bounds = jnp.cumsum(jax.nn.softmax(a_lb.astype(jnp.float32), axis=1), axis=1)

    h_lat, h_ctx = x, ctx
    for i in range(DEPTH):
        last = i == DEPTH - 1
        kind, j = i % N_MIXERS, i // N_MIXERS
        mod_lat = jnp.split((cond_lat @ mod_w[i] + mod_b[i])[:, None, :], N_MOD, axis=-1)
        mod_ctx = jnp.split(cond_ctx @ mod_w[i] + mod_b[i], N_MOD, axis=-1)

        u_lat = modulate(rms_norm(h_lat, norm_g[i, 0]), mod_lat[0], mod_lat[1])
        u_ctx = modulate(rms_norm(h_ctx, norm_g[i, 0]), mod_ctx[0], mod_ctx[1])
        if kind == 0:
            y_lat, y_ctx = hgrn2_mixer(u_lat, u_ctx, a_w_in[j], lower_bounds[0, i], lower_bounds[1, i],
                                       a_onorm_g[j], a_w_out[j], not last)
        elif kind == 1:
            y_lat, y_ctx = mla_mixer(u_lat, u_ctx, b_w_in[j], b_qnorm_g[j], b_kvnorm_g[j], b_w_qb[j],
                                     b_w_kvb[j], b_w_out[j], pos_row, pos_col, not last)
        elif kind == 2:
            y_lat, y_ctx = gqa_mixer(u_lat, u_ctx, c_w_in[j], c_qnorm_g[j], c_knorm_g[j], c_w_out[j],
                                     pos_row, pos_col, not last)
        else:
            lambda_init = 0.8 - 0.6 * math.exp(-0.3 * i)
            y_lat, y_ctx = diff_mixer(u_lat, u_ctx, d_w_in[j], d_lambda[j], d_onorm_g[j], d_w_out[j],
                                      lambda_init, pos_row, pos_col, not last)
        h_lat = h_lat + mod_lat[2] * rms_norm(y_lat, norm_g[i, 1])

        def channel_mix(u):
            if i % 2 == 0:
                return swiglu(u, ffn_w_gu[i // 2], ffn_w_down[i // 2])
            return moe_swiglu(u, moe_router[i // 2], moe_w_gu[i // 2], moe_w_down[i // 2])

        u_lat = modulate(rms_norm(h_lat, norm_g[i, 2]), mod_lat[3], mod_lat[4])
        h_lat = h_lat + mod_lat[5] * rms_norm(channel_mix(u_lat), norm_g[i, 3])
        if not last:
            h_ctx = h_ctx + mod_ctx[2] * rms_norm(y_ctx, norm_g[i, 1])
            u_ctx = modulate(rms_norm(h_ctx, norm_g[i, 2]), mod_ctx[3], mod_ctx[4])
            h_ctx = h_ctx + mod_ctx[5] * rms_norm(channel_mix(u_ctx), norm_g[i, 3])
    return h_lat
```

```cpp
#include <hip/hip_runtime.h>
#include <cstdio>
#include <cstdint>

#define GAS __attribute__((address_space(1)))
#define LAS __attribute__((address_space(3)))
typedef unsigned short bf16_t;
typedef short bf16x8 __attribute__((ext_vector_type(8)));
typedef short s16x4 __attribute__((ext_vector_type(4)));
typedef float f32x2 __attribute__((ext_vector_type(2)));
typedef float f32x4 __attribute__((ext_vector_type(4)));
typedef float f32x16 __attribute__((ext_vector_type(16)));
typedef unsigned u32x2 __attribute__((ext_vector_type(2)));
typedef unsigned u32x4 __attribute__((ext_vector_type(4)));

__device__ __forceinline__ float bf2f(unsigned b) { return __uint_as_float(b << 16); }
__device__ __forceinline__ unsigned f2bf(float f) { unsigned u = __float_as_uint(f); return (u + 0x7fffu + ((u >> 16) & 1u)) >> 16; }
__device__ __forceinline__ unsigned pk2(float lo, float hi) { return f2bf(lo) | (f2bf(hi) << 16); }
__device__ __forceinline__ unsigned cvt_pk_bf16(float lo, float hi) { unsigned r; asm volatile("v_cvt_pk_bf16_f32 %0, %1, %2" : "=v"(r) : "v"(lo), "v"(hi)); return r; }
typedef int v8i32 __attribute__((ext_vector_type(8)));
__device__ __forceinline__ unsigned pk4_fp8(float a, float b, float c, float d) { int w = 0; w = __builtin_amdgcn_cvt_pk_fp8_f32(a, b, w, false); w = __builtin_amdgcn_cvt_pk_fp8_f32(c, d, w, true); asm volatile("s_nop 1" : "+v"(w)); return (unsigned)w; }
__device__ __forceinline__ float wave_sum(float v) {
#pragma unroll
    for (int o = 1; o < 64; o <<= 1) v += __shfl_xor(v, o);
    return v;
}
__device__ __forceinline__ int fresh_lane() { int l; asm volatile("v_mbcnt_lo_u32_b32 %0, -1, 0\n\tv_mbcnt_hi_u32_b32 %0, -1, %0" : "=v"(l)); return l; }
__device__ __forceinline__ float fast_exp(float x) { return __builtin_amdgcn_exp2f(x * 1.4426950408889634f); }
__device__ __forceinline__ float fast_rcp(float x) { return __builtin_amdgcn_rcpf(x); }
__device__ __forceinline__ float silu_f(float x) { return x * fast_rcp(1.0f + fast_exp(-x)); }

#ifndef MK_WT
#define MK_WT 0
#endif
__device__ __forceinline__ void st16(void* p, u32x4 v) {
#if MK_WT
    asm volatile("global_store_dwordx4 %0, %1, off sc1\n\ts_nop 1" :: "v"(p), "v"(v) : "memory");
#else
    *(u32x4*)p = v;
#endif
}
__device__ __forceinline__ void st16f(void* p, f32x4 v) { st16(p, __builtin_bit_cast(u32x4, v)); }

namespace pg8 {
constexpr int BM = 256, BK = 64, HALF = 128, HTB = HALF * BK * 2, STAGE_BYTES = 8 * HTB, NXCD = 8, WGM = 8;
__host__ __device__ __forceinline__ int lds_byte(int r, int c) { const int st = (r >> 4) * 2 + (c >> 5), rr = r & 15, cc = c & 31, ob = rr * 64 + cc * 2; return st * 1024 + (ob ^ (((ob >> 9) & 1) << 5)); }
__host__ __device__ __forceinline__ void stage_rc(int b, int& R, int& C) { const int st = b / 1024, sb = b % 1024, swz = sb ^ (((sb >> 9) & 1) << 5); R = (st >> 1) * 16 + swz / 64; C = (st & 1) * 32 + (swz % 64) / 2; }
__host__ __device__ __forceinline__ int perm32(int rho) { const int n = rho >> 4, i = rho & 15; return 8 * (i >> 2) + 4 * n + (i & 3); }

struct Unit { int pm, pn, e, pl, po, kt0; };
struct Gemm { const bf16_t* A; const bf16_t* Bt; int nt  , N, K  ; size_t bstride; const int* list; int list_stride; const LAS int* cnt; };

struct StaticOrder {
    int nM, nN, nwg, G, c, dup;
    __device__ __forceinline__ void init(int nM_, int nN_, int G_, int c_, int dup_ = 1) { nM = nM_; nN = nN_; nwg = nM * nN; G = G_; c = c_; dup = dup_; }
    __device__ __forceinline__ bool next(int i, Unit& u) const {
        const long L = (long)i * G + c; if (L >= (long)nwg * dup) return false;
        int wgid = (int)L; if (dup > 1) wgid = (int)((unsigned)wgid % (unsigned)nwg); { const int q = nwg / NXCD, r = nwg % NXCD, xcd = wgid % NXCD, off = wgid / NXCD; wgid = (xcd < r ? xcd * (q + 1) : r * (q + 1) + (xcd - r) * q) + off; }
        const int nig = WGM * nN, gid = wgid / nig, fm = gid * WGM, gsz = (nM - fm) < WGM ? (nM - fm) : WGM;
        u.pm = fm + ((wgid % nig) % gsz); u.pn = (wgid % nig) / gsz; u.e = 0; u.pl = 0; u.po = u.pm; u.kt0 = 0; return true;
    }
};
struct MoeOrder {
    StaticOrder so; const LAS int* rb0;
    __device__ __forceinline__ bool next(int i, Unit& u) const {
        if (!so.next(i, u)) return false;
        int e = 0;
#pragma unroll
        for (int j = 1; j < 8; ++j) e = (u.pm >= rb0[j]) ? j : e;
        u.e = e; u.pl = u.pm - rb0[e]; u.po = u.pm; u.kt0 = 0; return true;
    }
};

__device__ __forceinline__ void moe_tail_params(int NRB, int& RBM, int& trb, int& S) { RBM = (NRB >> 6) << 6; trb = NRB - RBM; S = trb <= 4 ? 14 : trb <= 9 ? 7 : trb <= 16 ? 4 : trb <= 32 ? 2 : 1; }
struct MoeTailOrder {
    int RBM, trb, S, ntsub, G, c0, dup; const LAS int* rb0;
    __device__ __forceinline__ bool next(int i, Unit& u) const { int L = i * G + c0; const int n = trb * 4 * S; if (L >= n * dup) return false; if (dup > 1) L %= n;
        const int s = L % S, r = L / S; u.pn = r & 3; const int tb = r >> 2; u.pm = RBM + tb; u.po = s * trb + tb; u.kt0 = s * ntsub; u.pl = 0;
        int e = 0;
#pragma unroll
        for (int j = 1; j < 8; ++j) e = (u.pm >= rb0[j]) ? j : e;
        u.e = e; return true; }
};
struct LatOrder {
    StaticOrder so;
    __device__ __forceinline__ bool next(int i, Unit& u) const { if (!so.next(i, u)) return false; u.pm = (u.pm >> 4) * 17 + 1 + (u.pm & 15); u.po = u.pm; return true; }
};
struct CtxSplitOrder {
    int nN, S, ntsub, G, c0, dup;
    __device__ __forceinline__ bool next(int i, Unit& u) const { int L = i * G + c0; if (L >= 8 * nN * S * dup) return false; if (dup > 1) L %= 8 * nN * S;
        const int s = L % S, r = L / S; u.pn = r % nN; const int c = r / nN; u.pm = 17 * c; u.po = s * 8 + c; u.kt0 = s * ntsub; u.e = 0; u.pl = 0; return true; }
};

struct EpiF32 {
    static constexpr bool PERM = false;
    float* C; int ldc;
    __device__ __forceinline__ void operator()(const f32x4 (&acc)[2][2][4][2], const Unit& u, int wr, int wc, int fr, int fq) const {
        const int row0 = u.po * BM + wr * 64 + fr, col0 = u.pn * BM + wc * 32 + 4 * fq;
#pragma unroll
        for (int ai = 0; ai < 2; ++ai)
#pragma unroll
            for (int m = 0; m < 4; ++m) { float* rowp = C + (size_t)(row0 + ai * HALF + m * 16) * ldc + col0;
#pragma unroll
                for (int bj = 0; bj < 2; ++bj)
#pragma unroll
                    for (int n = 0; n < 2; ++n) st16f(rowp + bj * HALF + n * 16, acc[ai][bj][m][n]); }
    }
};
struct EpiBf16 {
    static constexpr bool PERM = true;
    bf16_t* O; int ldc;
    __device__ __forceinline__ void operator()(const f32x4 (&acc)[2][2][4][2], const Unit& u, int wr, int wc, int fr, int fq) const {
        const int row0 = u.po * BM + wr * 64 + fr, col0 = u.pn * BM + wc * 32 + 8 * fq;
#pragma unroll
        for (int ai = 0; ai < 2; ++ai)
#pragma unroll
            for (int m = 0; m < 4; ++m) { bf16_t* rowp = O + (size_t)(row0 + ai * HALF + m * 16) * ldc + col0;
#pragma unroll
                for (int bj = 0; bj < 2; ++bj) { const f32x4 v0 = acc[ai][bj][m][0], v1 = acc[ai][bj][m][1];
                    u32x4 w; w.x = cvt_pk_bf16(v0[0], v0[1]); w.y = cvt_pk_bf16(v0[2], v0[3]); w.z = cvt_pk_bf16(v1[0], v1[1]); w.w = cvt_pk_bf16(v1[2], v1[3]);
                    st16(rowp + bj * HALF, w); } }
    }
};
struct EpiSwiglu {
    static constexpr bool PERM = true;
    bf16_t* O; int ldc; float sc;
    __device__ __forceinline__ void operator()(const f32x4 (&acc)[2][2][4][2], const Unit& u, int wr, int wc, int fr, int fq) const {
        const int row0 = u.po * BM + wr * 64 + fr, col0 = u.pn * HALF + wc * 32 + 8 * fq;
        const float k1 = -1.4426950408889634f * sc, c2 = 1.0f / (sc * sc);
#pragma unroll
        for (int ai = 0; ai < 2; ++ai)
#pragma unroll
            for (int m = 0; m < 4; ++m) { bf16_t* rowp = O + (size_t)(row0 + ai * HALF + m * 16) * ldc + col0;
                float r[8];
#pragma unroll
                for (int n = 0; n < 2; ++n)
#pragma unroll
                    for (int j = 0; j < 4; ++j) { const float ag = acc[ai][0][m][n][j], au = acc[ai][1][m][n][j];
                        const float e = __builtin_amdgcn_exp2f(ag * k1); r[n * 4 + j] = (ag * au) * __builtin_amdgcn_rcpf(fmaf(e, c2, c2)); }
                u32x4 w; w.x = cvt_pk_bf16(r[0], r[1]); w.y = cvt_pk_bf16(r[2], r[3]); w.z = cvt_pk_bf16(r[4], r[5]); w.w = cvt_pk_bf16(r[6], r[7]);
                st16(rowp, w); }
    }
};
constexpr int HM_TPB = 4352;
struct EpiKV {
    static constexpr bool PERM = true;
    bf16_t* Kp; int ldk; bf16_t* Vp; int ldv;
    __device__ __forceinline__ void operator()(const f32x4 (&acc)[2][2][4][2], const Unit& u, int wr, int wc, int fr, int fq) const {
        const int row0 = u.po * BM + wr * 64 + fr, within = wc * 32 + 8 * fq, bb = u.po / 17;
#pragma unroll
        for (int ai = 0; ai < 2; ++ai)
#pragma unroll
            for (int m = 0; m < 4; ++m) { const size_t row = (size_t)(row0 + ai * HALF + m * 16);
#pragma unroll
                for (int bj = 0; bj < 2; ++bj) { const int head = u.pn * 2 + bj; const f32x4 v0 = acc[ai][bj][m][0], v1 = acc[ai][bj][m][1];
                    u32x4 w; w.x = cvt_pk_bf16(v0[0], v0[1]); w.y = cvt_pk_bf16(v0[2], v0[3]); w.z = cvt_pk_bf16(v1[0], v1[1]); w.w = cvt_pk_bf16(v1[2], v1[3]);
                    const size_t hrow = (size_t)(bb * 16 + head) * HM_TPB + (row - (size_t)bb * HM_TPB);
                    bf16_t* dst = (within < 64) ? (Kp + hrow * 96 + within) : (Vp + hrow * 64 + (within - 64));
                    st16(dst, w); } }
    }
};

struct EpiRopeD {
    static constexpr bool PERM = true;
    bf16_t* Qp; bf16_t* Kp; bf16_t* Vp; const float* rt; float qs;
    __device__ __forceinline__ void operator()(const f32x4 (&acc)[2][2][4][2], const Unit& u, int wr, int wc, int fr, int fq) const {
        const int row0 = u.po * BM + wr * 64 + fr, cw = wc * 32 + 8 * fq, bb = u.po / 17;
        if (u.pn >= 8) {
#pragma unroll
            for (int ai = 0; ai < 2; ++ai)
#pragma unroll
                for (int m = 0; m < 4; ++m) { const size_t prow = (size_t)(row0 + ai * HALF + m * 16) - (size_t)bb * HM_TPB;
#pragma unroll
                    for (int bj = 0; bj < 2; ++bj) { const f32x4 v0 = acc[ai][bj][m][0], v1 = acc[ai][bj][m][1];
                        u32x4 w; w.x = cvt_pk_bf16(v0[0], v0[1]); w.y = cvt_pk_bf16(v0[2], v0[3]); w.z = cvt_pk_bf16(v1[0], v1[1]); w.w = cvt_pk_bf16(v1[2], v1[3]);
                        const int vh = (u.pn - 8) * 2 + bj;
                        st16(Vp + ((size_t)(bb * 8 + vh) * HM_TPB + prow) * 128 + cw, w); } }
            return; }
        const bool isq = u.pn < 4; const float osc = isq ? qs : 1.0f;
        const int tb = u.pm % 17; const bool isctx = (tb == 0), colpart = (wc & 1) != 0, x2 = (fq & 2) != 0;
        const int f0 = 8 * (fq & 1);
#pragma unroll
        for (int ai = 0; ai < 2; ++ai)
#pragma unroll
            for (int m = 0; m < 4; ++m) {
                const int pos = colpart ? (16 * m + fr) : ((tb - 1) * 4 + 2 * ai + wr);
                f32x4 cs[4];
#pragma unroll
                for (int q = 0; q < 4; ++q) cs[q] = isctx ? (f32x4){1.f, 0.f, 1.f, 0.f} : *(const f32x4*)(rt + ((size_t)(isctx ? 0 : pos) * 32 + f0 + 2 * q) * 2);
                const size_t grow = (size_t)(row0 + ai * HALF + m * 16), prow = grow - (size_t)bb * HM_TPB;
#pragma unroll
                for (int bj = 0; bj < 2; ++bj) { float r[8];
#pragma unroll
                    for (int e = 0; e < 8; ++e) { const float x = acc[ai][bj][m][e >> 2][e & 3] * osc; const float xp = __shfl_xor(x, 32);
                        const float c = cs[e >> 1][2 * (e & 1)], sn = cs[e >> 1][2 * (e & 1) + 1];
                        r[e] = x2 ? (x * c + xp * sn) : (x * c - xp * sn); }
                    u32x4 w; w.x = cvt_pk_bf16(r[0], r[1]); w.y = cvt_pk_bf16(r[2], r[3]); w.z = cvt_pk_bf16(r[4], r[5]); w.w = cvt_pk_bf16(r[6], r[7]);
                    const int cc = cw + bj * HALF;
                    bf16_t* dst = isq ? Qp + grow * 1024 + u.pn * BM + cc : Kp + ((size_t)(bb * 16 + (u.pn - 4) * 4 + (cc >> 6)) * HM_TPB + prow) * 64 + (cc & 63);
                    st16(dst, w); } }
    }
};

struct EpiRopeB {
    static constexpr bool PERM = true;
    bf16_t* O; const float* rt; float qs;
    __device__ __forceinline__ void operator()(const f32x4 (&acc)[2][2][4][2], const Unit& u, int wr, int wc, int fr, int fq) const {
        const int row0 = u.po * BM + wr * 64 + fr, col0 = u.pn * BM + wc * 32 + 8 * fq;
        const int tb = u.pm % 17; const bool isctx = (tb == 0), colpart = (fq & 2) != 0, x2 = (fq & 1) != 0;
#pragma unroll
        for (int ai = 0; ai < 2; ++ai)
#pragma unroll
            for (int m = 0; m < 4; ++m) {
                const int pos = colpart ? (16 * m + fr) : ((tb - 1) * 4 + 2 * ai + wr);
                f32x4 cs[4];
#pragma unroll
                for (int q = 0; q < 4; ++q) cs[q] = isctx ? (f32x4){1.f, 0.f, 1.f, 0.f} : *(const f32x4*)(rt + ((size_t)(isctx ? 0 : pos) * 32 + 2 * q) * 2);
                bf16_t* rowp = O + (size_t)(row0 + ai * HALF + m * 16) * 1536 + col0;
#pragma unroll
                for (int bj = 0; bj < 2; ++bj) { const bool rope = ((u.pn * 8 + bj * 4 + wc) % 3) == 2;
                    float r[8];
#pragma unroll
                    for (int e = 0; e < 8; ++e) { const float x = acc[ai][bj][m][e >> 2][e & 3] * qs; const float xp = __shfl_xor(x, 16);
                        const float c = cs[e >> 1][2 * (e & 1)], sn = cs[e >> 1][2 * (e & 1) + 1];
                        r[e] = rope ? (x2 ? (x * c + xp * sn) : (x * c - xp * sn)) : x; }
                    u32x4 w; w.x = cvt_pk_bf16(r[0], r[1]); w.y = cvt_pk_bf16(r[2], r[3]); w.z = cvt_pk_bf16(r[4], r[5]); w.w = cvt_pk_bf16(r[6], r[7]);
                    st16(rowp + bj * HALF, w); } }
    }
};

struct EpiNormRopeC {
    static constexpr bool PERM = true;
    bf16_t* Qp; bf16_t* Kp; bf16_t* Vp; const float* qg; const float* kg; const float* rt; LAS float* xch; float qs;
    __device__ __forceinline__ void operator()(const f32x4 (&acc)[2][2][4][2], const Unit& u, int wr, int wc, int fr, int fq) const {
        const int row0 = u.po * BM + wr * 64 + fr, bb = u.po / 17;
        if (u.pn == 5) {
#pragma unroll
            for (int ai = 0; ai < 2; ++ai)
#pragma unroll
                for (int m = 0; m < 4; ++m) { const size_t prow = (size_t)(row0 + ai * HALF + m * 16) - (size_t)bb * HM_TPB;
#pragma unroll
                    for (int bj = 0; bj < 2; ++bj) { const f32x4 v0 = acc[ai][bj][m][0], v1 = acc[ai][bj][m][1];
                        u32x4 w; w.x = cvt_pk_bf16(v0[0], v0[1]); w.y = cvt_pk_bf16(v0[2], v0[3]); w.z = cvt_pk_bf16(v1[0], v1[1]); w.w = cvt_pk_bf16(v1[2], v1[3]);
                        st16(Vp + ((size_t)(bb * 2 + bj) * HM_TPB + prow) * 128 + wc * 32 + 8 * fq, w); } }
            asm volatile("s_waitcnt lgkmcnt(0)" ::: "memory"); __builtin_amdgcn_s_barrier(); asm volatile("" ::: "memory");
            return; }
#pragma unroll
        for (int ai = 0; ai < 2; ++ai)
#pragma unroll
            for (int m = 0; m < 4; ++m)
#pragma unroll
                for (int bj = 0; bj < 2; ++bj) { const f32x4 v0 = acc[ai][bj][m][0], v1 = acc[ai][bj][m][1];
                    float sq = (v0[0] * v0[0] + v0[1] * v0[1]) + (v0[2] * v0[2] + v0[3] * v0[3]) + (v1[0] * v1[0] + v1[1] * v1[1]) + (v1[2] * v1[2] + v1[3] * v1[3]);
                    sq += __shfl_xor(sq, 16); sq += __shfl_xor(sq, 32);
                    if (fq == 0) xch[((ai * HALF + wr * 64 + m * 16 + fr) * 2 + bj) * 4 + wc] = sq; }
        asm volatile("s_waitcnt lgkmcnt(0)" ::: "memory"); __builtin_amdgcn_s_barrier(); asm volatile("" ::: "memory");
        const bool isq = u.pn < 4; const float* gv = isq ? qg : kg;
        const int d0 = 64 * (wc >> 1) + 32 * (fq >> 1) + 16 * (wc & 1) + 8 * (fq & 1);
        const f32x4 ga = *(const f32x4*)(gv + d0), gb = *(const f32x4*)(gv + d0 + 4);
        const int tb = u.pm % 17; const bool isctx = (tb == 0), colpart = (wc >> 1) != 0, x2 = (fq >> 1) != 0;
        const int f0 = d0 & 31;
#pragma unroll
        for (int ai = 0; ai < 2; ++ai)
#pragma unroll
            for (int m = 0; m < 4; ++m) {
                const int pos = colpart ? (16 * m + fr) : ((tb - 1) * 4 + 2 * ai + wr);
                f32x4 cs[4];
#pragma unroll
                for (int q = 0; q < 4; ++q) cs[q] = isctx ? (f32x4){1.f, 0.f, 1.f, 0.f} : *(const f32x4*)(rt + ((size_t)(isctx ? 0 : pos) * 32 + f0 + 2 * q) * 2);
                const int rl = ai * HALF + wr * 64 + m * 16 + fr; const size_t row = (size_t)(row0 + ai * HALF + m * 16);
#pragma unroll
                for (int bj = 0; bj < 2; ++bj) { const f32x4 ps = *(const LAS f32x4*)(xch + (rl * 2 + bj) * 4);
                    const float rstd = rsqrtf(((ps[0] + ps[1]) + (ps[2] + ps[3])) * (1.0f / 128.0f) + 1e-6f) * (isq ? qs : 1.0f);
                    const int head = 2 * u.pn + bj; float r[8];
#pragma unroll
                    for (int e = 0; e < 8; ++e) { const float y = acc[ai][bj][m][e >> 2][e & 3] * rstd * (e < 4 ? ga[e] : gb[e - 4]); const float yp = __shfl_xor(y, 32);
                        const float c = cs[e >> 1][2 * (e & 1)], sn = cs[e >> 1][2 * (e & 1) + 1];
                        r[e] = x2 ? (y * c + yp * sn) : (y * c - yp * sn); }
                    u32x4 w; w.x = cvt_pk_bf16(r[0], r[1]); w.y = cvt_pk_bf16(r[2], r[3]); w.z = cvt_pk_bf16(r[4], r[5]); w.w = cvt_pk_bf16(r[6], r[7]);
                    bf16_t* dst = isq ? Qp + row * 1024 + head * 128 + d0 : Kp + ((size_t)(bb * 2 + (head - 8)) * HM_TPB + (row - (size_t)bb * HM_TPB)) * 128 + d0;
                    st16(dst, w); } }
    }
};

template <class Epi, class Sched, bool GATHER, bool FP8 = false>
__device__ __forceinline__ void gemm_phase(LAS unsigned char* lds, const Gemm g, const Sched& S, const Epi& E, const int wid) {
    const int lane = fresh_lane(), tid = wid * 64 + lane, wr = wid >> 2, wc = wid & 3, fr = lane & 15, fq = lane >> 4;
    const int K = g.K, nt = g.nt;
    unsigned voffA[2], voffB[2];
#pragma unroll
    for (int i = 0; i < 2; ++i) { int R, C; stage_rc(tid * 16 + i * 8192, R, C); const int Rb = Epi::PERM ? ((R & ~31) + perm32(R & 31)) : R;
        voffA[i] = (unsigned)(R * K + C) * 2u; voffB[i] = (unsigned)(Rb * K + C) * 2u; }
    const size_t kstep = (size_t)(BK * 2);
    const size_t hstep = (size_t)HALF * K * 2;
    const size_t tstep = 2 * hstep;
    const unsigned ldsw = (unsigned)wid * 1024u;
    const int aoff = lds_byte(wr * 64 + fr, fq * 8), boff = lds_byte(wc * 32 + fr, fq * 8);
#define PG8_SA(b, h) (((b) * 2 + (h)) * HTB)
#define PG8_SB(b, h) ((4 + (b) * 2 + (h)) * HTB)
#define PG8_STAGE(bufoff, gbase, voff) do { _Pragma("unroll") for (int _i = 0; _i < 2; ++_i) \
        __builtin_amdgcn_global_load_lds((const unsigned*)((const char*)(gbase) + (voff)[_i]), (LAS unsigned*)(lds + (bufoff) + ldsw + _i * 8192), 16, 0, 0); } while (0)
#define PG8_STAGE_A(bufoff, Ap, G, h, kb) do { if constexpr (GATHER) { PG8_STAGE(bufoff, (const char*)g.A + (kb), (G)[h]); } else { PG8_STAGE(bufoff, (Ap) + (size_t)(h) * hstep + (kb), voffA); } } while (0)
#define PG8_LD16(off) (*(const LAS u32x4*)(lds + (off)))
#define PG8_LDA(dst, b, h) do { _Pragma("unroll") for (int m = 0; m < 4; ++m) { if constexpr (FP8) { dst##8[m] = __builtin_bit_cast(v8i32, __builtin_shufflevector(PG8_LD16(PG8_SA(b, h) + aoff + m * 2048), PG8_LD16(PG8_SA(b, h) + aoff + m * 2048 + 1024), 0, 1, 2, 3, 4, 5, 6, 7)); } \
        else { _Pragma("unroll") for (int k = 0; k < 2; ++k) dst[m][k] = *(const LAS bf16x8*)(lds + PG8_SA(b, h) + aoff + m * 2048 + k * 1024); } } } while (0)
#define PG8_LDB(dst, b, h) do { _Pragma("unroll") for (int n = 0; n < 2; ++n) { if constexpr (FP8) { dst##8[n] = __builtin_bit_cast(v8i32, __builtin_shufflevector(PG8_LD16(PG8_SB(b, h) + boff + n * 2048), PG8_LD16(PG8_SB(b, h) + boff + n * 2048 + 1024), 0, 1, 2, 3, 4, 5, 6, 7)); } \
        else { _Pragma("unroll") for (int k = 0; k < 2; ++k) dst[n][k] = *(const LAS bf16x8*)(lds + PG8_SB(b, h) + boff + n * 2048 + k * 1024); } } } while (0)
#define PG8_MMA(ai, bj, At, Bt) do { __builtin_amdgcn_s_setprio(1); _Pragma("unroll") for (int m = 0; m < 4; ++m) _Pragma("unroll") for (int n = 0; n < 2; ++n) { \
        if constexpr (FP8) { asm volatile("v_mfma_scale_f32_16x16x128_f8f6f4 %0, %1, %2, %0, %3, %3 op_sel_hi:[0,0,0]" : "+v"(acc[ai][bj][m][n]) : "v"(Bt##8[n]), "v"(At##8[m]), "v"(sc7f)); } \
        else { _Pragma("unroll") for (int k = 0; k < 2; ++k) acc[ai][bj][m][n] = __builtin_amdgcn_mfma_f32_16x16x32_bf16(Bt[n][k], At[m][k], acc[ai][bj][m][n], 0, 0, 0); } } \
        __builtin_amdgcn_s_setprio(0); } while (0)
#define PG8_WAIT_V(n) asm volatile("s_waitcnt vmcnt(" #n ")" ::: "memory")
#define PG8_WAIT_L(n) asm volatile("s_waitcnt lgkmcnt(" #n ")" ::: "memory")
#define PG8_BAR __builtin_amdgcn_s_barrier()
#define PG8_SCHED __builtin_amdgcn_sched_barrier(0)
    LAS unsigned char* tokt = lds + STAGE_BYTES;
#define PG8_TOKDMA(u, slot) do { if constexpr (GATHER) { if (wid < 4) { const unsigned _cn = (unsigned)g.cnt[(u).e]; const unsigned _s = (unsigned)((u).pl * BM + tid); \
        __builtin_amdgcn_global_load_lds((const unsigned*)(g.list + (size_t)(u).e * g.list_stride + (_s < _cn ? _s : _cn - 1u)), (LAS unsigned*)(tokt + (slot) * 1024 + wid * 256), 4, 0, 0); } } } while (0)
#define PG8_GOFFS(go, slot) do { if constexpr (GATHER) { \
        _Pragma("unroll") for (int _h = 0; _h < 2; ++_h) _Pragma("unroll") for (int _i = 0; _i < 2; ++_i) { int _R, _C; stage_rc(tid * 16 + _i * 8192, _R, _C); \
            const unsigned _t = *(const LAS unsigned*)(tokt + (slot) * 1024 + (_h * HALF + _R) * 4); (go)[_h][_i] = (_t * (unsigned)K + (unsigned)_C) * 2u; } } } while (0)
    Unit cur, nxt; int ui = 0;
    if (!S.next(0, cur)) return;
    f32x4 acc[2][2][4][2];
#pragma unroll
    for (int a = 0; a < 2; ++a)
#pragma unroll
        for (int b = 0; b < 2; ++b)
#pragma unroll
            for (int m = 0; m < 4; ++m)
#pragma unroll
                for (int n = 0; n < 2; ++n) acc[a][b][m][n] = (f32x4){0.f, 0.f, 0.f, 0.f};
    const unsigned sc7f = 0x7F7F7F7Fu;
    bf16x8 At[4][2], B0[2][2], B1[2][2]; v8i32 At8[4], B08[2], B18[2];
    unsigned gcur[2][2] = {{0u, 0u}, {0u, 0u}};
    const char* cA = (const char*)g.A + (size_t)cur.pm * tstep + (size_t)cur.kt0 * kstep; const char* cB = (const char*)g.Bt + ((size_t)cur.e * g.bstride) * 2 + (size_t)cur.pn * tstep + (size_t)cur.kt0 * kstep;
    if constexpr (GATHER) { PG8_TOKDMA(cur, 0); asm volatile("s_waitcnt vmcnt(0)" ::: "memory"); __builtin_amdgcn_s_barrier(); asm volatile("" ::: "memory"); }
    PG8_GOFFS(gcur, 0);
    PG8_STAGE(PG8_SB(0, 0), cB, voffB); PG8_STAGE(PG8_SB(0, 1), cB + hstep, voffB); PG8_STAGE_A(PG8_SA(0, 0), cA, gcur, 0, 0); PG8_STAGE_A(PG8_SA(0, 1), cA, gcur, 1, 0);
    if (wr == 1) PG8_BAR;
    PG8_WAIT_V(2); PG8_BAR;
    PG8_STAGE(PG8_SB(1, 0), cB + kstep, voffB); PG8_STAGE_A(PG8_SA(1, 0), cA, gcur, 0, kstep); PG8_STAGE(PG8_SB(1, 1), cB + hstep + kstep, voffB);
    PG8_WAIT_V(6); PG8_BAR;
    for (;;) {
        const bool has_next = S.next(ui + 1, nxt);
        if constexpr (GATHER) { if (has_next) PG8_TOKDMA(nxt, (ui + 1) & 1); }
        const char* nA = has_next ? (const char*)g.A + (size_t)nxt.pm * tstep + (size_t)nxt.kt0 * kstep : cA; const char* nB = has_next ? (const char*)g.Bt + ((size_t)nxt.e * g.bstride) * 2 + (size_t)nxt.pn * tstep + (size_t)nxt.kt0 * kstep : cB;
#pragma unroll 1
        for (int t = 0; t < nt; t += 2) {
            const bool last = (t == nt - 2);
            const size_t kb1 = (size_t)(t + 1) * kstep;
            const char* a2p = last ? nA : cA; const size_t kb2 = last ? (size_t)0 : (size_t)(t + 2) * kstep;
            const char* b2 = last ? nB : cB + (size_t)(t + 2) * kstep;
            const size_t kb3 = kb2 + kstep; const char* b3 = b2 + kstep;
            PG8_LDB(B0, 0, 0); PG8_LDB(B1, 0, 1); PG8_SCHED; PG8_LDA(At, 0, 0); PG8_STAGE_A(PG8_SA(1, 1), cA, gcur, 1, kb1);
            if constexpr (GATHER) { if (last && has_next) { PG8_GOFFS(gcur, (ui + 1) & 1); } }
            PG8_WAIT_V(8); PG8_WAIT_L(0); PG8_BAR; PG8_MMA(0, 0, At, B0); PG8_MMA(0, 1, At, B1); PG8_BAR; PG8_SCHED;
            PG8_LDA(At, 0, 1); PG8_STAGE(PG8_SB(0, 0), b2, voffB); PG8_STAGE(PG8_SB(0, 1), b2 + hstep, voffB); PG8_STAGE_A(PG8_SA(0, 0), a2p, gcur, 0, kb2);
            PG8_WAIT_V(8); PG8_WAIT_L(0); PG8_BAR; PG8_MMA(1, 0, At, B0); PG8_MMA(1, 1, At, B1); PG8_BAR; PG8_SCHED;
            PG8_LDB(B0, 1, 0); PG8_LDB(B1, 1, 1); PG8_SCHED; PG8_LDA(At, 1, 0); PG8_STAGE_A(PG8_SA(0, 1), a2p, gcur, 1, kb2);
            PG8_WAIT_V(8); PG8_WAIT_L(0); PG8_BAR; PG8_MMA(0, 0, At, B0); PG8_MMA(0, 1, At, B1); PG8_BAR; PG8_SCHED;
            PG8_LDA(At, 1, 1); PG8_STAGE(PG8_SB(1, 0), b3, voffB); PG8_STAGE(PG8_SB(1, 1), b3 + hstep, voffB); PG8_STAGE_A(PG8_SA(1, 0), a2p, gcur, 0, kb3);
            PG8_WAIT_V(8); PG8_WAIT_L(0); PG8_BAR; PG8_MMA(1, 0, At, B0); PG8_MMA(1, 1, At, B1); PG8_BAR; PG8_SCHED;
        }
        if (wr == 0) PG8_BAR;
        if constexpr (FP8) asm volatile("s_nop 15\n\ts_nop 15\n\ts_nop 15\n\ts_nop 15" ::: "memory");
        E(acc, cur, wr, wc, fr, fq);
        if (!has_next) break;
#pragma unroll
        for (int a = 0; a < 2; ++a)
#pragma unroll
            for (int b = 0; b < 2; ++b)
#pragma unroll
                for (int m = 0; m < 4; ++m)
#pragma unroll
                    for (int n = 0; n < 2; ++n) acc[a][b][m][n] = (f32x4){0.f, 0.f, 0.f, 0.f};
        cur = nxt; cA = nA; cB = nB; ++ui;
        if (wr == 1) PG8_BAR;
    }
    PG8_WAIT_V(0);
    PG8_BAR;
#undef PG8_SA
#undef PG8_SB
#undef PG8_STAGE
#undef PG8_STAGE_A
#undef PG8_LDA
#undef PG8_LDB
#undef PG8_MMA
#undef PG8_LD16
#undef PG8_WAIT_V
#undef PG8_WAIT_L
#undef PG8_BAR
#undef PG8_SCHED
#undef PG8_GOFFS
#undef PG8_TOKDMA
}
}
namespace att {
constexpr int NW = 8, QBLK = 32, KVBLK = 64;
constexpr float THR = 8.f;
#define ATT_SBAR() __builtin_amdgcn_sched_barrier(0)
template <int DK> __device__ __forceinline__ int kswz(int row, int colB) { return row * (DK * 2 + 16) + colB; }
__device__ __forceinline__ int crow(int r, int hi) { return (r & 3) + 8 * (r >> 2) + 4 * hi; }
__device__ __forceinline__ void partialSM(f32x16& p0, f32x16& p1, float& m_reg, float& mn, float& alpha, const float C, const float thr_raw) {
    float pmax = p0[0];
#pragma unroll
    for (int r = 1; r < 16; ++r) pmax = fmaxf(pmax, p0[r]);
#pragma unroll
    for (int r = 0; r < 16; ++r) pmax = fmaxf(pmax, p1[r]);
    { auto rr = __builtin_amdgcn_permlane32_swap(__float_as_uint(pmax), __float_as_uint(pmax), false, false);
      pmax = fmaxf(__uint_as_float(rr[0]), __uint_as_float(rr[1])); }
    if (__builtin_expect(__all(pmax - m_reg <= thr_raw), 1)) { mn = m_reg; alpha = 1.f; }
    else { mn = fmaxf(m_reg, pmax); alpha = __builtin_amdgcn_exp2f((m_reg - mn) * C); m_reg = mn; }
    const float mnC = -mn * C;
#pragma unroll
    for (int r = 0; r < 16; ++r) p0[r] = fmaf(p0[r], C, mnC);
#pragma unroll
    for (int r = 0; r < 16; ++r) p1[r] = fmaf(p1[r], C, mnC);
#pragma unroll
    for (int r = 0; r < 16; ++r) p0[r] = __builtin_amdgcn_exp2f(p0[r]);
}
__device__ __forceinline__ void finishSM(f32x16& p0, f32x16& p1, float alpha, float& l_reg, bf16x8& pa0, bf16x8& pa1, bf16x8& pa2, bf16x8& pa3) {
#pragma unroll
    for (int r = 0; r < 16; ++r) p1[r] = __builtin_amdgcn_exp2f(p1[r]);
#if MK_PROBE_ATT == 2
    { float dz = 0.f;
#pragma unroll
      for (int r = 0; r < 16; ++r) { dz += __builtin_amdgcn_exp2f(p0[r] - 1.0f); dz += __builtin_amdgcn_exp2f(p1[r] - 2.0f); }
      asm volatile("" :: "v"(dz)); }
#endif
    float ps = 0;
#pragma unroll
    for (int r = 0; r < 16; ++r) ps += p0[r];
#pragma unroll
    for (int r = 0; r < 16; ++r) ps += p1[r];
    { auto rr = __builtin_amdgcn_permlane32_swap(__float_as_uint(ps), __float_as_uint(ps), false, false);
      ps = __uint_as_float(rr[0]) + __uint_as_float(rr[1]); }
    l_reg = l_reg * alpha + ps;
#define ATT_PK4(P, BASE, OUT) do { unsigned a0 = cvt_pk_bf16(P[BASE + 0], P[BASE + 1]), a1 = cvt_pk_bf16(P[BASE + 2], P[BASE + 3]);   \
    unsigned b0 = cvt_pk_bf16(P[BASE + 4], P[BASE + 5]), b1 = cvt_pk_bf16(P[BASE + 6], P[BASE + 7]);                              \
    auto r0 = __builtin_amdgcn_permlane32_swap(a0, b0, false, false); auto r1 = __builtin_amdgcn_permlane32_swap(a1, b1, false, false); \
    u32x4 w = {r0[0], r1[0], r0[1], r1[1]}; OUT = *reinterpret_cast<bf16x8*>(&w); } while (0)
    ATT_PK4(p0, 0, pa0); ATT_PK4(p0, 8, pa1); ATT_PK4(p1, 0, pa2); ATT_PK4(p1, 8, pa3);
#undef ATT_PK4
}
#ifndef MK_PROBE_ATT
#define MK_PROBE_ATT 0
#endif
template <int DK> __device__ __forceinline__ void qkt(f32x16& p0, f32x16& p1, const char* Ks, const bf16x8* qr, int r32, int hi) {
    p0 = f32x16{}; p1 = f32x16{};
#if MK_PROBE_ATT == 1
    f32x16 d0_ = f32x16{}; d0_[0] = 1.0f;
#endif
#pragma unroll
    for (int d0 = 0; d0 < DK / 16; ++d0) { const int cb = (d0 * 16 + hi * 8) * 2;
        const bf16x8 b0 = *reinterpret_cast<const bf16x8*>(Ks + kswz<DK>(r32, cb));
        const bf16x8 b1 = *reinterpret_cast<const bf16x8*>(Ks + kswz<DK>(32 + r32, cb));
        p0 = __builtin_amdgcn_mfma_f32_32x32x16_bf16(b0, qr[d0], p0, 0, 0, 0);
        p1 = __builtin_amdgcn_mfma_f32_32x32x16_bf16(b1, qr[d0], p1, 0, 0, 0);
#if MK_PROBE_ATT == 1
        d0_ = __builtin_amdgcn_mfma_f32_32x32x16_bf16(b0, qr[d0], d0_, 0, 0, 0);
        d0_ = __builtin_amdgcn_mfma_f32_32x32x16_bf16(b1, qr[d0], d0_, 0, 0, 0);
#endif
    }
#if MK_PROBE_ATT == 1
    asm volatile("" :: "v"(d0_));
#endif
}
template <int DV> __device__ __forceinline__ int v_st(int k, int c) { const int kk = (k & ~0xC) | ((k & 4) << 1) | ((k & 8) >> 1); return ((kk >> 3) * (DV / 32) + (c >> 5)) * 512 + ((kk & 7) * 32 + (c & 31)) * 2; }
__device__ __forceinline__ int v_rd_base(int lane) { return ((lane & 3) << 3) | (((lane >> 2) & 3) << 6) | (((lane >> 4) & 1) << 5) | (((lane >> 5) & 1) << 8); }
template <int DV> constexpr int v_rd_off(int d0, int ks, int half) { return d0 * 512 + ks * (DV / 32) * 1024 + half * (DV / 32) * 512; }
template <int OFF> __device__ __forceinline__ s16x4 tr_read(int vb) {
    s16x4 r; asm volatile("ds_read_b64_tr_b16 %0, %1 offset:%2" : "=&v"(r) : "v"(vb), "i"(OFF) : "memory"); return r;
}
template <int DV, int D0> __device__ __forceinline__ void pv_one(f32x16& od, int vb, bf16x8 pa0, bf16x8 pa1, bf16x8 pa2, bf16x8 pa3) {
    const s16x4 l0 = tr_read<v_rd_off<DV>(D0, 0, 0)>(vb), h0 = tr_read<v_rd_off<DV>(D0, 0, 1)>(vb), l1 = tr_read<v_rd_off<DV>(D0, 1, 0)>(vb), h1 = tr_read<v_rd_off<DV>(D0, 1, 1)>(vb);
    const s16x4 l2 = tr_read<v_rd_off<DV>(D0, 2, 0)>(vb), h2 = tr_read<v_rd_off<DV>(D0, 2, 1)>(vb), l3 = tr_read<v_rd_off<DV>(D0, 3, 0)>(vb), h3 = tr_read<v_rd_off<DV>(D0, 3, 1)>(vb);
    asm volatile("s_waitcnt lgkmcnt(0)" ::: "memory"); ATT_SBAR();
#define ATT_PK(L, H) (bf16x8){L[0], L[1], L[2], L[3], H[0], H[1], H[2], H[3]}
    od = __builtin_amdgcn_mfma_f32_32x32x16_bf16(pa0, ATT_PK(l0, h0), od, 0, 0, 0);
    od = __builtin_amdgcn_mfma_f32_32x32x16_bf16(pa1, ATT_PK(l1, h1), od, 0, 0, 0);
    od = __builtin_amdgcn_mfma_f32_32x32x16_bf16(pa2, ATT_PK(l2, h2), od, 0, 0, 0);
    od = __builtin_amdgcn_mfma_f32_32x32x16_bf16(pa3, ATT_PK(l3, h3), od, 0, 0, 0);
#undef ATT_PK
}
template <int DV, int D0> __device__ __forceinline__ void pv_two(f32x16& oa, f32x16& ob, int vb, bf16x8 pa0, bf16x8 pa1, bf16x8 pa2, bf16x8 pa3) {
    const s16x4 l0 = tr_read<v_rd_off<DV>(D0, 0, 0)>(vb), h0 = tr_read<v_rd_off<DV>(D0, 0, 1)>(vb), l1 = tr_read<v_rd_off<DV>(D0, 1, 0)>(vb), h1 = tr_read<v_rd_off<DV>(D0, 1, 1)>(vb);
    const s16x4 l2 = tr_read<v_rd_off<DV>(D0, 2, 0)>(vb), h2 = tr_read<v_rd_off<DV>(D0, 2, 1)>(vb), l3 = tr_read<v_rd_off<DV>(D0, 3, 0)>(vb), h3 = tr_read<v_rd_off<DV>(D0, 3, 1)>(vb);
    const s16x4 m0 = tr_read<v_rd_off<DV>(D0 + 1, 0, 0)>(vb), n0 = tr_read<v_rd_off<DV>(D0 + 1, 0, 1)>(vb), m1 = tr_read<v_rd_off<DV>(D0 + 1, 1, 0)>(vb), n1 = tr_read<v_rd_off<DV>(D0 + 1, 1, 1)>(vb);
    const s16x4 m2 = tr_read<v_rd_off<DV>(D0 + 1, 2, 0)>(vb), n2 = tr_read<v_rd_off<DV>(D0 + 1, 2, 1)>(vb), m3 = tr_read<v_rd_off<DV>(D0 + 1, 3, 0)>(vb), n3 = tr_read<v_rd_off<DV>(D0 + 1, 3, 1)>(vb);
    asm volatile("s_waitcnt lgkmcnt(0)" ::: "memory"); ATT_SBAR();
#define ATT_PK(L, H) (bf16x8){L[0], L[1], L[2], L[3], H[0], H[1], H[2], H[3]}
    oa = __builtin_amdgcn_mfma_f32_32x32x16_bf16(pa0, ATT_PK(l0, h0), oa, 0, 0, 0);
    ob = __builtin_amdgcn_mfma_f32_32x32x16_bf16(pa0, ATT_PK(m0, n0), ob, 0, 0, 0);
    oa = __builtin_amdgcn_mfma_f32_32x32x16_bf16(pa1, ATT_PK(l1, h1), oa, 0, 0, 0);
    ob = __builtin_amdgcn_mfma_f32_32x32x16_bf16(pa1, ATT_PK(m1, n1), ob, 0, 0, 0);
    oa = __builtin_amdgcn_mfma_f32_32x32x16_bf16(pa2, ATT_PK(l2, h2), oa, 0, 0, 0);
    ob = __builtin_amdgcn_mfma_f32_32x32x16_bf16(pa2, ATT_PK(m2, n2), ob, 0, 0, 0);
    oa = __builtin_amdgcn_mfma_f32_32x32x16_bf16(pa3, ATT_PK(l3, h3), oa, 0, 0, 0);
    ob = __builtin_amdgcn_mfma_f32_32x32x16_bf16(pa3, ATT_PK(m3, n3), ob, 0, 0, 0);
#undef ATT_PK
}
struct VFrag64 { s16x4 l[2][4], h[2][4]; };
template <int DV> __device__ __forceinline__ void pv_issue(VFrag64& f, int vb) {
    f.l[0][0] = tr_read<v_rd_off<DV>(0, 0, 0)>(vb); f.h[0][0] = tr_read<v_rd_off<DV>(0, 0, 1)>(vb); f.l[0][1] = tr_read<v_rd_off<DV>(0, 1, 0)>(vb); f.h[0][1] = tr_read<v_rd_off<DV>(0, 1, 1)>(vb);
    f.l[0][2] = tr_read<v_rd_off<DV>(0, 2, 0)>(vb); f.h[0][2] = tr_read<v_rd_off<DV>(0, 2, 1)>(vb); f.l[0][3] = tr_read<v_rd_off<DV>(0, 3, 0)>(vb); f.h[0][3] = tr_read<v_rd_off<DV>(0, 3, 1)>(vb);
    f.l[1][0] = tr_read<v_rd_off<DV>(1, 0, 0)>(vb); f.h[1][0] = tr_read<v_rd_off<DV>(1, 0, 1)>(vb); f.l[1][1] = tr_read<v_rd_off<DV>(1, 1, 0)>(vb); f.h[1][1] = tr_read<v_rd_off<DV>(1, 1, 1)>(vb);
    f.l[1][2] = tr_read<v_rd_off<DV>(1, 2, 0)>(vb); f.h[1][2] = tr_read<v_rd_off<DV>(1, 2, 1)>(vb); f.l[1][3] = tr_read<v_rd_off<DV>(1, 3, 0)>(vb); f.h[1][3] = tr_read<v_rd_off<DV>(1, 3, 1)>(vb);
}
__device__ __forceinline__ void pv_mma64(f32x16* o, const VFrag64& f, bf16x8 pa0, bf16x8 pa1, bf16x8 pa2, bf16x8 pa3) {
    asm volatile("s_waitcnt lgkmcnt(0)" ::: "memory"); ATT_SBAR();
#define ATT_PK(L, H) (bf16x8){L[0], L[1], L[2], L[3], H[0], H[1], H[2], H[3]}
    o[0] = __builtin_amdgcn_mfma_f32_32x32x16_bf16(pa0, ATT_PK(f.l[0][0], f.h[0][0]), o[0], 0, 0, 0);
    o[1] = __builtin_amdgcn_mfma_f32_32x32x16_bf16(pa0, ATT_PK(f.l[1][0], f.h[1][0]), o[1], 0, 0, 0);
    o[0] = __builtin_amdgcn_mfma_f32_32x32x16_bf16(pa1, ATT_PK(f.l[0][1], f.h[0][1]), o[0], 0, 0, 0);
    o[1] = __builtin_amdgcn_mfma_f32_32x32x16_bf16(pa1, ATT_PK(f.l[1][1], f.h[1][1]), o[1], 0, 0, 0);
    o[0] = __builtin_amdgcn_mfma_f32_32x32x16_bf16(pa2, ATT_PK(f.l[0][2], f.h[0][2]), o[0], 0, 0, 0);
    o[1] = __builtin_amdgcn_mfma_f32_32x32x16_bf16(pa2, ATT_PK(f.l[1][2], f.h[1][2]), o[1], 0, 0, 0);
    o[0] = __builtin_amdgcn_mfma_f32_32x32x16_bf16(pa3, ATT_PK(f.l[0][3], f.h[0][3]), o[0], 0, 0, 0);
    o[1] = __builtin_amdgcn_mfma_f32_32x32x16_bf16(pa3, ATT_PK(f.l[1][3], f.h[1][3]), o[1], 0, 0, 0);
#undef ATT_PK
}
#ifndef MK_PV2
#define MK_PV2 1
#endif
#ifndef MK_VPRE
#define MK_VPRE 0
#endif
#ifndef MK_MBLK
#define MK_MBLK 1
#endif
#ifndef MK_ATT_PRIO
#define MK_ATT_PRIO 1
#endif
template <int DV> __device__ __forceinline__ void pv_d0(f32x16* o, int vb, bf16x8 pa0, bf16x8 pa1, bf16x8 pa2, bf16x8 pa3) {
#if MK_PV2
    pv_two<DV, 0>(o[0], o[1], vb, pa0, pa1, pa2, pa3);
    if constexpr (DV == 128) pv_two<DV, 2>(o[2], o[3], vb, pa0, pa1, pa2, pa3);
#else
    pv_one<DV, 0>(o[0], vb, pa0, pa1, pa2, pa3); pv_one<DV, 1>(o[1], vb, pa0, pa1, pa2, pa3);
    if constexpr (DV == 128) { pv_one<DV, 2>(o[2], vb, pa0, pa1, pa2, pa3); pv_one<DV, 3>(o[3], vb, pa0, pa1, pa2, pa3); }
#endif
}
template <int DK, int DV> constexpr int lds_bytes() { return 3 * KVBLK * DV * 2 + 3 * KVBLK * (DK * 2 + 16) + NW * 64 * 4; }

template <int DK, int DV, int ldq, int ldk, int ldv, int ldo, int SD, int EPI = 0>
__device__ __forceinline__ void attn_unit(const bf16_t* __restrict__ Qb, const bf16_t* __restrict__ Kh, const bf16_t* __restrict__ Vh,
                                          bf16_t* __restrict__ Ob, int seq, const float C, const float thr_raw, char* lds, const int wid, LAS unsigned* stash = nullptr, float lam = 0.f, const float* gvec = nullptr) {
    constexpr int SHM_V = KVBLK * DV * 2, SHM_K = KVBLK * (DK * 2 + 16);
    constexpr int NO = DV / 32, ND = DK / 16;
    const int lane = fresh_lane(), tid = wid * 64 + lane, r32 = lane & 31, hi = lane >> 5;
    char* V_lds = lds; char* K_lds = lds + 3 * SHM_V;
    float* wsf = (float*)(lds + 3 * SHM_V + 3 * SHM_K) + wid * 64; float* li_l = wsf; float* al_l = wsf + 32;
    float m_reg = -1e30f, l_reg = 0; f32x16 o[NO]; bf16x8 qr[ND];
#pragma unroll
    for (int d = 0; d < NO; ++d) o[d] = f32x16{};
    const bf16_t* Qw = Qb + (long)(wid * QBLK + r32) * ldq + hi * 8;
#pragma unroll
    for (int d0 = 0; d0 < ND; ++d0) qr[d0] = *reinterpret_cast<const bf16x8*>(Qw + d0 * 16);
    const int sr = tid >> 4, sc = (tid & 15) * 8; const bool kact = (DK == 128) ? true : (sc < DK), vact = (DV == 128) ? true : (sc < DV);
    const int vst0 = v_st<DV>(sr, vact ? sc : 0), vst1 = v_st<DV>(32 + sr, vact ? sc : 0);
    const int vb0 = (int)(uintptr_t)V_lds + v_rd_base(lane);
    const unsigned koff = (unsigned)(sr * ldk + sc) * 2u, voff = (unsigned)(sr * ldv + sc) * 2u;
    const size_t k32 = (size_t)32 * ldk * 2, v32 = (size_t)32 * ldv * 2;
    struct { bf16x8 vs0, vs1, ks0, ks1; } sr_[SD];
#define ATT_SLOAD(s, k0) do { const char* _kt = (const char*)Kh + (size_t)(k0) * ldk * 2; const char* _vt = (const char*)Vh + (size_t)(k0) * ldv * 2; \
    if (vact) { sr_[s].vs0 = *reinterpret_cast<const bf16x8*>(_vt + voff); sr_[s].vs1 = *reinterpret_cast<const bf16x8*>(_vt + v32 + voff); } \
    if (kact) { sr_[s].ks0 = *reinterpret_cast<const bf16x8*>(_kt + koff); sr_[s].ks1 = *reinterpret_cast<const bf16x8*>(_kt + k32 + koff); } } while (0)
#define ATT_SWRITE(b, s) do { if (vact) { *(bf16x8*)(V_lds + (b) * SHM_V + vst0) = sr_[s].vs0; *(bf16x8*)(V_lds + (b) * SHM_V + vst1) = sr_[s].vs1; } \
    if (kact) { const int kc = sc * 2; *(bf16x8*)(K_lds + (b) * SHM_K + kswz<DK>(sr, kc)) = sr_[s].ks0; *(bf16x8*)(K_lds + (b) * SHM_K + kswz<DK>(32 + sr, kc)) = sr_[s].ks1; } } while (0)
#define ATT_RESC(a) do { if (__any((a) < 1.f)) { if (hi == 0) al_l[r32] = (a); asm volatile("s_waitcnt lgkmcnt(0)" ::: "memory"); \
    _Pragma("unroll") for (int d = 0; d < NO; ++d) _Pragma("unroll") for (int r = 0; r < 16; ++r) o[d][r] *= al_l[crow(r, hi)]; } } while (0)
    f32x16 pA0, pA1, pB0, pB1; float mnA, mnB, alA, alB; bf16x8 pa0, pa1, pa2, pa3; const int NT = seq / KVBLK;
    constexpr int SE = 0, SO = SD - 1;
    constexpr bool VPRE = (DV == 64) && (MK_VPRE != 0); VFrag64 vf;
    __syncthreads();
    ATT_SLOAD(SE, 0); asm volatile("s_waitcnt vmcnt(0)" ::: "memory"); ATT_SWRITE(0, SE); __syncthreads();
    qkt<DK>(pA0, pA1, K_lds, qr, r32, hi); partialSM(pA0, pA1, m_reg, mnA, alA, C, thr_raw);
    ATT_SLOAD(SO, KVBLK); if constexpr (SD == 2) { if (2 < NT) ATT_SLOAD(SE, 2 * KVBLK); }
    ATT_SWRITE(1, SO); __syncthreads();
    int bj = 1;
    for (int j = 1; j + 1 < NT; j += 2) {
        const int bn = (bj == 2) ? 0 : bj + 1, bp = (bj == 0) ? 2 : bj - 1;
        ATT_SBAR(); if constexpr (VPRE) pv_issue<DV>(vf, vb0 + bp * SHM_V);
        qkt<DK>(pB0, pB1, K_lds + bj * SHM_K, qr, r32, hi);
        finishSM(pA0, pA1, alA, l_reg, pa0, pa1, pa2, pa3); ATT_SBAR();
        ATT_SLOAD(SO, (j + SD) * KVBLK); ATT_SBAR();
        if constexpr (VPRE) pv_mma64(o, vf, pa0, pa1, pa2, pa3); else pv_d0<DV>(o, vb0 + bp * SHM_V, pa0, pa1, pa2, pa3);
        partialSM(pB0, pB1, m_reg, mnB, alB, C, thr_raw);
        ATT_SWRITE(bn, SE);
        ATT_RESC(alB); __syncthreads();
        ATT_SBAR(); if constexpr (VPRE) pv_issue<DV>(vf, vb0 + bj * SHM_V);
        qkt<DK>(pA0, pA1, K_lds + bn * SHM_K, qr, r32, hi);
        finishSM(pB0, pB1, alB, l_reg, pa0, pa1, pa2, pa3); ATT_SBAR();
        if (SD == 1 || j + 3 < NT) ATT_SLOAD(SE, (j + 1 + SD) * KVBLK); ATT_SBAR();
        if constexpr (VPRE) pv_mma64(o, vf, pa0, pa1, pa2, pa3); else pv_d0<DV>(o, vb0 + bj * SHM_V, pa0, pa1, pa2, pa3);
        partialSM(pA0, pA1, m_reg, mnA, alA, C, thr_raw);
        ATT_SWRITE(bp, SO);
        ATT_RESC(alA); __syncthreads();
        bj = bp;
    }
    { const int bp = (bj == 0) ? 2 : bj - 1;
      ATT_SBAR(); qkt<DK>(pB0, pB1, K_lds + bj * SHM_K, qr, r32, hi);
      finishSM(pA0, pA1, alA, l_reg, pa0, pa1, pa2, pa3); ATT_SBAR();
      pv_d0<DV>(o, vb0 + bp * SHM_V, pa0, pa1, pa2, pa3); partialSM(pB0, pB1, m_reg, mnB, alB, C, thr_raw);
      ATT_RESC(alB);
      finishSM(pB0, pB1, alB, l_reg, pa0, pa1, pa2, pa3); ATT_SBAR();
      pv_d0<DV>(o, vb0 + bj * SHM_V, pa0, pa1, pa2, pa3); }
    if (hi == 0) li_l[r32] = l_reg; asm volatile("s_waitcnt lgkmcnt(0)" ::: "memory");
    float rli[16];
#pragma unroll
    for (int r = 0; r < 16; ++r) rli[r] = __builtin_amdgcn_rcpf(li_l[crow(r, hi)]);
    if constexpr (EPI == 1) {
#pragma unroll
        for (int r = 0; r < 16; ++r)
#pragma unroll
            for (int p = 0; p < NO / 2; ++p) stash[(r * (NO / 2) + p) * 64 + lane] = pk2(o[2 * p][r] * rli[r], o[2 * p + 1][r] * rli[r]);
    } else if constexpr (EPI == 2) {
        static_assert(EPI != 2 || DV == 128, "differential combine: DV = 128");
        float gl[NO];
#pragma unroll
        for (int d0 = 0; d0 < NO; ++d0) gl[d0] = gvec[d0 * 32 + r32];
        bf16_t* Ow = Ob + (long)(wid * QBLK) * ldo;
#pragma unroll
        for (int r = 0; r < 16; ++r) { float v[NO]; float ss = 0.f;
#pragma unroll
            for (int p = 0; p < NO / 2; ++p) { const unsigned w = stash[(r * (NO / 2) + p) * 64 + lane];
                v[2 * p] = o[2 * p][r] * rli[r] - lam * bf2f(w & 0xffffu); v[2 * p + 1] = o[2 * p + 1][r] * rli[r] - lam * bf2f(w >> 16); ss += v[2 * p] * v[2 * p] + v[2 * p + 1] * v[2 * p + 1]; }
#pragma unroll
            for (int x = 1; x < 32; x <<= 1) ss += __shfl_xor(ss, x);
            const float rstd = rsqrtf(ss * (1.0f / 128.0f) + 1e-6f); const int orow = crow(r, hi);
#pragma unroll
            for (int d0 = 0; d0 < NO; ++d0) Ow[(long)orow * ldo + d0 * 32 + r32] = (bf16_t)f2bf(v[d0] * rstd * gl[d0]); }
    } else {
    bf16_t* Ow = Ob + (long)(wid * QBLK) * ldo;
#pragma unroll
    for (int r = 0; r < 16; ++r) { const int orow = crow(r, hi);
#pragma unroll
        for (int d0 = 0; d0 < NO; ++d0) Ow[(long)orow * ldo + d0 * 32 + r32] = (bf16_t)f2bf(o[d0][r] * rli[r]); }
    }
#undef ATT_SLOAD
#undef ATT_SWRITE
#undef ATT_RESC
}

constexpr float THRL = THR * 1.4426950408889634f;
__device__ __forceinline__ float max3f(float a, float b, float c) { return __builtin_fmaxf(__builtin_fmaxf(a, b), c); }
__device__ __forceinline__ void softmax_rel(f32x16& p0, f32x16& p1, float& m_run, float& alpha, const bool first) {
    float pm = max3f(p0[0], p0[1], p0[2]);
#pragma unroll
    for (int r = 3; r < 15; r += 2) pm = max3f(pm, p0[r], p0[r + 1]);
    pm = max3f(pm, p0[15], p1[0]);
#pragma unroll
    for (int r = 1; r < 15; r += 2) pm = max3f(pm, p1[r], p1[r + 1]);
    pm = __builtin_fmaxf(pm, p1[15]);
    { auto rr = __builtin_amdgcn_permlane32_swap(__float_as_uint(pm), __float_as_uint(pm), false, false); pm = __builtin_fmaxf(__uint_as_float(rr[0]), __uint_as_float(rr[1])); }
    if (!first && __builtin_expect(__all(pm <= THRL), 1)) alpha = 1.f;
    else { const float d = first ? pm : __builtin_fmaxf(pm, 0.f); alpha = first ? 1.f : __builtin_amdgcn_exp2f(-d); m_run += d;
#pragma unroll
        for (int r = 0; r < 16; ++r) { p0[r] -= d; p1[r] -= d; } }
#pragma unroll
    for (int r = 0; r < 16; ++r) { p0[r] = __builtin_amdgcn_exp2f(p0[r]); p1[r] = __builtin_amdgcn_exp2f(p1[r]); }
}
template <int DK> __device__ __forceinline__ void qkt_init(f32x16& p0, f32x16& p1, const char* Ks, const bf16x8* qr, int r32, int hi, float init) {
#pragma unroll
    for (int r = 0; r < 16; ++r) { p0[r] = init; p1[r] = init; }
#pragma unroll
    for (int d0 = 0; d0 < DK / 16; ++d0) { const int cb = (d0 * 16 + hi * 8) * 2;
        const bf16x8 b0 = *reinterpret_cast<const bf16x8*>(Ks + kswz<DK>(r32, cb));
        const bf16x8 b1 = *reinterpret_cast<const bf16x8*>(Ks + kswz<DK>(32 + r32, cb));
        p0 = __builtin_amdgcn_mfma_f32_32x32x16_bf16(b0, qr[d0], p0, 0, 0, 0);
        p1 = __builtin_amdgcn_mfma_f32_32x32x16_bf16(b1, qr[d0], p1, 0, 0, 0); }
}
__device__ __forceinline__ void finish_rel(f32x16& p0, f32x16& p1, float alpha, float& l_reg, bf16x8& pa0, bf16x8& pa1, bf16x8& pa2, bf16x8& pa3) {
    float ps = 0;
#pragma unroll
    for (int r = 0; r < 16; ++r) ps += p0[r];
#pragma unroll
    for (int r = 0; r < 16; ++r) ps += p1[r];
    { auto rr = __builtin_amdgcn_permlane32_swap(__float_as_uint(ps), __float_as_uint(ps), false, false); ps = __uint_as_float(rr[0]) + __uint_as_float(rr[1]); }
    l_reg = l_reg * alpha + ps;
#define ATT_PK4(P, BASE, OUT) do { unsigned a0 = cvt_pk_bf16(P[BASE + 0], P[BASE + 1]), a1 = cvt_pk_bf16(P[BASE + 2], P[BASE + 3]);   \
    unsigned b0 = cvt_pk_bf16(P[BASE + 4], P[BASE + 5]), b1 = cvt_pk_bf16(P[BASE + 6], P[BASE + 7]);                              \
    auto r0 = __builtin_amdgcn_permlane32_swap(a0, b0, false, false); auto r1 = __builtin_amdgcn_permlane32_swap(a1, b1, false, false); \
    u32x4 w = {r0[0], r1[0], r0[1], r1[1]}; OUT = *reinterpret_cast<bf16x8*>(&w); } while (0)
    ATT_PK4(p0, 0, pa0); ATT_PK4(p0, 8, pa1); ATT_PK4(p1, 0, pa2); ATT_PK4(p1, 8, pa3);
#undef ATT_PK4
}

template <int OFF> __device__ __forceinline__ bf16x8 k_read(int ka) { bf16x8 r; asm volatile("ds_read_b128 %0, %1 offset:%2" : "=&v"(r) : "v"(ka), "i"(OFF) : "memory"); return r; }
#define ATT_WAITL(n) asm volatile("s_waitcnt lgkmcnt(%0)" :: "n"(n) : "memory")
#define ATT_PKV(L, H) (bf16x8){L[0], L[1], L[2], L[3], H[0], H[1], H[2], H[3]}
template <int DK, int DV, int KBD, bool FINM = false, bool MINIT = false>
__device__ __forceinline__ void mblock(f32x16* o, f32x16& p0, f32x16& p1, const bool pv, const int vb, const int ka, const bf16x8* qr, bf16x8 pa0, bf16x8 pa1, bf16x8 pa2, bf16x8 pa3, const float init, const float al = 1.f, float* l_reg = nullptr, const f32x16* minit = nullptr) {
    constexpr int ND = DK / 16, NB = ND / KBD, PITCH = DK * 2 + 16, KR = 2 * KBD;
    static_assert(ND % KBD == 0 && NB >= 2 && NB <= 4 && (KBD == 2 || KBD == 3), "K batches");
    bf16x8 ka0[2][KBD], ka1[2][KBD];
    s16x4 l[4], h[4], m[4], n[4];
#define ATT_KISSUE(b) do { ka0[(b) & 1][0] = k_read<((b) * KBD + 0) * 32>(ka); ka1[(b) & 1][0] = k_read<((b) * KBD + 0) * 32 + 32 * PITCH>(ka); \
        ka0[(b) & 1][1] = k_read<((b) * KBD + 1) * 32>(ka); ka1[(b) & 1][1] = k_read<((b) * KBD + 1) * 32 + 32 * PITCH>(ka); \
        if constexpr (KBD > 2) { ka0[(b) & 1][KBD - 1] = k_read<((b) * KBD + KBD - 1) * 32>(ka); ka1[(b) & 1][KBD - 1] = k_read<((b) * KBD + KBD - 1) * 32 + 32 * PITCH>(ka); } } while (0)
#define ATT_TRISSUE(D0) do { l[0] = tr_read<v_rd_off<DV>(D0, 0, 0)>(vb); h[0] = tr_read<v_rd_off<DV>(D0, 0, 1)>(vb); l[1] = tr_read<v_rd_off<DV>(D0, 1, 0)>(vb); h[1] = tr_read<v_rd_off<DV>(D0, 1, 1)>(vb); \
        l[2] = tr_read<v_rd_off<DV>(D0, 2, 0)>(vb); h[2] = tr_read<v_rd_off<DV>(D0, 2, 1)>(vb); l[3] = tr_read<v_rd_off<DV>(D0, 3, 0)>(vb); h[3] = tr_read<v_rd_off<DV>(D0, 3, 1)>(vb); \
        m[0] = tr_read<v_rd_off<DV>(D0 + 1, 0, 0)>(vb); n[0] = tr_read<v_rd_off<DV>(D0 + 1, 0, 1)>(vb); m[1] = tr_read<v_rd_off<DV>(D0 + 1, 1, 0)>(vb); n[1] = tr_read<v_rd_off<DV>(D0 + 1, 1, 1)>(vb); \
        m[2] = tr_read<v_rd_off<DV>(D0 + 1, 2, 0)>(vb); n[2] = tr_read<v_rd_off<DV>(D0 + 1, 2, 1)>(vb); m[3] = tr_read<v_rd_off<DV>(D0 + 1, 3, 0)>(vb); n[3] = tr_read<v_rd_off<DV>(D0 + 1, 3, 1)>(vb); } while (0)
#define ATT_PVMMA(OA, OB) do { OA = __builtin_amdgcn_mfma_f32_32x32x16_bf16(pa0, ATT_PKV(l[0], h[0]), OA, 0, 0, 0); OB = __builtin_amdgcn_mfma_f32_32x32x16_bf16(pa0, ATT_PKV(m[0], n[0]), OB, 0, 0, 0); \
        OA = __builtin_amdgcn_mfma_f32_32x32x16_bf16(pa1, ATT_PKV(l[1], h[1]), OA, 0, 0, 0); OB = __builtin_amdgcn_mfma_f32_32x32x16_bf16(pa1, ATT_PKV(m[1], n[1]), OB, 0, 0, 0); \
        OA = __builtin_amdgcn_mfma_f32_32x32x16_bf16(pa2, ATT_PKV(l[2], h[2]), OA, 0, 0, 0); OB = __builtin_amdgcn_mfma_f32_32x32x16_bf16(pa2, ATT_PKV(m[2], n[2]), OB, 0, 0, 0); \
        OA = __builtin_amdgcn_mfma_f32_32x32x16_bf16(pa3, ATT_PKV(l[3], h[3]), OA, 0, 0, 0); OB = __builtin_amdgcn_mfma_f32_32x32x16_bf16(pa3, ATT_PKV(m[3], n[3]), OB, 0, 0, 0); } while (0)
#define ATT_QKMMA(b) do { _Pragma("unroll") for (int q = 0; q < KBD; ++q) { const bool f_ = MINIT && (b) == 0 && q == 0; \
        p0 = __builtin_amdgcn_mfma_f32_32x32x16_bf16(ka0[(b) & 1][q], qr[(b) * KBD + q], f_ ? *minit : p0, 0, 0, 0); \
        p1 = __builtin_amdgcn_mfma_f32_32x32x16_bf16(ka1[(b) & 1][q], qr[(b) * KBD + q], f_ ? *minit : p1, 0, 0, 0); } } while (0)
#if MK_ATT_PRIO == 1
    __builtin_amdgcn_s_setprio(1);
#endif
    constexpr bool K2 = (DV == 64);
    if (pv) {
        ATT_TRISSUE(0); ATT_KISSUE(0); if constexpr (K2) ATT_KISSUE(1);
        if constexpr (FINM) { ATT_SBAR(); finish_rel(p0, p1, al, *l_reg, pa0, pa1, pa2, pa3); ATT_SBAR(); }
        ATT_WAITL(K2 ? 2 * KR : KR); ATT_SBAR();
        ATT_PVMMA(o[0], o[1]); ATT_SBAR();
        if constexpr (DV == 128) { ATT_TRISSUE(2); ATT_WAITL(0); ATT_SBAR(); ATT_PVMMA(o[2], o[3]); ATT_SBAR(); }
    } else { ATT_KISSUE(0); if constexpr (K2) ATT_KISSUE(1); }
    if constexpr (!K2) ATT_KISSUE(1);
    if constexpr (!MINIT) {
#pragma unroll
        for (int r = 0; r < 16; ++r) { p0[r] = init; p1[r] = init; } }
    ATT_WAITL(KR); ATT_SBAR(); ATT_QKMMA(0); ATT_SBAR();
    if constexpr (NB > 2) { ATT_KISSUE(2); ATT_WAITL(KR); } else ATT_WAITL(0);
    ATT_SBAR(); ATT_QKMMA(1); ATT_SBAR();
    if constexpr (NB > 2) { if constexpr (NB > 3) { ATT_KISSUE(3); ATT_WAITL(KR); } else ATT_WAITL(0);
        ATT_SBAR(); ATT_QKMMA(2); ATT_SBAR();
        if constexpr (NB > 3) { ATT_WAITL(0); ATT_SBAR(); ATT_QKMMA(3); ATT_SBAR(); } }
#if MK_ATT_PRIO == 1
    __builtin_amdgcn_s_setprio(0);
#endif
    if (MK_PROBE_ATT == 4) { f32x16 dz = f32x16{};
#pragma unroll
        for (int q = 0; q < ND; ++q) { dz = __builtin_amdgcn_mfma_f32_32x32x16_bf16(qr[q], qr[(q + 1) % ND], dz, 0, 0, 0); dz = __builtin_amdgcn_mfma_f32_32x32x16_bf16(qr[(q + 1) % ND], qr[q], dz, 0, 0, 0); }
        asm volatile("" :: "v"(dz)); }
    if (MK_PROBE_ATT == 5) { ATT_KISSUE(0); ATT_KISSUE(1); if constexpr (NB > 2) { ATT_WAITL(0); ATT_KISSUE(2); if constexpr (NB > 3) ATT_KISSUE(3); } ATT_WAITL(0);
        asm volatile("" :: "v"(ka0[0][0]), "v"(ka1[0][0]), "v"(ka0[1][0]), "v"(ka1[1][0])); }
#undef ATT_KISSUE
#undef ATT_TRISSUE
#undef ATT_PVMMA
#undef ATT_QKMMA
}

template <int DK, int DV, int ldq, int ldk, int ldv, int ldo, bool PRE, bool DEEP, bool PART = false>
__device__ __forceinline__ void attn_unit_stag(const bf16_t* __restrict__ Qb, const bf16_t* __restrict__ Kh, const bf16_t* __restrict__ Vh,
                                               bf16_t* __restrict__ Ob, int seq, const float C, const float thr_raw, char* lds, const int wid, float* po = nullptr, float* pml = nullptr) {
    constexpr int SHM_V = KVBLK * DV * 2, SHM_K = KVBLK * (DK * 2 + 16), R = 4;
    constexpr int NO = DV / 32, ND = DK / 16;
    const int lane = fresh_lane(), tid = wid * 64 + lane, r32 = lane & 31, hi = lane >> 5, half = wid >> 2;
    char* V_lds = lds; char* K_lds = lds + R * SHM_V;
    float* wsf = (float*)(lds + R * SHM_V + R * SHM_K) + wid * 64; float* li_l = wsf; float* al_l = wsf + 32;
    float m_reg = 0.f, l_reg = 0; f32x16 o[NO]; bf16x8 qr[ND];
#pragma unroll
    for (int d = 0; d < NO; ++d) o[d] = f32x16{};
    const bf16_t* Qw = Qb + (long)(wid * QBLK + r32) * ldq + hi * 8;
#pragma unroll
    for (int d0 = 0; d0 < ND; ++d0) qr[d0] = *reinterpret_cast<const bf16x8*>(Qw + d0 * 16);
    if constexpr (!PRE) {
#pragma unroll
        for (int d0 = 0; d0 < ND; ++d0) { const u32x4 w = *reinterpret_cast<const u32x4*>(&qr[d0]); u32x4 x;
            x.x = cvt_pk_bf16(bf2f(w.x & 0xffffu) * C, bf2f(w.x >> 16) * C); x.y = cvt_pk_bf16(bf2f(w.y & 0xffffu) * C, bf2f(w.y >> 16) * C);
            x.z = cvt_pk_bf16(bf2f(w.z & 0xffffu) * C, bf2f(w.z >> 16) * C); x.w = cvt_pk_bf16(bf2f(w.w & 0xffffu) * C, bf2f(w.w >> 16) * C);
            qr[d0] = *reinterpret_cast<const bf16x8*>(&x); } }
    const int sr = tid >> 4, sc = (tid & 15) * 8; const bool kact = (DK == 128) ? true : (sc < DK), vact = (DV == 128) ? true : (sc < DV);
    const int vst0 = v_st<DV>(sr, vact ? sc : 0), vst1 = v_st<DV>(32 + sr, vact ? sc : 0);
    const int vb0 = (int)(uintptr_t)V_lds + v_rd_base(lane);
    const int ka0 = (int)(uintptr_t)K_lds + kswz<DK>(r32, hi * 16);
    const unsigned koff = (unsigned)(sr * ldk + sc) * 2u, voff = (unsigned)(sr * ldv + sc) * 2u;
    const unsigned koff2 = koff + 32u * ldk * 2u, voff2 = voff + 32u * ldv * 2u;
    bf16x8 vsA0, vsA1, ksA0, ksA1, vsB0, vsB1, ksB0, ksB1;
#define STG_SLOAD(S, k0) do { const char* _kt = (const char*)Kh + (size_t)(k0) * ldk * 2; const char* _vt = (const char*)Vh + (size_t)(k0) * ldv * 2;        \
    if (vact) { vs##S##0 = *reinterpret_cast<const bf16x8*>(_vt + (size_t)voff); vs##S##1 = *reinterpret_cast<const bf16x8*>(_vt + (size_t)voff2); } \
    if (kact) { ks##S##0 = *reinterpret_cast<const bf16x8*>(_kt + (size_t)koff); ks##S##1 = *reinterpret_cast<const bf16x8*>(_kt + (size_t)koff2); } } while (0)
#define STG_SWRITE(S, b) do { if (vact) { *(bf16x8*)(V_lds + (b) * SHM_V + vst0) = vs##S##0; *(bf16x8*)(V_lds + (b) * SHM_V + vst1) = vs##S##1; } \
    if (kact) { const int kc = sc * 2; *(bf16x8*)(K_lds + (b) * SHM_K + kswz<DK>(sr, kc)) = ks##S##0; *(bf16x8*)(K_lds + (b) * SHM_K + kswz<DK>(32 + sr, kc)) = ks##S##1; } } while (0)
#define STG_BAR() do { ATT_SBAR(); asm volatile("s_waitcnt lgkmcnt(0)" ::: "memory"); __builtin_amdgcn_s_barrier(); asm volatile("" ::: "memory"); ATT_SBAR(); } while (0)
    constexpr bool MINIT = !(DK == 128 && DV == 128);
    f32x16 minit = f32x16{};
    constexpr bool FINM = false;
    f32x16 p0, p1; float al = 1.f; bf16x8 pa0, pa1, pa2, pa3; const int NT = seq / KVBLK; (void)thr_raw;
    __syncthreads();
    if constexpr (DEEP) { STG_SLOAD(A, 0); STG_SLOAD(B, KVBLK); asm volatile("s_waitcnt vmcnt(0)" ::: "memory"); STG_SWRITE(A, 0); STG_SWRITE(B, 1);
        if (2 < NT) { STG_SLOAD(A, 2 * KVBLK); STG_SLOAD(B, 3 * KVBLK); } }
    else if constexpr (!(DK == 128 && DV == 128)) {
        STG_SLOAD(A, 0); STG_SLOAD(B, KVBLK); asm volatile("s_waitcnt vmcnt(0)" ::: "memory"); STG_SWRITE(A, 0); STG_SWRITE(B, 1);
        if (2 < NT) STG_SLOAD(A, 2 * KVBLK); }
    else { STG_SLOAD(A, 0); asm volatile("s_waitcnt vmcnt(0)" ::: "memory"); STG_SWRITE(A, 0);
        STG_SLOAD(A, KVBLK); asm volatile("s_waitcnt vmcnt(0)" ::: "memory"); STG_SWRITE(A, 1);
        if (2 < NT) STG_SLOAD(A, 2 * KVBLK); }
    __syncthreads();
    if (half && MK_PROBE_ATT != 8) STG_BAR();
#define STG_TILE(t, S) do { \
        mblock<DK, DV, (DK == 96) ? 3 : 2, FINM, MINIT>(o, p0, p1, (t) > 0, vb0 + (((t) - 1) & 3) * SHM_V, ka0 + ((t) & 3) * SHM_K, qr, pa0, pa1, pa2, pa3, -m_reg, al, &l_reg, &minit); \
        STG_BAR(); \
        if (MK_ATT_PRIO == 2) __builtin_amdgcn_s_setprio(1); \
        { const float mo_ = m_reg; softmax_rel(p0, p1, m_reg, al, (t) == 0); \
          if (MINIT) { if (__builtin_expect(__any(m_reg != mo_), 0)) { _Pragma("unroll") for (int r = 0; r < 16; ++r) minit[r] = -m_reg; } } } \
        if (MK_PROBE_ATT == 3) { float dz = 0.f; _Pragma("unroll") for (int r = 0; r < 16; ++r) { dz += __builtin_amdgcn_exp2f(p0[r] - 1.0f); dz += __builtin_amdgcn_exp2f(p1[r] - 2.0f); } asm volatile("" :: "v"(dz)); } \
        if (MK_PROBE_ATT == 6) { STG_BAR(); } \
        if (MK_PROBE_ATT == 9) { float dz = al; _Pragma("unroll") for (int r = 0; r < 48; ++r) asm volatile("v_fma_f32 %0, %0, %0, %0" : "+v"(dz)); asm volatile("" :: "v"(dz)); } \
        if constexpr (!FINM) finish_rel(p0, p1, al, l_reg, pa0, pa1, pa2, pa3); \
        if (__any(al < 1.f)) { if (hi == 0) al_l[r32] = al; asm volatile("s_waitcnt lgkmcnt(0)" ::: "memory"); \
            _Pragma("unroll") for (int d = 0; d < NO; ++d) _Pragma("unroll") for (int r = 0; r < 16; ++r) o[d][r] *= al_l[crow(r, hi)]; } \
        if (MK_ATT_PRIO == 2) __builtin_amdgcn_s_setprio(0); \
        if constexpr (DEEP) { if ((t) + 2 < NT) { STG_SWRITE(S, ((t) + 2) & 3); if ((t) + 4 < NT) STG_SLOAD(S, ((t) + 4) * KVBLK); } } \
        else      { if ((t) + 2 < NT) { STG_SWRITE(A, ((t) + 2) & 3); if ((t) + 3 < NT) { STG_SLOAD(A, ((t) + 3) * KVBLK); \
            if (MK_PROBE_ATT == 7) { STG_SLOAD(B, ((t) + 3) * KVBLK + 32 * ((t) & 1)); asm volatile("" :: "v"(vsB0), "v"(vsB1), "v"(ksB0), "v"(ksB1)); } } } } \
        STG_BAR(); } while (0)
    if constexpr (DEEP) { for (int t = 0; t < NT; t += 2) { STG_TILE(t, A); STG_TILE(t + 1, B); } }
    else { for (int t = 0; t < NT; ++t) STG_TILE(t, A); }
#undef STG_TILE
    if constexpr (FINM) finish_rel(p0, p1, al, l_reg, pa0, pa1, pa2, pa3);
    pv_d0<DV>(o, (int)(uintptr_t)V_lds + v_rd_base(fresh_lane()) + ((NT - 1) & 3) * SHM_V, pa0, pa1, pa2, pa3);
    if (!half && MK_PROBE_ATT != 8) STG_BAR();
    if constexpr (PART) { const int ln = fresh_lane(), rr32 = ln & 31, hh = ln >> 5;
      if (hh == 0) { pml[(wid * QBLK + rr32) * 2] = m_reg; pml[(wid * QBLK + rr32) * 2 + 1] = l_reg; }
      float* pw = po + (size_t)(wid * QBLK) * DV;
#pragma unroll
      for (int r = 0; r < 16; ++r) { const int orow = crow(r, hh);
#pragma unroll
          for (int d0 = 0; d0 < NO; ++d0) pw[orow * DV + d0 * 32 + rr32] = o[d0][r]; } }
    else
    { const int ln = fresh_lane(), rr32 = ln & 31, hh = ln >> 5;
      float* wsf2 = (float*)(lds + R * SHM_V + R * SHM_K) + wid * 64;
      if (hh == 0) wsf2[rr32] = l_reg; asm volatile("s_waitcnt lgkmcnt(0)" ::: "memory");
      float rli[16];
#pragma unroll
      for (int r = 0; r < 16; ++r) rli[r] = __builtin_amdgcn_rcpf(wsf2[crow(r, hh)]);
      constexpr int OP = DV * 2 + 16, OSZ = 32 * OP, NV = (3 * SHM_V) / OSZ;
      static_assert((8 - NV) * OSZ <= R * SHM_K, "O staging");
      char* stg = lds + (wid < NV ? wid * OSZ : R * SHM_V + (wid - NV) * OSZ);
#pragma unroll
      for (int r = 0; r < 16; ++r) { const int orow = crow(r, hh);
#pragma unroll
          for (int d0 = 0; d0 < NO; ++d0) *(bf16_t*)(stg + orow * OP + (d0 * 32 + rr32) * 2) = (bf16_t)f2bf(o[d0][r] * rli[r]); }
      asm volatile("s_waitcnt lgkmcnt(0)" ::: "memory");
      bf16_t* Ow = Ob + (long)(wid * QBLK) * ldo;
      constexpr int SEG = DV * 2 / 16;
#pragma unroll
      for (int ps = 0; ps < DV / 16; ++ps) { const int idx = ps * 64 + ln, row = idx / SEG, seg = idx % SEG;
          const u32x4 w = *(const u32x4*)(stg + row * OP + seg * 16);
          *(u32x4*)(Ow + (long)row * ldo + seg * 8) = w; } }
#undef STG_SLOAD
#undef STG_SWRITE
#undef STG_BAR
}
}
constexpr int NWAVES = 8;
constexpr int DM = 1024, NBATCH = 8, SEQ = 4096, CTXL = 256, TPB = CTXL + SEQ  , T = NBATCH * TPB  ;
constexpr int FF = 3584, NEXP = 8, DEPTH = 4;
constexpr int A_IN = 5120, B_IN = 672, B_INP = 768, C_IN = 1536, D_IN = 3072;
constexpr float NORM_EPS = 1e-6f;
constexpr int MOE_ROWS = 2 * T + NEXP * 256;

enum { I_X = 0, I_C, I_CTX, I_CCTX, I_MODW, I_MODB, I_NORMG, I_A_WIN, I_A_LB, I_A_ONORM, I_A_WOUT, I_B_WIN, I_B_QNORM, I_B_KVNORM, I_B_WQB, I_B_WKVB, I_B_WOUT,
       I_C_WIN, I_C_QNORM, I_C_KNORM, I_C_WOUT, I_D_WIN, I_D_LAMBDA, I_D_ONORM, I_D_WOUT, I_FFN_GU, I_FFN_DOWN, I_MOE_ROUTER, I_MOE_GU, I_MOE_DOWN, N_IN };

constexpr size_t al256(size_t x) { return (x + 255) / 256 * 256; }
constexpr size_t WS_CTL = 0, CTL_BYTES = 1u << 20;
constexpr size_t WS_MOD = WS_CTL + CTL_BYTES;
constexpr size_t WS_ROPE = WS_MOD + al256((size_t)DEPTH * 9 * 6 * DM * 4);
constexpr size_t WS_LB = WS_ROPE + al256((size_t)3 * 64 * 32 * 2 * 4);
constexpr size_t WS_W0 = WS_LB + al256((size_t)2 * 1024 * 4);
constexpr size_t WS_WA_IN = WS_W0;                                  constexpr size_t SZ_WA_IN = (size_t)A_IN * DM * 2;
constexpr size_t WS_WA_OUT = WS_WA_IN + SZ_WA_IN;                   constexpr size_t SZ_WOUT = (size_t)DM * DM * 2;
constexpr size_t WS_WB_IN = WS_WA_OUT + SZ_WOUT;                    constexpr size_t SZ_WB_IN = (size_t)B_INP * DM * 2;
constexpr size_t WS_WB_QB = WS_WB_IN + SZ_WB_IN;                    constexpr size_t SZ_WB_QB = (size_t)1536 * 384 * 2;
constexpr size_t WS_WB_KVB = WS_WB_QB + SZ_WB_QB;                   constexpr size_t SZ_WB_KVB = (size_t)2048 * 256 * 2;
constexpr size_t WS_WB_OUT = WS_WB_KVB + SZ_WB_KVB;
constexpr size_t WS_WC_IN = WS_WB_OUT + SZ_WOUT;                    constexpr size_t SZ_WC_IN = (size_t)C_IN * DM * 2;
constexpr size_t WS_WC_OUT = WS_WC_IN + SZ_WC_IN;
constexpr size_t WS_WD_IN = WS_WC_OUT + SZ_WOUT;                    constexpr size_t SZ_WD_IN = (size_t)D_IN * DM * 2;
constexpr size_t WS_WD_OUT = WS_WD_IN + SZ_WD_IN;
constexpr size_t WS_FFN_GU = WS_WD_OUT + SZ_WOUT;                   constexpr size_t SZ_GU = (size_t)2 * FF * DM;
constexpr size_t WS_FFN_DN = WS_FFN_GU + 2 * SZ_GU;                 constexpr size_t SZ_DN = (size_t)DM * FF * 2;
constexpr size_t WS_MOE_GU = WS_FFN_DN + 2 * SZ_DN;
constexpr size_t WS_MOE_DN = WS_MOE_GU + 16 * SZ_GU;
constexpr size_t WS_WEND = WS_MOE_DN + 16 * SZ_DN;
constexpr size_t WS_H = al256(WS_WEND);                              constexpr size_t SZ_H = (size_t)T * DM * 4;
constexpr size_t WS_XA = WS_H + SZ_H;                                constexpr size_t SZ_XA = (size_t)T * DM * 2;
constexpr size_t WS_Y = WS_XA + SZ_XA;                               constexpr size_t SZ_Y = (size_t)T * DM * 4;
constexpr size_t WS_YS = WS_Y + SZ_Y;                              constexpr size_t SZ_YS = (size_t)8 * 2048 * DM * 4;
constexpr size_t WS_ROUTE = WS_YS + SZ_YS;                             constexpr size_t SZ_ROUTE = (size_t)T * 32;
constexpr size_t WS_WCNT = WS_ROUTE + SZ_ROUTE;                      constexpr size_t SZ_WCNT = (size_t)256 * 8 * 4;
constexpr size_t WS_LIST = WS_WCNT + SZ_WCNT;                      constexpr size_t SZ_LIST = (size_t)NEXP * T * 4;
constexpr size_t WS_R0 = al256(WS_LIST + SZ_LIST);
constexpr size_t WS_Z = WS_R0;                                       constexpr size_t SZ_Z = (size_t)T * A_IN * 2;
constexpr size_t WS_Q = WS_Z + SZ_Z;                                 constexpr size_t SZ_Q = (size_t)T * 2048 * 2;
constexpr size_t WS_K = WS_Q + SZ_Q;                                 constexpr size_t SZ_K = (size_t)T * 1536 * 2;
constexpr size_t WS_V = WS_K + SZ_K;                                 constexpr size_t SZ_V = (size_t)T * 1024 * 2;
constexpr size_t WS_O = WS_V + SZ_V;                                 constexpr size_t SZ_O = (size_t)T * 2048 * 2;
constexpr size_t WS_MIX_END = WS_O + SZ_O;
constexpr size_t WS_ACT = WS_R0;                                     constexpr size_t SZ_ACT = (size_t)MOE_ROWS * FF * 2;
constexpr size_t WS_YP = WS_ACT + al256(SZ_ACT);                     constexpr size_t SZ_YP = (size_t)MOE_ROWS * DM * 4;
constexpr size_t WS_FFN_END = WS_YP + SZ_YP;
constexpr size_t WS_END = (WS_MIX_END > WS_FFN_END ? WS_MIX_END : WS_FFN_END);
static_assert((size_t)T * 1536 * 4 <= SZ_Z && (size_t)T * B_INP * 4 <= SZ_Z && (size_t)T * D_IN * 2 <= SZ_Z, "Z region");
static_assert((size_t)T * (384 + 256) * 2 <= SZ_O, "MLA normalised latents fit the O region");

constexpr int CW_BAR = 4096;
constexpr int CW_MOECNT = 16384;
constexpr int RING_BYTES = 131072;
constexpr int MISC_OFF = 163840 - 1024;
constexpr int LDS_BYTES = 163840;
static_assert(RING_BYTES <= MISC_OFF, "LDS map");

#define XB_TMO      128
#define XB_XCNT(j)  (256  + 64 * (j))
#define XB_XSUB(j)  (1280 + 64 * (j))
#define XB_XGEN(j)  (2304 + 64 * (j))
#define XB_TOP      3328
#define XB_TOPGEN   3392
#define XCD_BAR_WORDS 3456
#define XB_SPIN_CAP (1u << 22)
__device__ __forceinline__ unsigned xb_ld(unsigned* p)              { return __hip_atomic_load(p, __ATOMIC_RELAXED, __HIP_MEMORY_SCOPE_AGENT); }
__device__ __forceinline__ unsigned xb_add(unsigned* p, unsigned v) { return __hip_atomic_fetch_add(p, v, __ATOMIC_RELAXED, __HIP_MEMORY_SCOPE_AGENT); }
__device__ __forceinline__ unsigned xb_xcc_id() { return (unsigned)__builtin_amdgcn_s_getreg((3 << 11) | 20) & 0xFu; }
#define XB_SPIN(cond, bar) do { unsigned _sp = 0; while (cond) { __builtin_amdgcn_s_sleep(1); \
    if ((++_sp & 255u) == 0u) { if (xb_ld(&(bar)[XB_TMO])) break; if (_sp > XB_SPIN_CAP) { atomicAdd(&(bar)[XB_TMO], 1u); break; } } } } while (0)
struct XcdBarrier { unsigned* bar; unsigned x; volatile LAS unsigned* st; };
__device__ __forceinline__ XcdBarrier xcd_barrier_post(unsigned* bar, volatile LAS unsigned* st) {
    XcdBarrier b; b.bar = bar; b.x = xb_xcc_id(); b.st = st;
    if (threadIdx.x == 0) (void)xb_add(&bar[XB_XCNT(b.x)], 1u);
    return b;
}
__device__ __forceinline__ void xcd_barrier_complete(unsigned* bar, unsigned x, unsigned& nloc, unsigned& nx) {
    const unsigned G = gridDim.x * gridDim.y * gridDim.z;
    unsigned sum, cnt, mine, sp = 0u;
    for (;;) {
        sum = 0u; cnt = 0u; mine = 0u;
#pragma unroll
        for (unsigned j = 0; j < 16; ++j) { const unsigned c = xb_ld(&bar[XB_XCNT(j)]); sum += c; cnt += (c > 0u) ? 1u : 0u; mine = (j == x) ? c : mine; }
        if (sum == G) break;
        __builtin_amdgcn_s_sleep(1);
        if ((++sp & 255u) == 0u) { if (xb_ld(&bar[XB_TMO])) break; if (sp > XB_SPIN_CAP) { atomicAdd(&bar[XB_TMO], 1u); break; } }
    }
    nloc = mine > 0u ? mine : 1u; nx = cnt > 0u ? cnt : 1u;
}
__device__ __forceinline__ void xcd_barrier(const XcdBarrier& b, const int wave) {
    asm volatile("s_waitcnt vmcnt(0)" ::: "memory");
    __syncthreads();
    if (wave == 0 && fresh_lane() == 0) {
        unsigned* bar = b.bar;
        __builtin_amdgcn_s_waitcnt(0);
        unsigned nloc = b.st[0], nx = b.st[1];
        if (nloc == 0u) { xcd_barrier_complete(bar, b.x, nloc, nx); b.st[0] = nloc; b.st[1] = nx; }
        const unsigned old = xb_add(&bar[XB_XSUB(b.x)], 1u);
        const unsigned gen = old / nloc;
        if (old + 1u == (gen + 1u) * nloc) {
            __builtin_amdgcn_fence(__ATOMIC_RELEASE, "agent");
            asm volatile("s_waitcnt vmcnt(0)" ::: "memory");
            const unsigned og = xb_add(&bar[XB_TOP], 1u);
            const unsigned tg = og / nx;
            if (og + 1u == (tg + 1u) * nx) xb_add(&bar[XB_TOPGEN], 1u);
            else XB_SPIN(xb_ld(&bar[XB_TOPGEN]) == tg, bar);
            __builtin_amdgcn_fence(__ATOMIC_ACQUIRE, "agent");
            xb_add(&bar[XB_XGEN(b.x)], 1u);
            asm volatile("s_waitcnt vmcnt(0)" ::: "memory");
        } else {
            XB_SPIN(xb_ld(&bar[XB_XGEN(b.x)]) == gen, bar);
            __builtin_amdgcn_fence(__ATOMIC_ACQUIRE, "agent");
            asm volatile("s_waitcnt vmcnt(0)" ::: "memory");
        }
    }
    __syncthreads();
}

struct Frame {
    LAS unsigned char* lds; volatile LAS unsigned* MISC; unsigned char* ws;
    int wave, vcu, G;
};
typedef __attribute__((address_space(4))) const unsigned long long* kargp_t;
__device__ __forceinline__ float* out_ptr() { kargp_t ka = (kargp_t)__builtin_amdgcn_kernarg_segment_ptr(); return (float*)(GAS float*)(ka[N_IN]); }
__device__ __forceinline__ const float* in_ptr(const Frame&, int idx) { kargp_t ka = (kargp_t)__builtin_amdgcn_kernarg_segment_ptr(); return (const float*)(const GAS float*)(ka[idx]); }

struct MatDesc { int in_idx; unsigned src_off  ; int K, Nsrc, Ndst, kind  ; unsigned long long dst  ; };
constexpr int NMAT = 10 + 2 + 2 + 16 + 16, NMAT0 = 4;
struct MatTable { MatDesc m[NMAT]; int item0[NMAT + 1]; };
constexpr MatTable make_mats() {
    MatTable t{}; int n = 0;
    auto add = [&](int in_idx, unsigned src_off, int K, int Nsrc, int Ndst, int kind, unsigned long long dst) { t.m[n] = MatDesc{in_idx, src_off, K, Nsrc, Ndst, kind, dst}; ++n; };
    add(I_A_WIN, 0, DM, A_IN, A_IN, 0, WS_WA_IN); add(I_A_WOUT, 0, DM, DM, DM, 0, WS_WA_OUT);
    add(I_FFN_GU, 0, DM, 2 * FF, 2 * FF, 2, WS_FFN_GU); add(I_FFN_DOWN, 0, FF, DM, DM, 0, WS_FFN_DN);
    add(I_B_WIN, 0, DM, B_IN, B_INP, 0, WS_WB_IN); add(I_B_WQB, 0, 384, 1536, 1536, 0, WS_WB_QB); add(I_B_WKVB, 0, 256, 2048, 2048, 0, WS_WB_KVB); add(I_B_WOUT, 0, DM, DM, DM, 0, WS_WB_OUT);
    add(I_C_WIN, 0, DM, C_IN, C_IN, 3, WS_WC_IN); add(I_C_WOUT, 0, DM, DM, DM, 0, WS_WC_OUT);
    add(I_D_WIN, 0, DM, D_IN, D_IN, 0, WS_WD_IN); add(I_D_WOUT, 0, DM, DM, DM, 0, WS_WD_OUT);
    add(I_FFN_GU, (unsigned)1 * DM * 2 * FF, DM, 2 * FF, 2 * FF, 2, WS_FFN_GU + SZ_GU); add(I_FFN_DOWN, (unsigned)1 * FF * DM, FF, DM, DM, 0, WS_FFN_DN + SZ_DN);
    for (int j = 0; j < 16; ++j) add(I_MOE_GU, (unsigned)j * DM * 2 * FF, DM, 2 * FF, 2 * FF, 2, WS_MOE_GU + (size_t)j * SZ_GU);
    for (int j = 0; j < 16; ++j) add(I_MOE_DOWN, (unsigned)j * FF * DM, FF, DM, DM, 0, WS_MOE_DN + (size_t)j * SZ_DN);
    int acc = 0; for (int i = 0; i < NMAT; ++i) { t.item0[i] = acc; acc += (t.m[i].K / 64) * (t.m[i].Ndst / 64); } t.item0[NMAT] = acc;
    return t;
}
__device__ const MatTable g_mats = make_mats();

__host__ __device__ __forceinline__ int gqa_dim(int c) { const int wc = c >> 5, fq = (c >> 3) & 3, e = c & 7; return 64 * (wc >> 1) + 32 * (fq >> 1) + 16 * (wc & 1) + 8 * (fq & 1) + e; }
constexpr int P0_SCR = 64 * 65 * 4;
__device__ __forceinline__ void p0_transpose_item(const float* W, int K, int Nsrc, int kind, bf16_t* WT, LAS float* scr, int item, int Ndst, int lane) {
    const int nblk = Ndst / 64, kb = item / nblk, nb = item % nblk, k0 = 64 * kb, n0 = 64 * nb;
    int s0;
    if (kind == 1 || kind == 2) { const int pn = n0 >> 8, bj = (n0 >> 7) & 1, cc = n0 & 127; s0 = bj * FF + 128 * pn + cc; } else s0 = n0;
    int sl = s0 + lane;
    if (kind == 3) { const int n = n0 + lane; sl = (n < 1280) ? (n & ~127) + gqa_dim(n & 127) : n; }
    const bool ok = (kind >= 1) || (n0 + lane < Nsrc);
    const float* src = W + (size_t)k0 * Nsrc + sl;
    float tv[64];
#pragma unroll
    for (int kk = 0; kk < 64; ++kk) tv[kk] = ok ? src[(size_t)kk * Nsrc] : 0.f;
#pragma unroll
    for (int kk = 0; kk < 64; ++kk) scr[kk * 65 + lane] = tv[kk];
    asm volatile("s_waitcnt lgkmcnt(0)" ::: "memory");
    if (kind == 2) {
        const int c = lane & 3; unsigned char* WT8 = (unsigned char*)WT;
#pragma unroll
        for (int j = 0; j < 4; ++j) { const int n = (lane >> 2) + 16 * j; const LAS float* sp = scr + (16 * c) * 65 + n;
            u32x4 o; o.x = pk4_fp8(32.f * sp[0 * 65], 32.f * sp[1 * 65], 32.f * sp[2 * 65], 32.f * sp[3 * 65]); o.y = pk4_fp8(32.f * sp[4 * 65], 32.f * sp[5 * 65], 32.f * sp[6 * 65], 32.f * sp[7 * 65]);
            o.z = pk4_fp8(32.f * sp[8 * 65], 32.f * sp[9 * 65], 32.f * sp[10 * 65], 32.f * sp[11 * 65]); o.w = pk4_fp8(32.f * sp[12 * 65], 32.f * sp[13 * 65], 32.f * sp[14 * 65], 32.f * sp[15 * 65]);
            *(u32x4*)(WT8 + (size_t)(n0 + n) * K + k0 + 16 * c) = o; }
    } else {
    const int c = lane & 7;
#pragma unroll
    for (int j = 0; j < 8; ++j) { const int n = (lane >> 3) + 8 * j; const LAS float* sp = scr + (8 * c) * 65 + n;
        u32x4 o; o.x = pk2(sp[0 * 65], sp[1 * 65]); o.y = pk2(sp[2 * 65], sp[3 * 65]); o.z = pk2(sp[4 * 65], sp[5 * 65]); o.w = pk2(sp[6 * 65], sp[7 * 65]);
        *(u32x4*)(WT + (size_t)(n0 + n) * K + k0 + 8 * c) = o; }
    }
    asm volatile("s_waitcnt lgkmcnt(0)" ::: "memory");
}

__device__ __forceinline__ void p0_convert(Frame& F, int it0, int it1, int worker, int nworkers, int lane) {
    LAS float* scr = (LAS float*)(F.lds + F.wave * P0_SCR);
    for (int it = it0 + worker; it < it1; it += nworkers) {
        int mi = 0;
#pragma unroll 1
        for (int j = 1; j < NMAT; ++j) mi = (it >= g_mats.item0[j]) ? j : mi;
        const MatDesc d = g_mats.m[mi];
        p0_transpose_item(in_ptr(F, d.in_idx) + d.src_off, d.K, d.Nsrc, d.kind, (bf16_t*)(F.ws + d.dst), scr, it - g_mats.item0[mi], d.Ndst, lane);
    }
}
__device__ __forceinline__ int p0_split_item() { const int i0 = g_mats.item0[NMAT0], i1 = g_mats.item0[NMAT]; return i0 + (int)((long)(i1 - i0) * 0 / 100); }
__device__ __forceinline__ void p0_prologue(Frame& F) {
    const int lane = fresh_lane(), tid = F.wave * 64 + lane; (void)tid;
    const int gw = F.vcu * NWAVES + F.wave, NGW = F.G * NWAVES;
    p0_convert(F, 0, p0_split_item(), gw, NGW, lane);
    __syncthreads();
    {
        LAS float* cond = (LAS float*)F.lds;
        LAS float* part = (LAS float*)(F.lds + 65536);
        const float* cin = in_ptr(F, I_C); const float* cctx = in_ptr(F, I_CCTX);
        for (int i = tid; i < 9 * DM; i += 512) { const int r = i / DM, k = i % DM; const float v = (r < 8) ? cin[r * DM + k] : cctx[k]; cond[i] = silu_f(v); }
        __syncthreads();
        const float* mw = in_ptr(F, I_MODW); const float* mb = in_ptr(F, I_MODB);
        float* modt = (float*)(F.ws + WS_MOD);
        constexpr int NITEM = DEPTH * (6 * DM / 64);
        for (int it = F.vcu; it < NITEM; it += F.G) {
            const int l = it / 96, cb = it % 96, col = cb * 64 + lane;
            float a[9];
#pragma unroll
            for (int r = 0; r < 9; ++r) a[r] = 0.f;
            const float* wp = mw + ((size_t)l * DM + F.wave * 128) * (6 * DM) + col;
#pragma unroll 8
            for (int k = 0; k < 128; ++k) { const float w = wp[(size_t)k * (6 * DM)];
#pragma unroll
                for (int r = 0; r < 9; ++r) a[r] = fmaf(cond[r * DM + F.wave * 128 + k], w, a[r]); }
#pragma unroll
            for (int r = 0; r < 9; ++r) part[(F.wave * 9 + r) * 64 + lane] = a[r];
            __syncthreads();
            for (int i = tid; i < 9 * 64; i += 512) { const int r = i / 64, c = i % 64; float s = mb[(size_t)l * 6 * DM + cb * 64 + c];
#pragma unroll
                for (int w = 0; w < 8; ++w) s += part[(w * 9 + r) * 64 + c];
                modt[((size_t)l * 9 + r) * (6 * DM) + cb * 64 + c] = s; }
            __syncthreads();
        }
    }
    {
        float* rt = (float*)(F.ws + WS_ROPE);
        for (int i = gw * 64 + lane; i < 3 * 64 * 32; i += NGW * 64) { const int kind = i / 2048, pos = (i / 32) % 64, fi = i % 32; const int n = 16 << kind;
            if (fi < n / 2) { const float inv = exp2f(-(float)(2 * fi) / (float)n * 13.287712379549449f);
                const float ang = (float)pos * inv; float s, c;
                {
                  const float rev = ang * 0.15915494309189535f; const float fr = rev - floorf(rev); s = __builtin_amdgcn_sinf(fr); c = __builtin_amdgcn_cosf(fr); }
                rt[(size_t)i * 2] = c; rt[(size_t)i * 2 + 1] = s; } }
    }
    {
        const float* alb = in_ptr(F, I_A_LB); float* lb = (float*)(F.ws + WS_LB);
        for (int i = gw * 64 + lane; i < 2 * 1024; i += NGW * 64) { const int dir = i / 1024, w = i % 1024; float v[5], mx = -1e30f;
#pragma unroll
            for (int j = 0; j < 5; ++j) { v[j] = alb[((size_t)dir * 5 + j) * 1024 + w]; mx = fmaxf(mx, v[j]); }
            float s = 0.f;
#pragma unroll
            for (int j = 0; j < 5; ++j) s += expf(v[j] - mx);
            lb[i] = expf(v[0] - mx) / s; }
    }
}

struct RowPos { int b, p, modrow, prow, pcol; bool isctx; };
__device__ __forceinline__ RowPos row_pos(int m) { RowPos r; r.b = m / TPB; r.p = m % TPB; r.isctx = r.p < CTXL; r.modrow = r.isctx ? 8 : r.b; const int t = r.isctx ? 0 : r.p - CTXL; r.prow = t >> 6; r.pcol = t & 63; return r; }
__device__ __forceinline__ void ld_row(const float* p, int lane, f32x4 (&v)[4]) {
#pragma unroll
    for (int j = 0; j < 4; ++j) v[j] = *(const f32x4*)(p + 256 * j + 4 * lane);
}
__device__ __forceinline__ void ld_row_bf16(const bf16_t* p, int lane, f32x4 (&v)[4]) {
#pragma unroll
    for (int j = 0; j < 4; ++j) { const u32x2 w = *(const u32x2*)(p + 256 * j + 4 * lane); v[j] = (f32x4){bf2f(w.x & 0xffffu), bf2f(w.x >> 16), bf2f(w.y & 0xffffu), bf2f(w.y >> 16)}; }
}
__device__ __forceinline__ void st_row_bf16(bf16_t* p, int lane, const f32x4 (&v)[4]) {
#pragma unroll
    for (int j = 0; j < 4; ++j) { u32x2 w; w.x = pk2(v[j].x, v[j].y); w.y = pk2(v[j].z, v[j].w); *(u32x2*)(p + 256 * j + 4 * lane) = w; }
}
__device__ __forceinline__ float sumsq_row(const f32x4 (&v)[4]) { float s = 0.f;
#pragma unroll
    for (int j = 0; j < 4; ++j) s += (v[j].x * v[j].x + v[j].y * v[j].y) + (v[j].z * v[j].z + v[j].w * v[j].w);
    return wave_sum(s); }
__device__ __forceinline__ void norm_mod_store(const f32x4 (&x)[4], float rstd, const float* g, const float* shift, const float* scale, bf16_t* dst, int lane, f32x4 (&u)[4]) {
#pragma unroll
    for (int j = 0; j < 4; ++j) { const int c = 256 * j + 4 * lane; const f32x4 gg = *(const f32x4*)(g + c), sh = *(const f32x4*)(shift + c), sc = *(const f32x4*)(scale + c);
        u[j] = (x[j] * rstd * gg) * (sc + 1.0f) + sh;
        u32x2 w; w.x = pk2(u[j].x, u[j].y); w.y = pk2(u[j].z, u[j].w); *(u32x2*)(dst + c) = w; }
}

__device__ __forceinline__ void norm_mod_store_fp8(const f32x4 (&x)[4], float rstd, const float* g, const float* shift, const float* scale, unsigned char* dst, int lane, f32x4 (&u)[4]) {
#pragma unroll
    for (int j = 0; j < 4; ++j) { const int c = 256 * j + 4 * lane; const f32x4 gg = *(const f32x4*)(g + c), sh = *(const f32x4*)(shift + c), sc = *(const f32x4*)(scale + c);
        u[j] = (x[j] * rstd * gg) * (sc + 1.0f) + sh;
        *(unsigned*)(dst + c) = pk4_fp8(u[j].x, u[j].y, u[j].z, u[j].w); }
}
__device__ __forceinline__ void ld_y_row(const unsigned char* ws, int m, const RowPos& rp, int S, int lane, f32x4 (&yv)[4]) {
    if (rp.isctx) { const float* ys = (const float*)(ws + WS_YS) + (size_t)(rp.b * CTXL + rp.p) * DM;
        ld_row(ys, lane, yv);
        for (int s = 1; s < S; ++s) { f32x4 t[4]; ld_row(ys + (size_t)s * 2048 * DM, lane, t);
#pragma unroll
            for (int j = 0; j < 4; ++j) yv[j] = yv[j] + t[j]; } }
    else ld_row_bf16((const bf16_t*)(ws + WS_Y) + (size_t)m * DM, lane, yv);
}
__device__ __forceinline__ void ld_yp_row(const unsigned char* ws, size_t r, int RBM, int trb, int S, int lane, f32x4 (&v)[4]) {
    const int rb = (int)(r >> 8);
    if (rb >= RBM) { const float* ys = (const float*)(ws + WS_YS) + ((size_t)(rb - RBM) * 256 + (r & 255)) * DM;
        ld_row(ys, lane, v);
        for (int s = 1; s < S; ++s) { f32x4 t[4]; ld_row(ys + (size_t)s * trb * 256 * DM, lane, t);
#pragma unroll
            for (int j = 0; j < 4; ++j) v[j] = v[j] + t[j]; } }
    else ld_row_bf16((const bf16_t*)(ws + WS_YP) + r * DM, lane, v);
}
__device__ __forceinline__ float half_sum(float v) {
#pragma unroll
    for (int o = 1; o < 32; o <<= 1) v += __shfl_xor(v, o);
    return v;
}
__device__ __forceinline__ void ld_row2(const float* p, int l32, f32x4 (&v)[8]) {
#pragma unroll
    for (int j = 0; j < 8; ++j) v[j] = *(const f32x4*)(p + 128 * j + 4 * l32);
}
__device__ __forceinline__ void ld_row2_bf16(const bf16_t* p, int l32, f32x4 (&v)[8]) {
#pragma unroll
    for (int j = 0; j < 8; ++j) { const u32x2 w = *(const u32x2*)(p + 128 * j + 4 * l32); v[j] = (f32x4){bf2f(w.x & 0xffffu), bf2f(w.x >> 16), bf2f(w.y & 0xffffu), bf2f(w.y >> 16)}; }
}
__device__ __forceinline__ void st_row2_bf16(bf16_t* p, int l32, const f32x4 (&v)[8]) {
#pragma unroll
    for (int j = 0; j < 8; ++j) { u32x2 w; w.x = pk2(v[j].x, v[j].y); w.y = pk2(v[j].z, v[j].w); *(u32x2*)(p + 128 * j + 4 * l32) = w; }
}
__device__ __forceinline__ float sumsq_row2(const f32x4 (&v)[8]) { float s = 0.f;
#pragma unroll
    for (int j = 0; j < 8; ++j) s += (v[j].x * v[j].x + v[j].y * v[j].y) + (v[j].z * v[j].z + v[j].w * v[j].w);
    return half_sum(s); }
template <bool FP8>
__device__ __forceinline__ void norm_mod2(const f32x4 (&x)[8], float rstd, const LAS float* g, const LAS float* shift, const LAS float* scale, void* dst, int l32, bool st, f32x4 (&u)[8]) {
#pragma unroll
    for (int j = 0; j < 8; ++j) { if ((j & 3) == 0) __builtin_amdgcn_sched_barrier(0);
        const int c = 128 * j + 4 * l32; const f32x4 gg = *(const LAS f32x4*)(g + c), sh = *(const LAS f32x4*)(shift + c), sc = *(const LAS f32x4*)(scale + c);
        u[j] = (x[j] * rstd * gg) * (sc + 1.0f) + sh;
        if (st) { if (FP8) *(unsigned*)((unsigned char*)dst + c) = pk4_fp8(u[j].x, u[j].y, u[j].z, u[j].w);
                  else { u32x2 w; w.x = pk2(u[j].x, u[j].y); w.y = pk2(u[j].z, u[j].w); *(u32x2*)((bf16_t*)dst + c) = w; } } }
}
constexpr int PAR_FLOATS = 29 * DM;
__device__ __forceinline__ void fill_params(Frame& F, const float* ga, const float* gb, const float* m0, const float* m1, const float* m2, int tid) {
    LAS float* par = (LAS float*)F.lds;
    for (int i = tid; i < PAR_FLOATS / 4; i += NWAVES * 64) { const int v = i >> 8, c = (i & 255) * 4; const float* src;
        if (v == 0) src = ga; else if (v == 1) src = gb; else { const int r = (v - 2) / 3, k = (v - 2) % 3; src = (k == 0 ? m0 : k == 1 ? m1 : m2) + (size_t)r * (6 * DM); }
        *(LAS f32x4*)(par + v * DM + c) = *(const f32x4*)(src + c); }
    __syncthreads();
}
__device__ __forceinline__ void ld_y_row2(const unsigned char* ws, int m, const RowPos& rp, bool slab, int S, int l32, f32x4 (&yv)[8]) {
    if (slab) { const float* ys = (const float*)(ws + WS_YS) + (size_t)(rp.b * CTXL + rp.p) * DM;
        ld_row2(ys, l32, yv);
#pragma unroll 1
        for (int s = 1; s < S; ++s) { f32x4 t[8]; ld_row2(ys + (size_t)s * 2048 * DM, l32, t);
#pragma unroll
            for (int j = 0; j < 8; ++j) yv[j] = yv[j] + t[j]; } }
    else ld_row2_bf16((const bf16_t*)(ws + WS_Y) + (size_t)m * DM, l32, yv);
}
__device__ __forceinline__ void ld_yp_row2(const unsigned char* ws, size_t r, int RBM, int trb, int S, int l32, f32x4 (&v)[8]) {
    const int rb = (int)(r >> 8);
    if (rb >= RBM) { const float* ys = (const float*)(ws + WS_YS) + ((size_t)(rb - RBM) * 256 + (r & 255)) * DM;
        ld_row2(ys, l32, v);
#pragma unroll 1
        for (int s = 1; s < S; ++s) { f32x4 t[8]; ld_row2(ys + (size_t)s * trb * 256 * DM, l32, t);
#pragma unroll
            for (int j = 0; j < 8; ++j) v[j] = v[j] + t[j]; } }
    else ld_row2_bf16((const bf16_t*)(ws + WS_YP) + r * DM, l32, v);
}

__device__ __forceinline__ void phase_r0(Frame& F) {
    const int lane = fresh_lane(), l32 = lane & 31, half = lane >> 5;
    const int gw = F.vcu * NWAVES + F.wave, NGW = F.G * NWAVES;
    const float* x = in_ptr(F, I_X); const float* ctx = in_ptr(F, I_CTX); const float* ng = in_ptr(F, I_NORMG);
    bf16_t* h = (bf16_t*)(F.ws + WS_H); bf16_t* xa = (bf16_t*)(F.ws + WS_XA); const float* modt = (const float*)(F.ws + WS_MOD);
    fill_params(F, ng + (0 * 4 + 0) * DM, ng + (0 * 4 + 0) * DM, modt + 0 * DM, modt + 1 * DM, modt + 1 * DM, F.wave * 64 + lane);
    const LAS float* par = (const LAS float*)F.lds;
    for (int pi = gw; pi < T / 2; pi += NGW) { const int m = 2 * pi + half; const RowPos rp = row_pos(m);
        const float* src = rp.isctx ? ctx + ((size_t)rp.b * CTXL + rp.p) * DM : x + ((size_t)rp.b * SEQ + (rp.p - CTXL)) * DM;
        f32x4 v[8], u[8]; ld_row2(src, l32, v);
        st_row2_bf16(h + (size_t)m * DM, l32, v);
        const float rstd = rsqrtf(sumsq_row2(v) * (1.0f / DM) + NORM_EPS);
        const LAS float* pm = par + (2 + 3 * rp.modrow) * DM;
        norm_mod2<false>(v, rstd, par, pm + 0 * DM, pm + 1 * DM, xa + (size_t)m * DM, l32, true, u); }
    __syncthreads();
}

template <bool MOE>
__device__ __forceinline__ void phase_r1(Frame& F, int l) {
    const int lane = fresh_lane(), tid = F.wave * 64 + lane, l32 = lane & 31, half = lane >> 5;
    const float* ng = in_ptr(F, I_NORMG); const float* modt = (const float*)(F.ws + WS_MOD);
    bf16_t* h = (bf16_t*)(F.ws + WS_H); unsigned char* xa = (unsigned char*)(F.ws + WS_XA);
    const float* router = MOE ? in_ptr(F, I_MOE_ROUTER) + (size_t)(l >> 1) * DM * NEXP : nullptr;
    constexpr int LB = PAR_FLOATS * 4;
    LAS int* lcnt = (LAS int*)(F.lds + LB);
    LAS int* lbase = (LAS int*)(F.lds + LB + 64);
    LAS int* lrow = (LAS int*)(F.lds + LB + 1024);
    LAS float* lw = (LAS float*)(F.lds + LB + 4096);
    constexpr int RPW = T / 256;
    if (MOE) { if (tid < 8) lcnt[tid] = 0; }
    { const float* ml = modt + (size_t)l * 9 * (6 * DM); fill_params(F, ng + (l * 4 + 1) * DM, ng + (l * 4 + 2) * DM, ml + 2 * DM, ml + 3 * DM, ml + 4 * DM, tid); }
    const LAS float* par = (const LAS float*)F.lds;
    const int row0 = F.vcu * RPW;
    f32x4 yn[8], hn[8];
    { const int m0 = row0 + 2 * F.wave + half; const RowPos r0 = row_pos(m0); ld_y_row2(F.ws, m0, r0, r0.isctx && !(l == DEPTH - 1), 8, l32, yn); ld_row2_bf16(h + (size_t)m0 * DM, l32, hn); }
    for (int i2 = F.wave; i2 < RPW / 2; i2 += NWAVES) { const int i = 2 * i2 + half, m = row0 + i; const RowPos rp = row_pos(m);
        const bool skip = (l == DEPTH - 1) && rp.isctx;
        const LAS float* pm = par + (2 + 3 * rp.modrow) * DM;
        f32x4 yv[8], hv[8], u[8];
#pragma unroll
        for (int j = 0; j < 8; ++j) { yv[j] = yn[j]; hv[j] = hn[j]; }
        if (i2 + NWAVES < RPW / 2) { const int mn = m + 2 * NWAVES; const RowPos rn = row_pos(mn); ld_y_row2(F.ws, mn, rn, rn.isctx && !(l == DEPTH - 1), 8, l32, yn); ld_row2_bf16(h + (size_t)mn * DM, l32, hn); }
        const float rstd_y = rsqrtf(sumsq_row2(yv) * (1.0f / DM) + NORM_EPS);
#pragma unroll
        for (int j = 0; j < 8; ++j) { if ((j & 3) == 0) __builtin_amdgcn_sched_barrier(0);
            const int c = 128 * j + 4 * l32; const f32x4 g1 = *(const LAS f32x4*)(par + c), gt = *(const LAS f32x4*)(pm + c);
            hv[j] = hv[j] + gt * (yv[j] * rstd_y * g1); }
        if (!skip) st_row2_bf16(h + (size_t)m * DM, l32, hv);
        const float rstd_h = rsqrtf(sumsq_row2(hv) * (1.0f / DM) + NORM_EPS);
        norm_mod2<true>(hv, rstd_h, par + DM, pm + 1 * DM, pm + 2 * DM, xa + (size_t)m * DM, l32, !skip, u);
        if (MOE) {
            float lg[8];
#pragma unroll
            for (int e = 0; e < 8; ++e) lg[e] = 0.f;
#pragma unroll
            for (int j = 0; j < 8; ++j) { __builtin_amdgcn_sched_barrier(0);
#pragma unroll
                for (int q = 0; q < 4; ++q) { const int c = 128 * j + 4 * l32 + q; const f32x4 r0 = *(const f32x4*)(router + (size_t)c * 8), r1 = *(const f32x4*)(router + (size_t)c * 8 + 4); const float uv = u[j][q];
                    lg[0] = fmaf(uv, r0.x, lg[0]); lg[1] = fmaf(uv, r0.y, lg[1]); lg[2] = fmaf(uv, r0.z, lg[2]); lg[3] = fmaf(uv, r0.w, lg[3]);
                    lg[4] = fmaf(uv, r1.x, lg[4]); lg[5] = fmaf(uv, r1.y, lg[5]); lg[6] = fmaf(uv, r1.z, lg[6]); lg[7] = fmaf(uv, r1.w, lg[7]); } }
#pragma unroll
            for (int e = 0; e < 8; ++e) lg[e] = half_sum(lg[e]);
            int e1 = 0; float v1 = lg[0];
#pragma unroll
            for (int e = 1; e < 8; ++e) if (lg[e] > v1) { v1 = lg[e]; e1 = e; }
            int e2 = (e1 == 0) ? 1 : 0; float v2 = (e1 == 0) ? lg[1] : lg[0];
#pragma unroll
            for (int e = 1; e < 8; ++e) if (e != e1 && lg[e] > v2) { v2 = lg[e]; e2 = e; }
            const float w2 = fast_rcp(1.0f + expf(v1 - v2)), w1 = 1.0f - w2;
            if (l32 == 0) { if (skip) lrow[i * 4 + 0] = -1;
                else { lrow[i * 4 + 0] = e1; lrow[i * 4 + 2] = e2; lw[i * 2] = w1; lw[i * 2 + 1] = w2; } }
        }
    }
    if (MOE) {
        __syncthreads();
        if (tid < 8) { int c = 0; for (int i = 0; i < RPW; ++i) { const int a = lrow[i * 4], b = lrow[i * 4 + 2]; if (a < 0) continue; if (a == tid) lrow[i * 4 + 1] = c++; else if (b == tid) lrow[i * 4 + 3] = c++; }
            lcnt[tid] = c; ((int*)(F.ws + WS_WCNT))[F.vcu * 8 + tid] = c;
            __hip_atomic_fetch_add((int*)((unsigned*)F.ws + CW_MOECNT + (l >> 1) * 64) + tid, c, __ATOMIC_RELAXED, __HIP_MEMORY_SCOPE_AGENT); }
        __syncthreads();
        int* route = (int*)(F.ws + WS_ROUTE);
        for (int i = tid; i < RPW; i += 512) { const int m = row0 + i; const int e1 = lrow[i * 4], e2 = lrow[i * 4 + 2]; route[(size_t)m * 8 + 0] = e1; if (e1 < 0) continue;
            route[(size_t)m * 8 + 1] = lrow[i * 4 + 1]; route[(size_t)m * 8 + 2] = e2; route[(size_t)m * 8 + 3] = lrow[i * 4 + 3];
            ((float*)route)[(size_t)m * 8 + 4] = lw[i * 2]; ((float*)route)[(size_t)m * 8 + 5] = lw[i * 2 + 1]; }
        __syncthreads();
    }
}
__device__ __forceinline__ void moe_build(Frame& F) {
    const int lane = fresh_lane(), tid = F.wave * 64 + lane;
    LAS int* red = (LAS int*)F.lds;
    const int* wcnt = (const int*)(F.ws + WS_WCNT);
    { const int e = tid & 7; int sacc = 0; for (int v = tid >> 3; v < F.vcu; v += 64) sacc += wcnt[v * 8 + e]; red[tid] = sacc; }
    __syncthreads();
    if (tid < 8) { int sacc = 0; for (int k = 0; k < 64; ++k) sacc += red[k * 8 + tid]; red[512 + tid] = sacc; }
    __syncthreads();
    constexpr int RPW = T / 256; const int row0 = F.vcu * RPW;
    int* list = (int*)(F.ws + WS_LIST); int* route = (int*)(F.ws + WS_ROUTE);
    for (int i = tid; i < RPW; i += 512) { const int m = row0 + i; const int e1 = route[(size_t)m * 8]; if (e1 < 0) continue; const int e2 = route[(size_t)m * 8 + 2];
        const int s1 = red[512 + e1] + route[(size_t)m * 8 + 1], s2 = red[512 + e2] + route[(size_t)m * 8 + 3];
        list[(size_t)e1 * T + s1] = m; list[(size_t)e2 * T + s2] = m; route[(size_t)m * 8 + 1] = s1; route[(size_t)m * 8 + 3] = s2; }
}

__device__ __forceinline__ void moe_tables(Frame& F, int l) {
    const int lane = fresh_lane(), tid = F.wave * 64 + lane; (void)tid;
    if (tid == 0) { const int* gcnt = (const int*)((unsigned*)F.ws + CW_MOECNT + (l >> 1) * 64); int acc = 0;
        for (int e = 0; e < 8; ++e) { const int c = __hip_atomic_load(gcnt + e, __ATOMIC_RELAXED, __HIP_MEMORY_SCOPE_AGENT); F.MISC[32 + e] = (unsigned)c; F.MISC[16 + e] = (unsigned)acc; acc += (c + 255) / 256; }
        F.MISC[24] = (unsigned)acc; }
    __syncthreads();
}

template <bool MOE>
__device__ __forceinline__ void phase_r2(Frame& F, int l) {
    const int lane = fresh_lane(), l32 = lane & 31, half = lane >> 5;
    const int gw = F.vcu * NWAVES + F.wave, NGW = F.G * NWAVES;
    const float* ng = in_ptr(F, I_NORMG); const float* modt = (const float*)(F.ws + WS_MOD);
    bf16_t* h = (bf16_t*)(F.ws + WS_H); bf16_t* xa = (bf16_t*)(F.ws + WS_XA);
    const int* route = (const int*)(F.ws + WS_ROUTE);
    int RBM = 0, trb = 0, S = 1; if (MOE) pg8::moe_tail_params((int)F.MISC[24], RBM, trb, S);
    { const int ln = (l < DEPTH - 1) ? l + 1 : l; const float* ml = modt + (size_t)l * 9 * (6 * DM); const float* mn = modt + (size_t)ln * 9 * (6 * DM);
      fill_params(F, ng + (l * 4 + 3) * DM, ng + (ln * 4 + 0) * DM, ml + 5 * DM, mn + 0 * DM, mn + 1 * DM, F.wave * 64 + lane); }
    const LAS float* par = (const LAS float*)F.lds;
    f32x4 an[8], bn[8], hn[8]; float w1n = 0.f, w2n = 0.f;
#define R2_LOAD(mm) do { const RowPos _r = row_pos(mm); const bool _sk = (l == DEPTH - 1) && _r.isctx; \
        if (MOE) { int e1 = 0, s1 = 0, e2 = 0, s2 = 0; w1n = 0.f; w2n = 0.f; \
            if (!_sk) { e1 = route[(size_t)(mm) * 8]; s1 = route[(size_t)(mm) * 8 + 1]; e2 = route[(size_t)(mm) * 8 + 2]; s2 = route[(size_t)(mm) * 8 + 3]; w1n = ((const float*)route)[(size_t)(mm) * 8 + 4]; w2n = ((const float*)route)[(size_t)(mm) * 8 + 5]; } \
            const size_t r1 = (size_t)F.MISC[16 + e1] * 256 + s1, r2 = (size_t)F.MISC[16 + e2] * 256 + s2; \
            ld_yp_row2(F.ws, r1, RBM, trb, S, l32, an); ld_yp_row2(F.ws, r2, RBM, trb, S, l32, bn); } \
        else ld_y_row2(F.ws, (mm), _r, _r.isctx, 4, l32, an); \
        ld_row2_bf16(h + (size_t)(mm) * DM, l32, hn); } while (0)
    if (gw < T / 2) R2_LOAD(2 * gw + half);
    for (int pi = gw; pi < T / 2; pi += NGW) { const int m = 2 * pi + half; const RowPos rp = row_pos(m);
        const bool skip = (l == DEPTH - 1) && rp.isctx;
        const LAS float* pm = par + (2 + 3 * rp.modrow) * DM;
        f32x4 yv[8], hv[8], u[8];
#pragma unroll
        for (int j = 0; j < 8; ++j) { yv[j] = MOE ? (an[j] * w1n + bn[j] * w2n) : an[j]; hv[j] = hn[j]; }
        if (pi + NGW < T / 2) R2_LOAD(m + 2 * NGW);
        const float rstd_y = rsqrtf(sumsq_row2(yv) * (1.0f / DM) + NORM_EPS);
#pragma unroll
        for (int j = 0; j < 8; ++j) { if ((j & 3) == 0) __builtin_amdgcn_sched_barrier(0);
            const int c = 128 * j + 4 * l32; const f32x4 g3 = *(const LAS f32x4*)(par + c), gt = *(const LAS f32x4*)(pm + c);
            hv[j] = hv[j] + gt * (yv[j] * rstd_y * g3); }
        if (l == DEPTH - 1) { if (!skip) { float* dsto = out_ptr() + ((size_t)rp.b * SEQ + (rp.p - CTXL)) * DM;
#pragma unroll
                for (int j = 0; j < 8; ++j) *(f32x4*)(dsto + 128 * j + 4 * l32) = hv[j]; } }
        else st_row2_bf16(h + (size_t)m * DM, l32, hv);
        if (l < DEPTH - 1) { const float rstd_h = rsqrtf(sumsq_row2(hv) * (1.0f / DM) + NORM_EPS);
            norm_mod2<false>(hv, rstd_h, par + DM, pm + 1 * DM, pm + 2 * DM, xa + (size_t)m * DM, l32, true, u); }
    }
}
namespace scan {
constexpr int A_STR = 272, T_STR = 80;
constexpr int A1_OFF = 0, A2_OFF = 32 * A_STR, K2T_OFF = 2 * 32 * A_STR, VT_OFF = K2T_OFF + 128 * T_STR, DEC_OFF = VT_OFF + 128 * T_STR, BUF_BYTES = DEC_OFF + 512;
constexpr int NCH = TPB / 32;
__device__ __forceinline__ int crow(int r, int hi) { return (r & 3) + 8 * (r >> 2) + 4 * hi; }
__device__ __forceinline__ int tok_of(int p, int dir) { return dir == 0 ? p : (p < CTXL ? (CTXL - 1 - p) : (TPB + CTXL - 1 - p)); }

__device__ __forceinline__ int chunk_lowtok(int n, int dir) { return dir == 0 ? 32 * n : (n < CTXL / 32 ? CTXL - 32 - 32 * n : TPB + CTXL - 32 - 32 * n); }
constexpr int RAW_OFF = 2 * BUF_BYTES, RAW_BYTES = 3 * 8192;
__device__ __forceinline__ void prep_dma(const bf16_t* __restrict__ z, int b, int hd, int dir, int n, LAS unsigned char* raw, int pw, int lane) {
    const char* U = (const char*)(z + (size_t)(b * TPB + chunk_lowtok(n, dir)) * A_IN + hd * 128);
#pragma unroll
    for (int k = 0; k < 2; ++k) { const int c = 8 * pw + 4 * k + (lane >> 4), mr = dir ? 31 - c : c; const unsigned L = (unsigned)(mr * A_IN + (lane & 15) * 8) * 2u;
        __builtin_amdgcn_global_load_lds((const unsigned*)(U + L), (LAS unsigned*)(raw + 0 * 8192 + (2 * pw + k) * 1024), 16, 0, 0);
        __builtin_amdgcn_global_load_lds((const unsigned*)(U + 2048 * (1 + dir) + L), (LAS unsigned*)(raw + 1 * 8192 + (2 * pw + k) * 1024), 16, 0, 0);
        __builtin_amdgcn_global_load_lds((const unsigned*)(U + 6144 + L), (LAS unsigned*)(raw + 2 * 8192 + (2 * pw + k) * 1024), 16, 0, 0); }
}
struct Raw { unsigned short q[16], f[16], v[16]; };
__device__ __forceinline__ void prep_read(Raw& r, const LAS unsigned char* raw, int d, int rh) {
#pragma unroll
    for (int i = 0; i < 16; ++i) { const int o = (16 * rh + i) * 256 + d * 2;
        r.q[i] = *(const LAS unsigned short*)(raw + o); r.f[i] = *(const LAS unsigned short*)(raw + 8192 + o); r.v[i] = *(const LAS unsigned short*)(raw + 16384 + o); }
}
__device__ __forceinline__ void prep_compute(const Raw& r, float lbv, LAS unsigned char* buf, int d, int rh, int lane) {
    float cum[16], kk[16]; float run = 0.f;
#pragma unroll
    for (int i = 0; i < 16; ++i) { const float s = fast_rcp(1.0f + __builtin_amdgcn_exp2f(bf2f(r.f[i]) * -1.4426950408889634f)); const float f = lbv + (1.0f - lbv) * s; kk[i] = 1.0f - f; run += __builtin_amdgcn_logf(f); cum[i] = run; }
    const float tot_lo = __shfl(run, lane & 31);
    if (rh) {
#pragma unroll
        for (int i = 0; i < 16; ++i) cum[i] += tot_lo; }
    const float cend = __shfl(cum[15], (lane & 31) + 32);
    const float dec = __builtin_amdgcn_exp2f(cend);
    unsigned short a1[16], a2[16], k2[16];
#pragma unroll
    for (int i = 0; i < 16; ++i) { const float e1 = __builtin_amdgcn_exp2f(cum[i]), e2 = __builtin_amdgcn_exp2f(-cum[i]); const float A2 = kk[i] * e2;
        const unsigned w12 = cvt_pk_bf16(bf2f(r.q[i]) * 0.08838834764831845f * e1, A2);
        a1[i] = (unsigned short)(w12 & 0xffffu); a2[i] = (unsigned short)(w12 >> 16); k2[i] = (unsigned short)(cvt_pk_bf16(A2 * dec, 0.f) & 0xffffu); }
#pragma unroll
    for (int i = 0; i < 16; ++i) { const int c = 16 * rh + i;
        *(LAS unsigned short*)(buf + A1_OFF + c * A_STR + d * 2) = a1[i]; *(LAS unsigned short*)(buf + A2_OFF + c * A_STR + d * 2) = a2[i]; }
#pragma unroll
    for (int i = 0; i < 16; i += 2) { const int c = 16 * rh + i;
        *(LAS unsigned*)(buf + K2T_OFF + d * T_STR + c * 2) = (unsigned)k2[i] | ((unsigned)k2[i + 1] << 16);
        *(LAS unsigned*)(buf + VT_OFF + d * T_STR + c * 2) = (unsigned)r.v[i] | ((unsigned)r.v[i + 1] << 16); }
    if (rh == 0) *(LAS float*)(buf + DEC_OFF + d * 4) = dec;
}
#define SCAN_BAR() do { asm volatile("s_waitcnt lgkmcnt(0)" ::: "memory"); __builtin_amdgcn_s_barrier(); asm volatile("" ::: "memory"); } while (0)

__device__ __forceinline__ bf16x8 cvt8(const f32x16& x, int base) {
    u32x4 w; w.x = cvt_pk_bf16(x[base + 0], x[base + 1]); w.y = cvt_pk_bf16(x[base + 2], x[base + 3]); w.z = cvt_pk_bf16(x[base + 4], x[base + 5]); w.w = cvt_pk_bf16(x[base + 6], x[base + 7]);
    return *reinterpret_cast<bf16x8*>(&w);
}
__device__ __forceinline__ bf16x8 ld44(const LAS unsigned char* p) {
    const u32x2 a = *(const LAS u32x2*)p, b = *(const LAS u32x2*)(p + 16); u32x4 w = {a.x, a.y, b.x, b.y}; return *reinterpret_cast<bf16x8*>(&w);
}

__device__ __forceinline__ void scan_unit(unsigned char* ws, LAS unsigned char* lds, int unit, int wave, int lane, int tid) {
    static_assert(NCH % 2 == 0, "even chunk count");
    const int b = unit >> 4, hd = (unit >> 1) & 7, dir = unit & 1;
    const bf16_t* z = (const bf16_t*)(ws + WS_Z);
    bf16_t* od = (bf16_t*)(ws + WS_O) + (size_t)dir * T * DM;
    const float* lb = (const float*)(ws + WS_LB) + dir * 1024 + hd * 128;
    const int r32 = lane & 31, hi = lane >> 5;
    if (wave >= 4) {
        const int pw = wave - 4, d = 32 * pw + r32, rh = hi; const float lbv = lb[d];
        asm volatile("s_waitcnt vmcnt(0)" ::: "memory");
        LAS unsigned char* rawb = lds + RAW_OFF; Raw R;
        prep_dma(z, b, hd, dir, 0, rawb, pw, lane); prep_dma(z, b, hd, dir, 1, rawb + RAW_BYTES, pw, lane);
        asm volatile("s_waitcnt vmcnt(6)" ::: "memory"); SCAN_BAR();
        int st = 0;
        for (int n = -1; n < NCH - 1; ++n) {
            prep_read(R, rawb + st * RAW_BYTES, d, rh); prep_compute(R, lbv, lds + ((n + 1) & 1) * BUF_BYTES, d, rh, lane);
            const int st3 = (st == 0) ? 2 : st - 1;
            if (n + 3 < NCH) { prep_dma(z, b, hd, dir, n + 3, rawb + st3 * RAW_BYTES, pw, lane); asm volatile("s_waitcnt vmcnt(6)" ::: "memory"); }
            else asm volatile("s_waitcnt vmcnt(0)" ::: "memory");
            SCAN_BAR();
            st = (st == 2) ? 0 : st + 1;
        }
        SCAN_BAR();
    } else {
        const int sw = wave;
        f32x16 S[4];
#pragma unroll
        for (int t = 0; t < 4; ++t) S[t] = f32x16{};
        SCAN_BAR(); SCAN_BAR();
        for (int n = 0; n < NCH; ++n) {
            const LAS unsigned char* buf = lds + (n & 1) * BUF_BYTES;
            f32x16 X = f32x16{}, Xb = f32x16{};
#pragma unroll
            for (int ks = 0; ks < 8; ++ks) { const bf16x8 a = *(const LAS bf16x8*)(buf + A2_OFF + r32 * A_STR + (16 * ks + 8 * hi) * 2), bb = *(const LAS bf16x8*)(buf + A1_OFF + r32 * A_STR + (16 * ks + 8 * hi) * 2);
                if (ks & 1) Xb = __builtin_amdgcn_mfma_f32_32x32x16_bf16(a, bb, Xb, 0, 0, 0); else X = __builtin_amdgcn_mfma_f32_32x32x16_bf16(a, bb, X, 0, 0, 0); }
#pragma unroll
            for (int r = 0; r < 16; ++r) X[r] = (crow(r, hi) <= r32) ? X[r] + Xb[r] : 0.f;
            f32x16 O = f32x16{};
#pragma unroll
            for (int s0 = 0; s0 < 2; ++s0) { const bf16x8 a = cvt8(X, 8 * s0); const bf16x8 bb = ld44(buf + VT_OFF + (32 * sw + r32) * T_STR + (16 * s0 + 4 * hi) * 2);
                O = __builtin_amdgcn_mfma_f32_32x32x16_bf16(a, bb, O, 0, 0, 0); }
            f32x16 O2 = f32x16{}, O3 = f32x16{};
#pragma unroll
            for (int t = 0; t < 4; ++t)
#pragma unroll
                for (int s0 = 0; s0 < 2; ++s0) { const bf16x8 a = ld44(buf + A1_OFF + r32 * A_STR + (32 * t + 16 * s0 + 4 * hi) * 2); const bf16x8 bb = cvt8(S[t], 8 * s0);
                    if (t & 1) O3 = __builtin_amdgcn_mfma_f32_32x32x16_bf16(a, bb, O3, 0, 0, 0); else O2 = __builtin_amdgcn_mfma_f32_32x32x16_bf16(a, bb, O2, 0, 0, 0); }
#pragma unroll
            for (int r = 0; r < 16; ++r) O[r] += O2[r] + O3[r];
#pragma unroll
            for (int r = 0; r < 16; ++r) { const int p = 32 * n + crow(r, hi); od[(size_t)(b * TPB + tok_of(p, dir)) * DM + hd * 128 + 32 * sw + r32] = (bf16_t)f2bf(O[r]); }
#pragma unroll
            for (int t = 0; t < 4; ++t) {
#pragma unroll
                for (int g4 = 0; g4 < 4; ++g4) { const f32x4 dc = *(const LAS f32x4*)(buf + DEC_OFF + (32 * t + 8 * g4 + 4 * hi) * 4);
                    S[t][4 * g4 + 0] *= dc.x; S[t][4 * g4 + 1] *= dc.y; S[t][4 * g4 + 2] *= dc.z; S[t][4 * g4 + 3] *= dc.w; }
#pragma unroll
                for (int s0 = 0; s0 < 2; ++s0) { const bf16x8 a = *(const LAS bf16x8*)(buf + K2T_OFF + (32 * t + r32) * T_STR + (16 * s0 + 8 * hi) * 2), bb = *(const LAS bf16x8*)(buf + VT_OFF + (32 * sw + r32) * T_STR + (16 * s0 + 8 * hi) * 2);
                    S[t] = __builtin_amdgcn_mfma_f32_32x32x16_bf16(a, bb, S[t], 0, 0, 0); }
            }
            SCAN_BAR();
        }
    }
}
}

__device__ __forceinline__ void phase_a_readout(Frame& F) {
    const int lane = fresh_lane(), l32 = lane & 31, hh = lane >> 5;
    const int gw = F.vcu * NWAVES + F.wave, NGW = F.G * NWAVES;
    const bf16_t* of = (const bf16_t*)(F.ws + WS_O); const bf16_t* ob = of + (size_t)T * DM; const bf16_t* z = (const bf16_t*)(F.ws + WS_Z); bf16_t* xa = (bf16_t*)(F.ws + WS_XA);
    const f32x4 g = *(const f32x4*)(in_ptr(F, I_A_ONORM) + 4 * l32);
    for (int m = gw; m < T; m += NGW) {
        u32x2 a[4], bb[4], gt[4];
#pragma unroll
        for (int it = 0; it < 4; ++it) { const int c = (2 * it + hh) * 128 + 4 * l32;
            a[it] = *(const u32x2*)(of + (size_t)m * DM + c); bb[it] = *(const u32x2*)(ob + (size_t)m * DM + c); gt[it] = *(const u32x2*)(z + (size_t)m * A_IN + 4096 + c); }
#pragma unroll
        for (int it = 0; it < 4; ++it) { const int c = (2 * it + hh) * 128 + 4 * l32;
            const float o0 = bf2f(a[it].x & 0xffffu) + bf2f(bb[it].x & 0xffffu), o1 = bf2f(a[it].x >> 16) + bf2f(bb[it].x >> 16), o2 = bf2f(a[it].y & 0xffffu) + bf2f(bb[it].y & 0xffffu), o3 = bf2f(a[it].y >> 16) + bf2f(bb[it].y >> 16);
            const float rstd = rsqrtf(half_sum((o0 * o0 + o1 * o1) + (o2 * o2 + o3 * o3)) * (1.0f / 128.0f) + NORM_EPS);
            u32x2 w; w.x = pk2(o0 * rstd * g.x * silu_f(bf2f(gt[it].x & 0xffffu)), o1 * rstd * g.y * silu_f(bf2f(gt[it].x >> 16)));
            w.y = pk2(o2 * rstd * g.z * silu_f(bf2f(gt[it].y & 0xffffu)), o3 * rstd * g.w * silu_f(bf2f(gt[it].y >> 16)));
            *(u32x2*)(xa + (size_t)m * DM + c) = w; }
    }
}

__device__ __forceinline__ f32x2 rope_cs(const float* rt, int kind, int pos, int fi) { return *(const f32x2*)(rt + (((size_t)kind * 64 + pos) * 32 + fi) * 2); }

__device__ __forceinline__ void phase_b_row1(Frame& F) {
    const int lane = fresh_lane();
    const int gw = F.vcu * NWAVES + F.wave, NGW = F.G * NWAVES;
    const bf16_t* z = (const bf16_t*)(F.ws + WS_Z); bf16_t* cq = (bf16_t*)(F.ws + WS_O); bf16_t* ckv = cq + (size_t)T * 384; bf16_t* Kb = (bf16_t*)(F.ws + WS_K);
    const float* qg = in_ptr(F, I_B_QNORM); const float* kg = in_ptr(F, I_B_KVNORM); const float* rt = (const float*)(F.ws + WS_ROPE);
    const int ip = lane & 15, hg = lane >> 4;
    for (int m = gw; m < T; m += NGW) { const RowPos rp = row_pos(m); const bf16_t* zr = z + (size_t)m * B_INP;
        float q[6]; float sq = 0.f;
#pragma unroll
        for (int j = 0; j < 3; ++j) { const unsigned w = *(const unsigned*)(zr + 128 * j + 2 * lane); q[2 * j] = bf2f(w & 0xffffu); q[2 * j + 1] = bf2f(w >> 16); sq += q[2 * j] * q[2 * j] + q[2 * j + 1] * q[2 * j + 1]; }
        const u32x2 kw = *(const u32x2*)(zr + 384 + 4 * lane); const float k0 = bf2f(kw.x & 0xffffu), k1 = bf2f(kw.x >> 16), k2 = bf2f(kw.y & 0xffffu), k3 = bf2f(kw.y >> 16);
        const float skv = (k0 * k0 + k1 * k1) + (k2 * k2 + k3 * k3);
        const float rq = rsqrtf(wave_sum(sq) * (1.0f / 384.0f) + NORM_EPS), rkv = rsqrtf(wave_sum(skv) * (1.0f / 256.0f) + NORM_EPS);
#pragma unroll
        for (int j = 0; j < 3; ++j) { const f32x2 g = *(const f32x2*)(qg + 128 * j + 2 * lane); *(unsigned*)(cq + (size_t)m * 384 + 128 * j + 2 * lane) = pk2(q[2 * j] * rq * g.x, q[2 * j + 1] * rq * g.y); }
        { const f32x4 g = *(const f32x4*)(kg + 4 * lane); u32x2 w; w.x = pk2(k0 * rkv * g.x, k1 * rkv * g.y); w.y = pk2(k2 * rkv * g.z, k3 * rkv * g.w); *(u32x2*)(ckv + (size_t)m * 256 + 4 * lane) = w; }
        const unsigned rw = *(const unsigned*)(zr + 640 + 2 * ip); float x0 = bf2f(rw & 0xffffu), x1 = bf2f(rw >> 16);
        const float p0 = __shfl_xor(x0, 4), p1 = __shfl_xor(x1, 4);
        if (!rp.isctx) { const int pos = (ip < 8) ? rp.prow : rp.pcol; const f32x2 c0 = rope_cs(rt, 0, pos, (2 * ip) & 7), c1 = rope_cs(rt, 0, pos, (2 * ip + 1) & 7);
            if (ip & 4) { x0 = x0 * c0.x + p0 * c0.y; x1 = x1 * c1.x + p1 * c1.y; } else { x0 = x0 * c0.x - p0 * c0.y; x1 = x1 * c1.x - p1 * c1.y; } }
        const unsigned kb = pk2(x0, x1);
#pragma unroll
        for (int hh = 0; hh < 4; ++hh) { const int hd = 4 * hh + hg; *(unsigned*)(Kb + ((size_t)(rp.b * 16 + hd) * TPB + rp.p) * 96 + 64 + 2 * ip) = kb; }
    }
}
__device__ __forceinline__ void phase_b_row2(Frame& F) {
    const int lane = fresh_lane();
    const int gw = F.vcu * NWAVES + F.wave, NGW = F.G * NWAVES;
    bf16_t* Qb = (bf16_t*)(F.ws + WS_Q); const float* rt = (const float*)(F.ws + WS_ROPE);
    const int ip = lane & 15, hg = lane >> 4;
    for (int m = gw; m < T; m += NGW) { const RowPos rp = row_pos(m); if (rp.isctx) continue;
        const int pos = (ip < 8) ? rp.prow : rp.pcol; const f32x2 c0 = rope_cs(rt, 0, pos, (2 * ip) & 7), c1 = rope_cs(rt, 0, pos, (2 * ip + 1) & 7);
        unsigned w[4];
#pragma unroll
        for (int hh = 0; hh < 4; ++hh) w[hh] = *(const unsigned*)(Qb + (size_t)m * 1536 + (4 * hh + hg) * 96 + 64 + 2 * ip);
#pragma unroll
        for (int hh = 0; hh < 4; ++hh) { float x0 = bf2f(w[hh] & 0xffffu), x1 = bf2f(w[hh] >> 16); const float p0 = __shfl_xor(x0, 4), p1 = __shfl_xor(x1, 4);
            if (ip & 4) { x0 = x0 * c0.x + p0 * c0.y; x1 = x1 * c1.x + p1 * c1.y; } else { x0 = x0 * c0.x - p0 * c0.y; x1 = x1 * c1.x - p1 * c1.y; }
            *(unsigned*)(Qb + (size_t)m * 1536 + (4 * hh + hg) * 96 + 64 + 2 * ip) = pk2(x0, x1); }
    }
}
__device__ __forceinline__ void phase_c_row(Frame& F) {
    const int lane = fresh_lane();
    const int gw = F.vcu * NWAVES + F.wave, NGW = F.G * NWAVES;
    const bf16_t* z = (const bf16_t*)(F.ws + WS_Z); bf16_t* Qb = (bf16_t*)(F.ws + WS_Q); bf16_t* Kb = (bf16_t*)(F.ws + WS_K); bf16_t* Vb = (bf16_t*)(F.ws + WS_V);
    const float* qg = in_ptr(F, I_C_QNORM); const float* kg = in_ptr(F, I_C_KNORM); const float* rt = (const float*)(F.ws + WS_ROPE);
    const f32x2 qgv = *(const f32x2*)(qg + 2 * lane), kgv = *(const f32x2*)(kg + 2 * lane);
    const bool up = (lane & 16) != 0;
    for (int m = gw; m < T; m += NGW) { const RowPos rp = row_pos(m); const bf16_t* zr = z + (size_t)m * C_IN;
        f32x2 c0 = (f32x2){1.f, 0.f}, c1 = (f32x2){1.f, 0.f};
        if (!rp.isctx) { const int pos = (lane < 32) ? rp.prow : rp.pcol; c0 = rope_cs(rt, 2, pos, (2 * lane) & 31); c1 = rope_cs(rt, 2, pos, (2 * lane + 1) & 31); }
        unsigned w[10];
#pragma unroll
        for (int hv = 0; hv < 10; ++hv) w[hv] = *(const unsigned*)(zr + hv * 128 + 2 * lane);
#pragma unroll
        for (int hv = 0; hv < 10; ++hv) { float a = bf2f(w[hv] & 0xffffu), bq = bf2f(w[hv] >> 16);
            const float rstd = rsqrtf(wave_sum(a * a + bq * bq) * (1.0f / 128.0f) + NORM_EPS);
            a *= rstd * (hv < 8 ? qgv.x : kgv.x); bq *= rstd * (hv < 8 ? qgv.y : kgv.y);
            const float ap = __shfl_xor(a, 16), bp = __shfl_xor(bq, 16);
            const float ar = up ? (a * c0.x + ap * c0.y) : (a * c0.x - ap * c0.y), br = up ? (bq * c1.x + bp * c1.y) : (bq * c1.x - bp * c1.y);
            bf16_t* dst = (hv < 8) ? Qb + (size_t)m * 1024 + hv * 128 : Kb + (size_t)m * 256 + (hv - 8) * 128;
            *(unsigned*)(dst + 2 * lane) = pk2(ar, br); }
        *(u32x2*)(Vb + (size_t)m * 256 + 4 * lane) = *(const u32x2*)(zr + 1280 + 4 * lane);
    }
}
__device__ __forceinline__ void phase_d_row1(Frame& F) {
    const int lane = fresh_lane();
    const int gw = F.vcu * NWAVES + F.wave, NGW = F.G * NWAVES;
    const bf16_t* z = (const bf16_t*)(F.ws + WS_Z); bf16_t* Qb = (bf16_t*)(F.ws + WS_Q); bf16_t* Kb = (bf16_t*)(F.ws + WS_K); bf16_t* Vb = (bf16_t*)(F.ws + WS_V);
    const float* rt = (const float*)(F.ws + WS_ROPE);
    const int lp = lane & 31; const bool up = (lane & 8) != 0;
    for (int m = gw; m < T; m += NGW) { const RowPos rp = row_pos(m); const bf16_t* zr = z + (size_t)m * D_IN;
        f32x2 c0 = (f32x2){1.f, 0.f}, c1 = (f32x2){1.f, 0.f};
        if (!rp.isctx) { const int pos = (lp < 16) ? rp.prow : rp.pcol; c0 = rope_cs(rt, 1, pos, (2 * lp) & 15); c1 = rope_cs(rt, 1, pos, (2 * lp + 1) & 15); }
        unsigned w[16];
#pragma unroll
        for (int i = 0; i < 16; ++i) w[i] = *(const unsigned*)(zr + 128 * i + 2 * lane);
#pragma unroll
        for (int i = 0; i < 16; ++i) { const float a = bf2f(w[i] & 0xffffu), bq = bf2f(w[i] >> 16); const float ap = __shfl_xor(a, 8), bp = __shfl_xor(bq, 8);
            const float ar = up ? (a * c0.x + ap * c0.y) : (a * c0.x - ap * c0.y), br = up ? (bq * c1.x + bp * c1.y) : (bq * c1.x - bp * c1.y);
            bf16_t* dst = (i < 8) ? Qb + (size_t)m * 1024 + 128 * i : Kb + (size_t)m * 1024 + 128 * (i - 8); *(unsigned*)(dst + 2 * lane) = pk2(ar, br); }
        { const u32x4 a = *(const u32x4*)(zr + 2048 + 16 * lane), bq = *(const u32x4*)(zr + 2048 + 16 * lane + 8); *(u32x4*)(Vb + (size_t)m * 1024 + 16 * lane) = a; *(u32x4*)(Vb + (size_t)m * 1024 + 16 * lane + 8) = bq; }
    }
}
__device__ __forceinline__ void phase_d_row2(Frame& F) {
    const int lane = fresh_lane(), l32 = lane & 31, hh = lane >> 5;
    const int gw = F.vcu * NWAVES + F.wave, NGW = F.G * NWAVES;
    const bf16_t* A = (const bf16_t*)(F.ws + WS_O); bf16_t* xa = (bf16_t*)(F.ws + WS_XA);
    const float* lam = in_ptr(F, I_D_LAMBDA);
    const float lambda_init = 0.8f - 0.6f * 0.40656965974059917f;
    const float s1 = wave_sum(lam[lane] * lam[64 + lane]), s2 = wave_sum(lam[128 + lane] * lam[192 + lane]);
    const float lam_full = expf(s1) - expf(s2) + lambda_init;
    const f32x4 g = *(const f32x4*)(in_ptr(F, I_D_ONORM) + 4 * l32) * (1.0f - lambda_init);
    for (int m = gw; m < T; m += NGW) { if ((m % TPB) < CTXL) continue;
        u32x2 a[4], bb[4];
#pragma unroll
        for (int it = 0; it < 4; ++it) { const int hd = 2 * it + hh; a[it] = *(const u32x2*)(A + (size_t)m * 2048 + (2 * hd) * 128 + 4 * l32); bb[it] = *(const u32x2*)(A + (size_t)m * 2048 + (2 * hd + 1) * 128 + 4 * l32); }
#pragma unroll
        for (int it = 0; it < 4; ++it) { const int hd = 2 * it + hh;
            const float o0 = bf2f(a[it].x & 0xffffu) - lam_full * bf2f(bb[it].x & 0xffffu), o1 = bf2f(a[it].x >> 16) - lam_full * bf2f(bb[it].x >> 16);
            const float o2 = bf2f(a[it].y & 0xffffu) - lam_full * bf2f(bb[it].y & 0xffffu), o3 = bf2f(a[it].y >> 16) - lam_full * bf2f(bb[it].y >> 16);
            const float rstd = rsqrtf(half_sum((o0 * o0 + o1 * o1) + (o2 * o2 + o3 * o3)) * (1.0f / 128.0f) + NORM_EPS);
            u32x2 w; w.x = pk2(o0 * rstd * g.x, o1 * rstd * g.y); w.y = pk2(o2 * rstd * g.z, o3 * rstd * g.w);
            *(u32x2*)(xa + (size_t)m * DM + hd * 128 + 4 * l32) = w; }
    }
}

#ifndef MK_STAG
#define MK_STAG 1
#endif
#define MK_SPLITKV 0
#define MK_PRE_B 1
#define MK_PRE_C 1
#define MK_PRE_D 1
#define MK_PRE(DK) (MK_STAG && ((DK) == 96 ? MK_PRE_B : (DK) == 128 ? MK_PRE_C : MK_PRE_D))
template <int DK, int DV, int ldq, int ldk, int ldv, int ldo, int H, int GK, int GV>
__device__ __forceinline__ void attn_phase(Frame& F, const bf16_t* Q, const bf16_t* K, const bf16_t* V, bf16_t* O, float scale, bool skip_ctx, int dup = 1) {
    const float C = scale * 1.4426950408889634f, thr_raw = att::THR / scale;
    const int NHV = NBATCH * H * 16, NCTX = skip_ctx ? 0 : NBATCH * H;
    const int LO = NHV % F.G, NFULL = NHV - LO; int SF = 1;
    if (MK_SPLITKV && dup == 1 && LO > 0 && F.G % LO == 0) { const int q = F.G / LO; if (q == 2 || q == 4) SF = q; }
    const int NPART = (SF > 1) ? LO * SF : 0, NLAT = (SF > 1) ? NFULL : NHV, NTOT = NLAT + NPART + NCTX;
    float* PO = (float*)(F.ws + WS_YS); float* PML = PO + (size_t)256 * 256 * 128;
    for (int L0 = F.vcu; L0 < NTOT * dup; L0 += F.G) { const int L = (dup > 1) ? L0 % NTOT : L0;
        int b, hd, qb, part = -1, U = L;
        if (L >= NLAT && L < NLAT + NPART) { const int j = L - NLAT; U = NFULL + j / SF; part = j % SF; }
        if (L < NLAT + NPART) { const int grp = U >> 4; b = grp / H; hd = grp % H; qb = 1 + (U & 15); } else { const int L2 = L - NLAT - NPART; b = L2 / H; hd = L2 % H; qb = 0; }
        const size_t row0 = (size_t)b * TPB + (size_t)qb * 256; const bf16_t* Kh = K + (size_t)(b * (H / GK) + hd / GK) * TPB * DK; const bf16_t* Vh = V + (size_t)(b * (H / GV) + hd / GV) * TPB * DV;
        if (part >= 0) { const int klen = TPB / SF, j = L - NLAT;
            att::attn_unit_stag<DK, DV, ldq, DK, DV, ldo, MK_PRE(DK) != 0, false, true>(Q + row0 * ldq + hd * DK, Kh + (size_t)part * klen * DK, Vh + (size_t)part * klen * DV, nullptr,
                               klen, C, thr_raw, (char*)F.lds, F.wave, PO + (size_t)j * 256 * DV, PML + (size_t)j * 256 * 2); }
        else
        att::attn_unit_stag<DK, DV, ldq, DK, DV, ldo, MK_PRE(DK) != 0, false>(Q + row0 * ldq + hd * DK, Kh, Vh, O + row0 * ldo + hd * DV,
                               qb == 0 ? CTXL : TPB, C, thr_raw, (char*)F.lds, F.wave);
    }
    __syncthreads();
}
template <int DV, int ldo, int H>
__device__ __forceinline__ void attn_merge(Frame& F, bf16_t* O) {
    const int NHV = NBATCH * H * 16, LO = NHV % F.G, NFULL = NHV - LO; int SF = 1;
    if (LO > 0 && F.G % LO == 0) { const int q = F.G / LO; if (q == 2 || q == 4) SF = q; }
    if (SF == 1) return;
    const float* PO = (const float*)(F.ws + WS_YS); const float* PML = PO + (size_t)256 * 256 * 128;
    const int lane = fresh_lane(), gw = F.vcu * NWAVES + F.wave, NGW = F.G * NWAVES;
    for (int it = gw; it < LO * 256; it += NGW) { const int u = it >> 8, r = it & 255, U = NFULL + u;
        const int grp = U >> 4, b = grp / H, hd = grp % H, qb = 1 + (U & 15);
        float mi[4], li[4], m = -3.0e38f;
#pragma unroll
        for (int i = 0; i < 4; ++i) { if (i < SF) { const f32x2 ml = *(const f32x2*)(PML + ((size_t)(u * SF + i) * 256 + r) * 2); mi[i] = ml.x; li[i] = ml.y; m = fmaxf(m, ml.x); } else { mi[i] = 0.f; li[i] = 0.f; } }
        float l = 0.f, w[4];
#pragma unroll
        for (int i = 0; i < 4; ++i) { w[i] = (i < SF) ? __builtin_amdgcn_exp2f(mi[i] - m) : 0.f; l += w[i] * li[i]; }
        const float rl = 1.0f / l;
        bf16_t* orow = O + ((size_t)b * TPB + (size_t)qb * 256 + r) * ldo + hd * DV;
#pragma unroll
        for (int c0 = 0; c0 < DV; c0 += 64) { float acc = 0.f;
#pragma unroll
            for (int i = 0; i < 4; ++i) if (i < SF) acc += w[i] * PO[((size_t)(u * SF + i) * 256 + r) * DV + c0 + lane];
            orow[c0 + lane] = (bf16_t)f2bf(acc * rl); } }
}
#ifndef MK_MULTI
#define MK_MULTI 0
#endif
constexpr int NPHASE = 37;
#ifndef MK_REP_MASK
#define MK_REP_MASK 0ull
#endif
#ifndef MK_REP_N
#define MK_REP_N 1
#endif
#ifndef MK_DUP
#define MK_DUP -1
#endif
#define DUPF(k) ((k) == MK_DUP ? 2 : 1)
#ifndef MK_LIMIT
#define MK_LIMIT 37
#endif
struct Args { const float* in[N_IN]; float* out; unsigned char* ws; int ph_lo, ph_hi; };

__device__ __forceinline__ void gemm_plain_f32(Frame& F, const bf16_t* A, const bf16_t* Bt, int N, int K, float* C, int ldc, int dup = 1) {
    pg8::Gemm g{A, Bt, K / 64, N, K, 0, nullptr, 0, nullptr}; pg8::StaticOrder S; S.init(T / 256, N / 256, F.G, (int)blockIdx.x, dup); pg8::EpiF32 E{C, ldc};
    pg8::gemm_phase<pg8::EpiF32, pg8::StaticOrder, false>(F.lds, g, S, E, F.wave);
}
__device__ __forceinline__ void gemm_plain_bf16(Frame& F, const bf16_t* A, const bf16_t* Bt, int N, int K, bf16_t* C, int ldc, int dup = 1) {
    pg8::Gemm g{A, Bt, K / 64, N, K, 0, nullptr, 0, nullptr}; pg8::StaticOrder S; S.init(T / 256, N / 256, F.G, (int)blockIdx.x, dup); pg8::EpiBf16 E{C, ldc};
    pg8::gemm_phase<pg8::EpiBf16, pg8::StaticOrder, false>(F.lds, g, S, E, F.wave);
}
template <int S>
__device__ __forceinline__ void gemm_n1024(Frame& F, const bf16_t* A, const bf16_t* Bt, int K, bool skip_ctx, int dup = 1) {
    { pg8::Gemm g{A, Bt, K / 64, DM, K, 0, nullptr, 0, nullptr}; pg8::LatOrder S1; S1.so.init(128, DM / 256, F.G, (int)blockIdx.x, dup); pg8::EpiBf16 E{(bf16_t*)(F.ws + WS_Y), DM};
      pg8::gemm_phase<pg8::EpiBf16, pg8::LatOrder, false>(F.lds, g, S1, E, F.wave); }
    if (!skip_ctx) { pg8::Gemm g{A, Bt, K / 64 / S, DM, K, 0, nullptr, 0, nullptr}; pg8::CtxSplitOrder S2{DM / 256, S, K / 64 / S, F.G, (int)blockIdx.x, dup}; pg8::EpiF32 E{(float*)(F.ws + WS_YS), DM};
      pg8::gemm_phase<pg8::EpiF32, pg8::CtxSplitOrder, false>(F.lds, g, S2, E, F.wave); }
}
__device__ __forceinline__ void gemm_swiglu(Frame& F, const bf16_t* A, const bf16_t* Bt, bf16_t* C, int dup = 1) {
    pg8::Gemm g{A, Bt, DM / 128, 2 * FF, DM / 2, 0, nullptr, 0, nullptr}; pg8::StaticOrder S; S.init(T / 256, 2 * FF / 256, F.G, (int)blockIdx.x, dup); pg8::EpiSwiglu E{C, FF, 1.0f / 32.0f};
    pg8::gemm_phase<pg8::EpiSwiglu, pg8::StaticOrder, false, true>(F.lds, g, S, E, F.wave);
}
__device__ __forceinline__ void gemm_moe_gu(Frame& F, int lm, int dup = 1) {
    moe_tables(F, 2 * lm + 1);
    pg8::Gemm g{(const bf16_t*)(F.ws + WS_XA), (const bf16_t*)(F.ws + WS_MOE_GU + (size_t)lm * 8 * SZ_GU), DM / 128, 2 * FF, DM / 2, (size_t)2 * FF * DM / 2, (const int*)(F.ws + WS_LIST), T, (const LAS int*)(F.MISC + 32)};
    pg8::MoeOrder S; S.so.init((int)F.MISC[24], 2 * FF / 256, F.G, (int)blockIdx.x, dup); S.rb0 = (const LAS int*)(F.MISC + 16); pg8::EpiSwiglu E{(bf16_t*)(F.ws + WS_ACT), FF, 1.0f / 32.0f};
    pg8::gemm_phase<pg8::EpiSwiglu, pg8::MoeOrder, true, true>(F.lds, g, S, E, F.wave);
}
__device__ __forceinline__ void gemm_moe_down(Frame& F, int lm, int dup = 1) {
    moe_tables(F, 2 * lm + 1);
    int RBM, trb, S; pg8::moe_tail_params((int)F.MISC[24], RBM, trb, S);
    const bf16_t* A = (const bf16_t*)(F.ws + WS_ACT); const bf16_t* Bt = (const bf16_t*)(F.ws + WS_MOE_DN + (size_t)lm * 8 * SZ_DN);
    { pg8::Gemm g{A, Bt, FF / 64, DM, FF, (size_t)DM * FF, nullptr, 0, nullptr};
      pg8::MoeOrder S1; S1.so.init(RBM, DM / 256, F.G, (int)blockIdx.x, dup); S1.rb0 = (const LAS int*)(F.MISC + 16); pg8::EpiBf16 E{(bf16_t*)(F.ws + WS_YP), DM};
      pg8::gemm_phase<pg8::EpiBf16, pg8::MoeOrder, false>(F.lds, g, S1, E, F.wave); }
    if (trb > 0) { pg8::Gemm g{A, Bt, FF / 64 / S, DM, FF, (size_t)DM * FF, nullptr, 0, nullptr};
      pg8::MoeTailOrder S2{RBM, trb, S, FF / 64 / S, F.G, (int)blockIdx.x, dup, (const LAS int*)(F.MISC + 16)}; pg8::EpiF32 E{(float*)(F.ws + WS_YS), DM};
      pg8::gemm_phase<pg8::EpiF32, pg8::MoeTailOrder, false>(F.lds, g, S2, E, F.wave); }
}
__device__ __forceinline__ void xcd_or_nothing(const XcdBarrier& b, int wave) { if (!MK_MULTI) xcd_barrier(b, wave); }
__global__ void __launch_bounds__(NWAVES * 64, 2) fwd_kernel(Args args) {
    extern __shared__ __attribute__((aligned(16))) unsigned char lds_raw[];
    Frame F;
    F.lds = (LAS unsigned char*)lds_raw; F.MISC = (volatile LAS unsigned*)(F.lds + MISC_OFF);
    F.wave = __builtin_amdgcn_readfirstlane((int)threadIdx.x >> 6);
    F.G = gridDim.x; { const int bx = blockIdx.x; F.vcu = (F.G % 8 == 0) ? (bx % 8) * (F.G / 8) + bx / 8 : bx; }
    F.ws = args.ws;
    for (int u = threadIdx.x; u < 256; u += NWAVES * 64) ((LAS unsigned*)(F.lds + MISC_OFF))[u] = 0u;
    __syncthreads();
    XcdBarrier bar; bar.bar = (unsigned*)((unsigned*)F.ws + CW_BAR); bar.x = 0; bar.st = nullptr;
    if (!MK_MULTI) bar = xcd_barrier_post((unsigned*)((unsigned*)F.ws + CW_BAR), F.MISC + 0);
    const int lo = args.ph_lo, hi = args.ph_hi;
#define IN(k) (lo <= (k) && (k) < hi)
#define NREP(k) ((((unsigned long long)(MK_REP_MASK) >> (k)) & 1ull) ? (1 + MK_REP_N) : 1)
#define SEAM(k) do { if (!MK_MULTI && IN((k) + 1)) xcd_barrier(bar, F.wave); } while (0)
    unsigned char* ws = F.ws;
    bf16_t* XA = (bf16_t*)(ws + WS_XA); bf16_t* Y = (bf16_t*)(ws + WS_Y); bf16_t* ACT = (bf16_t*)(ws + WS_ACT);
    bf16_t* Qb = (bf16_t*)(ws + WS_Q); bf16_t* Kb = (bf16_t*)(ws + WS_K); bf16_t* Vb = (bf16_t*)(ws + WS_V); bf16_t* Ob = (bf16_t*)(ws + WS_O);

    if (IN(0)) { for (int rep = 0; rep < NREP(0); ++rep) { p0_prologue(F); if (rep + 1 < NREP(0)) xcd_or_nothing(bar, F.wave); } SEAM(0); }
    if (IN(1)) { for (int rep = 0; rep < NREP(1); ++rep) { for (int d2 = 0; d2 < DUPF(1); ++d2) { phase_r0(F); } if (rep + 1 < NREP(1)) xcd_or_nothing(bar, F.wave); } SEAM(1); }
    if (IN(2)) { for (int rep = 0; rep < NREP(2); ++rep) { gemm_plain_bf16(F, XA, (const bf16_t*)(ws + WS_WA_IN), A_IN, DM, (bf16_t*)(ws + WS_Z), A_IN, DUPF(2)); if (rep + 1 < NREP(2)) xcd_or_nothing(bar, F.wave); } SEAM(2); }
    if (IN(3)) { for (int rep = 0; rep < NREP(3); ++rep) { if ((int)blockIdx.x < NBATCH * 8 * 2) { for (int d2 = 0; d2 < DUPF(3); ++d2) { const int ln = fresh_lane(); scan::scan_unit(ws, F.lds, (int)blockIdx.x, F.wave, ln, F.wave * 64 + ln); __syncthreads(); } }
        else if (rep == 0) { const int nidle = F.G - NBATCH * 8 * 2; p0_convert(F, p0_split_item(), g_mats.item0[NMAT], ((int)blockIdx.x - NBATCH * 8 * 2) * NWAVES + F.wave, nidle * NWAVES, fresh_lane()); } if (rep + 1 < NREP(3)) xcd_or_nothing(bar, F.wave); } SEAM(3); }
    if (IN(4)) { for (int rep = 0; rep < NREP(4); ++rep) { for (int d2 = 0; d2 < DUPF(4); ++d2) { phase_a_readout(F); } if (rep + 1 < NREP(4)) xcd_or_nothing(bar, F.wave); } SEAM(4); }
    if (IN(5)) { for (int rep = 0; rep < NREP(5); ++rep) { gemm_n1024<8>(F, XA, (const bf16_t*)(ws + WS_WA_OUT), DM, false, DUPF(5)); if (rep + 1 < NREP(5)) xcd_or_nothing(bar, F.wave); } SEAM(5); }
    if (IN(6)) { for (int rep = 0; rep < NREP(6); ++rep) { phase_r1<false>(F, 0); if (rep + 1 < NREP(6)) xcd_or_nothing(bar, F.wave); } SEAM(6); }
    if (IN(7)) { for (int rep = 0; rep < NREP(7); ++rep) { gemm_swiglu(F, XA, (const bf16_t*)(ws + WS_FFN_GU), ACT, DUPF(7)); if (rep + 1 < NREP(7)) xcd_or_nothing(bar, F.wave); } SEAM(7); }
    if (IN(8)) { for (int rep = 0; rep < NREP(8); ++rep) { gemm_n1024<4>(F, ACT, (const bf16_t*)(ws + WS_FFN_DN), FF, false, DUPF(8)); if (rep + 1 < NREP(8)) xcd_or_nothing(bar, F.wave); } SEAM(8); }
    if (IN(9)) { for (int rep = 0; rep < NREP(9); ++rep) { phase_r2<false>(F, 0); if (rep + 1 < NREP(9)) xcd_or_nothing(bar, F.wave); } SEAM(9); }
    if (IN(10)) { for (int rep = 0; rep < NREP(10); ++rep) { gemm_plain_bf16(F, XA, (const bf16_t*)(ws + WS_WB_IN), B_INP, DM, (bf16_t*)(ws + WS_Z), B_INP, DUPF(10)); if (rep + 1 < NREP(10)) xcd_or_nothing(bar, F.wave); } SEAM(10); }
    if (IN(11)) { for (int rep = 0; rep < NREP(11); ++rep) { for (int d2 = 0; d2 < DUPF(11); ++d2) { phase_b_row1(F); } if (rep + 1 < NREP(11)) xcd_or_nothing(bar, F.wave); } SEAM(11); }
    if (IN(12)) {
        { pg8::Gemm g{Ob, (const bf16_t*)(ws + WS_WB_QB), 384 / 64, 1536, 384, 0, nullptr, 0, nullptr}; pg8::StaticOrder S; S.init(T / 256, 1536 / 256, F.G, (int)blockIdx.x); pg8::EpiRopeB E{Qb, (const float*)(ws + WS_ROPE), MK_PRE(96) ? 0.10206207261596575f * 1.4426950408889634f : 1.0f};
          pg8::gemm_phase<pg8::EpiRopeB, pg8::StaticOrder, false>(F.lds, g, S, E, F.wave); }
        { pg8::Gemm g{Ob + (size_t)T * 384, (const bf16_t*)(ws + WS_WB_KVB), 256 / 64, 2048, 256, 0, nullptr, 0, nullptr}; pg8::StaticOrder S; S.init(T / 256, 2048 / 256, F.G, (int)blockIdx.x); pg8::EpiKV E{Kb, 1536, Vb, 1024};
          pg8::gemm_phase<pg8::EpiKV, pg8::StaticOrder, false>(F.lds, g, S, E, F.wave); }
        SEAM(12); }
    if (IN(13)) { for (int rep = 0; rep < NREP(13); ++rep) { attn_phase<96, 64, 1536, 1536, 1024, DM, 16, 1, 1>(F, Qb, Kb, Vb, XA, 0.10206207261596575f, false, DUPF(13)); if (rep + 1 < NREP(13)) xcd_or_nothing(bar, F.wave); } SEAM(13); }
    if (IN(14)) { for (int rep = 0; rep < NREP(14); ++rep) { gemm_n1024<8>(F, XA, (const bf16_t*)(ws + WS_WB_OUT), DM, false, DUPF(14)); if (rep + 1 < NREP(14)) xcd_or_nothing(bar, F.wave); } SEAM(14); }
    if (IN(15)) { for (int rep = 0; rep < NREP(15); ++rep) { phase_r1<true>(F, 1); if (rep + 1 < NREP(15)) xcd_or_nothing(bar, F.wave); } SEAM(15); }
    if (IN(16)) { moe_build(F); SEAM(16); }
    if (IN(17)) { for (int rep = 0; rep < NREP(17); ++rep) { gemm_moe_gu(F, 0, DUPF(17)); if (rep + 1 < NREP(17)) xcd_or_nothing(bar, F.wave); } SEAM(17); }
    if (IN(18)) { for (int rep = 0; rep < NREP(18); ++rep) { gemm_moe_down(F, 0, DUPF(18)); if (rep + 1 < NREP(18)) xcd_or_nothing(bar, F.wave); } SEAM(18); }
    if (IN(19)) { for (int rep = 0; rep < NREP(19); ++rep) { moe_tables(F, 1); phase_r2<true>(F, 1); if (rep + 1 < NREP(19)) xcd_or_nothing(bar, F.wave); } SEAM(19); }
    if (IN(20)) { { pg8::Gemm g{XA, (const bf16_t*)(ws + WS_WC_IN), DM / 64, C_IN, DM, 0, nullptr, 0, nullptr}; pg8::StaticOrder S; S.init(T / 256, C_IN / 256, F.G, (int)blockIdx.x, DUPF(20));
          pg8::EpiNormRopeC E{Qb, Kb, Vb, in_ptr(F, I_C_QNORM), in_ptr(F, I_C_KNORM), (const float*)(ws + WS_ROPE) + (size_t)2 * 64 * 32 * 2, (LAS float*)(F.lds + pg8::STAGE_BYTES + 2048), MK_PRE(128) ? 0.08838834764831845f * 1.4426950408889634f : 1.0f};
          pg8::gemm_phase<pg8::EpiNormRopeC, pg8::StaticOrder, false>(F.lds, g, S, E, F.wave); } }
    if (IN(21)) { SEAM(21); }
    if (IN(22)) { for (int rep = 0; rep < NREP(22); ++rep) { attn_phase<128, 128, 1024, 256, 256, DM, 8, 4, 4>(F, Qb, Kb, Vb, XA, 0.08838834764831845f, false, DUPF(22)); if (rep + 1 < NREP(22)) xcd_or_nothing(bar, F.wave); } SEAM(22); }
    if (IN(23)) { for (int rep = 0; rep < NREP(23); ++rep) { gemm_n1024<8>(F, XA, (const bf16_t*)(ws + WS_WC_OUT), DM, false, DUPF(23)); if (rep + 1 < NREP(23)) xcd_or_nothing(bar, F.wave); } SEAM(23); }
    if (IN(24)) { for (int rep = 0; rep < NREP(24); ++rep) { phase_r1<false>(F, 2); if (rep + 1 < NREP(24)) xcd_or_nothing(bar, F.wave); } SEAM(24); }
    if (IN(25)) { for (int rep = 0; rep < NREP(25); ++rep) { gemm_swiglu(F, XA, (const bf16_t*)(ws + WS_FFN_GU + SZ_GU), ACT, DUPF(25)); if (rep + 1 < NREP(25)) xcd_or_nothing(bar, F.wave); } SEAM(25); }
    if (IN(26)) { for (int rep = 0; rep < NREP(26); ++rep) { gemm_n1024<4>(F, ACT, (const bf16_t*)(ws + WS_FFN_DN + SZ_DN), FF, false, DUPF(26)); if (rep + 1 < NREP(26)) xcd_or_nothing(bar, F.wave); } SEAM(26); }
    if (IN(27)) { for (int rep = 0; rep < NREP(27); ++rep) { phase_r2<false>(F, 2); if (rep + 1 < NREP(27)) xcd_or_nothing(bar, F.wave); } SEAM(27); }
    if (IN(28)) { { pg8::Gemm g{XA, (const bf16_t*)(ws + WS_WD_IN), DM / 64, D_IN, DM, 0, nullptr, 0, nullptr}; pg8::StaticOrder S; S.init(T / 256, D_IN / 256, F.G, (int)blockIdx.x, DUPF(28));
          pg8::EpiRopeD E{Qb, Kb, Vb, (const float*)(ws + WS_ROPE) + (size_t)1 * 64 * 32 * 2, MK_PRE(64) ? 0.125f * 1.4426950408889634f : 1.0f};
          pg8::gemm_phase<pg8::EpiRopeD, pg8::StaticOrder, false>(F.lds, g, S, E, F.wave); } SEAM(28); }
    if (IN(29)) { for (int rep = 0; rep < NREP(29); ++rep) { attn_phase<64, 128, 1024, 1024, 1024, 2048, 16, 1, 2>(F, Qb, Kb, Vb, Ob, 0.125f, true, DUPF(29)); if (rep + 1 < NREP(29)) xcd_or_nothing(bar, F.wave); } SEAM(29); }
    if (IN(30)) { for (int rep = 0; rep < NREP(30); ++rep) { for (int d2 = 0; d2 < DUPF(30); ++d2) { phase_d_row2(F); } if (rep + 1 < NREP(30)) xcd_or_nothing(bar, F.wave); } SEAM(30); }
    if (IN(31)) { for (int rep = 0; rep < NREP(31); ++rep) { gemm_n1024<8>(F, XA, (const bf16_t*)(ws + WS_WD_OUT), DM, true, DUPF(31)); if (rep + 1 < NREP(31)) xcd_or_nothing(bar, F.wave); } SEAM(31); }
    if (IN(32)) { for (int rep = 0; rep < NREP(32); ++rep) { phase_r1<true>(F, 3); if (rep + 1 < NREP(32)) xcd_or_nothing(bar, F.wave); } SEAM(32); }
    if (IN(33)) { moe_build(F); SEAM(33); }
    if (IN(34)) { for (int rep = 0; rep < NREP(34); ++rep) { gemm_moe_gu(F, 1, DUPF(34)); if (rep + 1 < NREP(34)) xcd_or_nothing(bar, F.wave); } SEAM(34); }
    if (IN(35)) { for (int rep = 0; rep < NREP(35); ++rep) { gemm_moe_down(F, 1, DUPF(35)); if (rep + 1 < NREP(35)) xcd_or_nothing(bar, F.wave); } SEAM(35); }
    if (IN(36)) { moe_tables(F, 3); phase_r2<true>(F, 3); }
#if MK_LIMIT < 37
    {
        xcd_barrier(bar, F.wave);
        float* outp = out_ptr(); const int tid = F.wave * 64 + fresh_lane();
#if MK_LIMIT == 34 || MK_LIMIT == 35 || MK_LIMIT == 36
        moe_tables(F, 3);
        int RBM, trb, S; pg8::moe_tail_params((int)F.MISC[24], RBM, trb, S);
#endif
        for (int r = (int)blockIdx.x; r < NBATCH * SEQ; r += F.G) { const int b = r / SEQ, l = r % SEQ; const size_t m = (size_t)b * TPB + CTXL + l;
#if MK_LIMIT == 34
            const int* route = (const int*)(ws + WS_ROUTE); const int* list = (const int*)(ws + WS_LIST);
            const int e1 = route[m * 8], s1 = route[m * 8 + 1], e2 = route[m * 8 + 2], s2 = route[m * 8 + 3];
            const unsigned char* xa8 = (const unsigned char*)(ws + WS_XA) + m * DM;
            for (int c = tid; c < DM; c += NWAVES * 64) { float v = 0.f;
                if (c >= 512) v = (float)((unsigned)xa8[2 * (c - 512)] + 256u * (unsigned)xa8[2 * (c - 512) + 1]); else
                if (c < 4) v = (float)route[m * 8 + c]; else if (c < 6) v = ((const float*)route)[m * 8 + c]; else if (c == 6) v = (float)(list[(size_t)e1 * T + s1] - (int)m); else if (c == 7) v = (float)(list[(size_t)e2 * T + s2] - (int)m);
                else if (c < 16) v = (float)F.MISC[16 + (c - 8)]; else if (c < 24) v = (float)F.MISC[32 + (c - 16)]; else if (c == 24) v = (float)F.MISC[24];
                outp[(size_t)r * DM + c] = v; }
#elif MK_LIMIT == 35
            const int* route = (const int*)(ws + WS_ROUTE); const bf16_t* act = (const bf16_t*)(ws + WS_ACT);
            const size_t r1 = (size_t)F.MISC[16 + route[m * 8]] * 256 + route[m * 8 + 1], r2 = (size_t)F.MISC[16 + route[m * 8 + 2]] * 256 + route[m * 8 + 3];
            for (int c = tid; c < DM; c += NWAVES * 64) { float v = 0.f;
                for (int q = 0; q < 4; ++q) { const int cc = c + q * DM; if (cc < FF) v += bf2f((unsigned)act[r1 * FF + cc]) + 2.0f * bf2f((unsigned)act[r2 * FF + cc]); }
                outp[(size_t)r * DM + c] = v; }
#elif MK_LIMIT == 36
            const int* route = (const int*)(ws + WS_ROUTE);
            const size_t r1 = (size_t)F.MISC[16 + route[m * 8]] * 256 + route[m * 8 + 1], r2 = (size_t)F.MISC[16 + route[m * 8 + 2]] * 256 + route[m * 8 + 3];
            for (int c = tid; c < DM; c += NWAVES * 64) { float v = 0.f;
                for (int k = 0; k < 2; ++k) { const size_t rr = k ? r2 : r1; const int rb = (int)(rr >> 8); float a = 0.f;
                    if (rb >= RBM) { const float* ys = (const float*)(ws + WS_YS) + ((size_t)(rb - RBM) * 256 + (rr & 255)) * DM; for (int s2 = 0; s2 < S; ++s2) a += ys[(size_t)s2 * trb * 256 * DM + c]; }
                    else a = bf2f((unsigned)((const bf16_t*)(ws + WS_YP))[rr * DM + c]);
                    v += (k ? 2.0f : 1.0f) * a; }
                outp[(size_t)r * DM + c] = v; }
#else
            const bf16_t* hh = (const bf16_t*)(ws + WS_H); const size_t src = m * DM;
            for (int c = tid; c < DM; c += NWAVES * 64) outp[(size_t)r * DM + c] = bf2f((unsigned)hh[src + c]);
#endif
        }
    }
#endif
#undef IN
#undef SEAM
}

extern "C" void kernel_launch(void* const* d_in, const int* in_sizes, int n_in, void* d_out, int out_size, void* d_ws, size_t ws_size, hipStream_t stream) {
    static int grid = 0;
    if (grid == 0) {
        if (n_in != N_IN || out_size != NBATCH * SEQ * DM || ws_size < WS_END) { fprintf(stderr, "kernel_launch: unexpected shapes: n_in %d out %d ws %zu (need %zu)\n", n_in, out_size, ws_size, (size_t)WS_END); grid = -1; return; }
        int dev = 0, cus = 0, per_cu = 0;
        if (hipGetDevice(&dev) != hipSuccess || hipDeviceGetAttribute(&cus, hipDeviceAttributeMultiprocessorCount, dev) != hipSuccess) { grid = -1; return; }
        if (hipFuncSetAttribute((const void*)fwd_kernel, hipFuncAttributeMaxDynamicSharedMemorySize, LDS_BYTES) != hipSuccess) { fprintf(stderr, "kernel_launch: hipFuncSetAttribute failed\n"); grid = -1; return; }
        if (hipOccupancyMaxActiveBlocksPerMultiprocessor(&per_cu, (const void*)fwd_kernel, NWAVES * 64, LDS_BYTES) != hipSuccess || per_cu < 1) fprintf(stderr, "kernel_launch: occupancy query reports %d\n", per_cu);
        (void)hipGetLastError();
        grid = cus;
    }
    if (grid < 0) return;
    (void)hipMemsetAsync((char*)d_ws + WS_CTL, 0, CTL_BYTES, stream);
    Args a{};
    for (int i = 0; i < N_IN; ++i) a.in[i] = (const float*)d_in[i];
    a.out = (float*)d_out; a.ws = (unsigned char*)d_ws;
#if MK_MULTI
    for (int p = 0; p < MK_LIMIT; ++p) { a.ph_lo = p; a.ph_hi = p + 1; hipLaunchKernelGGL(fwd_kernel, dim3(grid), dim3(NWAVES * 64), LDS_BYTES, stream, a); }
#else
    a.ph_lo = 0; a.ph_hi = MK_LIMIT; hipLaunchKernelGGL(fwd_kernel, dim3(grid), dim3(NWAVES * 64), LDS_BYTES, stream, a);
#endif
    const hipError_t le = hipPeekAtLastError();
    if (le != hipSuccess) fprintf(stderr, "kernel_launch: launch failed: %s\n", hipGetErrorName(le));
}
```

```cpp
#include <hip/hip_runtime.h>
#include <cstdio>
#include <cstdint>

#define GAS __attribute__((address_space(1)))
#define LAS __attribute__((address_space(3)))
typedef unsigned short bf16_t;
typedef short bf16x8 __attribute__((ext_vector_type(8)));
typedef short s16x4 __attribute__((ext_vector_type(4)));
typedef float f32x2 __attribute__((ext_vector_type(2)));
typedef float f32x4 __attribute__((ext_vector_type(4)));
typedef float f32x16 __attribute__((ext_vector_type(16)));
typedef unsigned u32x2 __attribute__((ext_vector_type(2)));
typedef unsigned u32x4 __attribute__((ext_vector_type(4)));

__device__ __forceinline__ float bf2f(unsigned b) { return __uint_as_float(b << 16); }
__device__ __forceinline__ unsigned f2bf(float f) { unsigned u = __float_as_uint(f); return (u + 0x7fffu + ((u >> 16) & 1u)) >> 16; }
__device__ __forceinline__ unsigned pk2(float lo, float hi) { return f2bf(lo) | (f2bf(hi) << 16); }
__device__ __forceinline__ unsigned cvt_pk_bf16(float lo, float hi) { unsigned r; asm volatile("v_cvt_pk_bf16_f32 %0, %1, %2" : "=v"(r) : "v"(lo), "v"(hi)); return r; }
typedef int v8i32 __attribute__((ext_vector_type(8)));
__device__ __forceinline__ unsigned pk4_fp8(float a, float b, float c, float d) { int w = 0; w = __builtin_amdgcn_cvt_pk_fp8_f32(a, b, w, false); w = __builtin_amdgcn_cvt_pk_fp8_f32(c, d, w, true); asm volatile("s_nop 1" : "+v"(w)); return (unsigned)w; }
__device__ __forceinline__ float wave_sum(float v) {
#pragma unroll
    for (int o = 1; o < 64; o <<= 1) v += __shfl_xor(v, o);
    return v;
}
__device__ __forceinline__ int fresh_lane() { int l; asm volatile("v_mbcnt_lo_u32_b32 %0, -1, 0\n\tv_mbcnt_hi_u32_b32 %0, -1, %0" : "=v"(l)); return l; }
__device__ __forceinline__ float fast_exp(float x) { return __builtin_amdgcn_exp2f(x * 1.4426950408889634f); }
__device__ __forceinline__ float fast_rcp(float x) { return __builtin_amdgcn_rcpf(x); }
__device__ __forceinline__ float silu_f(float x) { return x * fast_rcp(1.0f + fast_exp(-x)); }

#ifndef MK_WT
#define MK_WT 0
#endif
__device__ __forceinline__ void st16(void* p, u32x4 v) {
#if MK_WT
    asm volatile("global_store_dwordx4 %0, %1, off sc1\n\ts_nop 1" :: "v"(p), "v"(v) : "memory");
#else
    *(u32x4*)p = v;
#endif
}
__device__ __forceinline__ void st16f(void* p, f32x4 v) { st16(p, __builtin_bit_cast(u32x4, v)); }

namespace pg8 {
constexpr int BM = 256, BK = 64, HALF = 128, HTB = HALF * BK * 2, STAGE_BYTES = 8 * HTB, NXCD = 8, WGM = 8;
__host__ __device__ __forceinline__ int lds_byte(int r, int c) { const int st = (r >> 4) * 2 + (c >> 5), rr = r & 15, cc = c & 31, ob = rr * 64 + cc * 2; return st * 1024 + (ob ^ (((ob >> 9) & 1) << 5)); }
__host__ __device__ __forceinline__ void stage_rc(int b, int& R, int& C) { const int st = b / 1024, sb = b % 1024, swz = sb ^ (((sb >> 9) & 1) << 5); R = (st >> 1) * 16 + swz / 64; C = (st & 1) * 32 + (swz % 64) / 2; }
__host__ __device__ __forceinline__ int perm32(int rho) { const int n = rho >> 4, i = rho & 15; return 8 * (i >> 2) + 4 * n + (i & 3); }

struct Unit { int pm, pn, e, pl, po, kt0; };
struct Gemm { const bf16_t* A; const bf16_t* Bt; int nt  , N, K  ; size_t bstride; const int* list; int list_stride; const LAS int* cnt; };

struct StaticOrder {
    int nM, nN, nwg, G, c, dup;
    __device__ __forceinline__ void init(int nM_, int nN_, int G_, int c_, int dup_ = 1) { nM = nM_; nN = nN_; nwg = nM * nN; G = G_; c = c_; dup = dup_; }
    __device__ __forceinline__ bool next(int i, Unit& u) const {
        const long L = (long)i * G + c; if (L >= (long)nwg * dup) return false;
        int wgid = (int)L; if (dup > 1) wgid = (int)((unsigned)wgid % (unsigned)nwg); { const int q = nwg / NXCD, r = nwg % NXCD, xcd = wgid % NXCD, off = wgid / NXCD; wgid = (xcd < r ? xcd * (q + 1) : r * (q + 1) + (xcd - r) * q) + off; }
        const int nig = WGM * nN, gid = wgid / nig, fm = gid * WGM, gsz = (nM - fm) < WGM ? (nM - fm) : WGM;
        u.pm = fm + ((wgid % nig) % gsz); u.pn = (wgid % nig) / gsz; u.e = 0; u.pl = 0; u.po = u.pm; u.kt0 = 0; return true;
    }
};
struct MoeOrder {
    StaticOrder so; const LAS int* rb0;
    __device__ __forceinline__ bool next(int i, Unit& u) const {
        if (!so.next(i, u)) return false;
        int e = 0;
#pragma unroll
        for (int j = 1; j < 8; ++j) e = (u.pm >= rb0[j]) ? j : e;
        u.e = e; u.pl = u.pm - rb0[e]; u.po = u.pm; u.kt0 = 0; return true;
    }
};

__device__ __forceinline__ void moe_tail_params(int NRB, int& RBM, int& trb, int& S) { RBM = (NRB >> 6) << 6; trb = NRB - RBM; S = trb <= 4 ? 14 : trb <= 9 ? 7 : trb <= 16 ? 4 : trb <= 32 ? 2 : 1; }
struct MoeTailOrder {
    int RBM, trb, S, ntsub, G, c0, dup; const LAS int* rb0;
    __device__ __forceinline__ bool next(int i, Unit& u) const { int L = i * G + c0; const int n = trb * 4 * S; if (L >= n * dup) return false; if (dup > 1) L %= n;
        const int s = L % S, r = L / S; u.pn = r & 3; const int tb = r >> 2; u.pm = RBM + tb; u.po = s * trb + tb; u.kt0 = s * ntsub; u.pl = 0;
        int e = 0;
#pragma unroll
        for (int j = 1; j < 8; ++j) e = (u.pm >= rb0[j]) ? j : e;
        u.e = e; return true; }
};
struct LatOrder {
    StaticOrder so;
    __device__ __forceinline__ bool next(int i, Unit& u) const { if (!so.next(i, u)) return false; u.pm = (u.pm >> 4) * 17 + 1 + (u.pm & 15); u.po = u.pm; return true; }
};
struct CtxSplitOrder {
    int nN, S, ntsub, G, c0, dup;
    __device__ __forceinline__ bool next(int i, Unit& u) const { int L = i * G + c0; if (L >= 8 * nN * S * dup) return false; if (dup > 1) L %= 8 * nN * S;
        const int s = L % S, r = L / S; u.pn = r % nN; const int c = r / nN; u.pm = 17 * c; u.po = s * 8 + c; u.kt0 = s * ntsub; u.e = 0; u.pl = 0; return true; }
};

struct EpiF32 {
    static constexpr bool PERM = false;
    float* C; int ldc;
    __device__ __forceinline__ void operator()(const f32x4 (&acc)[2][2][4][2], const Unit& u, int wr, int wc, int fr, int fq) const {
        const int row0 = u.po * BM + wr * 64 + fr, col0 = u.pn * BM + wc * 32 + 4 * fq;
#pragma unroll
        for (int ai = 0; ai < 2; ++ai)
#pragma unroll
            for (int m = 0; m < 4; ++m) { float* rowp = C + (size_t)(row0 + ai * HALF + m * 16) * ldc + col0;
#pragma unroll
                for (int bj = 0; bj < 2; ++bj)
#pragma unroll
                    for (int n = 0; n < 2; ++n) st16f(rowp + bj * HALF + n * 16, acc[ai][bj][m][n]); }
    }
};
struct EpiBf16 {
    static constexpr bool PERM = true;
    bf16_t* O; int ldc;
    __device__ __forceinline__ void operator()(const f32x4 (&acc)[2][2][4][2], const Unit& u, int wr, int wc, int fr, int fq) const {
        const int row0 = u.po * BM + wr * 64 + fr, col0 = u.pn * BM + wc * 32 + 8 * fq;
#pragma unroll
        for (int ai = 0; ai < 2; ++ai)
#pragma unroll
            for (int m = 0; m < 4; ++m) { bf16_t* rowp = O + (size_t)(row0 + ai * HALF + m * 16) * ldc + col0;
#pragma unroll
                for (int bj = 0; bj < 2; ++bj) { const f32x4 v0 = acc[ai][bj][m][0], v1 = acc[ai][bj][m][1];
                    u32x4 w; w.x = cvt_pk_bf16(v0[0], v0[1]); w.y = cvt_pk_bf16(v0[2], v0[3]); w.z = cvt_pk_bf16(v1[0], v1[1]); w.w = cvt_pk_bf16(v1[2], v1[3]);
                    st16(rowp + bj * HALF, w); } }
    }
};
struct EpiSwiglu {
    static constexpr bool PERM = true;
    bf16_t* O; int ldc; float sc;
    __device__ __forceinline__ void operator()(const f32x4 (&acc)[2][2][4][2], const Unit& u, int wr, int wc, int fr, int fq) const {
        const int row0 = u.po * BM + wr * 64 + fr, col0 = u.pn * HALF + wc * 32 + 8 * fq;
        const float k1 = -1.4426950408889634f * sc, c2 = 1.0f / (sc * sc);
#pragma unroll
        for (int ai = 0; ai < 2; ++ai)
#pragma unroll
            for (int m = 0; m < 4; ++m) { bf16_t* rowp = O + (size_t)(row0 + ai * HALF + m * 16) * ldc + col0;
                float r[8];
#pragma unroll
                for (int n = 0; n < 2; ++n)
#pragma unroll
                    for (int j = 0; j < 4; ++j) { const float ag = acc[ai][0][m][n][j], au = acc[ai][1][m][n][j];
                        const float e = __builtin_amdgcn_exp2f(ag * k1); r[n * 4 + j] = (ag * au) * __builtin_amdgcn_rcpf(fmaf(e, c2, c2)); }
                u32x4 w; w.x = cvt_pk_bf16(r[0], r[1]); w.y = cvt_pk_bf16(r[2], r[3]); w.z = cvt_pk_bf16(r[4], r[5]); w.w = cvt_pk_bf16(r[6], r[7]);
                st16(rowp, w); }
    }
};
constexpr int HM_TPB = 4352;
struct EpiKV {
    static constexpr bool PERM = true;
    bf16_t* Kp; int ldk; bf16_t* Vp; int ldv;
    __device__ __forceinline__ void operator()(const f32x4 (&acc)[2][2][4][2], const Unit& u, int wr, int wc, int fr, int fq) const {
        const int row0 = u.po * BM + wr * 64 + fr, within = wc * 32 + 8 * fq, bb = u.po / 17;
#pragma unroll
        for (int ai = 0; ai < 2; ++ai)
#pragma unroll
            for (int m = 0; m < 4; ++m) { const size_t row = (size_t)(row0 + ai * HALF + m * 16);
#pragma unroll
                for (int bj = 0; bj < 2; ++bj) { const int head = u.pn * 2 + bj; const f32x4 v0 = acc[ai][bj][m][0], v1 = acc[ai][bj][m][1];
                    u32x4 w; w.x = cvt_pk_bf16(v0[0], v0[1]); w.y = cvt_pk_bf16(v0[2], v0[3]); w.z = cvt_pk_bf16(v1[0], v1[1]); w.w = cvt_pk_bf16(v1[2], v1[3]);
                    const size_t hrow = (size_t)(bb * 16 + head) * HM_TPB + (row - (size_t)bb * HM_TPB);
                    bf16_t* dst = (within < 64) ? (Kp + hrow * 96 + within) : (Vp + hrow * 64 + (within - 64));
                    st16(dst, w); } }
    }
};

struct EpiRopeD {
    static constexpr bool PERM = true;
    bf16_t* Qp; bf16_t* Kp; bf16_t* Vp; const float* rt; float qs;
    __device__ __forceinline__ void operator()(const f32x4 (&acc)[2][2][4][2], const Unit& u, int wr, int wc, int fr, int fq) const {
        const int row0 = u.po * BM + wr * 64 + fr, cw = wc * 32 + 8 * fq, bb = u.po / 17;
        if (u.pn >= 8) {
#pragma unroll
            for (int ai = 0; ai < 2; ++ai)
#pragma unroll
                for (int m = 0; m < 4; ++m) { const size_t prow = (size_t)(row0 + ai * HALF + m * 16) - (size_t)bb * HM_TPB;
#pragma unroll
                    for (int bj = 0; bj < 2; ++bj) { const f32x4 v0 = acc[ai][bj][m][0], v1 = acc[ai][bj][m][1];
                        u32x4 w; w.x = cvt_pk_bf16(v0[0], v0[1]); w.y = cvt_pk_bf16(v0[2], v0[3]); w.z = cvt_pk_bf16(v1[0], v1[1]); w.w = cvt_pk_bf16(v1[2], v1[3]);
                        const int vh = (u.pn - 8) * 2 + bj;
                        st16(Vp + ((size_t)(bb * 8 + vh) * HM_TPB + prow) * 128 + cw, w); } }
            return; }
        const bool isq = u.pn < 4; const float osc = isq ? qs : 1.0f;
        const int tb = u.pm % 17; const bool isctx = (tb == 0), colpart = (wc & 1) != 0, x2 = (fq & 2) != 0;
        const int f0 = 8 * (fq & 1);
#pragma unroll
        for (int ai = 0; ai < 2; ++ai)
#pragma unroll
            for (int m = 0; m < 4; ++m) {
                const int pos = colpart ? (16 * m + fr) : ((tb - 1) * 4 + 2 * ai + wr);
                f32x4 cs[4];
#pragma unroll
                for (int q = 0; q < 4; ++q) cs[q] = isctx ? (f32x4){1.f, 0.f, 1.f, 0.f} : *(const f32x4*)(rt + ((size_t)(isctx ? 0 : pos) * 32 + f0 + 2 * q) * 2);
                const size_t grow = (size_t)(row0 + ai * HALF + m * 16), prow = grow - (size_t)bb * HM_TPB;
#pragma unroll
                for (int bj = 0; bj < 2; ++bj) { float r[8];
#pragma unroll
                    for (int e = 0; e < 8; ++e) { const float x = acc[ai][bj][m][e >> 2][e & 3] * osc; const float xp = __shfl_xor(x, 32);
                        const float c = cs[e >> 1][2 * (e & 1)], sn = cs[e >> 1][2 * (e & 1) + 1];
                        r[e] = x2 ? (x * c + xp * sn) : (x * c - xp * sn); }
                    u32x4 w; w.x = cvt_pk_bf16(r[0], r[1]); w.y = cvt_pk_bf16(r[2], r[3]); w.z = cvt_pk_bf16(r[4], r[5]); w.w = cvt_pk_bf16(r[6], r[7]);
                    const int cc = cw + bj * HALF;
                    bf16_t* dst = isq ? Qp + grow * 1024 + u.pn * BM + cc : Kp + ((size_t)(bb * 16 + (u.pn - 4) * 4 + (cc >> 6)) * HM_TPB + prow) * 64 + (cc & 63);
                    st16(dst, w); } }
    }
};

struct EpiRopeB {
    static constexpr bool PERM = true;
    bf16_t* O; const float* rt; float qs;
    __device__ __forceinline__ void operator()(const f32x4 (&acc)[2][2][4][2], const Unit& u, int wr, int wc, int fr, int fq) const {
        const int row0 = u.po * BM + wr * 64 + fr, col0 = u.pn * BM + wc * 32 + 8 * fq;
        const int tb = u.pm % 17; const bool isctx = (tb == 0), colpart = (fq & 2) != 0, x2 = (fq & 1) != 0;
#pragma unroll
        for (int ai = 0; ai < 2; ++ai)
#pragma unroll
            for (int m = 0; m < 4; ++m) {
                const int pos = colpart ? (16 * m + fr) : ((tb - 1) * 4 + 2 * ai + wr);
                f32x4 cs[4];
#pragma unroll
                for (int q = 0; q < 4; ++q) cs[q] = isctx ? (f32x4){1.f, 0.f, 1.f, 0.f} : *(const f32x4*)(rt + ((size_t)(isctx ? 0 : pos) * 32 + 2 * q) * 2);
                bf16_t* rowp = O + (size_t)(row0 + ai * HALF + m * 16) * 1536 + col0;
#pragma unroll
                for (int bj = 0; bj < 2; ++bj) { const bool rope = ((u.pn * 8 + bj * 4 + wc) % 3) == 2;
                    float r[8];
#pragma unroll
                    for (int e = 0; e < 8; ++e) { const float x = acc[ai][bj][m][e >> 2][e & 3] * qs; const float xp = __shfl_xor(x, 16);
                        const float c = cs[e >> 1][2 * (e & 1)], sn = cs[e >> 1][2 * (e & 1) + 1];
                        r[e] = rope ? (x2 ? (x * c + xp * sn) : (x * c - xp * sn)) : x; }
                    u32x4 w; w.x = cvt_pk_bf16(r[0], r[1]); w.y = cvt_pk_bf16(r[2], r[3]); w.z = cvt_pk_bf16(r[4], r[5]); w.w = cvt_pk_bf16(r[6], r[7]);
                    st16(rowp + bj * HALF, w); } }
    }
};

struct EpiNormRopeC {
    static constexpr bool PERM = true;
    bf16_t* Qp; bf16_t* Kp; bf16_t* Vp; const float* qg; const float* kg; const float* rt; LAS float* xch; float qs;
    __device__ __forceinline__ void operator()(const f32x4 (&acc)[2][2][4][2], const Unit& u, int wr, int wc, int fr, int fq) const {
        const int row0 = u.po * BM + wr * 64 + fr, bb = u.po / 17;
        if (u.pn == 5) {
#pragma unroll
            for (int ai = 0; ai < 2; ++ai)
#pragma unroll
                for (int m = 0; m < 4; ++m) { const size_t prow = (size_t)(row0 + ai * HALF + m * 16) - (size_t)bb * HM_TPB;
#pragma unroll
                    for (int bj = 0; bj < 2; ++bj) { const f32x4 v0 = acc[ai][bj][m][0], v1 = acc[ai][bj][m][1];
                        u32x4 w; w.x = cvt_pk_bf16(v0[0], v0[1]); w.y = cvt_pk_bf16(v0[2], v0[3]); w.z = cvt_pk_bf16(v1[0], v1[1]); w.w = cvt_pk_bf16(v1[2], v1[3]);
                        st16(Vp + ((size_t)(bb * 2 + bj) * HM_TPB + prow) * 128 + wc * 32 + 8 * fq, w); } }
            asm volatile("s_waitcnt lgkmcnt(0)" ::: "memory"); __builtin_amdgcn_s_barrier(); asm volatile("" ::: "memory");
            return; }
#pragma unroll
        for (int ai = 0; ai < 2; ++ai)
#pragma unroll
            for (int m = 0; m < 4; ++m)
#pragma unroll
                for (int bj = 0; bj < 2; ++bj) { const f32x4 v0 = acc[ai][bj][m][0], v1 = acc[ai][bj][m][1];
                    float sq = (v0[0] * v0[0] + v0[1] * v0[1]) + (v0[2] * v0[2] + v0[3] * v0[3]) + (v1[0] * v1[0] + v1[1] * v1[1]) + (v1[2] * v1[2] + v1[3] * v1[3]);
                    sq += __shfl_xor(sq, 16); sq += __shfl_xor(sq, 32);
                    if (fq == 0) xch[((ai * HALF + wr * 64 + m * 16 + fr) * 2 + bj) * 4 + wc] = sq; }
        asm volatile("s_waitcnt lgkmcnt(0)" ::: "memory"); __builtin_amdgcn_s_barrier(); asm volatile("" ::: "memory");
        const bool isq = u.pn < 4; const float* gv = isq ? qg : kg;
        const int d0 = 64 * (wc >> 1) + 32 * (fq >> 1) + 16 * (wc & 1) + 8 * (fq & 1);
        const f32x4 ga = *(const f32x4*)(gv + d0), gb = *(const f32x4*)(gv + d0 + 4);
        const int tb = u.pm % 17; const bool isctx = (tb == 0), colpart = (wc >> 1) != 0, x2 = (fq >> 1) != 0;
        const int f0 = d0 & 31;
#pragma unroll
        for (int ai = 0; ai < 2; ++ai)
#pragma unroll
            for (int m = 0; m < 4; ++m) {
                const int pos = colpart ? (16 * m + fr) : ((tb - 1) * 4 + 2 * ai + wr);
                f32x4 cs[4];
#pragma unroll
                for (int q = 0; q < 4; ++q) cs[q] = isctx ? (f32x4){1.f, 0.f, 1.f, 0.f} : *(const f32x4*)(rt + ((size_t)(isctx ? 0 : pos) * 32 + f0 + 2 * q) * 2);
                const int rl = ai * HALF + wr * 64 + m * 16 + fr; const size_t row = (size_t)(row0 + ai * HALF + m * 16);
#pragma unroll
                for (int bj = 0; bj < 2; ++bj) { const f32x4 ps = *(const LAS f32x4*)(xch + (rl * 2 + bj) * 4);
                    const float rstd = rsqrtf(((ps[0] + ps[1]) + (ps[2] + ps[3])) * (1.0f / 128.0f) + 1e-6f) * (isq ? qs : 1.0f);
                    const int head = 2 * u.pn + bj; float r[8];
#pragma unroll
                    for (int e = 0; e < 8; ++e) { const float y = acc[ai][bj][m][e >> 2][e & 3] * rstd * (e < 4 ? ga[e] : gb[e - 4]); const float yp = __shfl_xor(y, 32);
                        const float c = cs[e >> 1][2 * (e & 1)], sn = cs[e >> 1][2 * (e & 1) + 1];
                        r[e] = x2 ? (y * c + yp * sn) : (y * c - yp * sn); }
                    u32x4 w; w.x = cvt_pk_bf16(r[0], r[1]); w.y = cvt_pk_bf16(r[2], r[3]); w.z = cvt_pk_bf16(r[4], r[5]); w.w = cvt_pk_bf16(r[6], r[7]);
                    bf16_t* dst = isq ? Qp + row * 1024 + head * 128 + d0 : Kp + ((size_t)(bb * 2 + (head - 8)) * HM_TPB + (row - (size_t)bb * HM_TPB)) * 128 + d0;
                    st16(dst, w); } }
    }
};

template <class Epi, class Sched, bool GATHER, bool FP8 = false>
__device__ __forceinline__ void gemm_phase(LAS unsigned char* lds, const Gemm g, const Sched& S, const Epi& E, const int wid) {
    const int lane = fresh_lane(), tid = wid * 64 + lane, wr = wid >> 2, wc = wid & 3, fr = lane & 15, fq = lane >> 4;
    const int K = g.K, nt = g.nt;
    unsigned voffA[2], voffB[2];
#pragma unroll
    for (int i = 0; i < 2; ++i) { int R, C; stage_rc(tid * 16 + i * 8192, R, C); const int Rb = Epi::PERM ? ((R & ~31) + perm32(R & 31)) : R;
        voffA[i] = (unsigned)(R * K + C) * 2u; voffB[i] = (unsigned)(Rb * K + C) * 2u; }
    const size_t kstep = (size_t)(BK * 2);
    const size_t hstep = (size_t)HALF * K * 2;
    const size_t tstep = 2 * hstep;
    const unsigned ldsw = (unsigned)wid * 1024u;
    const int aoff = lds_byte(wr * 64 + fr, fq * 8), boff = lds_byte(wc * 32 + fr, fq * 8);
#define PG8_SA(b, h) (((b) * 2 + (h)) * HTB)
#define PG8_SB(b, h) ((4 + (b) * 2 + (h)) * HTB)
#define PG8_STAGE(bufoff, gbase, voff) do { _Pragma("unroll") for (int _i = 0; _i < 2; ++_i) \
        __builtin_amdgcn_global_load_lds((const unsigned*)((const char*)(gbase) + (voff)[_i]), (LAS unsigned*)(lds + (bufoff) + ldsw + _i * 8192), 16, 0, 0); } while (0)
#define PG8_STAGE_A(bufoff, Ap, G, h, kb) do { if constexpr (GATHER) { PG8_STAGE(bufoff, (const char*)g.A + (kb), (G)[h]); } else { PG8_STAGE(bufoff, (Ap) + (size_t)(h) * hstep + (kb), voffA); } } while (0)
#define PG8_LD16(off) (*(const LAS u32x4*)(lds + (off)))
#define PG8_LDA(dst, b, h) do { _Pragma("unroll") for (int m = 0; m < 4; ++m) { if constexpr (FP8) { dst##8[m] = __builtin_bit_cast(v8i32, __builtin_shufflevector(PG8_LD16(PG8_SA(b, h) + aoff + m * 2048), PG8_LD16(PG8_SA(b, h) + aoff + m * 2048 + 1024), 0, 1, 2, 3, 4, 5, 6, 7)); } \
        else { _Pragma("unroll") for (int k = 0; k < 2; ++k) dst[m][k] = *(const LAS bf16x8*)(lds + PG8_SA(b, h) + aoff + m * 2048 + k * 1024); } } } while (0)
#define PG8_LDB(dst, b, h) do { _Pragma("unroll") for (int n = 0; n < 2; ++n) { if constexpr (FP8) { dst##8[n] = __builtin_bit_cast(v8i32, __builtin_shufflevector(PG8_LD16(PG8_SB(b, h) + boff + n * 2048), PG8_LD16(PG8_SB(b, h) + boff + n * 2048 + 1024), 0, 1, 2, 3, 4, 5, 6, 7)); } \
        else { _Pragma("unroll") for (int k = 0; k < 2; ++k) dst[n][k] = *(const LAS bf16x8*)(lds + PG8_SB(b, h) + boff + n * 2048 + k * 1024); } } } while (0)
#define PG8_MMA(ai, bj, At, Bt) do { __builtin_amdgcn_s_setprio(1); _Pragma("unroll") for (int m = 0; m < 4; ++m) _Pragma("unroll") for (int n = 0; n < 2; ++n) { \
        if constexpr (FP8) { asm volatile("v_mfma_scale_f32_16x16x128_f8f6f4 %0, %1, %2, %0, %3, %3 op_sel_hi:[0,0,0]" : "+v"(acc[ai][bj][m][n]) : "v"(Bt##8[n]), "v"(At##8[m]), "v"(sc7f)); } \
        else { _Pragma("unroll") for (int k = 0; k < 2; ++k) acc[ai][bj][m][n] = __builtin_amdgcn_mfma_f32_16x16x32_bf16(Bt[n][k], At[m][k], acc[ai][bj][m][n], 0, 0, 0); } } \
        __builtin_amdgcn_s_setprio(0); } while (0)
#define PG8_WAIT_V(n) asm volatile("s_waitcnt vmcnt(" #n ")" ::: "memory")
#define PG8_WAIT_L(n) asm volatile("s_waitcnt lgkmcnt(" #n ")" ::: "memory")
#define PG8_BAR __builtin_amdgcn_s_barrier()
#define PG8_SCHED __builtin_amdgcn_sched_barrier(0)
    LAS unsigned char* tokt = lds + STAGE_BYTES;
#define PG8_TOKDMA(u, slot) do { if constexpr (GATHER) { if (wid < 4) { const unsigned _cn = (unsigned)g.cnt[(u).e]; const unsigned _s = (unsigned)((u).pl * BM + tid); \
        __builtin_amdgcn_global_load_lds((const unsigned*)(g.list + (size_t)(u).e * g.list_stride + (_s < _cn ? _s : _cn - 1u)), (LAS unsigned*)(tokt + (slot) * 1024 + wid * 256), 4, 0, 0); } } } while (0)
#define PG8_GOFFS(go, slot) do { if constexpr (GATHER) { \
        _Pragma("unroll") for (int _h = 0; _h < 2; ++_h) _Pragma("unroll") for (int _i = 0; _i < 2; ++_i) { int _R, _C; stage_rc(tid * 16 + _i * 8192, _R, _C); \
            const unsigned _t = *(const LAS unsigned*)(tokt + (slot) * 1024 + (_h * HALF + _R) * 4); (go)[_h][_i] = (_t * (unsigned)K + (unsigned)_C) * 2u; } } } while (0)
    Unit cur, nxt; int ui = 0;
    if (!S.next(0, cur)) return;
    f32x4 acc[2][2][4][2];
#pragma unroll
    for (int a = 0; a < 2; ++a)
#pragma unroll
        for (int b = 0; b < 2; ++b)
#pragma unroll
            for (int m = 0; m < 4; ++m)
#pragma unroll
                for (int n = 0; n < 2; ++n) acc[a][b][m][n] = (f32x4){0.f, 0.f, 0.f, 0.f};
    const unsigned sc7f = 0x7F7F7F7Fu;
    bf16x8 At[4][2], B0[2][2], B1[2][2]; v8i32 At8[4], B08[2], B18[2];
    unsigned gcur[2][2] = {{0u, 0u}, {0u, 0u}};
    const char* cA = (const char*)g.A + (size_t)cur.pm * tstep + (size_t)cur.kt0 * kstep; const char* cB = (const char*)g.Bt + ((size_t)cur.e * g.bstride) * 2 + (size_t)cur.pn * tstep + (size_t)cur.kt0 * kstep;
    if constexpr (GATHER) { PG8_TOKDMA(cur, 0); asm volatile("s_waitcnt vmcnt(0)" ::: "memory"); __builtin_amdgcn_s_barrier(); asm volatile("" ::: "memory"); }
    PG8_GOFFS(gcur, 0);
    PG8_STAGE(PG8_SB(0, 0), cB, voffB); PG8_STAGE(PG8_SB(0, 1), cB + hstep, voffB); PG8_STAGE_A(PG8_SA(0, 0), cA, gcur, 0, 0); PG8_STAGE_A(PG8_SA(0, 1), cA, gcur, 1, 0);
    if (wr == 1) PG8_BAR;
    PG8_WAIT_V(2); PG8_BAR;
    PG8_STAGE(PG8_SB(1, 0), cB + kstep, voffB); PG8_STAGE_A(PG8_SA(1, 0), cA, gcur, 0, kstep); PG8_STAGE(PG8_SB(1, 1), cB + hstep + kstep, voffB);
    PG8_WAIT_V(6); PG8_BAR;
    for (;;) {
        const bool has_next = S.next(ui + 1, nxt);
        if constexpr (GATHER) { if (has_next) PG8_TOKDMA(nxt, (ui + 1) & 1); }
        const char* nA = has_next ? (const char*)g.A + (size_t)nxt.pm * tstep + (size_t)nxt.kt0 * kstep : cA; const char* nB = has_next ? (const char*)g.Bt + ((size_t)nxt.e * g.bstride) * 2 + (size_t)nxt.pn * tstep + (size_t)nxt.kt0 * kstep : cB;
#pragma unroll 1
        for (int t = 0; t < nt; t += 2) {
            const bool last = (t == nt - 2);
            const size_t kb1 = (size_t)(t + 1) * kstep;
            const char* a2p = last ? nA : cA; const size_t kb2 = last ? (size_t)0 : (size_t)(t + 2) * kstep;
            const char* b2 = last ? nB : cB + (size_t)(t + 2) * kstep;
            const size_t kb3 = kb2 + kstep; const char* b3 = b2 + kstep;
            PG8_LDB(B0, 0, 0); PG8_LDB(B1, 0, 1); PG8_SCHED; PG8_LDA(At, 0, 0); PG8_STAGE_A(PG8_SA(1, 1), cA, gcur, 1, kb1);
            if constexpr (GATHER) { if (last && has_next) { PG8_GOFFS(gcur, (ui + 1) & 1); } }
            PG8_WAIT_V(8); PG8_WAIT_L(0); PG8_BAR; PG8_MMA(0, 0, At, B0); PG8_MMA(0, 1, At, B1); PG8_BAR; PG8_SCHED;
            PG8_LDA(At, 0, 1); PG8_STAGE(PG8_SB(0, 0), b2, voffB); PG8_STAGE(PG8_SB(0, 1), b2 + hstep, voffB); PG8_STAGE_A(PG8_SA(0, 0), a2p, gcur, 0, kb2);
            PG8_WAIT_V(8); PG8_WAIT_L(0); PG8_BAR; PG8_MMA(1, 0, At, B0); PG8_MMA(1, 1, At, B1); PG8_BAR; PG8_SCHED;
            PG8_LDB(B0, 1, 0); PG8_LDB(B1, 1, 1); PG8_SCHED; PG8_LDA(At, 1, 0); PG8_STAGE_A(PG8_SA(0, 1), a2p, gcur, 1, kb2);
            PG8_WAIT_V(8); PG8_WAIT_L(0); PG8_BAR; PG8_MMA(0, 0, At, B0); PG8_MMA(0, 1, At, B1); PG8_BAR; PG8_SCHED;
            PG8_LDA(At, 1, 1); PG8_STAGE(PG8_SB(1, 0), b3, voffB); PG8_STAGE(PG8_SB(1, 1), b3 + hstep, voffB); PG8_STAGE_A(PG8_SA(1, 0), a2p, gcur, 0, kb3);
            PG8_WAIT_V(8); PG8_WAIT_L(0); PG8_BAR; PG8_MMA(1, 0, At, B0); PG8_MMA(1, 1, At, B1); PG8_BAR; PG8_SCHED;
        }
        if (wr == 0) PG8_BAR;
        if constexpr (FP8) asm volatile("s_nop 15\n\ts_nop 15\n\ts_nop 15\n\ts_nop 15" ::: "memory");
        E(acc, cur, wr, wc, fr, fq);
        if (!has_next) break;
#pragma unroll
        for (int a = 0; a < 2; ++a)
#pragma unroll
            for (int b = 0; b < 2; ++b)
#pragma unroll
                for (int m = 0; m < 4; ++m)
#pragma unroll
                    for (int n = 0; n < 2; ++n) acc[a][b][m][n] = (f32x4){0.f, 0.f, 0.f, 0.f};
        cur = nxt; cA = nA; cB = nB; ++ui;
        if (wr == 1) PG8_BAR;
    }
    PG8_WAIT_V(0);
    PG8_BAR;
#undef PG8_SA
#undef PG8_SB
#undef PG8_STAGE
#undef PG8_STAGE_A
#undef PG8_LDA
#undef PG8_LDB
#undef PG8_MMA
#undef PG8_LD16
#undef PG8_WAIT_V
#undef PG8_WAIT_L
#undef PG8_BAR
#undef PG8_SCHED
#undef PG8_GOFFS
#undef PG8_TOKDMA
}
}
namespace att {
constexpr int NW = 8, QBLK = 32, KVBLK = 64;
constexpr float THR = 8.f;
#define ATT_SBAR() __builtin_amdgcn_sched_barrier(0)
template <int DK> __device__ __forceinline__ int kswz(int row, int colB) { return row * (DK * 2 + 16) + colB; }
__device__ __forceinline__ int crow(int r, int hi) { return (r & 3) + 8 * (r >> 2) + 4 * hi; }
__device__ __forceinline__ void partialSM(f32x16& p0, f32x16& p1, float& m_reg, float& mn, float& alpha, const float C, const float thr_raw) {
    float pmax = p0[0];
#pragma unroll
    for (int r = 1; r < 16; ++r) pmax = fmaxf(pmax, p0[r]);
#pragma unroll
    for (int r = 0; r < 16; ++r) pmax = fmaxf(pmax, p1[r]);
    { auto rr = __builtin_amdgcn_permlane32_swap(__float_as_uint(pmax), __float_as_uint(pmax), false, false);
      pmax = fmaxf(__uint_as_float(rr[0]), __uint_as_float(rr[1])); }
    if (__builtin_expect(__all(pmax - m_reg <= thr_raw), 1)) { mn = m_reg; alpha = 1.f; }
    else { mn = fmaxf(m_reg, pmax); alpha = __builtin_amdgcn_exp2f((m_reg - mn) * C); m_reg = mn; }
    const float mnC = -mn * C;
#pragma unroll
    for (int r = 0; r < 16; ++r) p0[r] = fmaf(p0[r], C, mnC);
#pragma unroll
    for (int r = 0; r < 16; ++r) p1[r] = fmaf(p1[r], C, mnC);
#pragma unroll
    for (int r = 0; r < 16; ++r) p0[r] = __builtin_amdgcn_exp2f(p0[r]);
}
__device__ __forceinline__ void finishSM(f32x16& p0, f32x16& p1, float alpha, float& l_reg, bf16x8& pa0, bf16x8& pa1, bf16x8& pa2, bf16x8& pa3) {
#pragma unroll
    for (int r = 0; r < 16; ++r) p1[r] = __builtin_amdgcn_exp2f(p1[r]);
#if MK_PROBE_ATT == 2
    { float dz = 0.f;
#pragma unroll
      for (int r = 0; r < 16; ++r) { dz += __builtin_amdgcn_exp2f(p0[r] - 1.0f); dz += __builtin_amdgcn_exp2f(p1[r] - 2.0f); }
      asm volatile("" :: "v"(dz)); }
#endif
    float ps = 0;
#pragma unroll
    for (int r = 0; r < 16; ++r) ps += p0[r];
#pragma unroll
    for (int r = 0; r < 16; ++r) ps += p1[r];
    { auto rr = __builtin_amdgcn_permlane32_swap(__float_as_uint(ps), __float_as_uint(ps), false, false);
      ps = __uint_as_float(rr[0]) + __uint_as_float(rr[1]); }
    l_reg = l_reg * alpha + ps;
#define ATT_PK4(P, BASE, OUT) do { unsigned a0 = cvt_pk_bf16(P[BASE + 0], P[BASE + 1]), a1 = cvt_pk_bf16(P[BASE + 2], P[BASE + 3]);   \
    unsigned b0 = cvt_pk_bf16(P[BASE + 4], P[BASE + 5]), b1 = cvt_pk_bf16(P[BASE + 6], P[BASE + 7]);                              \
    auto r0 = __builtin_amdgcn_permlane32_swap(a0, b0, false, false); auto r1 = __builtin_amdgcn_permlane32_swap(a1, b1, false, false); \
    u32x4 w = {r0[0], r1[0], r0[1], r1[1]}; OUT = *reinterpret_cast<bf16x8*>(&w); } while (0)
    ATT_PK4(p0, 0, pa0); ATT_PK4(p0, 8, pa1); ATT_PK4(p1, 0, pa2); ATT_PK4(p1, 8, pa3);
#undef ATT_PK4
}
#ifndef MK_PROBE_ATT
#define MK_PROBE_ATT 0
#endif
template <int DK> __device__ __forceinline__ void qkt(f32x16& p0, f32x16& p1, const char* Ks, const bf16x8* qr, int r32, int hi) {
    p0 = f32x16{}; p1 = f32x16{};
#if MK_PROBE_ATT == 1
    f32x16 d0_ = f32x16{}; d0_[0] = 1.0f;
#endif
#pragma unroll
    for (int d0 = 0; d0 < DK / 16; ++d0) { const int cb = (d0 * 16 + hi * 8) * 2;
        const bf16x8 b0 = *reinterpret_cast<const bf16x8*>(Ks + kswz<DK>(r32, cb));
        const bf16x8 b1 = *reinterpret_cast<const bf16x8*>(Ks + kswz<DK>(32 + r32, cb));
        p0 = __builtin_amdgcn_mfma_f32_32x32x16_bf16(b0, qr[d0], p0, 0, 0, 0);
        p1 = __builtin_amdgcn_mfma_f32_32x32x16_bf16(b1, qr[d0], p1, 0, 0, 0);
#if MK_PROBE_ATT == 1
        d0_ = __builtin_amdgcn_mfma_f32_32x32x16_bf16(b0, qr[d0], d0_, 0, 0, 0);
        d0_ = __builtin_amdgcn_mfma_f32_32x32x16_bf16(b1, qr[d0], d0_, 0, 0, 0);
#endif
    }
#if MK_PROBE_ATT == 1
    asm volatile("" :: "v"(d0_));
#endif
}
template <int DV> __device__ __forceinline__ int v_st(int k, int c) { const int kk = (k & ~0xC) | ((k & 4) << 1) | ((k & 8) >> 1); return ((kk >> 3) * (DV / 32) + (c >> 5)) * 512 + ((kk & 7) * 32 + (c & 31)) * 2; }
__device__ __forceinline__ int v_rd_base(int lane) { return ((lane & 3) << 3) | (((lane >> 2) & 3) << 6) | (((lane >> 4) & 1) << 5) | (((lane >> 5) & 1) << 8); }
template <int DV> constexpr int v_rd_off(int d0, int ks, int half) { return d0 * 512 + ks * (DV / 32) * 1024 + half * (DV / 32) * 512; }
template <int OFF> __device__ __forceinline__ s16x4 tr_read(int vb) {
    s16x4 r; asm volatile("ds_read_b64_tr_b16 %0, %1 offset:%2" : "=&v"(r) : "v"(vb), "i"(OFF) : "memory"); return r;
}
template <int DV, int D0> __device__ __forceinline__ void pv_one(f32x16& od, int vb, bf16x8 pa0, bf16x8 pa1, bf16x8 pa2, bf16x8 pa3) {
    const s16x4 l0 = tr_read<v_rd_off<DV>(D0, 0, 0)>(vb), h0 = tr_read<v_rd_off<DV>(D0, 0, 1)>(vb), l1 = tr_read<v_rd_off<DV>(D0, 1, 0)>(vb), h1 = tr_read<v_rd_off<DV>(D0, 1, 1)>(vb);
    const s16x4 l2 = tr_read<v_rd_off<DV>(D0, 2, 0)>(vb), h2 = tr_read<v_rd_off<DV>(D0, 2, 1)>(vb), l3 = tr_read<v_rd_off<DV>(D0, 3, 0)>(vb), h3 = tr_read<v_rd_off<DV>(D0, 3, 1)>(vb);
    asm volatile("s_waitcnt lgkmcnt(0)" ::: "memory"); ATT_SBAR();
#define ATT_PK(L, H) (bf16x8){L[0], L[1], L[2], L[3], H[0], H[1], H[2], H[3]}
    od = __builtin_amdgcn_mfma_f32_32x32x16_bf16(pa0, ATT_PK(l0, h0), od, 0, 0, 0);
    od = __builtin_amdgcn_mfma_f32_32x32x16_bf16(pa1, ATT_PK(l1, h1), od, 0, 0, 0);
    od = __builtin_amdgcn_mfma_f32_32x32x16_bf16(pa2, ATT_PK(l2, h2), od, 0, 0, 0);
    od = __builtin_amdgcn_mfma_f32_32x32x16_bf16(pa3, ATT_PK(l3, h3), od, 0, 0, 0);
#undef ATT_PK
}
template <int DV, int D0> __device__ __forceinline__ void pv_two(f32x16& oa, f32x16& ob, int vb, bf16x8 pa0, bf16x8 pa1, bf16x8 pa2, bf16x8 pa3) {
    const s16x4 l0 = tr_read<v_rd_off<DV>(D0, 0, 0)>(vb), h0 = tr_read<v_rd_off<DV>(D0, 0, 1)>(vb), l1 = tr_read<v_rd_off<DV>(D0, 1, 0)>(vb), h1 = tr_read<v_rd_off<DV>(D0, 1, 1)>(vb);
    const s16x4 l2 = tr_read<v_rd_off<DV>(D0, 2, 0)>(vb), h2 = tr_read<v_rd_off<DV>(D0, 2, 1)>(vb), l3 = tr_read<v_rd_off<DV>(D0, 3, 0)>(vb), h3 = tr_read<v_rd_off<DV>(D0, 3, 1)>(vb);
    const s16x4 m0 = tr_read<v_rd_off<DV>(D0 + 1, 0, 0)>(vb), n0 = tr_read<v_rd_off<DV>(D0 + 1, 0, 1)>(vb), m1 = tr_read<v_rd_off<DV>(D0 + 1, 1, 0)>(vb), n1 = tr_read<v_rd_off<DV>(D0 + 1, 1, 1)>(vb);
    const s16x4 m2 = tr_read<v_rd_off<DV>(D0 + 1, 2, 0)>(vb), n2 = tr_read<v_rd_off<DV>(D0 + 1, 2, 1)>(vb), m3 = tr_read<v_rd_off<DV>(D0 + 1, 3, 0)>(vb), n3 = tr_read<v_rd_off<DV>(D0 + 1, 3, 1)>(vb);
    asm volatile("s_waitcnt lgkmcnt(0)" ::: "memory"); ATT_SBAR();
#define ATT_PK(L, H) (bf16x8){L[0], L[1], L[2], L[3], H[0], H[1], H[2], H[3]}
    oa = __builtin_amdgcn_mfma_f32_32x32x16_bf16(pa0, ATT_PK(l0, h0), oa, 0, 0, 0);
    ob = __builtin_amdgcn_mfma_f32_32x32x16_bf16(pa0, ATT_PK(m0, n0), ob, 0, 0, 0);
    oa = __builtin_amdgcn_mfma_f32_32x32x16_bf16(pa1, ATT_PK(l1, h1), oa, 0, 0, 0);
    ob = __builtin_amdgcn_mfma_f32_32x32x16_bf16(pa1, ATT_PK(m1, n1), ob, 0, 0, 0);
    oa = __builtin_amdgcn_mfma_f32_32x32x16_bf16(pa2, ATT_PK(l2, h2), oa, 0, 0, 0);
    ob = __builtin_amdgcn_mfma_f32_32x32x16_bf16(pa2, ATT_PK(m2, n2), ob, 0, 0, 0);
    oa = __builtin_amdgcn_mfma_f32_32x32x16_bf16(pa3, ATT_PK(l3, h3), oa, 0, 0, 0);
    ob = __builtin_amdgcn_mfma_f32_32x32x16_bf16(pa3, ATT_PK(m3, n3), ob, 0, 0, 0);
#undef ATT_PK
}
struct VFrag64 { s16x4 l[2][4], h[2][4]; };
template <int DV> __device__ __forceinline__ void pv_issue(VFrag64& f, int vb) {
    f.l[0][0] = tr_read<v_rd_off<DV>(0, 0, 0)>(vb); f.h[0][0] = tr_read<v_rd_off<DV>(0, 0, 1)>(vb); f.l[0][1] = tr_read<v_rd_off<DV>(0, 1, 0)>(vb); f.h[0][1] = tr_read<v_rd_off<DV>(0, 1, 1)>(vb);
    f.l[0][2] = tr_read<v_rd_off<DV>(0, 2, 0)>(vb); f.h[0][2] = tr_read<v_rd_off<DV>(0, 2, 1)>(vb); f.l[0][3] = tr_read<v_rd_off<DV>(0, 3, 0)>(vb); f.h[0][3] = tr_read<v_rd_off<DV>(0, 3, 1)>(vb);
    f.l[1][0] = tr_read<v_rd_off<DV>(1, 0, 0)>(vb); f.h[1][0] = tr_read<v_rd_off<DV>(1, 0, 1)>(vb); f.l[1][1] = tr_read<v_rd_off<DV>(1, 1, 0)>(vb); f.h[1][1] = tr_read<v_rd_off<DV>(1, 1, 1)>(vb);
    f.l[1][2] = tr_read<v_rd_off<DV>(1, 2, 0)>(vb); f.h[1][2] = tr_read<v_rd_off<DV>(1, 2, 1)>(vb); f.l[1][3] = tr_read<v_rd_off<DV>(1, 3, 0)>(vb); f.h[1][3] = tr_read<v_rd_off<DV>(1, 3, 1)>(vb);
}
__device__ __forceinline__ void pv_mma64(f32x16* o, const VFrag64& f, bf16x8 pa0, bf16x8 pa1, bf16x8 pa2, bf16x8 pa3) {
    asm volatile("s_waitcnt lgkmcnt(0)" ::: "memory"); ATT_SBAR();
#define ATT_PK(L, H) (bf16x8){L[0], L[1], L[2], L[3], H[0], H[1], H[2], H[3]}
    o[0] = __builtin_amdgcn_mfma_f32_32x32x16_bf16(pa0, ATT_PK(f.l[0][0], f.h[0][0]), o[0], 0, 0, 0);
    o[1] = __builtin_amdgcn_mfma_f32_32x32x16_bf16(pa0, ATT_PK(f.l[1][0], f.h[1][0]), o[1], 0, 0, 0);
    o[0] = __builtin_amdgcn_mfma_f32_32x32x16_bf16(pa1, ATT_PK(f.l[0][1], f.h[0][1]), o[0], 0, 0, 0);
    o[1] = __builtin_amdgcn_mfma_f32_32x32x16_bf16(pa1, ATT_PK(f.l[1][1], f.h[1][1]), o[1], 0, 0, 0);
    o[0] = __builtin_amdgcn_mfma_f32_32x32x16_bf16(pa2, ATT_PK(f.l[0][2], f.h[0][2]), o[0], 0, 0, 0);
    o[1] = __builtin_amdgcn_mfma_f32_32x32x16_bf16(pa2, ATT_PK(f.l[1][2], f.h[1][2]), o[1], 0, 0, 0);
    o[0] = __builtin_amdgcn_mfma_f32_32x32x16_bf16(pa3, ATT_PK(f.l[0][3], f.h[0][3]), o[0], 0, 0, 0);
    o[1] = __builtin_amdgcn_mfma_f32_32x32x16_bf16(pa3, ATT_PK(f.l[1][3], f.h[1][3]), o[1], 0, 0, 0);
#undef ATT_PK
}
#ifndef MK_PV2
#define MK_PV2 1
#endif
#ifndef MK_VPRE
#define MK_VPRE 0
#endif
#ifndef MK_MBLK
#define MK_MBLK 1
#endif
#ifndef MK_ATT_PRIO
#define MK_ATT_PRIO 1
#endif
template <int DV> __device__ __forceinline__ void pv_d0(f32x16* o, int vb, bf16x8 pa0, bf16x8 pa1, bf16x8 pa2, bf16x8 pa3) {
#if MK_PV2
    pv_two<DV, 0>(o[0], o[1], vb, pa0, pa1, pa2, pa3);
    if constexpr (DV == 128) pv_two<DV, 2>(o[2], o[3], vb, pa0, pa1, pa2, pa3);
#else
    pv_one<DV, 0>(o[0], vb, pa0, pa1, pa2, pa3); pv_one<DV, 1>(o[1], vb, pa0, pa1, pa2, pa3);
    if constexpr (DV == 128) { pv_one<DV, 2>(o[2], vb, pa0, pa1, pa2, pa3); pv_one<DV, 3>(o[3], vb, pa0, pa1, pa2, pa3); }
#endif
}
template <int DK, int DV> constexpr int lds_bytes() { return 3 * KVBLK * DV * 2 + 3 * KVBLK * (DK * 2 + 16) + NW * 64 * 4; }

template <int DK, int DV, int ldq, int ldk, int ldv, int ldo, int SD, int EPI = 0>
__device__ __forceinline__ void attn_unit(const bf16_t* __restrict__ Qb, const bf16_t* __restrict__ Kh, const bf16_t* __restrict__ Vh,
                                          bf16_t* __restrict__ Ob, int seq, const float C, const float thr_raw, char* lds, const int wid, LAS unsigned* stash = nullptr, float lam = 0.f, const float* gvec = nullptr) {
    constexpr int SHM_V = KVBLK * DV * 2, SHM_K = KVBLK * (DK * 2 + 16);
    constexpr int NO = DV / 32, ND = DK / 16;
    const int lane = fresh_lane(), tid = wid * 64 + lane, r32 = lane & 31, hi = lane >> 5;
    char* V_lds = lds; char* K_lds = lds + 3 * SHM_V;
    float* wsf = (float*)(lds + 3 * SHM_V + 3 * SHM_K) + wid * 64; float* li_l = wsf; float* al_l = wsf + 32;
    float m_reg = -1e30f, l_reg = 0; f32x16 o[NO]; bf16x8 qr[ND];
#pragma unroll
    for (int d = 0; d < NO; ++d) o[d] = f32x16{};
    const bf16_t* Qw = Qb + (long)(wid * QBLK + r32) * ldq + hi * 8;
#pragma unroll
    for (int d0 = 0; d0 < ND; ++d0) qr[d0] = *reinterpret_cast<const bf16x8*>(Qw + d0 * 16);
    const int sr = tid >> 4, sc = (tid & 15) * 8; const bool kact = (DK == 128) ? true : (sc < DK), vact = (DV == 128) ? true : (sc < DV);
    const int vst0 = v_st<DV>(sr, vact ? sc : 0), vst1 = v_st<DV>(32 + sr, vact ? sc : 0);
    const int vb0 = (int)(uintptr_t)V_lds + v_rd_base(lane);
    const unsigned koff = (unsigned)(sr * ldk + sc) * 2u, voff = (unsigned)(sr * ldv + sc) * 2u;
    const size_t k32 = (size_t)32 * ldk * 2, v32 = (size_t)32 * ldv * 2;
    struct { bf16x8 vs0, vs1, ks0, ks1; } sr_[SD];
#define ATT_SLOAD(s, k0) do { const char* _kt = (const char*)Kh + (size_t)(k0) * ldk * 2; const char* _vt = (const char*)Vh + (size_t)(k0) * ldv * 2; \
    if (vact) { sr_[s].vs0 = *reinterpret_cast<const bf16x8*>(_vt + voff); sr_[s].vs1 = *reinterpret_cast<const bf16x8*>(_vt + v32 + voff); } \
    if (kact) { sr_[s].ks0 = *reinterpret_cast<const bf16x8*>(_kt + koff); sr_[s].ks1 = *reinterpret_cast<const bf16x8*>(_kt + k32 + koff); } } while (0)
#define ATT_SWRITE(b, s) do { if (vact) { *(bf16x8*)(V_lds + (b) * SHM_V + vst0) = sr_[s].vs0; *(bf16x8*)(V_lds + (b) * SHM_V + vst1) = sr_[s].vs1; } \
    if (kact) { const int kc = sc * 2; *(bf16x8*)(K_lds + (b) * SHM_K + kswz<DK>(sr, kc)) = sr_[s].ks0; *(bf16x8*)(K_lds + (b) * SHM_K + kswz<DK>(32 + sr, kc)) = sr_[s].ks1; } } while (0)
#define ATT_RESC(a) do { if (__any((a) < 1.f)) { if (hi == 0) al_l[r32] = (a); asm volatile("s_waitcnt lgkmcnt(0)" ::: "memory"); \
    _Pragma("unroll") for (int d = 0; d < NO; ++d) _Pragma("unroll") for (int r = 0; r < 16; ++r) o[d][r] *= al_l[crow(r, hi)]; } } while (0)
    f32x16 pA0, pA1, pB0, pB1; float mnA, mnB, alA, alB; bf16x8 pa0, pa1, pa2, pa3; const int NT = seq / KVBLK;
    constexpr int SE = 0, SO = SD - 1;
    constexpr bool VPRE = (DV == 64) && (MK_VPRE != 0); VFrag64 vf;
    __syncthreads();
    ATT_SLOAD(SE, 0); asm volatile("s_waitcnt vmcnt(0)" ::: "memory"); ATT_SWRITE(0, SE); __syncthreads();
    qkt<DK>(pA0, pA1, K_lds, qr, r32, hi); partialSM(pA0, pA1, m_reg, mnA, alA, C, thr_raw);
    ATT_SLOAD(SO, KVBLK); if constexpr (SD == 2) { if (2 < NT) ATT_SLOAD(SE, 2 * KVBLK); }
    ATT_SWRITE(1, SO); __syncthreads();
    int bj = 1;
    for (int j = 1; j + 1 < NT; j += 2) {
        const int bn = (bj == 2) ? 0 : bj + 1, bp = (bj == 0) ? 2 : bj - 1;
        ATT_SBAR(); if constexpr (VPRE) pv_issue<DV>(vf, vb0 + bp * SHM_V);
        qkt<DK>(pB0, pB1, K_lds + bj * SHM_K, qr, r32, hi);
        finishSM(pA0, pA1, alA, l_reg, pa0, pa1, pa2, pa3); ATT_SBAR();
        ATT_SLOAD(SO, (j + SD) * KVBLK); ATT_SBAR();
        if constexpr (VPRE) pv_mma64(o, vf, pa0, pa1, pa2, pa3); else pv_d0<DV>(o, vb0 + bp * SHM_V, pa0, pa1, pa2, pa3);
        partialSM(pB0, pB1, m_reg, mnB, alB, C, thr_raw);
        ATT_SWRITE(bn, SE);
        ATT_RESC(alB); __syncthreads();
        ATT_SBAR(); if constexpr (VPRE) pv_issue<DV>(vf, vb0 + bj * SHM_V);
        qkt<DK>(pA0, pA1, K_lds + bn * SHM_K, qr, r32, hi);
        finishSM(pB0, pB1, alB, l_reg, pa0, pa1, pa2, pa3); ATT_SBAR();
        if (SD == 1 || j + 3 < NT) ATT_SLOAD(SE, (j + 1 + SD) * KVBLK); ATT_SBAR();
        if constexpr (VPRE) pv_mma64(o, vf, pa0, pa1, pa2, pa3); else pv_d0<DV>(o, vb0 + bj * SHM_V, pa0, pa1, pa2, pa3);
        partialSM(pA0, pA1, m_reg, mnA, alA, C, thr_raw);
        ATT_SWRITE(bp, SO);
        ATT_RESC(alA); __syncthreads();
        bj = bp;
    }
    { const int bp = (bj == 0) ? 2 : bj - 1;
      ATT_SBAR(); qkt<DK>(pB0, pB1, K_lds + bj * SHM_K, qr, r32, hi);
      finishSM(pA0, pA1, alA, l_reg, pa0, pa1, pa2, pa3); ATT_SBAR();
      pv_d0<DV>(o, vb0 + bp * SHM_V, pa0, pa1, pa2, pa3); partialSM(pB0, pB1, m_reg, mnB, alB, C, thr_raw);
      ATT_RESC(alB);
      finishSM(pB0, pB1, alB, l_reg, pa0, pa1, pa2, pa3); ATT_SBAR();
      pv_d0<DV>(o, vb0 + bj * SHM_V, pa0, pa1, pa2, pa3); }
    if (hi == 0) li_l[r32] = l_reg; asm volatile("s_waitcnt lgkmcnt(0)" ::: "memory");
    float rli[16];
#pragma unroll
    for (int r = 0; r < 16; ++r) rli[r] = __builtin_amdgcn_rcpf(li_l[crow(r, hi)]);
    if constexpr (EPI == 1) {
#pragma unroll
        for (int r = 0; r < 16; ++r)
#pragma unroll
            for (int p = 0; p < NO / 2; ++p) stash[(r * (NO / 2) + p) * 64 + lane] = pk2(o[2 * p][r] * rli[r], o[2 * p + 1][r] * rli[r]);
    } else if constexpr (EPI == 2) {
        static_assert(EPI != 2 || DV == 128, "differential combine: DV = 128");
        float gl[NO];
#pragma unroll
        for (int d0 = 0; d0 < NO; ++d0) gl[d0] = gvec[d0 * 32 + r32];
        bf16_t* Ow = Ob + (long)(wid * QBLK) * ldo;
#pragma unroll
        for (int r = 0; r < 16; ++r) { float v[NO]; float ss = 0.f;
#pragma unroll
            for (int p = 0; p < NO / 2; ++p) { const unsigned w = stash[(r * (NO / 2) + p) * 64 + lane];
                v[2 * p] = o[2 * p][r] * rli[r] - lam * bf2f(w & 0xffffu); v[2 * p + 1] = o[2 * p + 1][r] * rli[r] - lam * bf2f(w >> 16); ss += v[2 * p] * v[2 * p] + v[2 * p + 1] * v[2 * p + 1]; }
#pragma unroll
            for (int x = 1; x < 32; x <<= 1) ss += __shfl_xor(ss, x);
            const float rstd = rsqrtf(ss * (1.0f / 128.0f) + 1e-6f); const int orow = crow(r, hi);
#pragma unroll
            for (int d0 = 0; d0 < NO; ++d0) Ow[(long)orow * ldo + d0 * 32 + r32] = (bf16_t)f2bf(v[d0] * rstd * gl[d0]); }
    } else {
    bf16_t* Ow = Ob + (long)(wid * QBLK) * ldo;
#pragma unroll
    for (int r = 0; r < 16; ++r) { const int orow = crow(r, hi);
#pragma unroll
        for (int d0 = 0; d0 < NO; ++d0) Ow[(long)orow * ldo + d0 * 32 + r32] = (bf16_t)f2bf(o[d0][r] * rli[r]); }
    }
#undef ATT_SLOAD
#undef ATT_SWRITE
#undef ATT_RESC
}

constexpr float THRL = THR * 1.4426950408889634f;
__device__ __forceinline__ float max3f(float a, float b, float c) { return __builtin_fmaxf(__builtin_fmaxf(a, b), c); }
__device__ __forceinline__ void softmax_rel(f32x16& p0, f32x16& p1, float& m_run, float& alpha, const bool first) {
    float pm = max3f(p0[0], p0[1], p0[2]);
#pragma unroll
    for (int r = 3; r < 15; r += 2) pm = max3f(pm, p0[r], p0[r + 1]);
    pm = max3f(pm, p0[15], p1[0]);
#pragma unroll
    for (int r = 1; r < 15; r += 2) pm = max3f(pm, p1[r], p1[r + 1]);
    pm = __builtin_fmaxf(pm, p1[15]);
    { auto rr = __builtin_amdgcn_permlane32_swap(__float_as_uint(pm), __float_as_uint(pm), false, false); pm = __builtin_fmaxf(__uint_as_float(rr[0]), __uint_as_float(rr[1])); }
    if (!first && __builtin_expect(__all(pm <= THRL), 1)) alpha = 1.f;
    else { const float d = first ? pm : __builtin_fmaxf(pm, 0.f); alpha = first ? 1.f : __builtin_amdgcn_exp2f(-d); m_run += d;
#pragma unroll
        for (int r = 0; r < 16; ++r) { p0[r] -= d; p1[r] -= d; } }
#pragma unroll
    for (int r = 0; r < 16; ++r) { p0[r] = __builtin_amdgcn_exp2f(p0[r]); p1[r] = __builtin_amdgcn_exp2f(p1[r]); }
}
template <int DK> __device__ __forceinline__ void qkt_init(f32x16& p0, f32x16& p1, const char* Ks, const bf16x8* qr, int r32, int hi, float init) {
#pragma unroll
    for (int r = 0; r < 16; ++r) { p0[r] = init; p1[r] = init; }
#pragma unroll
    for (int d0 = 0; d0 < DK / 16; ++d0) { const int cb = (d0 * 16 + hi * 8) * 2;
        const bf16x8 b0 = *reinterpret_cast<const bf16x8*>(Ks + kswz<DK>(r32, cb));
        const bf16x8 b1 = *reinterpret_cast<const bf16x8*>(Ks + kswz<DK>(32 + r32, cb));
        p0 = __builtin_amdgcn_mfma_f32_32x32x16_bf16(b0, qr[d0], p0, 0, 0, 0);
        p1 = __builtin_amdgcn_mfma_f32_32x32x16_bf16(b1, qr[d0], p1, 0, 0, 0); }
}
__device__ __forceinline__ void finish_rel(f32x16& p0, f32x16& p1, float alpha, float& l_reg, bf16x8& pa0, bf16x8& pa1, bf16x8& pa2, bf16x8& pa3) {
    float ps = 0;
#pragma unroll
    for (int r = 0; r < 16; ++r) ps += p0[r];
#pragma unroll
    for (int r = 0; r < 16; ++r) ps += p1[r];
    { auto rr = __builtin_amdgcn_permlane32_swap(__float_as_uint(ps), __float_as_uint(ps), false, false); ps = __uint_as_float(rr[0]) + __uint_as_float(rr[1]); }
    l_reg = l_reg * alpha + ps;
#define ATT_PK4(P, BASE, OUT) do { unsigned a0 = cvt_pk_bf16(P[BASE + 0], P[BASE + 1]), a1 = cvt_pk_bf16(P[BASE + 2], P[BASE + 3]);   \
    unsigned b0 = cvt_pk_bf16(P[BASE + 4], P[BASE + 5]), b1 = cvt_pk_bf16(P[BASE + 6], P[BASE + 7]);                              \
    auto r0 = __builtin_amdgcn_permlane32_swap(a0, b0, false, false); auto r1 = __builtin_amdgcn_permlane32_swap(a1, b1, false, false); \
    u32x4 w = {r0[0], r1[0], r0[1], r1[1]}; OUT = *reinterpret_cast<bf16x8*>(&w); } while (0)
    ATT_PK4(p0, 0, pa0); ATT_PK4(p0, 8, pa1); ATT_PK4(p1, 0, pa2); ATT_PK4(p1, 8, pa3);
#undef ATT_PK4
}

template <int OFF> __device__ __forceinline__ bf16x8 k_read(int ka) { bf16x8 r; asm volatile("ds_read_b128 %0, %1 offset:%2" : "=&v"(r) : "v"(ka), "i"(OFF) : "memory"); return r; }
#define ATT_WAITL(n) asm volatile("s_waitcnt lgkmcnt(%0)" :: "n"(n) : "memory")
#define ATT_PKV(L, H) (bf16x8){L[0], L[1], L[2], L[3], H[0], H[1], H[2], H[3]}
template <int DK, int DV, int KBD, bool FINM = false, bool MINIT = false>
__device__ __forceinline__ void mblock(f32x16* o, f32x16& p0, f32x16& p1, const bool pv, const int vb, const int ka, const bf16x8* qr, bf16x8 pa0, bf16x8 pa1, bf16x8 pa2, bf16x8 pa3, const float init, const float al = 1.f, float* l_reg = nullptr, const f32x16* minit = nullptr) {
    constexpr int ND = DK / 16, NB = ND / KBD, PITCH = DK * 2 + 16, KR = 2 * KBD;
    static_assert(ND % KBD == 0 && NB >= 2 && NB <= 4 && (KBD == 2 || KBD == 3), "K batches");
    bf16x8 ka0[2][KBD], ka1[2][KBD];
    s16x4 l[4], h[4], m[4], n[4];
#define ATT_KISSUE(b) do { ka0[(b) & 1][0] = k_read<((b) * KBD + 0) * 32>(ka); ka1[(b) & 1][0] = k_read<((b) * KBD + 0) * 32 + 32 * PITCH>(ka); \
        ka0[(b) & 1][1] = k_read<((b) * KBD + 1) * 32>(ka); ka1[(b) & 1][1] = k_read<((b) * KBD + 1) * 32 + 32 * PITCH>(ka); \
        if constexpr (KBD > 2) { ka0[(b) & 1][KBD - 1] = k_read<((b) * KBD + KBD - 1) * 32>(ka); ka1[(b) & 1][KBD - 1] = k_read<((b) * KBD + KBD - 1) * 32 + 32 * PITCH>(ka); } } while (0)
#define ATT_TRISSUE(D0) do { l[0] = tr_read<v_rd_off<DV>(D0, 0, 0)>(vb); h[0] = tr_read<v_rd_off<DV>(D0, 0, 1)>(vb); l[1] = tr_read<v_rd_off<DV>(D0, 1, 0)>(vb); h[1] = tr_read<v_rd_off<DV>(D0, 1, 1)>(vb); \
        l[2] = tr_read<v_rd_off<DV>(D0, 2, 0)>(vb); h[2] = tr_read<v_rd_off<DV>(D0, 2, 1)>(vb); l[3] = tr_read<v_rd_off<DV>(D0, 3, 0)>(vb); h[3] = tr_read<v_rd_off<DV>(D0, 3, 1)>(vb); \
        m[0] = tr_read<v_rd_off<DV>(D0 + 1, 0, 0)>(vb); n[0] = tr_read<v_rd_off<DV>(D0 + 1, 0, 1)>(vb); m[1] = tr_read<v_rd_off<DV>(D0 + 1, 1, 0)>(vb); n[1] = tr_read<v_rd_off<DV>(D0 + 1, 1, 1)>(vb); \
        m[2] = tr_read<v_rd_off<DV>(D0 + 1, 2, 0)>(vb); n[2] = tr_read<v_rd_off<DV>(D0 + 1, 2, 1)>(vb); m[3] = tr_read<v_rd_off<DV>(D0 + 1, 3, 0)>(vb); n[3] = tr_read<v_rd_off<DV>(D0 + 1, 3, 1)>(vb); } while (0)
#define ATT_PVMMA(OA, OB) do { OA = __builtin_amdgcn_mfma_f32_32x32x16_bf16(pa0, ATT_PKV(l[0], h[0]), OA, 0, 0, 0); OB = __builtin_amdgcn_mfma_f32_32x32x16_bf16(pa0, ATT_PKV(m[0], n[0]), OB, 0, 0, 0); \
        OA = __builtin_amdgcn_mfma_f32_32x32x16_bf16(pa1, ATT_PKV(l[1], h[1]), OA, 0, 0, 0); OB = __builtin_amdgcn_mfma_f32_32x32x16_bf16(pa1, ATT_PKV(m[1], n[1]), OB, 0, 0, 0); \
        OA = __builtin_amdgcn_mfma_f32_32x32x16_bf16(pa2, ATT_PKV(l[2], h[2]), OA, 0, 0, 0); OB = __builtin_amdgcn_mfma_f32_32x32x16_bf16(pa2, ATT_PKV(m[2], n[2]), OB, 0, 0, 0); \
        OA = __builtin_amdgcn_mfma_f32_32x32x16_bf16(pa3, ATT_PKV(l[3], h[3]), OA, 0, 0, 0); OB = __builtin_amdgcn_mfma_f32_32x32x16_bf16(pa3, ATT_PKV(m[3], n[3]), OB, 0, 0, 0); } while (0)
#define ATT_QKMMA(b) do { _Pragma("unroll") for (int q = 0; q < KBD; ++q) { const bool f_ = MINIT && (b) == 0 && q == 0; \
        p0 = __builtin_amdgcn_mfma_f32_32x32x16_bf16(ka0[(b) & 1][q], qr[(b) * KBD + q], f_ ? *minit : p0, 0, 0, 0); \
        p1 = __builtin_amdgcn_mfma_f32_32x32x16_bf16(ka1[(b) & 1][q], qr[(b) * KBD + q], f_ ? *minit : p1, 0, 0, 0); } } while (0)
#if MK_ATT_PRIO == 1
    __builtin_amdgcn_s_setprio(1);
#endif
    constexpr bool K2 = (DV == 64);
    if (pv) {
        ATT_TRISSUE(0); ATT_KISSUE(0); if constexpr (K2) ATT_KISSUE(1);
        if constexpr (FINM) { ATT_SBAR(); finish_rel(p0, p1, al, *l_reg, pa0, pa1, pa2, pa3); ATT_SBAR(); }
        ATT_WAITL(K2 ? 2 * KR : KR); ATT_SBAR();
        ATT_PVMMA(o[0], o[1]); ATT_SBAR();
        if constexpr (DV == 128) { ATT_TRISSUE(2); ATT_WAITL(0); ATT_SBAR(); ATT_PVMMA(o[2], o[3]); ATT_SBAR(); }
    } else { ATT_KISSUE(0); if constexpr (K2) ATT_KISSUE(1); }
    if constexpr (!K2) ATT_KISSUE(1);
    if constexpr (!MINIT) {
#pragma unroll
        for (int r = 0; r < 16; ++r) { p0[r] = init; p1[r] = init; } }
    ATT_WAITL(KR); ATT_SBAR(); ATT_QKMMA(0); ATT_SBAR();
    if constexpr (NB > 2) { ATT_KISSUE(2); ATT_WAITL(KR); } else ATT_WAITL(0);
    ATT_SBAR(); ATT_QKMMA(1); ATT_SBAR();
    if constexpr (NB > 2) { if constexpr (NB > 3) { ATT_KISSUE(3); ATT_WAITL(KR); } else ATT_WAITL(0);
        ATT_SBAR(); ATT_QKMMA(2); ATT_SBAR();
        if constexpr (NB > 3) { ATT_WAITL(0); ATT_SBAR(); ATT_QKMMA(3); ATT_SBAR(); } }
#if MK_ATT_PRIO == 1
    __builtin_amdgcn_s_setprio(0);
#endif
    if (MK_PROBE_ATT == 4) { f32x16 dz = f32x16{};
#pragma unroll
        for (int q = 0; q < ND; ++q) { dz = __builtin_amdgcn_mfma_f32_32x32x16_bf16(qr[q], qr[(q + 1) % ND], dz, 0, 0, 0); dz = __builtin_amdgcn_mfma_f32_32x32x16_bf16(qr[(q + 1) % ND], qr[q], dz, 0, 0, 0); }
        asm volatile("" :: "v"(dz)); }
    if (MK_PROBE_ATT == 5) { ATT_KISSUE(0); ATT_KISSUE(1); if constexpr (NB > 2) { ATT_WAITL(0); ATT_KISSUE(2); if constexpr (NB > 3) ATT_KISSUE(3); } ATT_WAITL(0);
        asm volatile("" :: "v"(ka0[0][0]), "v"(ka1[0][0]), "v"(ka0[1][0]), "v"(ka1[1][0])); }
#undef ATT_KISSUE
#undef ATT_TRISSUE
#undef ATT_PVMMA
#undef ATT_QKMMA
}

template <int DK, int DV, int ldq, int ldk, int ldv, int ldo, bool PRE, bool DEEP, bool PART = false>
__device__ __forceinline__ void attn_unit_stag(const bf16_t* __restrict__ Qb, const bf16_t* __restrict__ Kh, const bf16_t* __restrict__ Vh,
                                               bf16_t* __restrict__ Ob, int seq, const float C, const float thr_raw, char* lds, const int wid, float* po = nullptr, float* pml = nullptr) {
    constexpr int SHM_V = KVBLK * DV * 2, SHM_K = KVBLK * (DK * 2 + 16), R = 4;
    constexpr int NO = DV / 32, ND = DK / 16;
    const int lane = fresh_lane(), tid = wid * 64 + lane, r32 = lane & 31, hi = lane >> 5, half = wid >> 2;
    char* V_lds = lds; char* K_lds = lds + R * SHM_V;
    float* wsf = (float*)(lds + R * SHM_V + R * SHM_K) + wid * 64; float* li_l = wsf; float* al_l = wsf + 32;
    float m_reg = 0.f, l_reg = 0; f32x16 o[NO]; bf16x8 qr[ND];
#pragma unroll
    for (int d = 0; d < NO; ++d) o[d] = f32x16{};
    const bf16_t* Qw = Qb + (long)(wid * QBLK + r32) * ldq + hi * 8;
#pragma unroll
    for (int d0 = 0; d0 < ND; ++d0) qr[d0] = *reinterpret_cast<const bf16x8*>(Qw + d0 * 16);
    if constexpr (!PRE) {
#pragma unroll
        for (int d0 = 0; d0 < ND; ++d0) { const u32x4 w = *reinterpret_cast<const u32x4*>(&qr[d0]); u32x4 x;
            x.x = cvt_pk_bf16(bf2f(w.x & 0xffffu) * C, bf2f(w.x >> 16) * C); x.y = cvt_pk_bf16(bf2f(w.y & 0xffffu) * C, bf2f(w.y >> 16) * C);
            x.z = cvt_pk_bf16(bf2f(w.z & 0xffffu) * C, bf2f(w.z >> 16) * C); x.w = cvt_pk_bf16(bf2f(w.w & 0xffffu) * C, bf2f(w.w >> 16) * C);
            qr[d0] = *reinterpret_cast<const bf16x8*>(&x); } }
    const int sr = tid >> 4, sc = (tid & 15) * 8; const bool kact = (DK == 128) ? true : (sc < DK), vact = (DV == 128) ? true : (sc < DV);
    const int vst0 = v_st<DV>(sr, vact ? sc : 0), vst1 = v_st<DV>(32 + sr, vact ? sc : 0);
    const int vb0 = (int)(uintptr_t)V_lds + v_rd_base(lane);
    const int ka0 = (int)(uintptr_t)K_lds + kswz<DK>(r32, hi * 16);
    const unsigned koff = (unsigned)(sr * ldk + sc) * 2u, voff = (unsigned)(sr * ldv + sc) * 2u;
    const unsigned koff2 = koff + 32u * ldk * 2u, voff2 = voff + 32u * ldv * 2u;
    bf16x8 vsA0, vsA1, ksA0, ksA1, vsB0, vsB1, ksB0, ksB1;
#define STG_SLOAD(S, k0) do { const char* _kt = (const char*)Kh + (size_t)(k0) * ldk * 2; const char* _vt = (const char*)Vh + (size_t)(k0) * ldv * 2;        \
    if (vact) { vs##S##0 = *reinterpret_cast<const bf16x8*>(_vt + (size_t)voff); vs##S##1 = *reinterpret_cast<const bf16x8*>(_vt + (size_t)voff2); } \
    if (kact) { ks##S##0 = *reinterpret_cast<const bf16x8*>(_kt + (size_t)koff); ks##S##1 = *reinterpret_cast<const bf16x8*>(_kt + (size_t)koff2); } } while (0)
#define STG_SWRITE(S, b) do { if (vact) { *(bf16x8*)(V_lds + (b) * SHM_V + vst0) = vs##S##0; *(bf16x8*)(V_lds + (b) * SHM_V + vst1) = vs##S##1; } \
    if (kact) { const int kc = sc * 2; *(bf16x8*)(K_lds + (b) * SHM_K + kswz<DK>(sr, kc)) = ks##S##0; *(bf16x8*)(K_lds + (b) * SHM_K + kswz<DK>(32 + sr, kc)) = ks##S##1; } } while (0)
#define STG_BAR() do { ATT_SBAR(); asm volatile("s_waitcnt lgkmcnt(0)" ::: "memory"); __builtin_amdgcn_s_barrier(); asm volatile("" ::: "memory"); ATT_SBAR(); } while (0)
    constexpr bool MINIT = !(DK == 128 && DV == 128);
    f32x16 minit = f32x16{};
    constexpr bool FINM = false;
    f32x16 p0, p1; float al = 1.f; bf16x8 pa0, pa1, pa2, pa3; const int NT = seq / KVBLK; (void)thr_raw;
    __syncthreads();
    if constexpr (DEEP) { STG_SLOAD(A, 0); STG_SLOAD(B, KVBLK); asm volatile("s_waitcnt vmcnt(0)" ::: "memory"); STG_SWRITE(A, 0); STG_SWRITE(B, 1);
        if (2 < NT) { STG_SLOAD(A, 2 * KVBLK); STG_SLOAD(B, 3 * KVBLK); } }
    else if constexpr (!(DK == 128 && DV == 128)) {
        STG_SLOAD(A, 0); STG_SLOAD(B, KVBLK); asm volatile("s_waitcnt vmcnt(0)" ::: "memory"); STG_SWRITE(A, 0); STG_SWRITE(B, 1);
        if (2 < NT) STG_SLOAD(A, 2 * KVBLK); }
    else { STG_SLOAD(A, 0); asm volatile("s_waitcnt vmcnt(0)" ::: "memory"); STG_SWRITE(A, 0);
        STG_SLOAD(A, KVBLK); asm volatile("s_waitcnt vmcnt(0)" ::: "memory"); STG_SWRITE(A, 1);
        if (2 < NT) STG_SLOAD(A, 2 * KVBLK); }
    __syncthreads();
    if (half && MK_PROBE_ATT != 8) STG_BAR();
#define STG_TILE(t, S) do { \
        mblock<DK, DV, (DK == 96) ? 3 : 2, FINM, MINIT>(o, p0, p1, (t) > 0, vb0 + (((t) - 1) & 3) * SHM_V, ka0 + ((t) & 3) * SHM_K, qr, pa0, pa1, pa2, pa3, -m_reg, al, &l_reg, &minit); \
        STG_BAR(); \
        if (MK_ATT_PRIO == 2) __builtin_amdgcn_s_setprio(1); \
        { const float mo_ = m_reg; softmax_rel(p0, p1, m_reg, al, (t) == 0); \
          if (MINIT) { if (__builtin_expect(__any(m_reg != mo_), 0)) { _Pragma("unroll") for (int r = 0; r < 16; ++r) minit[r] = -m_reg; } } } \
        if (MK_PROBE_ATT == 3) { float dz = 0.f; _Pragma("unroll") for (int r = 0; r < 16; ++r) { dz += __builtin_amdgcn_exp2f(p0[r] - 1.0f); dz += __builtin_amdgcn_exp2f(p1[r] - 2.0f); } asm volatile("" :: "v"(dz)); } \
        if (MK_PROBE_ATT == 6) { STG_BAR(); } \
        if (MK_PROBE_ATT == 9) { float dz = al; _Pragma("unroll") for (int r = 0; r < 48; ++r) asm volatile("v_fma_f32 %0, %0, %0, %0" : "+v"(dz)); asm volatile("" :: "v"(dz)); } \
        if constexpr (!FINM) finish_rel(p0, p1, al, l_reg, pa0, pa1, pa2, pa3); \
        if (__any(al < 1.f)) { if (hi == 0) al_l[r32] = al; asm volatile("s_waitcnt lgkmcnt(0)" ::: "memory"); \
            _Pragma("unroll") for (int d = 0; d < NO; ++d) _Pragma("unroll") for (int r = 0; r < 16; ++r) o[d][r] *= al_l[crow(r, hi)]; } \
        if (MK_ATT_PRIO == 2) __builtin_amdgcn_s_setprio(0); \
        if constexpr (DEEP) { if ((t) + 2 < NT) { STG_SWRITE(S, ((t) + 2) & 3); if ((t) + 4 < NT) STG_SLOAD(S, ((t) + 4) * KVBLK); } } \
        else      { if ((t) + 2 < NT) { STG_SWRITE(A, ((t) + 2) & 3); if ((t) + 3 < NT) { STG_SLOAD(A, ((t) + 3) * KVBLK); \
            if (MK_PROBE_ATT == 7) { STG_SLOAD(B, ((t) + 3) * KVBLK + 32 * ((t) & 1)); asm volatile("" :: "v"(vsB0), "v"(vsB1), "v"(ksB0), "v"(ksB1)); } } } } \
        STG_BAR(); } while (0)
    if constexpr (DEEP) { for (int t = 0; t < NT; t += 2) { STG_TILE(t, A); STG_TILE(t + 1, B); } }
    else { for (int t = 0; t < NT; ++t) STG_TILE(t, A); }
#undef STG_TILE
    if constexpr (FINM) finish_rel(p0, p1, al, l_reg, pa0, pa1, pa2, pa3);
    pv_d0<DV>(o, (int)(uintptr_t)V_lds + v_rd_base(fresh_lane()) + ((NT - 1) & 3) * SHM_V, pa0, pa1, pa2, pa3);
    if (!half && MK_PROBE_ATT != 8) STG_BAR();
    if constexpr (PART) { const int ln = fresh_lane(), rr32 = ln & 31, hh = ln >> 5;
      if (hh == 0) { pml[(wid * QBLK + rr32) * 2] = m_reg; pml[(wid * QBLK + rr32) * 2 + 1] = l_reg; }
      float* pw = po + (size_t)(wid * QBLK) * DV;
#pragma unroll
      for (int r = 0; r < 16; ++r) { const int orow = crow(r, hh);
#pragma unroll
          for (int d0 = 0; d0 < NO; ++d0) pw[orow * DV + d0 * 32 + rr32] = o[d0][r]; } }
    else
    { const int ln = fresh_lane(), rr32 = ln & 31, hh = ln >> 5;
      float* wsf2 = (float*)(lds + R * SHM_V + R * SHM_K) + wid * 64;
      if (hh == 0) wsf2[rr32] = l_reg; asm volatile("s_waitcnt lgkmcnt(0)" ::: "memory");
      float rli[16];
#pragma unroll
      for (int r = 0; r < 16; ++r) rli[r] = __builtin_amdgcn_rcpf(wsf2[crow(r, hh)]);
      constexpr int OP = DV * 2 + 16, OSZ = 32 * OP, NV = (3 * SHM_V) / OSZ;
      static_assert((8 - NV) * OSZ <= R * SHM_K, "O staging");
      char* stg = lds + (wid < NV ? wid * OSZ : R * SHM_V + (wid - NV) * OSZ);
#pragma unroll
      for (int r = 0; r < 16; ++r) { const int orow = crow(r, hh);
#pragma unroll
          for (int d0 = 0; d0 < NO; ++d0) *(bf16_t*)(stg + orow * OP + (d0 * 32 + rr32) * 2) = (bf16_t)f2bf(o[d0][r] * rli[r]); }
      asm volatile("s_waitcnt lgkmcnt(0)" ::: "memory");
      bf16_t* Ow = Ob + (long)(wid * QBLK) * ldo;
      constexpr int SEG = DV * 2 / 16;
#pragma unroll
      for (int ps = 0; ps < DV / 16; ++ps) { const int idx = ps * 64 + ln, row = idx / SEG, seg = idx % SEG;
          const u32x4 w = *(const u32x4*)(stg + row * OP + seg * 16);
          *(u32x4*)(Ow + (long)row * ldo + seg * 8) = w; } }
#undef STG_SLOAD
#undef STG_SWRITE
#undef STG_BAR
}
}
constexpr int NWAVES = 8;
constexpr int DM = 1024, NBATCH = 8, SEQ = 4096, CTXL = 256, TPB = CTXL + SEQ  , T = NBATCH * TPB  ;
constexpr int FF = 3584, NEXP = 8, DEPTH = 4;
constexpr int A_IN = 5120, B_IN = 672, B_INP = 768, C_IN = 1536, D_IN = 3072;
constexpr float NORM_EPS = 1e-6f;
constexpr int MOE_ROWS = 2 * T + NEXP * 256;

enum { I_X = 0, I_C, I_CTX, I_CCTX, I_MODW, I_MODB, I_NORMG, I_A_WIN, I_A_LB, I_A_ONORM, I_A_WOUT, I_B_WIN, I_B_QNORM, I_B_KVNORM, I_B_WQB, I_B_WKVB, I_B_WOUT,
       I_C_WIN, I_C_QNORM, I_C_KNORM, I_C_WOUT, I_D_WIN, I_D_LAMBDA, I_D_ONORM, I_D_WOUT, I_FFN_GU, I_FFN_DOWN, I_MOE_ROUTER, I_MOE_GU, I_MOE_DOWN, N_IN };

constexpr size_t al256(size_t x) { return (x + 255) / 256 * 256; }
constexpr size_t WS_CTL = 0, CTL_BYTES = 1u << 20;
constexpr size_t WS_MOD = WS_CTL + CTL_BYTES;
constexpr size_t WS_ROPE = WS_MOD + al256((size_t)DEPTH * 9 * 6 * DM * 4);
constexpr size_t WS_LB = WS_ROPE + al256((size_t)3 * 64 * 32 * 2 * 4);
constexpr size_t WS_W0 = WS_LB + al256((size_t)2 * 1024 * 4);
constexpr size_t WS_WA_IN = WS_W0;                                  constexpr size_t SZ_WA_IN = (size_t)A_IN * DM * 2;
constexpr size_t WS_WA_OUT = WS_WA_IN + SZ_WA_IN;                   constexpr size_t SZ_WOUT = (size_t)DM * DM * 2;
constexpr size_t WS_WB_IN = WS_WA_OUT + SZ_WOUT;                    constexpr size_t SZ_WB_IN = (size_t)B_INP * DM * 2;
constexpr size_t WS_WB_QB = WS_WB_IN + SZ_WB_IN;                    constexpr size_t SZ_WB_QB = (size_t)1536 * 384 * 2;
constexpr size_t WS_WB_KVB = WS_WB_QB + SZ_WB_QB;                   constexpr size_t SZ_WB_KVB = (size_t)2048 * 256 * 2;
constexpr size_t WS_WB_OUT = WS_WB_KVB + SZ_WB_KVB;
constexpr size_t WS_WC_IN = WS_WB_OUT + SZ_WOUT;                    constexpr size_t SZ_WC_IN = (size_t)C_IN * DM * 2;
constexpr size_t WS_WC_OUT = WS_WC_IN + SZ_WC_IN;
constexpr size_t WS_WD_IN = WS_WC_OUT + SZ_WOUT;                    constexpr size_t SZ_WD_IN = (size_t)D_IN * DM * 2;
constexpr size_t WS_WD_OUT = WS_WD_IN + SZ_WD_IN;
constexpr size_t WS_FFN_GU = WS_WD_OUT + SZ_WOUT;                   constexpr size_t SZ_GU = (size_t)2 * FF * DM;
constexpr size_t WS_FFN_DN = WS_FFN_GU + 2 * SZ_GU;                 constexpr size_t SZ_DN = (size_t)DM * FF * 2;
constexpr size_t WS_MOE_GU = WS_FFN_DN + 2 * SZ_DN;
constexpr size_t WS_MOE_DN = WS_MOE_GU + 16 * SZ_GU;
constexpr size_t WS_WEND = WS_MOE_DN + 16 * SZ_DN;
constexpr size_t WS_H = al256(WS_WEND);                              constexpr size_t SZ_H = (size_t)T * DM * 4;
constexpr size_t WS_XA = WS_H + SZ_H;                                constexpr size_t SZ_XA = (size_t)T * DM * 2;
constexpr size_t WS_Y = WS_XA + SZ_XA;                               constexpr size_t SZ_Y = (size_t)T * DM * 4;
constexpr size_t WS_YS = WS_Y + SZ_Y;                              constexpr size_t SZ_YS = (size_t)8 * 2048 * DM * 4;
constexpr size_t WS_ROUTE = WS_YS + SZ_YS;                             constexpr size_t SZ_ROUTE = (size_t)T * 32;
constexpr size_t WS_WCNT = WS_ROUTE + SZ_ROUTE;                      constexpr size_t SZ_WCNT = (size_t)256 * 8 * 4;
constexpr size_t WS_LIST = WS_WCNT + SZ_WCNT;                      constexpr size_t SZ_LIST = (size_t)NEXP * T * 4;
constexpr size_t WS_R0 = al256(WS_LIST + SZ_LIST);
constexpr size_t WS_Z = WS_R0;                                       constexpr size_t SZ_Z = (size_t)T * A_IN * 2;
constexpr size_t WS_Q = WS_Z + SZ_Z;                                 constexpr size_t SZ_Q = (size_t)T * 2048 * 2;
constexpr size_t WS_K = WS_Q + SZ_Q;                                 constexpr size_t SZ_K = (size_t)T * 1536 * 2;
constexpr size_t WS_V = WS_K + SZ_K;                                 constexpr size_t SZ_V = (size_t)T * 1024 * 2;
constexpr size_t WS_O = WS_V + SZ_V;                                 constexpr size_t SZ_O = (size_t)T * 2048 * 2;
constexpr size_t WS_MIX_END = WS_O + SZ_O;
constexpr size_t WS_ACT = WS_R0;                                     constexpr size_t SZ_ACT = (size_t)MOE_ROWS * FF * 2;
constexpr size_t WS_YP = WS_ACT + al256(SZ_ACT);                     constexpr size_t SZ_YP = (size_t)MOE_ROWS * DM * 4;
constexpr size_t WS_FFN_END = WS_YP + SZ_YP;
constexpr size_t WS_END = (WS_MIX_END > WS_FFN_END ? WS_MIX_END : WS_FFN_END);
static_assert((size_t)T * 1536 * 4 <= SZ_Z && (size_t)T * B_INP * 4 <= SZ_Z && (size_t)T * D_IN * 2 <= SZ_Z, "Z region");
static_assert((size_t)T * (384 + 256) * 2 <= SZ_O, "MLA normalised latents fit the O region");

constexpr int CW_BAR = 4096;
constexpr int CW_MOECNT = 16384;
constexpr int RING_BYTES = 131072;
constexpr int MISC_OFF = 163840 - 1024;
constexpr int LDS_BYTES = 163840;
static_assert(RING_BYTES <= MISC_OFF, "LDS map");

#define XB_TMO      128
#define XB_XCNT(j)  (256  + 64 * (j))
#define XB_XSUB(j)  (1280 + 64 * (j))
#define XB_XGEN(j)  (2304 + 64 * (j))
#define XB_TOP      3328
#define XB_TOPGEN   3392
#define XCD_BAR_WORDS 3456
#define XB_SPIN_CAP (1u << 22)
__device__ __forceinline__ unsigned xb_ld(unsigned* p)              { return __hip_atomic_load(p, __ATOMIC_RELAXED, __HIP_MEMORY_SCOPE_AGENT); }
__device__ __forceinline__ unsigned xb_add(unsigned* p, unsigned v) { return __hip_atomic_fetch_add(p, v, __ATOMIC_RELAXED, __HIP_MEMORY_SCOPE_AGENT); }
__device__ __forceinline__ unsigned xb_xcc_id() { return (unsigned)__builtin_amdgcn_s_getreg((3 << 11) | 20) & 0xFu; }
#define XB_SPIN(cond, bar) do { unsigned _sp = 0; while (cond) { __builtin_amdgcn_s_sleep(1); \
    if ((++_sp & 255u) == 0u) { if (xb_ld(&(bar)[XB_TMO])) break; if (_sp > XB_SPIN_CAP) { atomicAdd(&(bar)[XB_TMO], 1u); break; } } } } while (0)
struct XcdBarrier { unsigned* bar; unsigned x; volatile LAS unsigned* st; };
__device__ __forceinline__ XcdBarrier xcd_barrier_post(unsigned* bar, volatile LAS unsigned* st) {
    XcdBarrier b; b.bar = bar; b.x = xb_xcc_id(); b.st = st;
    if (threadIdx.x == 0) (void)xb_add(&bar[XB_XCNT(b.x)], 1u);
    return b;
}
__device__ __forceinline__ void xcd_barrier_complete(unsigned* bar, unsigned x, unsigned& nloc, unsigned& nx) {
    const unsigned G = gridDim.x * gridDim.y * gridDim.z;
    unsigned sum, cnt, mine, sp = 0u;
    for (;;) {
        sum = 0u; cnt = 0u; mine = 0u;
#pragma unroll
        for (unsigned j = 0; j < 16; ++j) { const unsigned c = xb_ld(&bar[XB_XCNT(j)]); sum += c; cnt += (c > 0u) ? 1u : 0u; mine = (j == x) ? c : mine; }
        if (sum == G) break;
        __builtin_amdgcn_s_sleep(1);
        if ((++sp & 255u) == 0u) { if (xb_ld(&bar[XB_TMO])) break; if (sp > XB_SPIN_CAP) { atomicAdd(&bar[XB_TMO], 1u); break; } }
    }
    nloc = mine > 0u ? mine : 1u; nx = cnt > 0u ? cnt : 1u;
}
__device__ __forceinline__ void xcd_barrier(const XcdBarrier& b, const int wave) {
    asm volatile("s_waitcnt vmcnt(0)" ::: "memory");
    __syncthreads();
    if (wave == 0 && fresh_lane() == 0) {
        unsigned* bar = b.bar;
        __builtin_amdgcn_s_waitcnt(0);
        unsigned nloc = b.st[0], nx = b.st[1];
        if (nloc == 0u) { xcd_barrier_complete(bar, b.x, nloc, nx); b.st[0] = nloc; b.st[1] = nx; }
        const unsigned old = xb_add(&bar[XB_XSUB(b.x)], 1u);
        const unsigned gen = old / nloc;
        if (old + 1u == (gen + 1u) * nloc) {
            __builtin_amdgcn_fence(__ATOMIC_RELEASE, "agent");
            asm volatile("s_waitcnt vmcnt(0)" ::: "memory");
            const unsigned og = xb_add(&bar[XB_TOP], 1u);
            const unsigned tg = og / nx;
            if (og + 1u == (tg + 1u) * nx) xb_add(&bar[XB_TOPGEN], 1u);
            else XB_SPIN(xb_ld(&bar[XB_TOPGEN]) == tg, bar);
            __builtin_amdgcn_fence(__ATOMIC_ACQUIRE, "agent");
            xb_add(&bar[XB_XGEN(b.x)], 1u);
            asm volatile("s_waitcnt vmcnt(0)" ::: "memory");
        } else {
            XB_SPIN(xb_ld(&bar[XB_XGEN(b.x)]) == gen, bar);
            __builtin_amdgcn_fence(__ATOMIC_ACQUIRE, "agent");
            asm volatile("s_waitcnt vmcnt(0)" ::: "memory");
        }
    }
    __syncthreads();
}

struct Frame {
    LAS unsigned char* lds; volatile LAS unsigned* MISC; unsigned char* ws;
    int wave, vcu, G;
};
typedef __attribute__((address_space(4))) const unsigned long long* kargp_t;
__device__ __forceinline__ float* out_ptr() { kargp_t ka = (kargp_t)__builtin_amdgcn_kernarg_segment_ptr(); return (float*)(GAS float*)(ka[N_IN]); }
__device__ __forceinline__ const float* in_ptr(const Frame&, int idx) { kargp_t ka = (kargp_t)__builtin_amdgcn_kernarg_segment_ptr(); return (const float*)(const GAS float*)(ka[idx]); }

struct MatDesc { int in_idx; unsigned src_off  ; int K, Nsrc, Ndst, kind  ; unsigned long long dst  ; };
constexpr int NMAT = 10 + 2 + 2 + 16 + 16, NMAT0 = 4;
struct MatTable { MatDesc m[NMAT]; int item0[NMAT + 1]; };
constexpr MatTable make_mats() {
    MatTable t{}; int n = 0;
    auto add = [&](int in_idx, unsigned src_off, int K, int Nsrc, int Ndst, int kind, unsigned long long dst) { t.m[n] = MatDesc{in_idx, src_off, K, Nsrc, Ndst, kind, dst}; ++n; };
    add(I_A_WIN, 0, DM, A_IN, A_IN, 0, WS_WA_IN); add(I_A_WOUT, 0, DM, DM, DM, 0, WS_WA_OUT);
    add(I_FFN_GU, 0, DM, 2 * FF, 2 * FF, 2, WS_FFN_GU); add(I_FFN_DOWN, 0, FF, DM, DM, 0, WS_FFN_DN);
    add(I_B_WIN, 0, DM, B_IN, B_INP, 0, WS_WB_IN); add(I_B_WQB, 0, 384, 1536, 1536, 0, WS_WB_QB); add(I_B_WKVB, 0, 256, 2048, 2048, 0, WS_WB_KVB); add(I_B_WOUT, 0, DM, DM, DM, 0, WS_WB_OUT);
    add(I_C_WIN, 0, DM, C_IN, C_IN, 3, WS_WC_IN); add(I_C_WOUT, 0, DM, DM, DM, 0, WS_WC_OUT);
    add(I_D_WIN, 0, DM, D_IN, D_IN, 0, WS_WD_IN); add(I_D_WOUT, 0, DM, DM, DM, 0, WS_WD_OUT);
    add(I_FFN_GU, (unsigned)1 * DM * 2 * FF, DM, 2 * FF, 2 * FF, 2, WS_FFN_GU + SZ_GU); add(I_FFN_DOWN, (unsigned)1 * FF * DM, FF, DM, DM, 0, WS_FFN_DN + SZ_DN);
    for (int j = 0; j < 16; ++j) add(I_MOE_GU, (unsigned)j * DM * 2 * FF, DM, 2 * FF, 2 * FF, 2, WS_MOE_GU + (size_t)j * SZ_GU);
    for (int j = 0; j < 16; ++j) add(I_MOE_DOWN, (unsigned)j * FF * DM, FF, DM, DM, 0, WS_MOE_DN + (size_t)j * SZ_DN);
    int acc = 0; for (int i = 0; i < NMAT; ++i) { t.item0[i] = acc; acc += (t.m[i].K / 64) * (t.m[i].Ndst / 64); } t.item0[NMAT] = acc;
    return t;
}
__device__ const MatTable g_mats = make_mats();

__host__ __device__ __forceinline__ int gqa_dim(int c) { const int wc = c >> 5, fq = (c >> 3) & 3, e = c & 7; return 64 * (wc >> 1) + 32 * (fq >> 1) + 16 * (wc & 1) + 8 * (fq & 1) + e; }
constexpr int P0_SCR = 64 * 65 * 4;
__device__ __forceinline__ void p0_transpose_item(const float* W, int K, int Nsrc, int kind, bf16_t* WT, LAS float* scr, int item, int Ndst, int lane) {
    const int nblk = Ndst / 64, kb = item / nblk, nb = item % nblk, k0 = 64 * kb, n0 = 64 * nb;
    int s0;
    if (kind == 1 || kind == 2) { const int pn = n0 >> 8, bj = (n0 >> 7) & 1, cc = n0 & 127; s0 = bj * FF + 128 * pn + cc; } else s0 = n0;
    int sl = s0 + lane;
    if (kind == 3) { const int n = n0 + lane; sl = (n < 1280) ? (n & ~127) + gqa_dim(n & 127) : n; }
    const bool ok = (kind >= 1) || (n0 + lane < Nsrc);
    const float* src = W + (size_t)k0 * Nsrc + sl;
    float tv[64];
#pragma unroll
    for (int kk = 0; kk < 64; ++kk) tv[kk] = ok ? src[(size_t)kk * Nsrc] : 0.f;
#pragma unroll
    for (int kk = 0; kk < 64; ++kk) scr[kk * 65 + lane] = tv[kk];
    asm volatile("s_waitcnt lgkmcnt(0)" ::: "memory");
    if (kind == 2) {
        const int c = lane & 3; unsigned char* WT8 = (unsigned char*)WT;
#pragma unroll
        for (int j = 0; j < 4; ++j) { const int n = (lane >> 2) + 16 * j; const LAS float* sp = scr + (16 * c) * 65 + n;
            u32x4 o; o.x = pk4_fp8(32.f * sp[0 * 65], 32.f * sp[1 * 65], 32.f * sp[2 * 65], 32.f * sp[3 * 65]); o.y = pk4_fp8(32.f * sp[4 * 65], 32.f * sp[5 * 65], 32.f * sp[6 * 65], 32.f * sp[7 * 65]);
            o.z = pk4_fp8(32.f * sp[8 * 65], 32.f * sp[9 * 65], 32.f * sp[10 * 65], 32.f * sp[11 * 65]); o.w = pk4_fp8(32.f * sp[12 * 65], 32.f * sp[13 * 65], 32.f * sp[14 * 65], 32.f * sp[15 * 65]);
            *(u32x4*)(WT8 + (size_t)(n0 + n) * K + k0 + 16 * c) = o; }
    } else {
    const int c = lane & 7;
#pragma unroll
    for (int j = 0; j < 8; ++j) { const int n = (lane >> 3) + 8 * j; const LAS float* sp = scr + (8 * c) * 65 + n;
        u32x4 o; o.x = pk2(sp[0 * 65], sp[1 * 65]); o.y = pk2(sp[2 * 65], sp[3 * 65]); o.z = pk2(sp[4 * 65], sp[5 * 65]); o.w = pk2(sp[6 * 65], sp[7 * 65]);
        *(u32x4*)(WT + (size_t)(n0 + n) * K + k0 + 8 * c) = o; }
    }
    asm volatile("s_waitcnt lgkmcnt(0)" ::: "memory");
}

__device__ __forceinline__ void p0_convert(Frame& F, int it0, int it1, int worker, int nworkers, int lane) {
    LAS float* scr = (LAS float*)(F.lds + F.wave * P0_SCR);
    for (int it = it0 + worker; it < it1; it += nworkers) {
        int mi = 0;
#pragma unroll 1
        for (int j = 1; j < NMAT; ++j) mi = (it >= g_mats.item0[j]) ? j : mi;
        const MatDesc d = g_mats.m[mi];
        p0_transpose_item(in_ptr(F, d.in_idx) + d.src_off, d.K, d.Nsrc, d.kind, (bf16_t*)(F.ws + d.dst), scr, it - g_mats.item0[mi], d.Ndst, lane);
    }
}
__device__ __forceinline__ int p0_split_item() { const int i0 = g_mats.item0[NMAT0], i1 = g_mats.item0[NMAT]; return i0 + (int)((long)(i1 - i0) * 0 / 100); }
__device__ __forceinline__ void p0_prologue(Frame& F) {
    const int lane = fresh_lane(), tid = F.wave * 64 + lane; (void)tid;
    const int gw = F.vcu * NWAVES + F.wave, NGW = F.G * NWAVES;
    p0_convert(F, 0, p0_split_item(), gw, NGW, lane);
    __syncthreads();
    {
        LAS float* cond = (LAS float*)F.lds;
        LAS float* part = (LAS float*)(F.lds + 65536);
        const float* cin = in_ptr(F, I_C); const float* cctx = in_ptr(F, I_CCTX);
        for (int i = tid; i < 9 * DM; i += 512) { const int r = i / DM, k = i % DM; const float v = (r < 8) ? cin[r * DM + k] : cctx[k]; cond[i] = silu_f(v); }
        __syncthreads();
        const float* mw = in_ptr(F, I_MODW); const float* mb = in_ptr(F, I_MODB);
        float* modt = (float*)(F.ws + WS_MOD);
        constexpr int NITEM = DEPTH * (6 * DM / 64);
        for (int it = F.vcu; it < NITEM; it += F.G) {
            const int l = it / 96, cb = it % 96, col = cb * 64 + lane;
            float a[9];
#pragma unroll
            for (int r = 0; r < 9; ++r) a[r] = 0.f;
            const float* wp = mw + ((size_t)l * DM + F.wave * 128) * (6 * DM) + col;
#pragma unroll 8
            for (int k = 0; k < 128; ++k) { const float w = wp[(size_t)k * (6 * DM)];
#pragma unroll
                for (int r = 0; r < 9; ++r) a[r] = fmaf(cond[r * DM + F.wave * 128 + k], w, a[r]); }
#pragma unroll
            for (int r = 0; r < 9; ++r) part[(F.wave * 9 + r) * 64 + lane] = a[r];
            __syncthreads();
            for (int i = tid; i < 9 * 64; i += 512) { const int r = i / 64, c = i % 64; float s = mb[(size_t)l * 6 * DM + cb * 64 + c];
#pragma unroll
                for (int w = 0; w < 8; ++w) s += part[(w * 9 + r) * 64 + c];
                modt[((size_t)l * 9 + r) * (6 * DM) + cb * 64 + c] = s; }
            __syncthreads();
        }
    }
    {
        float* rt = (float*)(F.ws + WS_ROPE);
        for (int i = gw * 64 + lane; i < 3 * 64 * 32; i += NGW * 64) { const int kind = i / 2048, pos = (i / 32) % 64, fi = i % 32; const int n = 16 << kind;
            if (fi < n / 2) { const float inv = exp2f(-(float)(2 * fi) / (float)n * 13.287712379549449f);
                const float ang = (float)pos * inv; float s, c;
                {
                  const float rev = ang * 0.15915494309189535f; const float fr = rev - floorf(rev); s = __builtin_amdgcn_sinf(fr); c = __builtin_amdgcn_cosf(fr); }
                rt[(size_t)i * 2] = c; rt[(size_t)i * 2 + 1] = s; } }
    }
    {
        const float* alb = in_ptr(F, I_A_LB); float* lb = (float*)(F.ws + WS_LB);
        for (int i = gw * 64 + lane; i < 2 * 1024; i += NGW * 64) { const int dir = i / 1024, w = i % 1024; float v[5], mx = -1e30f;
#pragma unroll
            for (int j = 0; j < 5; ++j) { v[j] = alb[((size_t)dir * 5 + j) * 1024 + w]; mx = fmaxf(mx, v[j]); }
            float s = 0.f;
#pragma unroll
            for (int j = 0; j < 5; ++j) s += expf(v[j] - mx);
            lb[i] = expf(v[0] - mx) / s; }
    }
}

struct RowPos { int b, p, modrow, prow, pcol; bool isctx; };
__device__ __forceinline__ RowPos row_pos(int m) { RowPos r; r.b = m / TPB; r.p = m % TPB; r.isctx = r.p < CTXL; r.modrow = r.isctx ? 8 : r.b; const int t = r.isctx ? 0 : r.p - CTXL; r.prow = t >> 6; r.pcol = t & 63; return r; }
__device__ __forceinline__ void ld_row(const float* p, int lane, f32x4 (&v)[4]) {
#pragma unroll
    for (int j = 0; j < 4; ++j) v[j] = *(const f32x4*)(p + 256 * j + 4 * lane);
}
__device__ __forceinline__ void ld_row_bf16(const bf16_t* p, int lane, f32x4 (&v)[4]) {
#pragma unroll
    for (int j = 0; j < 4; ++j) { const u32x2 w = *(const u32x2*)(p + 256 * j + 4 * lane); v[j] = (f32x4){bf2f(w.x & 0xffffu), bf2f(w.x >> 16), bf2f(w.y & 0xffffu), bf2f(w.y >> 16)}; }
}
__device__ __forceinline__ void st_row_bf16(bf16_t* p, int lane, const f32x4 (&v)[4]) {
#pragma unroll
    for (int j = 0; j < 4; ++j) { u32x2 w; w.x = pk2(v[j].x, v[j].y); w.y = pk2(v[j].z, v[j].w); *(u32x2*)(p + 256 * j + 4 * lane) = w; }
}
__device__ __forceinline__ float sumsq_row(const f32x4 (&v)[4]) { float s = 0.f;
#pragma unroll
    for (int j = 0; j < 4; ++j) s += (v[j].x * v[j].x + v[j].y * v[j].y) + (v[j].z * v[j].z + v[j].w * v[j].w);
    return wave_sum(s); }
__device__ __forceinline__ void norm_mod_store(const f32x4 (&x)[4], float rstd, const float* g, const float* shift, const float* scale, bf16_t* dst, int lane, f32x4 (&u)[4]) {
#pragma unroll
    for (int j = 0; j < 4; ++j) { const int c = 256 * j + 4 * lane; const f32x4 gg = *(const f32x4*)(g + c), sh = *(const f32x4*)(shift + c), sc = *(const f32x4*)(scale + c);
        u[j] = (x[j] * rstd * gg) * (sc + 1.0f) + sh;
        u32x2 w; w.x = pk2(u[j].x, u[j].y); w.y = pk2(u[j].z, u[j].w); *(u32x2*)(dst + c) = w; }
}

__device__ __forceinline__ void norm_mod_store_fp8(const f32x4 (&x)[4], float rstd, const float* g, const float* shift, const float* scale, unsigned char* dst, int lane, f32x4 (&u)[4]) {
#pragma unroll
    for (int j = 0; j < 4; ++j) { const int c = 256 * j + 4 * lane; const f32x4 gg = *(const f32x4*)(g + c), sh = *(const f32x4*)(shift + c), sc = *(const f32x4*)(scale + c);
        u[j] = (x[j] * rstd * gg) * (sc + 1.0f) + sh;
        *(unsigned*)(dst + c) = pk4_fp8(u[j].x, u[j].y, u[j].z, u[j].w); }
}
__device__ __forceinline__ void ld_y_row(const unsigned char* ws, int m, const RowPos& rp, int S, int lane, f32x4 (&yv)[4]) {
    if (rp.isctx) { const float* ys = (const float*)(ws + WS_YS) + (size_t)(rp.b * CTXL + rp.p) * DM;
        ld_row(ys, lane, yv);
        for (int s = 1; s < S; ++s) { f32x4 t[4]; ld_row(ys + (size_t)s * 2048 * DM, lane, t);
#pragma unroll
            for (int j = 0; j < 4; ++j) yv[j] = yv[j] + t[j]; } }
    else ld_row_bf16((const bf16_t*)(ws + WS_Y) + (size_t)m * DM, lane, yv);
}
__device__ __forceinline__ void ld_yp_row(const unsigned char* ws, size_t r, int RBM, int trb, int S, int lane, f32x4 (&v)[4]) {
    const int rb = (int)(r >> 8);
    if (rb >= RBM) { const float* ys = (const float*)(ws + WS_YS) + ((size_t)(rb - RBM) * 256 + (r & 255)) * DM;
        ld_row(ys, lane, v);
        for (int s = 1; s < S; ++s) { f32x4 t[4]; ld_row(ys + (size_t)s * trb * 256 * DM, lane, t);
#pragma unroll
            for (int j = 0; j < 4; ++j) v[j] = v[j] + t[j]; } }
    else ld_row_bf16((const bf16_t*)(ws + WS_YP) + r * DM, lane, v);
}
__device__ __forceinline__ float half_sum(float v) {
#pragma unroll
    for (int o = 1; o < 32; o <<= 1) v += __shfl_xor(v, o);
    return v;
}
__device__ __forceinline__ void ld_row2(const float* p, int l32, f32x4 (&v)[8]) {
#pragma unroll
    for (int j = 0; j < 8; ++j) v[j] = *(const f32x4*)(p + 128 * j + 4 * l32);
}
__device__ __forceinline__ void ld_row2_bf16(const bf16_t* p, int l32, f32x4 (&v)[8]) {
#pragma unroll
    for (int j = 0; j < 8; ++j) { const u32x2 w = *(const u32x2*)(p + 128 * j + 4 * l32); v[j] = (f32x4){bf2f(w.x & 0xffffu), bf2f(w.x >> 16), bf2f(w.y & 0xffffu), bf2f(w.y >> 16)}; }
}
__device__ __forceinline__ void st_row2_bf16(bf16_t* p, int l32, const f32x4 (&v)[8]) {
#pragma unroll
    for (int j = 0; j < 8; ++j) { u32x2 w; w.x = pk2(v[j].x, v[j].y); w.y = pk2(v[j].z, v[j].w); *(u32x2*)(p + 128 * j + 4 * l32) = w; }
}
__device__ __forceinline__ float sumsq_row2(const f32x4 (&v)[8]) { float s = 0.f;
#pragma unroll
    for (int j = 0; j < 8; ++j) s += (v[j].x * v[j].x + v[j].y * v[j].y) + (v[j].z * v[j].z + v[j].w * v[j].w);
    return half_sum(s); }
template <bool FP8>
__device__ __forceinline__ void norm_mod2(const f32x4 (&x)[8], float rstd, const LAS float* g, const LAS float* shift, const LAS float* scale, void* dst, int l32, bool st, f32x4 (&u)[8]) {
#pragma unroll
    for (int j = 0; j < 8; ++j) { if ((j & 3) == 0) __builtin_amdgcn_sched_barrier(0);
        const int c = 128 * j + 4 * l32; const f32x4 gg = *(const LAS f32x4*)(g + c), sh = *(const LAS f32x4*)(shift + c), sc = *(const LAS f32x4*)(scale + c);
        u[j] = (x[j] * rstd * gg) * (sc + 1.0f) + sh;
        if (st) { if (FP8) *(unsigned*)((unsigned char*)dst + c) = pk4_fp8(u[j].x, u[j].y, u[j].z, u[j].w);
                  else { u32x2 w; w.x = pk2(u[j].x, u[j].y); w.y = pk2(u[j].z, u[j].w); *(u32x2*)((bf16_t*)dst + c) = w; } } }
}
constexpr int PAR_FLOATS = 29 * DM;
__device__ __forceinline__ void fill_params(Frame& F, const float* ga, const float* gb, const float* m0, const float* m1, const float* m2, int tid) {
    LAS float* par = (LAS float*)F.lds;
    for (int i = tid; i < PAR_FLOATS / 4; i += NWAVES * 64) { const int v = i >> 8, c = (i & 255) * 4; const float* src;
        if (v == 0) src = ga; else if (v == 1) src = gb; else { const int r = (v - 2) / 3, k = (v - 2) % 3; src = (k == 0 ? m0 : k == 1 ? m1 : m2) + (size_t)r * (6 * DM); }
        *(LAS f32x4*)(par + v * DM + c) = *(const f32x4*)(src + c); }
    __syncthreads();
}
__device__ __forceinline__ void ld_y_row2(const unsigned char* ws, int m, const RowPos& rp, bool slab, int S, int l32, f32x4 (&yv)[8]) {
    if (slab) { const float* ys = (const float*)(ws + WS_YS) + (size_t)(rp.b * CTXL + rp.p) * DM;
        ld_row2(ys, l32, yv);
#pragma unroll 1
        for (int s = 1; s < S; ++s) { f32x4 t[8]; ld_row2(ys + (size_t)s * 2048 * DM, l32, t);
#pragma unroll
            for (int j = 0; j < 8; ++j) yv[j] = yv[j] + t[j]; } }
    else ld_row2_bf16((const bf16_t*)(ws + WS_Y) + (size_t)m * DM, l32, yv);
}
__device__ __forceinline__ void ld_yp_row2(const unsigned char* ws, size_t r, int RBM, int trb, int S, int l32, f32x4 (&v)[8]) {
    const int rb = (int)(r >> 8);
    if (rb >= RBM) { const float* ys = (const float*)(ws + WS_YS) + ((size_t)(rb - RBM) * 256 + (r & 255)) * DM;
        ld_row2(ys, l32, v);
#pragma unroll 1
        for (int s = 1; s < S; ++s) { f32x4 t[8]; ld_row2(ys + (size_t)s * trb * 256 * DM, l32, t);
#pragma unroll
            for (int j = 0; j < 8; ++j) v[j] = v[j] + t[j]; } }
    else ld_row2_bf16((const bf16_t*)(ws + WS_YP) + r * DM, l32, v);
}

__device__ __forceinline__ void phase_r0(Frame& F) {
    const int lane = fresh_lane(), l32 = lane & 31, half = lane >> 5;
    const int gw = F.vcu * NWAVES + F.wave, NGW = F.G * NWAVES;
    const float* x = in_ptr(F, I_X); const float* ctx = in_ptr(F, I_CTX); const float* ng = in_ptr(F, I_NORMG);
    bf16_t* h = (bf16_t*)(F.ws + WS_H); bf16_t* xa = (bf16_t*)(F.ws + WS_XA); const float* modt = (const float*)(F.ws + WS_MOD);
    fill_params(F, ng + (0 * 4 + 0) * DM, ng + (0 * 4 + 0) * DM, modt + 0 * DM, modt + 1 * DM, modt + 1 * DM, F.wave * 64 + lane);
    const LAS float* par = (const LAS float*)F.lds;
    for (int pi = gw; pi < T / 2; pi += NGW) { const int m = 2 * pi + half; const RowPos rp = row_pos(m);
        const float* src = rp.isctx ? ctx + ((size_t)rp.b * CTXL + rp.p) * DM : x + ((size_t)rp.b * SEQ + (rp.p - CTXL)) * DM;
        f32x4 v[8], u[8]; ld_row2(src, l32, v);
        st_row2_bf16(h + (size_t)m * DM, l32, v);
        const float rstd = rsqrtf(sumsq_row2(v) * (1.0f / DM) + NORM_EPS);
        const LAS float* pm = par + (2 + 3 * rp.modrow) * DM;
        norm_mod2<false>(v, rstd, par, pm + 0 * DM, pm + 1 * DM, xa + (size_t)m * DM, l32, true, u); }
    __syncthreads();
}

template <bool MOE>
__device__ __forceinline__ void phase_r1(Frame& F, int l) {
    const int lane = fresh_lane(), tid = F.wave * 64 + lane, l32 = lane & 31, half = lane >> 5;
    const float* ng = in_ptr(F, I_NORMG); const float* modt = (const float*)(F.ws + WS_MOD);
    bf16_t* h = (bf16_t*)(F.ws + WS_H); unsigned char* xa = (unsigned char*)(F.ws + WS_XA);
    const float* router = MOE ? in_ptr(F, I_MOE_ROUTER) + (size_t)(l >> 1) * DM * NEXP : nullptr;
    constexpr int LB = PAR_FLOATS * 4;
    LAS int* lcnt = (LAS int*)(F.lds + LB);
    LAS int* lbase = (LAS int*)(F.lds + LB + 64);
    LAS int* lrow = (LAS int*)(F.lds + LB + 1024);
    LAS float* lw = (LAS float*)(F.lds + LB + 4096);
    constexpr int RPW = T / 256;
    if (MOE) { if (tid < 8) lcnt[tid] = 0; }
    { const float* ml = modt + (size_t)l * 9 * (6 * DM); fill_params(F, ng + (l * 4 + 1) * DM, ng + (l * 4 + 2) * DM, ml + 2 * DM, ml + 3 * DM, ml + 4 * DM, tid); }
    const LAS float* par = (const LAS float*)F.lds;
    LAS f32x4* rtA = (LAS f32x4*)(F.lds + LB + 8192); LAS f32x4* rtB = rtA + 1024;
    if (MOE) { for (int c = tid; c < DM; c += NWAVES * 64) { const int slot = ((c & 3) * 8 + (c >> 7)) * 32 + ((c & 127) >> 2);
            rtA[slot] = *(const f32x4*)(router + (size_t)c * 8); rtB[slot] = *(const f32x4*)(router + (size_t)c * 8 + 4); }
        __syncthreads(); }
    const int row0 = F.vcu * RPW;
    f32x4 yn[8], hn[8];
    { const int m0 = row0 + 2 * F.wave + half; const RowPos r0 = row_pos(m0); ld_y_row2(F.ws, m0, r0, r0.isctx && !(l == DEPTH - 1), 8, l32, yn); ld_row2_bf16(h + (size_t)m0 * DM, l32, hn); }
    for (int i2 = F.wave; i2 < RPW / 2; i2 += NWAVES) { const int i = 2 * i2 + half, m = row0 + i; const RowPos rp = row_pos(m);
        const bool skip = (l == DEPTH - 1) && rp.isctx;
        const LAS float* pm = par + (2 + 3 * rp.modrow) * DM;
        f32x4 yv[8], hv[8], u[8];
#pragma unroll
        for (int j = 0; j < 8; ++j) { yv[j] = yn[j]; hv[j] = hn[j]; }
        if (i2 + NWAVES < RPW / 2) { const int mn = m + 2 * NWAVES; const RowPos rn = row_pos(mn); ld_y_row2(F.ws, mn, rn, rn.isctx && !(l == DEPTH - 1), 8, l32, yn); ld_row2_bf16(h + (size_t)mn * DM, l32, hn); }
        const float rstd_y = rsqrtf(sumsq_row2(yv) * (1.0f / DM) + NORM_EPS);
#pragma unroll
        for (int j = 0; j < 8; ++j) { if ((j & 3) == 0) __builtin_amdgcn_sched_barrier(0);
            const int c = 128 * j + 4 * l32; const f32x4 g1 = *(const LAS f32x4*)(par + c), gt = *(const LAS f32x4*)(pm + c);
            hv[j] = hv[j] + gt * (yv[j] * rstd_y * g1); }
        if (!skip) st_row2_bf16(h + (size_t)m * DM, l32, hv);
        const float rstd_h = rsqrtf(sumsq_row2(hv) * (1.0f / DM) + NORM_EPS);
        norm_mod2<true>(hv, rstd_h, par + DM, pm + 1 * DM, pm + 2 * DM, xa + (size_t)m * DM, l32, !skip, u);
        if (MOE) {
            float lg[8];
#pragma unroll
            for (int e = 0; e < 8; ++e) lg[e] = 0.f;
#pragma unroll
            for (int j = 0; j < 8; ++j) { __builtin_amdgcn_sched_barrier(0);
#pragma unroll
                for (int q = 0; q < 4; ++q) { const f32x4 r0 = rtA[(q * 8 + j) * 32 + l32], r1 = rtB[(q * 8 + j) * 32 + l32]; const float uv = u[j][q];
                    lg[0] = fmaf(uv, r0.x, lg[0]); lg[1] = fmaf(uv, r0.y, lg[1]); lg[2] = fmaf(uv, r0.z, lg[2]); lg[3] = fmaf(uv, r0.w, lg[3]);
                    lg[4] = fmaf(uv, r1.x, lg[4]); lg[5] = fmaf(uv, r1.y, lg[5]); lg[6] = fmaf(uv, r1.z, lg[6]); lg[7] = fmaf(uv, r1.w, lg[7]); } }
#pragma unroll
            for (int e = 0; e < 8; ++e) lg[e] = half_sum(lg[e]);
            int e1 = 0; float v1 = lg[0];
#pragma unroll
            for (int e = 1; e < 8; ++e) if (lg[e] > v1) { v1 = lg[e]; e1 = e; }
            int e2 = (e1 == 0) ? 1 : 0; float v2 = (e1 == 0) ? lg[1] : lg[0];
#pragma unroll
            for (int e = 1; e < 8; ++e) if (e != e1 && lg[e] > v2) { v2 = lg[e]; e2 = e; }
            const float w2 = fast_rcp(1.0f + expf(v1 - v2)), w1 = 1.0f - w2;
            if (l32 == 0) { if (skip) lrow[i * 4 + 0] = -1;
                else { lrow[i * 4 + 0] = e1; lrow[i * 4 + 2] = e2; lw[i * 2] = w1; lw[i * 2 + 1] = w2; } }
        }
    }
    if (MOE) {
        __syncthreads();
        if (tid < 8) { int c = 0; for (int i = 0; i < RPW; ++i) { const int a = lrow[i * 4], b = lrow[i * 4 + 2]; if (a < 0) continue; if (a == tid) lrow[i * 4 + 1] = c++; else if (b == tid) lrow[i * 4 + 3] = c++; }
            lcnt[tid] = c; ((int*)(F.ws + WS_WCNT))[F.vcu * 8 + tid] = c;
            __hip_atomic_fetch_add((int*)((unsigned*)F.ws + CW_MOECNT + (l >> 1) * 64) + tid, c, __ATOMIC_RELAXED, __HIP_MEMORY_SCOPE_AGENT); }
        __syncthreads();
        int* route = (int*)(F.ws + WS_ROUTE);
        for (int i = tid; i < RPW; i += 512) { const int m = row0 + i; const int e1 = lrow[i * 4], e2 = lrow[i * 4 + 2]; route[(size_t)m * 8 + 0] = e1; if (e1 < 0) continue;
            route[(size_t)m * 8 + 1] = lrow[i * 4 + 1]; route[(size_t)m * 8 + 2] = e2; route[(size_t)m * 8 + 3] = lrow[i * 4 + 3];
            ((float*)route)[(size_t)m * 8 + 4] = lw[i * 2]; ((float*)route)[(size_t)m * 8 + 5] = lw[i * 2 + 1]; }
        __syncthreads();
    }
}
__device__ __forceinline__ void moe_build(Frame& F) {
    const int lane = fresh_lane(), tid = F.wave * 64 + lane;
    LAS int* red = (LAS int*)F.lds;
    const int* wcnt = (const int*)(F.ws + WS_WCNT);
    { const int e = tid & 7; int sacc = 0; for (int v = tid >> 3; v < F.vcu; v += 64) sacc += wcnt[v * 8 + e]; red[tid] = sacc; }
    __syncthreads();
    if (tid < 8) { int sacc = 0; for (int k = 0; k < 64; ++k) sacc += red[k * 8 + tid]; red[512 + tid] = sacc; }
    __syncthreads();
    constexpr int RPW = T / 256; const int row0 = F.vcu * RPW;
    int* list = (int*)(F.ws + WS_LIST); int* route = (int*)(F.ws + WS_ROUTE);
    for (int i = tid; i < RPW; i += 512) { const int m = row0 + i; const int e1 = route[(size_t)m * 8]; if (e1 < 0) continue; const int e2 = route[(size_t)m * 8 + 2];
        const int s1 = red[512 + e1] + route[(size_t)m * 8 + 1], s2 = red[512 + e2] + route[(size_t)m * 8 + 3];
        list[(size_t)e1 * T + s1] = m; list[(size_t)e2 * T + s2] = m; route[(size_t)m * 8 + 1] = s1; route[(size_t)m * 8 + 3] = s2; }
}

__device__ __forceinline__ void moe_tables(Frame& F, int l) {
    const int lane = fresh_lane(), tid = F.wave * 64 + lane; (void)tid;
    if (tid == 0) { const int* gcnt = (const int*)((unsigned*)F.ws + CW_MOECNT + (l >> 1) * 64); int acc = 0;
        for (int e = 0; e < 8; ++e) { const int c = __hip_atomic_load(gcnt + e, __ATOMIC_RELAXED, __HIP_MEMORY_SCOPE_AGENT); F.MISC[32 + e] = (unsigned)c; F.MISC[16 + e] = (unsigned)acc; acc += (c + 255) / 256; }
        F.MISC[24] = (unsigned)acc; }
    __syncthreads();
}

template <bool MOE>
__device__ __forceinline__ void phase_r2(Frame& F, int l) {
    const int lane = fresh_lane(), l32 = lane & 31, half = lane >> 5;
    const int gw = F.vcu * NWAVES + F.wave, NGW = F.G * NWAVES;
    const float* ng = in_ptr(F, I_NORMG); const float* modt = (const float*)(F.ws + WS_MOD);
    bf16_t* h = (bf16_t*)(F.ws + WS_H); bf16_t* xa = (bf16_t*)(F.ws + WS_XA);
    const int* route = (const int*)(F.ws + WS_ROUTE);
    int RBM = 0, trb = 0, S = 1; if (MOE) pg8::moe_tail_params((int)F.MISC[24], RBM, trb, S);
    { const int ln = (l < DEPTH - 1) ? l + 1 : l; const float* ml = modt + (size_t)l * 9 * (6 * DM); const float* mn = modt + (size_t)ln * 9 * (6 * DM);
      fill_params(F, ng + (l * 4 + 3) * DM, ng + (ln * 4 + 0) * DM, ml + 5 * DM, mn + 0 * DM, mn + 1 * DM, F.wave * 64 + lane); }
    const LAS float* par = (const LAS float*)F.lds;
    f32x4 an[8], bn[8], hn[8]; float w1n = 0.f, w2n = 0.f;
#define R2_LOAD(mm) do { const RowPos _r = row_pos(mm); const bool _sk = (l == DEPTH - 1) && _r.isctx; \
        if (MOE) { int e1 = 0, s1 = 0, e2 = 0, s2 = 0; w1n = 0.f; w2n = 0.f; \
            if (!_sk) { e1 = route[(size_t)(mm) * 8]; s1 = route[(size_t)(mm) * 8 + 1]; e2 = route[(size_t)(mm) * 8 + 2]; s2 = route[(size_t)(mm) * 8 + 3]; w1n = ((const float*)route)[(size_t)(mm) * 8 + 4]; w2n = ((const float*)route)[(size_t)(mm) * 8 + 5]; } \
            const size_t r1 = (size_t)F.MISC[16 + e1] * 256 + s1, r2 = (size_t)F.MISC[16 + e2] * 256 + s2; \
            ld_yp_row2(F.ws, r1, RBM, trb, S, l32, an); ld_yp_row2(F.ws, r2, RBM, trb, S, l32, bn); } \
        else ld_y_row2(F.ws, (mm), _r, _r.isctx, 4, l32, an); \
        ld_row2_bf16(h + (size_t)(mm) * DM, l32, hn); } while (0)
    if (gw < T / 2) R2_LOAD(2 * gw + half);
    for (int pi = gw; pi < T / 2; pi += NGW) { const int m = 2 * pi + half; const RowPos rp = row_pos(m);
        const bool skip = (l == DEPTH - 1) && rp.isctx;
        const LAS float* pm = par + (2 + 3 * rp.modrow) * DM;
        f32x4 yv[8], hv[8], u[8];
#pragma unroll
        for (int j = 0; j < 8; ++j) { yv[j] = MOE ? (an[j] * w1n + bn[j] * w2n) : an[j]; hv[j] = hn[j]; }
        if (pi + NGW < T / 2) R2_LOAD(m + 2 * NGW);
        const float rstd_y = rsqrtf(sumsq_row2(yv) * (1.0f / DM) + NORM_EPS);
#pragma unroll
        for (int j = 0; j < 8; ++j) { if ((j & 3) == 0) __builtin_amdgcn_sched_barrier(0);
            const int c = 128 * j + 4 * l32; const f32x4 g3 = *(const LAS f32x4*)(par + c), gt = *(const LAS f32x4*)(pm + c);
            hv[j] = hv[j] + gt * (yv[j] * rstd_y * g3); }
        if (l == DEPTH - 1) { if (!skip) { float* dsto = out_ptr() + ((size_t)rp.b * SEQ + (rp.p - CTXL)) * DM;
#pragma unroll
                for (int j = 0; j < 8; ++j) *(f32x4*)(dsto + 128 * j + 4 * l32) = hv[j]; } }
        else st_row2_bf16(h + (size_t)m * DM, l32, hv);
        if (l < DEPTH - 1) { const float rstd_h = rsqrtf(sumsq_row2(hv) * (1.0f / DM) + NORM_EPS);
            norm_mod2<false>(hv, rstd_h, par + DM, pm + 1 * DM, pm + 2 * DM, xa + (size_t)m * DM, l32, true, u); }
    }
}
namespace scan {
constexpr int A_STR = 272, T_STR = 80;
constexpr int A1_OFF = 0, A2_OFF = 32 * A_STR, K2T_OFF = 2 * 32 * A_STR, VT_OFF = K2T_OFF + 128 * T_STR, DEC_OFF = VT_OFF + 128 * T_STR, BUF_BYTES = DEC_OFF + 512;
constexpr int NCH = TPB / 32;
__device__ __forceinline__ int crow(int r, int hi) { return (r & 3) + 8 * (r >> 2) + 4 * hi; }
__device__ __forceinline__ int tok_of(int p, int dir) { return dir == 0 ? p : (p < CTXL ? (CTXL - 1 - p) : (TPB + CTXL - 1 - p)); }

__device__ __forceinline__ int chunk_lowtok(int n, int dir) { return dir == 0 ? 32 * n : (n < CTXL / 32 ? CTXL - 32 - 32 * n : TPB + CTXL - 32 - 32 * n); }
constexpr int RAW_OFF = 2 * BUF_BYTES, RAW_BYTES = 3 * 8192;
__device__ __forceinline__ void prep_dma(const bf16_t* __restrict__ z, int b, int hd, int dir, int n, LAS unsigned char* raw, int pw, int lane) {
    const char* U = (const char*)(z + (size_t)(b * TPB + chunk_lowtok(n, dir)) * A_IN + hd * 128);
#pragma unroll
    for (int k = 0; k < 2; ++k) { const int c = 8 * pw + 4 * k + (lane >> 4), mr = dir ? 31 - c : c; const unsigned L = (unsigned)(mr * A_IN + (lane & 15) * 8) * 2u;
        __builtin_amdgcn_global_load_lds((const unsigned*)(U + L), (LAS unsigned*)(raw + 0 * 8192 + (2 * pw + k) * 1024), 16, 0, 0);
        __builtin_amdgcn_global_load_lds((const unsigned*)(U + 2048 * (1 + dir) + L), (LAS unsigned*)(raw + 1 * 8192 + (2 * pw + k) * 1024), 16, 0, 0);
        __builtin_amdgcn_global_load_lds((const unsigned*)(U + 6144 + L), (LAS unsigned*)(raw + 2 * 8192 + (2 * pw + k) * 1024), 16, 0, 0); }
}
struct Raw { unsigned short q[16], f[16], v[16]; };
__device__ __forceinline__ void prep_read(Raw& r, const LAS unsigned char* raw, int d, int rh) {
#pragma unroll
    for (int i = 0; i < 16; ++i) { const int o = (16 * rh + i) * 256 + d * 2;
        r.q[i] = *(const LAS unsigned short*)(raw + o); r.f[i] = *(const LAS unsigned short*)(raw + 8192 + o); r.v[i] = *(const LAS unsigned short*)(raw + 16384 + o); }
}
__device__ __forceinline__ void prep_compute(const Raw& r, float lbv, LAS unsigned char* buf, int d, int rh, int lane) {
    float cum[16], kk[16]; float run = 0.f;
#pragma unroll
    for (int i = 0; i < 16; ++i) { const float s = fast_rcp(1.0f + __builtin_amdgcn_exp2f(bf2f(r.f[i]) * -1.4426950408889634f)); const float f = lbv + (1.0f - lbv) * s; kk[i] = 1.0f - f; run += __builtin_amdgcn_logf(f); cum[i] = run; }
    const float tot_lo = __shfl(run, lane & 31);
    if (rh) {
#pragma unroll
        for (int i = 0; i < 16; ++i) cum[i] += tot_lo; }
    const float cend = __shfl(cum[15], (lane & 31) + 32);
    const float dec = __builtin_amdgcn_exp2f(cend);
    unsigned short a1[16], a2[16], k2[16];
#pragma unroll
    for (int i = 0; i < 16; ++i) { const float e1 = __builtin_amdgcn_exp2f(cum[i]), e2 = __builtin_amdgcn_exp2f(-cum[i]); const float A2 = kk[i] * e2;
        const unsigned w12 = cvt_pk_bf16(bf2f(r.q[i]) * 0.08838834764831845f * e1, A2);
        a1[i] = (unsigned short)(w12 & 0xffffu); a2[i] = (unsigned short)(w12 >> 16); k2[i] = (unsigned short)(cvt_pk_bf16(A2 * dec, 0.f) & 0xffffu); }
#pragma unroll
    for (int i = 0; i < 16; ++i) { const int c = 16 * rh + i;
        *(LAS unsigned short*)(buf + A1_OFF + c * A_STR + d * 2) = a1[i]; *(LAS unsigned short*)(buf + A2_OFF + c * A_STR + d * 2) = a2[i]; }
#pragma unroll
    for (int i = 0; i < 16; i += 2) { const int c = 16 * rh + i;
        *(LAS unsigned*)(buf + K2T_OFF + d * T_STR + c * 2) = (unsigned)k2[i] | ((unsigned)k2[i + 1] << 16);
        *(LAS unsigned*)(buf + VT_OFF + d * T_STR + c * 2) = (unsigned)r.v[i] | ((unsigned)r.v[i + 1] << 16); }
    if (rh == 0) *(LAS float*)(buf + DEC_OFF + d * 4) = dec;
}
#define SCAN_BAR() do { asm volatile("s_waitcnt lgkmcnt(0)" ::: "memory"); __builtin_amdgcn_s_barrier(); asm volatile("" ::: "memory"); } while (0)

__device__ __forceinline__ bf16x8 cvt8(const f32x16& x, int base) {
    u32x4 w; w.x = cvt_pk_bf16(x[base + 0], x[base + 1]); w.y = cvt_pk_bf16(x[base + 2], x[base + 3]); w.z = cvt_pk_bf16(x[base + 4], x[base + 5]); w.w = cvt_pk_bf16(x[base + 6], x[base + 7]);
    return *reinterpret_cast<bf16x8*>(&w);
}
__device__ __forceinline__ bf16x8 ld44(const LAS unsigned char* p) {
    const u32x2 a = *(const LAS u32x2*)p, b = *(const LAS u32x2*)(p + 16); u32x4 w = {a.x, a.y, b.x, b.y}; return *reinterpret_cast<bf16x8*>(&w);
}

__device__ __forceinline__ void scan_unit(unsigned char* ws, LAS unsigned char* lds, int unit, int wave, int lane, int tid) {
    static_assert(NCH % 2 == 0, "even chunk count");
    const int b = unit >> 4, hd = (unit >> 1) & 7, dir = unit & 1;
    const bf16_t* z = (const bf16_t*)(ws + WS_Z);
    bf16_t* od = (bf16_t*)(ws + WS_O) + (size_t)dir * T * DM;
    const float* lb = (const float*)(ws + WS_LB) + dir * 1024 + hd * 128;
    const int r32 = lane & 31, hi = lane >> 5;
    if (wave >= 4) {
        const int pw = wave - 4, d = 32 * pw + r32, rh = hi; const float lbv = lb[d];
        asm volatile("s_waitcnt vmcnt(0)" ::: "memory");
        LAS unsigned char* rawb = lds + RAW_OFF; Raw R;
        prep_dma(z, b, hd, dir, 0, rawb, pw, lane); prep_dma(z, b, hd, dir, 1, rawb + RAW_BYTES, pw, lane);
        asm volatile("s_waitcnt vmcnt(6)" ::: "memory"); SCAN_BAR();
        int st = 0;
        for (int n = -1; n < NCH - 1; ++n) {
            prep_read(R, rawb + st * RAW_BYTES, d, rh); prep_compute(R, lbv, lds + ((n + 1) & 1) * BUF_BYTES, d, rh, lane);
            const int st3 = (st == 0) ? 2 : st - 1;
            if (n + 3 < NCH) { prep_dma(z, b, hd, dir, n + 3, rawb + st3 * RAW_BYTES, pw, lane); asm volatile("s_waitcnt vmcnt(6)" ::: "memory"); }
            else asm volatile("s_waitcnt vmcnt(0)" ::: "memory");
            SCAN_BAR();
            st = (st == 2) ? 0 : st + 1;
        }
        SCAN_BAR();
    } else {
        const int sw = wave;
        f32x16 S[4];
#pragma unroll
        for (int t = 0; t < 4; ++t) S[t] = f32x16{};
        SCAN_BAR(); SCAN_BAR();
        for (int n = 0; n < NCH; ++n) {
            const LAS unsigned char* buf = lds + (n & 1) * BUF_BYTES;
            f32x16 X = f32x16{}, Xb = f32x16{};
#pragma unroll
            for (int ks = 0; ks < 8; ++ks) { const bf16x8 a = *(const LAS bf16x8*)(buf + A2_OFF + r32 * A_STR + (16 * ks + 8 * hi) * 2), bb = *(const LAS bf16x8*)(buf + A1_OFF + r32 * A_STR + (16 * ks + 8 * hi) * 2);
                if (ks & 1) Xb = __builtin_amdgcn_mfma_f32_32x32x16_bf16(a, bb, Xb, 0, 0, 0); else X = __builtin_amdgcn_mfma_f32_32x32x16_bf16(a, bb, X, 0, 0, 0); }
#pragma unroll
            for (int r = 0; r < 16; ++r) X[r] = (crow(r, hi) <= r32) ? X[r] + Xb[r] : 0.f;
            f32x16 O = f32x16{};
#pragma unroll
            for (int s0 = 0; s0 < 2; ++s0) { const bf16x8 a = cvt8(X, 8 * s0); const bf16x8 bb = ld44(buf + VT_OFF + (32 * sw + r32) * T_STR + (16 * s0 + 4 * hi) * 2);
                O = __builtin_amdgcn_mfma_f32_32x32x16_bf16(a, bb, O, 0, 0, 0); }
            f32x16 O2 = f32x16{}, O3 = f32x16{};
#pragma unroll
            for (int t = 0; t < 4; ++t)
#pragma unroll
                for (int s0 = 0; s0 < 2; ++s0) { const bf16x8 a = ld44(buf + A1_OFF + r32 * A_STR + (32 * t + 16 * s0 + 4 * hi) * 2); const bf16x8 bb = cvt8(S[t], 8 * s0);
                    if (t & 1) O3 = __builtin_amdgcn_mfma_f32_32x32x16_bf16(a, bb, O3, 0, 0, 0); else O2 = __builtin_amdgcn_mfma_f32_32x32x16_bf16(a, bb, O2, 0, 0, 0); }
#pragma unroll
            for (int r = 0; r < 16; ++r) O[r] += O2[r] + O3[r];
#pragma unroll
            for (int r = 0; r < 16; ++r) { const int p = 32 * n + crow(r, hi); od[(size_t)(b * TPB + tok_of(p, dir)) * DM + hd * 128 + 32 * sw + r32] = (bf16_t)f2bf(O[r]); }
#pragma unroll
            for (int t = 0; t < 4; ++t) {
#pragma unroll
                for (int g4 = 0; g4 < 4; ++g4) { const f32x4 dc = *(const LAS f32x4*)(buf + DEC_OFF + (32 * t + 8 * g4 + 4 * hi) * 4);
                    S[t][4 * g4 + 0] *= dc.x; S[t][4 * g4 + 1] *= dc.y; S[t][4 * g4 + 2] *= dc.z; S[t][4 * g4 + 3] *= dc.w; }
#pragma unroll
                for (int s0 = 0; s0 < 2; ++s0) { const bf16x8 a = *(const LAS bf16x8*)(buf + K2T_OFF + (32 * t + r32) * T_STR + (16 * s0 + 8 * hi) * 2), bb = *(const LAS bf16x8*)(buf + VT_OFF + (32 * sw + r32) * T_STR + (16 * s0 + 8 * hi) * 2);
                    S[t] = __builtin_amdgcn_mfma_f32_32x32x16_bf16(a, bb, S[t], 0, 0, 0); }
            }
            SCAN_BAR();
        }
    }
}
}

__device__ __forceinline__ void phase_a_readout(Frame& F) {
    const int lane = fresh_lane(), l32 = lane & 31, hh = lane >> 5;
    const int gw = F.vcu * NWAVES + F.wave, NGW = F.G * NWAVES;
    const bf16_t* of = (const bf16_t*)(F.ws + WS_O); const bf16_t* ob = of + (size_t)T * DM; const bf16_t* z = (const bf16_t*)(F.ws + WS_Z); bf16_t* xa = (bf16_t*)(F.ws + WS_XA);
    const f32x4 g = *(const f32x4*)(in_ptr(F, I_A_ONORM) + 4 * l32);
    for (int m = gw; m < T; m += NGW) {
        u32x2 a[4], bb[4], gt[4];
#pragma unroll
        for (int it = 0; it < 4; ++it) { const int c = (2 * it + hh) * 128 + 4 * l32;
            a[it] = *(const u32x2*)(of + (size_t)m * DM + c); bb[it] = *(const u32x2*)(ob + (size_t)m * DM + c); gt[it] = *(const u32x2*)(z + (size_t)m * A_IN + 4096 + c); }
#pragma unroll
        for (int it = 0; it < 4; ++it) { const int c = (2 * it + hh) * 128 + 4 * l32;
            const float o0 = bf2f(a[it].x & 0xffffu) + bf2f(bb[it].x & 0xffffu), o1 = bf2f(a[it].x >> 16) + bf2f(bb[it].x >> 16), o2 = bf2f(a[it].y & 0xffffu) + bf2f(bb[it].y & 0xffffu), o3 = bf2f(a[it].y >> 16) + bf2f(bb[it].y >> 16);
            const float rstd = rsqrtf(half_sum((o0 * o0 + o1 * o1) + (o2 * o2 + o3 * o3)) * (1.0f / 128.0f) + NORM_EPS);
            u32x2 w; w.x = pk2(o0 * rstd * g.x * silu_f(bf2f(gt[it].x & 0xffffu)), o1 * rstd * g.y * silu_f(bf2f(gt[it].x >> 16)));
            w.y = pk2(o2 * rstd * g.z * silu_f(bf2f(gt[it].y & 0xffffu)), o3 * rstd * g.w * silu_f(bf2f(gt[it].y >> 16)));
            *(u32x2*)(xa + (size_t)m * DM + c) = w; }
    }
}

__device__ __forceinline__ f32x2 rope_cs(const float* rt, int kind, int pos, int fi) { return *(const f32x2*)(rt + (((size_t)kind * 64 + pos) * 32 + fi) * 2); }

__device__ __forceinline__ void phase_b_row1(Frame& F) {
    const int lane = fresh_lane();
    const int gw = F.vcu * NWAVES + F.wave, NGW = F.G * NWAVES;
    const bf16_t* z = (const bf16_t*)(F.ws + WS_Z); bf16_t* cq = (bf16_t*)(F.ws + WS_O); bf16_t* ckv = cq + (size_t)T * 384; bf16_t* Kb = (bf16_t*)(F.ws + WS_K);
    const float* qg = in_ptr(F, I_B_QNORM); const float* kg = in_ptr(F, I_B_KVNORM); const float* rt = (const float*)(F.ws + WS_ROPE);
    const int ip = lane & 15, hg = lane >> 4;
    f32x2 qgv[3];
#pragma unroll
    for (int j = 0; j < 3; ++j) qgv[j] = *(const f32x2*)(qg + 128 * j + 2 * lane);
    const f32x4 kgv = *(const f32x4*)(kg + 4 * lane);
    for (int m = gw; m < T; m += NGW) { const RowPos rp = row_pos(m); const bf16_t* zr = z + (size_t)m * B_INP;
        float q[6]; float sq = 0.f;
#pragma unroll
        for (int j = 0; j < 3; ++j) { const unsigned w = *(const unsigned*)(zr + 128 * j + 2 * lane); q[2 * j] = bf2f(w & 0xffffu); q[2 * j + 1] = bf2f(w >> 16); sq += q[2 * j] * q[2 * j] + q[2 * j + 1] * q[2 * j + 1]; }
        const u32x2 kw = *(const u32x2*)(zr + 384 + 4 * lane); const float k0 = bf2f(kw.x & 0xffffu), k1 = bf2f(kw.x >> 16), k2 = bf2f(kw.y & 0xffffu), k3 = bf2f(kw.y >> 16);
        const float skv = (k0 * k0 + k1 * k1) + (k2 * k2 + k3 * k3);
        const float rq = rsqrtf(wave_sum(sq) * (1.0f / 384.0f) + NORM_EPS), rkv = rsqrtf(wave_sum(skv) * (1.0f / 256.0f) + NORM_EPS);
#pragma unroll
        for (int j = 0; j < 3; ++j) { const f32x2 g = qgv[j]; *(unsigned*)(cq + (size_t)m * 384 + 128 * j + 2 * lane) = pk2(q[2 * j] * rq * g.x, q[2 * j + 1] * rq * g.y); }
        { const f32x4 g = kgv; u32x2 w; w.x = pk2(k0 * rkv * g.x, k1 * rkv * g.y); w.y = pk2(k2 * rkv * g.z, k3 * rkv * g.w); *(u32x2*)(ckv + (size_t)m * 256 + 4 * lane) = w; }
        const unsigned rw = *(const unsigned*)(zr + 640 + 2 * ip); float x0 = bf2f(rw & 0xffffu), x1 = bf2f(rw >> 16);
        const float p0 = __shfl_xor(x0, 4), p1 = __shfl_xor(x1, 4);
        if (!rp.isctx) { const int pos = (ip < 8) ? rp.prow : rp.pcol; const f32x2 c0 = rope_cs(rt, 0, pos, (2 * ip) & 7), c1 = rope_cs(rt, 0, pos, (2 * ip + 1) & 7);
            if (ip & 4) { x0 = x0 * c0.x + p0 * c0.y; x1 = x1 * c1.x + p1 * c1.y; } else { x0 = x0 * c0.x - p0 * c0.y; x1 = x1 * c1.x - p1 * c1.y; } }
        const unsigned kb = pk2(x0, x1);
#pragma unroll
        for (int hh = 0; hh < 4; ++hh) { const int hd = 4 * hh + hg; *(unsigned*)(Kb + ((size_t)(rp.b * 16 + hd) * TPB + rp.p) * 96 + 64 + 2 * ip) = kb; }
    }
}
__device__ __forceinline__ void phase_b_row2(Frame& F) {
    const int lane = fresh_lane();
    const int gw = F.vcu * NWAVES + F.wave, NGW = F.G * NWAVES;
    bf16_t* Qb = (bf16_t*)(F.ws + WS_Q); const float* rt = (const float*)(F.ws + WS_ROPE);
    const int ip = lane & 15, hg = lane >> 4;
    for (int m = gw; m < T; m += NGW) { const RowPos rp = row_pos(m); if (rp.isctx) continue;
        const int pos = (ip < 8) ? rp.prow : rp.pcol; const f32x2 c0 = rope_cs(rt, 0, pos, (2 * ip) & 7), c1 = rope_cs(rt, 0, pos, (2 * ip + 1) & 7);
        unsigned w[4];
#pragma unroll
        for (int hh = 0; hh < 4; ++hh) w[hh] = *(const unsigned*)(Qb + (size_t)m * 1536 + (4 * hh + hg) * 96 + 64 + 2 * ip);
#pragma unroll
        for (int hh = 0; hh < 4; ++hh) { float x0 = bf2f(w[hh] & 0xffffu), x1 = bf2f(w[hh] >> 16); const float p0 = __shfl_xor(x0, 4), p1 = __shfl_xor(x1, 4);
            if (ip & 4) { x0 = x0 * c0.x + p0 * c0.y; x1 = x1 * c1.x + p1 * c1.y; } else { x0 = x0 * c0.x - p0 * c0.y; x1 = x1 * c1.x - p1 * c1.y; }
            *(unsigned*)(Qb + (size_t)m * 1536 + (4 * hh + hg) * 96 + 64 + 2 * ip) = pk2(x0, x1); }
    }
}
__device__ __forceinline__ void phase_c_row(Frame& F) {
    const int lane = fresh_lane();
    const int gw = F.vcu * NWAVES + F.wave, NGW = F.G * NWAVES;
    const bf16_t* z = (const bf16_t*)(F.ws + WS_Z); bf16_t* Qb = (bf16_t*)(F.ws + WS_Q); bf16_t* Kb = (bf16_t*)(F.ws + WS_K); bf16_t* Vb = (bf16_t*)(F.ws + WS_V);
    const float* qg = in_ptr(F, I_C_QNORM); const float* kg = in_ptr(F, I_C_KNORM); const float* rt = (const float*)(F.ws + WS_ROPE);
    const f32x2 qgv = *(const f32x2*)(qg + 2 * lane), kgv = *(const f32x2*)(kg + 2 * lane);
    const bool up = (lane & 16) != 0;
    for (int m = gw; m < T; m += NGW) { const RowPos rp = row_pos(m); const bf16_t* zr = z + (size_t)m * C_IN;
        f32x2 c0 = (f32x2){1.f, 0.f}, c1 = (f32x2){1.f, 0.f};
        if (!rp.isctx) { const int pos = (lane < 32) ? rp.prow : rp.pcol; c0 = rope_cs(rt, 2, pos, (2 * lane) & 31); c1 = rope_cs(rt, 2, pos, (2 * lane + 1) & 31); }
        unsigned w[10];
#pragma unroll
        for (int hv = 0; hv < 10; ++hv) w[hv] = *(const unsigned*)(zr + hv * 128 + 2 * lane);
#pragma unroll
        for (int hv = 0; hv < 10; ++hv) { float a = bf2f(w[hv] & 0xffffu), bq = bf2f(w[hv] >> 16);
            const float rstd = rsqrtf(wave_sum(a * a + bq * bq) * (1.0f / 128.0f) + NORM_EPS);
            a *= rstd * (hv < 8 ? qgv.x : kgv.x); bq *= rstd * (hv < 8 ? qgv.y : kgv.y);
            const float ap = __shfl_xor(a, 16), bp = __shfl_xor(bq, 16);
            const float ar = up ? (a * c0.x + ap * c0.y) : (a * c0.x - ap * c0.y), br = up ? (bq * c1.x + bp * c1.y) : (bq * c1.x - bp * c1.y);
            bf16_t* dst = (hv < 8) ? Qb + (size_t)m * 1024 + hv * 128 : Kb + (size_t)m * 256 + (hv - 8) * 128;
            *(unsigned*)(dst + 2 * lane) = pk2(ar, br); }
        *(u32x2*)(Vb + (size_t)m * 256 + 4 * lane) = *(const u32x2*)(zr + 1280 + 4 * lane);
    }
}
__device__ __forceinline__ void phase_d_row1(Frame& F) {
    const int lane = fresh_lane();
    const int gw = F.vcu * NWAVES + F.wave, NGW = F.G * NWAVES;
    const bf16_t* z = (const bf16_t*)(F.ws + WS_Z); bf16_t* Qb = (bf16_t*)(F.ws + WS_Q); bf16_t* Kb = (bf16_t*)(F.ws + WS_K); bf16_t* Vb = (bf16_t*)(F.ws + WS_V);
    const float* rt = (const float*)(F.ws + WS_ROPE);
    const int lp = lane & 31; const bool up = (lane & 8) != 0;
    for (int m = gw; m < T; m += NGW) { const RowPos rp = row_pos(m); const bf16_t* zr = z + (size_t)m * D_IN;
        f32x2 c0 = (f32x2){1.f, 0.f}, c1 = (f32x2){1.f, 0.f};
        if (!rp.isctx) { const int pos = (lp < 16) ? rp.prow : rp.pcol; c0 = rope_cs(rt, 1, pos, (2 * lp) & 15); c1 = rope_cs(rt, 1, pos, (2 * lp + 1) & 15); }
        unsigned w[16];
#pragma unroll
        for (int i = 0; i < 16; ++i) w[i] = *(const unsigned*)(zr + 128 * i + 2 * lane);
#pragma unroll
        for (int i = 0; i < 16; ++i) { const float a = bf2f(w[i] & 0xffffu), bq = bf2f(w[i] >> 16); const float ap = __shfl_xor(a, 8), bp = __shfl_xor(bq, 8);
            const float ar = up ? (a * c0.x + ap * c0.y) : (a * c0.x - ap * c0.y), br = up ? (bq * c1.x + bp * c1.y) : (bq * c1.x - bp * c1.y);
            bf16_t* dst = (i < 8) ? Qb + (size_t)m * 1024 + 128 * i : Kb + (size_t)m * 1024 + 128 * (i - 8); *(unsigned*)(dst + 2 * lane) = pk2(ar, br); }
        { const u32x4 a = *(const u32x4*)(zr + 2048 + 16 * lane), bq = *(const u32x4*)(zr + 2048 + 16 * lane + 8); *(u32x4*)(Vb + (size_t)m * 1024 + 16 * lane) = a; *(u32x4*)(Vb + (size_t)m * 1024 + 16 * lane + 8) = bq; }
    }
}
__device__ __forceinline__ void phase_d_row2(Frame& F) {
    const int lane = fresh_lane(), l32 = lane & 31, hh = lane >> 5;
    const int gw = F.vcu * NWAVES + F.wave, NGW = F.G * NWAVES;
    const bf16_t* A = (const bf16_t*)(F.ws + WS_O); bf16_t* xa = (bf16_t*)(F.ws + WS_XA);
    const float* lam = in_ptr(F, I_D_LAMBDA);
    const float lambda_init = 0.8f - 0.6f * 0.40656965974059917f;
    const float s1 = wave_sum(lam[lane] * lam[64 + lane]), s2 = wave_sum(lam[128 + lane] * lam[192 + lane]);
    const float lam_full = expf(s1) - expf(s2) + lambda_init;
    const f32x4 g = *(const f32x4*)(in_ptr(F, I_D_ONORM) + 4 * l32) * (1.0f - lambda_init);
    for (int m = gw; m < T; m += NGW) { if ((m % TPB) < CTXL) continue;
        u32x2 a[4], bb[4];
#pragma unroll
        for (int it = 0; it < 4; ++it) { const int hd = 2 * it + hh; a[it] = *(const u32x2*)(A + (size_t)m * 2048 + (2 * hd) * 128 + 4 * l32); bb[it] = *(const u32x2*)(A + (size_t)m * 2048 + (2 * hd + 1) * 128 + 4 * l32); }
#pragma unroll
        for (int it = 0; it < 4; ++it) { const int hd = 2 * it + hh;
            const float o0 = bf2f(a[it].x & 0xffffu) - lam_full * bf2f(bb[it].x & 0xffffu), o1 = bf2f(a[it].x >> 16) - lam_full * bf2f(bb[it].x >> 16);
            const float o2 = bf2f(a[it].y & 0xffffu) - lam_full * bf2f(bb[it].y & 0xffffu), o3 = bf2f(a[it].y >> 16) - lam_full * bf2f(bb[it].y >> 16);
            const float rstd = rsqrtf(half_sum((o0 * o0 + o1 * o1) + (o2 * o2 + o3 * o3)) * (1.0f / 128.0f) + NORM_EPS);
            u32x2 w; w.x = pk2(o0 * rstd * g.x, o1 * rstd * g.y); w.y = pk2(o2 * rstd * g.z, o3 * rstd * g.w);
            *(u32x2*)(xa + (size_t)m * DM + hd * 128 + 4 * l32) = w; }
    }
}

#ifndef MK_STAG
#define MK_STAG 1
#endif
#define MK_SPLITKV 0
#define MK_PRE_B 1
#define MK_PRE_C 1
#define MK_PRE_D 1
#define MK_PRE(DK) (MK_STAG && ((DK) == 96 ? MK_PRE_B : (DK) == 128 ? MK_PRE_C : MK_PRE_D))
template <int DK, int DV, int ldq, int ldk, int ldv, int ldo, int H, int GK, int GV>
__device__ __forceinline__ void attn_phase(Frame& F, const bf16_t* Q, const bf16_t* K, const bf16_t* V, bf16_t* O, float scale, bool skip_ctx, int dup = 1) {
    const float C = scale * 1.4426950408889634f, thr_raw = att::THR / scale;
    const int NHV = NBATCH * H * 16, NCTX = skip_ctx ? 0 : NBATCH * H;
    const int LO = NHV % F.G, NFULL = NHV - LO; int SF = 1;
    if (MK_SPLITKV && dup == 1 && LO > 0 && F.G % LO == 0) { const int q = F.G / LO; if (q == 2 || q == 4) SF = q; }
    const int NPART = (SF > 1) ? LO * SF : 0, NLAT = (SF > 1) ? NFULL : NHV, NTOT = NLAT + NPART + NCTX;
    float* PO = (float*)(F.ws + WS_YS); float* PML = PO + (size_t)256 * 256 * 128;
    for (int L0 = F.vcu; L0 < NTOT * dup; L0 += F.G) { const int L = (dup > 1) ? L0 % NTOT : L0;
        int b, hd, qb, part = -1, U = L;
        if (L >= NLAT && L < NLAT + NPART) { const int j = L - NLAT; U = NFULL + j / SF; part = j % SF; }
        if (L < NLAT + NPART) { const int grp = U >> 4; b = grp / H; hd = grp % H; qb = 1 + (U & 15); } else { const int L2 = L - NLAT - NPART; b = L2 / H; hd = L2 % H; qb = 0; }
        const size_t row0 = (size_t)b * TPB + (size_t)qb * 256; const bf16_t* Kh = K + (size_t)(b * (H / GK) + hd / GK) * TPB * DK; const bf16_t* Vh = V + (size_t)(b * (H / GV) + hd / GV) * TPB * DV;
        if (part >= 0) { const int klen = TPB / SF, j = L - NLAT;
            att::attn_unit_stag<DK, DV, ldq, DK, DV, ldo, MK_PRE(DK) != 0, false, true>(Q + row0 * ldq + hd * DK, Kh + (size_t)part * klen * DK, Vh + (size_t)part * klen * DV, nullptr,
                               klen, C, thr_raw, (char*)F.lds, F.wave, PO + (size_t)j * 256 * DV, PML + (size_t)j * 256 * 2); }
        else
        att::attn_unit_stag<DK, DV, ldq, DK, DV, ldo, MK_PRE(DK) != 0, false>(Q + row0 * ldq + hd * DK, Kh, Vh, O + row0 * ldo + hd * DV,
                               qb == 0 ? CTXL : TPB, C, thr_raw, (char*)F.lds, F.wave);
    }
    __syncthreads();
}
template <int DV, int ldo, int H>
__device__ __forceinline__ void attn_merge(Frame& F, bf16_t* O) {
    const int NHV = NBATCH * H * 16, LO = NHV % F.G, NFULL = NHV - LO; int SF = 1;
    if (LO > 0 && F.G % LO == 0) { const int q = F.G / LO; if (q == 2 || q == 4) SF = q; }
    if (SF == 1) return;
    const float* PO = (const float*)(F.ws + WS_YS); const float* PML = PO + (size_t)256 * 256 * 128;
    const int lane = fresh_lane(), gw = F.vcu * NWAVES + F.wave, NGW = F.G * NWAVES;
    for (int it = gw; it < LO * 256; it += NGW) { const int u = it >> 8, r = it & 255, U = NFULL + u;
        const int grp = U >> 4, b = grp / H, hd = grp % H, qb = 1 + (U & 15);
        float mi[4], li[4], m = -3.0e38f;
#pragma unroll
        for (int i = 0; i < 4; ++i) { if (i < SF) { const f32x2 ml = *(const f32x2*)(PML + ((size_t)(u * SF + i) * 256 + r) * 2); mi[i] = ml.x; li[i] = ml.y; m = fmaxf(m, ml.x); } else { mi[i] = 0.f; li[i] = 0.f; } }
        float l = 0.f, w[4];
#pragma unroll
        for (int i = 0; i < 4; ++i) { w[i] = (i < SF) ? __builtin_amdgcn_exp2f(mi[i] - m) : 0.f; l += w[i] * li[i]; }
        const float rl = 1.0f / l;
        bf16_t* orow = O + ((size_t)b * TPB + (size_t)qb * 256 + r) * ldo + hd * DV;
#pragma unroll
        for (int c0 = 0; c0 < DV; c0 += 64) { float acc = 0.f;
#pragma unroll
            for (int i = 0; i < 4; ++i) if (i < SF) acc += w[i] * PO[((size_t)(u * SF + i) * 256 + r) * DV + c0 + lane];
            orow[c0 + lane] = (bf16_t)f2bf(acc * rl); } }
}
#ifndef MK_MULTI
#define MK_MULTI 0
#endif
constexpr int NPHASE = 37;
#ifndef MK_REP_MASK
#define MK_REP_MASK 0ull
#endif
#ifndef MK_REP_N
#define MK_REP_N 1
#endif
#ifndef MK_DUP
#define MK_DUP -1
#endif
#define DUPF(k) ((k) == MK_DUP ? 2 : 1)
#ifndef MK_LIMIT
#define MK_LIMIT 37
#endif
struct Args { const float* in[N_IN]; float* out; unsigned char* ws; int ph_lo, ph_hi; };

__device__ __forceinline__ void gemm_plain_f32(Frame& F, const bf16_t* A, const bf16_t* Bt, int N, int K, float* C, int ldc, int dup = 1) {
    pg8::Gemm g{A, Bt, K / 64, N, K, 0, nullptr, 0, nullptr}; pg8::StaticOrder S; S.init(T / 256, N / 256, F.G, (int)blockIdx.x, dup); pg8::EpiF32 E{C, ldc};
    pg8::gemm_phase<pg8::EpiF32, pg8::StaticOrder, false>(F.lds, g, S, E, F.wave);
}
__device__ __forceinline__ void gemm_plain_bf16(Frame& F, const bf16_t* A, const bf16_t* Bt, int N, int K, bf16_t* C, int ldc, int dup = 1) {
    pg8::Gemm g{A, Bt, K / 64, N, K, 0, nullptr, 0, nullptr}; pg8::StaticOrder S; S.init(T / 256, N / 256, F.G, (int)blockIdx.x, dup); pg8::EpiBf16 E{C, ldc};
    pg8::gemm_phase<pg8::EpiBf16, pg8::StaticOrder, false>(F.lds, g, S, E, F.wave);
}
template <int S>
__device__ __forceinline__ void gemm_n1024(Frame& F, const bf16_t* A, const bf16_t* Bt, int K, bool skip_ctx, int dup = 1) {
    { pg8::Gemm g{A, Bt, K / 64, DM, K, 0, nullptr, 0, nullptr}; pg8::LatOrder S1; S1.so.init(128, DM / 256, F.G, (int)blockIdx.x, dup); pg8::EpiBf16 E{(bf16_t*)(F.ws + WS_Y), DM};
      pg8::gemm_phase<pg8::EpiBf16, pg8::LatOrder, false>(F.lds, g, S1, E, F.wave); }
    if (!skip_ctx) { pg8::Gemm g{A, Bt, K / 64 / S, DM, K, 0, nullptr, 0, nullptr}; pg8::CtxSplitOrder S2{DM / 256, S, K / 64 / S, F.G, (int)blockIdx.x, dup}; pg8::EpiF32 E{(float*)(F.ws + WS_YS), DM};
      pg8::gemm_phase<pg8::EpiF32, pg8::CtxSplitOrder, false>(F.lds, g, S2, E, F.wave); }
}
__device__ __forceinline__ void gemm_swiglu(Frame& F, const bf16_t* A, const bf16_t* Bt, bf16_t* C, int dup = 1) {
    pg8::Gemm g{A, Bt, DM / 128, 2 * FF, DM / 2, 0, nullptr, 0, nullptr}; pg8::StaticOrder S; S.init(T / 256, 2 * FF / 256, F.G, (int)blockIdx.x, dup); pg8::EpiSwiglu E{C, FF, 1.0f / 32.0f};
    pg8::gemm_phase<pg8::EpiSwiglu, pg8::StaticOrder, false, true>(F.lds, g, S, E, F.wave);
}
__device__ __forceinline__ void gemm_moe_gu(Frame& F, int lm, int dup = 1) {
    moe_tables(F, 2 * lm + 1);
    pg8::Gemm g{(const bf16_t*)(F.ws + WS_XA), (const bf16_t*)(F.ws + WS_MOE_GU + (size_t)lm * 8 * SZ_GU), DM / 128, 2 * FF, DM / 2, (size_t)2 * FF * DM / 2, (const int*)(F.ws + WS_LIST), T, (const LAS int*)(F.MISC + 32)};
    pg8::MoeOrder S; S.so.init((int)F.MISC[24], 2 * FF / 256, F.G, (int)blockIdx.x, dup); S.rb0 = (const LAS int*)(F.MISC + 16); pg8::EpiSwiglu E{(bf16_t*)(F.ws + WS_ACT), FF, 1.0f / 32.0f};
    pg8::gemm_phase<pg8::EpiSwiglu, pg8::MoeOrder, true, true>(F.lds, g, S, E, F.wave);
}
__device__ __forceinline__ void gemm_moe_down(Frame& F, int lm, int dup = 1) {
    moe_tables(F, 2 * lm + 1);
    int RBM, trb, S; pg8::moe_tail_params((int)F.MISC[24], RBM, trb, S);
    const bf16_t* A = (const bf16_t*)(F.ws + WS_ACT); const bf16_t* Bt = (const bf16_t*)(F.ws + WS_MOE_DN + (size_t)lm * 8 * SZ_DN);
    { pg8::Gemm g{A, Bt, FF / 64, DM, FF, (size_t)DM * FF, nullptr, 0, nullptr};
      pg8::MoeOrder S1; S1.so.init(RBM, DM / 256, F.G, (int)blockIdx.x, dup); S1.rb0 = (const LAS int*)(F.MISC + 16); pg8::EpiBf16 E{(bf16_t*)(F.ws + WS_YP), DM};
      pg8::gemm_phase<pg8::EpiBf16, pg8::MoeOrder, false>(F.lds, g, S1, E, F.wave); }
    if (trb > 0) { pg8::Gemm g{A, Bt, FF / 64 / S, DM, FF, (size_t)DM * FF, nullptr, 0, nullptr};
      pg8::MoeTailOrder S2{RBM, trb, S, FF / 64 / S, F.G, (int)blockIdx.x, dup, (const LAS int*)(F.MISC + 16)}; pg8::EpiF32 E{(float*)(F.ws + WS_YS), DM};
      pg8::gemm_phase<pg8::EpiF32, pg8::MoeTailOrder, false>(F.lds, g, S2, E, F.wave); }
}
__device__ __forceinline__ void xcd_or_nothing(const XcdBarrier& b, int wave) { if (!MK_MULTI) xcd_barrier(b, wave); }
__global__ void __launch_bounds__(NWAVES * 64, 2) fwd_kernel(Args args) {
    extern __shared__ __attribute__((aligned(16))) unsigned char lds_raw[];
    Frame F;
    F.lds = (LAS unsigned char*)lds_raw; F.MISC = (volatile LAS unsigned*)(F.lds + MISC_OFF);
    F.wave = __builtin_amdgcn_readfirstlane((int)threadIdx.x >> 6);
    F.G = gridDim.x; { const int bx = blockIdx.x; F.vcu = (F.G % 8 == 0) ? (bx % 8) * (F.G / 8) + bx / 8 : bx; }
    F.ws = args.ws;
    for (int u = threadIdx.x; u < 256; u += NWAVES * 64) ((LAS unsigned*)(F.lds + MISC_OFF))[u] = 0u;
    __syncthreads();
    XcdBarrier bar; bar.bar = (unsigned*)((unsigned*)F.ws + CW_BAR); bar.x = 0; bar.st = nullptr;
    if (!MK_MULTI) bar = xcd_barrier_post((unsigned*)((unsigned*)F.ws + CW_BAR), F.MISC + 0);
    const int lo = args.ph_lo, hi = args.ph_hi;
#define IN(k) (lo <= (k) && (k) < hi)
#define NREP(k) ((((unsigned long long)(MK_REP_MASK) >> (k)) & 1ull) ? (1 + MK_REP_N) : 1)
#define SEAM(k) do { if (!MK_MULTI && IN((k) + 1)) xcd_barrier(bar, F.wave); } while (0)
    unsigned char* ws = F.ws;
    bf16_t* XA = (bf16_t*)(ws + WS_XA); bf16_t* Y = (bf16_t*)(ws + WS_Y); bf16_t* ACT = (bf16_t*)(ws + WS_ACT);
    bf16_t* Qb = (bf16_t*)(ws + WS_Q); bf16_t* Kb = (bf16_t*)(ws + WS_K); bf16_t* Vb = (bf16_t*)(ws + WS_V); bf16_t* Ob = (bf16_t*)(ws + WS_O);

    if (IN(0)) { for (int rep = 0; rep < NREP(0); ++rep) { p0_prologue(F); if (rep + 1 < NREP(0)) xcd_or_nothing(bar, F.wave); } SEAM(0); }
    if (IN(1)) { for (int rep = 0; rep < NREP(1); ++rep) { for (int d2 = 0; d2 < DUPF(1); ++d2) { phase_r0(F); } if (rep + 1 < NREP(1)) xcd_or_nothing(bar, F.wave); } SEAM(1); }
    if (IN(2)) { for (int rep = 0; rep < NREP(2); ++rep) { gemm_plain_bf16(F, XA, (const bf16_t*)(ws + WS_WA_IN), A_IN, DM, (bf16_t*)(ws + WS_Z), A_IN, DUPF(2)); if (rep + 1 < NREP(2)) xcd_or_nothing(bar, F.wave); } SEAM(2); }
    if (IN(3)) { for (int rep = 0; rep < NREP(3); ++rep) { if ((int)blockIdx.x < NBATCH * 8 * 2) { for (int d2 = 0; d2 < DUPF(3); ++d2) { const int ln = fresh_lane(); scan::scan_unit(ws, F.lds, (int)blockIdx.x, F.wave, ln, F.wave * 64 + ln); __syncthreads(); } }
        else if (rep == 0) { const int nidle = F.G - NBATCH * 8 * 2; p0_convert(F, p0_split_item(), g_mats.item0[NMAT], ((int)blockIdx.x - NBATCH * 8 * 2) * NWAVES + F.wave, nidle * NWAVES, fresh_lane()); } if (rep + 1 < NREP(3)) xcd_or_nothing(bar, F.wave); } SEAM(3); }
    if (IN(4)) { for (int rep = 0; rep < NREP(4); ++rep) { for (int d2 = 0; d2 < DUPF(4); ++d2) { phase_a_readout(F); } if (rep + 1 < NREP(4)) xcd_or_nothing(bar, F.wave); } SEAM(4); }
    if (IN(5)) { for (int rep = 0; rep < NREP(5); ++rep) { gemm_n1024<8>(F, XA, (const bf16_t*)(ws + WS_WA_OUT), DM, false, DUPF(5)); if (rep + 1 < NREP(5)) xcd_or_nothing(bar, F.wave); } SEAM(5); }
    if (IN(6)) { for (int rep = 0; rep < NREP(6); ++rep) { phase_r1<false>(F, 0); if (rep + 1 < NREP(6)) xcd_or_nothing(bar, F.wave); } SEAM(6); }
    if (IN(7)) { for (int rep = 0; rep < NREP(7); ++rep) { gemm_swiglu(F, XA, (const bf16_t*)(ws + WS_FFN_GU), ACT, DUPF(7)); if (rep + 1 < NREP(7)) xcd_or_nothing(bar, F.wave); } SEAM(7); }
    if (IN(8)) { for (int rep = 0; rep < NREP(8); ++rep) { gemm_n1024<4>(F, ACT, (const bf16_t*)(ws + WS_FFN_DN), FF, false, DUPF(8)); if (rep + 1 < NREP(8)) xcd_or_nothing(bar, F.wave); } SEAM(8); }
    if (IN(9)) { for (int rep = 0; rep < NREP(9); ++rep) { phase_r2<false>(F, 0); if (rep + 1 < NREP(9)) xcd_or_nothing(bar, F.wave); } SEAM(9); }
    if (IN(10)) { for (int rep = 0; rep < NREP(10); ++rep) { gemm_plain_bf16(F, XA, (const bf16_t*)(ws + WS_WB_IN), B_INP, DM, (bf16_t*)(ws + WS_Z), B_INP, DUPF(10)); if (rep + 1 < NREP(10)) xcd_or_nothing(bar, F.wave); } SEAM(10); }
    if (IN(11)) { for (int rep = 0; rep < NREP(11); ++rep) { for (int d2 = 0; d2 < DUPF(11); ++d2) { phase_b_row1(F); } if (rep + 1 < NREP(11)) xcd_or_nothing(bar, F.wave); } SEAM(11); }
    if (IN(12)) {
        { pg8::Gemm g{Ob, (const bf16_t*)(ws + WS_WB_QB), 384 / 64, 1536, 384, 0, nullptr, 0, nullptr}; pg8::StaticOrder S; S.init(T / 256, 1536 / 256, F.G, (int)blockIdx.x); pg8::EpiRopeB E{Qb, (const float*)(ws + WS_ROPE), MK_PRE(96) ? 0.10206207261596575f * 1.4426950408889634f : 1.0f};
          pg8::gemm_phase<pg8::EpiRopeB, pg8::StaticOrder, false>(F.lds, g, S, E, F.wave); }
        { pg8::Gemm g{Ob + (size_t)T * 384, (const bf16_t*)(ws + WS_WB_KVB), 256 / 64, 2048, 256, 0, nullptr, 0, nullptr}; pg8::StaticOrder S; S.init(T / 256, 2048 / 256, F.G, (int)blockIdx.x); pg8::EpiKV E{Kb, 1536, Vb, 1024};
          pg8::gemm_phase<pg8::EpiKV, pg8::StaticOrder, false>(F.lds, g, S, E, F.wave); }
        SEAM(12); }
    if (IN(13)) { for (int rep = 0; rep < NREP(13); ++rep) { attn_phase<96, 64, 1536, 1536, 1024, DM, 16, 1, 1>(F, Qb, Kb, Vb, XA, 0.10206207261596575f, false, DUPF(13)); if (rep + 1 < NREP(13)) xcd_or_nothing(bar, F.wave); } SEAM(13); }
    if (IN(14)) { for (int rep = 0; rep < NREP(14); ++rep) { gemm_n1024<8>(F, XA, (const bf16_t*)(ws + WS_WB_OUT), DM, false, DUPF(14)); if (rep + 1 < NREP(14)) xcd_or_nothing(bar, F.wave); } SEAM(14); }
    if (IN(15)) { for (int rep = 0; rep < NREP(15); ++rep) { phase_r1<true>(F, 1); if (rep + 1 < NREP(15)) xcd_or_nothing(bar, F.wave); } SEAM(15); }
    if (IN(16)) { moe_build(F); SEAM(16); }
    if (IN(17)) { for (int rep = 0; rep < NREP(17); ++rep) { gemm_moe_gu(F, 0, DUPF(17)); if (rep + 1 < NREP(17)) xcd_or_nothing(bar, F.wave); } SEAM(17); }
    if (IN(18)) { for (int rep = 0; rep < NREP(18); ++rep) { gemm_moe_down(F, 0, DUPF(18)); if (rep + 1 < NREP(18)) xcd_or_nothing(bar, F.wave); } SEAM(18); }
    if (IN(19)) { for (int rep = 0; rep < NREP(19); ++rep) { moe_tables(F, 1); phase_r2<true>(F, 1); if (rep + 1 < NREP(19)) xcd_or_nothing(bar, F.wave); } SEAM(19); }
    if (IN(20)) { { pg8::Gemm g{XA, (const bf16_t*)(ws + WS_WC_IN), DM / 64, C_IN, DM, 0, nullptr, 0, nullptr}; pg8::StaticOrder S; S.init(T / 256, C_IN / 256, F.G, (int)blockIdx.x, DUPF(20));
          pg8::EpiNormRopeC E{Qb, Kb, Vb, in_ptr(F, I_C_QNORM), in_ptr(F, I_C_KNORM), (const float*)(ws + WS_ROPE) + (size_t)2 * 64 * 32 * 2, (LAS float*)(F.lds + pg8::STAGE_BYTES + 2048), MK_PRE(128) ? 0.08838834764831845f * 1.4426950408889634f : 1.0f};
          pg8::gemm_phase<pg8::EpiNormRopeC, pg8::StaticOrder, false>(F.lds, g, S, E, F.wave); } }
    if (IN(21)) { SEAM(21); }
    if (IN(22)) { for (int rep = 0; rep < NREP(22); ++rep) { attn_phase<128, 128, 1024, 256, 256, DM, 8, 4, 4>(F, Qb, Kb, Vb, XA, 0.08838834764831845f, false, DUPF(22)); if (rep + 1 < NREP(22)) xcd_or_nothing(bar, F.wave); } SEAM(22); }
    if (IN(23)) { for (int rep = 0; rep < NREP(23); ++rep) { gemm_n1024<8>(F, XA, (const bf16_t*)(ws + WS_WC_OUT), DM, false, DUPF(23)); if (rep + 1 < NREP(23)) xcd_or_nothing(bar, F.wave); } SEAM(23); }
    if (IN(24)) { for (int rep = 0; rep < NREP(24); ++rep) { phase_r1<false>(F, 2); if (rep + 1 < NREP(24)) xcd_or_nothing(bar, F.wave); } SEAM(24); }
    if (IN(25)) { for (int rep = 0; rep < NREP(25); ++rep) { gemm_swiglu(F, XA, (const bf16_t*)(ws + WS_FFN_GU + SZ_GU), ACT, DUPF(25)); if (rep + 1 < NREP(25)) xcd_or_nothing(bar, F.wave); } SEAM(25); }
    if (IN(26)) { for (int rep = 0; rep < NREP(26); ++rep) { gemm_n1024<4>(F, ACT, (const bf16_t*)(ws + WS_FFN_DN + SZ_DN), FF, false, DUPF(26)); if (rep + 1 < NREP(26)) xcd_or_nothing(bar, F.wave); } SEAM(26); }
    if (IN(27)) { for (int rep = 0; rep < NREP(27); ++rep) { phase_r2<false>(F, 2); if (rep + 1 < NREP(27)) xcd_or_nothing(bar, F.wave); } SEAM(27); }
    if (IN(28)) { { pg8::Gemm g{XA, (const bf16_t*)(ws + WS_WD_IN), DM / 64, D_IN, DM, 0, nullptr, 0, nullptr}; pg8::StaticOrder S; S.init(T / 256, D_IN / 256, F.G, (int)blockIdx.x, DUPF(28));
          pg8::EpiRopeD E{Qb, Kb, Vb, (const float*)(ws + WS_ROPE) + (size_t)1 * 64 * 32 * 2, MK_PRE(64) ? 0.125f * 1.4426950408889634f : 1.0f};
          pg8::gemm_phase<pg8::EpiRopeD, pg8::StaticOrder, false>(F.lds, g, S, E, F.wave); } SEAM(28); }
    if (IN(29)) { for (int rep = 0; rep < NREP(29); ++rep) { attn_phase<64, 128, 1024, 1024, 1024, 2048, 16, 1, 2>(F, Qb, Kb, Vb, Ob, 0.125f, true, DUPF(29)); if (rep + 1 < NREP(29)) xcd_or_nothing(bar, F.wave); } SEAM(29); }
    if (IN(30)) { for (int rep = 0; rep < NREP(30); ++rep) { for (int d2 = 0; d2 < DUPF(30); ++d2) { phase_d_row2(F); } if (rep + 1 < NREP(30)) xcd_or_nothing(bar, F.wave); } SEAM(30); }
    if (IN(31)) { for (int rep = 0; rep < NREP(31); ++rep) { gemm_n1024<8>(F, XA, (const bf16_t*)(ws + WS_WD_OUT), DM, true, DUPF(31)); if (rep + 1 < NREP(31)) xcd_or_nothing(bar, F.wave); } SEAM(31); }
    if (IN(32)) { for (int rep = 0; rep < NREP(32); ++rep) { phase_r1<true>(F, 3); if (rep + 1 < NREP(32)) xcd_or_nothing(bar, F.wave); } SEAM(32); }
    if (IN(33)) { moe_build(F); SEAM(33); }
    if (IN(34)) { for (int rep = 0; rep < NREP(34); ++rep) { gemm_moe_gu(F, 1, DUPF(34)); if (rep + 1 < NREP(34)) xcd_or_nothing(bar, F.wave); } SEAM(34); }
    if (IN(35)) { for (int rep = 0; rep < NREP(35); ++rep) { gemm_moe_down(F, 1, DUPF(35)); if (rep + 1 < NREP(35)) xcd_or_nothing(bar, F.wave); } SEAM(35); }
    if (IN(36)) { moe_tables(F, 3); phase_r2<true>(F, 3); }
#if MK_LIMIT < 37
    {
        xcd_barrier(bar, F.wave);
        float* outp = out_ptr(); const int tid = F.wave * 64 + fresh_lane();
#if MK_LIMIT == 34 || MK_LIMIT == 35 || MK_LIMIT == 36
        moe_tables(F, 3);
        int RBM, trb, S; pg8::moe_tail_params((int)F.MISC[24], RBM, trb, S);
#endif
        for (int r = (int)blockIdx.x; r < NBATCH * SEQ; r += F.G) { const int b = r / SEQ, l = r % SEQ; const size_t m = (size_t)b * TPB + CTXL + l;
#if MK_LIMIT == 34
            const int* route = (const int*)(ws + WS_ROUTE); const int* list = (const int*)(ws + WS_LIST);
            const int e1 = route[m * 8], s1 = route[m * 8 + 1], e2 = route[m * 8 + 2], s2 = route[m * 8 + 3];
            const unsigned char* xa8 = (const unsigned char*)(ws + WS_XA) + m * DM;
            for (int c = tid; c < DM; c += NWAVES * 64) { float v = 0.f;
                if (c >= 512) v = (float)((unsigned)xa8[2 * (c - 512)] + 256u * (unsigned)xa8[2 * (c - 512) + 1]); else
                if (c < 4) v = (float)route[m * 8 + c]; else if (c < 6) v = ((const float*)route)[m * 8 + c]; else if (c == 6) v = (float)(list[(size_t)e1 * T + s1] - (int)m); else if (c == 7) v = (float)(list[(size_t)e2 * T + s2] - (int)m);
                else if (c < 16) v = (float)F.MISC[16 + (c - 8)]; else if (c < 24) v = (float)F.MISC[32 + (c - 16)]; else if (c == 24) v = (float)F.MISC[24];
                outp[(size_t)r * DM + c] = v; }
#elif MK_LIMIT == 35
            const int* route = (const int*)(ws + WS_ROUTE); const bf16_t* act = (const bf16_t*)(ws + WS_ACT);
            const size_t r1 = (size_t)F.MISC[16 + route[m * 8]] * 256 + route[m * 8 + 1], r2 = (size_t)F.MISC[16 + route[m * 8 + 2]] * 256 + route[m * 8 + 3];
            for (int c = tid; c < DM; c += NWAVES * 64) { float v = 0.f;
                for (int q = 0; q < 4; ++q) { const int cc = c + q * DM; if (cc < FF) v += bf2f((unsigned)act[r1 * FF + cc]) + 2.0f * bf2f((unsigned)act[r2 * FF + cc]); }
                outp[(size_t)r * DM + c] = v; }
#elif MK_LIMIT == 36
            const int* route = (const int*)(ws + WS_ROUTE);
            const size_t r1 = (size_t)F.MISC[16 + route[m * 8]] * 256 + route[m * 8 + 1], r2 = (size_t)F.MISC[16 + route[m * 8 + 2]] * 256 + route[m * 8 + 3];
            for (int c = tid; c < DM; c += NWAVES * 64) { float v = 0.f;
                for (int k = 0; k < 2; ++k) { const size_t rr = k ? r2 : r1; const int rb = (int)(rr >> 8); float a = 0.f;
                    if (rb >= RBM) { const float* ys = (const float*)(ws + WS_YS) + ((size_t)(rb - RBM) * 256 + (rr & 255)) * DM; for (int s2 = 0; s2 < S; ++s2) a += ys[(size_t)s2 * trb * 256 * DM + c]; }
                    else a = bf2f((unsigned)((const bf16_t*)(ws + WS_YP))[rr * DM + c]);
                    v += (k ? 2.0f : 1.0f) * a; }
                outp[(size_t)r * DM + c] = v; }
#else
            const bf16_t* hh = (const bf16_t*)(ws + WS_H); const size_t src = m * DM;
            for (int c = tid; c < DM; c += NWAVES * 64) outp[(size_t)r * DM + c] = bf2f((unsigned)hh[src + c]);
#endif
        }
    }
#endif
#undef IN
#undef SEAM
}

extern "C" void kernel_launch(void* const* d_in, const int* in_sizes, int n_in, void* d_out, int out_size, void* d_ws, size_t ws_size, hipStream_t stream) {
    static int grid = 0;
    if (grid == 0) {
        if (n_in != N_IN || out_size != NBATCH * SEQ * DM || ws_size < WS_END) { fprintf(stderr, "kernel_launch: unexpected shapes: n_in %d out %d ws %zu (need %zu)\n", n_in, out_size, ws_size, (size_t)WS_END); grid = -1; return; }
        int dev = 0, cus = 0, per_cu = 0;
        if (hipGetDevice(&dev) != hipSuccess || hipDeviceGetAttribute(&cus, hipDeviceAttributeMultiprocessorCount, dev) != hipSuccess) { grid = -1; return; }
        if (hipFuncSetAttribute((const void*)fwd_kernel, hipFuncAttributeMaxDynamicSharedMemorySize, LDS_BYTES) != hipSuccess) { fprintf(stderr, "kernel_launch: hipFuncSetAttribute failed\n"); grid = -1; return; }
        if (hipOccupancyMaxActiveBlocksPerMultiprocessor(&per_cu, (const void*)fwd_kernel, NWAVES * 64, LDS_BYTES) != hipSuccess || per_cu < 1) fprintf(stderr, "kernel_launch: occupancy query reports %d\n", per_cu);
        (void)hipGetLastError();
        grid = cus;
    }
    if (grid < 0) return;
    (void)hipMemsetAsync((char*)d_ws + WS_CTL, 0, CTL_BYTES, stream);
    Args a{};
    for (int i = 0; i < N_IN; ++i) a.in[i] = (const float*)d_in[i];
    a.out = (float*)d_out; a.ws = (unsigned char*)d_ws;
#if MK_MULTI
    for (int p = 0; p < MK_LIMIT; ++p) { a.ph_lo = p; a.ph_hi = p + 1; hipLaunchKernelGGL(fwd_kernel, dim3(grid), dim3(NWAVES * 64), LDS_BYTES, stream, a); }
#else
    a.ph_lo = 0; a.ph_hi = MK_LIMIT; hipLaunchKernelGGL(fwd_kernel, dim3(grid), dim3(NWAVES * 64), LDS_BYTES, stream, a);
#endif
    const hipError_t le = hipPeekAtLastError();
    if (le != hipSuccess) fprintf(stderr, "kernel_launch: launch failed: %s\n", hipGetErrorName(le));
}
```

```cpp
#include <hip/hip_runtime.h>
#include <cstdio>
#include <cstdint>

#define GAS __attribute__((address_space(1)))
#define LAS __attribute__((address_space(3)))
typedef unsigned short bf16_t;
typedef short bf16x8 __attribute__((ext_vector_type(8)));
typedef short s16x4 __attribute__((ext_vector_type(4)));
typedef float f32x2 __attribute__((ext_vector_type(2)));
typedef float f32x4 __attribute__((ext_vector_type(4)));
typedef float f32x16 __attribute__((ext_vector_type(16)));
typedef unsigned u32x2 __attribute__((ext_vector_type(2)));
typedef unsigned u32x4 __attribute__((ext_vector_type(4)));

__device__ __forceinline__ float bf2f(unsigned b) { return __uint_as_float(b << 16); }
__device__ __forceinline__ unsigned f2bf(float f) { unsigned u = __float_as_uint(f); return (u + 0x7fffu + ((u >> 16) & 1u)) >> 16; }
__device__ __forceinline__ unsigned pk2(float lo, float hi) { return f2bf(lo) | (f2bf(hi) << 16); }
__device__ __forceinline__ unsigned cvt_pk_bf16(float lo, float hi) { unsigned r; asm volatile("v_cvt_pk_bf16_f32 %0, %1, %2" : "=v"(r) : "v"(lo), "v"(hi)); return r; }
typedef int v8i32 __attribute__((ext_vector_type(8)));
__device__ __forceinline__ unsigned pk4_fp8(float a, float b, float c, float d) { int w = 0; w = __builtin_amdgcn_cvt_pk_fp8_f32(a, b, w, false); w = __builtin_amdgcn_cvt_pk_fp8_f32(c, d, w, true); asm volatile("s_nop 1" : "+v"(w)); return (unsigned)w; }
__device__ __forceinline__ float wave_sum(float v) {
#pragma unroll
    for (int o = 1; o < 64; o <<= 1) v += __shfl_xor(v, o);
    return v;
}
__device__ __forceinline__ int fresh_lane() { int l; asm volatile("v_mbcnt_lo_u32_b32 %0, -1, 0\n\tv_mbcnt_hi_u32_b32 %0, -1, %0" : "=v"(l)); return l; }
__device__ __forceinline__ float fast_exp(float x) { return __builtin_amdgcn_exp2f(x * 1.4426950408889634f); }
__device__ __forceinline__ float fast_rcp(float x) { return __builtin_amdgcn_rcpf(x); }
__device__ __forceinline__ float silu_f(float x) { return x * fast_rcp(1.0f + fast_exp(-x)); }

#ifndef MK_WT
#define MK_WT 0
#endif
__device__ __forceinline__ void st16(void* p, u32x4 v) {
#if MK_WT
    asm volatile("global_store_dwordx4 %0, %1, off sc1\n\ts_nop 1" :: "v"(p), "v"(v) : "memory");
#else
    *(u32x4*)p = v;
#endif
}
__device__ __forceinline__ void st16f(void* p, f32x4 v) { st16(p, __builtin_bit_cast(u32x4, v)); }

namespace pg8 {
constexpr int BM = 256, BK = 64, HALF = 128, HTB = HALF * BK * 2, STAGE_BYTES = 8 * HTB, NXCD = 8, WGM = 8;
__host__ __device__ __forceinline__ int lds_byte(int r, int c) { const int st = (r >> 4) * 2 + (c >> 5), rr = r & 15, cc = c & 31, ob = rr * 64 + cc * 2; return st * 1024 + (ob ^ (((ob >> 9) & 1) << 5)); }
__host__ __device__ __forceinline__ void stage_rc(int b, int& R, int& C) { const int st = b / 1024, sb = b % 1024, swz = sb ^ (((sb >> 9) & 1) << 5); R = (st >> 1) * 16 + swz / 64; C = (st & 1) * 32 + (swz % 64) / 2; }
__host__ __device__ __forceinline__ int perm32(int rho) { const int n = rho >> 4, i = rho & 15; return 8 * (i >> 2) + 4 * n + (i & 3); }

struct Unit { int pm, pn, e, pl, po, kt0; };
struct Gemm { const bf16_t* A; const bf16_t* Bt; int nt  , N, K  ; size_t bstride; const int* list; int list_stride; const LAS int* cnt; };

struct StaticOrder {
    int nM, nN, nwg, G, c, dup;
    __device__ __forceinline__ void init(int nM_, int nN_, int G_, int c_, int dup_ = 1) { nM = nM_; nN = nN_; nwg = nM * nN; G = G_; c = c_; dup = dup_; }
    __device__ __forceinline__ bool next(int i, Unit& u) const {
        const long L = (long)i * G + c; if (L >= (long)nwg * dup) return false;
        int wgid = (int)L; if (dup > 1) wgid = (int)((unsigned)wgid % (unsigned)nwg); { const int q = nwg / NXCD, r = nwg % NXCD, xcd = wgid % NXCD, off = wgid / NXCD; wgid = (xcd < r ? xcd * (q + 1) : r * (q + 1) + (xcd - r) * q) + off; }
        const int nig = WGM * nN, gid = wgid / nig, fm = gid * WGM, gsz = (nM - fm) < WGM ? (nM - fm) : WGM;
        u.pm = fm + ((wgid % nig) % gsz); u.pn = (wgid % nig) / gsz; u.e = 0; u.pl = 0; u.po = u.pm; u.kt0 = 0; return true;
    }
};
struct MoeOrder {
    StaticOrder so; const LAS int* rb0;
    __device__ __forceinline__ bool next(int i, Unit& u) const {
        if (!so.next(i, u)) return false;
        int e = 0;
#pragma unroll
        for (int j = 1; j < 8; ++j) e = (u.pm >= rb0[j]) ? j : e;
        u.e = e; u.pl = u.pm - rb0[e]; u.po = u.pm; u.kt0 = 0; return true;
    }
};

__device__ __forceinline__ void moe_tail_params(int NRB, int& RBM, int& trb, int& S) { RBM = (NRB >> 6) << 6; trb = NRB - RBM; S = trb <= 4 ? 14 : trb <= 9 ? 7 : trb <= 16 ? 4 : trb <= 32 ? 2 : 1; }
struct MoeTailOrder {
    int RBM, trb, S, ntsub, G, c0, dup; const LAS int* rb0;
    __device__ __forceinline__ bool next(int i, Unit& u) const { int L = i * G + c0; const int n = trb * 4 * S; if (L >= n * dup) return false; if (dup > 1) L %= n;
        const int s = L % S, r = L / S; u.pn = r & 3; const int tb = r >> 2; u.pm = RBM + tb; u.po = s * trb + tb; u.kt0 = s * ntsub; u.pl = 0;
        int e = 0;
#pragma unroll
        for (int j = 1; j < 8; ++j) e = (u.pm >= rb0[j]) ? j : e;
        u.e = e; return true; }
};
struct LatOrder {
    StaticOrder so;
    __device__ __forceinline__ bool next(int i, Unit& u) const { if (!so.next(i, u)) return false; u.pm = (u.pm >> 4) * 17 + 1 + (u.pm & 15); u.po = u.pm; return true; }
};
struct CtxSplitOrder {
    int nN, S, ntsub, G, c0, dup;
    __device__ __forceinline__ bool next(int i, Unit& u) const { int L = i * G + c0; if (L >= 8 * nN * S * dup) return false; if (dup > 1) L %= 8 * nN * S;
        const int s = L % S, r = L / S; u.pn = r % nN; const int c = r / nN; u.pm = 17 * c; u.po = s * 8 + c; u.kt0 = s * ntsub; u.e = 0; u.pl = 0; return true; }
};

struct EpiF32 {
    static constexpr bool PERM = false;
    float* C; int ldc;
    __device__ __forceinline__ void operator()(const f32x4 (&acc)[2][2][4][2], const Unit& u, int wr, int wc, int fr, int fq) const {
        const int row0 = u.po * BM + wr * 64 + fr, col0 = u.pn * BM + wc * 32 + 4 * fq;
#pragma unroll
        for (int ai = 0; ai < 2; ++ai)
#pragma unroll
            for (int m = 0; m < 4; ++m) { float* rowp = C + (size_t)(row0 + ai * HALF + m * 16) * ldc + col0;
#pragma unroll
                for (int bj = 0; bj < 2; ++bj)
#pragma unroll
                    for (int n = 0; n < 2; ++n) st16f(rowp + bj * HALF + n * 16, acc[ai][bj][m][n]); }
    }
};
struct EpiBf16 {
    static constexpr bool PERM = true;
    bf16_t* O; int ldc;
    __device__ __forceinline__ void operator()(const f32x4 (&acc)[2][2][4][2], const Unit& u, int wr, int wc, int fr, int fq) const {
        const int row0 = u.po * BM + wr * 64 + fr, col0 = u.pn * BM + wc * 32 + 8 * fq;
#pragma unroll
        for (int ai = 0; ai < 2; ++ai)
#pragma unroll
            for (int m = 0; m < 4; ++m) { bf16_t* rowp = O + (size_t)(row0 + ai * HALF + m * 16) * ldc + col0;
#pragma unroll
                for (int bj = 0; bj < 2; ++bj) { const f32x4 v0 = acc[ai][bj][m][0], v1 = acc[ai][bj][m][1];
                    u32x4 w; w.x = cvt_pk_bf16(v0[0], v0[1]); w.y = cvt_pk_bf16(v0[2], v0[3]); w.z = cvt_pk_bf16(v1[0], v1[1]); w.w = cvt_pk_bf16(v1[2], v1[3]);
                    st16(rowp + bj * HALF, w); } }
    }
};
struct EpiSwiglu {
    static constexpr bool PERM = true;
    bf16_t* O; int ldc; float sc;
    __device__ __forceinline__ void operator()(const f32x4 (&acc)[2][2][4][2], const Unit& u, int wr, int wc, int fr, int fq) const {
        const int row0 = u.po * BM + wr * 64 + fr, col0 = u.pn * HALF + wc * 32 + 8 * fq;
        const float k1 = -1.4426950408889634f * sc, c2 = 1.0f / (sc * sc);
#pragma unroll
        for (int ai = 0; ai < 2; ++ai)
#pragma unroll
            for (int m = 0; m < 4; ++m) { bf16_t* rowp = O + (size_t)(row0 + ai * HALF + m * 16) * ldc + col0;
                float r[8];
#pragma unroll
                for (int n = 0; n < 2; ++n)
#pragma unroll
                    for (int j = 0; j < 4; ++j) { const float ag = acc[ai][0][m][n][j], au = acc[ai][1][m][n][j];
                        const float e = __builtin_amdgcn_exp2f(ag * k1); r[n * 4 + j] = (ag * au) * __builtin_amdgcn_rcpf(fmaf(e, c2, c2)); }
                u32x4 w; w.x = cvt_pk_bf16(r[0], r[1]); w.y = cvt_pk_bf16(r[2], r[3]); w.z = cvt_pk_bf16(r[4], r[5]); w.w = cvt_pk_bf16(r[6], r[7]);
                st16(rowp, w); }
    }
};
constexpr int HM_TPB = 4352;
struct EpiKV {
    static constexpr bool PERM = true;
    bf16_t* Kp; int ldk; bf16_t* Vp; int ldv;
    __device__ __forceinline__ void operator()(const f32x4 (&acc)[2][2][4][2], const Unit& u, int wr, int wc, int fr, int fq) const {
        const int row0 = u.po * BM + wr * 64 + fr, within = wc * 32 + 8 * fq, bb = u.po / 17;
#pragma unroll
        for (int ai = 0; ai < 2; ++ai)
#pragma unroll
            for (int m = 0; m < 4; ++m) { const size_t row = (size_t)(row0 + ai * HALF + m * 16);
#pragma unroll
                for (int bj = 0; bj < 2; ++bj) { const int head = u.pn * 2 + bj; const f32x4 v0 = acc[ai][bj][m][0], v1 = acc[ai][bj][m][1];
                    u32x4 w; w.x = cvt_pk_bf16(v0[0], v0[1]); w.y = cvt_pk_bf16(v0[2], v0[3]); w.z = cvt_pk_bf16(v1[0], v1[1]); w.w = cvt_pk_bf16(v1[2], v1[3]);
                    const size_t hrow = (size_t)(bb * 16 + head) * HM_TPB + (row - (size_t)bb * HM_TPB);
                    bf16_t* dst = (within < 64) ? (Kp + hrow * 96 + within) : (Vp + hrow * 64 + (within - 64));
                    st16(dst, w); } }
    }
};

struct EpiRopeD {
    static constexpr bool PERM = true;
    bf16_t* Qp; bf16_t* Kp; bf16_t* Vp; const float* rt; float qs;
    __device__ __forceinline__ void operator()(const f32x4 (&acc)[2][2][4][2], const Unit& u, int wr, int wc, int fr, int fq) const {
        const int row0 = u.po * BM + wr * 64 + fr, cw = wc * 32 + 8 * fq, bb = u.po / 17;
        if (u.pn >= 8) {
#pragma unroll
            for (int ai = 0; ai < 2; ++ai)
#pragma unroll
                for (int m = 0; m < 4; ++m) { const size_t prow = (size_t)(row0 + ai * HALF + m * 16) - (size_t)bb * HM_TPB;
#pragma unroll
                    for (int bj = 0; bj < 2; ++bj) { const f32x4 v0 = acc[ai][bj][m][0], v1 = acc[ai][bj][m][1];
                        u32x4 w; w.x = cvt_pk_bf16(v0[0], v0[1]); w.y = cvt_pk_bf16(v0[2], v0[3]); w.z = cvt_pk_bf16(v1[0], v1[1]); w.w = cvt_pk_bf16(v1[2], v1[3]);
                        const int vh = (u.pn - 8) * 2 + bj;
                        st16(Vp + ((size_t)(bb * 8 + vh) * HM_TPB + prow) * 128 + cw, w); } }
            return; }
        const bool isq = u.pn < 4; const float osc = isq ? qs : 1.0f;
        const int tb = u.pm % 17; const bool isctx = (tb == 0), colpart = (wc & 1) != 0, x2 = (fq & 2) != 0;
        const int f0 = 8 * (fq & 1);
#pragma unroll
        for (int ai = 0; ai < 2; ++ai)
#pragma unroll
            for (int m = 0; m < 4; ++m) {
                const int pos = colpart ? (16 * m + fr) : ((tb - 1) * 4 + 2 * ai + wr);
                f32x4 cs[4];
#pragma unroll
                for (int q = 0; q < 4; ++q) cs[q] = isctx ? (f32x4){1.f, 0.f, 1.f, 0.f} : *(const f32x4*)(rt + ((size_t)(isctx ? 0 : pos) * 32 + f0 + 2 * q) * 2);
                const size_t grow = (size_t)(row0 + ai * HALF + m * 16), prow = grow - (size_t)bb * HM_TPB;
#pragma unroll
                for (int bj = 0; bj < 2; ++bj) { float r[8];
#pragma unroll
                    for (int e = 0; e < 8; ++e) { const float x = acc[ai][bj][m][e >> 2][e & 3] * osc; const float xp = __shfl_xor(x, 32);
                        const float c = cs[e >> 1][2 * (e & 1)], sn = cs[e >> 1][2 * (e & 1) + 1];
                        r[e] = x2 ? (x * c + xp * sn) : (x * c - xp * sn); }
                    u32x4 w; w.x = cvt_pk_bf16(r[0], r[1]); w.y = cvt_pk_bf16(r[2], r[3]); w.z = cvt_pk_bf16(r[4], r[5]); w.w = cvt_pk_bf16(r[6], r[7]);
                    const int cc = cw + bj * HALF;
                    bf16_t* dst = isq ? Qp + grow * 1024 + u.pn * BM + cc : Kp + ((size_t)(bb * 16 + (u.pn - 4) * 4 + (cc >> 6)) * HM_TPB + prow) * 64 + (cc & 63);
                    st16(dst, w); } }
    }
};

struct EpiRopeB {
    static constexpr bool PERM = true;
    bf16_t* O; const float* rt; float qs;
    __device__ __forceinline__ void operator()(const f32x4 (&acc)[2][2][4][2], const Unit& u, int wr, int wc, int fr, int fq) const {
        const int row0 = u.po * BM + wr * 64 + fr, col0 = u.pn * BM + wc * 32 + 8 * fq;
        const int tb = u.pm % 17; const bool isctx = (tb == 0), colpart = (fq & 2) != 0, x2 = (fq & 1) != 0;
#pragma unroll
        for (int ai = 0; ai < 2; ++ai)
#pragma unroll
            for (int m = 0; m < 4; ++m) {
                const int pos = colpart ? (16 * m + fr) : ((tb - 1) * 4 + 2 * ai + wr);
                f32x4 cs[4];
#pragma unroll
                for (int q = 0; q < 4; ++q) cs[q] = isctx ? (f32x4){1.f, 0.f, 1.f, 0.f} : *(const f32x4*)(rt + ((size_t)(isctx ? 0 : pos) * 32 + 2 * q) * 2);
                bf16_t* rowp = O + (size_t)(row0 + ai * HALF + m * 16) * 1536 + col0;
#pragma unroll
                for (int bj = 0; bj < 2; ++bj) { const bool rope = ((u.pn * 8 + bj * 4 + wc) % 3) == 2;
                    float r[8];
#pragma unroll
                    for (int e = 0; e < 8; ++e) { const float x = acc[ai][bj][m][e >> 2][e & 3] * qs; const float xp = __shfl_xor(x, 16);
                        const float c = cs[e >> 1][2 * (e & 1)], sn = cs[e >> 1][2 * (e & 1) + 1];
                        r[e] = rope ? (x2 ? (x * c + xp * sn) : (x * c - xp * sn)) : x; }
                    u32x4 w; w.x = cvt_pk_bf16(r[0], r[1]); w.y = cvt_pk_bf16(r[2], r[3]); w.z = cvt_pk_bf16(r[4], r[5]); w.w = cvt_pk_bf16(r[6], r[7]);
                    st16(rowp + bj * HALF, w); } }
    }
};

struct EpiNormRopeC {
    static constexpr bool PERM = true;
    bf16_t* Qp; bf16_t* Kp; bf16_t* Vp; const float* qg; const float* kg; const float* rt; LAS float* xch; float qs;
    __device__ __forceinline__ void operator()(const f32x4 (&acc)[2][2][4][2], const Unit& u, int wr, int wc, int fr, int fq) const {
        const int row0 = u.po * BM + wr * 64 + fr, bb = u.po / 17;
        if (u.pn == 5) {
#pragma unroll
            for (int ai = 0; ai < 2; ++ai)
#pragma unroll
                for (int m = 0; m < 4; ++m) { const size_t prow = (size_t)(row0 + ai * HALF + m * 16) - (size_t)bb * HM_TPB;
#pragma unroll
                    for (int bj = 0; bj < 2; ++bj) { const f32x4 v0 = acc[ai][bj][m][0], v1 = acc[ai][bj][m][1];
                        u32x4 w; w.x = cvt_pk_bf16(v0[0], v0[1]); w.y = cvt_pk_bf16(v0[2], v0[3]); w.z = cvt_pk_bf16(v1[0], v1[1]); w.w = cvt_pk_bf16(v1[2], v1[3]);
                        st16(Vp + ((size_t)(bb * 2 + bj) * HM_TPB + prow) * 128 + wc * 32 + 8 * fq, w); } }
            asm volatile("s_waitcnt lgkmcnt(0)" ::: "memory"); __builtin_amdgcn_s_barrier(); asm volatile("" ::: "memory");
            return; }
#pragma unroll
        for (int ai = 0; ai < 2; ++ai)
#pragma unroll
            for (int m = 0; m < 4; ++m)
#pragma unroll
                for (int bj = 0; bj < 2; ++bj) { const f32x4 v0 = acc[ai][bj][m][0], v1 = acc[ai][bj][m][1];
                    float sq = (v0[0] * v0[0] + v0[1] * v0[1]) + (v0[2] * v0[2] + v0[3] * v0[3]) + (v1[0] * v1[0] + v1[1] * v1[1]) + (v1[2] * v1[2] + v1[3] * v1[3]);
                    sq += __shfl_xor(sq, 16); sq += __shfl_xor(sq, 32);
                    if (fq == 0) xch[((ai * HALF + wr * 64 + m * 16 + fr) * 2 + bj) * 4 + wc] = sq; }
        asm volatile("s_waitcnt lgkmcnt(0)" ::: "memory"); __builtin_amdgcn_s_barrier(); asm volatile("" ::: "memory");
        const bool isq = u.pn < 4; const float* gv = isq ? qg : kg;
        const int d0 = 64 * (wc >> 1) + 32 * (fq >> 1) + 16 * (wc & 1) + 8 * (fq & 1);
        const f32x4 ga = *(const f32x4*)(gv + d0), gb = *(const f32x4*)(gv + d0 + 4);
        const int tb = u.pm % 17; const bool isctx = (tb == 0), colpart = (wc >> 1) != 0, x2 = (fq >> 1) != 0;
        const int f0 = d0 & 31;
#pragma unroll
        for (int ai = 0; ai < 2; ++ai)
#pragma unroll
            for (int m = 0; m < 4; ++m) {
                const int pos = colpart ? (16 * m + fr) : ((tb - 1) * 4 + 2 * ai + wr);
                f32x4 cs[4];
#pragma unroll
                for (int q = 0; q < 4; ++q) cs[q] = isctx ? (f32x4){1.f, 0.f, 1.f, 0.f} : *(const f32x4*)(rt + ((size_t)(isctx ? 0 : pos) * 32 + f0 + 2 * q) * 2);
                const int rl = ai * HALF + wr * 64 + m * 16 + fr; const size_t row = (size_t)(row0 + ai * HALF + m * 16);
#pragma unroll
                for (int bj = 0; bj < 2; ++bj) { const f32x4 ps = *(const LAS f32x4*)(xch + (rl * 2 + bj) * 4);
                    const float rstd = rsqrtf(((ps[0] + ps[1]) + (ps[2] + ps[3])) * (1.0f / 128.0f) + 1e-6f) * (isq ? qs : 1.0f);
                    const int head = 2 * u.pn + bj; float r[8];
#pragma unroll
                    for (int e = 0; e < 8; ++e) { const float y = acc[ai][bj][m][e >> 2][e & 3] * rstd * (e < 4 ? ga[e] : gb[e - 4]); const float yp = __shfl_xor(y, 32);
                        const float c = cs[e >> 1][2 * (e & 1)], sn = cs[e >> 1][2 * (e & 1) + 1];
                        r[e] = x2 ? (y * c + yp * sn) : (y * c - yp * sn); }
                    u32x4 w; w.x = cvt_pk_bf16(r[0], r[1]); w.y = cvt_pk_bf16(r[2], r[3]); w.z = cvt_pk_bf16(r[4], r[5]); w.w = cvt_pk_bf16(r[6], r[7]);
                    bf16_t* dst = isq ? Qp + row * 1024 + head * 128 + d0 : Kp + ((size_t)(bb * 2 + (head - 8)) * HM_TPB + (row - (size_t)bb * HM_TPB)) * 128 + d0;
                    st16(dst, w); } }
    }
};

template <class Epi, class Sched, bool GATHER, bool FP8 = false>
__device__ __forceinline__ void gemm_phase(LAS unsigned char* lds, const Gemm g, const Sched& S, const Epi& E, const int wid) {
    const int lane = fresh_lane(), tid = wid * 64 + lane, wr = wid >> 2, wc = wid & 3, fr = lane & 15, fq = lane >> 4;
    const int K = g.K, nt = g.nt;
    unsigned voffA[2], voffB[2];
#pragma unroll
    for (int i = 0; i < 2; ++i) { int R, C; stage_rc(tid * 16 + i * 8192, R, C); const int Rb = Epi::PERM ? ((R & ~31) + perm32(R & 31)) : R;
        voffA[i] = (unsigned)(R * K + C) * 2u; voffB[i] = (unsigned)(Rb * K + C) * 2u; }
    const size_t kstep = (size_t)(BK * 2);
    const size_t hstep = (size_t)HALF * K * 2;
    const size_t tstep = 2 * hstep;
    const unsigned ldsw = (unsigned)wid * 1024u;
    const int aoff = lds_byte(wr * 64 + fr, fq * 8), boff = lds_byte(wc * 32 + fr, fq * 8);
#define PG8_SA(b, h) (((b) * 2 + (h)) * HTB)
#define PG8_SB(b, h) ((4 + (b) * 2 + (h)) * HTB)
#define PG8_STAGE(bufoff, gbase, voff) do { _Pragma("unroll") for (int _i = 0; _i < 2; ++_i) \
        __builtin_amdgcn_global_load_lds((const unsigned*)((const char*)(gbase) + (voff)[_i]), (LAS unsigned*)(lds + (bufoff) + ldsw + _i * 8192), 16, 0, 0); } while (0)
#define PG8_STAGE_A(bufoff, Ap, G, h, kb) do { if constexpr (GATHER) { PG8_STAGE(bufoff, (const char*)g.A + (kb), (G)[h]); } else { PG8_STAGE(bufoff, (Ap) + (size_t)(h) * hstep + (kb), voffA); } } while (0)
#define PG8_LD16(off) (*(const LAS u32x4*)(lds + (off)))
#define PG8_LDA(dst, b, h) do { _Pragma("unroll") for (int m = 0; m < 4; ++m) { if constexpr (FP8) { dst##8[m] = __builtin_bit_cast(v8i32, __builtin_shufflevector(PG8_LD16(PG8_SA(b, h) + aoff + m * 2048), PG8_LD16(PG8_SA(b, h) + aoff + m * 2048 + 1024), 0, 1, 2, 3, 4, 5, 6, 7)); } \
        else { _Pragma("unroll") for (int k = 0; k < 2; ++k) dst[m][k] = *(const LAS bf16x8*)(lds + PG8_SA(b, h) + aoff + m * 2048 + k * 1024); } } } while (0)
#define PG8_LDB(dst, b, h) do { _Pragma("unroll") for (int n = 0; n < 2; ++n) { if constexpr (FP8) { dst##8[n] = __builtin_bit_cast(v8i32, __builtin_shufflevector(PG8_LD16(PG8_SB(b, h) + boff + n * 2048), PG8_LD16(PG8_SB(b, h) + boff + n * 2048 + 1024), 0, 1, 2, 3, 4, 5, 6, 7)); } \
        else { _Pragma("unroll") for (int k = 0; k < 2; ++k) dst[n][k] = *(const LAS bf16x8*)(lds + PG8_SB(b, h) + boff + n * 2048 + k * 1024); } } } while (0)
#define PG8_MMA(ai, bj, At, Bt) do { __builtin_amdgcn_s_setprio(1); _Pragma("unroll") for (int m = 0; m < 4; ++m) _Pragma("unroll") for (int n = 0; n < 2; ++n) { \
        if constexpr (FP8) { asm volatile("v_mfma_scale_f32_16x16x128_f8f6f4 %0, %1, %2, %0, %3, %3 op_sel_hi:[0,0,0]" : "+v"(acc[ai][bj][m][n]) : "v"(Bt##8[n]), "v"(At##8[m]), "v"(sc7f)); } \
        else { _Pragma("unroll") for (int k = 0; k < 2; ++k) acc[ai][bj][m][n] = __builtin_amdgcn_mfma_f32_16x16x32_bf16(Bt[n][k], At[m][k], acc[ai][bj][m][n], 0, 0, 0); } } \
        __builtin_amdgcn_s_setprio(0); } while (0)
#define PG8_WAIT_V(n) asm volatile("s_waitcnt vmcnt(" #n ")" ::: "memory")
#define PG8_WAIT_L(n) asm volatile("s_waitcnt lgkmcnt(" #n ")" ::: "memory")
#define PG8_BAR __builtin_amdgcn_s_barrier()
#define PG8_SCHED __builtin_amdgcn_sched_barrier(0)
    LAS unsigned char* tokt = lds + STAGE_BYTES;
#define PG8_TOKDMA(u, slot) do { if constexpr (GATHER) { if (wid < 4) { const unsigned _cn = (unsigned)g.cnt[(u).e]; const unsigned _s = (unsigned)((u).pl * BM + tid); \
        __builtin_amdgcn_global_load_lds((const unsigned*)(g.list + (size_t)(u).e * g.list_stride + (_s < _cn ? _s : _cn - 1u)), (LAS unsigned*)(tokt + (slot) * 1024 + wid * 256), 4, 0, 0); } } } while (0)
#define PG8_GOFFS(go, slot) do { if constexpr (GATHER) { \
        _Pragma("unroll") for (int _h = 0; _h < 2; ++_h) _Pragma("unroll") for (int _i = 0; _i < 2; ++_i) { int _R, _C; stage_rc(tid * 16 + _i * 8192, _R, _C); \
            const unsigned _t = *(const LAS unsigned*)(tokt + (slot) * 1024 + (_h * HALF + _R) * 4); (go)[_h][_i] = (_t * (unsigned)K + (unsigned)_C) * 2u; } } } while (0)
    Unit cur, nxt; int ui = 0;
    if (!S.next(0, cur)) return;
    f32x4 acc[2][2][4][2];
#pragma unroll
    for (int a = 0; a < 2; ++a)
#pragma unroll
        for (int b = 0; b < 2; ++b)
#pragma unroll
            for (int m = 0; m < 4; ++m)
#pragma unroll
                for (int n = 0; n < 2; ++n) acc[a][b][m][n] = (f32x4){0.f, 0.f, 0.f, 0.f};
    const unsigned sc7f = 0x7F7F7F7Fu;
    bf16x8 At[4][2], B0[2][2], B1[2][2]; v8i32 At8[4], B08[2], B18[2];
    unsigned gcur[2][2] = {{0u, 0u}, {0u, 0u}};
    const char* cA = (const char*)g.A + (size_t)cur.pm * tstep + (size_t)cur.kt0 * kstep; const char* cB = (const char*)g.Bt + ((size_t)cur.e * g.bstride) * 2 + (size_t)cur.pn * tstep + (size_t)cur.kt0 * kstep;
    if constexpr (GATHER) { PG8_TOKDMA(cur, 0); asm volatile("s_waitcnt vmcnt(0)" ::: "memory"); __builtin_amdgcn_s_barrier(); asm volatile("" ::: "memory"); }
    PG8_GOFFS(gcur, 0);
    PG8_STAGE(PG8_SB(0, 0), cB, voffB); PG8_STAGE(PG8_SB(0, 1), cB + hstep, voffB); PG8_STAGE_A(PG8_SA(0, 0), cA, gcur, 0, 0); PG8_STAGE_A(PG8_SA(0, 1), cA, gcur, 1, 0);
    if (wr == 1) PG8_BAR;
    PG8_WAIT_V(2); PG8_BAR;
    PG8_STAGE(PG8_SB(1, 0), cB + kstep, voffB); PG8_STAGE_A(PG8_SA(1, 0), cA, gcur, 0, kstep); PG8_STAGE(PG8_SB(1, 1), cB + hstep + kstep, voffB);
    PG8_WAIT_V(6); PG8_BAR;
    for (;;) {
        const bool has_next = S.next(ui + 1, nxt);
        if constexpr (GATHER) { if (has_next) PG8_TOKDMA(nxt, (ui + 1) & 1); }
        const char* nA = has_next ? (const char*)g.A + (size_t)nxt.pm * tstep + (size_t)nxt.kt0 * kstep : cA; const char* nB = has_next ? (const char*)g.Bt + ((size_t)nxt.e * g.bstride) * 2 + (size_t)nxt.pn * tstep + (size_t)nxt.kt0 * kstep : cB;
#pragma unroll 1
        for (int t = 0; t < nt; t += 2) {
            const bool last = (t == nt - 2);
            const size_t kb1 = (size_t)(t + 1) * kstep;
            const char* a2p = last ? nA : cA; const size_t kb2 = last ? (size_t)0 : (size_t)(t + 2) * kstep;
            const char* b2 = last ? nB : cB + (size_t)(t + 2) * kstep;
            const size_t kb3 = kb2 + kstep; const char* b3 = b2 + kstep;
            PG8_LDB(B0, 0, 0); PG8_LDB(B1, 0, 1); PG8_SCHED; PG8_LDA(At, 0, 0); PG8_STAGE_A(PG8_SA(1, 1), cA, gcur, 1, kb1);
            if constexpr (GATHER) { if (last && has_next) { PG8_GOFFS(gcur, (ui + 1) & 1); } }
            PG8_WAIT_V(8); PG8_WAIT_L(0); PG8_BAR; PG8_MMA(0, 0, At, B0); PG8_MMA(0, 1, At, B1); PG8_BAR; PG8_SCHED;
            PG8_LDA(At, 0, 1); PG8_STAGE(PG8_SB(0, 0), b2, voffB); PG8_STAGE(PG8_SB(0, 1), b2 + hstep, voffB); PG8_STAGE_A(PG8_SA(0, 0), a2p, gcur, 0, kb2);
            PG8_WAIT_V(8); PG8_WAIT_L(0); PG8_BAR; PG8_MMA(1, 0, At, B0); PG8_MMA(1, 1, At, B1); PG8_BAR; PG8_SCHED;
            PG8_LDB(B0, 1, 0); PG8_LDB(B1, 1, 1); PG8_SCHED; PG8_LDA(At, 1, 0); PG8_STAGE_A(PG8_SA(0, 1), a2p, gcur, 1, kb2);
            PG8_WAIT_V(8); PG8_WAIT_L(0); PG8_BAR; PG8_MMA(0, 0, At, B0); PG8_MMA(0, 1, At, B1); PG8_BAR; PG8_SCHED;
            PG8_LDA(At, 1, 1); PG8_STAGE(PG8_SB(1, 0), b3, voffB); PG8_STAGE(PG8_SB(1, 1), b3 + hstep, voffB); PG8_STAGE_A(PG8_SA(1, 0), a2p, gcur, 0, kb3);
            PG8_WAIT_V(8); PG8_WAIT_L(0); PG8_BAR; PG8_MMA(1, 0, At, B0); PG8_MMA(1, 1, At, B1); PG8_BAR; PG8_SCHED;
        }
        if (wr == 0) PG8_BAR;
        if constexpr (FP8) asm volatile("s_nop 15\n\ts_nop 15\n\ts_nop 15\n\ts_nop 15" ::: "memory");
        E(acc, cur, wr, wc, fr, fq);
        if (!has_next) break;
#pragma unroll
        for (int a = 0; a < 2; ++a)
#pragma unroll
            for (int b = 0; b < 2; ++b)
#pragma unroll
                for (int m = 0; m < 4; ++m)
#pragma unroll
                    for (int n = 0; n < 2; ++n) acc[a][b][m][n] = (f32x4){0.f, 0.f, 0.f, 0.f};
        cur = nxt; cA = nA; cB = nB; ++ui;
        if (wr == 1) PG8_BAR;
    }
    PG8_WAIT_V(0);
    PG8_BAR;
#undef PG8_SA
#undef PG8_SB
#undef PG8_STAGE
#undef PG8_STAGE_A
#undef PG8_LDA
#undef PG8_LDB
#undef PG8_MMA
#undef PG8_LD16
#undef PG8_WAIT_V
#undef PG8_WAIT_L
#undef PG8_BAR
#undef PG8_SCHED
#undef PG8_GOFFS
#undef PG8_TOKDMA
}
}
namespace att {
constexpr int NW = 8, QBLK = 32, KVBLK = 64;
constexpr float THR = 8.f;
#define ATT_SBAR() __builtin_amdgcn_sched_barrier(0)
template <int DK> __device__ __forceinline__ int kswz(int row, int colB) { return row * (DK * 2 + 16) + colB; }
__device__ __forceinline__ int crow(int r, int hi) { return (r & 3) + 8 * (r >> 2) + 4 * hi; }
__device__ __forceinline__ void partialSM(f32x16& p0, f32x16& p1, float& m_reg, float& mn, float& alpha, const float C, const float thr_raw) {
    float pmax = p0[0];
#pragma unroll
    for (int r = 1; r < 16; ++r) pmax = fmaxf(pmax, p0[r]);
#pragma unroll
    for (int r = 0; r < 16; ++r) pmax = fmaxf(pmax, p1[r]);
    { auto rr = __builtin_amdgcn_permlane32_swap(__float_as_uint(pmax), __float_as_uint(pmax), false, false);
      pmax = fmaxf(__uint_as_float(rr[0]), __uint_as_float(rr[1])); }
    if (__builtin_expect(__all(pmax - m_reg <= thr_raw), 1)) { mn = m_reg; alpha = 1.f; }
    else { mn = fmaxf(m_reg, pmax); alpha = __builtin_amdgcn_exp2f((m_reg - mn) * C); m_reg = mn; }
    const float mnC = -mn * C;
#pragma unroll
    for (int r = 0; r < 16; ++r) p0[r] = fmaf(p0[r], C, mnC);
#pragma unroll
    for (int r = 0; r < 16; ++r) p1[r] = fmaf(p1[r], C, mnC);
#pragma unroll
    for (int r = 0; r < 16; ++r) p0[r] = __builtin_amdgcn_exp2f(p0[r]);
}
__device__ __forceinline__ void finishSM(f32x16& p0, f32x16& p1, float alpha, float& l_reg, bf16x8& pa0, bf16x8& pa1, bf16x8& pa2, bf16x8& pa3) {
#pragma unroll
    for (int r = 0; r < 16; ++r) p1[r] = __builtin_amdgcn_exp2f(p1[r]);
#if MK_PROBE_ATT == 2
    { float dz = 0.f;
#pragma unroll
      for (int r = 0; r < 16; ++r) { dz += __builtin_amdgcn_exp2f(p0[r] - 1.0f); dz += __builtin_amdgcn_exp2f(p1[r] - 2.0f); }
      asm volatile("" :: "v"(dz)); }
#endif
    float ps = 0;
#pragma unroll
    for (int r = 0; r < 16; ++r) ps += p0[r];
#pragma unroll
    for (int r = 0; r < 16; ++r) ps += p1[r];
    { auto rr = __builtin_amdgcn_permlane32_swap(__float_as_uint(ps), __float_as_uint(ps), false, false);
      ps = __uint_as_float(rr[0]) + __uint_as_float(rr[1]); }
    l_reg = l_reg * alpha + ps;
#define ATT_PK4(P, BASE, OUT) do { unsigned a0 = cvt_pk_bf16(P[BASE + 0], P[BASE + 1]), a1 = cvt_pk_bf16(P[BASE + 2], P[BASE + 3]);   \
    unsigned b0 = cvt_pk_bf16(P[BASE + 4], P[BASE + 5]), b1 = cvt_pk_bf16(P[BASE + 6], P[BASE + 7]);                              \
    auto r0 = __builtin_amdgcn_permlane32_swap(a0, b0, false, false); auto r1 = __builtin_amdgcn_permlane32_swap(a1, b1, false, false); \
    u32x4 w = {r0[0], r1[0], r0[1], r1[1]}; OUT = *reinterpret_cast<bf16x8*>(&w); } while (0)
    ATT_PK4(p0, 0, pa0); ATT_PK4(p0, 8, pa1); ATT_PK4(p1, 0, pa2); ATT_PK4(p1, 8, pa3);
#undef ATT_PK4
}
#ifndef MK_PROBE_ATT
#define MK_PROBE_ATT 0
#endif
template <int DK> __device__ __forceinline__ void qkt(f32x16& p0, f32x16& p1, const char* Ks, const bf16x8* qr, int r32, int hi) {
    p0 = f32x16{}; p1 = f32x16{};
#if MK_PROBE_ATT == 1
    f32x16 d0_ = f32x16{}; d0_[0] = 1.0f;
#endif
#pragma unroll
    for (int d0 = 0; d0 < DK / 16; ++d0) { const int cb = (d0 * 16 + hi * 8) * 2;
        const bf16x8 b0 = *reinterpret_cast<const bf16x8*>(Ks + kswz<DK>(r32, cb));
        const bf16x8 b1 = *reinterpret_cast<const bf16x8*>(Ks + kswz<DK>(32 + r32, cb));
        p0 = __builtin_amdgcn_mfma_f32_32x32x16_bf16(b0, qr[d0], p0, 0, 0, 0);
        p1 = __builtin_amdgcn_mfma_f32_32x32x16_bf16(b1, qr[d0], p1, 0, 0, 0);
#if MK_PROBE_ATT == 1
        d0_ = __builtin_amdgcn_mfma_f32_32x32x16_bf16(b0, qr[d0], d0_, 0, 0, 0);
        d0_ = __builtin_amdgcn_mfma_f32_32x32x16_bf16(b1, qr[d0], d0_, 0, 0, 0);
#endif
    }
#if MK_PROBE_ATT == 1
    asm volatile("" :: "v"(d0_));
#endif
}
template <int DV> __device__ __forceinline__ int v_st(int k, int c) { const int kk = (k & ~0xC) | ((k & 4) << 1) | ((k & 8) >> 1); return ((kk >> 3) * (DV / 32) + (c >> 5)) * 512 + ((kk & 7) * 32 + (c & 31)) * 2; }
__device__ __forceinline__ int v_rd_base(int lane) { return ((lane & 3) << 3) | (((lane >> 2) & 3) << 6) | (((lane >> 4) & 1) << 5) | (((lane >> 5) & 1) << 8); }
template <int DV> constexpr int v_rd_off(int d0, int ks, int half) { return d0 * 512 + ks * (DV / 32) * 1024 + half * (DV / 32) * 512; }
template <int OFF> __device__ __forceinline__ s16x4 tr_read(int vb) {
    s16x4 r; asm volatile("ds_read_b64_tr_b16 %0, %1 offset:%2" : "=&v"(r) : "v"(vb), "i"(OFF) : "memory"); return r;
}
template <int DV, int D0> __device__ __forceinline__ void pv_one(f32x16& od, int vb, bf16x8 pa0, bf16x8 pa1, bf16x8 pa2, bf16x8 pa3) {
    const s16x4 l0 = tr_read<v_rd_off<DV>(D0, 0, 0)>(vb), h0 = tr_read<v_rd_off<DV>(D0, 0, 1)>(vb), l1 = tr_read<v_rd_off<DV>(D0, 1, 0)>(vb), h1 = tr_read<v_rd_off<DV>(D0, 1, 1)>(vb);
    const s16x4 l2 = tr_read<v_rd_off<DV>(D0, 2, 0)>(vb), h2 = tr_read<v_rd_off<DV>(D0, 2, 1)>(vb), l3 = tr_read<v_rd_off<DV>(D0, 3, 0)>(vb), h3 = tr_read<v_rd_off<DV>(D0, 3, 1)>(vb);
    asm volatile("s_waitcnt lgkmcnt(0)" ::: "memory"); ATT_SBAR();
#define ATT_PK(L, H) (bf16x8){L[0], L[1], L[2], L[3], H[0], H[1], H[2], H[3]}
    od = __builtin_amdgcn_mfma_f32_32x32x16_bf16(pa0, ATT_PK(l0, h0), od, 0, 0, 0);
    od = __builtin_amdgcn_mfma_f32_32x32x16_bf16(pa1, ATT_PK(l1, h1), od, 0, 0, 0);
    od = __builtin_amdgcn_mfma_f32_32x32x16_bf16(pa2, ATT_PK(l2, h2), od, 0, 0, 0);
    od = __builtin_amdgcn_mfma_f32_32x32x16_bf16(pa3, ATT_PK(l3, h3), od, 0, 0, 0);
#undef ATT_PK
}
template <int DV, int D0> __device__ __forceinline__ void pv_two(f32x16& oa, f32x16& ob, int vb, bf16x8 pa0, bf16x8 pa1, bf16x8 pa2, bf16x8 pa3) {
    const s16x4 l0 = tr_read<v_rd_off<DV>(D0, 0, 0)>(vb), h0 = tr_read<v_rd_off<DV>(D0, 0, 1)>(vb), l1 = tr_read<v_rd_off<DV>(D0, 1, 0)>(vb), h1 = tr_read<v_rd_off<DV>(D0, 1, 1)>(vb);
    const s16x4 l2 = tr_read<v_rd_off<DV>(D0, 2, 0)>(vb), h2 = tr_read<v_rd_off<DV>(D0, 2, 1)>(vb), l3 = tr_read<v_rd_off<DV>(D0, 3, 0)>(vb), h3 = tr_read<v_rd_off<DV>(D0, 3, 1)>(vb);
    const s16x4 m0 = tr_read<v_rd_off<DV>(D0 + 1, 0, 0)>(vb), n0 = tr_read<v_rd_off<DV>(D0 + 1, 0, 1)>(vb), m1 = tr_read<v_rd_off<DV>(D0 + 1, 1, 0)>(vb), n1 = tr_read<v_rd_off<DV>(D0 + 1, 1, 1)>(vb);
    const s16x4 m2 = tr_read<v_rd_off<DV>(D0 + 1, 2, 0)>(vb), n2 = tr_read<v_rd_off<DV>(D0 + 1, 2, 1)>(vb), m3 = tr_read<v_rd_off<DV>(D0 + 1, 3, 0)>(vb), n3 = tr_read<v_rd_off<DV>(D0 + 1, 3, 1)>(vb);
    asm volatile("s_waitcnt lgkmcnt(0)" ::: "memory"); ATT_SBAR();
#define ATT_PK(L, H) (bf16x8){L[0], L[1], L[2], L[3], H[0], H[1], H[2], H[3]}
    oa = __builtin_amdgcn_mfma_f32_32x32x16_bf16(pa0, ATT_PK(l0, h0), oa, 0, 0, 0);
    ob = __builtin_amdgcn_mfma_f32_32x32x16_bf16(pa0, ATT_PK(m0, n0), ob, 0, 0, 0);
    oa = __builtin_amdgcn_mfma_f32_32x32x16_bf16(pa1, ATT_PK(l1, h1), oa, 0, 0, 0);
    ob = __builtin_amdgcn_mfma_f32_32x32x16_bf16(pa1, ATT_PK(m1, n1), ob, 0, 0, 0);
    oa = __builtin_amdgcn_mfma_f32_32x32x16_bf16(pa2, ATT_PK(l2, h2), oa, 0, 0, 0);
    ob = __builtin_amdgcn_mfma_f32_32x32x16_bf16(pa2, ATT_PK(m2, n2), ob, 0, 0, 0);
    oa = __builtin_amdgcn_mfma_f32_32x32x16_bf16(pa3, ATT_PK(l3, h3), oa, 0, 0, 0);
    ob = __builtin_amdgcn_mfma_f32_32x32x16_bf16(pa3, ATT_PK(m3, n3), ob, 0, 0, 0);
#undef ATT_PK
}
struct VFrag64 { s16x4 l[2][4], h[2][4]; };
template <int DV> __device__ __forceinline__ void pv_issue(VFrag64& f, int vb) {
    f.l[0][0] = tr_read<v_rd_off<DV>(0, 0, 0)>(vb); f.h[0][0] = tr_read<v_rd_off<DV>(0, 0, 1)>(vb); f.l[0][1] = tr_read<v_rd_off<DV>(0, 1, 0)>(vb); f.h[0][1] = tr_read<v_rd_off<DV>(0, 1, 1)>(vb);
    f.l[0][2] = tr_read<v_rd_off<DV>(0, 2, 0)>(vb); f.h[0][2] = tr_read<v_rd_off<DV>(0, 2, 1)>(vb); f.l[0][3] = tr_read<v_rd_off<DV>(0, 3, 0)>(vb); f.h[0][3] = tr_read<v_rd_off<DV>(0, 3, 1)>(vb);
    f.l[1][0] = tr_read<v_rd_off<DV>(1, 0, 0)>(vb); f.h[1][0] = tr_read<v_rd_off<DV>(1, 0, 1)>(vb); f.l[1][1] = tr_read<v_rd_off<DV>(1, 1, 0)>(vb); f.h[1][1] = tr_read<v_rd_off<DV>(1, 1, 1)>(vb);
    f.l[1][2] = tr_read<v_rd_off<DV>(1, 2, 0)>(vb); f.h[1][2] = tr_read<v_rd_off<DV>(1, 2, 1)>(vb); f.l[1][3] = tr_read<v_rd_off<DV>(1, 3, 0)>(vb); f.h[1][3] = tr_read<v_rd_off<DV>(1, 3, 1)>(vb);
}
__device__ __forceinline__ void pv_mma64(f32x16* o, const VFrag64& f, bf16x8 pa0, bf16x8 pa1, bf16x8 pa2, bf16x8 pa3) {
    asm volatile("s_waitcnt lgkmcnt(0)" ::: "memory"); ATT_SBAR();
#define ATT_PK(L, H) (bf16x8){L[0], L[1], L[2], L[3], H[0], H[1], H[2], H[3]}
    o[0] = __builtin_amdgcn_mfma_f32_32x32x16_bf16(pa0, ATT_PK(f.l[0][0], f.h[0][0]), o[0], 0, 0, 0);
    o[1] = __builtin_amdgcn_mfma_f32_32x32x16_bf16(pa0, ATT_PK(f.l[1][0], f.h[1][0]), o[1], 0, 0, 0);
    o[0] = __builtin_amdgcn_mfma_f32_32x32x16_bf16(pa1, ATT_PK(f.l[0][1], f.h[0][1]), o[0], 0, 0, 0);
    o[1] = __builtin_amdgcn_mfma_f32_32x32x16_bf16(pa1, ATT_PK(f.l[1][1], f.h[1][1]), o[1], 0, 0, 0);
    o[0] = __builtin_amdgcn_mfma_f32_32x32x16_bf16(pa2, ATT_PK(f.l[0][2], f.h[0][2]), o[0], 0, 0, 0);
    o[1] = __builtin_amdgcn_mfma_f32_32x32x16_bf16(pa2, ATT_PK(f.l[1][2], f.h[1][2]), o[1], 0, 0, 0);
    o[0] = __builtin_amdgcn_mfma_f32_32x32x16_bf16(pa3, ATT_PK(f.l[0][3], f.h[0][3]), o[0], 0, 0, 0);
    o[1] = __builtin_amdgcn_mfma_f32_32x32x16_bf16(pa3, ATT_PK(f.l[1][3], f.h[1][3]), o[1], 0, 0, 0);
#undef ATT_PK
}
#ifndef MK_PV2
#define MK_PV2 1
#endif
#ifndef MK_VPRE
#define MK_VPRE 0
#endif
#ifndef MK_MBLK
#define MK_MBLK 1
#endif
#ifndef MK_ATT_PRIO
#define MK_ATT_PRIO 1
#endif
template <int DV> __device__ __forceinline__ void pv_d0(f32x16* o, int vb, bf16x8 pa0, bf16x8 pa1, bf16x8 pa2, bf16x8 pa3) {
#if MK_PV2
    pv_two<DV, 0>(o[0], o[1], vb, pa0, pa1, pa2, pa3);
    if constexpr (DV == 128) pv_two<DV, 2>(o[2], o[3], vb, pa0, pa1, pa2, pa3);
#else
    pv_one<DV, 0>(o[0], vb, pa0, pa1, pa2, pa3); pv_one<DV, 1>(o[1], vb, pa0, pa1, pa2, pa3);
    if constexpr (DV == 128) { pv_one<DV, 2>(o[2], vb, pa0, pa1, pa2, pa3); pv_one<DV, 3>(o[3], vb, pa0, pa1, pa2, pa3); }
#endif
}
template <int DK, int DV> constexpr int lds_bytes() { return 3 * KVBLK * DV * 2 + 3 * KVBLK * (DK * 2 + 16) + NW * 64 * 4; }

template <int DK, int DV, int ldq, int ldk, int ldv, int ldo, int SD, int EPI = 0>
__device__ __forceinline__ void attn_unit(const bf16_t* __restrict__ Qb, const bf16_t* __restrict__ Kh, const bf16_t* __restrict__ Vh,
                                          bf16_t* __restrict__ Ob, int seq, const float C, const float thr_raw, char* lds, const int wid, LAS unsigned* stash = nullptr, float lam = 0.f, const float* gvec = nullptr) {
    constexpr int SHM_V = KVBLK * DV * 2, SHM_K = KVBLK * (DK * 2 + 16);
    constexpr int NO = DV / 32, ND = DK / 16;
    const int lane = fresh_lane(), tid = wid * 64 + lane, r32 = lane & 31, hi = lane >> 5;
    char* V_lds = lds; char* K_lds = lds + 3 * SHM_V;
    float* wsf = (float*)(lds + 3 * SHM_V + 3 * SHM_K) + wid * 64; float* li_l = wsf; float* al_l = wsf + 32;
    float m_reg = -1e30f, l_reg = 0; f32x16 o[NO]; bf16x8 qr[ND];
#pragma unroll
    for (int d = 0; d < NO; ++d) o[d] = f32x16{};
    const bf16_t* Qw = Qb + (long)(wid * QBLK + r32) * ldq + hi * 8;
#pragma unroll
    for (int d0 = 0; d0 < ND; ++d0) qr[d0] = *reinterpret_cast<const bf16x8*>(Qw + d0 * 16);
    const int sr = tid >> 4, sc = (tid & 15) * 8; const bool kact = (DK == 128) ? true : (sc < DK), vact = (DV == 128) ? true : (sc < DV);
    const int vst0 = v_st<DV>(sr, vact ? sc : 0), vst1 = v_st<DV>(32 + sr, vact ? sc : 0);
    const int vb0 = (int)(uintptr_t)V_lds + v_rd_base(lane);
    const unsigned koff = (unsigned)(sr * ldk + sc) * 2u, voff = (unsigned)(sr * ldv + sc) * 2u;
    const size_t k32 = (size_t)32 * ldk * 2, v32 = (size_t)32 * ldv * 2;
    struct { bf16x8 vs0, vs1, ks0, ks1; } sr_[SD];
#define ATT_SLOAD(s, k0) do { const char* _kt = (const char*)Kh + (size_t)(k0) * ldk * 2; const char* _vt = (const char*)Vh + (size_t)(k0) * ldv * 2; \
    if (vact) { sr_[s].vs0 = *reinterpret_cast<const bf16x8*>(_vt + voff); sr_[s].vs1 = *reinterpret_cast<const bf16x8*>(_vt + v32 + voff); } \
    if (kact) { sr_[s].ks0 = *reinterpret_cast<const bf16x8*>(_kt + koff); sr_[s].ks1 = *reinterpret_cast<const bf16x8*>(_kt + k32 + koff); } } while (0)
#define ATT_SWRITE(b, s) do { if (vact) { *(bf16x8*)(V_lds + (b) * SHM_V + vst0) = sr_[s].vs0; *(bf16x8*)(V_lds + (b) * SHM_V + vst1) = sr_[s].vs1; } \
    if (kact) { const int kc = sc * 2; *(bf16x8*)(K_lds + (b) * SHM_K + kswz<DK>(sr, kc)) = sr_[s].ks0; *(bf16x8*)(K_lds + (b) * SHM_K + kswz<DK>(32 + sr, kc)) = sr_[s].ks1; } } while (0)
#define ATT_RESC(a) do { if (__any((a) < 1.f)) { if (hi == 0) al_l[r32] = (a); asm volatile("s_waitcnt lgkmcnt(0)" ::: "memory"); \
    _Pragma("unroll") for (int d = 0; d < NO; ++d) _Pragma("unroll") for (int r = 0; r < 16; ++r) o[d][r] *= al_l[crow(r, hi)]; } } while (0)
    f32x16 pA0, pA1, pB0, pB1; float mnA, mnB, alA, alB; bf16x8 pa0, pa1, pa2, pa3; const int NT = seq / KVBLK;
    constexpr int SE = 0, SO = SD - 1;
    constexpr bool VPRE = (DV == 64) && (MK_VPRE != 0); VFrag64 vf;
    __syncthreads();
    ATT_SLOAD(SE, 0); asm volatile("s_waitcnt vmcnt(0)" ::: "memory"); ATT_SWRITE(0, SE); __syncthreads();
    qkt<DK>(pA0, pA1, K_lds, qr, r32, hi); partialSM(pA0, pA1, m_reg, mnA, alA, C, thr_raw);
    ATT_SLOAD(SO, KVBLK); if constexpr (SD == 2) { if (2 < NT) ATT_SLOAD(SE, 2 * KVBLK); }
    ATT_SWRITE(1, SO); __syncthreads();
    int bj = 1;
    for (int j = 1; j + 1 < NT; j += 2) {
        const int bn = (bj == 2) ? 0 : bj + 1, bp = (bj == 0) ? 2 : bj - 1;
        ATT_SBAR(); if constexpr (VPRE) pv_issue<DV>(vf, vb0 + bp * SHM_V);
        qkt<DK>(pB0, pB1, K_lds + bj * SHM_K, qr, r32, hi);
        finishSM(pA0, pA1, alA, l_reg, pa0, pa1, pa2, pa3); ATT_SBAR();
        ATT_SLOAD(SO, (j + SD) * KVBLK); ATT_SBAR();
        if constexpr (VPRE) pv_mma64(o, vf, pa0, pa1, pa2, pa3); else pv_d0<DV>(o, vb0 + bp * SHM_V, pa0, pa1, pa2, pa3);
        partialSM(pB0, pB1, m_reg, mnB, alB, C, thr_raw);
        ATT_SWRITE(bn, SE);
        ATT_RESC(alB); __syncthreads();
        ATT_SBAR(); if constexpr (VPRE) pv_issue<DV>(vf, vb0 + bj * SHM_V);
        qkt<DK>(pA0, pA1, K_lds + bn * SHM_K, qr, r32, hi);
        finishSM(pB0, pB1, alB, l_reg, pa0, pa1, pa2, pa3); ATT_SBAR();
        if (SD == 1 || j + 3 < NT) ATT_SLOAD(SE, (j + 1 + SD) * KVBLK); ATT_SBAR();
        if constexpr (VPRE) pv_mma64(o, vf, pa0, pa1, pa2, pa3); else pv_d0<DV>(o, vb0 + bj * SHM_V, pa0, pa1, pa2, pa3);
        partialSM(pA0, pA1, m_reg, mnA, alA, C, thr_raw);
        ATT_SWRITE(bp, SO);
        ATT_RESC(alA); __syncthreads();
        bj = bp;
    }
    { const int bp = (bj == 0) ? 2 : bj - 1;
      ATT_SBAR(); qkt<DK>(pB0, pB1, K_lds + bj * SHM_K, qr, r32, hi);
      finishSM(pA0, pA1, alA, l_reg, pa0, pa1, pa2, pa3); ATT_SBAR();
      pv_d0<DV>(o, vb0 + bp * SHM_V, pa0, pa1, pa2, pa3); partialSM(pB0, pB1, m_reg, mnB, alB, C, thr_raw);
      ATT_RESC(alB);
      finishSM(pB0, pB1, alB, l_reg, pa0, pa1, pa2, pa3); ATT_SBAR();
      pv_d0<DV>(o, vb0 + bj * SHM_V, pa0, pa1, pa2, pa3); }
    if (hi == 0) li_l[r32] = l_reg; asm volatile("s_waitcnt lgkmcnt(0)" ::: "memory");
    float rli[16];
#pragma unroll
    for (int r = 0; r < 16; ++r) rli[r] = __builtin_amdgcn_rcpf(li_l[crow(r, hi)]);
    if constexpr (EPI == 1) {
#pragma unroll
        for (int r = 0; r < 16; ++r)
#pragma unroll
            for (int p = 0; p < NO / 2; ++p) stash[(r * (NO / 2) + p) * 64 + lane] = pk2(o[2 * p][r] * rli[r], o[2 * p + 1][r] * rli[r]);
    } else if constexpr (EPI == 2) {
        static_assert(EPI != 2 || DV == 128, "differential combine: DV = 128");
        float gl[NO];
#pragma unroll
        for (int d0 = 0; d0 < NO; ++d0) gl[d0] = gvec[d0 * 32 + r32];
        bf16_t* Ow = Ob + (long)(wid * QBLK) * ldo;
#pragma unroll
        for (int r = 0; r < 16; ++r) { float v[NO]; float ss = 0.f;
#pragma unroll
            for (int p = 0; p < NO / 2; ++p) { const unsigned w = stash[(r * (NO / 2) + p) * 64 + lane];
                v[2 * p] = o[2 * p][r] * rli[r] - lam * bf2f(w & 0xffffu); v[2 * p + 1] = o[2 * p + 1][r] * rli[r] - lam * bf2f(w >> 16); ss += v[2 * p] * v[2 * p] + v[2 * p + 1] * v[2 * p + 1]; }
#pragma unroll
            for (int x = 1; x < 32; x <<= 1) ss += __shfl_xor(ss, x);
            const float rstd = rsqrtf(ss * (1.0f / 128.0f) + 1e-6f); const int orow = crow(r, hi);
#pragma unroll
            for (int d0 = 0; d0 < NO; ++d0) Ow[(long)orow * ldo + d0 * 32 + r32] = (bf16_t)f2bf(v[d0] * rstd * gl[d0]); }
    } else {
    bf16_t* Ow = Ob + (long)(wid * QBLK) * ldo;
#pragma unroll
    for (int r = 0; r < 16; ++r) { const int orow = crow(r, hi);
#pragma unroll
        for (int d0 = 0; d0 < NO; ++d0) Ow[(long)orow * ldo + d0 * 32 + r32] = (bf16_t)f2bf(o[d0][r] * rli[r]); }
    }
#undef ATT_SLOAD
#undef ATT_SWRITE
#undef ATT_RESC
}

constexpr float THRL = THR * 1.4426950408889634f;
__device__ __forceinline__ float max3f(float a, float b, float c) { return __builtin_fmaxf(__builtin_fmaxf(a, b), c); }
__device__ __forceinline__ void softmax_rel(f32x16& p0, f32x16& p1, float& m_run, float& alpha, const bool first) {
    float pm = max3f(p0[0], p0[1], p0[2]);
#pragma unroll
    for (int r = 3; r < 15; r += 2) pm = max3f(pm, p0[r], p0[r + 1]);
    pm = max3f(pm, p0[15], p1[0]);
#pragma unroll
    for (int r = 1; r < 15; r += 2) pm = max3f(pm, p1[r], p1[r + 1]);
    pm = __builtin_fmaxf(pm, p1[15]);
    { auto rr = __builtin_amdgcn_permlane32_swap(__float_as_uint(pm), __float_as_uint(pm), false, false); pm = __builtin_fmaxf(__uint_as_float(rr[0]), __uint_as_float(rr[1])); }
    if (!first && __builtin_expect(__all(pm <= THRL), 1)) alpha = 1.f;
    else { const float d = first ? pm : __builtin_fmaxf(pm, 0.f); alpha = first ? 1.f : __builtin_amdgcn_exp2f(-d); m_run += d;
#pragma unroll
        for (int r = 0; r < 16; ++r) { p0[r] -= d; p1[r] -= d; } }
#pragma unroll
    for (int r = 0; r < 16; ++r) { p0[r] = __builtin_amdgcn_exp2f(p0[r]); p1[r] = __builtin_amdgcn_exp2f(p1[r]); }
}
template <int DK> __device__ __forceinline__ void qkt_init(f32x16& p0, f32x16& p1, const char* Ks, const bf16x8* qr, int r32, int hi, float init) {
#pragma unroll
    for (int r = 0; r < 16; ++r) { p0[r] = init; p1[r] = init; }
#pragma unroll
    for (int d0 = 0; d0 < DK / 16; ++d0) { const int cb = (d0 * 16 + hi * 8) * 2;
        const bf16x8 b0 = *reinterpret_cast<const bf16x8*>(Ks + kswz<DK>(r32, cb));
        const bf16x8 b1 = *reinterpret_cast<const bf16x8*>(Ks + kswz<DK>(32 + r32, cb));
        p0 = __builtin_amdgcn_mfma_f32_32x32x16_bf16(b0, qr[d0], p0, 0, 0, 0);
        p1 = __builtin_amdgcn_mfma_f32_32x32x16_bf16(b1, qr[d0], p1, 0, 0, 0); }
}
__device__ __forceinline__ void finish_rel(f32x16& p0, f32x16& p1, float alpha, float& l_reg, bf16x8& pa0, bf16x8& pa1, bf16x8& pa2, bf16x8& pa3) {
    float ps = 0;
#pragma unroll
    for (int r = 0; r < 16; ++r) ps += p0[r];
#pragma unroll
    for (int r = 0; r < 16; ++r) ps += p1[r];
    { auto rr = __builtin_amdgcn_permlane32_swap(__float_as_uint(ps), __float_as_uint(ps), false, false); ps = __uint_as_float(rr[0]) + __uint_as_float(rr[1]); }
    l_reg = l_reg * alpha + ps;
#define ATT_PK4(P, BASE, OUT) do { unsigned a0 = cvt_pk_bf16(P[BASE + 0], P[BASE + 1]), a1 = cvt_pk_bf16(P[BASE + 2], P[BASE + 3]);   \
    unsigned b0 = cvt_pk_bf16(P[BASE + 4], P[BASE + 5]), b1 = cvt_pk_bf16(P[BASE + 6], P[BASE + 7]);                              \
    auto r0 = __builtin_amdgcn_permlane32_swap(a0, b0, false, false); auto r1 = __builtin_amdgcn_permlane32_swap(a1, b1, false, false); \
    u32x4 w = {r0[0], r1[0], r0[1], r1[1]}; OUT = *reinterpret_cast<bf16x8*>(&w); } while (0)
    ATT_PK4(p0, 0, pa0); ATT_PK4(p0, 8, pa1); ATT_PK4(p1, 0, pa2); ATT_PK4(p1, 8, pa3);
#undef ATT_PK4
}

template <int OFF> __device__ __forceinline__ bf16x8 k_read(int ka) { bf16x8 r; asm volatile("ds_read_b128 %0, %1 offset:%2" : "=&v"(r) : "v"(ka), "i"(OFF) : "memory"); return r; }
#define ATT_WAITL(n) asm volatile("s_waitcnt lgkmcnt(%0)" :: "n"(n) : "memory")
#define ATT_PKV(L, H) (bf16x8){L[0], L[1], L[2], L[3], H[0], H[1], H[2], H[3]}
template <int DK, int DV, int KBD, bool FINM = false, bool MINIT = false>
__device__ __forceinline__ void mblock(f32x16* o, f32x16& p0, f32x16& p1, const bool pv, const int vb, const int ka, const bf16x8* qr, bf16x8 pa0, bf16x8 pa1, bf16x8 pa2, bf16x8 pa3, const float init, const float al = 1.f, float* l_reg = nullptr, const f32x16* minit = nullptr) {
    constexpr int ND = DK / 16, NB = ND / KBD, PITCH = DK * 2 + 16, KR = 2 * KBD;
    static_assert(ND % KBD == 0 && NB >= 2 && NB <= 4 && (KBD == 2 || KBD == 3), "K batches");
    bf16x8 ka0[2][KBD], ka1[2][KBD];
    s16x4 l[4], h[4], m[4], n[4];
#define ATT_KISSUE(b) do { ka0[(b) & 1][0] = k_read<((b) * KBD + 0) * 32>(ka); ka1[(b) & 1][0] = k_read<((b) * KBD + 0) * 32 + 32 * PITCH>(ka); \
        ka0[(b) & 1][1] = k_read<((b) * KBD + 1) * 32>(ka); ka1[(b) & 1][1] = k_read<((b) * KBD + 1) * 32 + 32 * PITCH>(ka); \
        if constexpr (KBD > 2) { ka0[(b) & 1][KBD - 1] = k_read<((b) * KBD + KBD - 1) * 32>(ka); ka1[(b) & 1][KBD - 1] = k_read<((b) * KBD + KBD - 1) * 32 + 32 * PITCH>(ka); } } while (0)
#define ATT_TRISSUE(D0) do { l[0] = tr_read<v_rd_off<DV>(D0, 0, 0)>(vb); h[0] = tr_read<v_rd_off<DV>(D0, 0, 1)>(vb); l[1] = tr_read<v_rd_off<DV>(D0, 1, 0)>(vb); h[1] = tr_read<v_rd_off<DV>(D0, 1, 1)>(vb); \
        l[2] = tr_read<v_rd_off<DV>(D0, 2, 0)>(vb); h[2] = tr_read<v_rd_off<DV>(D0, 2, 1)>(vb); l[3] = tr_read<v_rd_off<DV>(D0, 3, 0)>(vb); h[3] = tr_read<v_rd_off<DV>(D0, 3, 1)>(vb); \
        m[0] = tr_read<v_rd_off<DV>(D0 + 1, 0, 0)>(vb); n[0] = tr_read<v_rd_off<DV>(D0 + 1, 0, 1)>(vb); m[1] = tr_read<v_rd_off<DV>(D0 + 1, 1, 0)>(vb); n[1] = tr_read<v_rd_off<DV>(D0 + 1, 1, 1)>(vb); \
        m[2] = tr_read<v_rd_off<DV>(D0 + 1, 2, 0)>(vb); n[2] = tr_read<v_rd_off<DV>(D0 + 1, 2, 1)>(vb); m[3] = tr_read<v_rd_off<DV>(D0 + 1, 3, 0)>(vb); n[3] = tr_read<v_rd_off<DV>(D0 + 1, 3, 1)>(vb); } while (0)
#define ATT_PVMMA(OA, OB) do { OA = __builtin_amdgcn_mfma_f32_32x32x16_bf16(pa0, ATT_PKV(l[0], h[0]), OA, 0, 0, 0); OB = __builtin_amdgcn_mfma_f32_32x32x16_bf16(pa0, ATT_PKV(m[0], n[0]), OB, 0, 0, 0); \
        OA = __builtin_amdgcn_mfma_f32_32x32x16_bf16(pa1, ATT_PKV(l[1], h[1]), OA, 0, 0, 0); OB = __builtin_amdgcn_mfma_f32_32x32x16_bf16(pa1, ATT_PKV(m[1], n[1]), OB, 0, 0, 0); \
        OA = __builtin_amdgcn_mfma_f32_32x32x16_bf16(pa2, ATT_PKV(l[2], h[2]), OA, 0, 0, 0); OB = __builtin_amdgcn_mfma_f32_32x32x16_bf16(pa2, ATT_PKV(m[2], n[2]), OB, 0, 0, 0); \
        OA = __builtin_amdgcn_mfma_f32_32x32x16_bf16(pa3, ATT_PKV(l[3], h[3]), OA, 0, 0, 0); OB = __builtin_amdgcn_mfma_f32_32x32x16_bf16(pa3, ATT_PKV(m[3], n[3]), OB, 0, 0, 0); } while (0)
#define ATT_QKMMA(b) do { _Pragma("unroll") for (int q = 0; q < KBD; ++q) { const bool f_ = MINIT && (b) == 0 && q == 0; \
        p0 = __builtin_amdgcn_mfma_f32_32x32x16_bf16(ka0[(b) & 1][q], qr[(b) * KBD + q], f_ ? *minit : p0, 0, 0, 0); \
        p1 = __builtin_amdgcn_mfma_f32_32x32x16_bf16(ka1[(b) & 1][q], qr[(b) * KBD + q], f_ ? *minit : p1, 0, 0, 0); } } while (0)
#if MK_ATT_PRIO == 1
    __builtin_amdgcn_s_setprio(1);
#endif
    constexpr bool K2 = (DV == 64);
    if (pv) {
        ATT_TRISSUE(0); ATT_KISSUE(0); if constexpr (K2) ATT_KISSUE(1);
        if constexpr (FINM) { ATT_SBAR(); finish_rel(p0, p1, al, *l_reg, pa0, pa1, pa2, pa3); ATT_SBAR(); }
        ATT_WAITL(K2 ? 2 * KR : KR); ATT_SBAR();
        ATT_PVMMA(o[0], o[1]); ATT_SBAR();
        if constexpr (DV == 128) { ATT_TRISSUE(2); ATT_WAITL(0); ATT_SBAR(); ATT_PVMMA(o[2], o[3]); ATT_SBAR(); }
    } else { ATT_KISSUE(0); if constexpr (K2) ATT_KISSUE(1); }
    if constexpr (!K2) ATT_KISSUE(1);
    if constexpr (!MINIT) {
#pragma unroll
        for (int r = 0; r < 16; ++r) { p0[r] = init; p1[r] = init; } }
    ATT_WAITL(KR); ATT_SBAR(); ATT_QKMMA(0); ATT_SBAR();
    if constexpr (NB > 2) { ATT_KISSUE(2); ATT_WAITL(KR); } else ATT_WAITL(0);
    ATT_SBAR(); ATT_QKMMA(1); ATT_SBAR();
    if constexpr (NB > 2) { if constexpr (NB > 3) { ATT_KISSUE(3); ATT_WAITL(KR); } else ATT_WAITL(0);
        ATT_SBAR(); ATT_QKMMA(2); ATT_SBAR();
        if constexpr (NB > 3) { ATT_WAITL(0); ATT_SBAR(); ATT_QKMMA(3); ATT_SBAR(); } }
#if MK_ATT_PRIO == 1
    __builtin_amdgcn_s_setprio(0);
#endif
    if (MK_PROBE_ATT == 4) { f32x16 dz = f32x16{};
#pragma unroll
        for (int q = 0; q < ND; ++q) { dz = __builtin_amdgcn_mfma_f32_32x32x16_bf16(qr[q], qr[(q + 1) % ND], dz, 0, 0, 0); dz = __builtin_amdgcn_mfma_f32_32x32x16_bf16(qr[(q + 1) % ND], qr[q], dz, 0, 0, 0); }
        asm volatile("" :: "v"(dz)); }
    if (MK_PROBE_ATT == 5) { ATT_KISSUE(0); ATT_KISSUE(1); if constexpr (NB > 2) { ATT_WAITL(0); ATT_KISSUE(2); if constexpr (NB > 3) ATT_KISSUE(3); } ATT_WAITL(0);
        asm volatile("" :: "v"(ka0[0][0]), "v"(ka1[0][0]), "v"(ka0[1][0]), "v"(ka1[1][0])); }
#undef ATT_KISSUE
#undef ATT_TRISSUE
#undef ATT_PVMMA
#undef ATT_QKMMA
}

template <int DK, int DV, int ldq, int ldk, int ldv, int ldo, bool PRE, bool DEEP, bool PART = false>
__device__ __forceinline__ void attn_unit_stag(const bf16_t* __restrict__ Qb, const bf16_t* __restrict__ Kh, const bf16_t* __restrict__ Vh,
                                               bf16_t* __restrict__ Ob, int seq, const float C, const float thr_raw, char* lds, const int wid, float* po = nullptr, float* pml = nullptr) {
    constexpr int SHM_V = KVBLK * DV * 2, SHM_K = KVBLK * (DK * 2 + 16), R = 4;
    constexpr int NO = DV / 32, ND = DK / 16;
    const int lane = fresh_lane(), tid = wid * 64 + lane, r32 = lane & 31, hi = lane >> 5, half = wid >> 2;
    char* V_lds = lds; char* K_lds = lds + R * SHM_V;
    float* wsf = (float*)(lds + R * SHM_V + R * SHM_K) + wid * 64; float* li_l = wsf; float* al_l = wsf + 32;
    float m_reg = 0.f, l_reg = 0; f32x16 o[NO]; bf16x8 qr[ND];
#pragma unroll
    for (int d = 0; d < NO; ++d) o[d] = f32x16{};
    const bf16_t* Qw = Qb + (long)(wid * QBLK + r32) * ldq + hi * 8;
#pragma unroll
    for (int d0 = 0; d0 < ND; ++d0) qr[d0] = *reinterpret_cast<const bf16x8*>(Qw + d0 * 16);
    if constexpr (!PRE) {
#pragma unroll
        for (int d0 = 0; d0 < ND; ++d0) { const u32x4 w = *reinterpret_cast<const u32x4*>(&qr[d0]); u32x4 x;
            x.x = cvt_pk_bf16(bf2f(w.x & 0xffffu) * C, bf2f(w.x >> 16) * C); x.y = cvt_pk_bf16(bf2f(w.y & 0xffffu) * C, bf2f(w.y >> 16) * C);
            x.z = cvt_pk_bf16(bf2f(w.z & 0xffffu) * C, bf2f(w.z >> 16) * C); x.w = cvt_pk_bf16(bf2f(w.w & 0xffffu) * C, bf2f(w.w >> 16) * C);
            qr[d0] = *reinterpret_cast<const bf16x8*>(&x); } }
    const int sr = tid >> 4, sc = (tid & 15) * 8; const bool kact = (DK == 128) ? true : (sc < DK), vact = (DV == 128) ? true : (sc < DV);
    const int vst0 = v_st<DV>(sr, vact ? sc : 0), vst1 = v_st<DV>(32 + sr, vact ? sc : 0);
    const int vb0 = (int)(uintptr_t)V_lds + v_rd_base(lane);
    const int ka0 = (int)(uintptr_t)K_lds + kswz<DK>(r32, hi * 16);
    const unsigned koff = (unsigned)(sr * ldk + sc) * 2u, voff = (unsigned)(sr * ldv + sc) * 2u;
    const unsigned koff2 = koff + 32u * ldk * 2u, voff2 = voff + 32u * ldv * 2u;
    bf16x8 vsA0, vsA1, ksA0, ksA1, vsB0, vsB1, ksB0, ksB1;
#define STG_SLOAD(S, k0) do { const char* _kt = (const char*)Kh + (size_t)(k0) * ldk * 2; const char* _vt = (const char*)Vh + (size_t)(k0) * ldv * 2;        \
    if (vact) { vs##S##0 = *reinterpret_cast<const bf16x8*>(_vt + (size_t)voff); vs##S##1 = *reinterpret_cast<const bf16x8*>(_vt + (size_t)voff2); } \
    if (kact) { ks##S##0 = *reinterpret_cast<const bf16x8*>(_kt + (size_t)koff); ks##S##1 = *reinterpret_cast<const bf16x8*>(_kt + (size_t)koff2); } } while (0)
#define STG_SWRITE(S, b) do { if (vact) { *(bf16x8*)(V_lds + (b) * SHM_V + vst0) = vs##S##0; *(bf16x8*)(V_lds + (b) * SHM_V + vst1) = vs##S##1; } \
    if (kact) { const int kc = sc * 2; *(bf16x8*)(K_lds + (b) * SHM_K + kswz<DK>(sr, kc)) = ks##S##0; *(bf16x8*)(K_lds + (b) * SHM_K + kswz<DK>(32 + sr, kc)) = ks##S##1; } } while (0)
#define STG_BAR() do { ATT_SBAR(); asm volatile("s_waitcnt lgkmcnt(0)" ::: "memory"); __builtin_amdgcn_s_barrier(); asm volatile("" ::: "memory"); ATT_SBAR(); } while (0)
    constexpr bool MINIT = !(DK == 128 && DV == 128);
    f32x16 minit = f32x16{};
    constexpr bool FINM = false;
    f32x16 p0, p1; float al = 1.f; bf16x8 pa0, pa1, pa2, pa3; const int NT = seq / KVBLK; (void)thr_raw;
    __syncthreads();
    if constexpr (DEEP) { STG_SLOAD(A, 0); STG_SLOAD(B, KVBLK); asm volatile("s_waitcnt vmcnt(0)" ::: "memory"); STG_SWRITE(A, 0); STG_SWRITE(B, 1);
        if (2 < NT) { STG_SLOAD(A, 2 * KVBLK); STG_SLOAD(B, 3 * KVBLK); } }
    else if constexpr (!(DK == 128 && DV == 128)) {
        STG_SLOAD(A, 0); STG_SLOAD(B, KVBLK); asm volatile("s_waitcnt vmcnt(0)" ::: "memory"); STG_SWRITE(A, 0); STG_SWRITE(B, 1);
        if (2 < NT) STG_SLOAD(A, 2 * KVBLK); }
    else { STG_SLOAD(A, 0); asm volatile("s_waitcnt vmcnt(0)" ::: "memory"); STG_SWRITE(A, 0);
        STG_SLOAD(A, KVBLK); asm volatile("s_waitcnt vmcnt(0)" ::: "memory"); STG_SWRITE(A, 1);
        if (2 < NT) STG_SLOAD(A, 2 * KVBLK); }
    __syncthreads();
    if (half && MK_PROBE_ATT != 8) STG_BAR();
#define STG_TILE(t, S) do { \
        mblock<DK, DV, (DK == 96) ? 3 : 2, FINM, MINIT>(o, p0, p1, (t) > 0, vb0 + (((t) - 1) & 3) * SHM_V, ka0 + ((t) & 3) * SHM_K, qr, pa0, pa1, pa2, pa3, -m_reg, al, &l_reg, &minit); \
        STG_BAR(); \
        if (MK_ATT_PRIO == 2) __builtin_amdgcn_s_setprio(1); \
        { const float mo_ = m_reg; softmax_rel(p0, p1, m_reg, al, (t) == 0); \
          if (MINIT) { if (__builtin_expect(__any(m_reg != mo_), 0)) { _Pragma("unroll") for (int r = 0; r < 16; ++r) minit[r] = -m_reg; } } } \
        if (MK_PROBE_ATT == 3) { float dz = 0.f; _Pragma("unroll") for (int r = 0; r < 16; ++r) { dz += __builtin_amdgcn_exp2f(p0[r] - 1.0f); dz += __builtin_amdgcn_exp2f(p1[r] - 2.0f); } asm volatile("" :: "v"(dz)); } \
        if (MK_PROBE_ATT == 6) { STG_BAR(); } \
        if (MK_PROBE_ATT == 9) { float dz = al; _Pragma("unroll") for (int r = 0; r < 48; ++r) asm volatile("v_fma_f32 %0, %0, %0, %0" : "+v"(dz)); asm volatile("" :: "v"(dz)); } \
        if constexpr (!FINM) finish_rel(p0, p1, al, l_reg, pa0, pa1, pa2, pa3); \
        if (__any(al < 1.f)) { if (hi == 0) al_l[r32] = al; asm volatile("s_waitcnt lgkmcnt(0)" ::: "memory"); \
            _Pragma("unroll") for (int d = 0; d < NO; ++d) _Pragma("unroll") for (int r = 0; r < 16; ++r) o[d][r] *= al_l[crow(r, hi)]; } \
        if (MK_ATT_PRIO == 2) __builtin_amdgcn_s_setprio(0); \
        if constexpr (DEEP) { if ((t) + 2 < NT) { STG_SWRITE(S, ((t) + 2) & 3); if ((t) + 4 < NT) STG_SLOAD(S, ((t) + 4) * KVBLK); } } \
        else      { if ((t) + 2 < NT) { STG_SWRITE(A, ((t) + 2) & 3); if ((t) + 3 < NT) { STG_SLOAD(A, ((t) + 3) * KVBLK); \
            if (MK_PROBE_ATT == 7) { STG_SLOAD(B, ((t) + 3) * KVBLK + 32 * ((t) & 1)); asm volatile("" :: "v"(vsB0), "v"(vsB1), "v"(ksB0), "v"(ksB1)); } } } } \
        STG_BAR(); } while (0)
    if constexpr (DEEP) { for (int t = 0; t < NT; t += 2) { STG_TILE(t, A); STG_TILE(t + 1, B); } }
    else { for (int t = 0; t < NT; ++t) STG_TILE(t, A); }
#undef STG_TILE
    if constexpr (FINM) finish_rel(p0, p1, al, l_reg, pa0, pa1, pa2, pa3);
    pv_d0<DV>(o, (int)(uintptr_t)V_lds + v_rd_base(fresh_lane()) + ((NT - 1) & 3) * SHM_V, pa0, pa1, pa2, pa3);
    if (!half && MK_PROBE_ATT != 8) STG_BAR();
    if constexpr (PART) { const int ln = fresh_lane(), rr32 = ln & 31, hh = ln >> 5;
      if (hh == 0) { pml[(wid * QBLK + rr32) * 2] = m_reg; pml[(wid * QBLK + rr32) * 2 + 1] = l_reg; }
      float* pw = po + (size_t)(wid * QBLK) * DV;
#pragma unroll
      for (int r = 0; r < 16; ++r) { const int orow = crow(r, hh);
#pragma unroll
          for (int d0 = 0; d0 < NO; ++d0) pw[orow * DV + d0 * 32 + rr32] = o[d0][r]; } }
    else
    { const int ln = fresh_lane(), rr32 = ln & 31, hh = ln >> 5;
      float* wsf2 = (float*)(lds + R * SHM_V + R * SHM_K) + wid * 64;
      if (hh == 0) wsf2[rr32] = l_reg; asm volatile("s_waitcnt lgkmcnt(0)" ::: "memory");
      float rli[16];
#pragma unroll
      for (int r = 0; r < 16; ++r) rli[r] = __builtin_amdgcn_rcpf(wsf2[crow(r, hh)]);
      constexpr int OP = DV * 2 + 16, OSZ = 32 * OP, NV = (3 * SHM_V) / OSZ;
      static_assert((8 - NV) * OSZ <= R * SHM_K, "O staging");
      char* stg = lds + (wid < NV ? wid * OSZ : R * SHM_V + (wid - NV) * OSZ);
#pragma unroll
      for (int r = 0; r < 16; ++r) { const int orow = crow(r, hh);
#pragma unroll
          for (int d0 = 0; d0 < NO; ++d0) *(bf16_t*)(stg + orow * OP + (d0 * 32 + rr32) * 2) = (bf16_t)f2bf(o[d0][r] * rli[r]); }
      asm volatile("s_waitcnt lgkmcnt(0)" ::: "memory");
      bf16_t* Ow = Ob + (long)(wid * QBLK) * ldo;
      constexpr int SEG = DV * 2 / 16;
#pragma unroll
      for (int ps = 0; ps < DV / 16; ++ps) { const int idx = ps * 64 + ln, row = idx / SEG, seg = idx % SEG;
          const u32x4 w = *(const u32x4*)(stg + row * OP + seg * 16);
          *(u32x4*)(Ow + (long)row * ldo + seg * 8) = w; } }
#undef STG_SLOAD
#undef STG_SWRITE
#undef STG_BAR
}
}
constexpr int NWAVES = 8;
constexpr int DM = 1024, NBATCH = 8, SEQ = 4096, CTXL = 256, TPB = CTXL + SEQ  , T = NBATCH * TPB  ;
constexpr int FF = 3584, NEXP = 8, DEPTH = 4;
constexpr int A_IN = 5120, B_IN = 672, B_INP = 768, C_IN = 1536, D_IN = 3072;
constexpr float NORM_EPS = 1e-6f;
constexpr int MOE_ROWS = 2 * T + NEXP * 256;

enum { I_X = 0, I_C, I_CTX, I_CCTX, I_MODW, I_MODB, I_NORMG, I_A_WIN, I_A_LB, I_A_ONORM, I_A_WOUT, I_B_WIN, I_B_QNORM, I_B_KVNORM, I_B_WQB, I_B_WKVB, I_B_WOUT,
       I_C_WIN, I_C_QNORM, I_C_KNORM, I_C_WOUT, I_D_WIN, I_D_LAMBDA, I_D_ONORM, I_D_WOUT, I_FFN_GU, I_FFN_DOWN, I_MOE_ROUTER, I_MOE_GU, I_MOE_DOWN, N_IN };

constexpr size_t al256(size_t x) { return (x + 255) / 256 * 256; }
constexpr size_t WS_CTL = 0, CTL_BYTES = 1u << 20;
constexpr size_t WS_MOD = WS_CTL + CTL_BYTES;
constexpr size_t WS_ROPE = WS_MOD + al256((size_t)DEPTH * 9 * 6 * DM * 4);
constexpr size_t WS_LB = WS_ROPE + al256((size_t)3 * 64 * 32 * 2 * 4);
constexpr size_t WS_W0 = WS_LB + al256((size_t)2 * 1024 * 4);
constexpr size_t WS_WA_IN = WS_W0;                                  constexpr size_t SZ_WA_IN = (size_t)A_IN * DM * 2;
constexpr size_t WS_WA_OUT = WS_WA_IN + SZ_WA_IN;                   constexpr size_t SZ_WOUT = (size_t)DM * DM * 2;
constexpr size_t WS_WB_IN = WS_WA_OUT + SZ_WOUT;                    constexpr size_t SZ_WB_IN = (size_t)B_INP * DM * 2;
constexpr size_t WS_WB_QB = WS_WB_IN + SZ_WB_IN;                    constexpr size_t SZ_WB_QB = (size_t)1536 * 384 * 2;
constexpr size_t WS_WB_KVB = WS_WB_QB + SZ_WB_QB;                   constexpr size_t SZ_WB_KVB = (size_t)2048 * 256 * 2;
constexpr size_t WS_WB_OUT = WS_WB_KVB + SZ_WB_KVB;
constexpr size_t WS_WC_IN = WS_WB_OUT + SZ_WOUT;                    constexpr size_t SZ_WC_IN = (size_t)C_IN * DM * 2;
constexpr size_t WS_WC_OUT = WS_WC_IN + SZ_WC_IN;
constexpr size_t WS_WD_IN = WS_WC_OUT + SZ_WOUT;                    constexpr size_t SZ_WD_IN = (size_t)D_IN * DM * 2;
constexpr size_t WS_WD_OUT = WS_WD_IN + SZ_WD_IN;
constexpr size_t WS_FFN_GU = WS_WD_OUT + SZ_WOUT;                   constexpr size_t SZ_GU = (size_t)2 * FF * DM;
constexpr size_t WS_FFN_DN = WS_FFN_GU + 2 * SZ_GU;                 constexpr size_t SZ_DN = (size_t)DM * FF * 2;
constexpr size_t WS_MOE_GU = WS_FFN_DN + 2 * SZ_DN;
constexpr size_t WS_MOE_DN = WS_MOE_GU + 16 * SZ_GU;
constexpr size_t WS_WEND = WS_MOE_DN + 16 * SZ_DN;
constexpr size_t WS_H = al256(WS_WEND);                              constexpr size_t SZ_H = (size_t)T * DM * 4;
constexpr size_t WS_XA = WS_H + SZ_H;                                constexpr size_t SZ_XA = (size_t)T * DM * 2;
constexpr size_t WS_Y = WS_XA + SZ_XA;                               constexpr size_t SZ_Y = (size_t)T * DM * 4;
constexpr size_t WS_YS = WS_Y + SZ_Y;                              constexpr size_t SZ_YS = (size_t)8 * 2048 * DM * 4;
constexpr size_t WS_ROUTE = WS_YS + SZ_YS;                             constexpr size_t SZ_ROUTE = (size_t)T * 32;
constexpr size_t WS_WCNT = WS_ROUTE + SZ_ROUTE;                      constexpr size_t SZ_WCNT = (size_t)256 * 8 * 4;
constexpr size_t WS_LIST = WS_WCNT + SZ_WCNT;                      constexpr size_t SZ_LIST = (size_t)NEXP * T * 4;
constexpr size_t WS_R0 = al256(WS_LIST + SZ_LIST);
constexpr size_t WS_Z = WS_R0;                                       constexpr size_t SZ_Z = (size_t)T * A_IN * 2;
constexpr size_t WS_Q = WS_Z + SZ_Z;                                 constexpr size_t SZ_Q = (size_t)T * 2048 * 2;
constexpr size_t WS_K = WS_Q + SZ_Q;                                 constexpr size_t SZ_K = (size_t)T * 1536 * 2;
constexpr size_t WS_V = WS_K + SZ_K;                                 constexpr size_t SZ_V = (size_t)T * 1024 * 2;
constexpr size_t WS_O = WS_V + SZ_V;                                 constexpr size_t SZ_O = (size_t)T * 2048 * 2;
constexpr size_t WS_MIX_END = WS_O + SZ_O;
constexpr size_t WS_ACT = WS_R0;                                     constexpr size_t SZ_ACT = (size_t)MOE_ROWS * FF * 2;
constexpr size_t WS_YP = WS_ACT + al256(SZ_ACT);                     constexpr size_t SZ_YP = (size_t)MOE_ROWS * DM * 4;
constexpr size_t WS_FFN_END = WS_YP + SZ_YP;
constexpr size_t WS_END = (WS_MIX_END > WS_FFN_END ? WS_MIX_END : WS_FFN_END);
static_assert((size_t)T * 1536 * 4 <= SZ_Z && (size_t)T * B_INP * 4 <= SZ_Z && (size_t)T * D_IN * 2 <= SZ_Z, "Z region");
static_assert((size_t)T * (384 + 256) * 2 <= SZ_O, "MLA normalised latents fit the O region");

constexpr int CW_BAR = 4096;
constexpr int CW_MOECNT = 16384;
constexpr int RING_BYTES = 131072;
constexpr int MISC_OFF = 163840 - 1024;
constexpr int LDS_BYTES = 163840;
static_assert(RING_BYTES <= MISC_OFF, "LDS map");

#define XB_TMO      128
#define XB_XCNT(j)  (256  + 64 * (j))
#define XB_XSUB(j)  (1280 + 64 * (j))
#define XB_XGEN(j)  (2304 + 64 * (j))
#define XB_TOP      3328
#define XB_TOPGEN   3392
#define XCD_BAR_WORDS 3456
#define XB_SPIN_CAP (1u << 22)
__device__ __forceinline__ unsigned xb_ld(unsigned* p)              { return __hip_atomic_load(p, __ATOMIC_RELAXED, __HIP_MEMORY_SCOPE_AGENT); }
__device__ __forceinline__ unsigned xb_add(unsigned* p, unsigned v) { return __hip_atomic_fetch_add(p, v, __ATOMIC_RELAXED, __HIP_MEMORY_SCOPE_AGENT); }
__device__ __forceinline__ unsigned xb_xcc_id() { return (unsigned)__builtin_amdgcn_s_getreg((3 << 11) | 20) & 0xFu; }
#define XB_SPIN(cond, bar) do { unsigned _sp = 0; while (cond) { __builtin_amdgcn_s_sleep(1); \
    if ((++_sp & 255u) == 0u) { if (xb_ld(&(bar)[XB_TMO])) break; if (_sp > XB_SPIN_CAP) { atomicAdd(&(bar)[XB_TMO], 1u); break; } } } } while (0)
struct XcdBarrier { unsigned* bar; unsigned x; volatile LAS unsigned* st; };
__device__ __forceinline__ XcdBarrier xcd_barrier_post(unsigned* bar, volatile LAS unsigned* st) {
    XcdBarrier b; b.bar = bar; b.x = xb_xcc_id(); b.st = st;
    if (threadIdx.x == 0) (void)xb_add(&bar[XB_XCNT(b.x)], 1u);
    return b;
}
__device__ __forceinline__ void xcd_barrier_complete(unsigned* bar, unsigned x, unsigned& nloc, unsigned& nx) {
    const unsigned G = gridDim.x * gridDim.y * gridDim.z;
    unsigned sum, cnt, mine, sp = 0u;
    for (;;) {
        sum = 0u; cnt = 0u; mine = 0u;
#pragma unroll
        for (unsigned j = 0; j < 16; ++j) { const unsigned c = xb_ld(&bar[XB_XCNT(j)]); sum += c; cnt += (c > 0u) ? 1u : 0u; mine = (j == x) ? c : mine; }
        if (sum == G) break;
        __builtin_amdgcn_s_sleep(1);
        if ((++sp & 255u) == 0u) { if (xb_ld(&bar[XB_TMO])) break; if (sp > XB_SPIN_CAP) { atomicAdd(&bar[XB_TMO], 1u); break; } }
    }
    nloc = mine > 0u ? mine : 1u; nx = cnt > 0u ? cnt : 1u;
}
__device__ __forceinline__ void xcd_barrier(const XcdBarrier& b, const int wave) {
    asm volatile("s_waitcnt vmcnt(0)" ::: "memory");
    __syncthreads();
    if (wave == 0 && fresh_lane() == 0) {
        unsigned* bar = b.bar;
        __builtin_amdgcn_s_waitcnt(0);
        unsigned nloc = b.st[0], nx = b.st[1];
        if (nloc == 0u) { xcd_barrier_complete(bar, b.x, nloc, nx); b.st[0] = nloc; b.st[1] = nx; }
        const unsigned old = xb_add(&bar[XB_XSUB(b.x)], 1u);
        const unsigned gen = old / nloc;
        if (old + 1u == (gen + 1u) * nloc) {
            __builtin_amdgcn_fence(__ATOMIC_RELEASE, "agent");
            asm volatile("s_waitcnt vmcnt(0)" ::: "memory");
            const unsigned og = xb_add(&bar[XB_TOP], 1u);
            const unsigned tg = og / nx;
            if (og + 1u == (tg + 1u) * nx) xb_add(&bar[XB_TOPGEN], 1u);
            else XB_SPIN(xb_ld(&bar[XB_TOPGEN]) == tg, bar);
            __builtin_amdgcn_fence(__ATOMIC_ACQUIRE, "agent");
            xb_add(&bar[XB_XGEN(b.x)], 1u);
            asm volatile("s_waitcnt vmcnt(0)" ::: "memory");
        } else {
            XB_SPIN(xb_ld(&bar[XB_XGEN(b.x)]) == gen, bar);
            __builtin_amdgcn_fence(__ATOMIC_ACQUIRE, "agent");
            asm volatile("s_waitcnt vmcnt(0)" ::: "memory");
        }
    }
    __syncthreads();
}

struct Frame {
    LAS unsigned char* lds; volatile LAS unsigned* MISC; unsigned char* ws;
    int wave, vcu, G;
};
typedef __attribute__((address_space(4))) const unsigned long long* kargp_t;
__device__ __forceinline__ float* out_ptr() { kargp_t ka = (kargp_t)__builtin_amdgcn_kernarg_segment_ptr(); return (float*)(GAS float*)(ka[N_IN]); }
__device__ __forceinline__ const float* in_ptr(const Frame&, int idx) { kargp_t ka = (kargp_t)__builtin_amdgcn_kernarg_segment_ptr(); return (const float*)(const GAS float*)(ka[idx]); }

struct MatDesc { int in_idx; unsigned src_off  ; int K, Nsrc, Ndst, kind  ; unsigned long long dst  ; };
constexpr int NMAT = 10 + 2 + 2 + 16 + 16, NMAT0 = 4;
struct MatTable { MatDesc m[NMAT]; int item0[NMAT + 1]; };
constexpr MatTable make_mats() {
    MatTable t{}; int n = 0;
    auto add = [&](int in_idx, unsigned src_off, int K, int Nsrc, int Ndst, int kind, unsigned long long dst) { t.m[n] = MatDesc{in_idx, src_off, K, Nsrc, Ndst, kind, dst}; ++n; };
    add(I_A_WIN, 0, DM, A_IN, A_IN, 0, WS_WA_IN); add(I_A_WOUT, 0, DM, DM, DM, 0, WS_WA_OUT);
    add(I_FFN_GU, 0, DM, 2 * FF, 2 * FF, 2, WS_FFN_GU); add(I_FFN_DOWN, 0, FF, DM, DM, 0, WS_FFN_DN);
    add(I_B_WIN, 0, DM, B_IN, B_INP, 0, WS_WB_IN); add(I_B_WQB, 0, 384, 1536, 1536, 0, WS_WB_QB); add(I_B_WKVB, 0, 256, 2048, 2048, 0, WS_WB_KVB); add(I_B_WOUT, 0, DM, DM, DM, 0, WS_WB_OUT);
    add(I_C_WIN, 0, DM, C_IN, C_IN, 3, WS_WC_IN); add(I_C_WOUT, 0, DM, DM, DM, 0, WS_WC_OUT);
    add(I_D_WIN, 0, DM, D_IN, D_IN, 0, WS_WD_IN); add(I_D_WOUT, 0, DM, DM, DM, 0, WS_WD_OUT);
    add(I_FFN_GU, (unsigned)1 * DM * 2 * FF, DM, 2 * FF, 2 * FF, 2, WS_FFN_GU + SZ_GU); add(I_FFN_DOWN, (unsigned)1 * FF * DM, FF, DM, DM, 0, WS_FFN_DN + SZ_DN);
    for (int j = 0; j < 16; ++j) add(I_MOE_GU, (unsigned)j * DM * 2 * FF, DM, 2 * FF, 2 * FF, 2, WS_MOE_GU + (size_t)j * SZ_GU);
    for (int j = 0; j < 16; ++j) add(I_MOE_DOWN, (unsigned)j * FF * DM, FF, DM, DM, 0, WS_MOE_DN + (size_t)j * SZ_DN);
    int acc = 0; for (int i = 0; i < NMAT; ++i) { t.item0[i] = acc; acc += (t.m[i].K / 64) * (t.m[i].Ndst / 64); } t.item0[NMAT] = acc;
    return t;
}
__device__ const MatTable g_mats = make_mats();

__host__ __device__ __forceinline__ int gqa_dim(int c) { const int wc = c >> 5, fq = (c >> 3) & 3, e = c & 7; return 64 * (wc >> 1) + 32 * (fq >> 1) + 16 * (wc & 1) + 8 * (fq & 1) + e; }
constexpr int P0_SCR = 64 * 65 * 4;
__device__ __forceinline__ void p0_transpose_item(const float* W, int K, int Nsrc, int kind, bf16_t* WT, LAS float* scr, int item, int Ndst, int lane) {
    const int nblk = Ndst / 64, kb = item / nblk, nb = item % nblk, k0 = 64 * kb, n0 = 64 * nb;
    int s0;
    if (kind == 1 || kind == 2) { const int pn = n0 >> 8, bj = (n0 >> 7) & 1, cc = n0 & 127; s0 = bj * FF + 128 * pn + cc; } else s0 = n0;
    int sl = s0 + lane;
    if (kind == 3) { const int n = n0 + lane; sl = (n < 1280) ? (n & ~127) + gqa_dim(n & 127) : n; }
    const bool ok = (kind >= 1) || (n0 + lane < Nsrc);
    const float* src = W + (size_t)k0 * Nsrc + sl;
    float tv[64];
#pragma unroll
    for (int kk = 0; kk < 64; ++kk) tv[kk] = ok ? src[(size_t)kk * Nsrc] : 0.f;
#pragma unroll
    for (int kk = 0; kk < 64; ++kk) scr[kk * 65 + lane] = tv[kk];
    asm volatile("s_waitcnt lgkmcnt(0)" ::: "memory");
    if (kind == 2) {
        const int c = lane & 3; unsigned char* WT8 = (unsigned char*)WT;
#pragma unroll
        for (int j = 0; j < 4; ++j) { const int n = (lane >> 2) + 16 * j; const LAS float* sp = scr + (16 * c) * 65 + n;
            u32x4 o; o.x = pk4_fp8(32.f * sp[0 * 65], 32.f * sp[1 * 65], 32.f * sp[2 * 65], 32.f * sp[3 * 65]); o.y = pk4_fp8(32.f * sp[4 * 65], 32.f * sp[5 * 65], 32.f * sp[6 * 65], 32.f * sp[7 * 65]);
            o.z = pk4_fp8(32.f * sp[8 * 65], 32.f * sp[9 * 65], 32.f * sp[10 * 65], 32.f * sp[11 * 65]); o.w = pk4_fp8(32.f * sp[12 * 65], 32.f * sp[13 * 65], 32.f * sp[14 * 65], 32.f * sp[15 * 65]);
            *(u32x4*)(WT8 + (size_t)(n0 + n) * K + k0 + 16 * c) = o; }
    } else {
    const int c = lane & 7;
#pragma unroll
    for (int j = 0; j < 8; ++j) { const int n = (lane >> 3) + 8 * j; const LAS float* sp = scr + (8 * c) * 65 + n;
        u32x4 o; o.x = pk2(sp[0 * 65], sp[1 * 65]); o.y = pk2(sp[2 * 65], sp[3 * 65]); o.z = pk2(sp[4 * 65], sp[5 * 65]); o.w = pk2(sp[6 * 65], sp[7 * 65]);
        *(u32x4*)(WT + (size_t)(n0 + n) * K + k0 + 8 * c) = o; }
    }
    asm volatile("s_waitcnt lgkmcnt(0)" ::: "memory");
}

__device__ __forceinline__ void p0_convert(Frame& F, int it0, int it1, int worker, int nworkers, int lane) {
    LAS float* scr = (LAS float*)(F.lds + F.wave * P0_SCR);
    for (int it = it0 + worker; it < it1; it += nworkers) {
        int mi = 0;
#pragma unroll 1
        for (int j = 1; j < NMAT; ++j) mi = (it >= g_mats.item0[j]) ? j : mi;
        const MatDesc d = g_mats.m[mi];
        p0_transpose_item(in_ptr(F, d.in_idx) + d.src_off, d.K, d.Nsrc, d.kind, (bf16_t*)(F.ws + d.dst), scr, it - g_mats.item0[mi], d.Ndst, lane);
    }
}
__device__ __forceinline__ int p0_split_item() { const int i0 = g_mats.item0[NMAT0], i1 = g_mats.item0[NMAT]; return i0 + (int)((long)(i1 - i0) * 0 / 100); }
__device__ __forceinline__ void p0_prologue(Frame& F) {
    const int lane = fresh_lane(), tid = F.wave * 64 + lane; (void)tid;
    const int gw = F.vcu * NWAVES + F.wave, NGW = F.G * NWAVES;
    p0_convert(F, 0, p0_split_item(), gw, NGW, lane);
    __syncthreads();
    {
        LAS float* cond = (LAS float*)F.lds;
        LAS float* part = (LAS float*)(F.lds + 65536);
        const float* cin = in_ptr(F, I_C); const float* cctx = in_ptr(F, I_CCTX);
        for (int i = tid; i < 9 * DM; i += 512) { const int r = i / DM, k = i % DM; const float v = (r < 8) ? cin[r * DM + k] : cctx[k]; cond[i] = silu_f(v); }
        __syncthreads();
        const float* mw = in_ptr(F, I_MODW); const float* mb = in_ptr(F, I_MODB);
        float* modt = (float*)(F.ws + WS_MOD);
        constexpr int NITEM = DEPTH * (6 * DM / 64);
        for (int it = F.vcu; it < NITEM; it += F.G) {
            const int l = it / 96, cb = it % 96, col = cb * 64 + lane;
            float a[9];
#pragma unroll
            for (int r = 0; r < 9; ++r) a[r] = 0.f;
            const float* wp = mw + ((size_t)l * DM + F.wave * 128) * (6 * DM) + col;
#pragma unroll 8
            for (int k = 0; k < 128; ++k) { const float w = wp[(size_t)k * (6 * DM)];
#pragma unroll
                for (int r = 0; r < 9; ++r) a[r] = fmaf(cond[r * DM + F.wave * 128 + k], w, a[r]); }
#pragma unroll
            for (int r = 0; r < 9; ++r) part[(F.wave * 9 + r) * 64 + lane] = a[r];
            __syncthreads();
            for (int i = tid; i < 9 * 64; i += 512) { const int r = i / 64, c = i % 64; float s = mb[(size_t)l * 6 * DM + cb * 64 + c];
#pragma unroll
                for (int w = 0; w < 8; ++w) s += part[(w * 9 + r) * 64 + c];
                modt[((size_t)l * 9 + r) * (6 * DM) + cb * 64 + c] = s; }
            __syncthreads();
        }
    }
    {
        float* rt = (float*)(F.ws + WS_ROPE);
        for (int i = gw * 64 + lane; i < 3 * 64 * 32; i += NGW * 64) { const int kind = i / 2048, pos = (i / 32) % 64, fi = i % 32; const int n = 16 << kind;
            if (fi < n / 2) { const float inv = exp2f(-(float)(2 * fi) / (float)n * 13.287712379549449f);
                const float ang = (float)pos * inv; float s, c;
                {
                  const float rev = ang * 0.15915494309189535f; const float fr = rev - floorf(rev); s = __builtin_amdgcn_sinf(fr); c = __builtin_amdgcn_cosf(fr); }
                rt[(size_t)i * 2] = c; rt[(size_t)i * 2 + 1] = s; } }
    }
    {
        const float* alb = in_ptr(F, I_A_LB); float* lb = (float*)(F.ws + WS_LB);
        for (int i = gw * 64 + lane; i < 2 * 1024; i += NGW * 64) { const int dir = i / 1024, w = i % 1024; float v[5], mx = -1e30f;
#pragma unroll
            for (int j = 0; j < 5; ++j) { v[j] = alb[((size_t)dir * 5 + j) * 1024 + w]; mx = fmaxf(mx, v[j]); }
            float s = 0.f;
#pragma unroll
            for (int j = 0; j < 5; ++j) s += expf(v[j] - mx);
            lb[i] = expf(v[0] - mx) / s; }
    }
}

struct RowPos { int b, p, modrow, prow, pcol; bool isctx; };
__device__ __forceinline__ RowPos row_pos(int m) { RowPos r; r.b = m / TPB; r.p = m % TPB; r.isctx = r.p < CTXL; r.modrow = r.isctx ? 8 : r.b; const int t = r.isctx ? 0 : r.p - CTXL; r.prow = t >> 6; r.pcol = t & 63; return r; }
__device__ __forceinline__ void ld_row(const float* p, int lane, f32x4 (&v)[4]) {
#pragma unroll
    for (int j = 0; j < 4; ++j) v[j] = *(const f32x4*)(p + 256 * j + 4 * lane);
}
__device__ __forceinline__ void ld_row_bf16(const bf16_t* p, int lane, f32x4 (&v)[4]) {
#pragma unroll
    for (int j = 0; j < 4; ++j) { const u32x2 w = *(const u32x2*)(p + 256 * j + 4 * lane); v[j] = (f32x4){bf2f(w.x & 0xffffu), bf2f(w.x >> 16), bf2f(w.y & 0xffffu), bf2f(w.y >> 16)}; }
}
__device__ __forceinline__ void st_row_bf16(bf16_t* p, int lane, const f32x4 (&v)[4]) {
#pragma unroll
    for (int j = 0; j < 4; ++j) { u32x2 w; w.x = pk2(v[j].x, v[j].y); w.y = pk2(v[j].z, v[j].w); *(u32x2*)(p + 256 * j + 4 * lane) = w; }
}
__device__ __forceinline__ float sumsq_row(const f32x4 (&v)[4]) { float s = 0.f;
#pragma unroll
    for (int j = 0; j < 4; ++j) s += (v[j].x * v[j].x + v[j].y * v[j].y) + (v[j].z * v[j].z + v[j].w * v[j].w);
    return wave_sum(s); }
__device__ __forceinline__ void norm_mod_store(const f32x4 (&x)[4], float rstd, const float* g, const float* shift, const float* scale, bf16_t* dst, int lane, f32x4 (&u)[4]) {
#pragma unroll
    for (int j = 0; j < 4; ++j) { const int c = 256 * j + 4 * lane; const f32x4 gg = *(const f32x4*)(g + c), sh = *(const f32x4*)(shift + c), sc = *(const f32x4*)(scale + c);
        u[j] = (x[j] * rstd * gg) * (sc + 1.0f) + sh;
        u32x2 w; w.x = pk2(u[j].x, u[j].y); w.y = pk2(u[j].z, u[j].w); *(u32x2*)(dst + c) = w; }
}

__device__ __forceinline__ void norm_mod_store_fp8(const f32x4 (&x)[4], float rstd, const float* g, const float* shift, const float* scale, unsigned char* dst, int lane, f32x4 (&u)[4]) {
#pragma unroll
    for (int j = 0; j < 4; ++j) { const int c = 256 * j + 4 * lane; const f32x4 gg = *(const f32x4*)(g + c), sh = *(const f32x4*)(shift + c), sc = *(const f32x4*)(scale + c);
        u[j] = (x[j] * rstd * gg) * (sc + 1.0f) + sh;
        *(unsigned*)(dst + c) = pk4_fp8(u[j].x, u[j].y, u[j].z, u[j].w); }
}
__device__ __forceinline__ void ld_y_row(const unsigned char* ws, int m, const RowPos& rp, int S, int lane, f32x4 (&yv)[4]) {
    if (rp.isctx) { const float* ys = (const float*)(ws + WS_YS) + (size_t)(rp.b * CTXL + rp.p) * DM;
        ld_row(ys, lane, yv);
        for (int s = 1; s < S; ++s) { f32x4 t[4]; ld_row(ys + (size_t)s * 2048 * DM, lane, t);
#pragma unroll
            for (int j = 0; j < 4; ++j) yv[j] = yv[j] + t[j]; } }
    else ld_row_bf16((const bf16_t*)(ws + WS_Y) + (size_t)m * DM, lane, yv);
}
__device__ __forceinline__ void ld_yp_row(const unsigned char* ws, size_t r, int RBM, int trb, int S, int lane, f32x4 (&v)[4]) {
    const int rb = (int)(r >> 8);
    if (rb >= RBM) { const float* ys = (const float*)(ws + WS_YS) + ((size_t)(rb - RBM) * 256 + (r & 255)) * DM;
        ld_row(ys, lane, v);
        for (int s = 1; s < S; ++s) { f32x4 t[4]; ld_row(ys + (size_t)s * trb * 256 * DM, lane, t);
#pragma unroll
            for (int j = 0; j < 4; ++j) v[j] = v[j] + t[j]; } }
    else ld_row_bf16((const bf16_t*)(ws + WS_YP) + r * DM, lane, v);
}
__device__ __forceinline__ float half_sum(float v) {
#pragma unroll
    for (int o = 1; o < 32; o <<= 1) v += __shfl_xor(v, o);
    return v;
}
__device__ __forceinline__ void ld_row2(const float* p, int l32, f32x4 (&v)[8]) {
#pragma unroll
    for (int j = 0; j < 8; ++j) v[j] = *(const f32x4*)(p + 128 * j + 4 * l32);
}
__device__ __forceinline__ void ld_row2_bf16(const bf16_t* p, int l32, f32x4 (&v)[8]) {
#pragma unroll
    for (int j = 0; j < 8; ++j) { const u32x2 w = *(const u32x2*)(p + 128 * j + 4 * l32); v[j] = (f32x4){bf2f(w.x & 0xffffu), bf2f(w.x >> 16), bf2f(w.y & 0xffffu), bf2f(w.y >> 16)}; }
}
__device__ __forceinline__ void st_row2_bf16(bf16_t* p, int l32, const f32x4 (&v)[8]) {
#pragma unroll
    for (int j = 0; j < 8; ++j) { u32x2 w; w.x = pk2(v[j].x, v[j].y); w.y = pk2(v[j].z, v[j].w); *(u32x2*)(p + 128 * j + 4 * l32) = w; }
}
__device__ __forceinline__ float sumsq_row2(const f32x4 (&v)[8]) { float s = 0.f;
#pragma unroll
    for (int j = 0; j < 8; ++j) s += (v[j].x * v[j].x + v[j].y * v[j].y) + (v[j].z * v[j].z + v[j].w * v[j].w);
    return half_sum(s); }
template <bool FP8>
__device__ __forceinline__ void norm_mod2(const f32x4 (&x)[8], float rstd, const LAS float* g, const LAS float* shift, const LAS float* scale, void* dst, int l32, bool st, f32x4 (&u)[8]) {
#pragma unroll
    for (int j = 0; j < 8; ++j) { if ((j & 3) == 0) __builtin_amdgcn_sched_barrier(0);
        const int c = 128 * j + 4 * l32; const f32x4 gg = *(const LAS f32x4*)(g + c), sh = *(const LAS f32x4*)(shift + c), sc = *(const LAS f32x4*)(scale + c);
        u[j] = (x[j] * rstd * gg) * (sc + 1.0f) + sh;
        if (st) { if (FP8) *(unsigned*)((unsigned char*)dst + c) = pk4_fp8(u[j].x, u[j].y, u[j].z, u[j].w);
                  else { u32x2 w; w.x = pk2(u[j].x, u[j].y); w.y = pk2(u[j].z, u[j].w); *(u32x2*)((bf16_t*)dst + c) = w; } } }
}
constexpr int PAR_FLOATS = 29 * DM;
__device__ __forceinline__ void fill_params(Frame& F, const float* ga, const float* gb, const float* m0, const float* m1, const float* m2, int tid) {
    LAS float* par = (LAS float*)F.lds;
    for (int i = tid; i < PAR_FLOATS / 4; i += NWAVES * 64) { const int v = i >> 8, c = (i & 255) * 4; const float* src;
        if (v == 0) src = ga; else if (v == 1) src = gb; else { const int r = (v - 2) / 3, k = (v - 2) % 3; src = (k == 0 ? m0 : k == 1 ? m1 : m2) + (size_t)r * (6 * DM); }
        *(LAS f32x4*)(par + v * DM + c) = *(const f32x4*)(src + c); }
    __syncthreads();
}
__device__ __forceinline__ void ld_y_row2(const unsigned char* ws, int m, const RowPos& rp, bool slab, int S, int l32, f32x4 (&yv)[8]) {
    if (slab) { const float* ys = (const float*)(ws + WS_YS) + (size_t)(rp.b * CTXL + rp.p) * DM;
        ld_row2(ys, l32, yv);
#pragma unroll 1
        for (int s = 1; s < S; ++s) { f32x4 t[8]; ld_row2(ys + (size_t)s * 2048 * DM, l32, t);
#pragma unroll
            for (int j = 0; j < 8; ++j) yv[j] = yv[j] + t[j]; } }
    else ld_row2_bf16((const bf16_t*)(ws + WS_Y) + (size_t)m * DM, l32, yv);
}
__device__ __forceinline__ void ld_yp_row2(const unsigned char* ws, size_t r, int RBM, int trb, int S, int l32, f32x4 (&v)[8]) {
    const int rb = (int)(r >> 8);
    if (rb >= RBM) { const float* ys = (const float*)(ws + WS_YS) + ((size_t)(rb - RBM) * 256 + (r & 255)) * DM;
        ld_row2(ys, l32, v);
#pragma unroll 1
        for (int s = 1; s < S; ++s) { f32x4 t[8]; ld_row2(ys + (size_t)s * trb * 256 * DM, l32, t);
#pragma unroll
            for (int j = 0; j < 8; ++j) v[j] = v[j] + t[j]; } }
    else ld_row2_bf16((const bf16_t*)(ws + WS_YP) + r * DM, l32, v);
}

__device__ __forceinline__ void phase_r0(Frame& F) {
    const int lane = fresh_lane(), l32 = lane & 31, half = lane >> 5;
    const int gw = F.vcu * NWAVES + F.wave, NGW = F.G * NWAVES;
    const float* x = in_ptr(F, I_X); const float* ctx = in_ptr(F, I_CTX); const float* ng = in_ptr(F, I_NORMG);
    bf16_t* h = (bf16_t*)(F.ws + WS_H); bf16_t* xa = (bf16_t*)(F.ws + WS_XA); const float* modt = (const float*)(F.ws + WS_MOD);
    fill_params(F, ng + (0 * 4 + 0) * DM, ng + (0 * 4 + 0) * DM, modt + 0 * DM, modt + 1 * DM, modt + 1 * DM, F.wave * 64 + lane);
    const LAS float* par = (const LAS float*)F.lds;
    for (int pi = gw; pi < T / 2; pi += NGW) { const int m = 2 * pi + half; const RowPos rp = row_pos(m);
        const float* src = rp.isctx ? ctx + ((size_t)rp.b * CTXL + rp.p) * DM : x + ((size_t)rp.b * SEQ + (rp.p - CTXL)) * DM;
        f32x4 v[8], u[8]; ld_row2(src, l32, v);
        st_row2_bf16(h + (size_t)m * DM, l32, v);
        const float rstd = rsqrtf(sumsq_row2(v) * (1.0f / DM) + NORM_EPS);
        const LAS float* pm = par + (2 + 3 * rp.modrow) * DM;
        norm_mod2<false>(v, rstd, par, pm + 0 * DM, pm + 1 * DM, xa + (size_t)m * DM, l32, true, u); }
    __syncthreads();
}

template <bool MOE>
__device__ __forceinline__ void phase_r1(Frame& F, int l) {
    const int lane = fresh_lane(), tid = F.wave * 64 + lane, l32 = lane & 31, half = lane >> 5;
    const float* ng = in_ptr(F, I_NORMG); const float* modt = (const float*)(F.ws + WS_MOD);
    bf16_t* h = (bf16_t*)(F.ws + WS_H); unsigned char* xa = (unsigned char*)(F.ws + WS_XA);
    const float* router = MOE ? in_ptr(F, I_MOE_ROUTER) + (size_t)(l >> 1) * DM * NEXP : nullptr;
    constexpr int LB = PAR_FLOATS * 4;
    LAS int* lcnt = (LAS int*)(F.lds + LB);
    LAS int* lbase = (LAS int*)(F.lds + LB + 64);
    LAS int* lrow = (LAS int*)(F.lds + LB + 1024);
    LAS float* lw = (LAS float*)(F.lds + LB + 4096);
    constexpr int RPW = T / 256;
    if (MOE) { if (tid < 8) lcnt[tid] = 0; }
    { const float* ml = modt + (size_t)l * 9 * (6 * DM); fill_params(F, ng + (l * 4 + 1) * DM, ng + (l * 4 + 2) * DM, ml + 2 * DM, ml + 3 * DM, ml + 4 * DM, tid); }
    const LAS float* par = (const LAS float*)F.lds;
    LAS f32x4* rtA = (LAS f32x4*)(F.lds + LB + 8192); LAS f32x4* rtB = rtA + 1024;
    if (MOE) { for (int c = tid; c < DM; c += NWAVES * 64) { const int slot = ((c & 3) * 8 + (c >> 7)) * 32 + ((c & 127) >> 2);
            rtA[slot] = *(const f32x4*)(router + (size_t)c * 8); rtB[slot] = *(const f32x4*)(router + (size_t)c * 8 + 4); }
        __syncthreads(); }
#define R1_ROW(i) ((i) * 256 + F.vcu)
    f32x4 yn[8], hn[8];
    { const int m0 = R1_ROW(2 * F.wave + half); const RowPos r0 = row_pos(m0); ld_y_row2(F.ws, m0, r0, r0.isctx && !(l == DEPTH - 1), 8, l32, yn); ld_row2_bf16(h + (size_t)m0 * DM, l32, hn); }
    for (int i2 = F.wave; i2 < RPW / 2; i2 += NWAVES) { const int i = 2 * i2 + half, m = R1_ROW(i); const RowPos rp = row_pos(m);
        const bool skip = (l == DEPTH - 1) && rp.isctx;
        const LAS float* pm = par + (2 + 3 * rp.modrow) * DM;
        f32x4 yv[8], hv[8], u[8];
#pragma unroll
        for (int j = 0; j < 8; ++j) { yv[j] = yn[j]; hv[j] = hn[j]; }
        if (i2 + NWAVES < RPW / 2) { const int mn = R1_ROW(i + 2 * NWAVES); const RowPos rn = row_pos(mn); ld_y_row2(F.ws, mn, rn, rn.isctx && !(l == DEPTH - 1), 8, l32, yn); ld_row2_bf16(h + (size_t)mn * DM, l32, hn); }
        const float rstd_y = rsqrtf(sumsq_row2(yv) * (1.0f / DM) + NORM_EPS);
#pragma unroll
        for (int j = 0; j < 8; ++j) { if ((j & 3) == 0) __builtin_amdgcn_sched_barrier(0);
            const int c = 128 * j + 4 * l32; const f32x4 g1 = *(const LAS f32x4*)(par + c), gt = *(const LAS f32x4*)(pm + c);
            hv[j] = hv[j] + gt * (yv[j] * rstd_y * g1); }
        if (!skip) st_row2_bf16(h + (size_t)m * DM, l32, hv);
        const float rstd_h = rsqrtf(sumsq_row2(hv) * (1.0f / DM) + NORM_EPS);
        norm_mod2<true>(hv, rstd_h, par + DM, pm + 1 * DM, pm + 2 * DM, xa + (size_t)m * DM, l32, !skip, u);
        if (MOE) {
            float lg[8];
#pragma unroll
            for (int e = 0; e < 8; ++e) lg[e] = 0.f;
#pragma unroll
            for (int j = 0; j < 8; ++j) { __builtin_amdgcn_sched_barrier(0);
#pragma unroll
                for (int q = 0; q < 4; ++q) { const f32x4 r0 = rtA[(q * 8 + j) * 32 + l32], r1 = rtB[(q * 8 + j) * 32 + l32]; const float uv = u[j][q];
                    lg[0] = fmaf(uv, r0.x, lg[0]); lg[1] = fmaf(uv, r0.y, lg[1]); lg[2] = fmaf(uv, r0.z, lg[2]); lg[3] = fmaf(uv, r0.w, lg[3]);
                    lg[4] = fmaf(uv, r1.x, lg[4]); lg[5] = fmaf(uv, r1.y, lg[5]); lg[6] = fmaf(uv, r1.z, lg[6]); lg[7] = fmaf(uv, r1.w, lg[7]); } }
#pragma unroll
            for (int e = 0; e < 8; ++e) lg[e] = half_sum(lg[e]);
            int e1 = 0; float v1 = lg[0];
#pragma unroll
            for (int e = 1; e < 8; ++e) if (lg[e] > v1) { v1 = lg[e]; e1 = e; }
            int e2 = (e1 == 0) ? 1 : 0; float v2 = (e1 == 0) ? lg[1] : lg[0];
#pragma unroll
            for (int e = 1; e < 8; ++e) if (e != e1 && lg[e] > v2) { v2 = lg[e]; e2 = e; }
            const float w2 = fast_rcp(1.0f + expf(v1 - v2)), w1 = 1.0f - w2;
            if (l32 == 0) { if (skip) lrow[i * 4 + 0] = -1;
                else { lrow[i * 4 + 0] = e1; lrow[i * 4 + 2] = e2; lw[i * 2] = w1; lw[i * 2 + 1] = w2; } }
        }
    }
    if (MOE) {
        __syncthreads();
        if (tid < 8) { int c = 0; for (int i = 0; i < RPW; ++i) { const int a = lrow[i * 4], b = lrow[i * 4 + 2]; if (a < 0) continue; if (a == tid) lrow[i * 4 + 1] = c++; else if (b == tid) lrow[i * 4 + 3] = c++; }
            lcnt[tid] = c; ((int*)(F.ws + WS_WCNT))[F.vcu * 8 + tid] = c;
            __hip_atomic_fetch_add((int*)((unsigned*)F.ws + CW_MOECNT + (l >> 1) * 64) + tid, c, __ATOMIC_RELAXED, __HIP_MEMORY_SCOPE_AGENT); }
        __syncthreads();
        int* route = (int*)(F.ws + WS_ROUTE);
        for (int i = tid; i < RPW; i += 512) { const int m = R1_ROW(i); const int e1 = lrow[i * 4], e2 = lrow[i * 4 + 2]; route[(size_t)m * 8 + 0] = e1; if (e1 < 0) continue;
            route[(size_t)m * 8 + 1] = lrow[i * 4 + 1]; route[(size_t)m * 8 + 2] = e2; route[(size_t)m * 8 + 3] = lrow[i * 4 + 3];
            ((float*)route)[(size_t)m * 8 + 4] = lw[i * 2]; ((float*)route)[(size_t)m * 8 + 5] = lw[i * 2 + 1]; }
        __syncthreads();
    }
}
__device__ __forceinline__ void moe_build(Frame& F) {
    const int lane = fresh_lane(), tid = F.wave * 64 + lane;
    LAS int* red = (LAS int*)F.lds;
    const int* wcnt = (const int*)(F.ws + WS_WCNT);
    { const int e = tid & 7; int sacc = 0; for (int v = tid >> 3; v < F.vcu; v += 64) sacc += wcnt[v * 8 + e]; red[tid] = sacc; }
    __syncthreads();
    if (tid < 8) { int sacc = 0; for (int k = 0; k < 64; ++k) sacc += red[k * 8 + tid]; red[512 + tid] = sacc; }
    __syncthreads();
    constexpr int RPW = T / 256;
    int* list = (int*)(F.ws + WS_LIST); int* route = (int*)(F.ws + WS_ROUTE);
    for (int i = tid; i < RPW; i += 512) { const int m = R1_ROW(i); const int e1 = route[(size_t)m * 8]; if (e1 < 0) continue; const int e2 = route[(size_t)m * 8 + 2];
        const int s1 = red[512 + e1] + route[(size_t)m * 8 + 1], s2 = red[512 + e2] + route[(size_t)m * 8 + 3];
        list[(size_t)e1 * T + s1] = m; list[(size_t)e2 * T + s2] = m; route[(size_t)m * 8 + 1] = s1; route[(size_t)m * 8 + 3] = s2; }
}

__device__ __forceinline__ void moe_tables(Frame& F, int l) {
    const int lane = fresh_lane(), tid = F.wave * 64 + lane; (void)tid;
    if (tid == 0) { const int* gcnt = (const int*)((unsigned*)F.ws + CW_MOECNT + (l >> 1) * 64); int acc = 0;
        for (int e = 0; e < 8; ++e) { const int c = __hip_atomic_load(gcnt + e, __ATOMIC_RELAXED, __HIP_MEMORY_SCOPE_AGENT); F.MISC[32 + e] = (unsigned)c; F.MISC[16 + e] = (unsigned)acc; acc += (c + 255) / 256; }
        F.MISC[24] = (unsigned)acc; }
    __syncthreads();
}

template <bool MOE>
__device__ __forceinline__ void phase_r2(Frame& F, int l) {
    const int lane = fresh_lane(), l32 = lane & 31, half = lane >> 5;
    const int gw = F.vcu * NWAVES + F.wave, NGW = F.G * NWAVES;
    const float* ng = in_ptr(F, I_NORMG); const float* modt = (const float*)(F.ws + WS_MOD);
    bf16_t* h = (bf16_t*)(F.ws + WS_H); bf16_t* xa = (bf16_t*)(F.ws + WS_XA);
    const int* route = (const int*)(F.ws + WS_ROUTE);
    int RBM = 0, trb = 0, S = 1; if (MOE) pg8::moe_tail_params((int)F.MISC[24], RBM, trb, S);
    { const int ln = (l < DEPTH - 1) ? l + 1 : l; const float* ml = modt + (size_t)l * 9 * (6 * DM); const float* mn = modt + (size_t)ln * 9 * (6 * DM);
      fill_params(F, ng + (l * 4 + 3) * DM, ng + (ln * 4 + 0) * DM, ml + 5 * DM, mn + 0 * DM, mn + 1 * DM, F.wave * 64 + lane); }
    const LAS float* par = (const LAS float*)F.lds;
    f32x4 an[8], bn[8], hn[8]; float w1n = 0.f, w2n = 0.f;
#define R2_LOAD(mm) do { const RowPos _r = row_pos(mm); const bool _sk = (l == DEPTH - 1) && _r.isctx; \
        if (MOE) { int e1 = 0, s1 = 0, e2 = 0, s2 = 0; w1n = 0.f; w2n = 0.f; \
            if (!_sk) { e1 = route[(size_t)(mm) * 8]; s1 = route[(size_t)(mm) * 8 + 1]; e2 = route[(size_t)(mm) * 8 + 2]; s2 = route[(size_t)(mm) * 8 + 3]; w1n = ((const float*)route)[(size_t)(mm) * 8 + 4]; w2n = ((const float*)route)[(size_t)(mm) * 8 + 5]; } \
            const size_t r1 = (size_t)F.MISC[16 + e1] * 256 + s1, r2 = (size_t)F.MISC[16 + e2] * 256 + s2; \
            ld_yp_row2(F.ws, r1, RBM, trb, S, l32, an); ld_yp_row2(F.ws, r2, RBM, trb, S, l32, bn); } \
        else ld_y_row2(F.ws, (mm), _r, _r.isctx, 4, l32, an); \
        ld_row2_bf16(h + (size_t)(mm) * DM, l32, hn); } while (0)
    if (gw < T / 2) R2_LOAD(2 * gw + half);
    for (int pi = gw; pi < T / 2; pi += NGW) { const int m = 2 * pi + half; const RowPos rp = row_pos(m);
        const bool skip = (l == DEPTH - 1) && rp.isctx;
        const LAS float* pm = par + (2 + 3 * rp.modrow) * DM;
        f32x4 yv[8], hv[8], u[8];
#pragma unroll
        for (int j = 0; j < 8; ++j) { yv[j] = MOE ? (an[j] * w1n + bn[j] * w2n) : an[j]; hv[j] = hn[j]; }
        if (pi + NGW < T / 2) R2_LOAD(m + 2 * NGW);
        const float rstd_y = rsqrtf(sumsq_row2(yv) * (1.0f / DM) + NORM_EPS);
#pragma unroll
        for (int j = 0; j < 8; ++j) { if ((j & 3) == 0) __builtin_amdgcn_sched_barrier(0);
            const int c = 128 * j + 4 * l32; const f32x4 g3 = *(const LAS f32x4*)(par + c), gt = *(const LAS f32x4*)(pm + c);
            hv[j] = hv[j] + gt * (yv[j] * rstd_y * g3); }
        if (l == DEPTH - 1) { if (!skip) { float* dsto = out_ptr() + ((size_t)rp.b * SEQ + (rp.p - CTXL)) * DM;
#pragma unroll
                for (int j = 0; j < 8; ++j) *(f32x4*)(dsto + 128 * j + 4 * l32) = hv[j]; } }
        else st_row2_bf16(h + (size_t)m * DM, l32, hv);
        if (l < DEPTH - 1) { const float rstd_h = rsqrtf(sumsq_row2(hv) * (1.0f / DM) + NORM_EPS);
            norm_mod2<false>(hv, rstd_h, par + DM, pm + 1 * DM, pm + 2 * DM, xa + (size_t)m * DM, l32, true, u); }
    }
}
namespace scan {
constexpr int A_STR = 272, T_STR = 80;
constexpr int A1_OFF = 0, A2_OFF = 32 * A_STR, K2T_OFF = 2 * 32 * A_STR, VT_OFF = K2T_OFF + 128 * T_STR, DEC_OFF = VT_OFF + 128 * T_STR, BUF_BYTES = DEC_OFF + 512;
constexpr int NCH = TPB / 32;
__device__ __forceinline__ int crow(int r, int hi) { return (r & 3) + 8 * (r >> 2) + 4 * hi; }
__device__ __forceinline__ int tok_of(int p, int dir) { return dir == 0 ? p : (p < CTXL ? (CTXL - 1 - p) : (TPB + CTXL - 1 - p)); }

__device__ __forceinline__ int chunk_lowtok(int n, int dir) { return dir == 0 ? 32 * n : (n < CTXL / 32 ? CTXL - 32 - 32 * n : TPB + CTXL - 32 - 32 * n); }
constexpr int RAW_OFF = 2 * BUF_BYTES, RAW_BYTES = 3 * 8192;
__device__ __forceinline__ void prep_dma(const bf16_t* __restrict__ z, int b, int hd, int dir, int n, LAS unsigned char* raw, int pw, int lane) {
    const char* U = (const char*)(z + (size_t)(b * TPB + chunk_lowtok(n, dir)) * A_IN + hd * 128);
#pragma unroll
    for (int k = 0; k < 2; ++k) { const int c = 8 * pw + 4 * k + (lane >> 4), mr = dir ? 31 - c : c; const unsigned L = (unsigned)(mr * A_IN + (lane & 15) * 8) * 2u;
        __builtin_amdgcn_global_load_lds((const unsigned*)(U + L), (LAS unsigned*)(raw + 0 * 8192 + (2 * pw + k) * 1024), 16, 0, 0);
        __builtin_amdgcn_global_load_lds((const unsigned*)(U + 2048 * (1 + dir) + L), (LAS unsigned*)(raw + 1 * 8192 + (2 * pw + k) * 1024), 16, 0, 0);
        __builtin_amdgcn_global_load_lds((const unsigned*)(U + 6144 + L), (LAS unsigned*)(raw + 2 * 8192 + (2 * pw + k) * 1024), 16, 0, 0); }
}
struct Raw { unsigned short q[16], f[16], v[16]; };
__device__ __forceinline__ void prep_read(Raw& r, const LAS unsigned char* raw, int d, int rh) {
#pragma unroll
    for (int i = 0; i < 16; ++i) { const int o = (16 * rh + i) * 256 + d * 2;
        r.q[i] = *(const LAS unsigned short*)(raw + o); r.f[i] = *(const LAS unsigned short*)(raw + 8192 + o); r.v[i] = *(const LAS unsigned short*)(raw + 16384 + o); }
}
__device__ __forceinline__ void prep_compute(const Raw& r, float lbv, LAS unsigned char* buf, int d, int rh, int lane) {
    float cum[16], kk[16]; float run = 0.f;
#pragma unroll
    for (int i = 0; i < 16; ++i) { const float s = fast_rcp(1.0f + __builtin_amdgcn_exp2f(bf2f(r.f[i]) * -1.4426950408889634f)); const float f = lbv + (1.0f - lbv) * s; kk[i] = 1.0f - f; run += __builtin_amdgcn_logf(f); cum[i] = run; }
    const float tot_lo = __shfl(run, lane & 31);
    if (rh) {
#pragma unroll
        for (int i = 0; i < 16; ++i) cum[i] += tot_lo; }
    const float cend = __shfl(cum[15], (lane & 31) + 32);
    const float dec = __builtin_amdgcn_exp2f(cend);
    unsigned short a1[16], a2[16], k2[16];
#pragma unroll
    for (int i = 0; i < 16; ++i) { const float e1 = __builtin_amdgcn_exp2f(cum[i]), e2 = __builtin_amdgcn_exp2f(-cum[i]); const float A2 = kk[i] * e2;
        const unsigned w12 = cvt_pk_bf16(bf2f(r.q[i]) * 0.08838834764831845f * e1, A2);
        a1[i] = (unsigned short)(w12 & 0xffffu); a2[i] = (unsigned short)(w12 >> 16); k2[i] = (unsigned short)(cvt_pk_bf16(A2 * dec, 0.f) & 0xffffu); }
#pragma unroll
    for (int i = 0; i < 16; ++i) { const int c = 16 * rh + i;
        *(LAS unsigned short*)(buf + A1_OFF + c * A_STR + d * 2) = a1[i]; *(LAS unsigned short*)(buf + A2_OFF + c * A_STR + d * 2) = a2[i]; }
#pragma unroll
    for (int i = 0; i < 16; i += 2) { const int c = 16 * rh + i;
        *(LAS unsigned*)(buf + K2T_OFF + d * T_STR + c * 2) = (unsigned)k2[i] | ((unsigned)k2[i + 1] << 16);
        *(LAS unsigned*)(buf + VT_OFF + d * T_STR + c * 2) = (unsigned)r.v[i] | ((unsigned)r.v[i + 1] << 16); }
    if (rh == 0) *(LAS float*)(buf + DEC_OFF + d * 4) = dec;
}
#define SCAN_BAR() do { asm volatile("s_waitcnt lgkmcnt(0)" ::: "memory"); __builtin_amdgcn_s_barrier(); asm volatile("" ::: "memory"); } while (0)

__device__ __forceinline__ bf16x8 cvt8(const f32x16& x, int base) {
    u32x4 w; w.x = cvt_pk_bf16(x[base + 0], x[base + 1]); w.y = cvt_pk_bf16(x[base + 2], x[base + 3]); w.z = cvt_pk_bf16(x[base + 4], x[base + 5]); w.w = cvt_pk_bf16(x[base + 6], x[base + 7]);
    return *reinterpret_cast<bf16x8*>(&w);
}
__device__ __forceinline__ bf16x8 ld44(const LAS unsigned char* p) {
    const u32x2 a = *(const LAS u32x2*)p, b = *(const LAS u32x2*)(p + 16); u32x4 w = {a.x, a.y, b.x, b.y}; return *reinterpret_cast<bf16x8*>(&w);
}

__device__ __forceinline__ void scan_unit(unsigned char* ws, LAS unsigned char* lds, int unit, int wave, int lane, int tid) {
    static_assert(NCH % 2 == 0, "even chunk count");
    const int b = unit >> 4, hd = (unit >> 1) & 7, dir = unit & 1;
    const bf16_t* z = (const bf16_t*)(ws + WS_Z);
    bf16_t* od = (bf16_t*)(ws + WS_O) + (size_t)dir * T * DM;
    const float* lb = (const float*)(ws + WS_LB) + dir * 1024 + hd * 128;
    const int r32 = lane & 31, hi = lane >> 5;
    if (wave >= 4) {
        const int pw = wave - 4, d = 32 * pw + r32, rh = hi; const float lbv = lb[d];
        asm volatile("s_waitcnt vmcnt(0)" ::: "memory");
        LAS unsigned char* rawb = lds + RAW_OFF; Raw R;
        prep_dma(z, b, hd, dir, 0, rawb, pw, lane); prep_dma(z, b, hd, dir, 1, rawb + RAW_BYTES, pw, lane);
        asm volatile("s_waitcnt vmcnt(6)" ::: "memory"); SCAN_BAR();
        int st = 0;
        for (int n = -1; n < NCH - 1; ++n) {
            prep_read(R, rawb + st * RAW_BYTES, d, rh); prep_compute(R, lbv, lds + ((n + 1) & 1) * BUF_BYTES, d, rh, lane);
            const int st3 = (st == 0) ? 2 : st - 1;
            if (n + 3 < NCH) { prep_dma(z, b, hd, dir, n + 3, rawb + st3 * RAW_BYTES, pw, lane); asm volatile("s_waitcnt vmcnt(6)" ::: "memory"); }
            else asm volatile("s_waitcnt vmcnt(0)" ::: "memory");
            SCAN_BAR();
            st = (st == 2) ? 0 : st + 1;
        }
        SCAN_BAR();
    } else {
        const int sw = wave;
        f32x16 S[4];
#pragma unroll
        for (int t = 0; t < 4; ++t) S[t] = f32x16{};
        SCAN_BAR(); SCAN_BAR();
        for (int n = 0; n < NCH; ++n) {
            const LAS unsigned char* buf = lds + (n & 1) * BUF_BYTES;
            f32x16 X = f32x16{}, Xb = f32x16{};
#pragma unroll
            for (int ks = 0; ks < 8; ++ks) { const bf16x8 a = *(const LAS bf16x8*)(buf + A2_OFF + r32 * A_STR + (16 * ks + 8 * hi) * 2), bb = *(const LAS bf16x8*)(buf + A1_OFF + r32 * A_STR + (16 * ks + 8 * hi) * 2);
                if (ks & 1) Xb = __builtin_amdgcn_mfma_f32_32x32x16_bf16(a, bb, Xb, 0, 0, 0); else X = __builtin_amdgcn_mfma_f32_32x32x16_bf16(a, bb, X, 0, 0, 0); }
#pragma unroll
            for (int r = 0; r < 16; ++r) X[r] = (crow(r, hi) <= r32) ? X[r] + Xb[r] : 0.f;
            f32x16 O = f32x16{};
#pragma unroll
            for (int s0 = 0; s0 < 2; ++s0) { const bf16x8 a = cvt8(X, 8 * s0); const bf16x8 bb = ld44(buf + VT_OFF + (32 * sw + r32) * T_STR + (16 * s0 + 4 * hi) * 2);
                O = __builtin_amdgcn_mfma_f32_32x32x16_bf16(a, bb, O, 0, 0, 0); }
            f32x16 O2 = f32x16{}, O3 = f32x16{};
#pragma unroll
            for (int t = 0; t < 4; ++t)
#pragma unroll
                for (int s0 = 0; s0 < 2; ++s0) { const bf16x8 a = ld44(buf + A1_OFF + r32 * A_STR + (32 * t + 16 * s0 + 4 * hi) * 2); const bf16x8 bb = cvt8(S[t], 8 * s0);
                    if (t & 1) O3 = __builtin_amdgcn_mfma_f32_32x32x16_bf16(a, bb, O3, 0, 0, 0); else O2 = __builtin_amdgcn_mfma_f32_32x32x16_bf16(a, bb, O2, 0, 0, 0); }
#pragma unroll
            for (int r = 0; r < 16; ++r) O[r] += O2[r] + O3[r];
#pragma unroll
            for (int r = 0; r < 16; ++r) { const int p = 32 * n + crow(r, hi); od[(size_t)(b * TPB + tok_of(p, dir)) * DM + hd * 128 + 32 * sw + r32] = (bf16_t)f2bf(O[r]); }
#pragma unroll
            for (int t = 0; t < 4; ++t) {
#pragma unroll
                for (int g4 = 0; g4 < 4; ++g4) { const f32x4 dc = *(const LAS f32x4*)(buf + DEC_OFF + (32 * t + 8 * g4 + 4 * hi) * 4);
                    S[t][4 * g4 + 0] *= dc.x; S[t][4 * g4 + 1] *= dc.y; S[t][4 * g4 + 2] *= dc.z; S[t][4 * g4 + 3] *= dc.w; }
#pragma unroll
                for (int s0 = 0; s0 < 2; ++s0) { const bf16x8 a = *(const LAS bf16x8*)(buf + K2T_OFF + (32 * t + r32) * T_STR + (16 * s0 + 8 * hi) * 2), bb = *(const LAS bf16x8*)(buf + VT_OFF + (32 * sw + r32) * T_STR + (16 * s0 + 8 * hi) * 2);
                    S[t] = __builtin_amdgcn_mfma_f32_32x32x16_bf16(a, bb, S[t], 0, 0, 0); }
            }
            SCAN_BAR();
        }
    }
}
}

__device__ __forceinline__ void phase_a_readout(Frame& F) {
    const int lane = fresh_lane(), l32 = lane & 31, hh = lane >> 5;
    const int gw = F.vcu * NWAVES + F.wave, NGW = F.G * NWAVES;
    const bf16_t* of = (const bf16_t*)(F.ws + WS_O); const bf16_t* ob = of + (size_t)T * DM; const bf16_t* z = (const bf16_t*)(F.ws + WS_Z); bf16_t* xa = (bf16_t*)(F.ws + WS_XA);
    const f32x4 g = *(const f32x4*)(in_ptr(F, I_A_ONORM) + 4 * l32);
    for (int m = gw; m < T; m += NGW) {
        u32x2 a[4], bb[4], gt[4];
#pragma unroll
        for (int it = 0; it < 4; ++it) { const int c = (2 * it + hh) * 128 + 4 * l32;
            a[it] = *(const u32x2*)(of + (size_t)m * DM + c); bb[it] = *(const u32x2*)(ob + (size_t)m * DM + c); gt[it] = *(const u32x2*)(z + (size_t)m * A_IN + 4096 + c); }
#pragma unroll
        for (int it = 0; it < 4; ++it) { const int c = (2 * it + hh) * 128 + 4 * l32;
            const float o0 = bf2f(a[it].x & 0xffffu) + bf2f(bb[it].x & 0xffffu), o1 = bf2f(a[it].x >> 16) + bf2f(bb[it].x >> 16), o2 = bf2f(a[it].y & 0xffffu) + bf2f(bb[it].y & 0xffffu), o3 = bf2f(a[it].y >> 16) + bf2f(bb[it].y >> 16);
            const float rstd = rsqrtf(half_sum((o0 * o0 + o1 * o1) + (o2 * o2 + o3 * o3)) * (1.0f / 128.0f) + NORM_EPS);
            u32x2 w; w.x = pk2(o0 * rstd * g.x * silu_f(bf2f(gt[it].x & 0xffffu)), o1 * rstd * g.y * silu_f(bf2f(gt[it].x >> 16)));
            w.y = pk2(o2 * rstd * g.z * silu_f(bf2f(gt[it].y & 0xffffu)), o3 * rstd * g.w * silu_f(bf2f(gt[it].y >> 16)));
            *(u32x2*)(xa + (size_t)m * DM + c) = w; }
    }
}

__device__ __forceinline__ f32x2 rope_cs(const float* rt, int kind, int pos, int fi) { return *(const f32x2*)(rt + (((size_t)kind * 64 + pos) * 32 + fi) * 2); }

__device__ __forceinline__ void phase_b_row1(Frame& F) {
    const int lane = fresh_lane();
    const int gw = F.vcu * NWAVES + F.wave, NGW = F.G * NWAVES;
    const bf16_t* z = (const bf16_t*)(F.ws + WS_Z); bf16_t* cq = (bf16_t*)(F.ws + WS_O); bf16_t* ckv = cq + (size_t)T * 384; bf16_t* Kb = (bf16_t*)(F.ws + WS_K);
    const float* qg = in_ptr(F, I_B_QNORM); const float* kg = in_ptr(F, I_B_KVNORM); const float* rt = (const float*)(F.ws + WS_ROPE);
    const int ip = lane & 15, hg = lane >> 4;
    f32x2 qgv[3];
#pragma unroll
    for (int j = 0; j < 3; ++j) qgv[j] = *(const f32x2*)(qg + 128 * j + 2 * lane);
    const f32x4 kgv = *(const f32x4*)(kg + 4 * lane);
    for (int m = gw; m < T; m += NGW) { const RowPos rp = row_pos(m); const bf16_t* zr = z + (size_t)m * B_INP;
        float q[6]; float sq = 0.f;
#pragma unroll
        for (int j = 0; j < 3; ++j) { const unsigned w = *(const unsigned*)(zr + 128 * j + 2 * lane); q[2 * j] = bf2f(w & 0xffffu); q[2 * j + 1] = bf2f(w >> 16); sq += q[2 * j] * q[2 * j] + q[2 * j + 1] * q[2 * j + 1]; }
        const u32x2 kw = *(const u32x2*)(zr + 384 + 4 * lane); const float k0 = bf2f(kw.x & 0xffffu), k1 = bf2f(kw.x >> 16), k2 = bf2f(kw.y & 0xffffu), k3 = bf2f(kw.y >> 16);
        const float skv = (k0 * k0 + k1 * k1) + (k2 * k2 + k3 * k3);
        const float rq = rsqrtf(wave_sum(sq) * (1.0f / 384.0f) + NORM_EPS), rkv = rsqrtf(wave_sum(skv) * (1.0f / 256.0f) + NORM_EPS);
#pragma unroll
        for (int j = 0; j < 3; ++j) { const f32x2 g = qgv[j]; *(unsigned*)(cq + (size_t)m * 384 + 128 * j + 2 * lane) = pk2(q[2 * j] * rq * g.x, q[2 * j + 1] * rq * g.y); }
        { const f32x4 g = kgv; u32x2 w; w.x = pk2(k0 * rkv * g.x, k1 * rkv * g.y); w.y = pk2(k2 * rkv * g.z, k3 * rkv * g.w); *(u32x2*)(ckv + (size_t)m * 256 + 4 * lane) = w; }
        const unsigned rw = *(const unsigned*)(zr + 640 + 2 * ip); float x0 = bf2f(rw & 0xffffu), x1 = bf2f(rw >> 16);
        const float p0 = __shfl_xor(x0, 4), p1 = __shfl_xor(x1, 4);
        if (!rp.isctx) { const int pos = (ip < 8) ? rp.prow : rp.pcol; const f32x2 c0 = rope_cs(rt, 0, pos, (2 * ip) & 7), c1 = rope_cs(rt, 0, pos, (2 * ip + 1) & 7);
            if (ip & 4) { x0 = x0 * c0.x + p0 * c0.y; x1 = x1 * c1.x + p1 * c1.y; } else { x0 = x0 * c0.x - p0 * c0.y; x1 = x1 * c1.x - p1 * c1.y; } }
        const unsigned kb = pk2(x0, x1);
#pragma unroll
        for (int hh = 0; hh < 4; ++hh) { const int hd = 4 * hh + hg; *(unsigned*)(Kb + ((size_t)(rp.b * 16 + hd) * TPB + rp.p) * 96 + 64 + 2 * ip) = kb; }
    }
}
__device__ __forceinline__ void phase_b_row2(Frame& F) {
    const int lane = fresh_lane();
    const int gw = F.vcu * NWAVES + F.wave, NGW = F.G * NWAVES;
    bf16_t* Qb = (bf16_t*)(F.ws + WS_Q); const float* rt = (const float*)(F.ws + WS_ROPE);
    const int ip = lane & 15, hg = lane >> 4;
    for (int m = gw; m < T; m += NGW) { const RowPos rp = row_pos(m); if (rp.isctx) continue;
        const int pos = (ip < 8) ? rp.prow : rp.pcol; const f32x2 c0 = rope_cs(rt, 0, pos, (2 * ip) & 7), c1 = rope_cs(rt, 0, pos, (2 * ip + 1) & 7);
        unsigned w[4];
#pragma unroll
        for (int hh = 0; hh < 4; ++hh) w[hh] = *(const unsigned*)(Qb + (size_t)m * 1536 + (4 * hh + hg) * 96 + 64 + 2 * ip);
#pragma unroll
        for (int hh = 0; hh < 4; ++hh) { float x0 = bf2f(w[hh] & 0xffffu), x1 = bf2f(w[hh] >> 16); const float p0 = __shfl_xor(x0, 4), p1 = __shfl_xor(x1, 4);
            if (ip & 4) { x0 = x0 * c0.x + p0 * c0.y; x1 = x1 * c1.x + p1 * c1.y; } else { x0 = x0 * c0.x - p0 * c0.y; x1 = x1 * c1.x - p1 * c1.y; }
            *(unsigned*)(Qb + (size_t)m * 1536 + (4 * hh + hg) * 96 + 64 + 2 * ip) = pk2(x0, x1); }
    }
}
__device__ __forceinline__ void phase_c_row(Frame& F) {
    const int lane = fresh_lane();
    const int gw = F.vcu * NWAVES + F.wave, NGW = F.G * NWAVES;
    const bf16_t* z = (const bf16_t*)(F.ws + WS_Z); bf16_t* Qb = (bf16_t*)(F.ws + WS_Q); bf16_t* Kb = (bf16_t*)(F.ws + WS_K); bf16_t* Vb = (bf16_t*)(F.ws + WS_V);
    const float* qg = in_ptr(F, I_C_QNORM); const float* kg = in_ptr(F, I_C_KNORM); const float* rt = (const float*)(F.ws + WS_ROPE);
    const f32x2 qgv = *(const f32x2*)(qg + 2 * lane), kgv = *(const f32x2*)(kg + 2 * lane);
    const bool up = (lane & 16) != 0;
    for (int m = gw; m < T; m += NGW) { const RowPos rp = row_pos(m); const bf16_t* zr = z + (size_t)m * C_IN;
        f32x2 c0 = (f32x2){1.f, 0.f}, c1 = (f32x2){1.f, 0.f};
        if (!rp.isctx) { const int pos = (lane < 32) ? rp.prow : rp.pcol; c0 = rope_cs(rt, 2, pos, (2 * lane) & 31); c1 = rope_cs(rt, 2, pos, (2 * lane + 1) & 31); }
        unsigned w[10];
#pragma unroll
        for (int hv = 0; hv < 10; ++hv) w[hv] = *(const unsigned*)(zr + hv * 128 + 2 * lane);
#pragma unroll
        for (int hv = 0; hv < 10; ++hv) { float a = bf2f(w[hv] & 0xffffu), bq = bf2f(w[hv] >> 16);
            const float rstd = rsqrtf(wave_sum(a * a + bq * bq) * (1.0f / 128.0f) + NORM_EPS);
            a *= rstd * (hv < 8 ? qgv.x : kgv.x); bq *= rstd * (hv < 8 ? qgv.y : kgv.y);
            const float ap = __shfl_xor(a, 16), bp = __shfl_xor(bq, 16);
            const float ar = up ? (a * c0.x + ap * c0.y) : (a * c0.x - ap * c0.y), br = up ? (bq * c1.x + bp * c1.y) : (bq * c1.x - bp * c1.y);
            bf16_t* dst = (hv < 8) ? Qb + (size_t)m * 1024 + hv * 128 : Kb + (size_t)m * 256 + (hv - 8) * 128;
            *(unsigned*)(dst + 2 * lane) = pk2(ar, br); }
        *(u32x2*)(Vb + (size_t)m * 256 + 4 * lane) = *(const u32x2*)(zr + 1280 + 4 * lane);
    }
}
__device__ __forceinline__ void phase_d_row1(Frame& F) {
    const int lane = fresh_lane();
    const int gw = F.vcu * NWAVES + F.wave, NGW = F.G * NWAVES;
    const bf16_t* z = (const bf16_t*)(F.ws + WS_Z); bf16_t* Qb = (bf16_t*)(F.ws + WS_Q); bf16_t* Kb = (bf16_t*)(F.ws + WS_K); bf16_t* Vb = (bf16_t*)(F.ws + WS_V);
    const float* rt = (const float*)(F.ws + WS_ROPE);
    const int lp = lane & 31; const bool up = (lane & 8) != 0;
    for (int m = gw; m < T; m += NGW) { const RowPos rp = row_pos(m); const bf16_t* zr = z + (size_t)m * D_IN;
        f32x2 c0 = (f32x2){1.f, 0.f}, c1 = (f32x2){1.f, 0.f};
        if (!rp.isctx) { const int pos = (lp < 16) ? rp.prow : rp.pcol; c0 = rope_cs(rt, 1, pos, (2 * lp) & 15); c1 = rope_cs(rt, 1, pos, (2 * lp + 1) & 15); }
        unsigned w[16];
#pragma unroll
        for (int i = 0; i < 16; ++i) w[i] = *(const unsigned*)(zr + 128 * i + 2 * lane);
#pragma unroll
        for (int i = 0; i < 16; ++i) { const float a = bf2f(w[i] & 0xffffu), bq = bf2f(w[i] >> 16); const float ap = __shfl_xor(a, 8), bp = __shfl_xor(bq, 8);
            const float ar = up ? (a * c0.x + ap * c0.y) : (a * c0.x - ap * c0.y), br = up ? (bq * c1.x + bp * c1.y) : (bq * c1.x - bp * c1.y);
            bf16_t* dst = (i < 8) ? Qb + (size_t)m * 1024 + 128 * i : Kb + (size_t)m * 1024 + 128 * (i - 8); *(unsigned*)(dst + 2 * lane) = pk2(ar, br); }
        { const u32x4 a = *(const u32x4*)(zr + 2048 + 16 * lane), bq = *(const u32x4*)(zr + 2048 + 16 * lane + 8); *(u32x4*)(Vb + (size_t)m * 1024 + 16 * lane) = a; *(u32x4*)(Vb + (size_t)m * 1024 + 16 * lane + 8) = bq; }
    }
}
__device__ __forceinline__ void phase_d_row2(Frame& F) {
    const int lane = fresh_lane(), l32 = lane & 31, hh = lane >> 5;
    const int gw = F.vcu * NWAVES + F.wave, NGW = F.G * NWAVES;
    const bf16_t* A = (const bf16_t*)(F.ws + WS_O); bf16_t* xa = (bf16_t*)(F.ws + WS_XA);
    const float* lam = in_ptr(F, I_D_LAMBDA);
    const float lambda_init = 0.8f - 0.6f * 0.40656965974059917f;
    const float s1 = wave_sum(lam[lane] * lam[64 + lane]), s2 = wave_sum(lam[128 + lane] * lam[192 + lane]);
    const float lam_full = expf(s1) - expf(s2) + lambda_init;
    const f32x4 g = *(const f32x4*)(in_ptr(F, I_D_ONORM) + 4 * l32) * (1.0f - lambda_init);
    for (int m = gw; m < T; m += NGW) { if ((m % TPB) < CTXL) continue;
        u32x2 a[4], bb[4];
#pragma unroll
        for (int it = 0; it < 4; ++it) { const int hd = 2 * it + hh; a[it] = *(const u32x2*)(A + (size_t)m * 2048 + (2 * hd) * 128 + 4 * l32); bb[it] = *(const u32x2*)(A + (size_t)m * 2048 + (2 * hd + 1) * 128 + 4 * l32); }
#pragma unroll
        for (int it = 0; it < 4; ++it) { const int hd = 2 * it + hh;
            const float o0 = bf2f(a[it].x & 0xffffu) - lam_full * bf2f(bb[it].x & 0xffffu), o1 = bf2f(a[it].x >> 16) - lam_full * bf2f(bb[it].x >> 16);
            const float o2 = bf2f(a[it].y & 0xffffu) - lam_full * bf2f(bb[it].y & 0xffffu), o3 = bf2f(a[it].y >> 16) - lam_full * bf2f(bb[it].y >> 16);
            const float rstd = rsqrtf(half_sum((o0 * o0 + o1 * o1) + (o2 * o2 + o3 * o3)) * (1.0f / 128.0f) + NORM_EPS);
            u32x2 w; w.x = pk2(o0 * rstd * g.x, o1 * rstd * g.y); w.y = pk2(o2 * rstd * g.z, o3 * rstd * g.w);
            *(u32x2*)(xa + (size_t)m * DM + hd * 128 + 4 * l32) = w; }
    }
}

#ifndef MK_STAG
#define MK_STAG 1
#endif
#define MK_SPLITKV 0
#define MK_PRE_B 1
#define MK_PRE_C 1
#define MK_PRE_D 1
#define MK_PRE(DK) (MK_STAG && ((DK) == 96 ? MK_PRE_B : (DK) == 128 ? MK_PRE_C : MK_PRE_D))
template <int DK, int DV, int ldq, int ldk, int ldv, int ldo, int H, int GK, int GV>
__device__ __forceinline__ void attn_phase(Frame& F, const bf16_t* Q, const bf16_t* K, const bf16_t* V, bf16_t* O, float scale, bool skip_ctx, int dup = 1) {
    const float C = scale * 1.4426950408889634f, thr_raw = att::THR / scale;
    const int NHV = NBATCH * H * 16, NCTX = skip_ctx ? 0 : NBATCH * H;
    const int LO = NHV % F.G, NFULL = NHV - LO; int SF = 1;
    if (MK_SPLITKV && dup == 1 && LO > 0 && F.G % LO == 0) { const int q = F.G / LO; if (q == 2 || q == 4) SF = q; }
    const int NPART = (SF > 1) ? LO * SF : 0, NLAT = (SF > 1) ? NFULL : NHV, NTOT = NLAT + NPART + NCTX;
    float* PO = (float*)(F.ws + WS_YS); float* PML = PO + (size_t)256 * 256 * 128;
    for (int L0 = F.vcu; L0 < NTOT * dup; L0 += F.G) { const int L = (dup > 1) ? L0 % NTOT : L0;
        int b, hd, qb, part = -1, U = L;
        if (L >= NLAT && L < NLAT + NPART) { const int j = L - NLAT; U = NFULL + j / SF; part = j % SF; }
        if (L < NLAT + NPART) { const int grp = U >> 4; b = grp / H; hd = grp % H; qb = 1 + (U & 15); } else { const int L2 = L - NLAT - NPART; b = L2 / H; hd = L2 % H; qb = 0; }
        const size_t row0 = (size_t)b * TPB + (size_t)qb * 256; const bf16_t* Kh = K + (size_t)(b * (H / GK) + hd / GK) * TPB * DK; const bf16_t* Vh = V + (size_t)(b * (H / GV) + hd / GV) * TPB * DV;
        if (part >= 0) { const int klen = TPB / SF, j = L - NLAT;
            att::attn_unit_stag<DK, DV, ldq, DK, DV, ldo, MK_PRE(DK) != 0, false, true>(Q + row0 * ldq + hd * DK, Kh + (size_t)part * klen * DK, Vh + (size_t)part * klen * DV, nullptr,
                               klen, C, thr_raw, (char*)F.lds, F.wave, PO + (size_t)j * 256 * DV, PML + (size_t)j * 256 * 2); }
        else
        att::attn_unit_stag<DK, DV, ldq, DK, DV, ldo, MK_PRE(DK) != 0, false>(Q + row0 * ldq + hd * DK, Kh, Vh, O + row0 * ldo + hd * DV,
                               qb == 0 ? CTXL : TPB, C, thr_raw, (char*)F.lds, F.wave);
    }
    __syncthreads();
}
template <int DV, int ldo, int H>
__device__ __forceinline__ void attn_merge(Frame& F, bf16_t* O) {
    const int NHV = NBATCH * H * 16, LO = NHV % F.G, NFULL = NHV - LO; int SF = 1;
    if (LO > 0 && F.G % LO == 0) { const int q = F.G / LO; if (q == 2 || q == 4) SF = q; }
    if (SF == 1) return;
    const float* PO = (const float*)(F.ws + WS_YS); const float* PML = PO + (size_t)256 * 256 * 128;
    const int lane = fresh_lane(), gw = F.vcu * NWAVES + F.wave, NGW = F.G * NWAVES;
    for (int it = gw; it < LO * 256; it += NGW) { const int u = it >> 8, r = it & 255, U = NFULL + u;
        const int grp = U >> 4, b = grp / H, hd = grp % H, qb = 1 + (U & 15);
        float mi[4], li[4], m = -3.0e38f;
#pragma unroll
        for (int i = 0; i < 4; ++i) { if (i < SF) { const f32x2 ml = *(const f32x2*)(PML + ((size_t)(u * SF + i) * 256 + r) * 2); mi[i] = ml.x; li[i] = ml.y; m = fmaxf(m, ml.x); } else { mi[i] = 0.f; li[i] = 0.f; } }
        float l = 0.f, w[4];
#pragma unroll
        for (int i = 0; i < 4; ++i) { w[i] = (i < SF) ? __builtin_amdgcn_exp2f(mi[i] - m) : 0.f; l += w[i] * li[i]; }
        const float rl = 1.0f / l;
        bf16_t* orow = O + ((size_t)b * TPB + (size_t)qb * 256 + r) * ldo + hd * DV;
#pragma unroll
        for (int c0 = 0; c0 < DV; c0 += 64) { float acc = 0.f;
#pragma unroll
            for (int i = 0; i < 4; ++i) if (i < SF) acc += w[i] * PO[((size_t)(u * SF + i) * 256 + r) * DV + c0 + lane];
            orow[c0 + lane] = (bf16_t)f2bf(acc * rl); } }
}
#ifndef MK_MULTI
#define MK_MULTI 0
#endif
constexpr int NPHASE = 37;
#ifndef MK_REP_MASK
#define MK_REP_MASK 0ull
#endif
#ifndef MK_REP_N
#define MK_REP_N 1
#endif
#ifndef MK_DUP
#define MK_DUP -1
#endif
#define DUPF(k) ((k) == MK_DUP ? 2 : 1)
#ifndef MK_LIMIT
#define MK_LIMIT 37
#endif
struct Args { const float* in[N_IN]; float* out; unsigned char* ws; int ph_lo, ph_hi; };

__device__ __forceinline__ void gemm_plain_f32(Frame& F, const bf16_t* A, const bf16_t* Bt, int N, int K, float* C, int ldc, int dup = 1) {
    pg8::Gemm g{A, Bt, K / 64, N, K, 0, nullptr, 0, nullptr}; pg8::StaticOrder S; S.init(T / 256, N / 256, F.G, (int)blockIdx.x, dup); pg8::EpiF32 E{C, ldc};
    pg8::gemm_phase<pg8::EpiF32, pg8::StaticOrder, false>(F.lds, g, S, E, F.wave);
}
__device__ __forceinline__ void gemm_plain_bf16(Frame& F, const bf16_t* A, const bf16_t* Bt, int N, int K, bf16_t* C, int ldc, int dup = 1) {
    pg8::Gemm g{A, Bt, K / 64, N, K, 0, nullptr, 0, nullptr}; pg8::StaticOrder S; S.init(T / 256, N / 256, F.G, (int)blockIdx.x, dup); pg8::EpiBf16 E{C, ldc};
    pg8::gemm_phase<pg8::EpiBf16, pg8::StaticOrder, false>(F.lds, g, S, E, F.wave);
}
template <int S>
__device__ __forceinline__ void gemm_n1024(Frame& F, const bf16_t* A, const bf16_t* Bt, int K, bool skip_ctx, int dup = 1) {
    { pg8::Gemm g{A, Bt, K / 64, DM, K, 0, nullptr, 0, nullptr}; pg8::LatOrder S1; S1.so.init(128, DM / 256, F.G, (int)blockIdx.x, dup); pg8::EpiBf16 E{(bf16_t*)(F.ws + WS_Y), DM};
      pg8::gemm_phase<pg8::EpiBf16, pg8::LatOrder, false>(F.lds, g, S1, E, F.wave); }
    if (!skip_ctx) { pg8::Gemm g{A, Bt, K / 64 / S, DM, K, 0, nullptr, 0, nullptr}; pg8::CtxSplitOrder S2{DM / 256, S, K / 64 / S, F.G, (int)blockIdx.x, dup}; pg8::EpiF32 E{(float*)(F.ws + WS_YS), DM};
      pg8::gemm_phase<pg8::EpiF32, pg8::CtxSplitOrder, false>(F.lds, g, S2, E, F.wave); }
}
__device__ __forceinline__ void gemm_swiglu(Frame& F, const bf16_t* A, const bf16_t* Bt, bf16_t* C, int dup = 1) {
    pg8::Gemm g{A, Bt, DM / 128, 2 * FF, DM / 2, 0, nullptr, 0, nullptr}; pg8::StaticOrder S; S.init(T / 256, 2 * FF / 256, F.G, (int)blockIdx.x, dup); pg8::EpiSwiglu E{C, FF, 1.0f / 32.0f};
    pg8::gemm_phase<pg8::EpiSwiglu, pg8::StaticOrder, false, true>(F.lds, g, S, E, F.wave);
}
__device__ __forceinline__ void gemm_moe_gu(Frame& F, int lm, int dup = 1) {
    moe_tables(F, 2 * lm + 1);
    pg8::Gemm g{(const bf16_t*)(F.ws + WS_XA), (const bf16_t*)(F.ws + WS_MOE_GU + (size_t)lm * 8 * SZ_GU), DM / 128, 2 * FF, DM / 2, (size_t)2 * FF * DM / 2, (const int*)(F.ws + WS_LIST), T, (const LAS int*)(F.MISC + 32)};
    pg8::MoeOrder S; S.so.init((int)F.MISC[24], 2 * FF / 256, F.G, (int)blockIdx.x, dup); S.rb0 = (const LAS int*)(F.MISC + 16); pg8::EpiSwiglu E{(bf16_t*)(F.ws + WS_ACT), FF, 1.0f / 32.0f};
    pg8::gemm_phase<pg8::EpiSwiglu, pg8::MoeOrder, true, true>(F.lds, g, S, E, F.wave);
}
__device__ __forceinline__ void gemm_moe_down(Frame& F, int lm, int dup = 1) {
    moe_tables(F, 2 * lm + 1);
    int RBM, trb, S; pg8::moe_tail_params((int)F.MISC[24], RBM, trb, S);
    const bf16_t* A = (const bf16_t*)(F.ws + WS_ACT); const bf16_t* Bt = (const bf16_t*)(F.ws + WS_MOE_DN + (size_t)lm * 8 * SZ_DN);
    { pg8::Gemm g{A, Bt, FF / 64, DM, FF, (size_t)DM * FF, nullptr, 0, nullptr};
      pg8::MoeOrder S1; S1.so.init(RBM, DM / 256, F.G, (int)blockIdx.x, dup); S1.rb0 = (const LAS int*)(F.MISC + 16); pg8::EpiBf16 E{(bf16_t*)(F.ws + WS_YP), DM};
      pg8::gemm_phase<pg8::EpiBf16, pg8::MoeOrder, false>(F.lds, g, S1, E, F.wave); }
    if (trb > 0) { pg8::Gemm g{A, Bt, FF / 64 / S, DM, FF, (size_t)DM * FF, nullptr, 0, nullptr};
      pg8::MoeTailOrder S2{RBM, trb, S, FF / 64 / S, F.G, (int)blockIdx.x, dup, (const LAS int*)(F.MISC + 16)}; pg8::EpiF32 E{(float*)(F.ws + WS_YS), DM};
      pg8::gemm_phase<pg8::EpiF32, pg8::MoeTailOrder, false>(F.lds, g, S2, E, F.wave); }
}
__device__ __forceinline__ void xcd_or_nothing(const XcdBarrier& b, int wave) { if (!MK_MULTI) xcd_barrier(b, wave); }
__global__ void __launch_bounds__(NWAVES * 64, 2) fwd_kernel(Args args) {
    extern __shared__ __attribute__((aligned(16))) unsigned char lds_raw[];
    Frame F;
    F.lds = (LAS unsigned char*)lds_raw; F.MISC = (volatile LAS unsigned*)(F.lds + MISC_OFF);
    F.wave = __builtin_amdgcn_readfirstlane((int)threadIdx.x >> 6);
    F.G = gridDim.x; { const int bx = blockIdx.x; F.vcu = (F.G % 8 == 0) ? (bx % 8) * (F.G / 8) + bx / 8 : bx; }
    F.ws = args.ws;
    for (int u = threadIdx.x; u < 256; u += NWAVES * 64) ((LAS unsigned*)(F.lds + MISC_OFF))[u] = 0u;
    __syncthreads();
    XcdBarrier bar; bar.bar = (unsigned*)((unsigned*)F.ws + CW_BAR); bar.x = 0; bar.st = nullptr;
    if (!MK_MULTI) bar = xcd_barrier_post((unsigned*)((unsigned*)F.ws + CW_BAR), F.MISC + 0);
    const int lo = args.ph_lo, hi = args.ph_hi;
#define IN(k) (lo <= (k) && (k) < hi)
#define NREP(k) ((((unsigned long long)(MK_REP_MASK) >> (k)) & 1ull) ? (1 + MK_REP_N) : 1)
#define SEAM(k) do { if (!MK_MULTI && IN((k) + 1)) xcd_barrier(bar, F.wave); } while (0)
    unsigned char* ws = F.ws;
    bf16_t* XA = (bf16_t*)(ws + WS_XA); bf16_t* Y = (bf16_t*)(ws + WS_Y); bf16_t* ACT = (bf16_t*)(ws + WS_ACT);
    bf16_t* Qb = (bf16_t*)(ws + WS_Q); bf16_t* Kb = (bf16_t*)(ws + WS_K); bf16_t* Vb = (bf16_t*)(ws + WS_V); bf16_t* Ob = (bf16_t*)(ws + WS_O);

    if (IN(0)) { for (int rep = 0; rep < NREP(0); ++rep) { p0_prologue(F); if (rep + 1 < NREP(0)) xcd_or_nothing(bar, F.wave); } SEAM(0); }
    if (IN(1)) { for (int rep = 0; rep < NREP(1); ++rep) { for (int d2 = 0; d2 < DUPF(1); ++d2) { phase_r0(F); } if (rep + 1 < NREP(1)) xcd_or_nothing(bar, F.wave); } SEAM(1); }
    if (IN(2)) { for (int rep = 0; rep < NREP(2); ++rep) { gemm_plain_bf16(F, XA, (const bf16_t*)(ws + WS_WA_IN), A_IN, DM, (bf16_t*)(ws + WS_Z), A_IN, DUPF(2)); if (rep + 1 < NREP(2)) xcd_or_nothing(bar, F.wave); } SEAM(2); }
    if (IN(3)) { for (int rep = 0; rep < NREP(3); ++rep) { if ((int)blockIdx.x < NBATCH * 8 * 2) { for (int d2 = 0; d2 < DUPF(3); ++d2) { const int ln = fresh_lane(); scan::scan_unit(ws, F.lds, (int)blockIdx.x, F.wave, ln, F.wave * 64 + ln); __syncthreads(); } }
        else if (rep == 0) { const int nidle = F.G - NBATCH * 8 * 2; p0_convert(F, p0_split_item(), g_mats.item0[NMAT], ((int)blockIdx.x - NBATCH * 8 * 2) * NWAVES + F.wave, nidle * NWAVES, fresh_lane()); } if (rep + 1 < NREP(3)) xcd_or_nothing(bar, F.wave); } SEAM(3); }
    if (IN(4)) { for (int rep = 0; rep < NREP(4); ++rep) { for (int d2 = 0; d2 < DUPF(4); ++d2) { phase_a_readout(F); } if (rep + 1 < NREP(4)) xcd_or_nothing(bar, F.wave); } SEAM(4); }
    if (IN(5)) { for (int rep = 0; rep < NREP(5); ++rep) { gemm_n1024<8>(F, XA, (const bf16_t*)(ws + WS_WA_OUT), DM, false, DUPF(5)); if (rep + 1 < NREP(5)) xcd_or_nothing(bar, F.wave); } SEAM(5); }
    if (IN(6)) { for (int rep = 0; rep < NREP(6); ++rep) { phase_r1<false>(F, 0); if (rep + 1 < NREP(6)) xcd_or_nothing(bar, F.wave); } SEAM(6); }
    if (IN(7)) { for (int rep = 0; rep < NREP(7); ++rep) { gemm_swiglu(F, XA, (const bf16_t*)(ws + WS_FFN_GU), ACT, DUPF(7)); if (rep + 1 < NREP(7)) xcd_or_nothing(bar, F.wave); } SEAM(7); }
    if (IN(8)) { for (int rep = 0; rep < NREP(8); ++rep) { gemm_n1024<4>(F, ACT, (const bf16_t*)(ws + WS_FFN_DN), FF, false, DUPF(8)); if (rep + 1 < NREP(8)) xcd_or_nothing(bar, F.wave); } SEAM(8); }
    if (IN(9)) { for (int rep = 0; rep < NREP(9); ++rep) { phase_r2<false>(F, 0); if (rep + 1 < NREP(9)) xcd_or_nothing(bar, F.wave); } SEAM(9); }
    if (IN(10)) { for (int rep = 0; rep < NREP(10); ++rep) { gemm_plain_bf16(F, XA, (const bf16_t*)(ws + WS_WB_IN), B_INP, DM, (bf16_t*)(ws + WS_Z), B_INP, DUPF(10)); if (rep + 1 < NREP(10)) xcd_or_nothing(bar, F.wave); } SEAM(10); }
    if (IN(11)) { for (int rep = 0; rep < NREP(11); ++rep) { for (int d2 = 0; d2 < DUPF(11); ++d2) { phase_b_row1(F); } if (rep + 1 < NREP(11)) xcd_or_nothing(bar, F.wave); } SEAM(11); }
    if (IN(12)) {
        { pg8::Gemm g{Ob, (const bf16_t*)(ws + WS_WB_QB), 384 / 64, 1536, 384, 0, nullptr, 0, nullptr}; pg8::StaticOrder S; S.init(T / 256, 1536 / 256, F.G, (int)blockIdx.x); pg8::EpiRopeB E{Qb, (const float*)(ws + WS_ROPE), MK_PRE(96) ? 0.10206207261596575f * 1.4426950408889634f : 1.0f};
          pg8::gemm_phase<pg8::EpiRopeB, pg8::StaticOrder, false>(F.lds, g, S, E, F.wave); }
        { pg8::Gemm g{Ob + (size_t)T * 384, (const bf16_t*)(ws + WS_WB_KVB), 256 / 64, 2048, 256, 0, nullptr, 0, nullptr}; pg8::StaticOrder S; S.init(T / 256, 2048 / 256, F.G, (int)blockIdx.x); pg8::EpiKV E{Kb, 1536, Vb, 1024};
          pg8::gemm_phase<pg8::EpiKV, pg8::StaticOrder, false>(F.lds, g, S, E, F.wave); }
        SEAM(12); }
    if (IN(13)) { for (int rep = 0; rep < NREP(13); ++rep) { attn_phase<96, 64, 1536, 1536, 1024, DM, 16, 1, 1>(F, Qb, Kb, Vb, XA, 0.10206207261596575f, false, DUPF(13)); if (rep + 1 < NREP(13)) xcd_or_nothing(bar, F.wave); } SEAM(13); }
    if (IN(14)) { for (int rep = 0; rep < NREP(14); ++rep) { gemm_n1024<8>(F, XA, (const bf16_t*)(ws + WS_WB_OUT), DM, false, DUPF(14)); if (rep + 1 < NREP(14)) xcd_or_nothing(bar, F.wave); } SEAM(14); }
    if (IN(15)) { for (int rep = 0; rep < NREP(15); ++rep) { phase_r1<true>(F, 1); if (rep + 1 < NREP(15)) xcd_or_nothing(bar, F.wave); } SEAM(15); }
    if (IN(16)) { moe_build(F); SEAM(16); }
    if (IN(17)) { for (int rep = 0; rep < NREP(17); ++rep) { gemm_moe_gu(F, 0, DUPF(17)); if (rep + 1 < NREP(17)) xcd_or_nothing(bar, F.wave); } SEAM(17); }
    if (IN(18)) { for (int rep = 0; rep < NREP(18); ++rep) { gemm_moe_down(F, 0, DUPF(18)); if (rep + 1 < NREP(18)) xcd_or_nothing(bar, F.wave); } SEAM(18); }
    if (IN(19)) { for (int rep = 0; rep < NREP(19); ++rep) { moe_tables(F, 1); phase_r2<true>(F, 1); if (rep + 1 < NREP(19)) xcd_or_nothing(bar, F.wave); } SEAM(19); }
    if (IN(20)) { { pg8::Gemm g{XA, (const bf16_t*)(ws + WS_WC_IN), DM / 64, C_IN, DM, 0, nullptr, 0, nullptr}; pg8::StaticOrder S; S.init(T / 256, C_IN / 256, F.G, (int)blockIdx.x, DUPF(20));
          pg8::EpiNormRopeC E{Qb, Kb, Vb, in_ptr(F, I_C_QNORM), in_ptr(F, I_C_KNORM), (const float*)(ws + WS_ROPE) + (size_t)2 * 64 * 32 * 2, (LAS float*)(F.lds + pg8::STAGE_BYTES + 2048), MK_PRE(128) ? 0.08838834764831845f * 1.4426950408889634f : 1.0f};
          pg8::gemm_phase<pg8::EpiNormRopeC, pg8::StaticOrder, false>(F.lds, g, S, E, F.wave); } }
    if (IN(21)) { SEAM(21); }
    if (IN(22)) { for (int rep = 0; rep < NREP(22); ++rep) { attn_phase<128, 128, 1024, 256, 256, DM, 8, 4, 4>(F, Qb, Kb, Vb, XA, 0.08838834764831845f, false, DUPF(22)); if (rep + 1 < NREP(22)) xcd_or_nothing(bar, F.wave); } SEAM(22); }
    if (IN(23)) { for (int rep = 0; rep < NREP(23); ++rep) { gemm_n1024<8>(F, XA, (const bf16_t*)(ws + WS_WC_OUT), DM, false, DUPF(23)); if (rep + 1 < NREP(23)) xcd_or_nothing(bar, F.wave); } SEAM(23); }
    if (IN(24)) { for (int rep = 0; rep < NREP(24); ++rep) { phase_r1<false>(F, 2); if (rep + 1 < NREP(24)) xcd_or_nothing(bar, F.wave); } SEAM(24); }
    if (IN(25)) { for (int rep = 0; rep < NREP(25); ++rep) { gemm_swiglu(F, XA, (const bf16_t*)(ws + WS_FFN_GU + SZ_GU), ACT, DUPF(25)); if (rep + 1 < NREP(25)) xcd_or_nothing(bar, F.wave); } SEAM(25); }
    if (IN(26)) { for (int rep = 0; rep < NREP(26); ++rep) { gemm_n1024<4>(F, ACT, (const bf16_t*)(ws + WS_FFN_DN + SZ_DN), FF, false, DUPF(26)); if (rep + 1 < NREP(26)) xcd_or_nothing(bar, F.wave); } SEAM(26); }
    if (IN(27)) { for (int rep = 0; rep < NREP(27); ++rep) { phase_r2<false>(F, 2); if (rep + 1 < NREP(27)) xcd_or_nothing(bar, F.wave); } SEAM(27); }
    if (IN(28)) { { pg8::Gemm g{XA, (const bf16_t*)(ws + WS_WD_IN), DM / 64, D_IN, DM, 0, nullptr, 0, nullptr}; pg8::StaticOrder S; S.init(T / 256, D_IN / 256, F.G, (int)blockIdx.x, DUPF(28));
          pg8::EpiRopeD E{Qb, Kb, Vb, (const float*)(ws + WS_ROPE) + (size_t)1 * 64 * 32 * 2, MK_PRE(64) ? 0.125f * 1.4426950408889634f : 1.0f};
          pg8::gemm_phase<pg8::EpiRopeD, pg8::StaticOrder, false>(F.lds, g, S, E, F.wave); } SEAM(28); }
    if (IN(29)) { for (int rep = 0; rep < NREP(29); ++rep) { attn_phase<64, 128, 1024, 1024, 1024, 2048, 16, 1, 2>(F, Qb, Kb, Vb, Ob, 0.125f, true, DUPF(29)); if (rep + 1 < NREP(29)) xcd_or_nothing(bar, F.wave); } SEAM(29); }
    if (IN(30)) { for (int rep = 0; rep < NREP(30); ++rep) { for (int d2 = 0; d2 < DUPF(30); ++d2) { phase_d_row2(F); } if (rep + 1 < NREP(30)) xcd_or_nothing(bar, F.wave); } SEAM(30); }
    if (IN(31)) { for (int rep = 0; rep < NREP(31); ++rep) { gemm_n1024<8>(F, XA, (const bf16_t*)(ws + WS_WD_OUT), DM, true, DUPF(31)); if (rep + 1 < NREP(31)) xcd_or_nothing(bar, F.wave); } SEAM(31); }
    if (IN(32)) { for (int rep = 0; rep < NREP(32); ++rep) { phase_r1<true>(F, 3); if (rep + 1 < NREP(32)) xcd_or_nothing(bar, F.wave); } SEAM(32); }
    if (IN(33)) { moe_build(F); SEAM(33); }
    if (IN(34)) { for (int rep = 0; rep < NREP(34); ++rep) { gemm_moe_gu(F, 1, DUPF(34)); if (rep + 1 < NREP(34)) xcd_or_nothing(bar, F.wave); } SEAM(34); }
    if (IN(35)) { for (int rep = 0; rep < NREP(35); ++rep) { gemm_moe_down(F, 1, DUPF(35)); if (rep + 1 < NREP(35)) xcd_or_nothing(bar, F.wave); } SEAM(35); }
    if (IN(36)) { moe_tables(F, 3); phase_r2<true>(F, 3); }
#if MK_LIMIT < 37
    {
        xcd_barrier(bar, F.wave);
        float* outp = out_ptr(); const int tid = F.wave * 64 + fresh_lane();
#if MK_LIMIT == 34 || MK_LIMIT == 35 || MK_LIMIT == 36
        moe_tables(F, 3);
        int RBM, trb, S; pg8::moe_tail_params((int)F.MISC[24], RBM, trb, S);
#endif
        for (int r = (int)blockIdx.x; r < NBATCH * SEQ; r += F.G) { const int b = r / SEQ, l = r % SEQ; const size_t m = (size_t)b * TPB + CTXL + l;
#if MK_LIMIT == 34
            const int* route = (const int*)(ws + WS_ROUTE); const int* list = (const int*)(ws + WS_LIST);
            const int e1 = route[m * 8], s1 = route[m * 8 + 1], e2 = route[m * 8 + 2], s2 = route[m * 8 + 3];
            const unsigned char* xa8 = (const unsigned char*)(ws + WS_XA) + m * DM;
            for (int c = tid; c < DM; c += NWAVES * 64) { float v = 0.f;
                if (c >= 512) v = (float)((unsigned)xa8[2 * (c - 512)] + 256u * (unsigned)xa8[2 * (c - 512) + 1]); else
                if (c < 4) v = (float)route[m * 8 + c]; else if (c < 6) v = ((const float*)route)[m * 8 + c]; else if (c == 6) v = (float)(list[(size_t)e1 * T + s1] - (int)m); else if (c == 7) v = (float)(list[(size_t)e2 * T + s2] - (int)m);
                else if (c < 16) v = (float)F.MISC[16 + (c - 8)]; else if (c < 24) v = (float)F.MISC[32 + (c - 16)]; else if (c == 24) v = (float)F.MISC[24];
                outp[(size_t)r * DM + c] = v; }
#elif MK_LIMIT == 35
            const int* route = (const int*)(ws + WS_ROUTE); const bf16_t* act = (const bf16_t*)(ws + WS_ACT);
            const size_t r1 = (size_t)F.MISC[16 + route[m * 8]] * 256 + route[m * 8 + 1], r2 = (size_t)F.MISC[16 + route[m * 8 + 2]] * 256 + route[m * 8 + 3];
            for (int c = tid; c < DM; c += NWAVES * 64) { float v = 0.f;
                for (int q = 0; q < 4; ++q) { const int cc = c + q * DM; if (cc < FF) v += bf2f((unsigned)act[r1 * FF + cc]) + 2.0f * bf2f((unsigned)act[r2 * FF + cc]); }
                outp[(size_t)r * DM + c] = v; }
#elif MK_LIMIT == 36
            const int* route = (const int*)(ws + WS_ROUTE);
            const size_t r1 = (size_t)F.MISC[16 + route[m * 8]] * 256 + route[m * 8 + 1], r2 = (size_t)F.MISC[16 + route[m * 8 + 2]] * 256 + route[m * 8 + 3];
            for (int c = tid; c < DM; c += NWAVES * 64) { float v = 0.f;
                for (int k = 0; k < 2; ++k) { const size_t rr = k ? r2 : r1; const int rb = (int)(rr >> 8); float a = 0.f;
                    if (rb >= RBM) { const float* ys = (const float*)(ws + WS_YS) + ((size_t)(rb - RBM) * 256 + (rr & 255)) * DM; for (int s2 = 0; s2 < S; ++s2) a += ys[(size_t)s2 * trb * 256 * DM + c]; }
                    else a = bf2f((unsigned)((const bf16_t*)(ws + WS_YP))[rr * DM + c]);
                    v += (k ? 2.0f : 1.0f) * a; }
                outp[(size_t)r * DM + c] = v; }
#else
            const bf16_t* hh = (const bf16_t*)(ws + WS_H); const size_t src = m * DM;
            for (int c = tid; c < DM; c += NWAVES * 64) outp[(size_t)r * DM + c] = bf2f((unsigned)hh[src + c]);
#endif
        }
    }
#endif
#undef IN
#undef SEAM
}

extern "C" void kernel_launch(void* const* d_in, const int* in_sizes, int n_in, void* d_out, int out_size, void* d_ws, size_t ws_size, hipStream_t stream) {
    static int grid = 0;
    if (grid == 0) {
        if (n_in != N_IN || out_size != NBATCH * SEQ * DM || ws_size < WS_END) { fprintf(stderr, "kernel_launch: unexpected shapes: n_in %d out %d ws %zu (need %zu)\n", n_in, out_size, ws_size, (size_t)WS_END); grid = -1; return; }
        int dev = 0, cus = 0, per_cu = 0;
        if (hipGetDevice(&dev) != hipSuccess || hipDeviceGetAttribute(&cus, hipDeviceAttributeMultiprocessorCount, dev) != hipSuccess) { grid = -1; return; }
        if (hipFuncSetAttribute((const void*)fwd_kernel, hipFuncAttributeMaxDynamicSharedMemorySize, LDS_BYTES) != hipSuccess) { fprintf(stderr, "kernel_launch: hipFuncSetAttribute failed\n"); grid = -1; return; }
        if (hipOccupancyMaxActiveBlocksPerMultiprocessor(&per_cu, (const void*)fwd_kernel, NWAVES * 64, LDS_BYTES) != hipSuccess || per_cu < 1) fprintf(stderr, "kernel_launch: occupancy query reports %d\n", per_cu);
        (void)hipGetLastError();
        grid = cus;
    }
    if (grid < 0) return;
    (void)hipMemsetAsync((char*)d_ws + WS_CTL, 0, CTL_BYTES, stream);
    Args a{};
    for (int i = 0; i < N_IN; ++i) a.in[i] = (const float*)d_in[i];
    a.out = (float*)d_out; a.ws = (unsigned char*)d_ws;
#if MK_MULTI
    for (int p = 0; p < MK_LIMIT; ++p) { a.ph_lo = p; a.ph_hi = p + 1; hipLaunchKernelGGL(fwd_kernel, dim3(grid), dim3(NWAVES * 64), LDS_BYTES, stream, a); }
#else
    a.ph_lo = 0; a.ph_hi = MK_LIMIT; hipLaunchKernelGGL(fwd_kernel, dim3(grid), dim3(NWAVES * 64), LDS_BYTES, stream, a);
#endif
    const hipError_t le = hipPeekAtLastError();
    if (le != hipSuccess) fprintf(stderr, "kernel_launch: launch failed: %s\n", hipGetErrorName(le));
}
```

```cpp
#include <hip/hip_runtime.h>
#include <cstdio>
#include <cstdint>

#define GAS __attribute__((address_space(1)))
#define LAS __attribute__((address_space(3)))
typedef unsigned short bf16_t;
typedef short bf16x8 __attribute__((ext_vector_type(8)));
typedef short s16x4 __attribute__((ext_vector_type(4)));
typedef float f32x2 __attribute__((ext_vector_type(2)));
typedef float f32x4 __attribute__((ext_vector_type(4)));
typedef float f32x16 __attribute__((ext_vector_type(16)));
typedef unsigned u32x2 __attribute__((ext_vector_type(2)));
typedef unsigned u32x4 __attribute__((ext_vector_type(4)));

__device__ __forceinline__ float bf2f(unsigned b) { return __uint_as_float(b << 16); }
__device__ __forceinline__ unsigned f2bf(float f) { unsigned u = __float_as_uint(f); return (u + 0x7fffu + ((u >> 16) & 1u)) >> 16; }
__device__ __forceinline__ unsigned pk2(float lo, float hi) { return f2bf(lo) | (f2bf(hi) << 16); }
__device__ __forceinline__ unsigned cvt_pk_bf16(float lo, float hi) { unsigned r; asm volatile("v_cvt_pk_bf16_f32 %0, %1, %2" : "=v"(r) : "v"(lo), "v"(hi)); return r; }
typedef int v8i32 __attribute__((ext_vector_type(8)));
__device__ __forceinline__ unsigned pk4_fp8(float a, float b, float c, float d) { int w = 0; w = __builtin_amdgcn_cvt_pk_fp8_f32(a, b, w, false); w = __builtin_amdgcn_cvt_pk_fp8_f32(c, d, w, true); asm volatile("s_nop 1" : "+v"(w)); return (unsigned)w; }
__device__ __forceinline__ float wave_sum(float v) {
#pragma unroll
    for (int o = 1; o < 64; o <<= 1) v += __shfl_xor(v, o);
    return v;
}
__device__ __forceinline__ int fresh_lane() { int l; asm volatile("v_mbcnt_lo_u32_b32 %0, -1, 0\n\tv_mbcnt_hi_u32_b32 %0, -1, %0" : "=v"(l)); return l; }
__device__ __forceinline__ float fast_exp(float x) { return __builtin_amdgcn_exp2f(x * 1.4426950408889634f); }
__device__ __forceinline__ float fast_rcp(float x) { return __builtin_amdgcn_rcpf(x); }
__device__ __forceinline__ float silu_f(float x) { return x * fast_rcp(1.0f + fast_exp(-x)); }

#ifndef MK_WT
#define MK_WT 0
#endif
__device__ __forceinline__ void st16(void* p, u32x4 v) {
#if MK_WT
    asm volatile("global_store_dwordx4 %0, %1, off sc1\n\ts_nop 1" :: "v"(p), "v"(v) : "memory");
#else
    *(u32x4*)p = v;
#endif
}
__device__ __forceinline__ void st16f(void* p, f32x4 v) { st16(p, __builtin_bit_cast(u32x4, v)); }

namespace pg8 {
constexpr int BM = 256, BK = 64, HALF = 128, HTB = HALF * BK * 2, STAGE_BYTES = 8 * HTB, NXCD = 8, WGM = 8;
__host__ __device__ __forceinline__ int lds_byte(int r, int c) { const int st = (r >> 4) * 2 + (c >> 5), rr = r & 15, cc = c & 31, ob = rr * 64 + cc * 2; return st * 1024 + (ob ^ (((ob >> 9) & 1) << 5)); }
__host__ __device__ __forceinline__ void stage_rc(int b, int& R, int& C) { const int st = b / 1024, sb = b % 1024, swz = sb ^ (((sb >> 9) & 1) << 5); R = (st >> 1) * 16 + swz / 64; C = (st & 1) * 32 + (swz % 64) / 2; }
__host__ __device__ __forceinline__ int perm32(int rho) { const int n = rho >> 4, i = rho & 15; return 8 * (i >> 2) + 4 * n + (i & 3); }

struct Unit { int pm, pn, e, pl, po, kt0; };
struct Gemm { const bf16_t* A; const bf16_t* Bt; int nt  , N, K  ; size_t bstride; const int* list; int list_stride; const LAS int* cnt; };

struct StaticOrder {
    int nM, nN, nwg, G, c, dup;
    __device__ __forceinline__ void init(int nM_, int nN_, int G_, int c_, int dup_ = 1) { nM = nM_; nN = nN_; nwg = nM * nN; G = G_; c = c_; dup = dup_; }
    __device__ __forceinline__ bool next(int i, Unit& u) const {
        const long L = (long)i * G + c; if (L >= (long)nwg * dup) return false;
        int wgid = (int)L; if (dup > 1) wgid = (int)((unsigned)wgid % (unsigned)nwg); { const int q = nwg / NXCD, r = nwg % NXCD, xcd = wgid % NXCD, off = wgid / NXCD; wgid = (xcd < r ? xcd * (q + 1) : r * (q + 1) + (xcd - r) * q) + off; }
        const int nig = WGM * nN, gid = wgid / nig, fm = gid * WGM, gsz = (nM - fm) < WGM ? (nM - fm) : WGM;
        u.pm = fm + ((wgid % nig) % gsz); u.pn = (wgid % nig) / gsz; u.e = 0; u.pl = 0; u.po = u.pm; u.kt0 = 0; return true;
    }
};
struct MoeOrder {
    StaticOrder so; const LAS int* rb0;
    __device__ __forceinline__ bool next(int i, Unit& u) const {
        if (!so.next(i, u)) return false;
        int e = 0;
#pragma unroll
        for (int j = 1; j < 8; ++j) e = (u.pm >= rb0[j]) ? j : e;
        u.e = e; u.pl = u.pm - rb0[e]; u.po = u.pm; u.kt0 = 0; return true;
    }
};

__device__ __forceinline__ void moe_tail_params(int NRB, int& RBM, int& trb, int& S) { RBM = (NRB >> 6) << 6; trb = NRB - RBM; S = trb <= 16 ? 4 : trb <= 32 ? 2 : 1; }
struct MoeTailOrder {
    int RBM, trb, S, ntsub, G, c0, dup; const LAS int* rb0;
    __device__ __forceinline__ bool next(int i, Unit& u) const { int L = i * G + c0; const int n = trb * 4 * S; if (L >= n * dup) return false; if (dup > 1) L %= n;
        const int s = L % S, r = L / S; u.pn = r & 3; const int tb = r >> 2; u.pm = RBM + tb; u.po = s * trb + tb; u.kt0 = s * ntsub; u.pl = 0;
        int e = 0;
#pragma unroll
        for (int j = 1; j < 8; ++j) e = (u.pm >= rb0[j]) ? j : e;
        u.e = e; return true; }
};
struct LatOrder {
    StaticOrder so;
    __device__ __forceinline__ bool next(int i, Unit& u) const { if (!so.next(i, u)) return false; u.pm = (u.pm >> 4) * 17 + 1 + (u.pm & 15); u.po = u.pm; return true; }
};
struct CtxSplitOrder {
    int nN, S, ntsub, G, c0, dup;
    __device__ __forceinline__ bool next(int i, Unit& u) const { int L = i * G + c0; if (L >= 8 * nN * S * dup) return false; if (dup > 1) L %= 8 * nN * S;
        const int s = L % S, r = L / S; u.pn = r % nN; const int c = r / nN; u.pm = 17 * c; u.po = s * 8 + c; u.kt0 = s * ntsub; u.e = 0; u.pl = 0; return true; }
};

struct EpiF32 {
    static constexpr bool PERM = false;
    float* C; int ldc;
    __device__ __forceinline__ void operator()(const f32x4 (&acc)[2][2][4][2], const Unit& u, int wr, int wc, int fr, int fq) const {
        const int row0 = u.po * BM + wr * 64 + fr, col0 = u.pn * BM + wc * 32 + 4 * fq;
#pragma unroll
        for (int ai = 0; ai < 2; ++ai)
#pragma unroll
            for (int m = 0; m < 4; ++m) { float* rowp = C + (size_t)(row0 + ai * HALF + m * 16) * ldc + col0;
#pragma unroll
                for (int bj = 0; bj < 2; ++bj)
#pragma unroll
                    for (int n = 0; n < 2; ++n) st16f(rowp + bj * HALF + n * 16, acc[ai][bj][m][n]); }
    }
};
struct EpiBf16 {
    static constexpr bool PERM = true;
    bf16_t* O; int ldc;
    __device__ __forceinline__ void operator()(const f32x4 (&acc)[2][2][4][2], const Unit& u, int wr, int wc, int fr, int fq) const {
        const int row0 = u.po * BM + wr * 64 + fr, col0 = u.pn * BM + wc * 32 + 8 * fq;
#pragma unroll
        for (int ai = 0; ai < 2; ++ai)
#pragma unroll
            for (int m = 0; m < 4; ++m) { bf16_t* rowp = O + (size_t)(row0 + ai * HALF + m * 16) * ldc + col0;
#pragma unroll
                for (int bj = 0; bj < 2; ++bj) { const f32x4 v0 = acc[ai][bj][m][0], v1 = acc[ai][bj][m][1];
                    u32x4 w; w.x = cvt_pk_bf16(v0[0], v0[1]); w.y = cvt_pk_bf16(v0[2], v0[3]); w.z = cvt_pk_bf16(v1[0], v1[1]); w.w = cvt_pk_bf16(v1[2], v1[3]);
                    st16(rowp + bj * HALF, w); } }
    }
};
struct EpiSwiglu {
    static constexpr bool PERM = true;
    bf16_t* O; int ldc; float sc;
    __device__ __forceinline__ void operator()(const f32x4 (&acc)[2][2][4][2], const Unit& u, int wr, int wc, int fr, int fq) const {
        const int row0 = u.po * BM + wr * 64 + fr, col0 = u.pn * HALF + wc * 32 + 8 * fq;
        const float k1 = -1.4426950408889634f * sc, c2 = 1.0f / (sc * sc);
#pragma unroll
        for (int ai = 0; ai < 2; ++ai)
#pragma unroll
            for (int m = 0; m < 4; ++m) { bf16_t* rowp = O + (size_t)(row0 + ai * HALF + m * 16) * ldc + col0;
                float r[8];
#pragma unroll
                for (int n = 0; n < 2; ++n)
#pragma unroll
                    for (int j = 0; j < 4; ++j) { const float ag = acc[ai][0][m][n][j], au = acc[ai][1][m][n][j];
                        const float e = __builtin_amdgcn_exp2f(ag * k1); r[n * 4 + j] = (ag * au) * __builtin_amdgcn_rcpf(fmaf(e, c2, c2)); }
                u32x4 w; w.x = cvt_pk_bf16(r[0], r[1]); w.y = cvt_pk_bf16(r[2], r[3]); w.z = cvt_pk_bf16(r[4], r[5]); w.w = cvt_pk_bf16(r[6], r[7]);
                st16(rowp, w); }
    }
};
constexpr int HM_TPB = 4352;
struct EpiKV {
    static constexpr bool PERM = true;
    bf16_t* Kp; int ldk; bf16_t* Vp; int ldv;
    __device__ __forceinline__ void operator()(const f32x4 (&acc)[2][2][4][2], const Unit& u, int wr, int wc, int fr, int fq) const {
        const int row0 = u.po * BM + wr * 64 + fr, within = wc * 32 + 8 * fq, bb = u.po / 17;
#pragma unroll
        for (int ai = 0; ai < 2; ++ai)
#pragma unroll
            for (int m = 0; m < 4; ++m) { const size_t row = (size_t)(row0 + ai * HALF + m * 16);
#pragma unroll
                for (int bj = 0; bj < 2; ++bj) { const int head = u.pn * 2 + bj; const f32x4 v0 = acc[ai][bj][m][0], v1 = acc[ai][bj][m][1];
                    u32x4 w; w.x = cvt_pk_bf16(v0[0], v0[1]); w.y = cvt_pk_bf16(v0[2], v0[3]); w.z = cvt_pk_bf16(v1[0], v1[1]); w.w = cvt_pk_bf16(v1[2], v1[3]);
                    const size_t hrow = (size_t)(bb * 16 + head) * HM_TPB + (row - (size_t)bb * HM_TPB);
                    bf16_t* dst = (within < 64) ? (Kp + hrow * 96 + within) : (Vp + hrow * 64 + (within - 64));
                    st16(dst, w); } }
    }
};

struct EpiRopeD {
    static constexpr bool PERM = true;
    bf16_t* Qp; bf16_t* Kp; bf16_t* Vp; const float* rt; float qs;
    __device__ __forceinline__ void operator()(const f32x4 (&acc)[2][2][4][2], const Unit& u, int wr, int wc, int fr, int fq) const {
        const int row0 = u.po * BM + wr * 64 + fr, cw = wc * 32 + 8 * fq, bb = u.po / 17;
        if (u.pn >= 8) {
#pragma unroll
            for (int ai = 0; ai < 2; ++ai)
#pragma unroll
                for (int m = 0; m < 4; ++m) { const size_t prow = (size_t)(row0 + ai * HALF + m * 16) - (size_t)bb * HM_TPB;
#pragma unroll
                    for (int bj = 0; bj < 2; ++bj) { const f32x4 v0 = acc[ai][bj][m][0], v1 = acc[ai][bj][m][1];
                        u32x4 w; w.x = cvt_pk_bf16(v0[0], v0[1]); w.y = cvt_pk_bf16(v0[2], v0[3]); w.z = cvt_pk_bf16(v1[0], v1[1]); w.w = cvt_pk_bf16(v1[2], v1[3]);
                        const int vh = (u.pn - 8) * 2 + bj;
                        st16(Vp + ((size_t)(bb * 8 + vh) * HM_TPB + prow) * 128 + cw, w); } }
            return; }
        const bool isq = u.pn < 4; const float osc = isq ? qs : 1.0f;
        const int tb = u.pm % 17; const bool isctx = (tb == 0), colpart = (wc & 1) != 0, x2 = (fq & 2) != 0;
        const int f0 = 8 * (fq & 1);
#pragma unroll
        for (int ai = 0; ai < 2; ++ai)
#pragma unroll
            for (int m = 0; m < 4; ++m) {
                const int pos = colpart ? (16 * m + fr) : ((tb - 1) * 4 + 2 * ai + wr);
                f32x4 cs[4];
#pragma unroll
                for (int q = 0; q < 4; ++q) cs[q] = isctx ? (f32x4){1.f, 0.f, 1.f, 0.f} : *(const f32x4*)(rt + ((size_t)(isctx ? 0 : pos) * 32 + f0 + 2 * q) * 2);
                const size_t grow = (size_t)(row0 + ai * HALF + m * 16), prow = grow - (size_t)bb * HM_TPB;
#pragma unroll
                for (int bj = 0; bj < 2; ++bj) { float r[8];
#pragma unroll
                    for (int e = 0; e < 8; ++e) { const float x = acc[ai][bj][m][e >> 2][e & 3] * osc; const float xp = __shfl_xor(x, 32);
                        const float c = cs[e >> 1][2 * (e & 1)], sn = cs[e >> 1][2 * (e & 1) + 1];
                        r[e] = x2 ? (x * c + xp * sn) : (x * c - xp * sn); }
                    u32x4 w; w.x = cvt_pk_bf16(r[0], r[1]); w.y = cvt_pk_bf16(r[2], r[3]); w.z = cvt_pk_bf16(r[4], r[5]); w.w = cvt_pk_bf16(r[6], r[7]);
                    const int cc = cw + bj * HALF;
                    bf16_t* dst = isq ? Qp + grow * 1024 + u.pn * BM + cc : Kp + ((size_t)(bb * 16 + (u.pn - 4) * 4 + (cc >> 6)) * HM_TPB + prow) * 64 + (cc & 63);
                    st16(dst, w); } }
    }
};

struct EpiRopeB {
    static constexpr bool PERM = true;
    bf16_t* O; const float* rt; float qs;
    __device__ __forceinline__ void operator()(const f32x4 (&acc)[2][2][4][2], const Unit& u, int wr, int wc, int fr, int fq) const {
        const int row0 = u.po * BM + wr * 64 + fr, col0 = u.pn * BM + wc * 32 + 8 * fq;
        const int tb = u.pm % 17; const bool isctx = (tb == 0), colpart = (fq & 2) != 0, x2 = (fq & 1) != 0;
#pragma unroll
        for (int ai = 0; ai < 2; ++ai)
#pragma unroll
            for (int m = 0; m < 4; ++m) {
                const int pos = colpart ? (16 * m + fr) : ((tb - 1) * 4 + 2 * ai + wr);
                f32x4 cs[4];
#pragma unroll
                for (int q = 0; q < 4; ++q) cs[q] = isctx ? (f32x4){1.f, 0.f, 1.f, 0.f} : *(const f32x4*)(rt + ((size_t)(isctx ? 0 : pos) * 32 + 2 * q) * 2);
                bf16_t* rowp = O + (size_t)(row0 + ai * HALF + m * 16) * 1536 + col0;
#pragma unroll
                for (int bj = 0; bj < 2; ++bj) { const bool rope = ((u.pn * 8 + bj * 4 + wc) % 3) == 2;
                    float r[8];
#pragma unroll
                    for (int e = 0; e < 8; ++e) { const float x = acc[ai][bj][m][e >> 2][e & 3] * qs; const float xp = __shfl_xor(x, 16);
                        const float c = cs[e >> 1][2 * (e & 1)], sn = cs[e >> 1][2 * (e & 1) + 1];
                        r[e] = rope ? (x2 ? (x * c + xp * sn) : (x * c - xp * sn)) : x; }
                    u32x4 w; w.x = cvt_pk_bf16(r[0], r[1]); w.y = cvt_pk_bf16(r[2], r[3]); w.z = cvt_pk_bf16(r[4], r[5]); w.w = cvt_pk_bf16(r[6], r[7]);
                    st16(rowp + bj * HALF, w); } }
    }
};

struct EpiNormRopeC {
    static constexpr bool PERM = true;
    bf16_t* Qp; bf16_t* Kp; bf16_t* Vp; const float* qg; const float* kg; const float* rt; LAS float* xch; float qs;
    __device__ __forceinline__ void operator()(const f32x4 (&acc)[2][2][4][2], const Unit& u, int wr, int wc, int fr, int fq) const {
        const int row0 = u.po * BM + wr * 64 + fr, bb = u.po / 17;
        if (u.pn == 5) {
#pragma unroll
            for (int ai = 0; ai < 2; ++ai)
#pragma unroll
                for (int m = 0; m < 4; ++m) { const size_t prow = (size_t)(row0 + ai * HALF + m * 16) - (size_t)bb * HM_TPB;
#pragma unroll
                    for (int bj = 0; bj < 2; ++bj) { const f32x4 v0 = acc[ai][bj][m][0], v1 = acc[ai][bj][m][1];
                        u32x4 w; w.x = cvt_pk_bf16(v0[0], v0[1]); w.y = cvt_pk_bf16(v0[2], v0[3]); w.z = cvt_pk_bf16(v1[0], v1[1]); w.w = cvt_pk_bf16(v1[2], v1[3]);
                        st16(Vp + ((size_t)(bb * 2 + bj) * HM_TPB + prow) * 128 + wc * 32 + 8 * fq, w); } }
            asm volatile("s_waitcnt lgkmcnt(0)" ::: "memory"); __builtin_amdgcn_s_barrier(); asm volatile("" ::: "memory");
            return; }
#pragma unroll
        for (int ai = 0; ai < 2; ++ai)
#pragma unroll
            for (int m = 0; m < 4; ++m)
#pragma unroll
                for (int bj = 0; bj < 2; ++bj) { const f32x4 v0 = acc[ai][bj][m][0], v1 = acc[ai][bj][m][1];
                    float sq = (v0[0] * v0[0] + v0[1] * v0[1]) + (v0[2] * v0[2] + v0[3] * v0[3]) + (v1[0] * v1[0] + v1[1] * v1[1]) + (v1[2] * v1[2] + v1[3] * v1[3]);
                    sq += __shfl_xor(sq, 16); sq += __shfl_xor(sq, 32);
                    if (fq == 0) xch[((ai * HALF + wr * 64 + m * 16 + fr) * 2 + bj) * 4 + wc] = sq; }
        asm volatile("s_waitcnt lgkmcnt(0)" ::: "memory"); __builtin_amdgcn_s_barrier(); asm volatile("" ::: "memory");
        const bool isq = u.pn < 4; const float* gv = isq ? qg : kg;
        const int d0 = 64 * (wc >> 1) + 32 * (fq >> 1) + 16 * (wc & 1) + 8 * (fq & 1);
        const f32x4 ga = *(const f32x4*)(gv + d0), gb = *(const f32x4*)(gv + d0 + 4);
        const int tb = u.pm % 17; const bool isctx = (tb == 0), colpart = (wc >> 1) != 0, x2 = (fq >> 1) != 0;
        const int f0 = d0 & 31;
#pragma unroll
        for (int ai = 0; ai < 2; ++ai)
#pragma unroll
            for (int m = 0; m < 4; ++m) {
                const int pos = colpart ? (16 * m + fr) : ((tb - 1) * 4 + 2 * ai + wr);
                f32x4 cs[4];
#pragma unroll
                for (int q = 0; q < 4; ++q) cs[q] = isctx ? (f32x4){1.f, 0.f, 1.f, 0.f} : *(const f32x4*)(rt + ((size_t)(isctx ? 0 : pos) * 32 + f0 + 2 * q) * 2);
                const int rl = ai * HALF + wr * 64 + m * 16 + fr; const size_t row = (size_t)(row0 + ai * HALF + m * 16);
#pragma unroll
                for (int bj = 0; bj < 2; ++bj) { const f32x4 ps = *(const LAS f32x4*)(xch + (rl * 2 + bj) * 4);
                    const float rstd = rsqrtf(((ps[0] + ps[1]) + (ps[2] + ps[3])) * (1.0f / 128.0f) + 1e-6f) * (isq ? qs : 1.0f);
                    const int head = 2 * u.pn + bj; float r[8];
#pragma unroll
                    for (int e = 0; e < 8; ++e) { const float y = acc[ai][bj][m][e >> 2][e & 3] * rstd * (e < 4 ? ga[e] : gb[e - 4]); const float yp = __shfl_xor(y, 32);
                        const float c = cs[e >> 1][2 * (e & 1)], sn = cs[e >> 1][2 * (e & 1) + 1];
                        r[e] = x2 ? (y * c + yp * sn) : (y * c - yp * sn); }
                    u32x4 w; w.x = cvt_pk_bf16(r[0], r[1]); w.y = cvt_pk_bf16(r[2], r[3]); w.z = cvt_pk_bf16(r[4], r[5]); w.w = cvt_pk_bf16(r[6], r[7]);
                    bf16_t* dst = isq ? Qp + row * 1024 + head * 128 + d0 : Kp + ((size_t)(bb * 2 + (head - 8)) * HM_TPB + (row - (size_t)bb * HM_TPB)) * 128 + d0;
                    st16(dst, w); } }
    }
};

template <class Epi, class Sched, bool GATHER, bool FP8 = false>
__device__ __forceinline__ void gemm_phase(LAS unsigned char* lds, const Gemm g, const Sched& S, const Epi& E, const int wid) {
    const int lane = fresh_lane(), tid = wid * 64 + lane, wr = wid >> 2, wc = wid & 3, fr = lane & 15, fq = lane >> 4;
    const int K = g.K, nt = g.nt;
    unsigned voffA[2], voffB[2];
#pragma unroll
    for (int i = 0; i < 2; ++i) { int R, C; stage_rc(tid * 16 + i * 8192, R, C); const int Rb = Epi::PERM ? ((R & ~31) + perm32(R & 31)) : R;
        voffA[i] = (unsigned)(R * K + C) * 2u; voffB[i] = (unsigned)(Rb * K + C) * 2u; }
    const size_t kstep = (size_t)(BK * 2);
    const size_t hstep = (size_t)HALF * K * 2;
    const size_t tstep = 2 * hstep;
    const unsigned ldsw = (unsigned)wid * 1024u;
    const int aoff = lds_byte(wr * 64 + fr, fq * 8), boff = lds_byte(wc * 32 + fr, fq * 8);
#define PG8_SA(b, h) (((b) * 2 + (h)) * HTB)
#define PG8_SB(b, h) ((4 + (b) * 2 + (h)) * HTB)
#define PG8_STAGE(bufoff, gbase, voff) do { _Pragma("unroll") for (int _i = 0; _i < 2; ++_i) \
        __builtin_amdgcn_global_load_lds((const unsigned*)((const char*)(gbase) + (voff)[_i]), (LAS unsigned*)(lds + (bufoff) + ldsw + _i * 8192), 16, 0, 0); } while (0)
#define PG8_STAGE_A(bufoff, Ap, G, h, kb) do { if constexpr (GATHER) { PG8_STAGE(bufoff, (const char*)g.A + (kb), (G)[h]); } else { PG8_STAGE(bufoff, (Ap) + (size_t)(h) * hstep + (kb), voffA); } } while (0)
#define PG8_LD16(off) (*(const LAS u32x4*)(lds + (off)))
#define PG8_LDA(dst, b, h) do { _Pragma("unroll") for (int m = 0; m < 4; ++m) { if constexpr (FP8) { dst##8[m] = __builtin_bit_cast(v8i32, __builtin_shufflevector(PG8_LD16(PG8_SA(b, h) + aoff + m * 2048), PG8_LD16(PG8_SA(b, h) + aoff + m * 2048 + 1024), 0, 1, 2, 3, 4, 5, 6, 7)); } \
        else { _Pragma("unroll") for (int k = 0; k < 2; ++k) dst[m][k] = *(const LAS bf16x8*)(lds + PG8_SA(b, h) + aoff + m * 2048 + k * 1024); } } } while (0)
#define PG8_LDB(dst, b, h) do { _Pragma("unroll") for (int n = 0; n < 2; ++n) { if constexpr (FP8) { dst##8[n] = __builtin_bit_cast(v8i32, __builtin_shufflevector(PG8_LD16(PG8_SB(b, h) + boff + n * 2048), PG8_LD16(PG8_SB(b, h) + boff + n * 2048 + 1024), 0, 1, 2, 3, 4, 5, 6, 7)); } \
        else { _Pragma("unroll") for (int k = 0; k < 2; ++k) dst[n][k] = *(const LAS bf16x8*)(lds + PG8_SB(b, h) + boff + n * 2048 + k * 1024); } } } while (0)
#define PG8_MMA(ai, bj, At, Bt) do { __builtin_amdgcn_s_setprio(1); _Pragma("unroll") for (int m = 0; m < 4; ++m) _Pragma("unroll") for (int n = 0; n < 2; ++n) { \
        if constexpr (FP8) { asm volatile("v_mfma_scale_f32_16x16x128_f8f6f4 %0, %1, %2, %0, %3, %3 op_sel_hi:[0,0,0]" : "+v"(acc[ai][bj][m][n]) : "v"(Bt##8[n]), "v"(At##8[m]), "v"(sc7f)); } \
        else { _Pragma("unroll") for (int k = 0; k < 2; ++k) acc[ai][bj][m][n] = __builtin_amdgcn_mfma_f32_16x16x32_bf16(Bt[n][k], At[m][k], acc[ai][bj][m][n], 0, 0, 0); } } \
        __builtin_amdgcn_s_setprio(0); } while (0)
#define PG8_WAIT_V(n) asm volatile("s_waitcnt vmcnt(" #n ")" ::: "memory")
#define PG8_WAIT_L(n) asm volatile("s_waitcnt lgkmcnt(" #n ")" ::: "memory")
#define PG8_BAR __builtin_amdgcn_s_barrier()
#define PG8_SCHED __builtin_amdgcn_sched_barrier(0)
    LAS unsigned char* tokt = lds + STAGE_BYTES;
#define PG8_TOKDMA(u, slot) do { if constexpr (GATHER) { if (wid < 4) { const unsigned _cn = (unsigned)g.cnt[(u).e]; const unsigned _s = (unsigned)((u).pl * BM + tid); \
        __builtin_amdgcn_global_load_lds((const unsigned*)(g.list + (size_t)(u).e * g.list_stride + (_s < _cn ? _s : _cn - 1u)), (LAS unsigned*)(tokt + (slot) * 1024 + wid * 256), 4, 0, 0); } } } while (0)
#define PG8_GOFFS(go, slot) do { if constexpr (GATHER) { \
        _Pragma("unroll") for (int _h = 0; _h < 2; ++_h) _Pragma("unroll") for (int _i = 0; _i < 2; ++_i) { int _R, _C; stage_rc(tid * 16 + _i * 8192, _R, _C); \
            const unsigned _t = *(const LAS unsigned*)(tokt + (slot) * 1024 + (_h * HALF + _R) * 4); (go)[_h][_i] = (_t * (unsigned)K + (unsigned)_C) * 2u; } } } while (0)
    Unit cur, nxt; int ui = 0;
    if (!S.next(0, cur)) return;
    f32x4 acc[2][2][4][2];
#pragma unroll
    for (int a = 0; a < 2; ++a)
#pragma unroll
        for (int b = 0; b < 2; ++b)
#pragma unroll
            for (int m = 0; m < 4; ++m)
#pragma unroll
                for (int n = 0; n < 2; ++n) acc[a][b][m][n] = (f32x4){0.f, 0.f, 0.f, 0.f};
    const unsigned sc7f = 0x7F7F7F7Fu;
    bf16x8 At[4][2], B0[2][2], B1[2][2]; v8i32 At8[4], B08[2], B18[2];
    unsigned gcur[2][2] = {{0u, 0u}, {0u, 0u}};
    const char* cA = (const char*)g.A + (size_t)cur.pm * tstep + (size_t)cur.kt0 * kstep; const char* cB = (const char*)g.Bt + ((size_t)cur.e * g.bstride) * 2 + (size_t)cur.pn * tstep + (size_t)cur.kt0 * kstep;
    if constexpr (GATHER) { PG8_TOKDMA(cur, 0); asm volatile("s_waitcnt vmcnt(0)" ::: "memory"); __builtin_amdgcn_s_barrier(); asm volatile("" ::: "memory"); }
    PG8_GOFFS(gcur, 0);
    PG8_STAGE(PG8_SB(0, 0), cB, voffB); PG8_STAGE(PG8_SB(0, 1), cB + hstep, voffB); PG8_STAGE_A(PG8_SA(0, 0), cA, gcur, 0, 0); PG8_STAGE_A(PG8_SA(0, 1), cA, gcur, 1, 0);
    if (wr == 1) PG8_BAR;
    PG8_WAIT_V(2); PG8_BAR;
    PG8_STAGE(PG8_SB(1, 0), cB + kstep, voffB); PG8_STAGE_A(PG8_SA(1, 0), cA, gcur, 0, kstep); PG8_STAGE(PG8_SB(1, 1), cB + hstep + kstep, voffB);
    PG8_WAIT_V(6); PG8_BAR;
    for (;;) {
        const bool has_next = S.next(ui + 1, nxt);
        if constexpr (GATHER) { if (has_next) PG8_TOKDMA(nxt, (ui + 1) & 1); }
        const char* nA = has_next ? (const char*)g.A + (size_t)nxt.pm * tstep + (size_t)nxt.kt0 * kstep : cA; const char* nB = has_next ? (const char*)g.Bt + ((size_t)nxt.e * g.bstride) * 2 + (size_t)nxt.pn * tstep + (size_t)nxt.kt0 * kstep : cB;
#pragma unroll 1
        for (int t = 0; t < nt; t += 2) {
            const bool last = (t == nt - 2);
            const size_t kb1 = (size_t)(t + 1) * kstep;
            const char* a2p = last ? nA : cA; const size_t kb2 = last ? (size_t)0 : (size_t)(t + 2) * kstep;
            const char* b2 = last ? nB : cB + (size_t)(t + 2) * kstep;
            const size_t kb3 = kb2 + kstep; const char* b3 = b2 + kstep;
            PG8_LDB(B0, 0, 0); PG8_LDB(B1, 0, 1); PG8_SCHED; PG8_LDA(At, 0, 0); PG8_STAGE_A(PG8_SA(1, 1), cA, gcur, 1, kb1);
            if constexpr (GATHER) { if (last && has_next) { PG8_GOFFS(gcur, (ui + 1) & 1); } }
            PG8_WAIT_V(8); PG8_WAIT_L(0); PG8_BAR; PG8_MMA(0, 0, At, B0); PG8_MMA(0, 1, At, B1); PG8_BAR; PG8_SCHED;
            PG8_LDA(At, 0, 1); PG8_STAGE(PG8_SB(0, 0), b2, voffB); PG8_STAGE(PG8_SB(0, 1), b2 + hstep, voffB); PG8_STAGE_A(PG8_SA(0, 0), a2p, gcur, 0, kb2);
            PG8_WAIT_V(8); PG8_WAIT_L(0); PG8_BAR; PG8_MMA(1, 0, At, B0); PG8_MMA(1, 1, At, B1); PG8_BAR; PG8_SCHED;
            PG8_LDB(B0, 1, 0); PG8_LDB(B1, 1, 1); PG8_SCHED; PG8_LDA(At, 1, 0); PG8_STAGE_A(PG8_SA(0, 1), a2p, gcur, 1, kb2);
            PG8_WAIT_V(8); PG8_WAIT_L(0); PG8_BAR; PG8_MMA(0, 0, At, B0); PG8_MMA(0, 1, At, B1); PG8_BAR; PG8_SCHED;
            PG8_LDA(At, 1, 1); PG8_STAGE(PG8_SB(1, 0), b3, voffB); PG8_STAGE(PG8_SB(1, 1), b3 + hstep, voffB); PG8_STAGE_A(PG8_SA(1, 0), a2p, gcur, 0, kb3);
            PG8_WAIT_V(8); PG8_WAIT_L(0); PG8_BAR; PG8_MMA(1, 0, At, B0); PG8_MMA(1, 1, At, B1); PG8_BAR; PG8_SCHED;
        }
        if (wr == 0) PG8_BAR;
        if constexpr (FP8) asm volatile("s_nop 15\n\ts_nop 15\n\ts_nop 15\n\ts_nop 15" ::: "memory");
        E(acc, cur, wr, wc, fr, fq);
        if (!has_next) break;
#pragma unroll
        for (int a = 0; a < 2; ++a)
#pragma unroll
            for (int b = 0; b < 2; ++b)
#pragma unroll
                for (int m = 0; m < 4; ++m)
#pragma unroll
                    for (int n = 0; n < 2; ++n) acc[a][b][m][n] = (f32x4){0.f, 0.f, 0.f, 0.f};
        cur = nxt; cA = nA; cB = nB; ++ui;
        if (wr == 1) PG8_BAR;
    }
    PG8_WAIT_V(0);
    PG8_BAR;
#undef PG8_SA
#undef PG8_SB
#undef PG8_STAGE
#undef PG8_STAGE_A
#undef PG8_LDA
#undef PG8_LDB
#undef PG8_MMA
#undef PG8_LD16
#undef PG8_WAIT_V
#undef PG8_WAIT_L
#undef PG8_BAR
#undef PG8_SCHED
#undef PG8_GOFFS
#undef PG8_TOKDMA
}
}
namespace att {
constexpr int NW = 8, QBLK = 32, KVBLK = 64;
constexpr float THR = 8.f;
#define ATT_SBAR() __builtin_amdgcn_sched_barrier(0)
template <int DK> __device__ __forceinline__ int kswz(int row, int colB) { return row * (DK * 2 + 16) + colB; }
__device__ __forceinline__ int crow(int r, int hi) { return (r & 3) + 8 * (r >> 2) + 4 * hi; }
__device__ __forceinline__ void partialSM(f32x16& p0, f32x16& p1, float& m_reg, float& mn, float& alpha, const float C, const float thr_raw) {
    float pmax = p0[0];
#pragma unroll
    for (int r = 1; r < 16; ++r) pmax = fmaxf(pmax, p0[r]);
#pragma unroll
    for (int r = 0; r < 16; ++r) pmax = fmaxf(pmax, p1[r]);
    { auto rr = __builtin_amdgcn_permlane32_swap(__float_as_uint(pmax), __float_as_uint(pmax), false, false);
      pmax = fmaxf(__uint_as_float(rr[0]), __uint_as_float(rr[1])); }
    if (__builtin_expect(__all(pmax - m_reg <= thr_raw), 1)) { mn = m_reg; alpha = 1.f; }
    else { mn = fmaxf(m_reg, pmax); alpha = __builtin_amdgcn_exp2f((m_reg - mn) * C); m_reg = mn; }
    const float mnC = -mn * C;
#pragma unroll
    for (int r = 0; r < 16; ++r) p0[r] = fmaf(p0[r], C, mnC);
#pragma unroll
    for (int r = 0; r < 16; ++r) p1[r] = fmaf(p1[r], C, mnC);
#pragma unroll
    for (int r = 0; r < 16; ++r) p0[r] = __builtin_amdgcn_exp2f(p0[r]);
}
__device__ __forceinline__ void finishSM(f32x16& p0, f32x16& p1, float alpha, float& l_reg, bf16x8& pa0, bf16x8& pa1, bf16x8& pa2, bf16x8& pa3) {
#pragma unroll
    for (int r = 0; r < 16; ++r) p1[r] = __builtin_amdgcn_exp2f(p1[r]);
#if MK_PROBE_ATT == 2
    { float dz = 0.f;
#pragma unroll
      for (int r = 0; r < 16; ++r) { dz += __builtin_amdgcn_exp2f(p0[r] - 1.0f); dz += __builtin_amdgcn_exp2f(p1[r] - 2.0f); }
      asm volatile("" :: "v"(dz)); }
#endif
    float ps = 0;
#pragma unroll
    for (int r = 0; r < 16; ++r) ps += p0[r];
#pragma unroll
    for (int r = 0; r < 16; ++r) ps += p1[r];
    { auto rr = __builtin_amdgcn_permlane32_swap(__float_as_uint(ps), __float_as_uint(ps), false, false);
      ps = __uint_as_float(rr[0]) + __uint_as_float(rr[1]); }
    l_reg = l_reg * alpha + ps;
#define ATT_PK4(P, BASE, OUT) do { unsigned a0 = cvt_pk_bf16(P[BASE + 0], P[BASE + 1]), a1 = cvt_pk_bf16(P[BASE + 2], P[BASE + 3]);   \
    unsigned b0 = cvt_pk_bf16(P[BASE + 4], P[BASE + 5]), b1 = cvt_pk_bf16(P[BASE + 6], P[BASE + 7]);                              \
    auto r0 = __builtin_amdgcn_permlane32_swap(a0, b0, false, false); auto r1 = __builtin_amdgcn_permlane32_swap(a1, b1, false, false); \
    u32x4 w = {r0[0], r1[0], r0[1], r1[1]}; OUT = *reinterpret_cast<bf16x8*>(&w); } while (0)
    ATT_PK4(p0, 0, pa0); ATT_PK4(p0, 8, pa1); ATT_PK4(p1, 0, pa2); ATT_PK4(p1, 8, pa3);
#undef ATT_PK4
}
#ifndef MK_PROBE_ATT
#define MK_PROBE_ATT 0
#endif
template <int DK> __device__ __forceinline__ void qkt(f32x16& p0, f32x16& p1, const char* Ks, const bf16x8* qr, int r32, int hi) {
    p0 = f32x16{}; p1 = f32x16{};
#if MK_PROBE_ATT == 1
    f32x16 d0_ = f32x16{}; d0_[0] = 1.0f;
#endif
#pragma unroll
    for (int d0 = 0; d0 < DK / 16; ++d0) { const int cb = (d0 * 16 + hi * 8) * 2;
        const bf16x8 b0 = *reinterpret_cast<const bf16x8*>(Ks + kswz<DK>(r32, cb));
        const bf16x8 b1 = *reinterpret_cast<const bf16x8*>(Ks + kswz<DK>(32 + r32, cb));
        p0 = __builtin_amdgcn_mfma_f32_32x32x16_bf16(b0, qr[d0], p0, 0, 0, 0);
        p1 = __builtin_amdgcn_mfma_f32_32x32x16_bf16(b1, qr[d0], p1, 0, 0, 0);
#if MK_PROBE_ATT == 1
        d0_ = __builtin_amdgcn_mfma_f32_32x32x16_bf16(b0, qr[d0], d0_, 0, 0, 0);
        d0_ = __builtin_amdgcn_mfma_f32_32x32x16_bf16(b1, qr[d0], d0_, 0, 0, 0);
#endif
    }
#if MK_PROBE_ATT == 1
    asm volatile("" :: "v"(d0_));
#endif
}
template <int DV> __device__ __forceinline__ int v_st(int k, int c) { const int kk = (k & ~0xC) | ((k & 4) << 1) | ((k & 8) >> 1); return ((kk >> 3) * (DV / 32) + (c >> 5)) * 512 + ((kk & 7) * 32 + (c & 31)) * 2; }
__device__ __forceinline__ int v_rd_base(int lane) { return ((lane & 3) << 3) | (((lane >> 2) & 3) << 6) | (((lane >> 4) & 1) << 5) | (((lane >> 5) & 1) << 8); }
template <int DV> constexpr int v_rd_off(int d0, int ks, int half) { return d0 * 512 + ks * (DV / 32) * 1024 + half * (DV / 32) * 512; }
template <int OFF> __device__ __forceinline__ s16x4 tr_read(int vb) {
    s16x4 r; asm volatile("ds_read_b64_tr_b16 %0, %1 offset:%2" : "=&v"(r) : "v"(vb), "i"(OFF) : "memory"); return r;
}
template <int DV, int D0> __device__ __forceinline__ void pv_one(f32x16& od, int vb, bf16x8 pa0, bf16x8 pa1, bf16x8 pa2, bf16x8 pa3) {
    const s16x4 l0 = tr_read<v_rd_off<DV>(D0, 0, 0)>(vb), h0 = tr_read<v_rd_off<DV>(D0, 0, 1)>(vb), l1 = tr_read<v_rd_off<DV>(D0, 1, 0)>(vb), h1 = tr_read<v_rd_off<DV>(D0, 1, 1)>(vb);
    const s16x4 l2 = tr_read<v_rd_off<DV>(D0, 2, 0)>(vb), h2 = tr_read<v_rd_off<DV>(D0, 2, 1)>(vb), l3 = tr_read<v_rd_off<DV>(D0, 3, 0)>(vb), h3 = tr_read<v_rd_off<DV>(D0, 3, 1)>(vb);
    asm volatile("s_waitcnt lgkmcnt(0)" ::: "memory"); ATT_SBAR();
#define ATT_PK(L, H) (bf16x8){L[0], L[1], L[2], L[3], H[0], H[1], H[2], H[3]}
    od = __builtin_amdgcn_mfma_f32_32x32x16_bf16(pa0, ATT_PK(l0, h0), od, 0, 0, 0);
    od = __builtin_amdgcn_mfma_f32_32x32x16_bf16(pa1, ATT_PK(l1, h1), od, 0, 0, 0);
    od = __builtin_amdgcn_mfma_f32_32x32x16_bf16(pa2, ATT_PK(l2, h2), od, 0, 0, 0);
    od = __builtin_amdgcn_mfma_f32_32x32x16_bf16(pa3, ATT_PK(l3, h3), od, 0, 0, 0);
#undef ATT_PK
}
template <int DV, int D0> __device__ __forceinline__ void pv_two(f32x16& oa, f32x16& ob, int vb, bf16x8 pa0, bf16x8 pa1, bf16x8 pa2, bf16x8 pa3) {
    const s16x4 l0 = tr_read<v_rd_off<DV>(D0, 0, 0)>(vb), h0 = tr_read<v_rd_off<DV>(D0, 0, 1)>(vb), l1 = tr_read<v_rd_off<DV>(D0, 1, 0)>(vb), h1 = tr_read<v_rd_off<DV>(D0, 1, 1)>(vb);
    const s16x4 l2 = tr_read<v_rd_off<DV>(D0, 2, 0)>(vb), h2 = tr_read<v_rd_off<DV>(D0, 2, 1)>(vb), l3 = tr_read<v_rd_off<DV>(D0, 3, 0)>(vb), h3 = tr_read<v_rd_off<DV>(D0, 3, 1)>(vb);
    const s16x4 m0 = tr_read<v_rd_off<DV>(D0 + 1, 0, 0)>(vb), n0 = tr_read<v_rd_off<DV>(D0 + 1, 0, 1)>(vb), m1 = tr_read<v_rd_off<DV>(D0 + 1, 1, 0)>(vb), n1 = tr_read<v_rd_off<DV>(D0 + 1, 1, 1)>(vb);
    const s16x4 m2 = tr_read<v_rd_off<DV>(D0 + 1, 2, 0)>(vb), n2 = tr_read<v_rd_off<DV>(D0 + 1, 2, 1)>(vb), m3 = tr_read<v_rd_off<DV>(D0 + 1, 3, 0)>(vb), n3 = tr_read<v_rd_off<DV>(D0 + 1, 3, 1)>(vb);
    asm volatile("s_waitcnt lgkmcnt(0)" ::: "memory"); ATT_SBAR();
#define ATT_PK(L, H) (bf16x8){L[0], L[1], L[2], L[3], H[0], H[1], H[2], H[3]}
    oa = __builtin_amdgcn_mfma_f32_32x32x16_bf16(pa0, ATT_PK(l0, h0), oa, 0, 0, 0);
    ob = __builtin_amdgcn_mfma_f32_32x32x16_bf16(pa0, ATT_PK(m0, n0), ob, 0, 0, 0);
    oa = __builtin_amdgcn_mfma_f32_32x32x16_bf16(pa1, ATT_PK(l1, h1), oa, 0, 0, 0);
    ob = __builtin_amdgcn_mfma_f32_32x32x16_bf16(pa1, ATT_PK(m1, n1), ob, 0, 0, 0);
    oa = __builtin_amdgcn_mfma_f32_32x32x16_bf16(pa2, ATT_PK(l2, h2), oa, 0, 0, 0);
    ob = __builtin_amdgcn_mfma_f32_32x32x16_bf16(pa2, ATT_PK(m2, n2), ob, 0, 0, 0);
    oa = __builtin_amdgcn_mfma_f32_32x32x16_bf16(pa3, ATT_PK(l3, h3), oa, 0, 0, 0);
    ob = __builtin_amdgcn_mfma_f32_32x32x16_bf16(pa3, ATT_PK(m3, n3), ob, 0, 0, 0);
#undef ATT_PK
}
struct VFrag64 { s16x4 l[2][4], h[2][4]; };
template <int DV> __device__ __forceinline__ void pv_issue(VFrag64& f, int vb) {
    f.l[0][0] = tr_read<v_rd_off<DV>(0, 0, 0)>(vb); f.h[0][0] = tr_read<v_rd_off<DV>(0, 0, 1)>(vb); f.l[0][1] = tr_read<v_rd_off<DV>(0, 1, 0)>(vb); f.h[0][1] = tr_read<v_rd_off<DV>(0, 1, 1)>(vb);
    f.l[0][2] = tr_read<v_rd_off<DV>(0, 2, 0)>(vb); f.h[0][2] = tr_read<v_rd_off<DV>(0, 2, 1)>(vb); f.l[0][3] = tr_read<v_rd_off<DV>(0, 3, 0)>(vb); f.h[0][3] = tr_read<v_rd_off<DV>(0, 3, 1)>(vb);
    f.l[1][0] = tr_read<v_rd_off<DV>(1, 0, 0)>(vb); f.h[1][0] = tr_read<v_rd_off<DV>(1, 0, 1)>(vb); f.l[1][1] = tr_read<v_rd_off<DV>(1, 1, 0)>(vb); f.h[1][1] = tr_read<v_rd_off<DV>(1, 1, 1)>(vb);
    f.l[1][2] = tr_read<v_rd_off<DV>(1, 2, 0)>(vb); f.h[1][2] = tr_read<v_rd_off<DV>(1, 2, 1)>(vb); f.l[1][3] = tr_read<v_rd_off<DV>(1, 3, 0)>(vb); f.h[1][3] = tr_read<v_rd_off<DV>(1, 3, 1)>(vb);
}
__device__ __forceinline__ void pv_mma64(f32x16* o, const VFrag64& f, bf16x8 pa0, bf16x8 pa1, bf16x8 pa2, bf16x8 pa3) {
    asm volatile("s_waitcnt lgkmcnt(0)" ::: "memory"); ATT_SBAR();
#define ATT_PK(L, H) (bf16x8){L[0], L[1], L[2], L[3], H[0], H[1], H[2], H[3]}
    o[0] = __builtin_amdgcn_mfma_f32_32x32x16_bf16(pa0, ATT_PK(f.l[0][0], f.h[0][0]), o[0], 0, 0, 0);
    o[1] = __builtin_amdgcn_mfma_f32_32x32x16_bf16(pa0, ATT_PK(f.l[1][0], f.h[1][0]), o[1], 0, 0, 0);
    o[0] = __builtin_amdgcn_mfma_f32_32x32x16_bf16(pa1, ATT_PK(f.l[0][1], f.h[0][1]), o[0], 0, 0, 0);
    o[1] = __builtin_amdgcn_mfma_f32_32x32x16_bf16(pa1, ATT_PK(f.l[1][1], f.h[1][1]), o[1], 0, 0, 0);
    o[0] = __builtin_amdgcn_mfma_f32_32x32x16_bf16(pa2, ATT_PK(f.l[0][2], f.h[0][2]), o[0], 0, 0, 0);
    o[1] = __builtin_amdgcn_mfma_f32_32x32x16_bf16(pa2, ATT_PK(f.l[1][2], f.h[1][2]), o[1], 0, 0, 0);
    o[0] = __builtin_amdgcn_mfma_f32_32x32x16_bf16(pa3, ATT_PK(f.l[0][3], f.h[0][3]), o[0], 0, 0, 0);
    o[1] = __builtin_amdgcn_mfma_f32_32x32x16_bf16(pa3, ATT_PK(f.l[1][3], f.h[1][3]), o[1], 0, 0, 0);
#undef ATT_PK
}
#ifndef MK_PV2
#define MK_PV2 1
#endif
#ifndef MK_VPRE
#define MK_VPRE 0
#endif
#ifndef MK_MBLK
#define MK_MBLK 1
#endif
#ifndef MK_ATT_PRIO
#define MK_ATT_PRIO 1
#endif
template <int DV> __device__ __forceinline__ void pv_d0(f32x16* o, int vb, bf16x8 pa0, bf16x8 pa1, bf16x8 pa2, bf16x8 pa3) {
#if MK_PV2
    pv_two<DV, 0>(o[0], o[1], vb, pa0, pa1, pa2, pa3);
    if constexpr (DV == 128) pv_two<DV, 2>(o[2], o[3], vb, pa0, pa1, pa2, pa3);
#else
    pv_one<DV, 0>(o[0], vb, pa0, pa1, pa2, pa3); pv_one<DV, 1>(o[1], vb, pa0, pa1, pa2, pa3);
    if constexpr (DV == 128) { pv_one<DV, 2>(o[2], vb, pa0, pa1, pa2, pa3); pv_one<DV, 3>(o[3], vb, pa0, pa1, pa2, pa3); }
#endif
}
template <int DK, int DV> constexpr int lds_bytes() { return 3 * KVBLK * DV * 2 + 3 * KVBLK * (DK * 2 + 16) + NW * 64 * 4; }

template <int DK, int DV, int ldq, int ldk, int ldv, int ldo, int SD, int EPI = 0>
__device__ __forceinline__ void attn_unit(const bf16_t* __restrict__ Qb, const bf16_t* __restrict__ Kh, const bf16_t* __restrict__ Vh,
                                          bf16_t* __restrict__ Ob, int seq, const float C, const float thr_raw, char* lds, const int wid, LAS unsigned* stash = nullptr, float lam = 0.f, const float* gvec = nullptr) {
    constexpr int SHM_V = KVBLK * DV * 2, SHM_K = KVBLK * (DK * 2 + 16);
    constexpr int NO = DV / 32, ND = DK / 16;
    const int lane = fresh_lane(), tid = wid * 64 + lane, r32 = lane & 31, hi = lane >> 5;
    char* V_lds = lds; char* K_lds = lds + 3 * SHM_V;
    float* wsf = (float*)(lds + 3 * SHM_V + 3 * SHM_K) + wid * 64; float* li_l = wsf; float* al_l = wsf + 32;
    float m_reg = -1e30f, l_reg = 0; f32x16 o[NO]; bf16x8 qr[ND];
#pragma unroll
    for (int d = 0; d < NO; ++d) o[d] = f32x16{};
    const bf16_t* Qw = Qb + (long)(wid * QBLK + r32) * ldq + hi * 8;
#pragma unroll
    for (int d0 = 0; d0 < ND; ++d0) qr[d0] = *reinterpret_cast<const bf16x8*>(Qw + d0 * 16);
    const int sr = tid >> 4, sc = (tid & 15) * 8; const bool kact = (DK == 128) ? true : (sc < DK), vact = (DV == 128) ? true : (sc < DV);
    const int vst0 = v_st<DV>(sr, vact ? sc : 0), vst1 = v_st<DV>(32 + sr, vact ? sc : 0);
    const int vb0 = (int)(uintptr_t)V_lds + v_rd_base(lane);
    const unsigned koff = (unsigned)(sr * ldk + sc) * 2u, voff = (unsigned)(sr * ldv + sc) * 2u;
    const size_t k32 = (size_t)32 * ldk * 2, v32 = (size_t)32 * ldv * 2;
    struct { bf16x8 vs0, vs1, ks0, ks1; } sr_[SD];
#define ATT_SLOAD(s, k0) do { const char* _kt = (const char*)Kh + (size_t)(k0) * ldk * 2; const char* _vt = (const char*)Vh + (size_t)(k0) * ldv * 2; \
    if (vact) { sr_[s].vs0 = *reinterpret_cast<const bf16x8*>(_vt + voff); sr_[s].vs1 = *reinterpret_cast<const bf16x8*>(_vt + v32 + voff); } \
    if (kact) { sr_[s].ks0 = *reinterpret_cast<const bf16x8*>(_kt + koff); sr_[s].ks1 = *reinterpret_cast<const bf16x8*>(_kt + k32 + koff); } } while (0)
#define ATT_SWRITE(b, s) do { if (vact) { *(bf16x8*)(V_lds + (b) * SHM_V + vst0) = sr_[s].vs0; *(bf16x8*)(V_lds + (b) * SHM_V + vst1) = sr_[s].vs1; } \
    if (kact) { const int kc = sc * 2; *(bf16x8*)(K_lds + (b) * SHM_K + kswz<DK>(sr, kc)) = sr_[s].ks0; *(bf16x8*)(K_lds + (b) * SHM_K + kswz<DK>(32 + sr, kc)) = sr_[s].ks1; } } while (0)
#define ATT_RESC(a) do { if (__any((a) < 1.f)) { if (hi == 0) al_l[r32] = (a); asm volatile("s_waitcnt lgkmcnt(0)" ::: "memory"); \
    _Pragma("unroll") for (int d = 0; d < NO; ++d) _Pragma("unroll") for (int r = 0; r < 16; ++r) o[d][r] *= al_l[crow(r, hi)]; } } while (0)
    f32x16 pA0, pA1, pB0, pB1; float mnA, mnB, alA, alB; bf16x8 pa0, pa1, pa2, pa3; const int NT = seq / KVBLK;
    constexpr int SE = 0, SO = SD - 1;
    constexpr bool VPRE = (DV == 64) && (MK_VPRE != 0); VFrag64 vf;
    __syncthreads();
    ATT_SLOAD(SE, 0); asm volatile("s_waitcnt vmcnt(0)" ::: "memory"); ATT_SWRITE(0, SE); __syncthreads();
    qkt<DK>(pA0, pA1, K_lds, qr, r32, hi); partialSM(pA0, pA1, m_reg, mnA, alA, C, thr_raw);
    ATT_SLOAD(SO, KVBLK); if constexpr (SD == 2) { if (2 < NT) ATT_SLOAD(SE, 2 * KVBLK); }
    ATT_SWRITE(1, SO); __syncthreads();
    int bj = 1;
    for (int j = 1; j + 1 < NT; j += 2) {
        const int bn = (bj == 2) ? 0 : bj + 1, bp = (bj == 0) ? 2 : bj - 1;
        ATT_SBAR(); if constexpr (VPRE) pv_issue<DV>(vf, vb0 + bp * SHM_V);
        qkt<DK>(pB0, pB1, K_lds + bj * SHM_K, qr, r32, hi);
        finishSM(pA0, pA1, alA, l_reg, pa0, pa1, pa2, pa3); ATT_SBAR();
        ATT_SLOAD(SO, (j + SD) * KVBLK); ATT_SBAR();
        if constexpr (VPRE) pv_mma64(o, vf, pa0, pa1, pa2, pa3); else pv_d0<DV>(o, vb0 + bp * SHM_V, pa0, pa1, pa2, pa3);
        partialSM(pB0, pB1, m_reg, mnB, alB, C, thr_raw);
        ATT_SWRITE(bn, SE);
        ATT_RESC(alB); __syncthreads();
        ATT_SBAR(); if constexpr (VPRE) pv_issue<DV>(vf, vb0 + bj * SHM_V);
        qkt<DK>(pA0, pA1, K_lds + bn * SHM_K, qr, r32, hi);
        finishSM(pB0, pB1, alB, l_reg, pa0, pa1, pa2, pa3); ATT_SBAR();
        if (SD == 1 || j + 3 < NT) ATT_SLOAD(SE, (j + 1 + SD) * KVBLK); ATT_SBAR();
        if constexpr (VPRE) pv_mma64(o, vf, pa0, pa1, pa2, pa3); else pv_d0<DV>(o, vb0 + bj * SHM_V, pa0, pa1, pa2, pa3);
        partialSM(pA0, pA1, m_reg, mnA, alA, C, thr_raw);
        ATT_SWRITE(bp, SO);
        ATT_RESC(alA); __syncthreads();
        bj = bp;
    }
    { const int bp = (bj == 0) ? 2 : bj - 1;
      ATT_SBAR(); qkt<DK>(pB0, pB1, K_lds + bj * SHM_K, qr, r32, hi);
      finishSM(pA0, pA1, alA, l_reg, pa0, pa1, pa2, pa3); ATT_SBAR();
      pv_d0<DV>(o, vb0 + bp * SHM_V, pa0, pa1, pa2, pa3); partialSM(pB0, pB1, m_reg, mnB, alB, C, thr_raw);
      ATT_RESC(alB);
      finishSM(pB0, pB1, alB, l_reg, pa0, pa1, pa2, pa3); ATT_SBAR();
      pv_d0<DV>(o, vb0 + bj * SHM_V, pa0, pa1, pa2, pa3); }
    if (hi == 0) li_l[r32] = l_reg; asm volatile("s_waitcnt lgkmcnt(0)" ::: "memory");
    float rli[16];
#pragma unroll
    for (int r = 0; r < 16; ++r) rli[r] = __builtin_amdgcn_rcpf(li_l[crow(r, hi)]);
    if constexpr (EPI == 1) {
#pragma unroll
        for (int r = 0; r < 16; ++r)
#pragma unroll
            for (int p = 0; p < NO / 2; ++p) stash[(r * (NO / 2) + p) * 64 + lane] = pk2(o[2 * p][r] * rli[r], o[2 * p + 1][r] * rli[r]);
    } else if constexpr (EPI == 2) {
        static_assert(EPI != 2 || DV == 128, "differential combine: DV = 128");
        float gl[NO];
#pragma unroll
        for (int d0 = 0; d0 < NO; ++d0) gl[d0] = gvec[d0 * 32 + r32];
        bf16_t* Ow = Ob + (long)(wid * QBLK) * ldo;
#pragma unroll
        for (int r = 0; r < 16; ++r) { float v[NO]; float ss = 0.f;
#pragma unroll
            for (int p = 0; p < NO / 2; ++p) { const unsigned w = stash[(r * (NO / 2) + p) * 64 + lane];
                v[2 * p] = o[2 * p][r] * rli[r] - lam * bf2f(w & 0xffffu); v[2 * p + 1] = o[2 * p + 1][r] * rli[r] - lam * bf2f(w >> 16); ss += v[2 * p] * v[2 * p] + v[2 * p + 1] * v[2 * p + 1]; }
#pragma unroll
            for (int x = 1; x < 32; x <<= 1) ss += __shfl_xor(ss, x);
            const float rstd = rsqrtf(ss * (1.0f / 128.0f) + 1e-6f); const int orow = crow(r, hi);
#pragma unroll
            for (int d0 = 0; d0 < NO; ++d0) Ow[(long)orow * ldo + d0 * 32 + r32] = (bf16_t)f2bf(v[d0] * rstd * gl[d0]); }
    } else {
    bf16_t* Ow = Ob + (long)(wid * QBLK) * ldo;
#pragma unroll
    for (int r = 0; r < 16; ++r) { const int orow = crow(r, hi);
#pragma unroll
        for (int d0 = 0; d0 < NO; ++d0) Ow[(long)orow * ldo + d0 * 32 + r32] = (bf16_t)f2bf(o[d0][r] * rli[r]); }
    }
#undef ATT_SLOAD
#undef ATT_SWRITE
#undef ATT_RESC
}

constexpr float THRL = THR * 1.4426950408889634f;
__device__ __forceinline__ float max3f(float a, float b, float c) { return __builtin_fmaxf(__builtin_fmaxf(a, b), c); }
__device__ __forceinline__ void softmax_rel(f32x16& p0, f32x16& p1, float& m_run, float& alpha, const bool first) {
    float pm = max3f(p0[0], p0[1], p0[2]);
#pragma unroll
    for (int r = 3; r < 15; r += 2) pm = max3f(pm, p0[r], p0[r + 1]);
    pm = max3f(pm, p0[15], p1[0]);
#pragma unroll
    for (int r = 1; r < 15; r += 2) pm = max3f(pm, p1[r], p1[r + 1]);
    pm = __builtin_fmaxf(pm, p1[15]);
    { auto rr = __builtin_amdgcn_permlane32_swap(__float_as_uint(pm), __float_as_uint(pm), false, false); pm = __builtin_fmaxf(__uint_as_float(rr[0]), __uint_as_float(rr[1])); }
    if (!first && __builtin_expect(__all(pm <= THRL), 1)) alpha = 1.f;
    else { const float d = first ? pm : __builtin_fmaxf(pm, 0.f); alpha = first ? 1.f : __builtin_amdgcn_exp2f(-d); m_run += d;
#pragma unroll
        for (int r = 0; r < 16; ++r) { p0[r] -= d; p1[r] -= d; } }
#pragma unroll
    for (int r = 0; r < 16; ++r) { p0[r] = __builtin_amdgcn_exp2f(p0[r]); p1[r] = __builtin_amdgcn_exp2f(p1[r]); }
}
template <int DK> __device__ __forceinline__ void qkt_init(f32x16& p0, f32x16& p1, const char* Ks, const bf16x8* qr, int r32, int hi, float init) {
#pragma unroll
    for (int r = 0; r < 16; ++r) { p0[r] = init; p1[r] = init; }
#pragma unroll
    for (int d0 = 0; d0 < DK / 16; ++d0) { const int cb = (d0 * 16 + hi * 8) * 2;
        const bf16x8 b0 = *reinterpret_cast<const bf16x8*>(Ks + kswz<DK>(r32, cb));
        const bf16x8 b1 = *reinterpret_cast<const bf16x8*>(Ks + kswz<DK>(32 + r32, cb));
        p0 = __builtin_amdgcn_mfma_f32_32x32x16_bf16(b0, qr[d0], p0, 0, 0, 0);
        p1 = __builtin_amdgcn_mfma_f32_32x32x16_bf16(b1, qr[d0], p1, 0, 0, 0); }
}
__device__ __forceinline__ void finish_rel(f32x16& p0, f32x16& p1, float alpha, float& l_reg, bf16x8& pa0, bf16x8& pa1, bf16x8& pa2, bf16x8& pa3) {
    float ps = 0;
#pragma unroll
    for (int r = 0; r < 16; ++r) ps += p0[r];
#pragma unroll
    for (int r = 0; r < 16; ++r) ps += p1[r];
    { auto rr = __builtin_amdgcn_permlane32_swap(__float_as_uint(ps), __float_as_uint(ps), false, false); ps = __uint_as_float(rr[0]) + __uint_as_float(rr[1]); }
    l_reg = l_reg * alpha + ps;
#define ATT_PK4(P, BASE, OUT) do { unsigned a0 = cvt_pk_bf16(P[BASE + 0], P[BASE + 1]), a1 = cvt_pk_bf16(P[BASE + 2], P[BASE + 3]);   \
    unsigned b0 = cvt_pk_bf16(P[BASE + 4], P[BASE + 5]), b1 = cvt_pk_bf16(P[BASE + 6], P[BASE + 7]);                              \
    auto r0 = __builtin_amdgcn_permlane32_swap(a0, b0, false, false); auto r1 = __builtin_amdgcn_permlane32_swap(a1, b1, false, false); \
    u32x4 w = {r0[0], r1[0], r0[1], r1[1]}; OUT = *reinterpret_cast<bf16x8*>(&w); } while (0)
    ATT_PK4(p0, 0, pa0); ATT_PK4(p0, 8, pa1); ATT_PK4(p1, 0, pa2); ATT_PK4(p1, 8, pa3);
#undef ATT_PK4
}

template <int OFF> __device__ __forceinline__ bf16x8 k_read(int ka) { bf16x8 r; asm volatile("ds_read_b128 %0, %1 offset:%2" : "=&v"(r) : "v"(ka), "i"(OFF) : "memory"); return r; }
#define ATT_WAITL(n) asm volatile("s_waitcnt lgkmcnt(%0)" :: "n"(n) : "memory")
#define ATT_PKV(L, H) (bf16x8){L[0], L[1], L[2], L[3], H[0], H[1], H[2], H[3]}
template <int DK, int DV, int KBD, bool FINM = false, bool MINIT = false>
__device__ __forceinline__ void mblock(f32x16* o, f32x16& p0, f32x16& p1, const bool pv, const int vb, const int ka, const bf16x8* qr, bf16x8 pa0, bf16x8 pa1, bf16x8 pa2, bf16x8 pa3, const float init, const float al = 1.f, float* l_reg = nullptr, const f32x16* minit = nullptr) {
    constexpr int ND = DK / 16, NB = ND / KBD, PITCH = DK * 2 + 16, KR = 2 * KBD;
    static_assert(ND % KBD == 0 && NB >= 2 && NB <= 4 && (KBD == 2 || KBD == 3), "K batches");
    bf16x8 ka0[2][KBD], ka1[2][KBD];
    s16x4 l[4], h[4], m[4], n[4];
#define ATT_KISSUE(b) do { ka0[(b) & 1][0] = k_read<((b) * KBD + 0) * 32>(ka); ka1[(b) & 1][0] = k_read<((b) * KBD + 0) * 32 + 32 * PITCH>(ka); \
        ka0[(b) & 1][1] = k_read<((b) * KBD + 1) * 32>(ka); ka1[(b) & 1][1] = k_read<((b) * KBD + 1) * 32 + 32 * PITCH>(ka); \
        if constexpr (KBD > 2) { ka0[(b) & 1][KBD - 1] = k_read<((b) * KBD + KBD - 1) * 32>(ka); ka1[(b) & 1][KBD - 1] = k_read<((b) * KBD + KBD - 1) * 32 + 32 * PITCH>(ka); } } while (0)
#define ATT_TRISSUE(D0) do { l[0] = tr_read<v_rd_off<DV>(D0, 0, 0)>(vb); h[0] = tr_read<v_rd_off<DV>(D0, 0, 1)>(vb); l[1] = tr_read<v_rd_off<DV>(D0, 1, 0)>(vb); h[1] = tr_read<v_rd_off<DV>(D0, 1, 1)>(vb); \
        l[2] = tr_read<v_rd_off<DV>(D0, 2, 0)>(vb); h[2] = tr_read<v_rd_off<DV>(D0, 2, 1)>(vb); l[3] = tr_read<v_rd_off<DV>(D0, 3, 0)>(vb); h[3] = tr_read<v_rd_off<DV>(D0, 3, 1)>(vb); \
        m[0] = tr_read<v_rd_off<DV>(D0 + 1, 0, 0)>(vb); n[0] = tr_read<v_rd_off<DV>(D0 + 1, 0, 1)>(vb); m[1] = tr_read<v_rd_off<DV>(D0 + 1, 1, 0)>(vb); n[1] = tr_read<v_rd_off<DV>(D0 + 1, 1, 1)>(vb); \
        m[2] = tr_read<v_rd_off<DV>(D0 + 1, 2, 0)>(vb); n[2] = tr_read<v_rd_off<DV>(D0 + 1, 2, 1)>(vb); m[3] = tr_read<v_rd_off<DV>(D0 + 1, 3, 0)>(vb); n[3] = tr_read<v_rd_off<DV>(D0 + 1, 3, 1)>(vb); } while (0)
#define ATT_PVMMA(OA, OB) do { OA = __builtin_amdgcn_mfma_f32_32x32x16_bf16(pa0, ATT_PKV(l[0], h[0]), OA, 0, 0, 0); OB = __builtin_amdgcn_mfma_f32_32x32x16_bf16(pa0, ATT_PKV(m[0], n[0]), OB, 0, 0, 0); \
        OA = __builtin_amdgcn_mfma_f32_32x32x16_bf16(pa1, ATT_PKV(l[1], h[1]), OA, 0, 0, 0); OB = __builtin_amdgcn_mfma_f32_32x32x16_bf16(pa1, ATT_PKV(m[1], n[1]), OB, 0, 0, 0); \
        OA = __builtin_amdgcn_mfma_f32_32x32x16_bf16(pa2, ATT_PKV(l[2], h[2]), OA, 0, 0, 0); OB = __builtin_amdgcn_mfma_f32_32x32x16_bf16(pa2, ATT_PKV(m[2], n[2]), OB, 0, 0, 0); \
        OA = __builtin_amdgcn_mfma_f32_32x32x16_bf16(pa3, ATT_PKV(l[3], h[3]), OA, 0, 0, 0); OB = __builtin_amdgcn_mfma_f32_32x32x16_bf16(pa3, ATT_PKV(m[3], n[3]), OB, 0, 0, 0); } while (0)
#define ATT_QKMMA(b) do { _Pragma("unroll") for (int q = 0; q < KBD; ++q) { const bool f_ = MINIT && (b) == 0 && q == 0; \
        p0 = __builtin_amdgcn_mfma_f32_32x32x16_bf16(ka0[(b) & 1][q], qr[(b) * KBD + q], f_ ? *minit : p0, 0, 0, 0); \
        p1 = __builtin_amdgcn_mfma_f32_32x32x16_bf16(ka1[(b) & 1][q], qr[(b) * KBD + q], f_ ? *minit : p1, 0, 0, 0); } } while (0)
#if MK_ATT_PRIO == 1
    __builtin_amdgcn_s_setprio(1);
#endif
    constexpr bool K2 = (DV == 64);
    if (pv) {
        ATT_TRISSUE(0); ATT_KISSUE(0); if constexpr (K2) ATT_KISSUE(1);
        if constexpr (FINM) { ATT_SBAR(); finish_rel(p0, p1, al, *l_reg, pa0, pa1, pa2, pa3); ATT_SBAR(); }
        ATT_WAITL(K2 ? 2 * KR : KR); ATT_SBAR();
        ATT_PVMMA(o[0], o[1]); ATT_SBAR();
        if constexpr (DV == 128) { ATT_TRISSUE(2); ATT_WAITL(0); ATT_SBAR(); ATT_PVMMA(o[2], o[3]); ATT_SBAR(); }
    } else { ATT_KISSUE(0); if constexpr (K2) ATT_KISSUE(1); }
    if constexpr (!K2) ATT_KISSUE(1);
    if constexpr (!MINIT) {
#pragma unroll
        for (int r = 0; r < 16; ++r) { p0[r] = init; p1[r] = init; } }
    ATT_WAITL(KR); ATT_SBAR(); ATT_QKMMA(0); ATT_SBAR();
    if constexpr (NB > 2) { ATT_KISSUE(2); ATT_WAITL(KR); } else ATT_WAITL(0);
    ATT_SBAR(); ATT_QKMMA(1); ATT_SBAR();
    if constexpr (NB > 2) { if constexpr (NB > 3) { ATT_KISSUE(3); ATT_WAITL(KR); } else ATT_WAITL(0);
        ATT_SBAR(); ATT_QKMMA(2); ATT_SBAR();
        if constexpr (NB > 3) { ATT_WAITL(0); ATT_SBAR(); ATT_QKMMA(3); ATT_SBAR(); } }
#if MK_ATT_PRIO == 1
    __builtin_amdgcn_s_setprio(0);
#endif
    if (MK_PROBE_ATT == 4) { f32x16 dz = f32x16{};
#pragma unroll
        for (int q = 0; q < ND; ++q) { dz = __builtin_amdgcn_mfma_f32_32x32x16_bf16(qr[q], qr[(q + 1) % ND], dz, 0, 0, 0); dz = __builtin_amdgcn_mfma_f32_32x32x16_bf16(qr[(q + 1) % ND], qr[q], dz, 0, 0, 0); }
        asm volatile("" :: "v"(dz)); }
    if (MK_PROBE_ATT == 5) { ATT_KISSUE(0); ATT_KISSUE(1); if constexpr (NB > 2) { ATT_WAITL(0); ATT_KISSUE(2); if constexpr (NB > 3) ATT_KISSUE(3); } ATT_WAITL(0);
        asm volatile("" :: "v"(ka0[0][0]), "v"(ka1[0][0]), "v"(ka0[1][0]), "v"(ka1[1][0])); }
#undef ATT_KISSUE
#undef ATT_TRISSUE
#undef ATT_PVMMA
#undef ATT_QKMMA
}

template <int DK, int DV, int ldq, int ldk, int ldv, int ldo, bool PRE, bool DEEP, bool PART = false>
__device__ __forceinline__ void attn_unit_stag(const bf16_t* __restrict__ Qb, const bf16_t* __restrict__ Kh, const bf16_t* __restrict__ Vh,
                                               bf16_t* __restrict__ Ob, int seq, const float C, const float thr_raw, char* lds, const int wid, float* po = nullptr, float* pml = nullptr) {
    constexpr int SHM_V = KVBLK * DV * 2, SHM_K = KVBLK * (DK * 2 + 16), R = 4;
    constexpr int NO = DV / 32, ND = DK / 16;
    const int lane = fresh_lane(), tid = wid * 64 + lane, r32 = lane & 31, hi = lane >> 5, half = wid >> 2;
    char* V_lds = lds; char* K_lds = lds + R * SHM_V;
    float* wsf = (float*)(lds + R * SHM_V + R * SHM_K) + wid * 64; float* li_l = wsf; float* al_l = wsf + 32;
    float m_reg = 0.f, l_reg = 0; f32x16 o[NO]; bf16x8 qr[ND];
#pragma unroll
    for (int d = 0; d < NO; ++d) o[d] = f32x16{};
    const bf16_t* Qw = Qb + (long)(wid * QBLK + r32) * ldq + hi * 8;
#pragma unroll
    for (int d0 = 0; d0 < ND; ++d0) qr[d0] = *reinterpret_cast<const bf16x8*>(Qw + d0 * 16);
    if constexpr (!PRE) {
#pragma unroll
        for (int d0 = 0; d0 < ND; ++d0) { const u32x4 w = *reinterpret_cast<const u32x4*>(&qr[d0]); u32x4 x;
            x.x = cvt_pk_bf16(bf2f(w.x & 0xffffu) * C, bf2f(w.x >> 16) * C); x.y = cvt_pk_bf16(bf2f(w.y & 0xffffu) * C, bf2f(w.y >> 16) * C);
            x.z = cvt_pk_bf16(bf2f(w.z & 0xffffu) * C, bf2f(w.z >> 16) * C); x.w = cvt_pk_bf16(bf2f(w.w & 0xffffu) * C, bf2f(w.w >> 16) * C);
            qr[d0] = *reinterpret_cast<const bf16x8*>(&x); } }
    const int sr = tid >> 4, sc = (tid & 15) * 8; const bool kact = (DK == 128) ? true : (sc < DK), vact = (DV == 128) ? true : (sc < DV);
    const int vst0 = v_st<DV>(sr, vact ? sc : 0), vst1 = v_st<DV>(32 + sr, vact ? sc : 0);
    const int vb0 = (int)(uintptr_t)V_lds + v_rd_base(lane);
    const int ka0 = (int)(uintptr_t)K_lds + kswz<DK>(r32, hi * 16);
    const unsigned koff = (unsigned)(sr * ldk + sc) * 2u, voff = (unsigned)(sr * ldv + sc) * 2u;
    const unsigned koff2 = koff + 32u * ldk * 2u, voff2 = voff + 32u * ldv * 2u;
    bf16x8 vsA0, vsA1, ksA0, ksA1, vsB0, vsB1, ksB0, ksB1;
#define STG_SLOAD(S, k0) do { const char* _kt = (const char*)Kh + (size_t)(k0) * ldk * 2; const char* _vt = (const char*)Vh + (size_t)(k0) * ldv * 2;        \
    if (vact) { vs##S##0 = *reinterpret_cast<const bf16x8*>(_vt + (size_t)voff); vs##S##1 = *reinterpret_cast<const bf16x8*>(_vt + (size_t)voff2); } \
    if (kact) { ks##S##0 = *reinterpret_cast<const bf16x8*>(_kt + (size_t)koff); ks##S##1 = *reinterpret_cast<const bf16x8*>(_kt + (size_t)koff2); } } while (0)
#define STG_SWRITE(S, b) do { if (vact) { *(bf16x8*)(V_lds + (b) * SHM_V + vst0) = vs##S##0; *(bf16x8*)(V_lds + (b) * SHM_V + vst1) = vs##S##1; } \
    if (kact) { const int kc = sc * 2; *(bf16x8*)(K_lds + (b) * SHM_K + kswz<DK>(sr, kc)) = ks##S##0; *(bf16x8*)(K_lds + (b) * SHM_K + kswz<DK>(32 + sr, kc)) = ks##S##1; } } while (0)
#define STG_BAR() do { ATT_SBAR(); asm volatile("s_waitcnt lgkmcnt(0)" ::: "memory"); __builtin_amdgcn_s_barrier(); asm volatile("" ::: "memory"); ATT_SBAR(); } while (0)
    constexpr bool MINIT = !(DK == 128 && DV == 128);
    f32x16 minit = f32x16{};
    constexpr bool FINM = false;
    f32x16 p0, p1; float al = 1.f; bf16x8 pa0, pa1, pa2, pa3; const int NT = seq / KVBLK; (void)thr_raw;
    __syncthreads();
    if constexpr (DEEP) { STG_SLOAD(A, 0); STG_SLOAD(B, KVBLK); asm volatile("s_waitcnt vmcnt(0)" ::: "memory"); STG_SWRITE(A, 0); STG_SWRITE(B, 1);
        if (2 < NT) { STG_SLOAD(A, 2 * KVBLK); STG_SLOAD(B, 3 * KVBLK); } }
    else if constexpr (!(DK == 128 && DV == 128)) {
        STG_SLOAD(A, 0); STG_SLOAD(B, KVBLK); asm volatile("s_waitcnt vmcnt(0)" ::: "memory"); STG_SWRITE(A, 0); STG_SWRITE(B, 1);
        if (2 < NT) STG_SLOAD(A, 2 * KVBLK); }
    else { STG_SLOAD(A, 0); asm volatile("s_waitcnt vmcnt(0)" ::: "memory"); STG_SWRITE(A, 0);
        STG_SLOAD(A, KVBLK); asm volatile("s_waitcnt vmcnt(0)" ::: "memory"); STG_SWRITE(A, 1);
        if (2 < NT) STG_SLOAD(A, 2 * KVBLK); }
    __syncthreads();
    if (half && MK_PROBE_ATT != 8) STG_BAR();
#define STG_TILE(t, S) do { \
        mblock<DK, DV, (DK == 96) ? 3 : 2, FINM, MINIT>(o, p0, p1, (t) > 0, vb0 + (((t) - 1) & 3) * SHM_V, ka0 + ((t) & 3) * SHM_K, qr, pa0, pa1, pa2, pa3, -m_reg, al, &l_reg, &minit); \
        STG_BAR(); \
        if (MK_ATT_PRIO == 2) __builtin_amdgcn_s_setprio(1); \
        { const float mo_ = m_reg; softmax_rel(p0, p1, m_reg, al, (t) == 0); \
          if (MINIT) { if (__builtin_expect(__any(m_reg != mo_), 0)) { _Pragma("unroll") for (int r = 0; r < 16; ++r) minit[r] = -m_reg; } } } \
        if (MK_PROBE_ATT == 3) { float dz = 0.f; _Pragma("unroll") for (int r = 0; r < 16; ++r) { dz += __builtin_amdgcn_exp2f(p0[r] - 1.0f); dz += __builtin_amdgcn_exp2f(p1[r] - 2.0f); } asm volatile("" :: "v"(dz)); } \
        if (MK_PROBE_ATT == 6) { STG_BAR(); } \
        if (MK_PROBE_ATT == 9) { float dz = al; _Pragma("unroll") for (int r = 0; r < 48; ++r) asm volatile("v_fma_f32 %0, %0, %0, %0" : "+v"(dz)); asm volatile("" :: "v"(dz)); } \
        if constexpr (!FINM) finish_rel(p0, p1, al, l_reg, pa0, pa1, pa2, pa3); \
        if (__any(al < 1.f)) { if (hi == 0) al_l[r32] = al; asm volatile("s_waitcnt lgkmcnt(0)" ::: "memory"); \
            _Pragma("unroll") for (int d = 0; d < NO; ++d) _Pragma("unroll") for (int r = 0; r < 16; ++r) o[d][r] *= al_l[crow(r, hi)]; } \
        if (MK_ATT_PRIO == 2) __builtin_amdgcn_s_setprio(0); \
        if constexpr (DEEP) { if ((t) + 2 < NT) { STG_SWRITE(S, ((t) + 2) & 3); if ((t) + 4 < NT) STG_SLOAD(S, ((t) + 4) * KVBLK); } } \
        else      { if ((t) + 2 < NT) { STG_SWRITE(A, ((t) + 2) & 3); if ((t) + 3 < NT) { STG_SLOAD(A, ((t) + 3) * KVBLK); \
            if (MK_PROBE_ATT == 7) { STG_SLOAD(B, ((t) + 3) * KVBLK + 32 * ((t) & 1)); asm volatile("" :: "v"(vsB0), "v"(vsB1), "v"(ksB0), "v"(ksB1)); } } } } \
        STG_BAR(); } while (0)
    if constexpr (DEEP) { for (int t = 0; t < NT; t += 2) { STG_TILE(t, A); STG_TILE(t + 1, B); } }
    else { for (int t = 0; t < NT; ++t) STG_TILE(t, A); }
#undef STG_TILE
    if constexpr (FINM) finish_rel(p0, p1, al, l_reg, pa0, pa1, pa2, pa3);
    pv_d0<DV>(o, (int)(uintptr_t)V_lds + v_rd_base(fresh_lane()) + ((NT - 1) & 3) * SHM_V, pa0, pa1, pa2, pa3);
    if (!half && MK_PROBE_ATT != 8) STG_BAR();
    if constexpr (PART) { const int ln = fresh_lane(), rr32 = ln & 31, hh = ln >> 5;
      if (hh == 0) { pml[(wid * QBLK + rr32) * 2] = m_reg; pml[(wid * QBLK + rr32) * 2 + 1] = l_reg; }
      float* pw = po + (size_t)(wid * QBLK) * DV;
#pragma unroll
      for (int r = 0; r < 16; ++r) { const int orow = crow(r, hh);
#pragma unroll
          for (int d0 = 0; d0 < NO; ++d0) pw[orow * DV + d0 * 32 + rr32] = o[d0][r]; } }
    else
    { const int ln = fresh_lane(), rr32 = ln & 31, hh = ln >> 5;
      float* wsf2 = (float*)(lds + R * SHM_V + R * SHM_K) + wid * 64;
      if (hh == 0) wsf2[rr32] = l_reg; asm volatile("s_waitcnt lgkmcnt(0)" ::: "memory");
      float rli[16];
#pragma unroll
      for (int r = 0; r < 16; ++r) rli[r] = __builtin_amdgcn_rcpf(wsf2[crow(r, hh)]);
      constexpr int OP = DV * 2 + 16, OSZ = 32 * OP, NV = (3 * SHM_V) / OSZ;
      static_assert((8 - NV) * OSZ <= R * SHM_K, "O staging");
      char* stg = lds + (wid < NV ? wid * OSZ : R * SHM_V + (wid - NV) * OSZ);
#pragma unroll
      for (int r = 0; r < 16; ++r) { const int orow = crow(r, hh);
#pragma unroll
          for (int d0 = 0; d0 < NO; ++d0) *(bf16_t*)(stg + orow * OP + (d0 * 32 + rr32) * 2) = (bf16_t)f2bf(o[d0][r] * rli[r]); }
      asm volatile("s_waitcnt lgkmcnt(0)" ::: "memory");
      bf16_t* Ow = Ob + (long)(wid * QBLK) * ldo;
      constexpr int SEG = DV * 2 / 16;
#pragma unroll
      for (int ps = 0; ps < DV / 16; ++ps) { const int idx = ps * 64 + ln, row = idx / SEG, seg = idx % SEG;
          const u32x4 w = *(const u32x4*)(stg + row * OP + seg * 16);
          *(u32x4*)(Ow + (long)row * ldo + seg * 8) = w; } }
#undef STG_SLOAD
#undef STG_SWRITE
#undef STG_BAR
}
}
constexpr int NWAVES = 8;
constexpr int DM = 1024, NBATCH = 8, SEQ = 4096, CTXL = 256, TPB = CTXL + SEQ  , T = NBATCH * TPB  ;
constexpr int FF = 3584, NEXP = 8, DEPTH = 4;
constexpr int A_IN = 5120, B_IN = 672, B_INP = 768, C_IN = 1536, D_IN = 3072;
constexpr float NORM_EPS = 1e-6f;
constexpr int MOE_ROWS = 2 * T + NEXP * 256;

enum { I_X = 0, I_C, I_CTX, I_CCTX, I_MODW, I_MODB, I_NORMG, I_A_WIN, I_A_LB, I_A_ONORM, I_A_WOUT, I_B_WIN, I_B_QNORM, I_B_KVNORM, I_B_WQB, I_B_WKVB, I_B_WOUT,
       I_C_WIN, I_C_QNORM, I_C_KNORM, I_C_WOUT, I_D_WIN, I_D_LAMBDA, I_D_ONORM, I_D_WOUT, I_FFN_GU, I_FFN_DOWN, I_MOE_ROUTER, I_MOE_GU, I_MOE_DOWN, N_IN };

constexpr size_t al256(size_t x) { return (x + 255) / 256 * 256; }
constexpr size_t WS_CTL = 0, CTL_BYTES = 1u << 20;
constexpr size_t WS_MOD = WS_CTL + CTL_BYTES;
constexpr size_t WS_ROPE = WS_MOD + al256((size_t)DEPTH * 9 * 6 * DM * 4);
constexpr size_t WS_LB = WS_ROPE + al256((size_t)3 * 64 * 32 * 2 * 4);
constexpr size_t WS_W0 = WS_LB + al256((size_t)2 * 1024 * 4);
constexpr size_t WS_WA_IN = WS_W0;                                  constexpr size_t SZ_WA_IN = (size_t)A_IN * DM * 2;
constexpr size_t WS_WA_OUT = WS_WA_IN + SZ_WA_IN;                   constexpr size_t SZ_WOUT = (size_t)DM * DM * 2;
constexpr size_t WS_WB_IN = WS_WA_OUT + SZ_WOUT;                    constexpr size_t SZ_WB_IN = (size_t)B_INP * DM * 2;
constexpr size_t WS_WB_QB = WS_WB_IN + SZ_WB_IN;                    constexpr size_t SZ_WB_QB = (size_t)1536 * 384 * 2;
constexpr size_t WS_WB_KVB = WS_WB_QB + SZ_WB_QB;                   constexpr size_t SZ_WB_KVB = (size_t)2048 * 256 * 2;
constexpr size_t WS_WB_OUT = WS_WB_KVB + SZ_WB_KVB;
constexpr size_t WS_WC_IN = WS_WB_OUT + SZ_WOUT;                    constexpr size_t SZ_WC_IN = (size_t)C_IN * DM * 2;
constexpr size_t WS_WC_OUT = WS_WC_IN + SZ_WC_IN;
constexpr size_t WS_WD_IN = WS_WC_OUT + SZ_WOUT;                    constexpr size_t SZ_WD_IN = (size_t)D_IN * DM * 2;
constexpr size_t WS_WD_OUT = WS_WD_IN + SZ_WD_IN;
constexpr size_t WS_FFN_GU = WS_WD_OUT + SZ_WOUT;                   constexpr size_t SZ_GU = (size_t)2 * FF * DM;
constexpr size_t WS_FFN_DN = WS_FFN_GU + 2 * SZ_GU;                 constexpr size_t SZ_DN = (size_t)DM * FF * 2;
constexpr size_t WS_MOE_GU = WS_FFN_DN + 2 * SZ_DN;
constexpr size_t WS_MOE_DN = WS_MOE_GU + 16 * SZ_GU;
constexpr size_t WS_WEND = WS_MOE_DN + 16 * SZ_DN;
constexpr size_t WS_H = al256(WS_WEND);                              constexpr size_t SZ_H = (size_t)T * DM * 4;
constexpr size_t WS_XA = WS_H + SZ_H;                                constexpr size_t SZ_XA = (size_t)T * DM * 2;
constexpr size_t WS_Y = WS_XA + SZ_XA;                               constexpr size_t SZ_Y = (size_t)T * DM * 4;
constexpr size_t WS_YS = WS_Y + SZ_Y;                              constexpr size_t SZ_YS = (size_t)8 * 2048 * DM * 4;
constexpr size_t WS_ROUTE = WS_YS + SZ_YS;                             constexpr size_t SZ_ROUTE = (size_t)T * 32;
constexpr size_t WS_WCNT = WS_ROUTE + SZ_ROUTE;                      constexpr size_t SZ_WCNT = (size_t)256 * 8 * 4;
constexpr size_t WS_LIST = WS_WCNT + SZ_WCNT;                      constexpr size_t SZ_LIST = (size_t)NEXP * T * 4;
constexpr size_t WS_R0 = al256(WS_LIST + SZ_LIST);
constexpr size_t WS_Z = WS_R0;                                       constexpr size_t SZ_Z = (size_t)T * A_IN * 2;
constexpr size_t WS_Q = WS_Z + SZ_Z;                                 constexpr size_t SZ_Q = (size_t)T * 2048 * 2;
constexpr size_t WS_K = WS_Q + SZ_Q;                                 constexpr size_t SZ_K = (size_t)T * 1536 * 2;
constexpr size_t WS_V = WS_K + SZ_K;                                 constexpr size_t SZ_V = (size_t)T * 1024 * 2;
constexpr size_t WS_O = WS_V + SZ_V;                                 constexpr size_t SZ_O = (size_t)T * 2048 * 2;
constexpr size_t WS_MIX_END = WS_O + SZ_O;
constexpr size_t WS_ACT = WS_R0;                                     constexpr size_t SZ_ACT = (size_t)MOE_ROWS * FF * 2;
constexpr size_t WS_YP = WS_ACT + al256(SZ_ACT);                     constexpr size_t SZ_YP = (size_t)MOE_ROWS * DM * 4;
constexpr size_t WS_FFN_END = WS_YP + SZ_YP;
constexpr size_t WS_END = (WS_MIX_END > WS_FFN_END ? WS_MIX_END : WS_FFN_END);
static_assert((size_t)T * 1536 * 4 <= SZ_Z && (size_t)T * B_INP * 4 <= SZ_Z && (size_t)T * D_IN * 2 <= SZ_Z, "Z region");
static_assert((size_t)T * (384 + 256) * 2 <= SZ_O, "MLA normalised latents fit the O region");

constexpr int CW_BAR = 4096;
constexpr int CW_MOECNT = 16384;
constexpr int RING_BYTES = 131072;
constexpr int MISC_OFF = 163840 - 1024;
constexpr int LDS_BYTES = 163840;
static_assert(RING_BYTES <= MISC_OFF, "LDS map");

#define XB_TMO      128
#define XB_XCNT(j)  (256  + 64 * (j))
#define XB_XSUB(j)  (1280 + 64 * (j))
#define XB_XGEN(j)  (2304 + 64 * (j))
#define XB_TOP      3328
#define XB_TOPGEN   3392
#define XCD_BAR_WORDS 3456
#define XB_SPIN_CAP (1u << 22)
__device__ __forceinline__ unsigned xb_ld(unsigned* p)              { return __hip_atomic_load(p, __ATOMIC_RELAXED, __HIP_MEMORY_SCOPE_AGENT); }
__device__ __forceinline__ unsigned xb_add(unsigned* p, unsigned v) { return __hip_atomic_fetch_add(p, v, __ATOMIC_RELAXED, __HIP_MEMORY_SCOPE_AGENT); }
__device__ __forceinline__ unsigned xb_xcc_id() { return (unsigned)__builtin_amdgcn_s_getreg((3 << 11) | 20) & 0xFu; }
#define XB_SPIN(cond, bar) do { unsigned _sp = 0; while (cond) { __builtin_amdgcn_s_sleep(1); \
    if ((++_sp & 255u) == 0u) { if (xb_ld(&(bar)[XB_TMO])) break; if (_sp > XB_SPIN_CAP) { atomicAdd(&(bar)[XB_TMO], 1u); break; } } } } while (0)
struct XcdBarrier { unsigned* bar; unsigned x; volatile LAS unsigned* st; };
__device__ __forceinline__ XcdBarrier xcd_barrier_post(unsigned* bar, volatile LAS unsigned* st) {
    XcdBarrier b; b.bar = bar; b.x = xb_xcc_id(); b.st = st;
    if (threadIdx.x == 0) (void)xb_add(&bar[XB_XCNT(b.x)], 1u);
    return b;
}
__device__ __forceinline__ void xcd_barrier_complete(unsigned* bar, unsigned x, unsigned& nloc, unsigned& nx) {
    const unsigned G = gridDim.x * gridDim.y * gridDim.z;
    unsigned sum, cnt, mine, sp = 0u;
    for (;;) {
        sum = 0u; cnt = 0u; mine = 0u;
#pragma unroll
        for (unsigned j = 0; j < 16; ++j) { const unsigned c = xb_ld(&bar[XB_XCNT(j)]); sum += c; cnt += (c > 0u) ? 1u : 0u; mine = (j == x) ? c : mine; }
        if (sum == G) break;
        __builtin_amdgcn_s_sleep(1);
        if ((++sp & 255u) == 0u) { if (xb_ld(&bar[XB_TMO])) break; if (sp > XB_SPIN_CAP) { atomicAdd(&bar[XB_TMO], 1u); break; } }
    }
    nloc = mine > 0u ? mine : 1u; nx = cnt > 0u ? cnt : 1u;
}
__device__ __forceinline__ void xcd_barrier(const XcdBarrier& b, const int wave) {
    asm volatile("s_waitcnt vmcnt(0)" ::: "memory");
    __syncthreads();
    if (wave == 0 && fresh_lane() == 0) {
        unsigned* bar = b.bar;
        __builtin_amdgcn_s_waitcnt(0);
        unsigned nloc = b.st[0], nx = b.st[1];
        if (nloc == 0u) { xcd_barrier_complete(bar, b.x, nloc, nx); b.st[0] = nloc; b.st[1] = nx; }
        const unsigned old = xb_add(&bar[XB_XSUB(b.x)], 1u);
        const unsigned gen = old / nloc;
        if (old + 1u == (gen + 1u) * nloc) {
            __builtin_amdgcn_fence(__ATOMIC_RELEASE, "agent");
            asm volatile("s_waitcnt vmcnt(0)" ::: "memory");
            const unsigned og = xb_add(&bar[XB_TOP], 1u);
            const unsigned tg = og / nx;
            if (og + 1u == (tg + 1u) * nx) xb_add(&bar[XB_TOPGEN], 1u);
            else XB_SPIN(xb_ld(&bar[XB_TOPGEN]) == tg, bar);
            __builtin_amdgcn_fence(__ATOMIC_ACQUIRE, "agent");
            xb_add(&bar[XB_XGEN(b.x)], 1u);
            asm volatile("s_waitcnt vmcnt(0)" ::: "memory");
        } else {
            XB_SPIN(xb_ld(&bar[XB_XGEN(b.x)]) == gen, bar);
            __builtin_amdgcn_fence(__ATOMIC_ACQUIRE, "agent");
            asm volatile("s_waitcnt vmcnt(0)" ::: "memory");
        }
    }
    __syncthreads();
}

struct Frame {
    LAS unsigned char* lds; volatile LAS unsigned* MISC; unsigned char* ws;
    int wave, vcu, G;
};
typedef __attribute__((address_space(4))) const unsigned long long* kargp_t;
__device__ __forceinline__ float* out_ptr() { kargp_t ka = (kargp_t)__builtin_amdgcn_kernarg_segment_ptr(); return (float*)(GAS float*)(ka[N_IN]); }
__device__ __forceinline__ const float* in_ptr(const Frame&, int idx) { kargp_t ka = (kargp_t)__builtin_amdgcn_kernarg_segment_ptr(); return (const float*)(const GAS float*)(ka[idx]); }

struct MatDesc { int in_idx; unsigned src_off  ; int K, Nsrc, Ndst, kind  ; unsigned long long dst  ; };
constexpr int NMAT = 10 + 2 + 2 + 16 + 16, NMAT0 = 4;
struct MatTable { MatDesc m[NMAT]; int item0[NMAT + 1]; };
constexpr MatTable make_mats() {
    MatTable t{}; int n = 0;
    auto add = [&](int in_idx, unsigned src_off, int K, int Nsrc, int Ndst, int kind, unsigned long long dst) { t.m[n] = MatDesc{in_idx, src_off, K, Nsrc, Ndst, kind, dst}; ++n; };
    add(I_A_WIN, 0, DM, A_IN, A_IN, 0, WS_WA_IN); add(I_A_WOUT, 0, DM, DM, DM, 0, WS_WA_OUT);
    add(I_FFN_GU, 0, DM, 2 * FF, 2 * FF, 2, WS_FFN_GU); add(I_FFN_DOWN, 0, FF, DM, DM, 0, WS_FFN_DN);
    add(I_B_WIN, 0, DM, B_IN, B_INP, 0, WS_WB_IN); add(I_B_WQB, 0, 384, 1536, 1536, 0, WS_WB_QB); add(I_B_WKVB, 0, 256, 2048, 2048, 0, WS_WB_KVB); add(I_B_WOUT, 0, DM, DM, DM, 0, WS_WB_OUT);
    add(I_C_WIN, 0, DM, C_IN, C_IN, 3, WS_WC_IN); add(I_C_WOUT, 0, DM, DM, DM, 0, WS_WC_OUT);
    add(I_D_WIN, 0, DM, D_IN, D_IN, 0, WS_WD_IN); add(I_D_WOUT, 0, DM, DM, DM, 0, WS_WD_OUT);
    add(I_FFN_GU, (unsigned)1 * DM * 2 * FF, DM, 2 * FF, 2 * FF, 2, WS_FFN_GU + SZ_GU); add(I_FFN_DOWN, (unsigned)1 * FF * DM, FF, DM, DM, 0, WS_FFN_DN + SZ_DN);
    for (int j = 0; j < 16; ++j) add(I_MOE_GU, (unsigned)j * DM * 2 * FF, DM, 2 * FF, 2 * FF, 2, WS_MOE_GU + (size_t)j * SZ_GU);
    for (int j = 0; j < 16; ++j) add(I_MOE_DOWN, (unsigned)j * FF * DM, FF, DM, DM, 0, WS_MOE_DN + (size_t)j * SZ_DN);
    int acc = 0; for (int i = 0; i < NMAT; ++i) { t.item0[i] = acc; acc += (t.m[i].K / 64) * (t.m[i].Ndst / 64); } t.item0[NMAT] = acc;
    return t;
}
__device__ const MatTable g_mats = make_mats();

__host__ __device__ __forceinline__ int gqa_dim(int c) { const int wc = c >> 5, fq = (c >> 3) & 3, e = c & 7; return 64 * (wc >> 1) + 32 * (fq >> 1) + 16 * (wc & 1) + 8 * (fq & 1) + e; }
constexpr int P0_SCR = 64 * 65 * 4;
__device__ __forceinline__ void p0_transpose_item(const float* W, int K, int Nsrc, int kind, bf16_t* WT, LAS float* scr, int item, int Ndst, int lane) {
    const int nblk = Ndst / 64, kb = item / nblk, nb = item % nblk, k0 = 64 * kb, n0 = 64 * nb;
    int s0;
    if (kind == 1 || kind == 2) { const int pn = n0 >> 8, bj = (n0 >> 7) & 1, cc = n0 & 127; s0 = bj * FF + 128 * pn + cc; } else s0 = n0;
    int sl = s0 + lane;
    if (kind == 3) { const int n = n0 + lane; sl = (n < 1280) ? (n & ~127) + gqa_dim(n & 127) : n; }
    const bool ok = (kind >= 1) || (n0 + lane < Nsrc);
    const float* src = W + (size_t)k0 * Nsrc + sl;
    float tv[64];
#pragma unroll
    for (int kk = 0; kk < 64; ++kk) tv[kk] = ok ? src[(size_t)kk * Nsrc] : 0.f;
#pragma unroll
    for (int kk = 0; kk < 64; ++kk) scr[kk * 65 + lane] = tv[kk];
    asm volatile("s_waitcnt lgkmcnt(0)" ::: "memory");
    if (kind == 2) {
        const int c = lane & 3; unsigned char* WT8 = (unsigned char*)WT;
#pragma unroll
        for (int j = 0; j < 4; ++j) { const int n = (lane >> 2) + 16 * j; const LAS float* sp = scr + (16 * c) * 65 + n;
            u32x4 o; o.x = pk4_fp8(32.f * sp[0 * 65], 32.f * sp[1 * 65], 32.f * sp[2 * 65], 32.f * sp[3 * 65]); o.y = pk4_fp8(32.f * sp[4 * 65], 32.f * sp[5 * 65], 32.f * sp[6 * 65], 32.f * sp[7 * 65]);
            o.z = pk4_fp8(32.f * sp[8 * 65], 32.f * sp[9 * 65], 32.f * sp[10 * 65], 32.f * sp[11 * 65]); o.w = pk4_fp8(32.f * sp[12 * 65], 32.f * sp[13 * 65], 32.f * sp[14 * 65], 32.f * sp[15 * 65]);
            *(u32x4*)(WT8 + (size_t)(n0 + n) * K + k0 + 16 * c) = o; }
    } else {
    const int c = lane & 7;
#pragma unroll
    for (int j = 0; j < 8; ++j) { const int n = (lane >> 3) + 8 * j; const LAS float* sp = scr + (8 * c) * 65 + n;
        u32x4 o; o.x = pk2(sp[0 * 65], sp[1 * 65]); o.y = pk2(sp[2 * 65], sp[3 * 65]); o.z = pk2(sp[4 * 65], sp[5 * 65]); o.w = pk2(sp[6 * 65], sp[7 * 65]);
        *(u32x4*)(WT + (size_t)(n0 + n) * K + k0 + 8 * c) = o; }
    }
    asm volatile("s_waitcnt lgkmcnt(0)" ::: "memory");
}

__device__ __forceinline__ void p0_convert(Frame& F, int it0, int it1, int worker, int nworkers, int lane) {
    LAS float* scr = (LAS float*)(F.lds + F.wave * P0_SCR);
    for (int it = it0 + worker; it < it1; it += nworkers) {
        int mi = 0;
#pragma unroll 1
        for (int j = 1; j < NMAT; ++j) mi = (it >= g_mats.item0[j]) ? j : mi;
        const MatDesc d = g_mats.m[mi];
        p0_transpose_item(in_ptr(F, d.in_idx) + d.src_off, d.K, d.Nsrc, d.kind, (bf16_t*)(F.ws + d.dst), scr, it - g_mats.item0[mi], d.Ndst, lane);
    }
}
__device__ __forceinline__ int p0_split_item() { const int i0 = g_mats.item0[NMAT0], i1 = g_mats.item0[NMAT]; return i0 + (int)((long)(i1 - i0) * 0 / 100); }
__device__ __forceinline__ void p0_prologue(Frame& F) {
    const int lane = fresh_lane(), tid = F.wave * 64 + lane; (void)tid;
    const int gw = F.vcu * NWAVES + F.wave, NGW = F.G * NWAVES;
    p0_convert(F, 0, p0_split_item(), gw, NGW, lane);
    __syncthreads();
    {
        LAS float* cond = (LAS float*)F.lds;
        LAS float* part = (LAS float*)(F.lds + 65536);
        const float* cin = in_ptr(F, I_C); const float* cctx = in_ptr(F, I_CCTX);
        for (int i = tid; i < 9 * DM; i += 512) { const int r = i / DM, k = i % DM; const float v = (r < 8) ? cin[r * DM + k] : cctx[k]; cond[i] = silu_f(v); }
        __syncthreads();
        const float* mw = in_ptr(F, I_MODW); const float* mb = in_ptr(F, I_MODB);
        float* modt = (float*)(F.ws + WS_MOD);
        constexpr int NITEM = DEPTH * (6 * DM / 64);
        for (int it = F.vcu; it < NITEM; it += F.G) {
            const int l = it / 96, cb = it % 96, col = cb * 64 + lane;
            float a[9];
#pragma unroll
            for (int r = 0; r < 9; ++r) a[r] = 0.f;
            const float* wp = mw + ((size_t)l * DM + F.wave * 128) * (6 * DM) + col;
#pragma unroll 8
            for (int k = 0; k < 128; ++k) { const float w = wp[(size_t)k * (6 * DM)];
#pragma unroll
                for (int r = 0; r < 9; ++r) a[r] = fmaf(cond[r * DM + F.wave * 128 + k], w, a[r]); }
#pragma unroll
            for (int r = 0; r < 9; ++r) part[(F.wave * 9 + r) * 64 + lane] = a[r];
            __syncthreads();
            for (int i = tid; i < 9 * 64; i += 512) { const int r = i / 64, c = i % 64; float s = mb[(size_t)l * 6 * DM + cb * 64 + c];
#pragma unroll
                for (int w = 0; w < 8; ++w) s += part[(w * 9 + r) * 64 + c];
                modt[((size_t)l * 9 + r) * (6 * DM) + cb * 64 + c] = s; }
            __syncthreads();
        }
    }
    {
        float* rt = (float*)(F.ws + WS_ROPE);
        for (int i = gw * 64 + lane; i < 3 * 64 * 32; i += NGW * 64) { const int kind = i / 2048, pos = (i / 32) % 64, fi = i % 32; const int n = 16 << kind;
            if (fi < n / 2) { const float inv = exp2f(-(float)(2 * fi) / (float)n * 13.287712379549449f);
                const float ang = (float)pos * inv; float s, c;
                {
                  const float rev = ang * 0.15915494309189535f; const float fr = rev - floorf(rev); s = __builtin_amdgcn_sinf(fr); c = __builtin_amdgcn_cosf(fr); }
                rt[(size_t)i * 2] = c; rt[(size_t)i * 2 + 1] = s; } }
    }
    {
        const float* alb = in_ptr(F, I_A_LB); float* lb = (float*)(F.ws + WS_LB);
        for (int i = gw * 64 + lane; i < 2 * 1024; i += NGW * 64) { const int dir = i / 1024, w = i % 1024; float v[5], mx = -1e30f;
#pragma unroll
            for (int j = 0; j < 5; ++j) { v[j] = alb[((size_t)dir * 5 + j) * 1024 + w]; mx = fmaxf(mx, v[j]); }
            float s = 0.f;
#pragma unroll
            for (int j = 0; j < 5; ++j) s += expf(v[j] - mx);
            lb[i] = expf(v[0] - mx) / s; }
    }
}

struct RowPos { int b, p, modrow, prow, pcol; bool isctx; };
__device__ __forceinline__ RowPos row_pos(int m) { RowPos r; r.b = m / TPB; r.p = m % TPB; r.isctx = r.p < CTXL; r.modrow = r.isctx ? 8 : r.b; const int t = r.isctx ? 0 : r.p - CTXL; r.prow = t >> 6; r.pcol = t & 63; return r; }
__device__ __forceinline__ void ld_row(const float* p, int lane, f32x4 (&v)[4]) {
#pragma unroll
    for (int j = 0; j < 4; ++j) v[j] = *(const f32x4*)(p + 256 * j + 4 * lane);
}
__device__ __forceinline__ void ld_row_bf16(const bf16_t* p, int lane, f32x4 (&v)[4]) {
#pragma unroll
    for (int j = 0; j < 4; ++j) { const u32x2 w = *(const u32x2*)(p + 256 * j + 4 * lane); v[j] = (f32x4){bf2f(w.x & 0xffffu), bf2f(w.x >> 16), bf2f(w.y & 0xffffu), bf2f(w.y >> 16)}; }
}
__device__ __forceinline__ void st_row_bf16(bf16_t* p, int lane, const f32x4 (&v)[4]) {
#pragma unroll
    for (int j = 0; j < 4; ++j) { u32x2 w; w.x = pk2(v[j].x, v[j].y); w.y = pk2(v[j].z, v[j].w); *(u32x2*)(p + 256 * j + 4 * lane) = w; }
}
__device__ __forceinline__ float sumsq_row(const f32x4 (&v)[4]) { float s = 0.f;
#pragma unroll
    for (int j = 0; j < 4; ++j) s += (v[j].x * v[j].x + v[j].y * v[j].y) + (v[j].z * v[j].z + v[j].w * v[j].w);
    return wave_sum(s); }
__device__ __forceinline__ void norm_mod_store(const f32x4 (&x)[4], float rstd, const float* g, const float* shift, const float* scale, bf16_t* dst, int lane, f32x4 (&u)[4]) {
#pragma unroll
    for (int j = 0; j < 4; ++j) { const int c = 256 * j + 4 * lane; const f32x4 gg = *(const f32x4*)(g + c), sh = *(const f32x4*)(shift + c), sc = *(const f32x4*)(scale + c);
        u[j] = (x[j] * rstd * gg) * (sc + 1.0f) + sh;
        u32x2 w; w.x = pk2(u[j].x, u[j].y); w.y = pk2(u[j].z, u[j].w); *(u32x2*)(dst + c) = w; }
}

__device__ __forceinline__ void norm_mod_store_fp8(const f32x4 (&x)[4], float rstd, const float* g, const float* shift, const float* scale, unsigned char* dst, int lane, f32x4 (&u)[4]) {
#pragma unroll
    for (int j = 0; j < 4; ++j) { const int c = 256 * j + 4 * lane; const f32x4 gg = *(const f32x4*)(g + c), sh = *(const f32x4*)(shift + c), sc = *(const f32x4*)(scale + c);
        u[j] = (x[j] * rstd * gg) * (sc + 1.0f) + sh;
        *(unsigned*)(dst + c) = pk4_fp8(u[j].x, u[j].y, u[j].z, u[j].w); }
}
__device__ __forceinline__ void ld_y_row(const unsigned char* ws, int m, const RowPos& rp, int S, int lane, f32x4 (&yv)[4]) {
    if (rp.isctx) { const float* ys = (const float*)(ws + WS_YS) + (size_t)(rp.b * CTXL + rp.p) * DM;
        ld_row(ys, lane, yv);
        for (int s = 1; s < S; ++s) { f32x4 t[4]; ld_row(ys + (size_t)s * 2048 * DM, lane, t);
#pragma unroll
            for (int j = 0; j < 4; ++j) yv[j] = yv[j] + t[j]; } }
    else ld_row_bf16((const bf16_t*)(ws + WS_Y) + (size_t)m * DM, lane, yv);
}
__device__ __forceinline__ void ld_yp_row(const unsigned char* ws, size_t r, int RBM, int trb, int S, int lane, f32x4 (&v)[4]) {
    const int rb = (int)(r >> 8);
    if (rb >= RBM) { const float* ys = (const float*)(ws + WS_YS) + ((size_t)(rb - RBM) * 256 + (r & 255)) * DM;
        ld_row(ys, lane, v);
        for (int s = 1; s < S; ++s) { f32x4 t[4]; ld_row(ys + (size_t)s * trb * 256 * DM, lane, t);
#pragma unroll
            for (int j = 0; j < 4; ++j) v[j] = v[j] + t[j]; } }
    else ld_row_bf16((const bf16_t*)(ws + WS_YP) + r * DM, lane, v);
}
__device__ __forceinline__ float half_sum(float v) {
#pragma unroll
    for (int o = 1; o < 32; o <<= 1) v += __shfl_xor(v, o);
    return v;
}
__device__ __forceinline__ void ld_row2(const float* p, int l32, f32x4 (&v)[8]) {
#pragma unroll
    for (int j = 0; j < 8; ++j) v[j] = *(const f32x4*)(p + 128 * j + 4 * l32);
}
__device__ __forceinline__ void ld_row2_bf16(const bf16_t* p, int l32, f32x4 (&v)[8]) {
#pragma unroll
    for (int j = 0; j < 8; ++j) { const u32x2 w = *(const u32x2*)(p + 128 * j + 4 * l32); v[j] = (f32x4){bf2f(w.x & 0xffffu), bf2f(w.x >> 16), bf2f(w.y & 0xffffu), bf2f(w.y >> 16)}; }
}
__device__ __forceinline__ void st_row2_bf16(bf16_t* p, int l32, const f32x4 (&v)[8]) {
#pragma unroll
    for (int j = 0; j < 8; ++j) { u32x2 w; w.x = pk2(v[j].x, v[j].y); w.y = pk2(v[j].z, v[j].w); *(u32x2*)(p + 128 * j + 4 * l32) = w; }
}
__device__ __forceinline__ float sumsq_row2(const f32x4 (&v)[8]) { float s = 0.f;
#pragma unroll
    for (int j = 0; j < 8; ++j) s += (v[j].x * v[j].x + v[j].y * v[j].y) + (v[j].z * v[j].z + v[j].w * v[j].w);
    return half_sum(s); }
template <bool FP8>
__device__ __forceinline__ void norm_mod2(const f32x4 (&x)[8], float rstd, const LAS float* g, const LAS float* shift, const LAS float* scale, void* dst, int l32, bool st, f32x4 (&u)[8]) {
#pragma unroll
    for (int j = 0; j < 8; ++j) { if ((j & 3) == 0) __builtin_amdgcn_sched_barrier(0);
        const int c = 128 * j + 4 * l32; const f32x4 gg = *(const LAS f32x4*)(g + c), sh = *(const LAS f32x4*)(shift + c), sc = *(const LAS f32x4*)(scale + c);
        u[j] = (x[j] * rstd * gg) * (sc + 1.0f) + sh;
        if (st) { if (FP8) *(unsigned*)((unsigned char*)dst + c) = pk4_fp8(u[j].x, u[j].y, u[j].z, u[j].w);
                  else { u32x2 w; w.x = pk2(u[j].x, u[j].y); w.y = pk2(u[j].z, u[j].w); *(u32x2*)((bf16_t*)dst + c) = w; } } }
}
constexpr int PAR_FLOATS = 29 * DM;
__device__ __forceinline__ void fill_params(Frame& F, const float* ga, const float* gb, const float* m0, const float* m1, const float* m2, int tid) {
    LAS float* par = (LAS float*)F.lds;
    for (int i = tid; i < PAR_FLOATS / 4; i += NWAVES * 64) { const int v = i >> 8, c = (i & 255) * 4; const float* src;
        if (v == 0) src = ga; else if (v == 1) src = gb; else { const int r = (v - 2) / 3, k = (v - 2) % 3; src = (k == 0 ? m0 : k == 1 ? m1 : m2) + (size_t)r * (6 * DM); }
        *(LAS f32x4*)(par + v * DM + c) = *(const f32x4*)(src + c); }
    __syncthreads();
}
__device__ __forceinline__ void ld_y_row2(const unsigned char* ws, int m, const RowPos& rp, bool slab, int S, int l32, f32x4 (&yv)[8]) {
    if (slab) { const float* ys = (const float*)(ws + WS_YS) + (size_t)(rp.b * CTXL + rp.p) * DM;
        ld_row2(ys, l32, yv);
#pragma unroll 1
        for (int s = 1; s < S; ++s) { f32x4 t[8]; ld_row2(ys + (size_t)s * 2048 * DM, l32, t);
#pragma unroll
            for (int j = 0; j < 8; ++j) yv[j] = yv[j] + t[j]; } }
    else ld_row2_bf16((const bf16_t*)(ws + WS_Y) + (size_t)m * DM, l32, yv);
}
__device__ __forceinline__ void ld_yp_row2(const unsigned char* ws, size_t r, int RBM, int trb, int S, int l32, f32x4 (&v)[8]) {
    const int rb = (int)(r >> 8);
    if (rb >= RBM) { const float* ys = (const float*)(ws + WS_YS) + ((size_t)(rb - RBM) * 256 + (r & 255)) * DM;
        ld_row2(ys, l32, v);
#pragma unroll 1
        for (int s = 1; s < S; ++s) { f32x4 t[8]; ld_row2(ys + (size_t)s * trb * 256 * DM, l32, t);
#pragma unroll
            for (int j = 0; j < 8; ++j) v[j] = v[j] + t[j]; } }
    else ld_row2_bf16((const bf16_t*)(ws + WS_YP) + r * DM, l32, v);
}

__device__ __forceinline__ void phase_r0(Frame& F) {
    const int lane = fresh_lane(), l32 = lane & 31, half = lane >> 5;
    const int gw = F.vcu * NWAVES + F.wave, NGW = F.G * NWAVES;
    const float* x = in_ptr(F, I_X); const float* ctx = in_ptr(F, I_CTX); const float* ng = in_ptr(F, I_NORMG);
    bf16_t* h = (bf16_t*)(F.ws + WS_H); bf16_t* xa = (bf16_t*)(F.ws + WS_XA); const float* modt = (const float*)(F.ws + WS_MOD);
    fill_params(F, ng + (0 * 4 + 0) * DM, ng + (0 * 4 + 0) * DM, modt + 0 * DM, modt + 1 * DM, modt + 1 * DM, F.wave * 64 + lane);
    const LAS float* par = (const LAS float*)F.lds;
    for (int pi = gw; pi < T / 2; pi += NGW) { const int m = 2 * pi + half; const RowPos rp = row_pos(m);
        const float* src = rp.isctx ? ctx + ((size_t)rp.b * CTXL + rp.p) * DM : x + ((size_t)rp.b * SEQ + (rp.p - CTXL)) * DM;
        f32x4 v[8], u[8]; ld_row2(src, l32, v);
        st_row2_bf16(h + (size_t)m * DM, l32, v);
        const float rstd = rsqrtf(sumsq_row2(v) * (1.0f / DM) + NORM_EPS);
        const LAS float* pm = par + (2 + 3 * rp.modrow) * DM;
        norm_mod2<false>(v, rstd, par, pm + 0 * DM, pm + 1 * DM, xa + (size_t)m * DM, l32, true, u); }
    __syncthreads();
}

template <bool MOE>
__device__ __forceinline__ void phase_r1(Frame& F, int l) {
    const int lane = fresh_lane(), tid = F.wave * 64 + lane, l32 = lane & 31, half = lane >> 5;
    const float* ng = in_ptr(F, I_NORMG); const float* modt = (const float*)(F.ws + WS_MOD);
    bf16_t* h = (bf16_t*)(F.ws + WS_H); unsigned char* xa = (unsigned char*)(F.ws + WS_XA);
    const float* router = MOE ? in_ptr(F, I_MOE_ROUTER) + (size_t)(l >> 1) * DM * NEXP : nullptr;
    constexpr int LB = PAR_FLOATS * 4;
    LAS int* lcnt = (LAS int*)(F.lds + LB);
    LAS int* lbase = (LAS int*)(F.lds + LB + 64);
    LAS int* lrow = (LAS int*)(F.lds + LB + 1024);
    LAS float* lw = (LAS float*)(F.lds + LB + 4096);
    constexpr int RPW = T / 256;
    if (MOE) { if (tid < 8) lcnt[tid] = 0; }
    { const float* ml = modt + (size_t)l * 9 * (6 * DM); fill_params(F, ng + (l * 4 + 1) * DM, ng + (l * 4 + 2) * DM, ml + 2 * DM, ml + 3 * DM, ml + 4 * DM, tid); }
    const LAS float* par = (const LAS float*)F.lds;
    LAS f32x4* rtA = (LAS f32x4*)(F.lds + LB + 8192); LAS f32x4* rtB = rtA + 1024;
    if (MOE) { for (int c = tid; c < DM; c += NWAVES * 64) { const int slot = ((c & 3) * 8 + (c >> 7)) * 32 + ((c & 127) >> 2);
            rtA[slot] = *(const f32x4*)(router + (size_t)c * 8); rtB[slot] = *(const f32x4*)(router + (size_t)c * 8 + 4); }
        __syncthreads(); }
#define R1_ROW(i) ((i) * 256 + F.vcu)
    f32x4 yn[8], hn[8];
    { const int m0 = R1_ROW(2 * F.wave + half); const RowPos r0 = row_pos(m0); ld_y_row2(F.ws, m0, r0, r0.isctx && !(l == DEPTH - 1), 4, l32, yn); ld_row2_bf16(h + (size_t)m0 * DM, l32, hn); }
    for (int i2 = F.wave; i2 < RPW / 2; i2 += NWAVES) { const int i = 2 * i2 + half, m = R1_ROW(i); const RowPos rp = row_pos(m);
        const bool skip = (l == DEPTH - 1) && rp.isctx;
        const LAS float* pm = par + (2 + 3 * rp.modrow) * DM;
        f32x4 yv[8], hv[8], u[8];
#pragma unroll
        for (int j = 0; j < 8; ++j) { yv[j] = yn[j]; hv[j] = hn[j]; }
        if (i2 + NWAVES < RPW / 2) { const int mn = R1_ROW(i + 2 * NWAVES); const RowPos rn = row_pos(mn); ld_y_row2(F.ws, mn, rn, rn.isctx && !(l == DEPTH - 1), 4, l32, yn); ld_row2_bf16(h + (size_t)mn * DM, l32, hn); }
        const float rstd_y = rsqrtf(sumsq_row2(yv) * (1.0f / DM) + NORM_EPS);
#pragma unroll
        for (int j = 0; j < 8; ++j) { if ((j & 3) == 0) __builtin_amdgcn_sched_barrier(0);
            const int c = 128 * j + 4 * l32; const f32x4 g1 = *(const LAS f32x4*)(par + c), gt = *(const LAS f32x4*)(pm + c);
            hv[j] = hv[j] + gt * (yv[j] * rstd_y * g1); }
        if (!skip) st_row2_bf16(h + (size_t)m * DM, l32, hv);
        const float rstd_h = rsqrtf(sumsq_row2(hv) * (1.0f / DM) + NORM_EPS);
        norm_mod2<true>(hv, rstd_h, par + DM, pm + 1 * DM, pm + 2 * DM, xa + (size_t)m * DM, l32, !skip, u);
        if (MOE) {
            float lg[8];
#pragma unroll
            for (int e = 0; e < 8; ++e) lg[e] = 0.f;
#pragma unroll
            for (int j = 0; j < 8; ++j) { __builtin_amdgcn_sched_barrier(0);
#pragma unroll
                for (int q = 0; q < 4; ++q) { const f32x4 r0 = rtA[(q * 8 + j) * 32 + l32], r1 = rtB[(q * 8 + j) * 32 + l32]; const float uv = u[j][q];
                    lg[0] = fmaf(uv, r0.x, lg[0]); lg[1] = fmaf(uv, r0.y, lg[1]); lg[2] = fmaf(uv, r0.z, lg[2]); lg[3] = fmaf(uv, r0.w, lg[3]);
                    lg[4] = fmaf(uv, r1.x, lg[4]); lg[5] = fmaf(uv, r1.y, lg[5]); lg[6] = fmaf(uv, r1.z, lg[6]); lg[7] = fmaf(uv, r1.w, lg[7]); } }
#pragma unroll
            for (int e = 0; e < 8; ++e) lg[e] = half_sum(lg[e]);
            int e1 = 0; float v1 = lg[0];
#pragma unroll
            for (int e = 1; e < 8; ++e) if (lg[e] > v1) { v1 = lg[e]; e1 = e; }
            int e2 = (e1 == 0) ? 1 : 0; float v2 = (e1 == 0) ? lg[1] : lg[0];
#pragma unroll
            for (int e = 1; e < 8; ++e) if (e != e1 && lg[e] > v2) { v2 = lg[e]; e2 = e; }
            const float w2 = fast_rcp(1.0f + expf(v1 - v2)), w1 = 1.0f - w2;
            if (l32 == 0) { if (skip) lrow[i * 4 + 0] = -1;
                else { lrow[i * 4 + 0] = e1; lrow[i * 4 + 2] = e2; lw[i * 2] = w1; lw[i * 2 + 1] = w2; } }
        }
    }
    if (MOE) {
        __syncthreads();
        if (tid < 8) { int c = 0; for (int i = 0; i < RPW; ++i) { const int a = lrow[i * 4], b = lrow[i * 4 + 2]; if (a < 0) continue; if (a == tid) lrow[i * 4 + 1] = c++; else if (b == tid) lrow[i * 4 + 3] = c++; }
            lcnt[tid] = c; ((int*)(F.ws + WS_WCNT))[F.vcu * 8 + tid] = c;
            __hip_atomic_fetch_add((int*)((unsigned*)F.ws + CW_MOECNT + (l >> 1) * 64) + tid, c, __ATOMIC_RELAXED, __HIP_MEMORY_SCOPE_AGENT); }
        __syncthreads();
        int* route = (int*)(F.ws + WS_ROUTE);
        for (int i = tid; i < RPW; i += 512) { const int m = R1_ROW(i); const int e1 = lrow[i * 4], e2 = lrow[i * 4 + 2]; route[(size_t)m * 8 + 0] = e1; if (e1 < 0) continue;
            route[(size_t)m * 8 + 1] = lrow[i * 4 + 1]; route[(size_t)m * 8 + 2] = e2; route[(size_t)m * 8 + 3] = lrow[i * 4 + 3];
            ((float*)route)[(size_t)m * 8 + 4] = lw[i * 2]; ((float*)route)[(size_t)m * 8 + 5] = lw[i * 2 + 1]; }
        __syncthreads();
    }
}
__device__ __forceinline__ void moe_build(Frame& F) {
    const int lane = fresh_lane(), tid = F.wave * 64 + lane;
    LAS int* red = (LAS int*)F.lds;
    const int* wcnt = (const int*)(F.ws + WS_WCNT);
    { const int e = tid & 7; int sacc = 0; for (int v = tid >> 3; v < F.vcu; v += 64) sacc += wcnt[v * 8 + e]; red[tid] = sacc; }
    __syncthreads();
    if (tid < 8) { int sacc = 0; for (int k = 0; k < 64; ++k) sacc += red[k * 8 + tid]; red[512 + tid] = sacc; }
    __syncthreads();
    constexpr int RPW = T / 256;
    int* list = (int*)(F.ws + WS_LIST); int* route = (int*)(F.ws + WS_ROUTE);
    for (int i = tid; i < RPW; i += 512) { const int m = R1_ROW(i); const int e1 = route[(size_t)m * 8]; if (e1 < 0) continue; const int e2 = route[(size_t)m * 8 + 2];
        const int s1 = red[512 + e1] + route[(size_t)m * 8 + 1], s2 = red[512 + e2] + route[(size_t)m * 8 + 3];
        list[(size_t)e1 * T + s1] = m; list[(size_t)e2 * T + s2] = m; route[(size_t)m * 8 + 1] = s1; route[(size_t)m * 8 + 3] = s2; }
}

__device__ __forceinline__ void moe_tables(Frame& F, int l) {
    const int lane = fresh_lane(), tid = F.wave * 64 + lane; (void)tid;
    if (tid == 0) { const int* gcnt = (const int*)((unsigned*)F.ws + CW_MOECNT + (l >> 1) * 64); int acc = 0;
        for (int e = 0; e < 8; ++e) { const int c = __hip_atomic_load(gcnt + e, __ATOMIC_RELAXED, __HIP_MEMORY_SCOPE_AGENT); F.MISC[32 + e] = (unsigned)c; F.MISC[16 + e] = (unsigned)acc; acc += (c + 255) / 256; }
        F.MISC[24] = (unsigned)acc; }
    __syncthreads();
}

template <bool MOE>
__device__ __forceinline__ void phase_r2(Frame& F, int l) {
    const int lane = fresh_lane(), l32 = lane & 31, half = lane >> 5;
    const int gw = F.vcu * NWAVES + F.wave, NGW = F.G * NWAVES;
    const float* ng = in_ptr(F, I_NORMG); const float* modt = (const float*)(F.ws + WS_MOD);
    bf16_t* h = (bf16_t*)(F.ws + WS_H); bf16_t* xa = (bf16_t*)(F.ws + WS_XA);
    const int* route = (const int*)(F.ws + WS_ROUTE);
    int RBM = 0, trb = 0, S = 1; if (MOE) pg8::moe_tail_params((int)F.MISC[24], RBM, trb, S);
    { const int ln = (l < DEPTH - 1) ? l + 1 : l; const float* ml = modt + (size_t)l * 9 * (6 * DM); const float* mn = modt + (size_t)ln * 9 * (6 * DM);
      fill_params(F, ng + (l * 4 + 3) * DM, ng + (ln * 4 + 0) * DM, ml + 5 * DM, mn + 0 * DM, mn + 1 * DM, F.wave * 64 + lane); }
    const LAS float* par = (const LAS float*)F.lds;
    f32x4 an[8], bn[8], hn[8]; float w1n = 0.f, w2n = 0.f;
#define R2_LOAD(mm) do { const RowPos _r = row_pos(mm); const bool _sk = (l == DEPTH - 1) && _r.isctx; \
        if (MOE) { int e1 = 0, s1 = 0, e2 = 0, s2 = 0; w1n = 0.f; w2n = 0.f; \
            if (!_sk) { e1 = route[(size_t)(mm) * 8]; s1 = route[(size_t)(mm) * 8 + 1]; e2 = route[(size_t)(mm) * 8 + 2]; s2 = route[(size_t)(mm) * 8 + 3]; w1n = ((const float*)route)[(size_t)(mm) * 8 + 4]; w2n = ((const float*)route)[(size_t)(mm) * 8 + 5]; } \
            const size_t r1 = (size_t)F.MISC[16 + e1] * 256 + s1, r2 = (size_t)F.MISC[16 + e2] * 256 + s2; \
            ld_yp_row2(F.ws, r1, RBM, trb, S, l32, an); ld_yp_row2(F.ws, r2, RBM, trb, S, l32, bn); } \
        else ld_y_row2(F.ws, (mm), _r, _r.isctx, 4, l32, an); \
        ld_row2_bf16(h + (size_t)(mm) * DM, l32, hn); } while (0)
    if (gw < T / 2) R2_LOAD(2 * gw + half);
    for (int pi = gw; pi < T / 2; pi += NGW) { const int m = 2 * pi + half; const RowPos rp = row_pos(m);
        const bool skip = (l == DEPTH - 1) && rp.isctx;
        const LAS float* pm = par + (2 + 3 * rp.modrow) * DM;
        f32x4 yv[8], hv[8], u[8];
#pragma unroll
        for (int j = 0; j < 8; ++j) { yv[j] = MOE ? (an[j] * w1n + bn[j] * w2n) : an[j]; hv[j] = hn[j]; }
        if (pi + NGW < T / 2) R2_LOAD(m + 2 * NGW);
        const float rstd_y = rsqrtf(sumsq_row2(yv) * (1.0f / DM) + NORM_EPS);
#pragma unroll
        for (int j = 0; j < 8; ++j) { if ((j & 3) == 0) __builtin_amdgcn_sched_barrier(0);
            const int c = 128 * j + 4 * l32; const f32x4 g3 = *(const LAS f32x4*)(par + c), gt = *(const LAS f32x4*)(pm + c);
            hv[j] = hv[j] + gt * (yv[j] * rstd_y * g3); }
        if (l == DEPTH - 1) { if (!skip) { float* dsto = out_ptr() + ((size_t)rp.b * SEQ + (rp.p - CTXL)) * DM;
#pragma unroll
                for (int j = 0; j < 8; ++j) *(f32x4*)(dsto + 128 * j + 4 * l32) = hv[j]; } }
        else st_row2_bf16(h + (size_t)m * DM, l32, hv);
        if (l < DEPTH - 1) { const float rstd_h = rsqrtf(sumsq_row2(hv) * (1.0f / DM) + NORM_EPS);
            norm_mod2<false>(hv, rstd_h, par + DM, pm + 1 * DM, pm + 2 * DM, xa + (size_t)m * DM, l32, true, u); }
    }
}
namespace scan {
constexpr int A_STR = 272, T_STR = 80;
constexpr int A1_OFF = 0, A2_OFF = 32 * A_STR, K2T_OFF = 2 * 32 * A_STR, VT_OFF = K2T_OFF + 128 * T_STR, DEC_OFF = VT_OFF + 128 * T_STR, BUF_BYTES = DEC_OFF + 512;
constexpr int NCH = TPB / 32;
__device__ __forceinline__ int crow(int r, int hi) { return (r & 3) + 8 * (r >> 2) + 4 * hi; }
__device__ __forceinline__ int tok_of(int p, int dir) { return dir == 0 ? p : (p < CTXL ? (CTXL - 1 - p) : (TPB + CTXL - 1 - p)); }

__device__ __forceinline__ int chunk_lowtok(int n, int dir) { return dir == 0 ? 32 * n : (n < CTXL / 32 ? CTXL - 32 - 32 * n : TPB + CTXL - 32 - 32 * n); }
constexpr int RAW_OFF = 2 * BUF_BYTES, RAW_BYTES = 3 * 8192;
__device__ __forceinline__ void prep_dma(const bf16_t* __restrict__ z, int b, int hd, int dir, int n, LAS unsigned char* raw, int pw, int lane) {
    const char* U = (const char*)(z + (size_t)(b * TPB + chunk_lowtok(n, dir)) * A_IN + hd * 128);
#pragma unroll
    for (int k = 0; k < 2; ++k) { const int c = 8 * pw + 4 * k + (lane >> 4), mr = dir ? 31 - c : c; const unsigned L = (unsigned)(mr * A_IN + (lane & 15) * 8) * 2u;
        __builtin_amdgcn_global_load_lds((const unsigned*)(U + L), (LAS unsigned*)(raw + 0 * 8192 + (2 * pw + k) * 1024), 16, 0, 0);
        __builtin_amdgcn_global_load_lds((const unsigned*)(U + 2048 * (1 + dir) + L), (LAS unsigned*)(raw + 1 * 8192 + (2 * pw + k) * 1024), 16, 0, 0);
        __builtin_amdgcn_global_load_lds((const unsigned*)(U + 6144 + L), (LAS unsigned*)(raw + 2 * 8192 + (2 * pw + k) * 1024), 16, 0, 0); }
}
struct Raw { unsigned short q[16], f[16], v[16]; };
__device__ __forceinline__ void prep_read(Raw& r, const LAS unsigned char* raw, int d, int rh) {
#pragma unroll
    for (int i = 0; i < 16; ++i) { const int o = (16 * rh + i) * 256 + d * 2;
        r.q[i] = *(const LAS unsigned short*)(raw + o); r.f[i] = *(const LAS unsigned short*)(raw + 8192 + o); r.v[i] = *(const LAS unsigned short*)(raw + 16384 + o); }
}
__device__ __forceinline__ void prep_compute(const Raw& r, float lbv, LAS unsigned char* buf, int d, int rh, int lane) {
    float cum[16], kk[16]; float run = 0.f;
#pragma unroll
    for (int i = 0; i < 16; ++i) { const float s = fast_rcp(1.0f + __builtin_amdgcn_exp2f(bf2f(r.f[i]) * -1.4426950408889634f)); const float f = lbv + (1.0f - lbv) * s; kk[i] = 1.0f - f; run += __builtin_amdgcn_logf(f); cum[i] = run; }
    const float tot_lo = __shfl(run, lane & 31);
    if (rh) {
#pragma unroll
        for (int i = 0; i < 16; ++i) cum[i] += tot_lo; }
    const float cend = __shfl(cum[15], (lane & 31) + 32);
    const float dec = __builtin_amdgcn_exp2f(cend);
    unsigned short a1[16], a2[16], k2[16];
#pragma unroll
    for (int i = 0; i < 16; ++i) { const float e1 = __builtin_amdgcn_exp2f(cum[i]), e2 = __builtin_amdgcn_exp2f(-cum[i]); const float A2 = kk[i] * e2;
        const unsigned w12 = cvt_pk_bf16(bf2f(r.q[i]) * 0.08838834764831845f * e1, A2);
        a1[i] = (unsigned short)(w12 & 0xffffu); a2[i] = (unsigned short)(w12 >> 16); k2[i] = (unsigned short)(cvt_pk_bf16(A2 * dec, 0.f) & 0xffffu); }
#pragma unroll
    for (int i = 0; i < 16; ++i) { const int c = 16 * rh + i;
        *(LAS unsigned short*)(buf + A1_OFF + c * A_STR + d * 2) = a1[i]; *(LAS unsigned short*)(buf + A2_OFF + c * A_STR + d * 2) = a2[i]; }
#pragma unroll
    for (int i = 0; i < 16; i += 2) { const int c = 16 * rh + i;
        *(LAS unsigned*)(buf + K2T_OFF + d * T_STR + c * 2) = (unsigned)k2[i] | ((unsigned)k2[i + 1] << 16);
        *(LAS unsigned*)(buf + VT_OFF + d * T_STR + c * 2) = (unsigned)r.v[i] | ((unsigned)r.v[i + 1] << 16); }
    if (rh == 0) *(LAS float*)(buf + DEC_OFF + d * 4) = dec;
}
#define SCAN_BAR() do { asm volatile("s_waitcnt lgkmcnt(0)" ::: "memory"); __builtin_amdgcn_s_barrier(); asm volatile("" ::: "memory"); } while (0)

__device__ __forceinline__ bf16x8 cvt8(const f32x16& x, int base) {
    u32x4 w; w.x = cvt_pk_bf16(x[base + 0], x[base + 1]); w.y = cvt_pk_bf16(x[base + 2], x[base + 3]); w.z = cvt_pk_bf16(x[base + 4], x[base + 5]); w.w = cvt_pk_bf16(x[base + 6], x[base + 7]);
    return *reinterpret_cast<bf16x8*>(&w);
}
__device__ __forceinline__ bf16x8 ld44(const LAS unsigned char* p) {
    const u32x2 a = *(const LAS u32x2*)p, b = *(const LAS u32x2*)(p + 16); u32x4 w = {a.x, a.y, b.x, b.y}; return *reinterpret_cast<bf16x8*>(&w);
}

__device__ __forceinline__ void scan_unit(unsigned char* ws, LAS unsigned char* lds, int unit, int wave, int lane, int tid) {
    static_assert(NCH % 2 == 0, "even chunk count");
    const int b = unit >> 4, hd = (unit >> 1) & 7, dir = unit & 1;
    const bf16_t* z = (const bf16_t*)(ws + WS_Z);
    bf16_t* od = (bf16_t*)(ws + WS_O) + (size_t)dir * T * DM;
    const float* lb = (const float*)(ws + WS_LB) + dir * 1024 + hd * 128;
    const int r32 = lane & 31, hi = lane >> 5;
    if (wave >= 4) {
        const int pw = wave - 4, d = 32 * pw + r32, rh = hi; const float lbv = lb[d];
        asm volatile("s_waitcnt vmcnt(0)" ::: "memory");
        LAS unsigned char* rawb = lds + RAW_OFF; Raw R;
        prep_dma(z, b, hd, dir, 0, rawb, pw, lane); prep_dma(z, b, hd, dir, 1, rawb + RAW_BYTES, pw, lane);
        asm volatile("s_waitcnt vmcnt(6)" ::: "memory"); SCAN_BAR();
        int st = 0;
        for (int n = -1; n < NCH - 1; ++n) {
            prep_read(R, rawb + st * RAW_BYTES, d, rh); prep_compute(R, lbv, lds + ((n + 1) & 1) * BUF_BYTES, d, rh, lane);
            const int st3 = (st == 0) ? 2 : st - 1;
            if (n + 3 < NCH) { prep_dma(z, b, hd, dir, n + 3, rawb + st3 * RAW_BYTES, pw, lane); asm volatile("s_waitcnt vmcnt(6)" ::: "memory"); }
            else asm volatile("s_waitcnt vmcnt(0)" ::: "memory");
            SCAN_BAR();
            st = (st == 2) ? 0 : st + 1;
        }
        SCAN_BAR();
    } else {
        const int sw = wave;
        f32x16 S[4];
#pragma unroll
        for (int t = 0; t < 4; ++t) S[t] = f32x16{};
        SCAN_BAR(); SCAN_BAR();
        for (int n = 0; n < NCH; ++n) {
            const LAS unsigned char* buf = lds + (n & 1) * BUF_BYTES;
            f32x16 X = f32x16{}, Xb = f32x16{};
#pragma unroll
            for (int ks = 0; ks < 8; ++ks) { const bf16x8 a = *(const LAS bf16x8*)(buf + A2_OFF + r32 * A_STR + (16 * ks + 8 * hi) * 2), bb = *(const LAS bf16x8*)(buf + A1_OFF + r32 * A_STR + (16 * ks + 8 * hi) * 2);
                if (ks & 1) Xb = __builtin_amdgcn_mfma_f32_32x32x16_bf16(a, bb, Xb, 0, 0, 0); else X = __builtin_amdgcn_mfma_f32_32x32x16_bf16(a, bb, X, 0, 0, 0); }
#pragma unroll
            for (int r = 0; r < 16; ++r) X[r] = (crow(r, hi) <= r32) ? X[r] + Xb[r] : 0.f;
            f32x16 O = f32x16{};
#pragma unroll
            for (int s0 = 0; s0 < 2; ++s0) { const bf16x8 a = cvt8(X, 8 * s0); const bf16x8 bb = ld44(buf + VT_OFF + (32 * sw + r32) * T_STR + (16 * s0 + 4 * hi) * 2);
                O = __builtin_amdgcn_mfma_f32_32x32x16_bf16(a, bb, O, 0, 0, 0); }
            f32x16 O2 = f32x16{}, O3 = f32x16{};
#pragma unroll
            for (int t = 0; t < 4; ++t)
#pragma unroll
                for (int s0 = 0; s0 < 2; ++s0) { const bf16x8 a = ld44(buf + A1_OFF + r32 * A_STR + (32 * t + 16 * s0 + 4 * hi) * 2); const bf16x8 bb = cvt8(S[t], 8 * s0);
                    if (t & 1) O3 = __builtin_amdgcn_mfma_f32_32x32x16_bf16(a, bb, O3, 0, 0, 0); else O2 = __builtin_amdgcn_mfma_f32_32x32x16_bf16(a, bb, O2, 0, 0, 0); }
#pragma unroll
            for (int r = 0; r < 16; ++r) O[r] += O2[r] + O3[r];
#pragma unroll
            for (int r = 0; r < 16; ++r) { const int p = 32 * n + crow(r, hi); od[(size_t)(b * TPB + tok_of(p, dir)) * DM + hd * 128 + 32 * sw + r32] = (bf16_t)f2bf(O[r]); }
#pragma unroll
            for (int t = 0; t < 4; ++t) {
#pragma unroll
                for (int g4 = 0; g4 < 4; ++g4) { const f32x4 dc = *(const LAS f32x4*)(buf + DEC_OFF + (32 * t + 8 * g4 + 4 * hi) * 4);
                    S[t][4 * g4 + 0] *= dc.x; S[t][4 * g4 + 1] *= dc.y; S[t][4 * g4 + 2] *= dc.z; S[t][4 * g4 + 3] *= dc.w; }
#pragma unroll
                for (int s0 = 0; s0 < 2; ++s0) { const bf16x8 a = *(const LAS bf16x8*)(buf + K2T_OFF + (32 * t + r32) * T_STR + (16 * s0 + 8 * hi) * 2), bb = *(const LAS bf16x8*)(buf + VT_OFF + (32 * sw + r32) * T_STR + (16 * s0 + 8 * hi) * 2);
                    S[t] = __builtin_amdgcn_mfma_f32_32x32x16_bf16(a, bb, S[t], 0, 0, 0); }
            }
            SCAN_BAR();
        }
    }
}
}

__device__ __forceinline__ void phase_a_readout(Frame& F) {
    const int lane = fresh_lane(), l32 = lane & 31, hh = lane >> 5;
    const int gw = F.vcu * NWAVES + F.wave, NGW = F.G * NWAVES;
    const bf16_t* of = (const bf16_t*)(F.ws + WS_O); const bf16_t* ob = of + (size_t)T * DM; const bf16_t* z = (const bf16_t*)(F.ws + WS_Z); bf16_t* xa = (bf16_t*)(F.ws + WS_XA);
    const f32x4 g = *(const f32x4*)(in_ptr(F, I_A_ONORM) + 4 * l32);
    for (int m = gw; m < T; m += NGW) {
        u32x2 a[4], bb[4], gt[4];
#pragma unroll
        for (int it = 0; it < 4; ++it) { const int c = (2 * it + hh) * 128 + 4 * l32;
            a[it] = *(const u32x2*)(of + (size_t)m * DM + c); bb[it] = *(const u32x2*)(ob + (size_t)m * DM + c); gt[it] = *(const u32x2*)(z + (size_t)m * A_IN + 4096 + c); }
#pragma unroll
        for (int it = 0; it < 4; ++it) { const int c = (2 * it + hh) * 128 + 4 * l32;
            const float o0 = bf2f(a[it].x & 0xffffu) + bf2f(bb[it].x & 0xffffu), o1 = bf2f(a[it].x >> 16) + bf2f(bb[it].x >> 16), o2 = bf2f(a[it].y & 0xffffu) + bf2f(bb[it].y & 0xffffu), o3 = bf2f(a[it].y >> 16) + bf2f(bb[it].y >> 16);
            const float rstd = rsqrtf(half_sum((o0 * o0 + o1 * o1) + (o2 * o2 + o3 * o3)) * (1.0f / 128.0f) + NORM_EPS);
            u32x2 w; w.x = pk2(o0 * rstd * g.x * silu_f(bf2f(gt[it].x & 0xffffu)), o1 * rstd * g.y * silu_f(bf2f(gt[it].x >> 16)));
            w.y = pk2(o2 * rstd * g.z * silu_f(bf2f(gt[it].y & 0xffffu)), o3 * rstd * g.w * silu_f(bf2f(gt[it].y >> 16)));
            *(u32x2*)(xa + (size_t)m * DM + c) = w; }
    }
}

__device__ __forceinline__ f32x2 rope_cs(const float* rt, int kind, int pos, int fi) { return *(const f32x2*)(rt + (((size_t)kind * 64 + pos) * 32 + fi) * 2); }

__device__ __forceinline__ void phase_b_row1(Frame& F) {
    const int lane = fresh_lane();
    const int gw = F.vcu * NWAVES + F.wave, NGW = F.G * NWAVES;
    const bf16_t* z = (const bf16_t*)(F.ws + WS_Z); bf16_t* cq = (bf16_t*)(F.ws + WS_O); bf16_t* ckv = cq + (size_t)T * 384; bf16_t* Kb = (bf16_t*)(F.ws + WS_K);
    const float* qg = in_ptr(F, I_B_QNORM); const float* kg = in_ptr(F, I_B_KVNORM); const float* rt = (const float*)(F.ws + WS_ROPE);
    const int ip = lane & 15, hg = lane >> 4;
    f32x2 qgv[3];
#pragma unroll
    for (int j = 0; j < 3; ++j) qgv[j] = *(const f32x2*)(qg + 128 * j + 2 * lane);
    const f32x4 kgv = *(const f32x4*)(kg + 4 * lane);
    for (int m = gw; m < T; m += NGW) { const RowPos rp = row_pos(m); const bf16_t* zr = z + (size_t)m * B_INP;
        float q[6]; float sq = 0.f;
#pragma unroll
        for (int j = 0; j < 3; ++j) { const unsigned w = *(const unsigned*)(zr + 128 * j + 2 * lane); q[2 * j] = bf2f(w & 0xffffu); q[2 * j + 1] = bf2f(w >> 16); sq += q[2 * j] * q[2 * j] + q[2 * j + 1] * q[2 * j + 1]; }
        const u32x2 kw = *(const u32x2*)(zr + 384 + 4 * lane); const float k0 = bf2f(kw.x & 0xffffu), k1 = bf2f(kw.x >> 16), k2 = bf2f(kw.y & 0xffffu), k3 = bf2f(kw.y >> 16);
        const float skv = (k0 * k0 + k1 * k1) + (k2 * k2 + k3 * k3);
        const float rq = rsqrtf(wave_sum(sq) * (1.0f / 384.0f) + NORM_EPS), rkv = rsqrtf(wave_sum(skv) * (1.0f / 256.0f) + NORM_EPS);
#pragma unroll
        for (int j = 0; j < 3; ++j) { const f32x2 g = qgv[j]; *(unsigned*)(cq + (size_t)m * 384 + 128 * j + 2 * lane) = pk2(q[2 * j] * rq * g.x, q[2 * j + 1] * rq * g.y); }
        { const f32x4 g = kgv; u32x2 w; w.x = pk2(k0 * rkv * g.x, k1 * rkv * g.y); w.y = pk2(k2 * rkv * g.z, k3 * rkv * g.w); *(u32x2*)(ckv + (size_t)m * 256 + 4 * lane) = w; }
        const unsigned rw = *(const unsigned*)(zr + 640 + 2 * ip); float x0 = bf2f(rw & 0xffffu), x1 = bf2f(rw >> 16);
        const float p0 = __shfl_xor(x0, 4), p1 = __shfl_xor(x1, 4);
        if (!rp.isctx) { const int pos = (ip < 8) ? rp.prow : rp.pcol; const f32x2 c0 = rope_cs(rt, 0, pos, (2 * ip) & 7), c1 = rope_cs(rt, 0, pos, (2 * ip + 1) & 7);
            if (ip & 4) { x0 = x0 * c0.x + p0 * c0.y; x1 = x1 * c1.x + p1 * c1.y; } else { x0 = x0 * c0.x - p0 * c0.y; x1 = x1 * c1.x - p1 * c1.y; } }
        const unsigned kb = pk2(x0, x1);
#pragma unroll
        for (int hh = 0; hh < 4; ++hh) { const int hd = 4 * hh + hg; *(unsigned*)(Kb + ((size_t)(rp.b * 16 + hd) * TPB + rp.p) * 96 + 64 + 2 * ip) = kb; }
    }
}
__device__ __forceinline__ void phase_b_row2(Frame& F) {
    const int lane = fresh_lane();
    const int gw = F.vcu * NWAVES + F.wave, NGW = F.G * NWAVES;
    bf16_t* Qb = (bf16_t*)(F.ws + WS_Q); const float* rt = (const float*)(F.ws + WS_ROPE);
    const int ip = lane & 15, hg = lane >> 4;
    for (int m = gw; m < T; m += NGW) { const RowPos rp = row_pos(m); if (rp.isctx) continue;
        const int pos = (ip < 8) ? rp.prow : rp.pcol; const f32x2 c0 = rope_cs(rt, 0, pos, (2 * ip) & 7), c1 = rope_cs(rt, 0, pos, (2 * ip + 1) & 7);
        unsigned w[4];
#pragma unroll
        for (int hh = 0; hh < 4; ++hh) w[hh] = *(const unsigned*)(Qb + (size_t)m * 1536 + (4 * hh + hg) * 96 + 64 + 2 * ip);
#pragma unroll
        for (int hh = 0; hh < 4; ++hh) { float x0 = bf2f(w[hh] & 0xffffu), x1 = bf2f(w[hh] >> 16); const float p0 = __shfl_xor(x0, 4), p1 = __shfl_xor(x1, 4);
            if (ip & 4) { x0 = x0 * c0.x + p0 * c0.y; x1 = x1 * c1.x + p1 * c1.y; } else { x0 = x0 * c0.x - p0 * c0.y; x1 = x1 * c1.x - p1 * c1.y; }
            *(unsigned*)(Qb + (size_t)m * 1536 + (4 * hh + hg) * 96 + 64 + 2 * ip) = pk2(x0, x1); }
    }
}
__device__ __forceinline__ void phase_c_row(Frame& F) {
    const int lane = fresh_lane();
    const int gw = F.vcu * NWAVES + F.wave, NGW = F.G * NWAVES;
    const bf16_t* z = (const bf16_t*)(F.ws + WS_Z); bf16_t* Qb = (bf16_t*)(F.ws + WS_Q); bf16_t* Kb = (bf16_t*)(F.ws + WS_K); bf16_t* Vb = (bf16_t*)(F.ws + WS_V);
    const float* qg = in_ptr(F, I_C_QNORM); const float* kg = in_ptr(F, I_C_KNORM); const float* rt = (const float*)(F.ws + WS_ROPE);
    const f32x2 qgv = *(const f32x2*)(qg + 2 * lane), kgv = *(const f32x2*)(kg + 2 * lane);
    const bool up = (lane & 16) != 0;
    for (int m = gw; m < T; m += NGW) { const RowPos rp = row_pos(m); const bf16_t* zr = z + (size_t)m * C_IN;
        f32x2 c0 = (f32x2){1.f, 0.f}, c1 = (f32x2){1.f, 0.f};
        if (!rp.isctx) { const int pos = (lane < 32) ? rp.prow : rp.pcol; c0 = rope_cs(rt, 2, pos, (2 * lane) & 31); c1 = rope_cs(rt, 2, pos, (2 * lane + 1) & 31); }
        unsigned w[10];
#pragma unroll
        for (int hv = 0; hv < 10; ++hv) w[hv] = *(const unsigned*)(zr + hv * 128 + 2 * lane);
#pragma unroll
        for (int hv = 0; hv < 10; ++hv) { float a = bf2f(w[hv] & 0xffffu), bq = bf2f(w[hv] >> 16);
            const float rstd = rsqrtf(wave_sum(a * a + bq * bq) * (1.0f / 128.0f) + NORM_EPS);
            a *= rstd * (hv < 8 ? qgv.x : kgv.x); bq *= rstd * (hv < 8 ? qgv.y : kgv.y);
            const float ap = __shfl_xor(a, 16), bp = __shfl_xor(bq, 16);
            const float ar = up ? (a * c0.x + ap * c0.y) : (a * c0.x - ap * c0.y), br = up ? (bq * c1.x + bp * c1.y) : (bq * c1.x - bp * c1.y);
            bf16_t* dst = (hv < 8) ? Qb + (size_t)m * 1024 + hv * 128 : Kb + (size_t)m * 256 + (hv - 8) * 128;
            *(unsigned*)(dst + 2 * lane) = pk2(ar, br); }
        *(u32x2*)(Vb + (size_t)m * 256 + 4 * lane) = *(const u32x2*)(zr + 1280 + 4 * lane);
    }
}
__device__ __forceinline__ void phase_d_row1(Frame& F) {
    const int lane = fresh_lane();
    const int gw = F.vcu * NWAVES + F.wave, NGW = F.G * NWAVES;
    const bf16_t* z = (const bf16_t*)(F.ws + WS_Z); bf16_t* Qb = (bf16_t*)(F.ws + WS_Q); bf16_t* Kb = (bf16_t*)(F.ws + WS_K); bf16_t* Vb = (bf16_t*)(F.ws + WS_V);
    const float* rt = (const float*)(F.ws + WS_ROPE);
    const int lp = lane & 31; const bool up = (lane & 8) != 0;
    for (int m = gw; m < T; m += NGW) { const RowPos rp = row_pos(m); const bf16_t* zr = z + (size_t)m * D_IN;
        f32x2 c0 = (f32x2){1.f, 0.f}, c1 = (f32x2){1.f, 0.f};
        if (!rp.isctx) { const int pos = (lp < 16) ? rp.prow : rp.pcol; c0 = rope_cs(rt, 1, pos, (2 * lp) & 15); c1 = rope_cs(rt, 1, pos, (2 * lp + 1) & 15); }
        unsigned w[16];
#pragma unroll
        for (int i = 0; i < 16; ++i) w[i] = *(const unsigned*)(zr + 128 * i + 2 * lane);
#pragma unroll
        for (int i = 0; i < 16; ++i) { const float a = bf2f(w[i] & 0xffffu), bq = bf2f(w[i] >> 16); const float ap = __shfl_xor(a, 8), bp = __shfl_xor(bq, 8);
            const float ar = up ? (a * c0.x + ap * c0.y) : (a * c0.x - ap * c0.y), br = up ? (bq * c1.x + bp * c1.y) : (bq * c1.x - bp * c1.y);
            bf16_t* dst = (i < 8) ? Qb + (size_t)m * 1024 + 128 * i : Kb + (size_t)m * 1024 + 128 * (i - 8); *(unsigned*)(dst + 2 * lane) = pk2(ar, br); }
        { const u32x4 a = *(const u32x4*)(zr + 2048 + 16 * lane), bq = *(const u32x4*)(zr + 2048 + 16 * lane + 8); *(u32x4*)(Vb + (size_t)m * 1024 + 16 * lane) = a; *(u32x4*)(Vb + (size_t)m * 1024 + 16 * lane + 8) = bq; }
    }
}
__device__ __forceinline__ void phase_d_row2(Frame& F) {
    const int lane = fresh_lane(), l32 = lane & 31, hh = lane >> 5;
    const int gw = F.vcu * NWAVES + F.wave, NGW = F.G * NWAVES;
    const bf16_t* A = (const bf16_t*)(F.ws + WS_O); bf16_t* xa = (bf16_t*)(F.ws + WS_XA);
    const float* lam = in_ptr(F, I_D_LAMBDA);
    const float lambda_init = 0.8f - 0.6f * 0.40656965974059917f;
    const float s1 = wave_sum(lam[lane] * lam[64 + lane]), s2 = wave_sum(lam[128 + lane] * lam[192 + lane]);
    const float lam_full = expf(s1) - expf(s2) + lambda_init;
    const f32x4 g = *(const f32x4*)(in_ptr(F, I_D_ONORM) + 4 * l32) * (1.0f - lambda_init);
    for (int m = gw; m < T; m += NGW) { if ((m % TPB) < CTXL) continue;
        u32x2 a[4], bb[4];
#pragma unroll
        for (int it = 0; it < 4; ++it) { const int hd = 2 * it + hh; a[it] = *(const u32x2*)(A + (size_t)m * 2048 + (2 * hd) * 128 + 4 * l32); bb[it] = *(const u32x2*)(A + (size_t)m * 2048 + (2 * hd + 1) * 128 + 4 * l32); }
#pragma unroll
        for (int it = 0; it < 4; ++it) { const int hd = 2 * it + hh;
            const float o0 = bf2f(a[it].x & 0xffffu) - lam_full * bf2f(bb[it].x & 0xffffu), o1 = bf2f(a[it].x >> 16) - lam_full * bf2f(bb[it].x >> 16);
            const float o2 = bf2f(a[it].y & 0xffffu) - lam_full * bf2f(bb[it].y & 0xffffu), o3 = bf2f(a[it].y >> 16) - lam_full * bf2f(bb[it].y >> 16);
            const float rstd = rsqrtf(half_sum((o0 * o0 + o1 * o1) + (o2 * o2 + o3 * o3)) * (1.0f / 128.0f) + NORM_EPS);
            u32x2 w; w.x = pk2(o0 * rstd * g.x, o1 * rstd * g.y); w.y = pk2(o2 * rstd * g.z, o3 * rstd * g.w);
            *(u32x2*)(xa + (size_t)m * DM + hd * 128 + 4 * l32) = w; }
    }
}

#ifndef MK_STAG
#define MK_STAG 1
#endif
#define MK_SPLITKV 0
#define MK_PRE_B 1
#define MK_PRE_C 1
#define MK_PRE_D 1
#define MK_PRE(DK) (MK_STAG && ((DK) == 96 ? MK_PRE_B : (DK) == 128 ? MK_PRE_C : MK_PRE_D))
template <int DK, int DV, int ldq, int ldk, int ldv, int ldo, int H, int GK, int GV>
__device__ __forceinline__ void attn_phase(Frame& F, const bf16_t* Q, const bf16_t* K, const bf16_t* V, bf16_t* O, float scale, bool skip_ctx, int dup = 1) {
    const float C = scale * 1.4426950408889634f, thr_raw = att::THR / scale;
    const int NHV = NBATCH * H * 16, NCTX = skip_ctx ? 0 : NBATCH * H;
    const int LO = NHV % F.G, NFULL = NHV - LO; int SF = 1;
    if (MK_SPLITKV && dup == 1 && LO > 0 && F.G % LO == 0) { const int q = F.G / LO; if (q == 2 || q == 4) SF = q; }
    const int NPART = (SF > 1) ? LO * SF : 0, NLAT = (SF > 1) ? NFULL : NHV, NTOT = NLAT + NPART + NCTX;
    float* PO = (float*)(F.ws + WS_YS); float* PML = PO + (size_t)256 * 256 * 128;
    for (int L0 = F.vcu; L0 < NTOT * dup; L0 += F.G) { const int L = (dup > 1) ? L0 % NTOT : L0;
        int b, hd, qb, part = -1, U = L;
        if (L >= NLAT && L < NLAT + NPART) { const int j = L - NLAT; U = NFULL + j / SF; part = j % SF; }
        if (L < NLAT + NPART) { const int grp = U >> 4; b = grp / H; hd = grp % H; qb = 1 + (U & 15); } else { const int L2 = L - NLAT - NPART; b = L2 / H; hd = L2 % H; qb = 0; }
        const size_t row0 = (size_t)b * TPB + (size_t)qb * 256; const bf16_t* Kh = K + (size_t)(b * (H / GK) + hd / GK) * TPB * DK; const bf16_t* Vh = V + (size_t)(b * (H / GV) + hd / GV) * TPB * DV;
        if (part >= 0) { const int klen = TPB / SF, j = L - NLAT;
            att::attn_unit_stag<DK, DV, ldq, DK, DV, ldo, MK_PRE(DK) != 0, false, true>(Q + row0 * ldq + hd * DK, Kh + (size_t)part * klen * DK, Vh + (size_t)part * klen * DV, nullptr,
                               klen, C, thr_raw, (char*)F.lds, F.wave, PO + (size_t)j * 256 * DV, PML + (size_t)j * 256 * 2); }
        else
        att::attn_unit_stag<DK, DV, ldq, DK, DV, ldo, MK_PRE(DK) != 0, false>(Q + row0 * ldq + hd * DK, Kh, Vh, O + row0 * ldo + hd * DV,
                               qb == 0 ? CTXL : TPB, C, thr_raw, (char*)F.lds, F.wave);
    }
    __syncthreads();
}
template <int DV, int ldo, int H>
__device__ __forceinline__ void attn_merge(Frame& F, bf16_t* O) {
    const int NHV = NBATCH * H * 16, LO = NHV % F.G, NFULL = NHV - LO; int SF = 1;
    if (LO > 0 && F.G % LO == 0) { const int q = F.G / LO; if (q == 2 || q == 4) SF = q; }
    if (SF == 1) return;
    const float* PO = (const float*)(F.ws + WS_YS); const float* PML = PO + (size_t)256 * 256 * 128;
    const int lane = fresh_lane(), gw = F.vcu * NWAVES + F.wave, NGW = F.G * NWAVES;
    for (int it = gw; it < LO * 256; it += NGW) { const int u = it >> 8, r = it & 255, U = NFULL + u;
        const int grp = U >> 4, b = grp / H, hd = grp % H, qb = 1 + (U & 15);
        float mi[4], li[4], m = -3.0e38f;
#pragma unroll
        for (int i = 0; i < 4; ++i) { if (i < SF) { const f32x2 ml = *(const f32x2*)(PML + ((size_t)(u * SF + i) * 256 + r) * 2); mi[i] = ml.x; li[i] = ml.y; m = fmaxf(m, ml.x); } else { mi[i] = 0.f; li[i] = 0.f; } }
        float l = 0.f, w[4];
#pragma unroll
        for (int i = 0; i < 4; ++i) { w[i] = (i < SF) ? __builtin_amdgcn_exp2f(mi[i] - m) : 0.f; l += w[i] * li[i]; }
        const float rl = 1.0f / l;
        bf16_t* orow = O + ((size_t)b * TPB + (size_t)qb * 256 + r) * ldo + hd * DV;
#pragma unroll
        for (int c0 = 0; c0 < DV; c0 += 64) { float acc = 0.f;
#pragma unroll
            for (int i = 0; i < 4; ++i) if (i < SF) acc += w[i] * PO[((size_t)(u * SF + i) * 256 + r) * DV + c0 + lane];
            orow[c0 + lane] = (bf16_t)f2bf(acc * rl); } }
}
#ifndef MK_MULTI
#define MK_MULTI 0
#endif
constexpr int NPHASE = 37;
#ifndef MK_REP_MASK
#define MK_REP_MASK 0ull
#endif
#ifndef MK_REP_N
#define MK_REP_N 1
#endif
#ifndef MK_DUP
#define MK_DUP -1
#endif
#define DUPF(k) ((k) == MK_DUP ? 2 : 1)
#ifndef MK_LIMIT
#define MK_LIMIT 37
#endif
struct Args { const float* in[N_IN]; float* out; unsigned char* ws; int ph_lo, ph_hi; };

__device__ __forceinline__ void gemm_plain_f32(Frame& F, const bf16_t* A, const bf16_t* Bt, int N, int K, float* C, int ldc, int dup = 1) {
    pg8::Gemm g{A, Bt, K / 64, N, K, 0, nullptr, 0, nullptr}; pg8::StaticOrder S; S.init(T / 256, N / 256, F.G, (int)blockIdx.x, dup); pg8::EpiF32 E{C, ldc};
    pg8::gemm_phase<pg8::EpiF32, pg8::StaticOrder, false>(F.lds, g, S, E, F.wave);
}
__device__ __forceinline__ void gemm_plain_bf16(Frame& F, const bf16_t* A, const bf16_t* Bt, int N, int K, bf16_t* C, int ldc, int dup = 1) {
    pg8::Gemm g{A, Bt, K / 64, N, K, 0, nullptr, 0, nullptr}; pg8::StaticOrder S; S.init(T / 256, N / 256, F.G, (int)blockIdx.x, dup); pg8::EpiBf16 E{C, ldc};
    pg8::gemm_phase<pg8::EpiBf16, pg8::StaticOrder, false>(F.lds, g, S, E, F.wave);
}
template <int S>
__device__ __forceinline__ void gemm_n1024(Frame& F, const bf16_t* A, const bf16_t* Bt, int K, bool skip_ctx, int dup = 1) {
    { pg8::Gemm g{A, Bt, K / 64, DM, K, 0, nullptr, 0, nullptr}; pg8::LatOrder S1; S1.so.init(128, DM / 256, F.G, (int)blockIdx.x, dup); pg8::EpiBf16 E{(bf16_t*)(F.ws + WS_Y), DM};
      pg8::gemm_phase<pg8::EpiBf16, pg8::LatOrder, false>(F.lds, g, S1, E, F.wave); }
    if (!skip_ctx) { pg8::Gemm g{A, Bt, K / 64 / S, DM, K, 0, nullptr, 0, nullptr}; pg8::CtxSplitOrder S2{DM / 256, S, K / 64 / S, F.G, (int)blockIdx.x, dup}; pg8::EpiF32 E{(float*)(F.ws + WS_YS), DM};
      pg8::gemm_phase<pg8::EpiF32, pg8::CtxSplitOrder, false>(F.lds, g, S2, E, F.wave); }
}
__device__ __forceinline__ void gemm_swiglu(Frame& F, const bf16_t* A, const bf16_t* Bt, bf16_t* C, int dup = 1) {
    pg8::Gemm g{A, Bt, DM / 128, 2 * FF, DM / 2, 0, nullptr, 0, nullptr}; pg8::StaticOrder S; S.init(T / 256, 2 * FF / 256, F.G, (int)blockIdx.x, dup); pg8::EpiSwiglu E{C, FF, 1.0f / 32.0f};
    pg8::gemm_phase<pg8::EpiSwiglu, pg8::StaticOrder, false, true>(F.lds, g, S, E, F.wave);
}
__device__ __forceinline__ void gemm_moe_gu(Frame& F, int lm, int dup = 1) {
    moe_tables(F, 2 * lm + 1);
    pg8::Gemm g{(const bf16_t*)(F.ws + WS_XA), (const bf16_t*)(F.ws + WS_MOE_GU + (size_t)lm * 8 * SZ_GU), DM / 128, 2 * FF, DM / 2, (size_t)2 * FF * DM / 2, (const int*)(F.ws + WS_LIST), T, (const LAS int*)(F.MISC + 32)};
    pg8::MoeOrder S; S.so.init((int)F.MISC[24], 2 * FF / 256, F.G, (int)blockIdx.x, dup); S.rb0 = (const LAS int*)(F.MISC + 16); pg8::EpiSwiglu E{(bf16_t*)(F.ws + WS_ACT), FF, 1.0f / 32.0f};
    pg8::gemm_phase<pg8::EpiSwiglu, pg8::MoeOrder, true, true>(F.lds, g, S, E, F.wave);
}
__device__ __forceinline__ void gemm_moe_down(Frame& F, int lm, int dup = 1) {
    moe_tables(F, 2 * lm + 1);
    int RBM, trb, S; pg8::moe_tail_params((int)F.MISC[24], RBM, trb, S);
    const bf16_t* A = (const bf16_t*)(F.ws + WS_ACT); const bf16_t* Bt = (const bf16_t*)(F.ws + WS_MOE_DN + (size_t)lm * 8 * SZ_DN);
    { pg8::Gemm g{A, Bt, FF / 64, DM, FF, (size_t)DM * FF, nullptr, 0, nullptr};
      pg8::MoeOrder S1; S1.so.init(RBM, DM / 256, F.G, (int)blockIdx.x, dup); S1.rb0 = (const LAS int*)(F.MISC + 16); pg8::EpiBf16 E{(bf16_t*)(F.ws + WS_YP), DM};
      pg8::gemm_phase<pg8::EpiBf16, pg8::MoeOrder, false>(F.lds, g, S1, E, F.wave); }
    if (trb > 0) { pg8::Gemm g{A, Bt, FF / 64 / S, DM, FF, (size_t)DM * FF, nullptr, 0, nullptr};
      pg8::MoeTailOrder S2{RBM, trb, S, FF / 64 / S, F.G, (int)blockIdx.x, dup, (const LAS int*)(F.MISC + 16)}; pg8::EpiF32 E{(float*)(F.ws + WS_YS), DM};
      pg8::gemm_phase<pg8::EpiF32, pg8::MoeTailOrder, false>(F.lds, g, S2, E, F.wave); }
}
__device__ __forceinline__ void xcd_or_nothing(const XcdBarrier& b, int wave) { if (!MK_MULTI) xcd_barrier(b, wave); }
__global__ void __launch_bounds__(NWAVES * 64, 2) fwd_kernel(Args args) {
    extern __shared__ __attribute__((aligned(16))) unsigned char lds_raw[];
    Frame F;
    F.lds = (LAS unsigned char*)lds_raw; F.MISC = (volatile LAS unsigned*)(F.lds + MISC_OFF);
    F.wave = __builtin_amdgcn_readfirstlane((int)threadIdx.x >> 6);
    F.G = gridDim.x; { const int bx = blockIdx.x; F.vcu = (F.G % 8 == 0) ? (bx % 8) * (F.G / 8) + bx / 8 : bx; }
    F.ws = args.ws;
    for (int u = threadIdx.x; u < 256; u += NWAVES * 64) ((LAS unsigned*)(F.lds + MISC_OFF))[u] = 0u;
    __syncthreads();
    XcdBarrier bar; bar.bar = (unsigned*)((unsigned*)F.ws + CW_BAR); bar.x = 0; bar.st = nullptr;
    if (!MK_MULTI) bar = xcd_barrier_post((unsigned*)((unsigned*)F.ws + CW_BAR), F.MISC + 0);
    const int lo = args.ph_lo, hi = args.ph_hi;
#define IN(k) (lo <= (k) && (k) < hi)
#define NREP(k) ((((unsigned long long)(MK_REP_MASK) >> (k)) & 1ull) ? (1 + MK_REP_N) : 1)
#define SEAM(k) do { if (!MK_MULTI && IN((k) + 1)) xcd_barrier(bar, F.wave); } while (0)
    unsigned char* ws = F.ws;
    bf16_t* XA = (bf16_t*)(ws + WS_XA); bf16_t* Y = (bf16_t*)(ws + WS_Y); bf16_t* ACT = (bf16_t*)(ws + WS_ACT);
    bf16_t* Qb = (bf16_t*)(ws + WS_Q); bf16_t* Kb = (bf16_t*)(ws + WS_K); bf16_t* Vb = (bf16_t*)(ws + WS_V); bf16_t* Ob = (bf16_t*)(ws + WS_O);

    if (IN(0)) { for (int rep = 0; rep < NREP(0); ++rep) { p0_prologue(F); if (rep + 1 < NREP(0)) xcd_or_nothing(bar, F.wave); } SEAM(0); }
    if (IN(1)) { for (int rep = 0; rep < NREP(1); ++rep) { for (int d2 = 0; d2 < DUPF(1); ++d2) { phase_r0(F); } if (rep + 1 < NREP(1)) xcd_or_nothing(bar, F.wave); } SEAM(1); }
    if (IN(2)) { for (int rep = 0; rep < NREP(2); ++rep) { gemm_plain_bf16(F, XA, (const bf16_t*)(ws + WS_WA_IN), A_IN, DM, (bf16_t*)(ws + WS_Z), A_IN, DUPF(2)); if (rep + 1 < NREP(2)) xcd_or_nothing(bar, F.wave); } SEAM(2); }
    if (IN(3)) { for (int rep = 0; rep < NREP(3); ++rep) { if ((int)blockIdx.x < NBATCH * 8 * 2) { for (int d2 = 0; d2 < DUPF(3); ++d2) { const int ln = fresh_lane(); scan::scan_unit(ws, F.lds, (int)blockIdx.x, F.wave, ln, F.wave * 64 + ln); __syncthreads(); } }
        else if (rep == 0) { const int nidle = F.G - NBATCH * 8 * 2; p0_convert(F, p0_split_item(), g_mats.item0[NMAT], ((int)blockIdx.x - NBATCH * 8 * 2) * NWAVES + F.wave, nidle * NWAVES, fresh_lane()); } if (rep + 1 < NREP(3)) xcd_or_nothing(bar, F.wave); } SEAM(3); }
    if (IN(4)) { for (int rep = 0; rep < NREP(4); ++rep) { for (int d2 = 0; d2 < DUPF(4); ++d2) { phase_a_readout(F); } if (rep + 1 < NREP(4)) xcd_or_nothing(bar, F.wave); } SEAM(4); }
    if (IN(5)) { for (int rep = 0; rep < NREP(5); ++rep) { gemm_n1024<4>(F, XA, (const bf16_t*)(ws + WS_WA_OUT), DM, false, DUPF(5)); if (rep + 1 < NREP(5)) xcd_or_nothing(bar, F.wave); } SEAM(5); }
    if (IN(6)) { for (int rep = 0; rep < NREP(6); ++rep) { phase_r1<false>(F, 0); if (rep + 1 < NREP(6)) xcd_or_nothing(bar, F.wave); } SEAM(6); }
    if (IN(7)) { for (int rep = 0; rep < NREP(7); ++rep) { gemm_swiglu(F, XA, (const bf16_t*)(ws + WS_FFN_GU), ACT, DUPF(7)); if (rep + 1 < NREP(7)) xcd_or_nothing(bar, F.wave); } SEAM(7); }
    if (IN(8)) { for (int rep = 0; rep < NREP(8); ++rep) { gemm_n1024<4>(F, ACT, (const bf16_t*)(ws + WS_FFN_DN), FF, false, DUPF(8)); if (rep + 1 < NREP(8)) xcd_or_nothing(bar, F.wave); } SEAM(8); }
    if (IN(9)) { for (int rep = 0; rep < NREP(9); ++rep) { phase_r2<false>(F, 0); if (rep + 1 < NREP(9)) xcd_or_nothing(bar, F.wave); } SEAM(9); }
    if (IN(10)) { for (int rep = 0; rep < NREP(10); ++rep) { gemm_plain_bf16(F, XA, (const bf16_t*)(ws + WS_WB_IN), B_INP, DM, (bf16_t*)(ws + WS_Z), B_INP, DUPF(10)); if (rep + 1 < NREP(10)) xcd_or_nothing(bar, F.wave); } SEAM(10); }
    if (IN(11)) { for (int rep = 0; rep < NREP(11); ++rep) { for (int d2 = 0; d2 < DUPF(11); ++d2) { phase_b_row1(F); } if (rep + 1 < NREP(11)) xcd_or_nothing(bar, F.wave); } SEAM(11); }
    if (IN(12)) {
        { pg8::Gemm g{Ob, (const bf16_t*)(ws + WS_WB_QB), 384 / 64, 1536, 384, 0, nullptr, 0, nullptr}; pg8::StaticOrder S; S.init(T / 256, 1536 / 256, F.G, (int)blockIdx.x); pg8::EpiRopeB E{Qb, (const float*)(ws + WS_ROPE), MK_PRE(96) ? 0.10206207261596575f * 1.4426950408889634f : 1.0f};
          pg8::gemm_phase<pg8::EpiRopeB, pg8::StaticOrder, false>(F.lds, g, S, E, F.wave); }
        { pg8::Gemm g{Ob + (size_t)T * 384, (const bf16_t*)(ws + WS_WB_KVB), 256 / 64, 2048, 256, 0, nullptr, 0, nullptr}; pg8::StaticOrder S; S.init(T / 256, 2048 / 256, F.G, (int)blockIdx.x); pg8::EpiKV E{Kb, 1536, Vb, 1024};
          pg8::gemm_phase<pg8::EpiKV, pg8::StaticOrder, false>(F.lds, g, S, E, F.wave); }
        SEAM(12); }
    if (IN(13)) { for (int rep = 0; rep < NREP(13); ++rep) { attn_phase<96, 64, 1536, 1536, 1024, DM, 16, 1, 1>(F, Qb, Kb, Vb, XA, 0.10206207261596575f, false, DUPF(13)); if (rep + 1 < NREP(13)) xcd_or_nothing(bar, F.wave); } SEAM(13); }
    if (IN(14)) { for (int rep = 0; rep < NREP(14); ++rep) { gemm_n1024<4>(F, XA, (const bf16_t*)(ws + WS_WB_OUT), DM, false, DUPF(14)); if (rep + 1 < NREP(14)) xcd_or_nothing(bar, F.wave); } SEAM(14); }
    if (IN(15)) { for (int rep = 0; rep < NREP(15); ++rep) { phase_r1<true>(F, 1); if (rep + 1 < NREP(15)) xcd_or_nothing(bar, F.wave); } SEAM(15); }
    if (IN(16)) { moe_build(F); SEAM(16); }
    if (IN(17)) { for (int rep = 0; rep < NREP(17); ++rep) { gemm_moe_gu(F, 0, DUPF(17)); if (rep + 1 < NREP(17)) xcd_or_nothing(bar, F.wave); } SEAM(17); }
    if (IN(18)) { for (int rep = 0; rep < NREP(18); ++rep) { gemm_moe_down(F, 0, DUPF(18)); if (rep + 1 < NREP(18)) xcd_or_nothing(bar, F.wave); } SEAM(18); }
    if (IN(19)) { for (int rep = 0; rep < NREP(19); ++rep) { moe_tables(F, 1); phase_r2<true>(F, 1); if (rep + 1 < NREP(19)) xcd_or_nothing(bar, F.wave); } SEAM(19); }
    if (IN(20)) { { pg8::Gemm g{XA, (const bf16_t*)(ws + WS_WC_IN), DM / 64, C_IN, DM, 0, nullptr, 0, nullptr}; pg8::StaticOrder S; S.init(T / 256, C_IN / 256, F.G, (int)blockIdx.x, DUPF(20));
          pg8::EpiNormRopeC E{Qb, Kb, Vb, in_ptr(F, I_C_QNORM), in_ptr(F, I_C_KNORM), (const float*)(ws + WS_ROPE) + (size_t)2 * 64 * 32 * 2, (LAS float*)(F.lds + pg8::STAGE_BYTES + 2048), MK_PRE(128) ? 0.08838834764831845f * 1.4426950408889634f : 1.0f};
          pg8::gemm_phase<pg8::EpiNormRopeC, pg8::StaticOrder, false>(F.lds, g, S, E, F.wave); } }
    if (IN(21)) { SEAM(21); }
    if (IN(22)) { for (int rep = 0; rep < NREP(22); ++rep) { attn_phase<128, 128, 1024, 256, 256, DM, 8, 4, 4>(F, Qb, Kb, Vb, XA, 0.08838834764831845f, false, DUPF(22)); if (rep + 1 < NREP(22)) xcd_or_nothing(bar, F.wave); } SEAM(22); }
    if (IN(23)) { for (int rep = 0; rep < NREP(23); ++rep) { gemm_n1024<4>(F, XA, (const bf16_t*)(ws + WS_WC_OUT), DM, false, DUPF(23)); if (rep + 1 < NREP(23)) xcd_or_nothing(bar, F.wave); } SEAM(23); }
    if (IN(24)) { for (int rep = 0; rep < NREP(24); ++rep) { phase_r1<false>(F, 2); if (rep + 1 < NREP(24)) xcd_or_nothing(bar, F.wave); } SEAM(24); }
    if (IN(25)) { for (int rep = 0; rep < NREP(25); ++rep) { gemm_swiglu(F, XA, (const bf16_t*)(ws + WS_FFN_GU + SZ_GU), ACT, DUPF(25)); if (rep + 1 < NREP(25)) xcd_or_nothing(bar, F.wave); } SEAM(25); }
    if (IN(26)) { for (int rep = 0; rep < NREP(26); ++rep) { gemm_n1024<4>(F, ACT, (const bf16_t*)(ws + WS_FFN_DN + SZ_DN), FF, false, DUPF(26)); if (rep + 1 < NREP(26)) xcd_or_nothing(bar, F.wave); } SEAM(26); }
    if (IN(27)) { for (int rep = 0; rep < NREP(27); ++rep) { phase_r2<false>(F, 2); if (rep + 1 < NREP(27)) xcd_or_nothing(bar, F.wave); } SEAM(27); }
    if (IN(28)) { { pg8::Gemm g{XA, (const bf16_t*)(ws + WS_WD_IN), DM / 64, D_IN, DM, 0, nullptr, 0, nullptr}; pg8::StaticOrder S; S.init(T / 256, D_IN / 256, F.G, (int)blockIdx.x, DUPF(28));
          pg8::EpiRopeD E{Qb, Kb, Vb, (const float*)(ws + WS_ROPE) + (size_t)1 * 64 * 32 * 2, MK_PRE(64) ? 0.125f * 1.4426950408889634f : 1.0f};
          pg8::gemm_phase<pg8::EpiRopeD, pg8::StaticOrder, false>(F.lds, g, S, E, F.wave); } SEAM(28); }
    if (IN(29)) { for (int rep = 0; rep < NREP(29); ++rep) { attn_phase<64, 128, 1024, 1024, 1024, 2048, 16, 1, 2>(F, Qb, Kb, Vb, Ob, 0.125f, true, DUPF(29)); if (rep + 1 < NREP(29)) xcd_or_nothing(bar, F.wave); } SEAM(29); }
    if (IN(30)) { for (int rep = 0; rep < NREP(30); ++rep) { for (int d2 = 0; d2 < DUPF(30); ++d2) { phase_d_row2(F); } if (rep + 1 < NREP(30)) xcd_or_nothing(bar, F.wave); } SEAM(30); }
    if (IN(31)) { for (int rep = 0; rep < NREP(31); ++rep) { gemm_n1024<4>(F, XA, (const bf16_t*)(ws + WS_WD_OUT), DM, true, DUPF(31)); if (rep + 1 < NREP(31)) xcd_or_nothing(bar, F.wave); } SEAM(31); }
    if (IN(32)) { for (int rep = 0; rep < NREP(32); ++rep) { phase_r1<true>(F, 3); if (rep + 1 < NREP(32)) xcd_or_nothing(bar, F.wave); } SEAM(32); }
    if (IN(33)) { moe_build(F); SEAM(33); }
    if (IN(34)) { for (int rep = 0; rep < NREP(34); ++rep) { gemm_moe_gu(F, 1, DUPF(34)); if (rep + 1 < NREP(34)) xcd_or_nothing(bar, F.wave); } SEAM(34); }
    if (IN(35)) { for (int rep = 0; rep < NREP(35); ++rep) { gemm_moe_down(F, 1, DUPF(35)); if (rep + 1 < NREP(35)) xcd_or_nothing(bar, F.wave); } SEAM(35); }
    if (IN(36)) { moe_tables(F, 3); phase_r2<true>(F, 3); }
#if MK_LIMIT < 37
    {
        xcd_barrier(bar, F.wave);
        float* outp = out_ptr(); const int tid = F.wave * 64 + fresh_lane();
#if MK_LIMIT == 34 || MK_LIMIT == 35 || MK_LIMIT == 36
        moe_tables(F, 3);
        int RBM, trb, S; pg8::moe_tail_params((int)F.MISC[24], RBM, trb, S);
#endif
        for (int r = (int)blockIdx.x; r < NBATCH * SEQ; r += F.G) { const int b = r / SEQ, l = r % SEQ; const size_t m = (size_t)b * TPB + CTXL + l;
#if MK_LIMIT == 34
            const int* route = (const int*)(ws + WS_ROUTE); const int* list = (const int*)(ws + WS_LIST);
            const int e1 = route[m * 8], s1 = route[m * 8 + 1], e2 = route[m * 8 + 2], s2 = route[m * 8 + 3];
            const unsigned char* xa8 = (const unsigned char*)(ws + WS_XA) + m * DM;
            for (int c = tid; c < DM; c += NWAVES * 64) { float v = 0.f;
                if (c >= 512) v = (float)((unsigned)xa8[2 * (c - 512)] + 256u * (unsigned)xa8[2 * (c - 512) + 1]); else
                if (c < 4) v = (float)route[m * 8 + c]; else if (c < 6) v = ((const float*)route)[m * 8 + c]; else if (c == 6) v = (float)(list[(size_t)e1 * T + s1] - (int)m); else if (c == 7) v = (float)(list[(size_t)e2 * T + s2] - (int)m);
                else if (c < 16) v = (float)F.MISC[16 + (c - 8)]; else if (c < 24) v = (float)F.MISC[32 + (c - 16)]; else if (c == 24) v = (float)F.MISC[24];
                outp[(size_t)r * DM + c] = v; }
#elif MK_LIMIT == 35
            const int* route = (const int*)(ws + WS_ROUTE); const bf16_t* act = (const bf16_t*)(ws + WS_ACT);
            const size_t r1 = (size_t)F.MISC[16 + route[m * 8]] * 256 + route[m * 8 + 1], r2 = (size_t)F.MISC[16 + route[m * 8 + 2]] * 256 + route[m * 8 + 3];
            for (int c = tid; c < DM; c += NWAVES * 64) { float v = 0.f;
                for (int q = 0; q < 4; ++q) { const int cc = c + q * DM; if (cc < FF) v += bf2f((unsigned)act[r1 * FF + cc]) + 2.0f * bf2f((unsigned)act[r2 * FF + cc]); }
                outp[(size_t)r * DM + c] = v; }
#elif MK_LIMIT == 36
            const int* route = (const int*)(ws + WS_ROUTE);
            const size_t r1 = (size_t)F.MISC[16 + route[m * 8]] * 256 + route[m * 8 + 1], r2 = (size_t)F.MISC[16 + route[m * 8 + 2]] * 256 + route[m * 8 + 3];
            for (int c = tid; c < DM; c += NWAVES * 64) { float v = 0.f;
                for (int k = 0; k < 2; ++k) { const size_t rr = k ? r2 : r1; const int rb = (int)(rr >> 8); float a = 0.f;
                    if (rb >= RBM) { const float* ys = (const float*)(ws + WS_YS) + ((size_t)(rb - RBM) * 256 + (rr & 255)) * DM; for (int s2 = 0; s2 < S; ++s2) a += ys[(size_t)s2 * trb * 256 * DM + c]; }
                    else a = bf2f((unsigned)((const bf16_t*)(ws + WS_YP))[rr * DM + c]);
                    v += (k ? 2.0f : 1.0f) * a; }
                outp[(size_t)r * DM + c] = v; }
#else
            const bf16_t* hh = (const bf16_t*)(ws + WS_H); const size_t src = m * DM;
            for (int c = tid; c < DM; c += NWAVES * 64) outp[(size_t)r * DM + c] = bf2f((unsigned)hh[src + c]);
#endif
        }
    }
#endif
#undef IN
#undef SEAM
}

extern "C" void kernel_launch(void* const* d_in, const int* in_sizes, int n_in, void* d_out, int out_size, void* d_ws, size_t ws_size, hipStream_t stream) {
    static int grid = 0;
    if (grid == 0) {
        if (n_in != N_IN || out_size != NBATCH * SEQ * DM || ws_size < WS_END) { fprintf(stderr, "kernel_launch: unexpected shapes: n_in %d out %d ws %zu (need %zu)\n", n_in, out_size, ws_size, (size_t)WS_END); grid = -1; return; }
        int dev = 0, cus = 0, per_cu = 0;
        if (hipGetDevice(&dev) != hipSuccess || hipDeviceGetAttribute(&cus, hipDeviceAttributeMultiprocessorCount, dev) != hipSuccess) { grid = -1; return; }
        if (hipFuncSetAttribute((const void*)fwd_kernel, hipFuncAttributeMaxDynamicSharedMemorySize, LDS_BYTES) != hipSuccess) { fprintf(stderr, "kernel_launch: hipFuncSetAttribute failed\n"); grid = -1; return; }
        if (hipOccupancyMaxActiveBlocksPerMultiprocessor(&per_cu, (const void*)fwd_kernel, NWAVES * 64, LDS_BYTES) != hipSuccess || per_cu < 1) fprintf(stderr, "kernel_launch: occupancy query reports %d\n", per_cu);
        (void)hipGetLastError();
        grid = cus;
    }
    if (grid < 0) return;
    (void)hipMemsetAsync((char*)d_ws + WS_CTL, 0, CTL_BYTES, stream);
    Args a{};
    for (int i = 0; i < N_IN; ++i) a.in[i] = (const float*)d_in[i];
    a.out = (float*)d_out; a.ws = (unsigned char*)d_ws;
#if MK_MULTI
    for (int p = 0; p < MK_LIMIT; ++p) { a.ph_lo = p; a.ph_hi = p + 1; hipLaunchKernelGGL(fwd_kernel, dim3(grid), dim3(NWAVES * 64), LDS_BYTES, stream, a); }
#else
    a.ph_lo = 0; a.ph_hi = MK_LIMIT; hipLaunchKernelGGL(fwd_kernel, dim3(grid), dim3(NWAVES * 64), LDS_BYTES, stream, a);
#endif
    const hipError_t le = hipPeekAtLastError();
    if (le != hipSuccess) fprintf(stderr, "kernel_launch: launch failed: %s\n", hipGetErrorName(le));
}
```

```cpp
#include <hip/hip_runtime.h>
#include <cstdio>
#include <cstdint>

#define GAS __attribute__((address_space(1)))
#define LAS __attribute__((address_space(3)))
typedef unsigned short bf16_t;
typedef short bf16x8 __attribute__((ext_vector_type(8)));
typedef short s16x4 __attribute__((ext_vector_type(4)));
typedef float f32x2 __attribute__((ext_vector_type(2)));
typedef float f32x4 __attribute__((ext_vector_type(4)));
typedef float f32x16 __attribute__((ext_vector_type(16)));
typedef unsigned u32x2 __attribute__((ext_vector_type(2)));
typedef unsigned u32x4 __attribute__((ext_vector_type(4)));

__device__ __forceinline__ float bf2f(unsigned b) { return __uint_as_float(b << 16); }
__device__ __forceinline__ unsigned f2bf(float f) { unsigned u = __float_as_uint(f); return (u + 0x7fffu + ((u >> 16) & 1u)) >> 16; }
__device__ __forceinline__ unsigned pk2(float lo, float hi) { return f2bf(lo) | (f2bf(hi) << 16); }
__device__ __forceinline__ unsigned cvt_pk_bf16(float lo, float hi) { unsigned r; asm volatile("v_cvt_pk_bf16_f32 %0, %1, %2" : "=v"(r) : "v"(lo), "v"(hi)); return r; }
typedef int v8i32 __attribute__((ext_vector_type(8)));
__device__ __forceinline__ unsigned pk4_fp8(float a, float b, float c, float d) { int w = 0; w = __builtin_amdgcn_cvt_pk_fp8_f32(a, b, w, false); w = __builtin_amdgcn_cvt_pk_fp8_f32(c, d, w, true); asm volatile("s_nop 1" : "+v"(w)); return (unsigned)w; }
__device__ __forceinline__ float wave_sum(float v) {
#pragma unroll
    for (int o = 1; o < 64; o <<= 1) v += __shfl_xor(v, o);
    return v;
}
__device__ __forceinline__ int fresh_lane() { int l; asm volatile("v_mbcnt_lo_u32_b32 %0, -1, 0\n\tv_mbcnt_hi_u32_b32 %0, -1, %0" : "=v"(l)); return l; }
__device__ __forceinline__ float fast_exp(float x) { return __builtin_amdgcn_exp2f(x * 1.4426950408889634f); }
__device__ __forceinline__ float fast_rcp(float x) { return __builtin_amdgcn_rcpf(x); }
__device__ __forceinline__ float silu_f(float x) { return x * fast_rcp(1.0f + fast_exp(-x)); }

#ifndef MK_WT
#define MK_WT 0
#endif
__device__ __forceinline__ void st16(void* p, u32x4 v) {
#if MK_WT
    asm volatile("global_store_dwordx4 %0, %1, off sc1\n\ts_nop 1" :: "v"(p), "v"(v) : "memory");
#else
    *(u32x4*)p = v;
#endif
}
__device__ __forceinline__ void st16f(void* p, f32x4 v) { st16(p, __builtin_bit_cast(u32x4, v)); }

namespace pg8 {
constexpr int BM = 256, BK = 64, HALF = 128, HTB = HALF * BK * 2, STAGE_BYTES = 8 * HTB, NXCD = 8, WGM = 8;
__host__ __device__ __forceinline__ int lds_byte(int r, int c) { const int st = (r >> 4) * 2 + (c >> 5), rr = r & 15, cc = c & 31, ob = rr * 64 + cc * 2; return st * 1024 + (ob ^ (((ob >> 9) & 1) << 5)); }
__host__ __device__ __forceinline__ void stage_rc(int b, int& R, int& C) { const int st = b / 1024, sb = b % 1024, swz = sb ^ (((sb >> 9) & 1) << 5); R = (st >> 1) * 16 + swz / 64; C = (st & 1) * 32 + (swz % 64) / 2; }
__host__ __device__ __forceinline__ int perm32(int rho) { const int n = rho >> 4, i = rho & 15; return 8 * (i >> 2) + 4 * n + (i & 3); }

struct Unit { int pm, pn, e, pl, po, kt0; };
struct Gemm { const bf16_t* A; const bf16_t* Bt; int nt  , N, K  ; size_t bstride; const int* list; int list_stride; const LAS int* cnt; };

struct StaticOrder {
    int nM, nN, nwg, G, c, dup;
    __device__ __forceinline__ void init(int nM_, int nN_, int G_, int c_, int dup_ = 1) { nM = nM_; nN = nN_; nwg = nM * nN; G = G_; c = c_; dup = dup_; }
    __device__ __forceinline__ bool next(int i, Unit& u) const {
        const long L = (long)i * G + c; if (L >= (long)nwg * dup) return false;
        int wgid = (int)L; if (dup > 1) wgid = (int)((unsigned)wgid % (unsigned)nwg); { const int q = nwg / NXCD, r = nwg % NXCD, xcd = wgid % NXCD, off = wgid / NXCD; wgid = (xcd < r ? xcd * (q + 1) : r * (q + 1) + (xcd - r) * q) + off; }
        const int nig = WGM * nN, gid = wgid / nig, fm = gid * WGM, gsz = (nM - fm) < WGM ? (nM - fm) : WGM;
        u.pm = fm + ((wgid % nig) % gsz); u.pn = (wgid % nig) / gsz; u.e = 0; u.pl = 0; u.po = u.pm; u.kt0 = 0; return true;
    }
};
struct MoeOrder {
    StaticOrder so; const LAS int* rb0;
    __device__ __forceinline__ bool next(int i, Unit& u) const {
        if (!so.next(i, u)) return false;
        int e = 0;
#pragma unroll
        for (int j = 1; j < 8; ++j) e = (u.pm >= rb0[j]) ? j : e;
        u.e = e; u.pl = u.pm - rb0[e]; u.po = u.pm; u.kt0 = 0; return true;
    }
};

__device__ __forceinline__ void moe_tail_params(int NRB, int& RBM, int& trb, int& S) { RBM = (NRB >> 6) << 6; trb = NRB - RBM; S = trb <= 16 ? 4 : trb <= 32 ? 2 : 1; }
struct MoeTailOrder {
    int RBM, trb, S, ntsub, G, c0, dup; const LAS int* rb0;
    __device__ __forceinline__ bool next(int i, Unit& u) const { int L = i * G + c0; const int n = trb * 4 * S; if (L >= n * dup) return false; if (dup > 1) L %= n;
        const int s = L % S, r = L / S; u.pn = r & 3; const int tb = r >> 2; u.pm = RBM + tb; u.po = s * trb + tb; u.kt0 = s * ntsub; u.pl = 0;
        int e = 0;
#pragma unroll
        for (int j = 1; j < 8; ++j) e = (u.pm >= rb0[j]) ? j : e;
        u.e = e; return true; }
};
struct LatOrder {
    StaticOrder so;
    __device__ __forceinline__ bool next(int i, Unit& u) const { if (!so.next(i, u)) return false; u.pm = (u.pm >> 4) * 17 + 1 + (u.pm & 15); u.po = u.pm; return true; }
};
struct CtxSplitOrder {
    int nN, S, ntsub, G, c0, dup;
    __device__ __forceinline__ bool next(int i, Unit& u) const { int L = i * G + c0; if (L >= 8 * nN * S * dup) return false; if (dup > 1) L %= 8 * nN * S;
        const int s = L % S, r = L / S; u.pn = r % nN; const int c = r / nN; u.pm = 17 * c; u.po = s * 8 + c; u.kt0 = s * ntsub; u.e = 0; u.pl = 0; return true; }
};

struct EpiF32 {
    static constexpr bool PERM = false;
    float* C; int ldc;
    __device__ __forceinline__ void operator()(const f32x4 (&acc)[2][2][4][2], const Unit& u, int wr, int wc, int fr, int fq) const {
        const int row0 = u.po * BM + wr * 64 + fr, col0 = u.pn * BM + wc * 32 + 4 * fq;
#pragma unroll
        for (int ai = 0; ai < 2; ++ai)
#pragma unroll
            for (int m = 0; m < 4; ++m) { float* rowp = C + (size_t)(row0 + ai * HALF + m * 16) * ldc + col0;
#pragma unroll
                for (int bj = 0; bj < 2; ++bj)
#pragma unroll
                    for (int n = 0; n < 2; ++n) st16f(rowp + bj * HALF + n * 16, acc[ai][bj][m][n]); }
    }
};
struct EpiBf16 {
    static constexpr bool PERM = true;
    bf16_t* O; int ldc;
    __device__ __forceinline__ void operator()(const f32x4 (&acc)[2][2][4][2], const Unit& u, int wr, int wc, int fr, int fq) const {
        const int row0 = u.po * BM + wr * 64 + fr, col0 = u.pn * BM + wc * 32 + 8 * fq;
#pragma unroll
        for (int ai = 0; ai < 2; ++ai)
#pragma unroll
            for (int m = 0; m < 4; ++m) { bf16_t* rowp = O + (size_t)(row0 + ai * HALF + m * 16) * ldc + col0;
#pragma unroll
                for (int bj = 0; bj < 2; ++bj) { const f32x4 v0 = acc[ai][bj][m][0], v1 = acc[ai][bj][m][1];
                    u32x4 w; w.x = cvt_pk_bf16(v0[0], v0[1]); w.y = cvt_pk_bf16(v0[2], v0[3]); w.z = cvt_pk_bf16(v1[0], v1[1]); w.w = cvt_pk_bf16(v1[2], v1[3]);
                    st16(rowp + bj * HALF, w); } }
    }
};
struct EpiSwiglu {
    static constexpr bool PERM = true;
    bf16_t* O; int ldc; float sc;
    __device__ __forceinline__ void operator()(const f32x4 (&acc)[2][2][4][2], const Unit& u, int wr, int wc, int fr, int fq) const {
        const int row0 = u.po * BM + wr * 64 + fr, col0 = u.pn * HALF + wc * 32 + 8 * fq;
        const float k1 = -1.4426950408889634f * sc, c2 = 1.0f / (sc * sc);
#pragma unroll
        for (int ai = 0; ai < 2; ++ai)
#pragma unroll
            for (int m = 0; m < 4; ++m) { bf16_t* rowp = O + (size_t)(row0 + ai * HALF + m * 16) * ldc + col0;
                float r[8];
#pragma unroll
                for (int n = 0; n < 2; ++n)
#pragma unroll
                    for (int j = 0; j < 4; ++j) { const float ag = acc[ai][0][m][n][j], au = acc[ai][1][m][n][j];
                        const float e = __builtin_amdgcn_exp2f(ag * k1); r[n * 4 + j] = (ag * au) * __builtin_amdgcn_rcpf(fmaf(e, c2, c2)); }
                u32x4 w; w.x = cvt_pk_bf16(r[0], r[1]); w.y = cvt_pk_bf16(r[2], r[3]); w.z = cvt_pk_bf16(r[4], r[5]); w.w = cvt_pk_bf16(r[6], r[7]);
                st16(rowp, w); }
    }
};
constexpr int HM_TPB = 4352;
struct EpiKV {
    static constexpr bool PERM = true;
    bf16_t* Kp; int ldk; bf16_t* Vp; int ldv;
    __device__ __forceinline__ void operator()(const f32x4 (&acc)[2][2][4][2], const Unit& u, int wr, int wc, int fr, int fq) const {
        const int row0 = u.po * BM + wr * 64 + fr, within = wc * 32 + 8 * fq, bb = u.po / 17;
#pragma unroll
        for (int ai = 0; ai < 2; ++ai)
#pragma unroll
            for (int m = 0; m < 4; ++m) { const size_t row = (size_t)(row0 + ai * HALF + m * 16);
#pragma unroll
                for (int bj = 0; bj < 2; ++bj) { const int head = u.pn * 2 + bj; const f32x4 v0 = acc[ai][bj][m][0], v1 = acc[ai][bj][m][1];
                    u32x4 w; w.x = cvt_pk_bf16(v0[0], v0[1]); w.y = cvt_pk_bf16(v0[2], v0[3]); w.z = cvt_pk_bf16(v1[0], v1[1]); w.w = cvt_pk_bf16(v1[2], v1[3]);
                    const size_t hrow = (size_t)(bb * 16 + head) * HM_TPB + (row - (size_t)bb * HM_TPB);
                    bf16_t* dst = (within < 64) ? (Kp + hrow * 96 + within) : (Vp + hrow * 64 + (within - 64));
                    st16(dst, w); } }
    }
};

struct EpiRopeD {
    static constexpr bool PERM = true;
    bf16_t* Qp; bf16_t* Kp; bf16_t* Vp; const float* rt; float qs;
    __device__ __forceinline__ void operator()(const f32x4 (&acc)[2][2][4][2], const Unit& u, int wr, int wc, int fr, int fq) const {
        const int row0 = u.po * BM + wr * 64 + fr, cw = wc * 32 + 8 * fq, bb = u.po / 17;
        if (u.pn >= 8) {
#pragma unroll
            for (int ai = 0; ai < 2; ++ai)
#pragma unroll
                for (int m = 0; m < 4; ++m) { const size_t prow = (size_t)(row0 + ai * HALF + m * 16) - (size_t)bb * HM_TPB;
#pragma unroll
                    for (int bj = 0; bj < 2; ++bj) { const f32x4 v0 = acc[ai][bj][m][0], v1 = acc[ai][bj][m][1];
                        u32x4 w; w.x = cvt_pk_bf16(v0[0], v0[1]); w.y = cvt_pk_bf16(v0[2], v0[3]); w.z = cvt_pk_bf16(v1[0], v1[1]); w.w = cvt_pk_bf16(v1[2], v1[3]);
                        const int vh = (u.pn - 8) * 2 + bj;
                        st16(Vp + ((size_t)(bb * 8 + vh) * HM_TPB + prow) * 128 + cw, w); } }
            return; }
        const bool isq = u.pn < 4; const float osc = isq ? qs : 1.0f;
        const int tb = u.pm % 17; const bool isctx = (tb == 0), colpart = (wc & 1) != 0, x2 = (fq & 2) != 0;
        const int f0 = 8 * (fq & 1);
#pragma unroll
        for (int ai = 0; ai < 2; ++ai)
#pragma unroll
            for (int m = 0; m < 4; ++m) {
                const int pos = colpart ? (16 * m + fr) : ((tb - 1) * 4 + 2 * ai + wr);
                f32x4 cs[4];
#pragma unroll
                for (int q = 0; q < 4; ++q) cs[q] = isctx ? (f32x4){1.f, 0.f, 1.f, 0.f} : *(const f32x4*)(rt + ((size_t)(isctx ? 0 : pos) * 32 + f0 + 2 * q) * 2);
                const size_t grow = (size_t)(row0 + ai * HALF + m * 16), prow = grow - (size_t)bb * HM_TPB;
#pragma unroll
                for (int bj = 0; bj < 2; ++bj) { float r[8];
#pragma unroll
                    for (int e = 0; e < 8; ++e) { const float x = acc[ai][bj][m][e >> 2][e & 3] * osc; const float xp = __shfl_xor(x, 32);
                        const float c = cs[e >> 1][2 * (e & 1)], sn = cs[e >> 1][2 * (e & 1) + 1];
                        r[e] = x2 ? (x * c + xp * sn) : (x * c - xp * sn); }
                    u32x4 w; w.x = cvt_pk_bf16(r[0], r[1]); w.y = cvt_pk_bf16(r[2], r[3]); w.z = cvt_pk_bf16(r[4], r[5]); w.w = cvt_pk_bf16(r[6], r[7]);
                    const int cc = cw + bj * HALF;
                    bf16_t* dst = isq ? Qp + grow * 1024 + u.pn * BM + cc : Kp + ((size_t)(bb * 16 + (u.pn - 4) * 4 + (cc >> 6)) * HM_TPB + prow) * 64 + (cc & 63);
                    st16(dst, w); } }
    }
};

struct EpiRopeB {
    static constexpr bool PERM = true;
    bf16_t* O; const float* rt; float qs;
    __device__ __forceinline__ void operator()(const f32x4 (&acc)[2][2][4][2], const Unit& u, int wr, int wc, int fr, int fq) const {
        const int row0 = u.po * BM + wr * 64 + fr, col0 = u.pn * BM + wc * 32 + 8 * fq;
        const int tb = u.pm % 17; const bool isctx = (tb == 0), colpart = (fq & 2) != 0, x2 = (fq & 1) != 0;
#pragma unroll
        for (int ai = 0; ai < 2; ++ai)
#pragma unroll
            for (int m = 0; m < 4; ++m) {
                const int pos = colpart ? (16 * m + fr) : ((tb - 1) * 4 + 2 * ai + wr);
                f32x4 cs[4];
#pragma unroll
                for (int q = 0; q < 4; ++q) cs[q] = isctx ? (f32x4){1.f, 0.f, 1.f, 0.f} : *(const f32x4*)(rt + ((size_t)(isctx ? 0 : pos) * 32 + 2 * q) * 2);
                bf16_t* rowp = O + (size_t)(row0 + ai * HALF + m * 16) * 1536 + col0;
#pragma unroll
                for (int bj = 0; bj < 2; ++bj) { const bool rope = ((u.pn * 8 + bj * 4 + wc) % 3) == 2;
                    float r[8];
#pragma unroll
                    for (int e = 0; e < 8; ++e) { const float x = acc[ai][bj][m][e >> 2][e & 3] * qs; const float xp = __shfl_xor(x, 16);
                        const float c = cs[e >> 1][2 * (e & 1)], sn = cs[e >> 1][2 * (e & 1) + 1];
                        r[e] = rope ? (x2 ? (x * c + xp * sn) : (x * c - xp * sn)) : x; }
                    u32x4 w; w.x = cvt_pk_bf16(r[0], r[1]); w.y = cvt_pk_bf16(r[2], r[3]); w.z = cvt_pk_bf16(r[4], r[5]); w.w = cvt_pk_bf16(r[6], r[7]);
                    st16(rowp + bj * HALF, w); } }
    }
};

struct EpiNormRopeC {
    static constexpr bool PERM = true;
    bf16_t* Qp; bf16_t* Kp; bf16_t* Vp; const float* qg; const float* kg; const float* rt; LAS float* xch; float qs;
    __device__ __forceinline__ void operator()(const f32x4 (&acc)[2][2][4][2], const Unit& u, int wr, int wc, int fr, int fq) const {
        const int row0 = u.po * BM + wr * 64 + fr, bb = u.po / 17;
        if (u.pn == 5) {
#pragma unroll
            for (int ai = 0; ai < 2; ++ai)
#pragma unroll
                for (int m = 0; m < 4; ++m) { const size_t prow = (size_t)(row0 + ai * HALF + m * 16) - (size_t)bb * HM_TPB;
#pragma unroll
                    for (int bj = 0; bj < 2; ++bj) { const f32x4 v0 = acc[ai][bj][m][0], v1 = acc[ai][bj][m][1];
                        u32x4 w; w.x = cvt_pk_bf16(v0[0], v0[1]); w.y = cvt_pk_bf16(v0[2], v0[3]); w.z = cvt_pk_bf16(v1[0], v1[1]); w.w = cvt_pk_bf16(v1[2], v1[3]);
                        st16(Vp + ((size_t)(bb * 2 + bj) * HM_TPB + prow) * 128 + wc * 32 + 8 * fq, w); } }
            asm volatile("s_waitcnt lgkmcnt(0)" ::: "memory"); __builtin_amdgcn_s_barrier(); asm volatile("" ::: "memory");
            return; }
#pragma unroll
        for (int ai = 0; ai < 2; ++ai)
#pragma unroll
            for (int m = 0; m < 4; ++m)
#pragma unroll
                for (int bj = 0; bj < 2; ++bj) { const f32x4 v0 = acc[ai][bj][m][0], v1 = acc[ai][bj][m][1];
                    float sq = (v0[0] * v0[0] + v0[1] * v0[1]) + (v0[2] * v0[2] + v0[3] * v0[3]) + (v1[0] * v1[0] + v1[1] * v1[1]) + (v1[2] * v1[2] + v1[3] * v1[3]);
                    sq += __shfl_xor(sq, 16); sq += __shfl_xor(sq, 32);
                    if (fq == 0) xch[((ai * HALF + wr * 64 + m * 16 + fr) * 2 + bj) * 4 + wc] = sq; }
        asm volatile("s_waitcnt lgkmcnt(0)" ::: "memory"); __builtin_amdgcn_s_barrier(); asm volatile("" ::: "memory");
        const bool isq = u.pn < 4; const float* gv = isq ? qg : kg;
        const int d0 = 64 * (wc >> 1) + 32 * (fq >> 1) + 16 * (wc & 1) + 8 * (fq & 1);
        const f32x4 ga = *(const f32x4*)(gv + d0), gb = *(const f32x4*)(gv + d0 + 4);
        const int tb = u.pm % 17; const bool isctx = (tb == 0), colpart = (wc >> 1) != 0, x2 = (fq >> 1) != 0;
        const int f0 = d0 & 31;
#pragma unroll
        for (int ai = 0; ai < 2; ++ai)
#pragma unroll
            for (int m = 0; m < 4; ++m) {
                const int pos = colpart ? (16 * m + fr) : ((tb - 1) * 4 + 2 * ai + wr);
                f32x4 cs[4];
#pragma unroll
                for (int q = 0; q < 4; ++q) cs[q] = isctx ? (f32x4){1.f, 0.f, 1.f, 0.f} : *(const f32x4*)(rt + ((size_t)(isctx ? 0 : pos) * 32 + f0 + 2 * q) * 2);
                const int rl = ai * HALF + wr * 64 + m * 16 + fr; const size_t row = (size_t)(row0 + ai * HALF + m * 16);
#pragma unroll
                for (int bj = 0; bj < 2; ++bj) { const f32x4 ps = *(const LAS f32x4*)(xch + (rl * 2 + bj) * 4);
                    const float rstd = rsqrtf(((ps[0] + ps[1]) + (ps[2] + ps[3])) * (1.0f / 128.0f) + 1e-6f) * (isq ? qs : 1.0f);
                    const int head = 2 * u.pn + bj; float r[8];
#pragma unroll
                    for (int e = 0; e < 8; ++e) { const float y = acc[ai][bj][m][e >> 2][e & 3] * rstd * (e < 4 ? ga[e] : gb[e - 4]); const float yp = __shfl_xor(y, 32);
                        const float c = cs[e >> 1][2 * (e & 1)], sn = cs[e >> 1][2 * (e & 1) + 1];
                        r[e] = x2 ? (y * c + yp * sn) : (y * c - yp * sn); }
                    u32x4 w; w.x = cvt_pk_bf16(r[0], r[1]); w.y = cvt_pk_bf16(r[2], r[3]); w.z = cvt_pk_bf16(r[4], r[5]); w.w = cvt_pk_bf16(r[6], r[7]);
                    bf16_t* dst = isq ? Qp + row * 1024 + head * 128 + d0 : Kp + ((size_t)(bb * 2 + (head - 8)) * HM_TPB + (row - (size_t)bb * HM_TPB)) * 128 + d0;
                    st16(dst, w); } }
    }
};

template <class Epi, class Sched, bool GATHER, bool FP8 = false>
__device__ __forceinline__ void gemm_phase(LAS unsigned char* lds, const Gemm g, const Sched& S, const Epi& E, const int wid) {
    const int lane = fresh_lane(), tid = wid * 64 + lane, wr = wid >> 2, wc = wid & 3, fr = lane & 15, fq = lane >> 4;
    const int K = g.K, nt = g.nt;
    unsigned voffA[2], voffB[2];
#pragma unroll
    for (int i = 0; i < 2; ++i) { int R, C; stage_rc(tid * 16 + i * 8192, R, C); const int Rb = Epi::PERM ? ((R & ~31) + perm32(R & 31)) : R;
        voffA[i] = (unsigned)(R * K + C) * 2u; voffB[i] = (unsigned)(Rb * K + C) * 2u; }
    const size_t kstep = (size_t)(BK * 2);
    const size_t hstep = (size_t)HALF * K * 2;
    const size_t tstep = 2 * hstep;
    const unsigned ldsw = (unsigned)wid * 1024u;
    const int aoff = lds_byte(wr * 64 + fr, fq * 8), boff = lds_byte(wc * 32 + fr, fq * 8);
#define PG8_SA(b, h) (((b) * 2 + (h)) * HTB)
#define PG8_SB(b, h) ((4 + (b) * 2 + (h)) * HTB)
#define PG8_STAGE(bufoff, gbase, voff) do { _Pragma("unroll") for (int _i = 0; _i < 2; ++_i) \
        __builtin_amdgcn_global_load_lds((const unsigned*)((const char*)(gbase) + (voff)[_i]), (LAS unsigned*)(lds + (bufoff) + ldsw + _i * 8192), 16, 0, 0); } while (0)
#define PG8_STAGE_A(bufoff, Ap, G, h, kb) do { if constexpr (GATHER) { PG8_STAGE(bufoff, (const char*)g.A + (kb), (G)[h]); } else { PG8_STAGE(bufoff, (Ap) + (size_t)(h) * hstep + (kb), voffA); } } while (0)
#define PG8_LD16(off) (*(const LAS u32x4*)(lds + (off)))
#define PG8_LDA(dst, b, h) do { _Pragma("unroll") for (int m = 0; m < 4; ++m) { if constexpr (FP8) { dst##8[m] = __builtin_bit_cast(v8i32, __builtin_shufflevector(PG8_LD16(PG8_SA(b, h) + aoff + m * 2048), PG8_LD16(PG8_SA(b, h) + aoff + m * 2048 + 1024), 0, 1, 2, 3, 4, 5, 6, 7)); } \
        else { _Pragma("unroll") for (int k = 0; k < 2; ++k) dst[m][k] = *(const LAS bf16x8*)(lds + PG8_SA(b, h) + aoff + m * 2048 + k * 1024); } } } while (0)
#define PG8_LDB(dst, b, h) do { _Pragma("unroll") for (int n = 0; n < 2; ++n) { if constexpr (FP8) { dst##8[n] = __builtin_bit_cast(v8i32, __builtin_shufflevector(PG8_LD16(PG8_SB(b, h) + boff + n * 2048), PG8_LD16(PG8_SB(b, h) + boff + n * 2048 + 1024), 0, 1, 2, 3, 4, 5, 6, 7)); } \
        else { _Pragma("unroll") for (int k = 0; k < 2; ++k) dst[n][k] = *(const LAS bf16x8*)(lds + PG8_SB(b, h) + boff + n * 2048 + k * 1024); } } } while (0)
#define PG8_MMA(ai, bj, At, Bt) do { __builtin_amdgcn_s_setprio(1); _Pragma("unroll") for (int m = 0; m < 4; ++m) _Pragma("unroll") for (int n = 0; n < 2; ++n) { \
        if constexpr (FP8) { asm volatile("v_mfma_scale_f32_16x16x128_f8f6f4 %0, %1, %2, %0, %3, %3 op_sel_hi:[0,0,0]" : "+v"(acc[ai][bj][m][n]) : "v"(Bt##8[n]), "v"(At##8[m]), "v"(sc7f)); } \
        else { _Pragma("unroll") for (int k = 0; k < 2; ++k) acc[ai][bj][m][n] = __builtin_amdgcn_mfma_f32_16x16x32_bf16(Bt[n][k], At[m][k], acc[ai][bj][m][n], 0, 0, 0); } } \
        __builtin_amdgcn_s_setprio(0); } while (0)
#define PG8_WAIT_V(n) asm volatile("s_waitcnt vmcnt(" #n ")" ::: "memory")
#define PG8_WAIT_L(n) asm volatile("s_waitcnt lgkmcnt(" #n ")" ::: "memory")
#define PG8_BAR __builtin_amdgcn_s_barrier()
#define PG8_SCHED __builtin_amdgcn_sched_barrier(0)
    LAS unsigned char* tokt = lds + STAGE_BYTES;
#define PG8_TOKDMA(u, slot) do { if constexpr (GATHER) { if (wid < 4) { const unsigned _cn = (unsigned)g.cnt[(u).e]; const unsigned _s = (unsigned)((u).pl * BM + tid); \
        __builtin_amdgcn_global_load_lds((const unsigned*)(g.list + (size_t)(u).e * g.list_stride + (_s < _cn ? _s : _cn - 1u)), (LAS unsigned*)(tokt + (slot) * 1024 + wid * 256), 4, 0, 0); } } } while (0)
#define PG8_GOFFS(go, slot) do { if constexpr (GATHER) { \
        _Pragma("unroll") for (int _h = 0; _h < 2; ++_h) _Pragma("unroll") for (int _i = 0; _i < 2; ++_i) { int _R, _C; stage_rc(tid * 16 + _i * 8192, _R, _C); \
            const unsigned _t = *(const LAS unsigned*)(tokt + (slot) * 1024 + (_h * HALF + _R) * 4); (go)[_h][_i] = (_t * (unsigned)K + (unsigned)_C) * 2u; } } } while (0)
    Unit cur, nxt; int ui = 0;
    if (!S.next(0, cur)) return;
    f32x4 acc[2][2][4][2];
#pragma unroll
    for (int a = 0; a < 2; ++a)
#pragma unroll
        for (int b = 0; b < 2; ++b)
#pragma unroll
            for (int m = 0; m < 4; ++m)
#pragma unroll
                for (int n = 0; n < 2; ++n) acc[a][b][m][n] = (f32x4){0.f, 0.f, 0.f, 0.f};
    const unsigned sc7f = 0x7F7F7F7Fu;
    bf16x8 At[4][2], B0[2][2], B1[2][2]; v8i32 At8[4], B08[2], B18[2];
    unsigned gcur[2][2] = {{0u, 0u}, {0u, 0u}};
    const char* cA = (const char*)g.A + (size_t)cur.pm * tstep + (size_t)cur.kt0 * kstep; const char* cB = (const char*)g.Bt + ((size_t)cur.e * g.bstride) * 2 + (size_t)cur.pn * tstep + (size_t)cur.kt0 * kstep;
    if constexpr (GATHER) { PG8_TOKDMA(cur, 0); asm volatile("s_waitcnt vmcnt(0)" ::: "memory"); __builtin_amdgcn_s_barrier(); asm volatile("" ::: "memory"); }
    PG8_GOFFS(gcur, 0);
    PG8_STAGE(PG8_SB(0, 0), cB, voffB); PG8_STAGE(PG8_SB(0, 1), cB + hstep, voffB); PG8_STAGE_A(PG8_SA(0, 0), cA, gcur, 0, 0); PG8_STAGE_A(PG8_SA(0, 1), cA, gcur, 1, 0);
    if (wr == 1) PG8_BAR;
    PG8_WAIT_V(2); PG8_BAR;
    PG8_STAGE(PG8_SB(1, 0), cB + kstep, voffB); PG8_STAGE_A(PG8_SA(1, 0), cA, gcur, 0, kstep); PG8_STAGE(PG8_SB(1, 1), cB + hstep + kstep, voffB);
    PG8_WAIT_V(6); PG8_BAR;
    for (;;) {
        const bool has_next = S.next(ui + 1, nxt);
        if constexpr (GATHER) { if (has_next) PG8_TOKDMA(nxt, (ui + 1) & 1); }
        const char* nA = has_next ? (const char*)g.A + (size_t)nxt.pm * tstep + (size_t)nxt.kt0 * kstep : cA; const char* nB = has_next ? (const char*)g.Bt + ((size_t)nxt.e * g.bstride) * 2 + (size_t)nxt.pn * tstep + (size_t)nxt.kt0 * kstep : cB;
#pragma unroll 1
        for (int t = 0; t < nt; t += 2) {
            const bool last = (t == nt - 2);
            const size_t kb1 = (size_t)(t + 1) * kstep;
            const char* a2p = last ? nA : cA; const size_t kb2 = last ? (size_t)0 : (size_t)(t + 2) * kstep;
            const char* b2 = last ? nB : cB + (size_t)(t + 2) * kstep;
            const size_t kb3 = kb2 + kstep; const char* b3 = b2 + kstep;
            PG8_LDB(B0, 0, 0); PG8_LDB(B1, 0, 1); PG8_SCHED; PG8_LDA(At, 0, 0); PG8_STAGE_A(PG8_SA(1, 1), cA, gcur, 1, kb1);
            if constexpr (GATHER) { if (last && has_next) { PG8_GOFFS(gcur, (ui + 1) & 1); } }
            PG8_WAIT_V(8); PG8_WAIT_L(0); PG8_BAR; PG8_MMA(0, 0, At, B0); PG8_MMA(0, 1, At, B1); PG8_BAR; PG8_SCHED;
            PG8_LDA(At, 0, 1); PG8_STAGE(PG8_SB(0, 0), b2, voffB); PG8_STAGE(PG8_SB(0, 1), b2 + hstep, voffB); PG8_STAGE_A(PG8_SA(0, 0), a2p, gcur, 0, kb2);
            PG8_WAIT_V(8); PG8_WAIT_L(0); PG8_BAR; PG8_MMA(1, 0, At, B0); PG8_MMA(1, 1, At, B1); PG8_BAR; PG8_SCHED;
            PG8_LDB(B0, 1, 0); PG8_LDB(B1, 1, 1); PG8_SCHED; PG8_LDA(At, 1, 0); PG8_STAGE_A(PG8_SA(0, 1), a2p, gcur, 1, kb2);
            PG8_WAIT_V(8); PG8_WAIT_L(0); PG8_BAR; PG8_MMA(0, 0, At, B0); PG8_MMA(0, 1, At, B1); PG8_BAR; PG8_SCHED;
            PG8_LDA(At, 1, 1); PG8_STAGE(PG8_SB(1, 0), b3, voffB); PG8_STAGE(PG8_SB(1, 1), b3 + hstep, voffB); PG8_STAGE_A(PG8_SA(1, 0), a2p, gcur, 0, kb3);
            PG8_WAIT_V(8); PG8_WAIT_L(0); PG8_BAR; PG8_MMA(1, 0, At, B0); PG8_MMA(1, 1, At, B1); PG8_BAR; PG8_SCHED;
        }
        if (wr == 0) PG8_BAR;
        if constexpr (FP8) asm volatile("s_nop 15\n\ts_nop 15\n\ts_nop 15\n\ts_nop 15" ::: "memory");
        E(acc, cur, wr, wc, fr, fq);
        if (!has_next) break;
#pragma unroll
        for (int a = 0; a < 2; ++a)
#pragma unroll
            for (int b = 0; b < 2; ++b)
#pragma unroll
                for (int m = 0; m < 4; ++m)
#pragma unroll
                    for (int n = 0; n < 2; ++n) acc[a][b][m][n] = (f32x4){0.f, 0.f, 0.f, 0.f};
        cur = nxt; cA = nA; cB = nB; ++ui;
        if (wr == 1) PG8_BAR;
    }
    PG8_WAIT_V(0);
    PG8_BAR;
#undef PG8_SA
#undef PG8_SB
#undef PG8_STAGE
#undef PG8_STAGE_A
#undef PG8_LDA
#undef PG8_LDB
#undef PG8_MMA
#undef PG8_LD16
#undef PG8_WAIT_V
#undef PG8_WAIT_L
#undef PG8_BAR
#undef PG8_SCHED
#undef PG8_GOFFS
#undef PG8_TOKDMA
}
}
namespace att {
constexpr int NW = 8, QBLK = 32, KVBLK = 64;
constexpr float THR = 8.f;
#define ATT_SBAR() __builtin_amdgcn_sched_barrier(0)
template <int DK> __device__ __forceinline__ int kswz(int row, int colB) { return row * (DK * 2 + 16) + colB; }
__device__ __forceinline__ int crow(int r, int hi) { return (r & 3) + 8 * (r >> 2) + 4 * hi; }
__device__ __forceinline__ void partialSM(f32x16& p0, f32x16& p1, float& m_reg, float& mn, float& alpha, const float C, const float thr_raw) {
    float pmax = p0[0];
#pragma unroll
    for (int r = 1; r < 16; ++r) pmax = fmaxf(pmax, p0[r]);
#pragma unroll
    for (int r = 0; r < 16; ++r) pmax = fmaxf(pmax, p1[r]);
    { auto rr = __builtin_amdgcn_permlane32_swap(__float_as_uint(pmax), __float_as_uint(pmax), false, false);
      pmax = fmaxf(__uint_as_float(rr[0]), __uint_as_float(rr[1])); }
    if (__builtin_expect(__all(pmax - m_reg <= thr_raw), 1)) { mn = m_reg; alpha = 1.f; }
    else { mn = fmaxf(m_reg, pmax); alpha = __builtin_amdgcn_exp2f((m_reg - mn) * C); m_reg = mn; }
    const float mnC = -mn * C;
#pragma unroll
    for (int r = 0; r < 16; ++r) p0[r] = fmaf(p0[r], C, mnC);
#pragma unroll
    for (int r = 0; r < 16; ++r) p1[r] = fmaf(p1[r], C, mnC);
#pragma unroll
    for (int r = 0; r < 16; ++r) p0[r] = __builtin_amdgcn_exp2f(p0[r]);
}
__device__ __forceinline__ void finishSM(f32x16& p0, f32x16& p1, float alpha, float& l_reg, bf16x8& pa0, bf16x8& pa1, bf16x8& pa2, bf16x8& pa3) {
#pragma unroll
    for (int r = 0; r < 16; ++r) p1[r] = __builtin_amdgcn_exp2f(p1[r]);
#if MK_PROBE_ATT == 2
    { float dz = 0.f;
#pragma unroll
      for (int r = 0; r < 16; ++r) { dz += __builtin_amdgcn_exp2f(p0[r] - 1.0f); dz += __builtin_amdgcn_exp2f(p1[r] - 2.0f); }
      asm volatile("" :: "v"(dz)); }
#endif
    float ps = 0;
#pragma unroll
    for (int r = 0; r < 16; ++r) ps += p0[r];
#pragma unroll
    for (int r = 0; r < 16; ++r) ps += p1[r];
    { auto rr = __builtin_amdgcn_permlane32_swap(__float_as_uint(ps), __float_as_uint(ps), false, false);
      ps = __uint_as_float(rr[0]) + __uint_as_float(rr[1]); }
    l_reg = l_reg * alpha + ps;
#define ATT_PK4(P, BASE, OUT) do { unsigned a0 = cvt_pk_bf16(P[BASE + 0], P[BASE + 1]), a1 = cvt_pk_bf16(P[BASE + 2], P[BASE + 3]);   \
    unsigned b0 = cvt_pk_bf16(P[BASE + 4], P[BASE + 5]), b1 = cvt_pk_bf16(P[BASE + 6], P[BASE + 7]);                              \
    auto r0 = __builtin_amdgcn_permlane32_swap(a0, b0, false, false); auto r1 = __builtin_amdgcn_permlane32_swap(a1, b1, false, false); \
    u32x4 w = {r0[0], r1[0], r0[1], r1[1]}; OUT = *reinterpret_cast<bf16x8*>(&w); } while (0)
    ATT_PK4(p0, 0, pa0); ATT_PK4(p0, 8, pa1); ATT_PK4(p1, 0, pa2); ATT_PK4(p1, 8, pa3);
#undef ATT_PK4
}
#ifndef MK_PROBE_ATT
#define MK_PROBE_ATT 0
#endif
template <int DK> __device__ __forceinline__ void qkt(f32x16& p0, f32x16& p1, const char* Ks, const bf16x8* qr, int r32, int hi) {
    p0 = f32x16{}; p1 = f32x16{};
#if MK_PROBE_ATT == 1
    f32x16 d0_ = f32x16{}; d0_[0] = 1.0f;
#endif
#pragma unroll
    for (int d0 = 0; d0 < DK / 16; ++d0) { const int cb = (d0 * 16 + hi * 8) * 2;
        const bf16x8 b0 = *reinterpret_cast<const bf16x8*>(Ks + kswz<DK>(r32, cb));
        const bf16x8 b1 = *reinterpret_cast<const bf16x8*>(Ks + kswz<DK>(32 + r32, cb));
        p0 = __builtin_amdgcn_mfma_f32_32x32x16_bf16(b0, qr[d0], p0, 0, 0, 0);
        p1 = __builtin_amdgcn_mfma_f32_32x32x16_bf16(b1, qr[d0], p1, 0, 0, 0);
#if MK_PROBE_ATT == 1
        d0_ = __builtin_amdgcn_mfma_f32_32x32x16_bf16(b0, qr[d0], d0_, 0, 0, 0);
        d0_ = __builtin_amdgcn_mfma_f32_32x32x16_bf16(b1, qr[d0], d0_, 0, 0, 0);
#endif
    }
#if MK_PROBE_ATT == 1
    asm volatile("" :: "v"(d0_));
#endif
}
template <int DV> __device__ __forceinline__ int v_st_nat(int k, int c) { return ((k >> 3) * (DV / 32) + (c >> 5)) * 512 + ((k & 7) * 32 + (c & 31)) * 2; }
template <int DV> __device__ __forceinline__ int v_st(int k, int c) { const int kk = (k & ~0xC) | ((k & 4) << 1) | ((k & 8) >> 1); return ((kk >> 3) * (DV / 32) + (c >> 5)) * 512 + ((kk & 7) * 32 + (c & 31)) * 2; }
__device__ __forceinline__ int v_rd_base(int lane) { return ((lane & 3) << 3) | (((lane >> 2) & 3) << 6) | (((lane >> 4) & 1) << 5) | (((lane >> 5) & 1) << 8); }
template <int DV> constexpr int v_rd_off(int d0, int ks, int half) { return d0 * 512 + ks * (DV / 32) * 1024 + half * (DV / 32) * 512; }
template <int OFF> __device__ __forceinline__ s16x4 tr_read(int vb) {
    s16x4 r; asm volatile("ds_read_b64_tr_b16 %0, %1 offset:%2" : "=&v"(r) : "v"(vb), "i"(OFF) : "memory"); return r;
}
template <int DV, int D0> __device__ __forceinline__ void pv_one(f32x16& od, int vb, bf16x8 pa0, bf16x8 pa1, bf16x8 pa2, bf16x8 pa3) {
    const s16x4 l0 = tr_read<v_rd_off<DV>(D0, 0, 0)>(vb), h0 = tr_read<v_rd_off<DV>(D0, 0, 1)>(vb), l1 = tr_read<v_rd_off<DV>(D0, 1, 0)>(vb), h1 = tr_read<v_rd_off<DV>(D0, 1, 1)>(vb);
    const s16x4 l2 = tr_read<v_rd_off<DV>(D0, 2, 0)>(vb), h2 = tr_read<v_rd_off<DV>(D0, 2, 1)>(vb), l3 = tr_read<v_rd_off<DV>(D0, 3, 0)>(vb), h3 = tr_read<v_rd_off<DV>(D0, 3, 1)>(vb);
    asm volatile("s_waitcnt lgkmcnt(0)" ::: "memory"); ATT_SBAR();
#define ATT_PK(L, H) (bf16x8){L[0], L[1], L[2], L[3], H[0], H[1], H[2], H[3]}
    od = __builtin_amdgcn_mfma_f32_32x32x16_bf16(pa0, ATT_PK(l0, h0), od, 0, 0, 0);
    od = __builtin_amdgcn_mfma_f32_32x32x16_bf16(pa1, ATT_PK(l1, h1), od, 0, 0, 0);
    od = __builtin_amdgcn_mfma_f32_32x32x16_bf16(pa2, ATT_PK(l2, h2), od, 0, 0, 0);
    od = __builtin_amdgcn_mfma_f32_32x32x16_bf16(pa3, ATT_PK(l3, h3), od, 0, 0, 0);
#undef ATT_PK
}
template <int DV, int D0> __device__ __forceinline__ void pv_two(f32x16& oa, f32x16& ob, int vb, bf16x8 pa0, bf16x8 pa1, bf16x8 pa2, bf16x8 pa3) {
    const s16x4 l0 = tr_read<v_rd_off<DV>(D0, 0, 0)>(vb), h0 = tr_read<v_rd_off<DV>(D0, 0, 1)>(vb), l1 = tr_read<v_rd_off<DV>(D0, 1, 0)>(vb), h1 = tr_read<v_rd_off<DV>(D0, 1, 1)>(vb);
    const s16x4 l2 = tr_read<v_rd_off<DV>(D0, 2, 0)>(vb), h2 = tr_read<v_rd_off<DV>(D0, 2, 1)>(vb), l3 = tr_read<v_rd_off<DV>(D0, 3, 0)>(vb), h3 = tr_read<v_rd_off<DV>(D0, 3, 1)>(vb);
    const s16x4 m0 = tr_read<v_rd_off<DV>(D0 + 1, 0, 0)>(vb), n0 = tr_read<v_rd_off<DV>(D0 + 1, 0, 1)>(vb), m1 = tr_read<v_rd_off<DV>(D0 + 1, 1, 0)>(vb), n1 = tr_read<v_rd_off<DV>(D0 + 1, 1, 1)>(vb);
    const s16x4 m2 = tr_read<v_rd_off<DV>(D0 + 1, 2, 0)>(vb), n2 = tr_read<v_rd_off<DV>(D0 + 1, 2, 1)>(vb), m3 = tr_read<v_rd_off<DV>(D0 + 1, 3, 0)>(vb), n3 = tr_read<v_rd_off<DV>(D0 + 1, 3, 1)>(vb);
    asm volatile("s_waitcnt lgkmcnt(0)" ::: "memory"); ATT_SBAR();
#define ATT_PK(L, H) (bf16x8){L[0], L[1], L[2], L[3], H[0], H[1], H[2], H[3]}
    oa = __builtin_amdgcn_mfma_f32_32x32x16_bf16(pa0, ATT_PK(l0, h0), oa, 0, 0, 0);
    ob = __builtin_amdgcn_mfma_f32_32x32x16_bf16(pa0, ATT_PK(m0, n0), ob, 0, 0, 0);
    oa = __builtin_amdgcn_mfma_f32_32x32x16_bf16(pa1, ATT_PK(l1, h1), oa, 0, 0, 0);
    ob = __builtin_amdgcn_mfma_f32_32x32x16_bf16(pa1, ATT_PK(m1, n1), ob, 0, 0, 0);
    oa = __builtin_amdgcn_mfma_f32_32x32x16_bf16(pa2, ATT_PK(l2, h2), oa, 0, 0, 0);
    ob = __builtin_amdgcn_mfma_f32_32x32x16_bf16(pa2, ATT_PK(m2, n2), ob, 0, 0, 0);
    oa = __builtin_amdgcn_mfma_f32_32x32x16_bf16(pa3, ATT_PK(l3, h3), oa, 0, 0, 0);
    ob = __builtin_amdgcn_mfma_f32_32x32x16_bf16(pa3, ATT_PK(m3, n3), ob, 0, 0, 0);
#undef ATT_PK
}
struct VFrag64 { s16x4 l[2][4], h[2][4]; };
template <int DV> __device__ __forceinline__ void pv_issue(VFrag64& f, int vb) {
    f.l[0][0] = tr_read<v_rd_off<DV>(0, 0, 0)>(vb); f.h[0][0] = tr_read<v_rd_off<DV>(0, 0, 1)>(vb); f.l[0][1] = tr_read<v_rd_off<DV>(0, 1, 0)>(vb); f.h[0][1] = tr_read<v_rd_off<DV>(0, 1, 1)>(vb);
    f.l[0][2] = tr_read<v_rd_off<DV>(0, 2, 0)>(vb); f.h[0][2] = tr_read<v_rd_off<DV>(0, 2, 1)>(vb); f.l[0][3] = tr_read<v_rd_off<DV>(0, 3, 0)>(vb); f.h[0][3] = tr_read<v_rd_off<DV>(0, 3, 1)>(vb);
    f.l[1][0] = tr_read<v_rd_off<DV>(1, 0, 0)>(vb); f.h[1][0] = tr_read<v_rd_off<DV>(1, 0, 1)>(vb); f.l[1][1] = tr_read<v_rd_off<DV>(1, 1, 0)>(vb); f.h[1][1] = tr_read<v_rd_off<DV>(1, 1, 1)>(vb);
    f.l[1][2] = tr_read<v_rd_off<DV>(1, 2, 0)>(vb); f.h[1][2] = tr_read<v_rd_off<DV>(1, 2, 1)>(vb); f.l[1][3] = tr_read<v_rd_off<DV>(1, 3, 0)>(vb); f.h[1][3] = tr_read<v_rd_off<DV>(1, 3, 1)>(vb);
}
__device__ __forceinline__ void pv_mma64(f32x16* o, const VFrag64& f, bf16x8 pa0, bf16x8 pa1, bf16x8 pa2, bf16x8 pa3) {
    asm volatile("s_waitcnt lgkmcnt(0)" ::: "memory"); ATT_SBAR();
#define ATT_PK(L, H) (bf16x8){L[0], L[1], L[2], L[3], H[0], H[1], H[2], H[3]}
    o[0] = __builtin_amdgcn_mfma_f32_32x32x16_bf16(pa0, ATT_PK(f.l[0][0], f.h[0][0]), o[0], 0, 0, 0);
    o[1] = __builtin_amdgcn_mfma_f32_32x32x16_bf16(pa0, ATT_PK(f.l[1][0], f.h[1][0]), o[1], 0, 0, 0);
    o[0] = __builtin_amdgcn_mfma_f32_32x32x16_bf16(pa1, ATT_PK(f.l[0][1], f.h[0][1]), o[0], 0, 0, 0);
    o[1] = __builtin_amdgcn_mfma_f32_32x32x16_bf16(pa1, ATT_PK(f.l[1][1], f.h[1][1]), o[1], 0, 0, 0);
    o[0] = __builtin_amdgcn_mfma_f32_32x32x16_bf16(pa2, ATT_PK(f.l[0][2], f.h[0][2]), o[0], 0, 0, 0);
    o[1] = __builtin_amdgcn_mfma_f32_32x32x16_bf16(pa2, ATT_PK(f.l[1][2], f.h[1][2]), o[1], 0, 0, 0);
    o[0] = __builtin_amdgcn_mfma_f32_32x32x16_bf16(pa3, ATT_PK(f.l[0][3], f.h[0][3]), o[0], 0, 0, 0);
    o[1] = __builtin_amdgcn_mfma_f32_32x32x16_bf16(pa3, ATT_PK(f.l[1][3], f.h[1][3]), o[1], 0, 0, 0);
#undef ATT_PK
}
#ifndef MK_PV2
#define MK_PV2 1
#endif
#ifndef MK_VPRE
#define MK_VPRE 0
#endif
#ifndef MK_MBLK
#define MK_MBLK 1
#endif
#ifndef MK_ATT_PRIO
#define MK_ATT_PRIO 1
#endif
template <int DV> __device__ __forceinline__ void pv_d0(f32x16* o, int vb, bf16x8 pa0, bf16x8 pa1, bf16x8 pa2, bf16x8 pa3) {
#if MK_PV2
    pv_two<DV, 0>(o[0], o[1], vb, pa0, pa1, pa2, pa3);
    if constexpr (DV == 128) pv_two<DV, 2>(o[2], o[3], vb, pa0, pa1, pa2, pa3);
#else
    pv_one<DV, 0>(o[0], vb, pa0, pa1, pa2, pa3); pv_one<DV, 1>(o[1], vb, pa0, pa1, pa2, pa3);
    if constexpr (DV == 128) { pv_one<DV, 2>(o[2], vb, pa0, pa1, pa2, pa3); pv_one<DV, 3>(o[3], vb, pa0, pa1, pa2, pa3); }
#endif
}
template <int DK, int DV> constexpr int lds_bytes() { return 3 * KVBLK * DV * 2 + 3 * KVBLK * (DK * 2 + 16) + NW * 64 * 4; }

template <int DK, int DV, int ldq, int ldk, int ldv, int ldo, int SD, int EPI = 0>
__device__ __forceinline__ void attn_unit(const bf16_t* __restrict__ Qb, const bf16_t* __restrict__ Kh, const bf16_t* __restrict__ Vh,
                                          bf16_t* __restrict__ Ob, int seq, const float C, const float thr_raw, char* lds, const int wid, LAS unsigned* stash = nullptr, float lam = 0.f, const float* gvec = nullptr) {
    constexpr int SHM_V = KVBLK * DV * 2, SHM_K = KVBLK * (DK * 2 + 16);
    constexpr int NO = DV / 32, ND = DK / 16;
    const int lane = fresh_lane(), tid = wid * 64 + lane, r32 = lane & 31, hi = lane >> 5;
    char* V_lds = lds; char* K_lds = lds + 3 * SHM_V;
    float* wsf = (float*)(lds + 3 * SHM_V + 3 * SHM_K) + wid * 64; float* li_l = wsf; float* al_l = wsf + 32;
    float m_reg = -1e30f, l_reg = 0; f32x16 o[NO]; bf16x8 qr[ND];
#pragma unroll
    for (int d = 0; d < NO; ++d) o[d] = f32x16{};
    const bf16_t* Qw = Qb + (long)(wid * QBLK + r32) * ldq + hi * 8;
#pragma unroll
    for (int d0 = 0; d0 < ND; ++d0) qr[d0] = *reinterpret_cast<const bf16x8*>(Qw + d0 * 16);
    const int sr = tid >> 4, sc = (tid & 15) * 8; const bool kact = (DK == 128) ? true : (sc < DK), vact = (DV == 128) ? true : (sc < DV);
    const int vst0 = v_st<DV>(sr, vact ? sc : 0), vst1 = v_st<DV>(32 + sr, vact ? sc : 0);
    const int vb0 = (int)(uintptr_t)V_lds + v_rd_base(lane);
    const unsigned koff = (unsigned)(sr * ldk + sc) * 2u, voff = (unsigned)(sr * ldv + sc) * 2u;
    const size_t k32 = (size_t)32 * ldk * 2, v32 = (size_t)32 * ldv * 2;
    struct { bf16x8 vs0, vs1, ks0, ks1; } sr_[SD];
#define ATT_SLOAD(s, k0) do { const char* _kt = (const char*)Kh + (size_t)(k0) * ldk * 2; const char* _vt = (const char*)Vh + (size_t)(k0) * ldv * 2; \
    if (vact) { sr_[s].vs0 = *reinterpret_cast<const bf16x8*>(_vt + voff); sr_[s].vs1 = *reinterpret_cast<const bf16x8*>(_vt + v32 + voff); } \
    if (kact) { sr_[s].ks0 = *reinterpret_cast<const bf16x8*>(_kt + koff); sr_[s].ks1 = *reinterpret_cast<const bf16x8*>(_kt + k32 + koff); } } while (0)
#define ATT_SWRITE(b, s) do { if (vact) { *(bf16x8*)(V_lds + (b) * SHM_V + vst0) = sr_[s].vs0; *(bf16x8*)(V_lds + (b) * SHM_V + vst1) = sr_[s].vs1; } \
    if (kact) { const int kc = sc * 2; *(bf16x8*)(K_lds + (b) * SHM_K + kswz<DK>(sr, kc)) = sr_[s].ks0; *(bf16x8*)(K_lds + (b) * SHM_K + kswz<DK>(32 + sr, kc)) = sr_[s].ks1; } } while (0)
#define ATT_RESC(a) do { if (__any((a) < 1.f)) { if (hi == 0) al_l[r32] = (a); asm volatile("s_waitcnt lgkmcnt(0)" ::: "memory"); \
    _Pragma("unroll") for (int d = 0; d < NO; ++d) _Pragma("unroll") for (int r = 0; r < 16; ++r) o[d][r] *= al_l[crow(r, hi)]; } } while (0)
    f32x16 pA0, pA1, pB0, pB1; float mnA, mnB, alA, alB; bf16x8 pa0, pa1, pa2, pa3; const int NT = seq / KVBLK;
    constexpr int SE = 0, SO = SD - 1;
    constexpr bool VPRE = (DV == 64) && (MK_VPRE != 0); VFrag64 vf;
    __syncthreads();
    ATT_SLOAD(SE, 0); asm volatile("s_waitcnt vmcnt(0)" ::: "memory"); ATT_SWRITE(0, SE); __syncthreads();
    qkt<DK>(pA0, pA1, K_lds, qr, r32, hi); partialSM(pA0, pA1, m_reg, mnA, alA, C, thr_raw);
    ATT_SLOAD(SO, KVBLK); if constexpr (SD == 2) { if (2 < NT) ATT_SLOAD(SE, 2 * KVBLK); }
    ATT_SWRITE(1, SO); __syncthreads();
    int bj = 1;
    for (int j = 1; j + 1 < NT; j += 2) {
        const int bn = (bj == 2) ? 0 : bj + 1, bp = (bj == 0) ? 2 : bj - 1;
        ATT_SBAR(); if constexpr (VPRE) pv_issue<DV>(vf, vb0 + bp * SHM_V);
        qkt<DK>(pB0, pB1, K_lds + bj * SHM_K, qr, r32, hi);
        finishSM(pA0, pA1, alA, l_reg, pa0, pa1, pa2, pa3); ATT_SBAR();
        ATT_SLOAD(SO, (j + SD) * KVBLK); ATT_SBAR();
        if constexpr (VPRE) pv_mma64(o, vf, pa0, pa1, pa2, pa3); else pv_d0<DV>(o, vb0 + bp * SHM_V, pa0, pa1, pa2, pa3);
        partialSM(pB0, pB1, m_reg, mnB, alB, C, thr_raw);
        ATT_SWRITE(bn, SE);
        ATT_RESC(alB); __syncthreads();
        ATT_SBAR(); if constexpr (VPRE) pv_issue<DV>(vf, vb0 + bj * SHM_V);
        qkt<DK>(pA0, pA1, K_lds + bn * SHM_K, qr, r32, hi);
        finishSM(pB0, pB1, alB, l_reg, pa0, pa1, pa2, pa3); ATT_SBAR();
        if (SD == 1 || j + 3 < NT) ATT_SLOAD(SE, (j + 1 + SD) * KVBLK); ATT_SBAR();
        if constexpr (VPRE) pv_mma64(o, vf, pa0, pa1, pa2, pa3); else pv_d0<DV>(o, vb0 + bj * SHM_V, pa0, pa1, pa2, pa3);
        partialSM(pA0, pA1, m_reg, mnA, alA, C, thr_raw);
        ATT_SWRITE(bp, SO);
        ATT_RESC(alA); __syncthreads();
        bj = bp;
    }
    { const int bp = (bj == 0) ? 2 : bj - 1;
      ATT_SBAR(); qkt<DK>(pB0, pB1, K_lds + bj * SHM_K, qr, r32, hi);
      finishSM(pA0, pA1, alA, l_reg, pa0, pa1, pa2, pa3); ATT_SBAR();
      pv_d0<DV>(o, vb0 + bp * SHM_V, pa0, pa1, pa2, pa3); partialSM(pB0, pB1, m_reg, mnB, alB, C, thr_raw);
      ATT_RESC(alB);
      finishSM(pB0, pB1, alB, l_reg, pa0, pa1, pa2, pa3); ATT_SBAR();
      pv_d0<DV>(o, vb0 + bj * SHM_V, pa0, pa1, pa2, pa3); }
    if (hi == 0) li_l[r32] = l_reg; asm volatile("s_waitcnt lgkmcnt(0)" ::: "memory");
    float rli[16];
#pragma unroll
    for (int r = 0; r < 16; ++r) rli[r] = __builtin_amdgcn_rcpf(li_l[crow(r, hi)]);
    if constexpr (EPI == 1) {
#pragma unroll
        for (int r = 0; r < 16; ++r)
#pragma unroll
            for (int p = 0; p < NO / 2; ++p) stash[(r * (NO / 2) + p) * 64 + lane] = pk2(o[2 * p][r] * rli[r], o[2 * p + 1][r] * rli[r]);
    } else if constexpr (EPI == 2) {
        static_assert(EPI != 2 || DV == 128, "differential combine: DV = 128");
        float gl[NO];
#pragma unroll
        for (int d0 = 0; d0 < NO; ++d0) gl[d0] = gvec[d0 * 32 + r32];
        bf16_t* Ow = Ob + (long)(wid * QBLK) * ldo;
#pragma unroll
        for (int r = 0; r < 16; ++r) { float v[NO]; float ss = 0.f;
#pragma unroll
            for (int p = 0; p < NO / 2; ++p) { const unsigned w = stash[(r * (NO / 2) + p) * 64 + lane];
                v[2 * p] = o[2 * p][r] * rli[r] - lam * bf2f(w & 0xffffu); v[2 * p + 1] = o[2 * p + 1][r] * rli[r] - lam * bf2f(w >> 16); ss += v[2 * p] * v[2 * p] + v[2 * p + 1] * v[2 * p + 1]; }
#pragma unroll
            for (int x = 1; x < 32; x <<= 1) ss += __shfl_xor(ss, x);
            const float rstd = rsqrtf(ss * (1.0f / 128.0f) + 1e-6f); const int orow = crow(r, hi);
#pragma unroll
            for (int d0 = 0; d0 < NO; ++d0) Ow[(long)orow * ldo + d0 * 32 + r32] = (bf16_t)f2bf(v[d0] * rstd * gl[d0]); }
    } else {
    bf16_t* Ow = Ob + (long)(wid * QBLK) * ldo;
#pragma unroll
    for (int r = 0; r < 16; ++r) { const int orow = crow(r, hi);
#pragma unroll
        for (int d0 = 0; d0 < NO; ++d0) Ow[(long)orow * ldo + d0 * 32 + r32] = (bf16_t)f2bf(o[d0][r] * rli[r]); }
    }
#undef ATT_SLOAD
#undef ATT_SWRITE
#undef ATT_RESC
}

constexpr float THRL = THR * 1.4426950408889634f;
__device__ __forceinline__ float max3f(float a, float b, float c) { return __builtin_fmaxf(__builtin_fmaxf(a, b), c); }
__device__ __forceinline__ void softmax_rel(f32x16& p0, f32x16& p1, float& m_run, float& alpha, const bool first) {
    float pm = max3f(p0[0], p0[1], p0[2]);
#pragma unroll
    for (int r = 3; r < 15; r += 2) pm = max3f(pm, p0[r], p0[r + 1]);
    pm = max3f(pm, p0[15], p1[0]);
#pragma unroll
    for (int r = 1; r < 15; r += 2) pm = max3f(pm, p1[r], p1[r + 1]);
    pm = __builtin_fmaxf(pm, p1[15]);
    { auto rr = __builtin_amdgcn_permlane32_swap(__float_as_uint(pm), __float_as_uint(pm), false, false); pm = __builtin_fmaxf(__uint_as_float(rr[0]), __uint_as_float(rr[1])); }
    if (!first && __builtin_expect(__all(pm <= THRL), 1)) alpha = 1.f;
    else { const float d = first ? pm : __builtin_fmaxf(pm, 0.f); alpha = first ? 1.f : __builtin_amdgcn_exp2f(-d); m_run += d;
#pragma unroll
        for (int r = 0; r < 16; ++r) { p0[r] -= d; p1[r] -= d; } }
#pragma unroll
    for (int r = 0; r < 16; ++r) { p0[r] = __builtin_amdgcn_exp2f(p0[r]); p1[r] = __builtin_amdgcn_exp2f(p1[r]); }
}
template <int DK> __device__ __forceinline__ void qkt_init(f32x16& p0, f32x16& p1, const char* Ks, const bf16x8* qr, int r32, int hi, float init) {
#pragma unroll
    for (int r = 0; r < 16; ++r) { p0[r] = init; p1[r] = init; }
#pragma unroll
    for (int d0 = 0; d0 < DK / 16; ++d0) { const int cb = (d0 * 16 + hi * 8) * 2;
        const bf16x8 b0 = *reinterpret_cast<const bf16x8*>(Ks + kswz<DK>(r32, cb));
        const bf16x8 b1 = *reinterpret_cast<const bf16x8*>(Ks + kswz<DK>(32 + r32, cb));
        p0 = __builtin_amdgcn_mfma_f32_32x32x16_bf16(b0, qr[d0], p0, 0, 0, 0);
        p1 = __builtin_amdgcn_mfma_f32_32x32x16_bf16(b1, qr[d0], p1, 0, 0, 0); }
}
__device__ __forceinline__ void finish_rel(f32x16& p0, f32x16& p1, float alpha, float& l_reg, bf16x8& pa0, bf16x8& pa1, bf16x8& pa2, bf16x8& pa3) {
    float ps = 0;
#pragma unroll
    for (int r = 0; r < 16; ++r) ps += p0[r];
#pragma unroll
    for (int r = 0; r < 16; ++r) ps += p1[r];
    { auto rr = __builtin_amdgcn_permlane32_swap(__float_as_uint(ps), __float_as_uint(ps), false, false); ps = __uint_as_float(rr[0]) + __uint_as_float(rr[1]); }
    l_reg = l_reg * alpha + ps;
#define ATT_PK4(P, BASE, OUT) do { u32x4 w = {cvt_pk_bf16(P[BASE + 0], P[BASE + 1]), cvt_pk_bf16(P[BASE + 2], P[BASE + 3]), cvt_pk_bf16(P[BASE + 4], P[BASE + 5]), cvt_pk_bf16(P[BASE + 6], P[BASE + 7])}; \
    OUT = *reinterpret_cast<bf16x8*>(&w); } while (0)
    ATT_PK4(p0, 0, pa0); ATT_PK4(p0, 8, pa1); ATT_PK4(p1, 0, pa2); ATT_PK4(p1, 8, pa3);
#undef ATT_PK4
}

template <int OFF> __device__ __forceinline__ bf16x8 k_read(int ka) { bf16x8 r; asm volatile("ds_read_b128 %0, %1 offset:%2" : "=&v"(r) : "v"(ka), "i"(OFF) : "memory"); return r; }
#define ATT_WAITL(n) asm volatile("s_waitcnt lgkmcnt(%0)" :: "n"(n) : "memory")
#define ATT_PKV(L, H) (bf16x8){L[0], L[1], L[2], L[3], H[0], H[1], H[2], H[3]}
template <int DK, int DV, int KBD, bool FINM = false, bool MINIT = false>
__device__ __forceinline__ void mblock(f32x16* o, f32x16& p0, f32x16& p1, const bool pv, const int vb, const int ka, const bf16x8* qr, bf16x8 pa0, bf16x8 pa1, bf16x8 pa2, bf16x8 pa3, const float init, const float al = 1.f, float* l_reg = nullptr, const f32x16* minit = nullptr) {
    constexpr int ND = DK / 16, NB = ND / KBD, PITCH = DK * 2 + 16, KR = 2 * KBD;
    static_assert(ND % KBD == 0 && NB >= 2 && NB <= 4 && (KBD == 2 || KBD == 3), "K batches");
    bf16x8 ka0[2][KBD], ka1[2][KBD];
    s16x4 l[4], h[4], m[4], n[4];
#define ATT_KISSUE(b) do { ka0[(b) & 1][0] = k_read<((b) * KBD + 0) * 32>(ka); ka1[(b) & 1][0] = k_read<((b) * KBD + 0) * 32 + 32 * PITCH>(ka); \
        ka0[(b) & 1][1] = k_read<((b) * KBD + 1) * 32>(ka); ka1[(b) & 1][1] = k_read<((b) * KBD + 1) * 32 + 32 * PITCH>(ka); \
        if constexpr (KBD > 2) { ka0[(b) & 1][KBD - 1] = k_read<((b) * KBD + KBD - 1) * 32>(ka); ka1[(b) & 1][KBD - 1] = k_read<((b) * KBD + KBD - 1) * 32 + 32 * PITCH>(ka); } } while (0)
#define ATT_TRISSUE(D0) do { l[0] = tr_read<v_rd_off<DV>(D0, 0, 0)>(vb); h[0] = tr_read<v_rd_off<DV>(D0, 0, 1)>(vb); l[1] = tr_read<v_rd_off<DV>(D0, 1, 0)>(vb); h[1] = tr_read<v_rd_off<DV>(D0, 1, 1)>(vb); \
        l[2] = tr_read<v_rd_off<DV>(D0, 2, 0)>(vb); h[2] = tr_read<v_rd_off<DV>(D0, 2, 1)>(vb); l[3] = tr_read<v_rd_off<DV>(D0, 3, 0)>(vb); h[3] = tr_read<v_rd_off<DV>(D0, 3, 1)>(vb); \
        m[0] = tr_read<v_rd_off<DV>(D0 + 1, 0, 0)>(vb); n[0] = tr_read<v_rd_off<DV>(D0 + 1, 0, 1)>(vb); m[1] = tr_read<v_rd_off<DV>(D0 + 1, 1, 0)>(vb); n[1] = tr_read<v_rd_off<DV>(D0 + 1, 1, 1)>(vb); \
        m[2] = tr_read<v_rd_off<DV>(D0 + 1, 2, 0)>(vb); n[2] = tr_read<v_rd_off<DV>(D0 + 1, 2, 1)>(vb); m[3] = tr_read<v_rd_off<DV>(D0 + 1, 3, 0)>(vb); n[3] = tr_read<v_rd_off<DV>(D0 + 1, 3, 1)>(vb); } while (0)
#define ATT_PVMMA(OA, OB) do { OA = __builtin_amdgcn_mfma_f32_32x32x16_bf16(pa0, ATT_PKV(l[0], h[0]), OA, 0, 0, 0); OB = __builtin_amdgcn_mfma_f32_32x32x16_bf16(pa0, ATT_PKV(m[0], n[0]), OB, 0, 0, 0); \
        OA = __builtin_amdgcn_mfma_f32_32x32x16_bf16(pa1, ATT_PKV(l[1], h[1]), OA, 0, 0, 0); OB = __builtin_amdgcn_mfma_f32_32x32x16_bf16(pa1, ATT_PKV(m[1], n[1]), OB, 0, 0, 0); \
        OA = __builtin_amdgcn_mfma_f32_32x32x16_bf16(pa2, ATT_PKV(l[2], h[2]), OA, 0, 0, 0); OB = __builtin_amdgcn_mfma_f32_32x32x16_bf16(pa2, ATT_PKV(m[2], n[2]), OB, 0, 0, 0); \
        OA = __builtin_amdgcn_mfma_f32_32x32x16_bf16(pa3, ATT_PKV(l[3], h[3]), OA, 0, 0, 0); OB = __builtin_amdgcn_mfma_f32_32x32x16_bf16(pa3, ATT_PKV(m[3], n[3]), OB, 0, 0, 0); } while (0)
#define ATT_QKMMA(b) do { _Pragma("unroll") for (int q = 0; q < KBD; ++q) { const bool f_ = MINIT && (b) == 0 && q == 0; \
        p0 = __builtin_amdgcn_mfma_f32_32x32x16_bf16(ka0[(b) & 1][q], qr[(b) * KBD + q], f_ ? *minit : p0, 0, 0, 0); \
        p1 = __builtin_amdgcn_mfma_f32_32x32x16_bf16(ka1[(b) & 1][q], qr[(b) * KBD + q], f_ ? *minit : p1, 0, 0, 0); } } while (0)
#if MK_ATT_PRIO == 1
    __builtin_amdgcn_s_setprio(1);
#endif
    constexpr bool K2 = (DV == 64);
    if (pv) {
        ATT_TRISSUE(0); ATT_KISSUE(0); if constexpr (K2) ATT_KISSUE(1);
        if constexpr (FINM) { ATT_SBAR(); finish_rel(p0, p1, al, *l_reg, pa0, pa1, pa2, pa3); ATT_SBAR(); }
        ATT_WAITL(K2 ? 2 * KR : KR); ATT_SBAR();
        ATT_PVMMA(o[0], o[1]); ATT_SBAR();
        if constexpr (DV == 128) { ATT_TRISSUE(2); ATT_WAITL(0); ATT_SBAR(); ATT_PVMMA(o[2], o[3]); ATT_SBAR(); }
    } else { ATT_KISSUE(0); if constexpr (K2) ATT_KISSUE(1); }
    if constexpr (!K2) ATT_KISSUE(1);
    if constexpr (!MINIT) {
#pragma unroll
        for (int r = 0; r < 16; ++r) { p0[r] = init; p1[r] = init; } }
    ATT_WAITL(KR); ATT_SBAR(); ATT_QKMMA(0); ATT_SBAR();
    if constexpr (NB > 2) { ATT_KISSUE(2); ATT_WAITL(KR); } else ATT_WAITL(0);
    ATT_SBAR(); ATT_QKMMA(1); ATT_SBAR();
    if constexpr (NB > 2) { if constexpr (NB > 3) { ATT_KISSUE(3); ATT_WAITL(KR); } else ATT_WAITL(0);
        ATT_SBAR(); ATT_QKMMA(2); ATT_SBAR();
        if constexpr (NB > 3) { ATT_WAITL(0); ATT_SBAR(); ATT_QKMMA(3); ATT_SBAR(); } }
#if MK_ATT_PRIO == 1
    __builtin_amdgcn_s_setprio(0);
#endif
    if (MK_PROBE_ATT == 4) { f32x16 dz = f32x16{};
#pragma unroll
        for (int q = 0; q < ND; ++q) { dz = __builtin_amdgcn_mfma_f32_32x32x16_bf16(qr[q], qr[(q + 1) % ND], dz, 0, 0, 0); dz = __builtin_amdgcn_mfma_f32_32x32x16_bf16(qr[(q + 1) % ND], qr[q], dz, 0, 0, 0); }
        asm volatile("" :: "v"(dz)); }
    if (MK_PROBE_ATT == 5) { ATT_KISSUE(0); ATT_KISSUE(1); if constexpr (NB > 2) { ATT_WAITL(0); ATT_KISSUE(2); if constexpr (NB > 3) ATT_KISSUE(3); } ATT_WAITL(0);
        asm volatile("" :: "v"(ka0[0][0]), "v"(ka1[0][0]), "v"(ka0[1][0]), "v"(ka1[1][0])); }
#undef ATT_KISSUE
#undef ATT_TRISSUE
#undef ATT_PVMMA
#undef ATT_QKMMA
}

template <int DK, int DV, int ldq, int ldk, int ldv, int ldo, bool PRE, bool DEEP, bool PART = false>
__device__ __forceinline__ void attn_unit_stag(const bf16_t* __restrict__ Qb, const bf16_t* __restrict__ Kh, const bf16_t* __restrict__ Vh,
                                               bf16_t* __restrict__ Ob, int seq, const float C, const float thr_raw, char* lds, const int wid, float* po = nullptr, float* pml = nullptr) {
    constexpr int SHM_V = KVBLK * DV * 2, SHM_K = KVBLK * (DK * 2 + 16), R = 4;
    constexpr int NO = DV / 32, ND = DK / 16;
    const int lane = fresh_lane(), tid = wid * 64 + lane, r32 = lane & 31, hi = lane >> 5, half = wid >> 2;
    char* V_lds = lds; char* K_lds = lds + R * SHM_V;
    float* wsf = (float*)(lds + R * SHM_V + R * SHM_K) + wid * 64; float* li_l = wsf; float* al_l = wsf + 32;
    float m_reg = 0.f, l_reg = 0; f32x16 o[NO]; bf16x8 qr[ND];
#pragma unroll
    for (int d = 0; d < NO; ++d) o[d] = f32x16{};
    const bf16_t* Qw = Qb + (long)(wid * QBLK + r32) * ldq + hi * 8;
#pragma unroll
    for (int d0 = 0; d0 < ND; ++d0) qr[d0] = *reinterpret_cast<const bf16x8*>(Qw + d0 * 16);
    if constexpr (!PRE) {
#pragma unroll
        for (int d0 = 0; d0 < ND; ++d0) { const u32x4 w = *reinterpret_cast<const u32x4*>(&qr[d0]); u32x4 x;
            x.x = cvt_pk_bf16(bf2f(w.x & 0xffffu) * C, bf2f(w.x >> 16) * C); x.y = cvt_pk_bf16(bf2f(w.y & 0xffffu) * C, bf2f(w.y >> 16) * C);
            x.z = cvt_pk_bf16(bf2f(w.z & 0xffffu) * C, bf2f(w.z >> 16) * C); x.w = cvt_pk_bf16(bf2f(w.w & 0xffffu) * C, bf2f(w.w >> 16) * C);
            qr[d0] = *reinterpret_cast<const bf16x8*>(&x); } }
    const int sr = tid >> 4, sc = (tid & 15) * 8; const bool kact = (DK == 128) ? true : (sc < DK), vact = (DV == 128) ? true : (sc < DV);
    const int vst0 = v_st_nat<DV>(sr, vact ? sc : 0), vst1 = v_st_nat<DV>(32 + sr, vact ? sc : 0);
    const int vb0 = (int)(uintptr_t)V_lds + v_rd_base(lane);
    const int ka0 = (int)(uintptr_t)K_lds + kswz<DK>(r32, hi * 16);
    const unsigned koff = (unsigned)(sr * ldk + sc) * 2u, voff = (unsigned)(sr * ldv + sc) * 2u;
    const unsigned koff2 = koff + 32u * ldk * 2u, voff2 = voff + 32u * ldv * 2u;
    bf16x8 vsA0, vsA1, ksA0, ksA1, vsB0, vsB1, ksB0, ksB1;
#define STG_SLOAD(S, k0) do { const char* _kt = (const char*)Kh + (size_t)(k0) * ldk * 2; const char* _vt = (const char*)Vh + (size_t)(k0) * ldv * 2;        \
    if (vact) { vs##S##0 = *reinterpret_cast<const bf16x8*>(_vt + (size_t)voff); vs##S##1 = *reinterpret_cast<const bf16x8*>(_vt + (size_t)voff2); } \
    if (kact) { ks##S##0 = *reinterpret_cast<const bf16x8*>(_kt + (size_t)koff); ks##S##1 = *reinterpret_cast<const bf16x8*>(_kt + (size_t)koff2); } } while (0)
#define STG_SWRITE(S, b) do { if (vact) { *(bf16x8*)(V_lds + (b) * SHM_V + vst0) = vs##S##0; *(bf16x8*)(V_lds + (b) * SHM_V + vst1) = vs##S##1; } \
    if (kact) { const int kc = sc * 2; *(bf16x8*)(K_lds + (b) * SHM_K + kswz<DK>(sr, kc)) = ks##S##0; *(bf16x8*)(K_lds + (b) * SHM_K + kswz<DK>(32 + sr, kc)) = ks##S##1; } } while (0)
#define STG_BAR() do { ATT_SBAR(); asm volatile("s_waitcnt lgkmcnt(0)" ::: "memory"); __builtin_amdgcn_s_barrier(); asm volatile("" ::: "memory"); ATT_SBAR(); } while (0)
    constexpr bool MINIT = !(DK == 128 && DV == 128);
    f32x16 minit = f32x16{};
    constexpr bool FINM = false;
    f32x16 p0, p1; float al = 1.f; bf16x8 pa0, pa1, pa2, pa3; const int NT = seq / KVBLK; (void)thr_raw;
    __syncthreads();
    if constexpr (DEEP) { STG_SLOAD(A, 0); STG_SLOAD(B, KVBLK); asm volatile("s_waitcnt vmcnt(0)" ::: "memory"); STG_SWRITE(A, 0); STG_SWRITE(B, 1);
        if (2 < NT) { STG_SLOAD(A, 2 * KVBLK); STG_SLOAD(B, 3 * KVBLK); } }
    else if constexpr (!(DK == 128 && DV == 128)) {
        STG_SLOAD(A, 0); STG_SLOAD(B, KVBLK); asm volatile("s_waitcnt vmcnt(0)" ::: "memory"); STG_SWRITE(A, 0); STG_SWRITE(B, 1);
        if (2 < NT) STG_SLOAD(A, 2 * KVBLK); }
    else { STG_SLOAD(A, 0); asm volatile("s_waitcnt vmcnt(0)" ::: "memory"); STG_SWRITE(A, 0);
        STG_SLOAD(A, KVBLK); asm volatile("s_waitcnt vmcnt(0)" ::: "memory"); STG_SWRITE(A, 1);
        if (2 < NT) STG_SLOAD(A, 2 * KVBLK); }
    __syncthreads();
    if (half && MK_PROBE_ATT != 8) STG_BAR();
#define STG_TILE(t, S) do { \
        mblock<DK, DV, (DK == 96) ? 3 : 2, FINM, MINIT>(o, p0, p1, (t) > 0, vb0 + (((t) - 1) & 3) * SHM_V, ka0 + ((t) & 3) * SHM_K, qr, pa0, pa1, pa2, pa3, -m_reg, al, &l_reg, &minit); \
        STG_BAR(); \
        if (MK_ATT_PRIO == 2) __builtin_amdgcn_s_setprio(1); \
        { const float mo_ = m_reg; softmax_rel(p0, p1, m_reg, al, (t) == 0); \
          if (MINIT) { if (__builtin_expect(__any(m_reg != mo_), 0)) { _Pragma("unroll") for (int r = 0; r < 16; ++r) minit[r] = -m_reg; } } } \
        if (MK_PROBE_ATT == 3) { float dz = 0.f; _Pragma("unroll") for (int r = 0; r < 16; ++r) { dz += __builtin_amdgcn_exp2f(p0[r] - 1.0f); dz += __builtin_amdgcn_exp2f(p1[r] - 2.0f); } asm volatile("" :: "v"(dz)); } \
        if (MK_PROBE_ATT == 6) { STG_BAR(); } \
        if (MK_PROBE_ATT == 9) { float dz = al; _Pragma("unroll") for (int r = 0; r < 48; ++r) asm volatile("v_fma_f32 %0, %0, %0, %0" : "+v"(dz)); asm volatile("" :: "v"(dz)); } \
        if constexpr (!FINM) finish_rel(p0, p1, al, l_reg, pa0, pa1, pa2, pa3); \
        if (__any(al < 1.f)) { if (hi == 0) al_l[r32] = al; asm volatile("s_waitcnt lgkmcnt(0)" ::: "memory"); \
            _Pragma("unroll") for (int d = 0; d < NO; ++d) _Pragma("unroll") for (int r = 0; r < 16; ++r) o[d][r] *= al_l[crow(r, hi)]; } \
        if (MK_ATT_PRIO == 2) __builtin_amdgcn_s_setprio(0); \
        if constexpr (DEEP) { if ((t) + 2 < NT) { STG_SWRITE(S, ((t) + 2) & 3); if ((t) + 4 < NT) STG_SLOAD(S, ((t) + 4) * KVBLK); } } \
        else      { if ((t) + 2 < NT) { STG_SWRITE(A, ((t) + 2) & 3); if ((t) + 3 < NT) { STG_SLOAD(A, ((t) + 3) * KVBLK); \
            if (MK_PROBE_ATT == 7) { STG_SLOAD(B, ((t) + 3) * KVBLK + 32 * ((t) & 1)); asm volatile("" :: "v"(vsB0), "v"(vsB1), "v"(ksB0), "v"(ksB1)); } } } } \
        STG_BAR(); } while (0)
    if constexpr (DEEP) { for (int t = 0; t < NT; t += 2) { STG_TILE(t, A); STG_TILE(t + 1, B); } }
    else { for (int t = 0; t < NT; ++t) STG_TILE(t, A); }
#undef STG_TILE
    if constexpr (FINM) finish_rel(p0, p1, al, l_reg, pa0, pa1, pa2, pa3);
    pv_d0<DV>(o, (int)(uintptr_t)V_lds + v_rd_base(fresh_lane()) + ((NT - 1) & 3) * SHM_V, pa0, pa1, pa2, pa3);
    if (!half && MK_PROBE_ATT != 8) STG_BAR();
    if constexpr (PART) { const int ln = fresh_lane(), rr32 = ln & 31, hh = ln >> 5;
      if (hh == 0) { pml[(wid * QBLK + rr32) * 2] = m_reg; pml[(wid * QBLK + rr32) * 2 + 1] = l_reg; }
      float* pw = po + (size_t)(wid * QBLK) * DV;
#pragma unroll
      for (int r = 0; r < 16; ++r) { const int orow = crow(r, hh);
#pragma unroll
          for (int d0 = 0; d0 < NO; ++d0) pw[orow * DV + d0 * 32 + rr32] = o[d0][r]; } }
    else
    { const int ln = fresh_lane(), rr32 = ln & 31, hh = ln >> 5;
      float* wsf2 = (float*)(lds + R * SHM_V + R * SHM_K) + wid * 64;
      if (hh == 0) wsf2[rr32] = l_reg; asm volatile("s_waitcnt lgkmcnt(0)" ::: "memory");
      float rli[16];
#pragma unroll
      for (int r = 0; r < 16; ++r) rli[r] = __builtin_amdgcn_rcpf(wsf2[crow(r, hh)]);
      constexpr int OP = DV * 2 + 16, OSZ = 32 * OP, NV = (3 * SHM_V) / OSZ;
      static_assert((8 - NV) * OSZ <= R * SHM_K, "O staging");
      char* stg = lds + (wid < NV ? wid * OSZ : R * SHM_V + (wid - NV) * OSZ);
#pragma unroll
      for (int r = 0; r < 16; ++r) { const int orow = crow(r, hh);
#pragma unroll
          for (int d0 = 0; d0 < NO; ++d0) *(bf16_t*)(stg + orow * OP + (d0 * 32 + rr32) * 2) = (bf16_t)f2bf(o[d0][r] * rli[r]); }
      asm volatile("s_waitcnt lgkmcnt(0)" ::: "memory");
      bf16_t* Ow = Ob + (long)(wid * QBLK) * ldo;
      constexpr int SEG = DV * 2 / 16;
#pragma unroll
      for (int ps = 0; ps < DV / 16; ++ps) { const int idx = ps * 64 + ln, row = idx / SEG, seg = idx % SEG;
          const u32x4 w = *(const u32x4*)(stg + row * OP + seg * 16);
          *(u32x4*)(Ow + (long)row * ldo + seg * 8) = w; } }
#undef STG_SLOAD
#undef STG_SWRITE
#undef STG_BAR
}
}
constexpr int NWAVES = 8;
constexpr int DM = 1024, NBATCH = 8, SEQ = 4096, CTXL = 256, TPB = CTXL + SEQ  , T = NBATCH * TPB  ;
constexpr int FF = 3584, NEXP = 8, DEPTH = 4;
constexpr int A_IN = 5120, B_IN = 672, B_INP = 768, C_IN = 1536, D_IN = 3072;
constexpr float NORM_EPS = 1e-6f;
constexpr int MOE_ROWS = 2 * T + NEXP * 256;

enum { I_X = 0, I_C, I_CTX, I_CCTX, I_MODW, I_MODB, I_NORMG, I_A_WIN, I_A_LB, I_A_ONORM, I_A_WOUT, I_B_WIN, I_B_QNORM, I_B_KVNORM, I_B_WQB, I_B_WKVB, I_B_WOUT,
       I_C_WIN, I_C_QNORM, I_C_KNORM, I_C_WOUT, I_D_WIN, I_D_LAMBDA, I_D_ONORM, I_D_WOUT, I_FFN_GU, I_FFN_DOWN, I_MOE_ROUTER, I_MOE_GU, I_MOE_DOWN, N_IN };

constexpr size_t al256(size_t x) { return (x + 255) / 256 * 256; }
constexpr size_t WS_CTL = 0, CTL_BYTES = 1u << 20;
constexpr size_t WS_MOD = WS_CTL + CTL_BYTES;
constexpr size_t WS_ROPE = WS_MOD + al256((size_t)DEPTH * 9 * 6 * DM * 4);
constexpr size_t WS_LB = WS_ROPE + al256((size_t)3 * 64 * 32 * 2 * 4);
constexpr size_t WS_W0 = WS_LB + al256((size_t)2 * 1024 * 4);
constexpr size_t WS_WA_IN = WS_W0;                                  constexpr size_t SZ_WA_IN = (size_t)A_IN * DM * 2;
constexpr size_t WS_WA_OUT = WS_WA_IN + SZ_WA_IN;                   constexpr size_t SZ_WOUT = (size_t)DM * DM * 2;
constexpr size_t WS_WB_IN = WS_WA_OUT + SZ_WOUT;                    constexpr size_t SZ_WB_IN = (size_t)B_INP * DM * 2;
constexpr size_t WS_WB_QB = WS_WB_IN + SZ_WB_IN;                    constexpr size_t SZ_WB_QB = (size_t)1536 * 384 * 2;
constexpr size_t WS_WB_KVB = WS_WB_QB + SZ_WB_QB;                   constexpr size_t SZ_WB_KVB = (size_t)2048 * 256 * 2;
constexpr size_t WS_WB_OUT = WS_WB_KVB + SZ_WB_KVB;
constexpr size_t WS_WC_IN = WS_WB_OUT + SZ_WOUT;                    constexpr size_t SZ_WC_IN = (size_t)C_IN * DM * 2;
constexpr size_t WS_WC_OUT = WS_WC_IN + SZ_WC_IN;
constexpr size_t WS_WD_IN = WS_WC_OUT + SZ_WOUT;                    constexpr size_t SZ_WD_IN = (size_t)D_IN * DM * 2;
constexpr size_t WS_WD_OUT = WS_WD_IN + SZ_WD_IN;
constexpr size_t WS_FFN_GU = WS_WD_OUT + SZ_WOUT;                   constexpr size_t SZ_GU = (size_t)2 * FF * DM;
constexpr size_t WS_FFN_DN = WS_FFN_GU + 2 * SZ_GU;                 constexpr size_t SZ_DN = (size_t)DM * FF * 2;
constexpr size_t WS_MOE_GU = WS_FFN_DN + 2 * SZ_DN;
constexpr size_t WS_MOE_DN = WS_MOE_GU + 16 * SZ_GU;
constexpr size_t WS_WEND = WS_MOE_DN + 16 * SZ_DN;
constexpr size_t WS_H = al256(WS_WEND);                              constexpr size_t SZ_H = (size_t)T * DM * 4;
constexpr size_t WS_XA = WS_H + SZ_H;                                constexpr size_t SZ_XA = (size_t)T * DM * 2;
constexpr size_t WS_Y = WS_XA + SZ_XA;                               constexpr size_t SZ_Y = (size_t)T * DM * 4;
constexpr size_t WS_YS = WS_Y + SZ_Y;                              constexpr size_t SZ_YS = (size_t)8 * 2048 * DM * 4;
constexpr size_t WS_ROUTE = WS_YS + SZ_YS;                             constexpr size_t SZ_ROUTE = (size_t)T * 32;
constexpr size_t WS_WCNT = WS_ROUTE + SZ_ROUTE;                      constexpr size_t SZ_WCNT = (size_t)256 * 8 * 4;
constexpr size_t WS_LIST = WS_WCNT + SZ_WCNT;                      constexpr size_t SZ_LIST = (size_t)NEXP * T * 4;
constexpr size_t WS_R0 = al256(WS_LIST + SZ_LIST);
constexpr size_t WS_Z = WS_R0;                                       constexpr size_t SZ_Z = (size_t)T * A_IN * 2;
constexpr size_t WS_Q = WS_Z + SZ_Z;                                 constexpr size_t SZ_Q = (size_t)T * 2048 * 2;
constexpr size_t WS_K = WS_Q + SZ_Q;                                 constexpr size_t SZ_K = (size_t)T * 1536 * 2;
constexpr size_t WS_V = WS_K + SZ_K;                                 constexpr size_t SZ_V = (size_t)T * 1024 * 2;
constexpr size_t WS_O = WS_V + SZ_V;                                 constexpr size_t SZ_O = (size_t)T * 2048 * 2;
constexpr size_t WS_MIX_END = WS_O + SZ_O;
constexpr size_t WS_ACT = WS_R0;                                     constexpr size_t SZ_ACT = (size_t)MOE_ROWS * FF * 2;
constexpr size_t WS_YP = WS_ACT + al256(SZ_ACT);                     constexpr size_t SZ_YP = (size_t)MOE_ROWS * DM * 4;
constexpr size_t WS_FFN_END = WS_YP + SZ_YP;
constexpr size_t WS_END = (WS_MIX_END > WS_FFN_END ? WS_MIX_END : WS_FFN_END);
static_assert((size_t)T * 1536 * 4 <= SZ_Z && (size_t)T * B_INP * 4 <= SZ_Z && (size_t)T * D_IN * 2 <= SZ_Z, "Z region");
static_assert((size_t)T * (384 + 256) * 2 <= SZ_O, "MLA normalised latents fit the O region");

constexpr int CW_BAR = 4096;
constexpr int CW_MOECNT = 16384;
constexpr int RING_BYTES = 131072;
constexpr int MISC_OFF = 163840 - 1024;
constexpr int LDS_BYTES = 163840;
static_assert(RING_BYTES <= MISC_OFF, "LDS map");

#define XB_TMO      128
#define XB_XCNT(j)  (256  + 64 * (j))
#define XB_XSUB(j)  (1280 + 64 * (j))
#define XB_XGEN(j)  (2304 + 64 * (j))
#define XB_TOP      3328
#define XB_TOPGEN   3392
#define XCD_BAR_WORDS 3456
#define XB_SPIN_CAP (1u << 22)
__device__ __forceinline__ unsigned xb_ld(unsigned* p)              { return __hip_atomic_load(p, __ATOMIC_RELAXED, __HIP_MEMORY_SCOPE_AGENT); }
__device__ __forceinline__ unsigned xb_add(unsigned* p, unsigned v) { return __hip_atomic_fetch_add(p, v, __ATOMIC_RELAXED, __HIP_MEMORY_SCOPE_AGENT); }
__device__ __forceinline__ unsigned xb_xcc_id() { return (unsigned)__builtin_amdgcn_s_getreg((3 << 11) | 20) & 0xFu; }
#define XB_SPIN(cond, bar) do { unsigned _sp = 0; while (cond) { __builtin_amdgcn_s_sleep(1); \
    if ((++_sp & 255u) == 0u) { if (xb_ld(&(bar)[XB_TMO])) break; if (_sp > XB_SPIN_CAP) { atomicAdd(&(bar)[XB_TMO], 1u); break; } } } } while (0)
struct XcdBarrier { unsigned* bar; unsigned x; volatile LAS unsigned* st; };
__device__ __forceinline__ XcdBarrier xcd_barrier_post(unsigned* bar, volatile LAS unsigned* st) {
    XcdBarrier b; b.bar = bar; b.x = xb_xcc_id(); b.st = st;
    if (threadIdx.x == 0) (void)xb_add(&bar[XB_XCNT(b.x)], 1u);
    return b;
}
__device__ __forceinline__ void xcd_barrier_complete(unsigned* bar, unsigned x, unsigned& nloc, unsigned& nx) {
    const unsigned G = gridDim.x * gridDim.y * gridDim.z;
    unsigned sum, cnt, mine, sp = 0u;
    for (;;) {
        sum = 0u; cnt = 0u; mine = 0u;
#pragma unroll
        for (unsigned j = 0; j < 16; ++j) { const unsigned c = xb_ld(&bar[XB_XCNT(j)]); sum += c; cnt += (c > 0u) ? 1u : 0u; mine = (j == x) ? c : mine; }
        if (sum == G) break;
        __builtin_amdgcn_s_sleep(1);
        if ((++sp & 255u) == 0u) { if (xb_ld(&bar[XB_TMO])) break; if (sp > XB_SPIN_CAP) { atomicAdd(&bar[XB_TMO], 1u); break; } }
    }
    nloc = mine > 0u ? mine : 1u; nx = cnt > 0u ? cnt : 1u;
}
__device__ __forceinline__ void xcd_barrier(const XcdBarrier& b, const int wave) {
    asm volatile("s_waitcnt vmcnt(0)" ::: "memory");
    __syncthreads();
    if (wave == 0 && fresh_lane() == 0) {
        unsigned* bar = b.bar;
        __builtin_amdgcn_s_waitcnt(0);
        unsigned nloc = b.st[0], nx = b.st[1];
        if (nloc == 0u) { xcd_barrier_complete(bar, b.x, nloc, nx); b.st[0] = nloc; b.st[1] = nx; }
        const unsigned old = xb_add(&bar[XB_XSUB(b.x)], 1u);
        const unsigned gen = old / nloc;
        if (old + 1u == (gen + 1u) * nloc) {
            __builtin_amdgcn_fence(__ATOMIC_RELEASE, "agent");
            asm volatile("s_waitcnt vmcnt(0)" ::: "memory");
            const unsigned og = xb_add(&bar[XB_TOP], 1u);
            const unsigned tg = og / nx;
            if (og + 1u == (tg + 1u) * nx) xb_add(&bar[XB_TOPGEN], 1u);
            else XB_SPIN(xb_ld(&bar[XB_TOPGEN]) == tg, bar);
            __builtin_amdgcn_fence(__ATOMIC_ACQUIRE, "agent");
            xb_add(&bar[XB_XGEN(b.x)], 1u);
            asm volatile("s_waitcnt vmcnt(0)" ::: "memory");
        } else {
            XB_SPIN(xb_ld(&bar[XB_XGEN(b.x)]) == gen, bar);
            __builtin_amdgcn_fence(__ATOMIC_ACQUIRE, "agent");
            asm volatile("s_waitcnt vmcnt(0)" ::: "memory");
        }
    }
    __syncthreads();
}

struct Frame {
    LAS unsigned char* lds; volatile LAS unsigned* MISC; unsigned char* ws;
    int wave, vcu, G;
};
typedef __attribute__((address_space(4))) const unsigned long long* kargp_t;
__device__ __forceinline__ float* out_ptr() { kargp_t ka = (kargp_t)__builtin_amdgcn_kernarg_segment_ptr(); return (float*)(GAS float*)(ka[N_IN]); }
__device__ __forceinline__ const float* in_ptr(const Frame&, int idx) { kargp_t ka = (kargp_t)__builtin_amdgcn_kernarg_segment_ptr(); return (const float*)(const GAS float*)(ka[idx]); }

struct MatDesc { int in_idx; unsigned src_off  ; int K, Nsrc, Ndst, kind  ; unsigned long long dst  ; };
constexpr int NMAT = 10 + 2 + 2 + 16 + 16, NMAT0 = 4;
struct MatTable { MatDesc m[NMAT]; int item0[NMAT + 1]; };
constexpr MatTable make_mats() {
    MatTable t{}; int n = 0;
    auto add = [&](int in_idx, unsigned src_off, int K, int Nsrc, int Ndst, int kind, unsigned long long dst) { t.m[n] = MatDesc{in_idx, src_off, K, Nsrc, Ndst, kind, dst}; ++n; };
    add(I_A_WIN, 0, DM, A_IN, A_IN, 0, WS_WA_IN); add(I_A_WOUT, 0, DM, DM, DM, 0, WS_WA_OUT);
    add(I_FFN_GU, 0, DM, 2 * FF, 2 * FF, 2, WS_FFN_GU); add(I_FFN_DOWN, 0, FF, DM, DM, 0, WS_FFN_DN);
    add(I_B_WIN, 0, DM, B_IN, B_INP, 0, WS_WB_IN); add(I_B_WQB, 0, 384, 1536, 1536, 0, WS_WB_QB); add(I_B_WKVB, 0, 256, 2048, 2048, 0, WS_WB_KVB); add(I_B_WOUT, 0, DM, DM, DM, 0, WS_WB_OUT);
    add(I_C_WIN, 0, DM, C_IN, C_IN, 3, WS_WC_IN); add(I_C_WOUT, 0, DM, DM, DM, 0, WS_WC_OUT);
    add(I_D_WIN, 0, DM, D_IN, D_IN, 0, WS_WD_IN); add(I_D_WOUT, 0, DM, DM, DM, 0, WS_WD_OUT);
    add(I_FFN_GU, (unsigned)1 * DM * 2 * FF, DM, 2 * FF, 2 * FF, 2, WS_FFN_GU + SZ_GU); add(I_FFN_DOWN, (unsigned)1 * FF * DM, FF, DM, DM, 0, WS_FFN_DN + SZ_DN);
    for (int j = 0; j < 16; ++j) add(I_MOE_GU, (unsigned)j * DM * 2 * FF, DM, 2 * FF, 2 * FF, 2, WS_MOE_GU + (size_t)j * SZ_GU);
    for (int j = 0; j < 16; ++j) add(I_MOE_DOWN, (unsigned)j * FF * DM, FF, DM, DM, 0, WS_MOE_DN + (size_t)j * SZ_DN);
    int acc = 0; for (int i = 0; i < NMAT; ++i) { t.item0[i] = acc; acc += (t.m[i].K / 64) * (t.m[i].Ndst / 64); } t.item0[NMAT] = acc;
    return t;
}
__device__ const MatTable g_mats = make_mats();

__host__ __device__ __forceinline__ int gqa_dim(int c) { const int wc = c >> 5, fq = (c >> 3) & 3, e = c & 7; return 64 * (wc >> 1) + 32 * (fq >> 1) + 16 * (wc & 1) + 8 * (fq & 1) + e; }
constexpr int P0_SCR = 64 * 65 * 4;
__device__ __forceinline__ void p0_transpose_item(const float* W, int K, int Nsrc, int kind, bf16_t* WT, LAS float* scr, int item, int Ndst, int lane) {
    const int nblk = Ndst / 64, kb = item / nblk, nb = item % nblk, k0 = 64 * kb, n0 = 64 * nb;
    int s0;
    if (kind == 1 || kind == 2) { const int pn = n0 >> 8, bj = (n0 >> 7) & 1, cc = n0 & 127; s0 = bj * FF + 128 * pn + cc; } else s0 = n0;
    int sl = s0 + lane;
    if (kind == 3) { const int n = n0 + lane; sl = (n < 1280) ? (n & ~127) + gqa_dim(n & 127) : n; }
    const bool ok = (kind >= 1) || (n0 + lane < Nsrc);
    const float* src = W + (size_t)k0 * Nsrc + sl;
    float tv[64];
#pragma unroll
    for (int kk = 0; kk < 64; ++kk) tv[kk] = ok ? src[(size_t)kk * Nsrc] : 0.f;
#pragma unroll
    for (int kk = 0; kk < 64; ++kk) scr[kk * 65 + lane] = tv[kk];
    asm volatile("s_waitcnt lgkmcnt(0)" ::: "memory");
    if (kind == 2) {
        const int c = lane & 3; unsigned char* WT8 = (unsigned char*)WT;
#pragma unroll
        for (int j = 0; j < 4; ++j) { const int n = (lane >> 2) + 16 * j; const LAS float* sp = scr + (16 * c) * 65 + n;
            u32x4 o; o.x = pk4_fp8(32.f * sp[0 * 65], 32.f * sp[1 * 65], 32.f * sp[2 * 65], 32.f * sp[3 * 65]); o.y = pk4_fp8(32.f * sp[4 * 65], 32.f * sp[5 * 65], 32.f * sp[6 * 65], 32.f * sp[7 * 65]);
            o.z = pk4_fp8(32.f * sp[8 * 65], 32.f * sp[9 * 65], 32.f * sp[10 * 65], 32.f * sp[11 * 65]); o.w = pk4_fp8(32.f * sp[12 * 65], 32.f * sp[13 * 65], 32.f * sp[14 * 65], 32.f * sp[15 * 65]);
            *(u32x4*)(WT8 + (size_t)(n0 + n) * K + k0 + 16 * c) = o; }
    } else {
    const int c = lane & 7;
#pragma unroll
    for (int j = 0; j < 8; ++j) { const int n = (lane >> 3) + 8 * j; const LAS float* sp = scr + (8 * c) * 65 + n;
        u32x4 o; o.x = pk2(sp[0 * 65], sp[1 * 65]); o.y = pk2(sp[2 * 65], sp[3 * 65]); o.z = pk2(sp[4 * 65], sp[5 * 65]); o.w = pk2(sp[6 * 65], sp[7 * 65]);
        *(u32x4*)(WT + (size_t)(n0 + n) * K + k0 + 8 * c) = o; }
    }
    asm volatile("s_waitcnt lgkmcnt(0)" ::: "memory");
}

__device__ __forceinline__ void p0_convert(Frame& F, int it0, int it1, int worker, int nworkers, int lane) {
    LAS float* scr = (LAS float*)(F.lds + F.wave * P0_SCR);
    for (int it = it0 + worker; it < it1; it += nworkers) {
        int mi = 0;
#pragma unroll 1
        for (int j = 1; j < NMAT; ++j) mi = (it >= g_mats.item0[j]) ? j : mi;
        const MatDesc d = g_mats.m[mi];
        p0_transpose_item(in_ptr(F, d.in_idx) + d.src_off, d.K, d.Nsrc, d.kind, (bf16_t*)(F.ws + d.dst), scr, it - g_mats.item0[mi], d.Ndst, lane);
    }
}
__device__ __forceinline__ int p0_split_item() { const int i0 = g_mats.item0[NMAT0], i1 = g_mats.item0[NMAT]; return i0 + (int)((long)(i1 - i0) * 0 / 100); }
__device__ __forceinline__ void p0_prologue(Frame& F) {
    const int lane = fresh_lane(), tid = F.wave * 64 + lane; (void)tid;
    const int gw = F.vcu * NWAVES + F.wave, NGW = F.G * NWAVES;
    p0_convert(F, 0, p0_split_item(), gw, NGW, lane);
    __syncthreads();
    {
        LAS float* cond = (LAS float*)F.lds;
        LAS float* part = (LAS float*)(F.lds + 65536);
        const float* cin = in_ptr(F, I_C); const float* cctx = in_ptr(F, I_CCTX);
        for (int i = tid; i < 9 * DM; i += 512) { const int r = i / DM, k = i % DM; const float v = (r < 8) ? cin[r * DM + k] : cctx[k]; cond[i] = silu_f(v); }
        __syncthreads();
        const float* mw = in_ptr(F, I_MODW); const float* mb = in_ptr(F, I_MODB);
        float* modt = (float*)(F.ws + WS_MOD);
        constexpr int NITEM = DEPTH * (6 * DM / 64);
        for (int it = F.vcu; it < NITEM; it += F.G) {
            const int l = it / 96, cb = it % 96, col = cb * 64 + lane;
            float a[9];
#pragma unroll
            for (int r = 0; r < 9; ++r) a[r] = 0.f;
            const float* wp = mw + ((size_t)l * DM + F.wave * 128) * (6 * DM) + col;
#pragma unroll 8
            for (int k = 0; k < 128; ++k) { const float w = wp[(size_t)k * (6 * DM)];
#pragma unroll
                for (int r = 0; r < 9; ++r) a[r] = fmaf(cond[r * DM + F.wave * 128 + k], w, a[r]); }
#pragma unroll
            for (int r = 0; r < 9; ++r) part[(F.wave * 9 + r) * 64 + lane] = a[r];
            __syncthreads();
            for (int i = tid; i < 9 * 64; i += 512) { const int r = i / 64, c = i % 64; float s = mb[(size_t)l * 6 * DM + cb * 64 + c];
#pragma unroll
                for (int w = 0; w < 8; ++w) s += part[(w * 9 + r) * 64 + c];
                modt[((size_t)l * 9 + r) * (6 * DM) + cb * 64 + c] = s; }
            __syncthreads();
        }
    }
    {
        float* rt = (float*)(F.ws + WS_ROPE);
        for (int i = gw * 64 + lane; i < 3 * 64 * 32; i += NGW * 64) { const int kind = i / 2048, pos = (i / 32) % 64, fi = i % 32; const int n = 16 << kind;
            if (fi < n / 2) { const float inv = exp2f(-(float)(2 * fi) / (float)n * 13.287712379549449f);
                const float ang = (float)pos * inv; float s, c;
                {
                  const float rev = ang * 0.15915494309189535f; const float fr = rev - floorf(rev); s = __builtin_amdgcn_sinf(fr); c = __builtin_amdgcn_cosf(fr); }
                rt[(size_t)i * 2] = c; rt[(size_t)i * 2 + 1] = s; } }
    }
    {
        const float* alb = in_ptr(F, I_A_LB); float* lb = (float*)(F.ws + WS_LB);
        for (int i = gw * 64 + lane; i < 2 * 1024; i += NGW * 64) { const int dir = i / 1024, w = i % 1024; float v[5], mx = -1e30f;
#pragma unroll
            for (int j = 0; j < 5; ++j) { v[j] = alb[((size_t)dir * 5 + j) * 1024 + w]; mx = fmaxf(mx, v[j]); }
            float s = 0.f;
#pragma unroll
            for (int j = 0; j < 5; ++j) s += expf(v[j] - mx);
            lb[i] = expf(v[0] - mx) / s; }
    }
}

struct RowPos { int b, p, modrow, prow, pcol; bool isctx; };
__device__ __forceinline__ RowPos row_pos(int m) { RowPos r; r.b = m / TPB; r.p = m % TPB; r.isctx = r.p < CTXL; r.modrow = r.isctx ? 8 : r.b; const int t = r.isctx ? 0 : r.p - CTXL; r.prow = t >> 6; r.pcol = t & 63; return r; }
__device__ __forceinline__ void ld_row(const float* p, int lane, f32x4 (&v)[4]) {
#pragma unroll
    for (int j = 0; j < 4; ++j) v[j] = *(const f32x4*)(p + 256 * j + 4 * lane);
}
__device__ __forceinline__ void ld_row_bf16(const bf16_t* p, int lane, f32x4 (&v)[4]) {
#pragma unroll
    for (int j = 0; j < 4; ++j) { const u32x2 w = *(const u32x2*)(p + 256 * j + 4 * lane); v[j] = (f32x4){bf2f(w.x & 0xffffu), bf2f(w.x >> 16), bf2f(w.y & 0xffffu), bf2f(w.y >> 16)}; }
}
__device__ __forceinline__ void st_row_bf16(bf16_t* p, int lane, const f32x4 (&v)[4]) {
#pragma unroll
    for (int j = 0; j < 4; ++j) { u32x2 w; w.x = pk2(v[j].x, v[j].y); w.y = pk2(v[j].z, v[j].w); *(u32x2*)(p + 256 * j + 4 * lane) = w; }
}
__device__ __forceinline__ float sumsq_row(const f32x4 (&v)[4]) { float s = 0.f;
#pragma unroll
    for (int j = 0; j < 4; ++j) s += (v[j].x * v[j].x + v[j].y * v[j].y) + (v[j].z * v[j].z + v[j].w * v[j].w);
    return wave_sum(s); }
__device__ __forceinline__ void norm_mod_store(const f32x4 (&x)[4], float rstd, const float* g, const float* shift, const float* scale, bf16_t* dst, int lane, f32x4 (&u)[4]) {
#pragma unroll
    for (int j = 0; j < 4; ++j) { const int c = 256 * j + 4 * lane; const f32x4 gg = *(const f32x4*)(g + c), sh = *(const f32x4*)(shift + c), sc = *(const f32x4*)(scale + c);
        u[j] = (x[j] * rstd * gg) * (sc + 1.0f) + sh;
        u32x2 w; w.x = pk2(u[j].x, u[j].y); w.y = pk2(u[j].z, u[j].w); *(u32x2*)(dst + c) = w; }
}

__device__ __forceinline__ void norm_mod_store_fp8(const f32x4 (&x)[4], float rstd, const float* g, const float* shift, const float* scale, unsigned char* dst, int lane, f32x4 (&u)[4]) {
#pragma unroll
    for (int j = 0; j < 4; ++j) { const int c = 256 * j + 4 * lane; const f32x4 gg = *(const f32x4*)(g + c), sh = *(const f32x4*)(shift + c), sc = *(const f32x4*)(scale + c);
        u[j] = (x[j] * rstd * gg) * (sc + 1.0f) + sh;
        *(unsigned*)(dst + c) = pk4_fp8(u[j].x, u[j].y, u[j].z, u[j].w); }
}
__device__ __forceinline__ void ld_y_row(const unsigned char* ws, int m, const RowPos& rp, int S, int lane, f32x4 (&yv)[4]) {
    if (rp.isctx) { const float* ys = (const float*)(ws + WS_YS) + (size_t)(rp.b * CTXL + rp.p) * DM;
        ld_row(ys, lane, yv);
        for (int s = 1; s < S; ++s) { f32x4 t[4]; ld_row(ys + (size_t)s * 2048 * DM, lane, t);
#pragma unroll
            for (int j = 0; j < 4; ++j) yv[j] = yv[j] + t[j]; } }
    else ld_row_bf16((const bf16_t*)(ws + WS_Y) + (size_t)m * DM, lane, yv);
}
__device__ __forceinline__ void ld_yp_row(const unsigned char* ws, size_t r, int RBM, int trb, int S, int lane, f32x4 (&v)[4]) {
    const int rb = (int)(r >> 8);
    if (rb >= RBM) { const float* ys = (const float*)(ws + WS_YS) + ((size_t)(rb - RBM) * 256 + (r & 255)) * DM;
        ld_row(ys, lane, v);
        for (int s = 1; s < S; ++s) { f32x4 t[4]; ld_row(ys + (size_t)s * trb * 256 * DM, lane, t);
#pragma unroll
            for (int j = 0; j < 4; ++j) v[j] = v[j] + t[j]; } }
    else ld_row_bf16((const bf16_t*)(ws + WS_YP) + r * DM, lane, v);
}
__device__ __forceinline__ float half_sum(float v) {
#pragma unroll
    for (int o = 1; o < 32; o <<= 1) v += __shfl_xor(v, o);
    return v;
}
__device__ __forceinline__ void ld_row2(const float* p, int l32, f32x4 (&v)[8]) {
#pragma unroll
    for (int j = 0; j < 8; ++j) v[j] = *(const f32x4*)(p + 128 * j + 4 * l32);
}
__device__ __forceinline__ void ld_row2_bf16(const bf16_t* p, int l32, f32x4 (&v)[8]) {
#pragma unroll
    for (int j = 0; j < 8; ++j) { const u32x2 w = *(const u32x2*)(p + 128 * j + 4 * l32); v[j] = (f32x4){bf2f(w.x & 0xffffu), bf2f(w.x >> 16), bf2f(w.y & 0xffffu), bf2f(w.y >> 16)}; }
}
__device__ __forceinline__ void st_row2_bf16(bf16_t* p, int l32, const f32x4 (&v)[8]) {
#pragma unroll
    for (int j = 0; j < 8; ++j) { u32x2 w; w.x = pk2(v[j].x, v[j].y); w.y = pk2(v[j].z, v[j].w); *(u32x2*)(p + 128 * j + 4 * l32) = w; }
}
__device__ __forceinline__ float sumsq_row2(const f32x4 (&v)[8]) { float s = 0.f;
#pragma unroll
    for (int j = 0; j < 8; ++j) s += (v[j].x * v[j].x + v[j].y * v[j].y) + (v[j].z * v[j].z + v[j].w * v[j].w);
    return half_sum(s); }
template <bool FP8>
__device__ __forceinline__ void norm_mod2(const f32x4 (&x)[8], float rstd, const LAS float* g, const LAS float* shift, const LAS float* scale, void* dst, int l32, bool st, f32x4 (&u)[8]) {
#pragma unroll
    for (int j = 0; j < 8; ++j) { if ((j & 3) == 0) __builtin_amdgcn_sched_barrier(0);
        const int c = 128 * j + 4 * l32; const f32x4 gg = *(const LAS f32x4*)(g + c), sh = *(const LAS f32x4*)(shift + c), sc = *(const LAS f32x4*)(scale + c);
        u[j] = (x[j] * rstd * gg) * (sc + 1.0f) + sh;
        if (st) { if (FP8) *(unsigned*)((unsigned char*)dst + c) = pk4_fp8(u[j].x, u[j].y, u[j].z, u[j].w);
                  else { u32x2 w; w.x = pk2(u[j].x, u[j].y); w.y = pk2(u[j].z, u[j].w); *(u32x2*)((bf16_t*)dst + c) = w; } } }
}
constexpr int PAR_FLOATS = 29 * DM;
__device__ __forceinline__ void fill_params(Frame& F, const float* ga, const float* gb, const float* m0, const float* m1, const float* m2, int tid) {
    LAS float* par = (LAS float*)F.lds;
    for (int i = tid; i < PAR_FLOATS / 4; i += NWAVES * 64) { const int v = i >> 8, c = (i & 255) * 4; const float* src;
        if (v == 0) src = ga; else if (v == 1) src = gb; else { const int r = (v - 2) / 3, k = (v - 2) % 3; src = (k == 0 ? m0 : k == 1 ? m1 : m2) + (size_t)r * (6 * DM); }
        *(LAS f32x4*)(par + v * DM + c) = *(const f32x4*)(src + c); }
    __syncthreads();
}
__device__ __forceinline__ void ld_y_row2(const unsigned char* ws, int m, const RowPos& rp, bool slab, int S, int l32, f32x4 (&yv)[8]) {
    if (slab) { const float* ys = (const float*)(ws + WS_YS) + (size_t)(rp.b * CTXL + rp.p) * DM;
        ld_row2(ys, l32, yv);
#pragma unroll 1
        for (int s = 1; s < S; ++s) { f32x4 t[8]; ld_row2(ys + (size_t)s * 2048 * DM, l32, t);
#pragma unroll
            for (int j = 0; j < 8; ++j) yv[j] = yv[j] + t[j]; } }
    else ld_row2_bf16((const bf16_t*)(ws + WS_Y) + (size_t)m * DM, l32, yv);
}
__device__ __forceinline__ void ld_yp_row2(const unsigned char* ws, size_t r, int RBM, int trb, int S, int l32, f32x4 (&v)[8]) {
    const int rb = (int)(r >> 8);
    if (rb >= RBM) { const float* ys = (const float*)(ws + WS_YS) + ((size_t)(rb - RBM) * 256 + (r & 255)) * DM;
        ld_row2(ys, l32, v);
#pragma unroll 1
        for (int s = 1; s < S; ++s) { f32x4 t[8]; ld_row2(ys + (size_t)s * trb * 256 * DM, l32, t);
#pragma unroll
            for (int j = 0; j < 8; ++j) v[j] = v[j] + t[j]; } }
    else ld_row2_bf16((const bf16_t*)(ws + WS_YP) + r * DM, l32, v);
}

__device__ __forceinline__ void phase_r0(Frame& F) {
    const int lane = fresh_lane(), l32 = lane & 31, half = lane >> 5;
    const int gw = F.vcu * NWAVES + F.wave, NGW = F.G * NWAVES;
    const float* x = in_ptr(F, I_X); const float* ctx = in_ptr(F, I_CTX); const float* ng = in_ptr(F, I_NORMG);
    bf16_t* h = (bf16_t*)(F.ws + WS_H); bf16_t* xa = (bf16_t*)(F.ws + WS_XA); const float* modt = (const float*)(F.ws + WS_MOD);
    fill_params(F, ng + (0 * 4 + 0) * DM, ng + (0 * 4 + 0) * DM, modt + 0 * DM, modt + 1 * DM, modt + 1 * DM, F.wave * 64 + lane);
    const LAS float* par = (const LAS float*)F.lds;
    for (int pi = gw; pi < T / 2; pi += NGW) { const int m = 2 * pi + half; const RowPos rp = row_pos(m);
        const float* src = rp.isctx ? ctx + ((size_t)rp.b * CTXL + rp.p) * DM : x + ((size_t)rp.b * SEQ + (rp.p - CTXL)) * DM;
        f32x4 v[8], u[8]; ld_row2(src, l32, v);
        st_row2_bf16(h + (size_t)m * DM, l32, v);
        const float rstd = rsqrtf(sumsq_row2(v) * (1.0f / DM) + NORM_EPS);
        const LAS float* pm = par + (2 + 3 * rp.modrow) * DM;
        norm_mod2<false>(v, rstd, par, pm + 0 * DM, pm + 1 * DM, xa + (size_t)m * DM, l32, true, u); }
    __syncthreads();
}

template <bool MOE>
__device__ __forceinline__ void phase_r1(Frame& F, int l) {
    const int lane = fresh_lane(), tid = F.wave * 64 + lane, l32 = lane & 31, half = lane >> 5;
    const float* ng = in_ptr(F, I_NORMG); const float* modt = (const float*)(F.ws + WS_MOD);
    bf16_t* h = (bf16_t*)(F.ws + WS_H); unsigned char* xa = (unsigned char*)(F.ws + WS_XA);
    const float* router = MOE ? in_ptr(F, I_MOE_ROUTER) + (size_t)(l >> 1) * DM * NEXP : nullptr;
    constexpr int LB = PAR_FLOATS * 4;
    LAS int* lcnt = (LAS int*)(F.lds + LB);
    LAS int* lbase = (LAS int*)(F.lds + LB + 64);
    LAS int* lrow = (LAS int*)(F.lds + LB + 1024);
    LAS float* lw = (LAS float*)(F.lds + LB + 4096);
    constexpr int RPW = T / 256;
    if (MOE) { if (tid < 8) lcnt[tid] = 0; }
    { const float* ml = modt + (size_t)l * 9 * (6 * DM); fill_params(F, ng + (l * 4 + 1) * DM, ng + (l * 4 + 2) * DM, ml + 2 * DM, ml + 3 * DM, ml + 4 * DM, tid); }
    const LAS float* par = (const LAS float*)F.lds;
    LAS f32x4* rtA = (LAS f32x4*)(F.lds + LB + 8192); LAS f32x4* rtB = rtA + 1024;
    if (MOE) { for (int c = tid; c < DM; c += NWAVES * 64) { const int slot = ((c & 3) * 8 + (c >> 7)) * 32 + ((c & 127) >> 2);
            rtA[slot] = *(const f32x4*)(router + (size_t)c * 8); rtB[slot] = *(const f32x4*)(router + (size_t)c * 8 + 4); }
        __syncthreads(); }
#define R1_ROW(i) ((i) * 256 + F.vcu)
    f32x4 yn[8], hn[8];
    { const int m0 = R1_ROW(2 * F.wave + half); const RowPos r0 = row_pos(m0); ld_y_row2(F.ws, m0, r0, r0.isctx && !(l == DEPTH - 1), 4, l32, yn); ld_row2_bf16(h + (size_t)m0 * DM, l32, hn); }
    for (int i2 = F.wave; i2 < RPW / 2; i2 += NWAVES) { const int i = 2 * i2 + half, m = R1_ROW(i); const RowPos rp = row_pos(m);
        const bool skip = (l == DEPTH - 1) && rp.isctx;
        const LAS float* pm = par + (2 + 3 * rp.modrow) * DM;
        f32x4 yv[8], hv[8], u[8];
#pragma unroll
        for (int j = 0; j < 8; ++j) { yv[j] = yn[j]; hv[j] = hn[j]; }
        if (i2 + NWAVES < RPW / 2) { const int mn = R1_ROW(i + 2 * NWAVES); const RowPos rn = row_pos(mn); ld_y_row2(F.ws, mn, rn, rn.isctx && !(l == DEPTH - 1), 4, l32, yn); ld_row2_bf16(h + (size_t)mn * DM, l32, hn); }
        const float rstd_y = rsqrtf(sumsq_row2(yv) * (1.0f / DM) + NORM_EPS);
#pragma unroll
        for (int j = 0; j < 8; ++j) { if ((j & 3) == 0) __builtin_amdgcn_sched_barrier(0);
            const int c = 128 * j + 4 * l32; const f32x4 g1 = *(const LAS f32x4*)(par + c), gt = *(const LAS f32x4*)(pm + c);
            hv[j] = hv[j] + gt * (yv[j] * rstd_y * g1); }
        if (!skip) st_row2_bf16(h + (size_t)m * DM, l32, hv);
        const float rstd_h = rsqrtf(sumsq_row2(hv) * (1.0f / DM) + NORM_EPS);
        norm_mod2<true>(hv, rstd_h, par + DM, pm + 1 * DM, pm + 2 * DM, xa + (size_t)m * DM, l32, !skip, u);
        if (MOE) {
            float lg[8];
#pragma unroll
            for (int e = 0; e < 8; ++e) lg[e] = 0.f;
#pragma unroll
            for (int j = 0; j < 8; ++j) { __builtin_amdgcn_sched_barrier(0);
#pragma unroll
                for (int q = 0; q < 4; ++q) { const f32x4 r0 = rtA[(q * 8 + j) * 32 + l32], r1 = rtB[(q * 8 + j) * 32 + l32]; const float uv = u[j][q];
                    lg[0] = fmaf(uv, r0.x, lg[0]); lg[1] = fmaf(uv, r0.y, lg[1]); lg[2] = fmaf(uv, r0.z, lg[2]); lg[3] = fmaf(uv, r0.w, lg[3]);
                    lg[4] = fmaf(uv, r1.x, lg[4]); lg[5] = fmaf(uv, r1.y, lg[5]); lg[6] = fmaf(uv, r1.z, lg[6]); lg[7] = fmaf(uv, r1.w, lg[7]); } }
#pragma unroll
            for (int e = 0; e < 8; ++e) lg[e] = half_sum(lg[e]);
            int e1 = 0; float v1 = lg[0];
#pragma unroll
            for (int e = 1; e < 8; ++e) if (lg[e] > v1) { v1 = lg[e]; e1 = e; }
            int e2 = (e1 == 0) ? 1 : 0; float v2 = (e1 == 0) ? lg[1] : lg[0];
#pragma unroll
            for (int e = 1; e < 8; ++e) if (e != e1 && lg[e] > v2) { v2 = lg[e]; e2 = e; }
            const float w2 = fast_rcp(1.0f + expf(v1 - v2)), w1 = 1.0f - w2;
            if (l32 == 0) { if (skip) lrow[i * 4 + 0] = -1;
                else { lrow[i * 4 + 0] = e1; lrow[i * 4 + 2] = e2; lw[i * 2] = w1; lw[i * 2 + 1] = w2; } }
        }
    }
    if (MOE) {
        __syncthreads();
        if (tid < 8) { int c = 0; for (int i = 0; i < RPW; ++i) { const int a = lrow[i * 4], b = lrow[i * 4 + 2]; if (a < 0) continue; if (a == tid) lrow[i * 4 + 1] = c++; else if (b == tid) lrow[i * 4 + 3] = c++; }
            lcnt[tid] = c; ((int*)(F.ws + WS_WCNT))[F.vcu * 8 + tid] = c;
            __hip_atomic_fetch_add((int*)((unsigned*)F.ws + CW_MOECNT + (l >> 1) * 64) + tid, c, __ATOMIC_RELAXED, __HIP_MEMORY_SCOPE_AGENT); }
        __syncthreads();
        int* route = (int*)(F.ws + WS_ROUTE);
        for (int i = tid; i < RPW; i += 512) { const int m = R1_ROW(i); const int e1 = lrow[i * 4], e2 = lrow[i * 4 + 2]; route[(size_t)m * 8 + 0] = e1; if (e1 < 0) continue;
            route[(size_t)m * 8 + 1] = lrow[i * 4 + 1]; route[(size_t)m * 8 + 2] = e2; route[(size_t)m * 8 + 3] = lrow[i * 4 + 3];
            ((float*)route)[(size_t)m * 8 + 4] = lw[i * 2]; ((float*)route)[(size_t)m * 8 + 5] = lw[i * 2 + 1]; }
        __syncthreads();
    }
}
__device__ __forceinline__ void moe_build(Frame& F) {
    const int lane = fresh_lane(), tid = F.wave * 64 + lane;
    LAS int* red = (LAS int*)F.lds;
    const int* wcnt = (const int*)(F.ws + WS_WCNT);
    { const int e = tid & 7; int sacc = 0; for (int v = tid >> 3; v < F.vcu; v += 64) sacc += wcnt[v * 8 + e]; red[tid] = sacc; }
    __syncthreads();
    if (tid < 8) { int sacc = 0; for (int k = 0; k < 64; ++k) sacc += red[k * 8 + tid]; red[512 + tid] = sacc; }
    __syncthreads();
    constexpr int RPW = T / 256;
    int* list = (int*)(F.ws + WS_LIST); int* route = (int*)(F.ws + WS_ROUTE);
    for (int i = tid; i < RPW; i += 512) { const int m = R1_ROW(i); const int e1 = route[(size_t)m * 8]; if (e1 < 0) continue; const int e2 = route[(size_t)m * 8 + 2];
        const int s1 = red[512 + e1] + route[(size_t)m * 8 + 1], s2 = red[512 + e2] + route[(size_t)m * 8 + 3];
        list[(size_t)e1 * T + s1] = m; list[(size_t)e2 * T + s2] = m; route[(size_t)m * 8 + 1] = s1; route[(size_t)m * 8 + 3] = s2; }
}

__device__ __forceinline__ void moe_tables(Frame& F, int l) {
    const int lane = fresh_lane(), tid = F.wave * 64 + lane; (void)tid;
    if (tid == 0) { const int* gcnt = (const int*)((unsigned*)F.ws + CW_MOECNT + (l >> 1) * 64); int acc = 0;
        for (int e = 0; e < 8; ++e) { const int c = __hip_atomic_load(gcnt + e, __ATOMIC_RELAXED, __HIP_MEMORY_SCOPE_AGENT); F.MISC[32 + e] = (unsigned)c; F.MISC[16 + e] = (unsigned)acc; acc += (c + 255) / 256; }
        F.MISC[24] = (unsigned)acc; }
    __syncthreads();
}

template <bool MOE>
__device__ __forceinline__ void phase_r2(Frame& F, int l) {
    const int lane = fresh_lane(), l32 = lane & 31, half = lane >> 5;
    const int gw = F.vcu * NWAVES + F.wave, NGW = F.G * NWAVES;
    const float* ng = in_ptr(F, I_NORMG); const float* modt = (const float*)(F.ws + WS_MOD);
    bf16_t* h = (bf16_t*)(F.ws + WS_H); bf16_t* xa = (bf16_t*)(F.ws + WS_XA);
    const int* route = (const int*)(F.ws + WS_ROUTE);
    int RBM = 0, trb = 0, S = 1; if (MOE) pg8::moe_tail_params((int)F.MISC[24], RBM, trb, S);
    { const int ln = (l < DEPTH - 1) ? l + 1 : l; const float* ml = modt + (size_t)l * 9 * (6 * DM); const float* mn = modt + (size_t)ln * 9 * (6 * DM);
      fill_params(F, ng + (l * 4 + 3) * DM, ng + (ln * 4 + 0) * DM, ml + 5 * DM, mn + 0 * DM, mn + 1 * DM, F.wave * 64 + lane); }
    const LAS float* par = (const LAS float*)F.lds;
    f32x4 an[8], bn[8], hn[8]; float w1n = 0.f, w2n = 0.f;
#define R2_LOAD(mm) do { const RowPos _r = row_pos(mm); const bool _sk = (l == DEPTH - 1) && _r.isctx; \
        if (MOE) { int e1 = 0, s1 = 0, e2 = 0, s2 = 0; w1n = 0.f; w2n = 0.f; \
            if (!_sk) { e1 = route[(size_t)(mm) * 8]; s1 = route[(size_t)(mm) * 8 + 1]; e2 = route[(size_t)(mm) * 8 + 2]; s2 = route[(size_t)(mm) * 8 + 3]; w1n = ((const float*)route)[(size_t)(mm) * 8 + 4]; w2n = ((const float*)route)[(size_t)(mm) * 8 + 5]; } \
            const size_t r1 = (size_t)F.MISC[16 + e1] * 256 + s1, r2 = (size_t)F.MISC[16 + e2] * 256 + s2; \
            ld_yp_row2(F.ws, r1, RBM, trb, S, l32, an); ld_yp_row2(F.ws, r2, RBM, trb, S, l32, bn); } \
        else ld_y_row2(F.ws, (mm), _r, _r.isctx, 4, l32, an); \
        ld_row2_bf16(h + (size_t)(mm) * DM, l32, hn); } while (0)
    if (gw < T / 2) R2_LOAD(2 * gw + half);
    for (int pi = gw; pi < T / 2; pi += NGW) { const int m = 2 * pi + half; const RowPos rp = row_pos(m);
        const bool skip = (l == DEPTH - 1) && rp.isctx;
        const LAS float* pm = par + (2 + 3 * rp.modrow) * DM;
        f32x4 yv[8], hv[8], u[8];
#pragma unroll
        for (int j = 0; j < 8; ++j) { yv[j] = MOE ? (an[j] * w1n + bn[j] * w2n) : an[j]; hv[j] = hn[j]; }
        if (pi + NGW < T / 2) R2_LOAD(m + 2 * NGW);
        const float rstd_y = rsqrtf(sumsq_row2(yv) * (1.0f / DM) + NORM_EPS);
#pragma unroll
        for (int j = 0; j < 8; ++j) { if ((j & 3) == 0) __builtin_amdgcn_sched_barrier(0);
            const int c = 128 * j + 4 * l32; const f32x4 g3 = *(const LAS f32x4*)(par + c), gt = *(const LAS f32x4*)(pm + c);
            hv[j] = hv[j] + gt * (yv[j] * rstd_y * g3); }
        if (l == DEPTH - 1) { if (!skip) { float* dsto = out_ptr() + ((size_t)rp.b * SEQ + (rp.p - CTXL)) * DM;
#pragma unroll
                for (int j = 0; j < 8; ++j) *(f32x4*)(dsto + 128 * j + 4 * l32) = hv[j]; } }
        else st_row2_bf16(h + (size_t)m * DM, l32, hv);
        if (l < DEPTH - 1) { const float rstd_h = rsqrtf(sumsq_row2(hv) * (1.0f / DM) + NORM_EPS);
            norm_mod2<false>(hv, rstd_h, par + DM, pm + 1 * DM, pm + 2 * DM, xa + (size_t)m * DM, l32, true, u); }
    }
}
namespace scan {
constexpr int A_STR = 272, T_STR = 80;
constexpr int A1_OFF = 0, A2_OFF = 32 * A_STR, K2T_OFF = 2 * 32 * A_STR, VT_OFF = K2T_OFF + 128 * T_STR, DEC_OFF = VT_OFF + 128 * T_STR, BUF_BYTES = DEC_OFF + 512;
constexpr int NCH = TPB / 32;
__device__ __forceinline__ int crow(int r, int hi) { return (r & 3) + 8 * (r >> 2) + 4 * hi; }
__device__ __forceinline__ int tok_of(int p, int dir) { return dir == 0 ? p : (p < CTXL ? (CTXL - 1 - p) : (TPB + CTXL - 1 - p)); }

__device__ __forceinline__ int chunk_lowtok(int n, int dir) { return dir == 0 ? 32 * n : (n < CTXL / 32 ? CTXL - 32 - 32 * n : TPB + CTXL - 32 - 32 * n); }
constexpr int RAW_OFF = 2 * BUF_BYTES, RAW_BYTES = 3 * 8192;
__device__ __forceinline__ void prep_dma(const bf16_t* __restrict__ z, int b, int hd, int dir, int n, LAS unsigned char* raw, int pw, int lane) {
    const char* U = (const char*)(z + (size_t)(b * TPB + chunk_lowtok(n, dir)) * A_IN + hd * 128);
#pragma unroll
    for (int k = 0; k < 2; ++k) { const int c = 8 * pw + 4 * k + (lane >> 4), mr = dir ? 31 - c : c; const unsigned L = (unsigned)(mr * A_IN + (lane & 15) * 8) * 2u;
        __builtin_amdgcn_global_load_lds((const unsigned*)(U + L), (LAS unsigned*)(raw + 0 * 8192 + (2 * pw + k) * 1024), 16, 0, 0);
        __builtin_amdgcn_global_load_lds((const unsigned*)(U + 2048 * (1 + dir) + L), (LAS unsigned*)(raw + 1 * 8192 + (2 * pw + k) * 1024), 16, 0, 0);
        __builtin_amdgcn_global_load_lds((const unsigned*)(U + 6144 + L), (LAS unsigned*)(raw + 2 * 8192 + (2 * pw + k) * 1024), 16, 0, 0); }
}
struct Raw { unsigned short q[16], f[16], v[16]; };
__device__ __forceinline__ void prep_read(Raw& r, const LAS unsigned char* raw, int d, int rh) {
#pragma unroll
    for (int i = 0; i < 16; ++i) { const int o = (16 * rh + i) * 256 + d * 2;
        r.q[i] = *(const LAS unsigned short*)(raw + o); r.f[i] = *(const LAS unsigned short*)(raw + 8192 + o); r.v[i] = *(const LAS unsigned short*)(raw + 16384 + o); }
}
__device__ __forceinline__ void prep_compute(const Raw& r, float lbv, LAS unsigned char* buf, int d, int rh, int lane) {
    float cum[16], kk[16]; float run = 0.f;
#pragma unroll
    for (int i = 0; i < 16; ++i) { const float s = fast_rcp(1.0f + __builtin_amdgcn_exp2f(bf2f(r.f[i]) * -1.4426950408889634f)); const float f = lbv + (1.0f - lbv) * s; kk[i] = 1.0f - f; run += __builtin_amdgcn_logf(f); cum[i] = run; }
    const float tot_lo = __shfl(run, lane & 31);
    if (rh) {
#pragma unroll
        for (int i = 0; i < 16; ++i) cum[i] += tot_lo; }
    const float cend = __shfl(cum[15], (lane & 31) + 32);
    const float dec = __builtin_amdgcn_exp2f(cend);
    unsigned short a1[16], a2[16], k2[16];
#pragma unroll
    for (int i = 0; i < 16; ++i) { const float e1 = __builtin_amdgcn_exp2f(cum[i]), e2 = __builtin_amdgcn_exp2f(-cum[i]); const float A2 = kk[i] * e2;
        const unsigned w12 = cvt_pk_bf16(bf2f(r.q[i]) * 0.08838834764831845f * e1, A2);
        a1[i] = (unsigned short)(w12 & 0xffffu); a2[i] = (unsigned short)(w12 >> 16); k2[i] = (unsigned short)(cvt_pk_bf16(A2 * dec, 0.f) & 0xffffu); }
#pragma unroll
    for (int i = 0; i < 16; ++i) { const int c = 16 * rh + i;
        *(LAS unsigned short*)(buf + A1_OFF + c * A_STR + d * 2) = a1[i]; *(LAS unsigned short*)(buf + A2_OFF + c * A_STR + d * 2) = a2[i]; }
#pragma unroll
    for (int i = 0; i < 16; i += 2) { const int c = 16 * rh + i;
        *(LAS unsigned*)(buf + K2T_OFF + d * T_STR + c * 2) = (unsigned)k2[i] | ((unsigned)k2[i + 1] << 16);
        *(LAS unsigned*)(buf + VT_OFF + d * T_STR + c * 2) = (unsigned)r.v[i] | ((unsigned)r.v[i + 1] << 16); }
    if (rh == 0) *(LAS float*)(buf + DEC_OFF + d * 4) = dec;
}
#define SCAN_BAR() do { asm volatile("s_waitcnt lgkmcnt(0)" ::: "memory"); __builtin_amdgcn_s_barrier(); asm volatile("" ::: "memory"); } while (0)

__device__ __forceinline__ bf16x8 cvt8(const f32x16& x, int base) {
    u32x4 w; w.x = cvt_pk_bf16(x[base + 0], x[base + 1]); w.y = cvt_pk_bf16(x[base + 2], x[base + 3]); w.z = cvt_pk_bf16(x[base + 4], x[base + 5]); w.w = cvt_pk_bf16(x[base + 6], x[base + 7]);
    return *reinterpret_cast<bf16x8*>(&w);
}
__device__ __forceinline__ bf16x8 ld44(const LAS unsigned char* p) {
    const u32x2 a = *(const LAS u32x2*)p, b = *(const LAS u32x2*)(p + 16); u32x4 w = {a.x, a.y, b.x, b.y}; return *reinterpret_cast<bf16x8*>(&w);
}

__device__ __forceinline__ void scan_unit(unsigned char* ws, LAS unsigned char* lds, int unit, int wave, int lane, int tid) {
    static_assert(NCH % 2 == 0, "even chunk count");
    const int b = unit >> 4, hd = (unit >> 1) & 7, dir = unit & 1;
    const bf16_t* z = (const bf16_t*)(ws + WS_Z);
    bf16_t* od = (bf16_t*)(ws + WS_O) + (size_t)dir * T * DM;
    const float* lb = (const float*)(ws + WS_LB) + dir * 1024 + hd * 128;
    const int r32 = lane & 31, hi = lane >> 5;
    if (wave >= 4) {
        const int pw = wave - 4, d = 32 * pw + r32, rh = hi; const float lbv = lb[d];
        asm volatile("s_waitcnt vmcnt(0)" ::: "memory");
        LAS unsigned char* rawb = lds + RAW_OFF; Raw R;
        prep_dma(z, b, hd, dir, 0, rawb, pw, lane); prep_dma(z, b, hd, dir, 1, rawb + RAW_BYTES, pw, lane);
        asm volatile("s_waitcnt vmcnt(6)" ::: "memory"); SCAN_BAR();
        int st = 0;
        for (int n = -1; n < NCH - 1; ++n) {
            prep_read(R, rawb + st * RAW_BYTES, d, rh); prep_compute(R, lbv, lds + ((n + 1) & 1) * BUF_BYTES, d, rh, lane);
            const int st3 = (st == 0) ? 2 : st - 1;
            if (n + 3 < NCH) { prep_dma(z, b, hd, dir, n + 3, rawb + st3 * RAW_BYTES, pw, lane); asm volatile("s_waitcnt vmcnt(6)" ::: "memory"); }
            else asm volatile("s_waitcnt vmcnt(0)" ::: "memory");
            SCAN_BAR();
            st = (st == 2) ? 0 : st + 1;
        }
        SCAN_BAR();
    } else {
        const int sw = wave;
        f32x16 S[4];
#pragma unroll
        for (int t = 0; t < 4; ++t) S[t] = f32x16{};
        SCAN_BAR(); SCAN_BAR();
        for (int n = 0; n < NCH; ++n) {
            const LAS unsigned char* buf = lds + (n & 1) * BUF_BYTES;
            f32x16 X = f32x16{}, Xb = f32x16{};
#pragma unroll
            for (int ks = 0; ks < 8; ++ks) { const bf16x8 a = *(const LAS bf16x8*)(buf + A2_OFF + r32 * A_STR + (16 * ks + 8 * hi) * 2), bb = *(const LAS bf16x8*)(buf + A1_OFF + r32 * A_STR + (16 * ks + 8 * hi) * 2);
                if (ks & 1) Xb = __builtin_amdgcn_mfma_f32_32x32x16_bf16(a, bb, Xb, 0, 0, 0); else X = __builtin_amdgcn_mfma_f32_32x32x16_bf16(a, bb, X, 0, 0, 0); }
#pragma unroll
            for (int r = 0; r < 16; ++r) X[r] = (crow(r, hi) <= r32) ? X[r] + Xb[r] : 0.f;
            f32x16 O = f32x16{};
#pragma unroll
            for (int s0 = 0; s0 < 2; ++s0) { const bf16x8 a = cvt8(X, 8 * s0); const bf16x8 bb = ld44(buf + VT_OFF + (32 * sw + r32) * T_STR + (16 * s0 + 4 * hi) * 2);
                O = __builtin_amdgcn_mfma_f32_32x32x16_bf16(a, bb, O, 0, 0, 0); }
            f32x16 O2 = f32x16{}, O3 = f32x16{};
#pragma unroll
            for (int t = 0; t < 4; ++t)
#pragma unroll
                for (int s0 = 0; s0 < 2; ++s0) { const bf16x8 a = ld44(buf + A1_OFF + r32 * A_STR + (32 * t + 16 * s0 + 4 * hi) * 2); const bf16x8 bb = cvt8(S[t], 8 * s0);
                    if (t & 1) O3 = __builtin_amdgcn_mfma_f32_32x32x16_bf16(a, bb, O3, 0, 0, 0); else O2 = __builtin_amdgcn_mfma_f32_32x32x16_bf16(a, bb, O2, 0, 0, 0); }
#pragma unroll
            for (int r = 0; r < 16; ++r) O[r] += O2[r] + O3[r];
#pragma unroll
            for (int r = 0; r < 16; ++r) { const int p = 32 * n + crow(r, hi); od[(size_t)(b * TPB + tok_of(p, dir)) * DM + hd * 128 + 32 * sw + r32] = (bf16_t)f2bf(O[r]); }
#pragma unroll
            for (int t = 0; t < 4; ++t) {
#pragma unroll
                for (int g4 = 0; g4 < 4; ++g4) { const f32x4 dc = *(const LAS f32x4*)(buf + DEC_OFF + (32 * t + 8 * g4 + 4 * hi) * 4);
                    S[t][4 * g4 + 0] *= dc.x; S[t][4 * g4 + 1] *= dc.y; S[t][4 * g4 + 2] *= dc.z; S[t][4 * g4 + 3] *= dc.w; }
#pragma unroll
                for (int s0 = 0; s0 < 2; ++s0) { const bf16x8 a = *(const LAS bf16x8*)(buf + K2T_OFF + (32 * t + r32) * T_STR + (16 * s0 + 8 * hi) * 2), bb = *(const LAS bf16x8*)(buf + VT_OFF + (32 * sw + r32) * T_STR + (16 * s0 + 8 * hi) * 2);
                    S[t] = __builtin_amdgcn_mfma_f32_32x32x16_bf16(a, bb, S[t], 0, 0, 0); }
            }
            SCAN_BAR();
        }
    }
}
}

__device__ __forceinline__ void phase_a_readout(Frame& F) {
    const int lane = fresh_lane(), l32 = lane & 31, hh = lane >> 5;
    const int gw = F.vcu * NWAVES + F.wave, NGW = F.G * NWAVES;
    const bf16_t* of = (const bf16_t*)(F.ws + WS_O); const bf16_t* ob = of + (size_t)T * DM; const bf16_t* z = (const bf16_t*)(F.ws + WS_Z); bf16_t* xa = (bf16_t*)(F.ws + WS_XA);
    const f32x4 g = *(const f32x4*)(in_ptr(F, I_A_ONORM) + 4 * l32);
    for (int m = gw; m < T; m += NGW) {
        u32x2 a[4], bb[4], gt[4];
#pragma unroll
        for (int it = 0; it < 4; ++it) { const int c = (2 * it + hh) * 128 + 4 * l32;
            a[it] = *(const u32x2*)(of + (size_t)m * DM + c); bb[it] = *(const u32x2*)(ob + (size_t)m * DM + c); gt[it] = *(const u32x2*)(z + (size_t)m * A_IN + 4096 + c); }
#pragma unroll
        for (int it = 0; it < 4; ++it) { const int c = (2 * it + hh) * 128 + 4 * l32;
            const float o0 = bf2f(a[it].x & 0xffffu) + bf2f(bb[it].x & 0xffffu), o1 = bf2f(a[it].x >> 16) + bf2f(bb[it].x >> 16), o2 = bf2f(a[it].y & 0xffffu) + bf2f(bb[it].y & 0xffffu), o3 = bf2f(a[it].y >> 16) + bf2f(bb[it].y >> 16);
            const float rstd = rsqrtf(half_sum((o0 * o0 + o1 * o1) + (o2 * o2 + o3 * o3)) * (1.0f / 128.0f) + NORM_EPS);
            u32x2 w; w.x = pk2(o0 * rstd * g.x * silu_f(bf2f(gt[it].x & 0xffffu)), o1 * rstd * g.y * silu_f(bf2f(gt[it].x >> 16)));
            w.y = pk2(o2 * rstd * g.z * silu_f(bf2f(gt[it].y & 0xffffu)), o3 * rstd * g.w * silu_f(bf2f(gt[it].y >> 16)));
            *(u32x2*)(xa + (size_t)m * DM + c) = w; }
    }
}

__device__ __forceinline__ f32x2 rope_cs(const float* rt, int kind, int pos, int fi) { return *(const f32x2*)(rt + (((size_t)kind * 64 + pos) * 32 + fi) * 2); }

__device__ __forceinline__ void phase_b_row1(Frame& F) {
    const int lane = fresh_lane();
    const int gw = F.vcu * NWAVES + F.wave, NGW = F.G * NWAVES;
    const bf16_t* z = (const bf16_t*)(F.ws + WS_Z); bf16_t* cq = (bf16_t*)(F.ws + WS_O); bf16_t* ckv = cq + (size_t)T * 384; bf16_t* Kb = (bf16_t*)(F.ws + WS_K);
    const float* qg = in_ptr(F, I_B_QNORM); const float* kg = in_ptr(F, I_B_KVNORM); const float* rt = (const float*)(F.ws + WS_ROPE);
    const int ip = lane & 15, hg = lane >> 4;
    f32x2 qgv[3];
#pragma unroll
    for (int j = 0; j < 3; ++j) qgv[j] = *(const f32x2*)(qg + 128 * j + 2 * lane);
    const f32x4 kgv = *(const f32x4*)(kg + 4 * lane);
    for (int m = gw; m < T; m += NGW) { const RowPos rp = row_pos(m); const bf16_t* zr = z + (size_t)m * B_INP;
        float q[6]; float sq = 0.f;
#pragma unroll
        for (int j = 0; j < 3; ++j) { const unsigned w = *(const unsigned*)(zr + 128 * j + 2 * lane); q[2 * j] = bf2f(w & 0xffffu); q[2 * j + 1] = bf2f(w >> 16); sq += q[2 * j] * q[2 * j] + q[2 * j + 1] * q[2 * j + 1]; }
        const u32x2 kw = *(const u32x2*)(zr + 384 + 4 * lane); const float k0 = bf2f(kw.x & 0xffffu), k1 = bf2f(kw.x >> 16), k2 = bf2f(kw.y & 0xffffu), k3 = bf2f(kw.y >> 16);
        const float skv = (k0 * k0 + k1 * k1) + (k2 * k2 + k3 * k3);
        const float rq = rsqrtf(wave_sum(sq) * (1.0f / 384.0f) + NORM_EPS), rkv = rsqrtf(wave_sum(skv) * (1.0f / 256.0f) + NORM_EPS);
#pragma unroll
        for (int j = 0; j < 3; ++j) { const f32x2 g = qgv[j]; *(unsigned*)(cq + (size_t)m * 384 + 128 * j + 2 * lane) = pk2(q[2 * j] * rq * g.x, q[2 * j + 1] * rq * g.y); }
        { const f32x4 g = kgv; u32x2 w; w.x = pk2(k0 * rkv * g.x, k1 * rkv * g.y); w.y = pk2(k2 * rkv * g.z, k3 * rkv * g.w); *(u32x2*)(ckv + (size_t)m * 256 + 4 * lane) = w; }
        const unsigned rw = *(const unsigned*)(zr + 640 + 2 * ip); float x0 = bf2f(rw & 0xffffu), x1 = bf2f(rw >> 16);
        const float p0 = __shfl_xor(x0, 4), p1 = __shfl_xor(x1, 4);
        if (!rp.isctx) { const int pos = (ip < 8) ? rp.prow : rp.pcol; const f32x2 c0 = rope_cs(rt, 0, pos, (2 * ip) & 7), c1 = rope_cs(rt, 0, pos, (2 * ip + 1) & 7);
            if (ip & 4) { x0 = x0 * c0.x + p0 * c0.y; x1 = x1 * c1.x + p1 * c1.y; } else { x0 = x0 * c0.x - p0 * c0.y; x1 = x1 * c1.x - p1 * c1.y; } }
        const unsigned kb = pk2(x0, x1);
#pragma unroll
        for (int hh = 0; hh < 4; ++hh) { const int hd = 4 * hh + hg; *(unsigned*)(Kb + ((size_t)(rp.b * 16 + hd) * TPB + rp.p) * 96 + 64 + 2 * ip) = kb; }
    }
}
__device__ __forceinline__ void phase_b_row2(Frame& F) {
    const int lane = fresh_lane();
    const int gw = F.vcu * NWAVES + F.wave, NGW = F.G * NWAVES;
    bf16_t* Qb = (bf16_t*)(F.ws + WS_Q); const float* rt = (const float*)(F.ws + WS_ROPE);
    const int ip = lane & 15, hg = lane >> 4;
    for (int m = gw; m < T; m += NGW) { const RowPos rp = row_pos(m); if (rp.isctx) continue;
        const int pos = (ip < 8) ? rp.prow : rp.pcol; const f32x2 c0 = rope_cs(rt, 0, pos, (2 * ip) & 7), c1 = rope_cs(rt, 0, pos, (2 * ip + 1) & 7);
        unsigned w[4];
#pragma unroll
        for (int hh = 0; hh < 4; ++hh) w[hh] = *(const unsigned*)(Qb + (size_t)m * 1536 + (4 * hh + hg) * 96 + 64 + 2 * ip);
#pragma unroll
        for (int hh = 0; hh < 4; ++hh) { float x0 = bf2f(w[hh] & 0xffffu), x1 = bf2f(w[hh] >> 16); const float p0 = __shfl_xor(x0, 4), p1 = __shfl_xor(x1, 4);
            if (ip & 4) { x0 = x0 * c0.x + p0 * c0.y; x1 = x1 * c1.x + p1 * c1.y; } else { x0 = x0 * c0.x - p0 * c0.y; x1 = x1 * c1.x - p1 * c1.y; }
            *(unsigned*)(Qb + (size_t)m * 1536 + (4 * hh + hg) * 96 + 64 + 2 * ip) = pk2(x0, x1); }
    }
}
__device__ __forceinline__ void phase_c_row(Frame& F) {
    const int lane = fresh_lane();
    const int gw = F.vcu * NWAVES + F.wave, NGW = F.G * NWAVES;
    const bf16_t* z = (const bf16_t*)(F.ws + WS_Z); bf16_t* Qb = (bf16_t*)(F.ws + WS_Q); bf16_t* Kb = (bf16_t*)(F.ws + WS_K); bf16_t* Vb = (bf16_t*)(F.ws + WS_V);
    const float* qg = in_ptr(F, I_C_QNORM); const float* kg = in_ptr(F, I_C_KNORM); const float* rt = (const float*)(F.ws + WS_ROPE);
    const f32x2 qgv = *(const f32x2*)(qg + 2 * lane), kgv = *(const f32x2*)(kg + 2 * lane);
    const bool up = (lane & 16) != 0;
    for (int m = gw; m < T; m += NGW) { const RowPos rp = row_pos(m); const bf16_t* zr = z + (size_t)m * C_IN;
        f32x2 c0 = (f32x2){1.f, 0.f}, c1 = (f32x2){1.f, 0.f};
        if (!rp.isctx) { const int pos = (lane < 32) ? rp.prow : rp.pcol; c0 = rope_cs(rt, 2, pos, (2 * lane) & 31); c1 = rope_cs(rt, 2, pos, (2 * lane + 1) & 31); }
        unsigned w[10];
#pragma unroll
        for (int hv = 0; hv < 10; ++hv) w[hv] = *(const unsigned*)(zr + hv * 128 + 2 * lane);
#pragma unroll
        for (int hv = 0; hv < 10; ++hv) { float a = bf2f(w[hv] & 0xffffu), bq = bf2f(w[hv] >> 16);
            const float rstd = rsqrtf(wave_sum(a * a + bq * bq) * (1.0f / 128.0f) + NORM_EPS);
            a *= rstd * (hv < 8 ? qgv.x : kgv.x); bq *= rstd * (hv < 8 ? qgv.y : kgv.y);
            const float ap = __shfl_xor(a, 16), bp = __shfl_xor(bq, 16);
            const float ar = up ? (a * c0.x + ap * c0.y) : (a * c0.x - ap * c0.y), br = up ? (bq * c1.x + bp * c1.y) : (bq * c1.x - bp * c1.y);
            bf16_t* dst = (hv < 8) ? Qb + (size_t)m * 1024 + hv * 128 : Kb + (size_t)m * 256 + (hv - 8) * 128;
            *(unsigned*)(dst + 2 * lane) = pk2(ar, br); }
        *(u32x2*)(Vb + (size_t)m * 256 + 4 * lane) = *(const u32x2*)(zr + 1280 + 4 * lane);
    }
}
__device__ __forceinline__ void phase_d_row1(Frame& F) {
    const int lane = fresh_lane();
    const int gw = F.vcu * NWAVES + F.wave, NGW = F.G * NWAVES;
    const bf16_t* z = (const bf16_t*)(F.ws + WS_Z); bf16_t* Qb = (bf16_t*)(F.ws + WS_Q); bf16_t* Kb = (bf16_t*)(F.ws + WS_K); bf16_t* Vb = (bf16_t*)(F.ws + WS_V);
    const float* rt = (const float*)(F.ws + WS_ROPE);
    const int lp = lane & 31; const bool up = (lane & 8) != 0;
    for (int m = gw; m < T; m += NGW) { const RowPos rp = row_pos(m); const bf16_t* zr = z + (size_t)m * D_IN;
        f32x2 c0 = (f32x2){1.f, 0.f}, c1 = (f32x2){1.f, 0.f};
        if (!rp.isctx) { const int pos = (lp < 16) ? rp.prow : rp.pcol; c0 = rope_cs(rt, 1, pos, (2 * lp) & 15); c1 = rope_cs(rt, 1, pos, (2 * lp + 1) & 15); }
        unsigned w[16];
#pragma unroll
        for (int i = 0; i < 16; ++i) w[i] = *(const unsigned*)(zr + 128 * i + 2 * lane);
#pragma unroll
        for (int i = 0; i < 16; ++i) { const float a = bf2f(w[i] & 0xffffu), bq = bf2f(w[i] >> 16); const float ap = __shfl_xor(a, 8), bp = __shfl_xor(bq, 8);
            const float ar = up ? (a * c0.x + ap * c0.y) : (a * c0.x - ap * c0.y), br = up ? (bq * c1.x + bp * c1.y) : (bq * c1.x - bp * c1.y);
            bf16_t* dst = (i < 8) ? Qb + (size_t)m * 1024 + 128 * i : Kb + (size_t)m * 1024 + 128 * (i - 8); *(unsigned*)(dst + 2 * lane) = pk2(ar, br); }
        { const u32x4 a = *(const u32x4*)(zr + 2048 + 16 * lane), bq = *(const u32x4*)(zr + 2048 + 16 * lane + 8); *(u32x4*)(Vb + (size_t)m * 1024 + 16 * lane) = a; *(u32x4*)(Vb + (size_t)m * 1024 + 16 * lane + 8) = bq; }
    }
}
__device__ __forceinline__ void phase_d_row2(Frame& F) {
    const int lane = fresh_lane(), l32 = lane & 31, hh = lane >> 5;
    const int gw = F.vcu * NWAVES + F.wave, NGW = F.G * NWAVES;
    const bf16_t* A = (const bf16_t*)(F.ws + WS_O); bf16_t* xa = (bf16_t*)(F.ws + WS_XA);
    const float* lam = in_ptr(F, I_D_LAMBDA);
    const float lambda_init = 0.8f - 0.6f * 0.40656965974059917f;
    const float s1 = wave_sum(lam[lane] * lam[64 + lane]), s2 = wave_sum(lam[128 + lane] * lam[192 + lane]);
    const float lam_full = expf(s1) - expf(s2) + lambda_init;
    const f32x4 g = *(const f32x4*)(in_ptr(F, I_D_ONORM) + 4 * l32) * (1.0f - lambda_init);
    for (int m = gw; m < T; m += NGW) { if ((m % TPB) < CTXL) continue;
        u32x2 a[4], bb[4];
#pragma unroll
        for (int it = 0; it < 4; ++it) { const int hd = 2 * it + hh; a[it] = *(const u32x2*)(A + (size_t)m * 2048 + (2 * hd) * 128 + 4 * l32); bb[it] = *(const u32x2*)(A + (size_t)m * 2048 + (2 * hd + 1) * 128 + 4 * l32); }
#pragma unroll
        for (int it = 0; it < 4; ++it) { const int hd = 2 * it + hh;
            const float o0 = bf2f(a[it].x & 0xffffu) - lam_full * bf2f(bb[it].x & 0xffffu), o1 = bf2f(a[it].x >> 16) - lam_full * bf2f(bb[it].x >> 16);
            const float o2 = bf2f(a[it].y & 0xffffu) - lam_full * bf2f(bb[it].y & 0xffffu), o3 = bf2f(a[it].y >> 16) - lam_full * bf2f(bb[it].y >> 16);
            const float rstd = rsqrtf(half_sum((o0 * o0 + o1 * o1) + (o2 * o2 + o3 * o3)) * (1.0f / 128.0f) + NORM_EPS);
            u32x2 w; w.x = pk2(o0 * rstd * g.x, o1 * rstd * g.y); w.y = pk2(o2 * rstd * g.z, o3 * rstd * g.w);
            *(u32x2*)(xa + (size_t)m * DM + hd * 128 + 4 * l32) = w; }
    }
}

#ifndef MK_STAG
#define MK_STAG 1
#endif
#define MK_SPLITKV 0
#define MK_PRE_B 1
#define MK_PRE_C 1
#define MK_PRE_D 1
#define MK_PRE(DK) (MK_STAG && ((DK) == 96 ? MK_PRE_B : (DK) == 128 ? MK_PRE_C : MK_PRE_D))
template <int DK, int DV, int ldq, int ldk, int ldv, int ldo, int H, int GK, int GV>
__device__ __forceinline__ void attn_phase(Frame& F, const bf16_t* Q, const bf16_t* K, const bf16_t* V, bf16_t* O, float scale, bool skip_ctx, int dup = 1) {
    const float C = scale * 1.4426950408889634f, thr_raw = att::THR / scale;
    const int NHV = NBATCH * H * 16, NCTX = skip_ctx ? 0 : NBATCH * H;
    const int LO = NHV % F.G, NFULL = NHV - LO; int SF = 1;
    if (MK_SPLITKV && dup == 1 && LO > 0 && F.G % LO == 0) { const int q = F.G / LO; if (q == 2 || q == 4) SF = q; }
    const int NPART = (SF > 1) ? LO * SF : 0, NLAT = (SF > 1) ? NFULL : NHV, NTOT = NLAT + NPART + NCTX;
    float* PO = (float*)(F.ws + WS_YS); float* PML = PO + (size_t)256 * 256 * 128;
    for (int L0 = F.vcu; L0 < NTOT * dup; L0 += F.G) { const int L = (dup > 1) ? L0 % NTOT : L0;
        int b, hd, qb, part = -1, U = L;
        if (L >= NLAT && L < NLAT + NPART) { const int j = L - NLAT; U = NFULL + j / SF; part = j % SF; }
        if (L < NLAT + NPART) { const int grp = U >> 4; b = grp / H; hd = grp % H; qb = 1 + (U & 15); } else { const int L2 = L - NLAT - NPART; b = L2 / H; hd = L2 % H; qb = 0; }
        const size_t row0 = (size_t)b * TPB + (size_t)qb * 256; const bf16_t* Kh = K + (size_t)(b * (H / GK) + hd / GK) * TPB * DK; const bf16_t* Vh = V + (size_t)(b * (H / GV) + hd / GV) * TPB * DV;
        if (part >= 0) { const int klen = TPB / SF, j = L - NLAT;
            att::attn_unit_stag<DK, DV, ldq, DK, DV, ldo, MK_PRE(DK) != 0, false, true>(Q + row0 * ldq + hd * DK, Kh + (size_t)part * klen * DK, Vh + (size_t)part * klen * DV, nullptr,
                               klen, C, thr_raw, (char*)F.lds, F.wave, PO + (size_t)j * 256 * DV, PML + (size_t)j * 256 * 2); }
        else
        att::attn_unit_stag<DK, DV, ldq, DK, DV, ldo, MK_PRE(DK) != 0, false>(Q + row0 * ldq + hd * DK, Kh, Vh, O + row0 * ldo + hd * DV,
                               qb == 0 ? CTXL : TPB, C, thr_raw, (char*)F.lds, F.wave);
    }
    __syncthreads();
}
template <int DV, int ldo, int H>
__device__ __forceinline__ void attn_merge(Frame& F, bf16_t* O) {
    const int NHV = NBATCH * H * 16, LO = NHV % F.G, NFULL = NHV - LO; int SF = 1;
    if (LO > 0 && F.G % LO == 0) { const int q = F.G / LO; if (q == 2 || q == 4) SF = q; }
    if (SF == 1) return;
    const float* PO = (const float*)(F.ws + WS_YS); const float* PML = PO + (size_t)256 * 256 * 128;
    const int lane = fresh_lane(), gw = F.vcu * NWAVES + F.wave, NGW = F.G * NWAVES;
    for (int it = gw; it < LO * 256; it += NGW) { const int u = it >> 8, r = it & 255, U = NFULL + u;
        const int grp = U >> 4, b = grp / H, hd = grp % H, qb = 1 + (U & 15);
        float mi[4], li[4], m = -3.0e38f;
#pragma unroll
        for (int i = 0; i < 4; ++i) { if (i < SF) { const f32x2 ml = *(const f32x2*)(PML + ((size_t)(u * SF + i) * 256 + r) * 2); mi[i] = ml.x; li[i] = ml.y; m = fmaxf(m, ml.x); } else { mi[i] = 0.f; li[i] = 0.f; } }
        float l = 0.f, w[4];
#pragma unroll
        for (int i = 0; i < 4; ++i) { w[i] = (i < SF) ? __builtin_amdgcn_exp2f(mi[i] - m) : 0.f; l += w[i] * li[i]; }
        const float rl = 1.0f / l;
        bf16_t* orow = O + ((size_t)b * TPB + (size_t)qb * 256 + r) * ldo + hd * DV;
#pragma unroll
        for (int c0 = 0; c0 < DV; c0 += 64) { float acc = 0.f;
#pragma unroll
            for (int i = 0; i < 4; ++i) if (i < SF) acc += w[i] * PO[((size_t)(u * SF + i) * 256 + r) * DV + c0 + lane];
            orow[c0 + lane] = (bf16_t)f2bf(acc * rl); } }
}
#ifndef MK_MULTI
#define MK_MULTI 0
#endif
constexpr int NPHASE = 37;
#ifndef MK_REP_MASK
#define MK_REP_MASK 0ull
#endif
#ifndef MK_REP_N
#define MK_REP_N 1
#endif
#ifndef MK_DUP
#define MK_DUP -1
#endif
#define DUPF(k) ((k) == MK_DUP ? 2 : 1)
#ifndef MK_LIMIT
#define MK_LIMIT 37
#endif
struct Args { const float* in[N_IN]; float* out; unsigned char* ws; int ph_lo, ph_hi; };

__device__ __forceinline__ void gemm_plain_f32(Frame& F, const bf16_t* A, const bf16_t* Bt, int N, int K, float* C, int ldc, int dup = 1) {
    pg8::Gemm g{A, Bt, K / 64, N, K, 0, nullptr, 0, nullptr}; pg8::StaticOrder S; S.init(T / 256, N / 256, F.G, (int)blockIdx.x, dup); pg8::EpiF32 E{C, ldc};
    pg8::gemm_phase<pg8::EpiF32, pg8::StaticOrder, false>(F.lds, g, S, E, F.wave);
}
__device__ __forceinline__ void gemm_plain_bf16(Frame& F, const bf16_t* A, const bf16_t* Bt, int N, int K, bf16_t* C, int ldc, int dup = 1) {
    pg8::Gemm g{A, Bt, K / 64, N, K, 0, nullptr, 0, nullptr}; pg8::StaticOrder S; S.init(T / 256, N / 256, F.G, (int)blockIdx.x, dup); pg8::EpiBf16 E{C, ldc};
    pg8::gemm_phase<pg8::EpiBf16, pg8::StaticOrder, false>(F.lds, g, S, E, F.wave);
}
template <int S>
__device__ __forceinline__ void gemm_n1024(Frame& F, const bf16_t* A, const bf16_t* Bt, int K, bool skip_ctx, int dup = 1) {
    { pg8::Gemm g{A, Bt, K / 64, DM, K, 0, nullptr, 0, nullptr}; pg8::LatOrder S1; S1.so.init(128, DM / 256, F.G, (int)blockIdx.x, dup); pg8::EpiBf16 E{(bf16_t*)(F.ws + WS_Y), DM};
      pg8::gemm_phase<pg8::EpiBf16, pg8::LatOrder, false>(F.lds, g, S1, E, F.wave); }
    if (!skip_ctx) { pg8::Gemm g{A, Bt, K / 64 / S, DM, K, 0, nullptr, 0, nullptr}; pg8::CtxSplitOrder S2{DM / 256, S, K / 64 / S, F.G, (int)blockIdx.x, dup}; pg8::EpiF32 E{(float*)(F.ws + WS_YS), DM};
      pg8::gemm_phase<pg8::EpiF32, pg8::CtxSplitOrder, false>(F.lds, g, S2, E, F.wave); }
}
__device__ __forceinline__ void gemm_swiglu(Frame& F, const bf16_t* A, const bf16_t* Bt, bf16_t* C, int dup = 1) {
    pg8::Gemm g{A, Bt, DM / 128, 2 * FF, DM / 2, 0, nullptr, 0, nullptr}; pg8::StaticOrder S; S.init(T / 256, 2 * FF / 256, F.G, (int)blockIdx.x, dup); pg8::EpiSwiglu E{C, FF, 1.0f / 32.0f};
    pg8::gemm_phase<pg8::EpiSwiglu, pg8::StaticOrder, false, true>(F.lds, g, S, E, F.wave);
}
__device__ __forceinline__ void gemm_moe_gu(Frame& F, int lm, int dup = 1) {
    moe_tables(F, 2 * lm + 1);
    pg8::Gemm g{(const bf16_t*)(F.ws + WS_XA), (const bf16_t*)(F.ws + WS_MOE_GU + (size_t)lm * 8 * SZ_GU), DM / 128, 2 * FF, DM / 2, (size_t)2 * FF * DM / 2, (const int*)(F.ws + WS_LIST), T, (const LAS int*)(F.MISC + 32)};
    pg8::MoeOrder S; S.so.init((int)F.MISC[24], 2 * FF / 256, F.G, (int)blockIdx.x, dup); S.rb0 = (const LAS int*)(F.MISC + 16); pg8::EpiSwiglu E{(bf16_t*)(F.ws + WS_ACT), FF, 1.0f / 32.0f};
    pg8::gemm_phase<pg8::EpiSwiglu, pg8::MoeOrder, true, true>(F.lds, g, S, E, F.wave);
}
__device__ __forceinline__ void gemm_moe_down(Frame& F, int lm, int dup = 1) {
    moe_tables(F, 2 * lm + 1);
    int RBM, trb, S; pg8::moe_tail_params((int)F.MISC[24], RBM, trb, S);
    const bf16_t* A = (const bf16_t*)(F.ws + WS_ACT); const bf16_t* Bt = (const bf16_t*)(F.ws + WS_MOE_DN + (size_t)lm * 8 * SZ_DN);
    { pg8::Gemm g{A, Bt, FF / 64, DM, FF, (size_t)DM * FF, nullptr, 0, nullptr};
      pg8::MoeOrder S1; S1.so.init(RBM, DM / 256, F.G, (int)blockIdx.x, dup); S1.rb0 = (const LAS int*)(F.MISC + 16); pg8::EpiBf16 E{(bf16_t*)(F.ws + WS_YP), DM};
      pg8::gemm_phase<pg8::EpiBf16, pg8::MoeOrder, false>(F.lds, g, S1, E, F.wave); }
    if (trb > 0) { pg8::Gemm g{A, Bt, FF / 64 / S, DM, FF, (size_t)DM * FF, nullptr, 0, nullptr};
      pg8::MoeTailOrder S2{RBM, trb, S, FF / 64 / S, F.G, (int)blockIdx.x, dup, (const LAS int*)(F.MISC + 16)}; pg8::EpiF32 E{(float*)(F.ws + WS_YS), DM};
      pg8::gemm_phase<pg8::EpiF32, pg8::MoeTailOrder, false>(F.lds, g, S2, E, F.wave); }
}
__device__ __forceinline__ void xcd_or_nothing(const XcdBarrier& b, int wave) { if (!MK_MULTI) xcd_barrier(b, wave); }
__global__ void __launch_bounds__(NWAVES * 64, 2) fwd_kernel(Args args) {
    extern __shared__ __attribute__((aligned(16))) unsigned char lds_raw[];
    Frame F;
    F.lds = (LAS unsigned char*)lds_raw; F.MISC = (volatile LAS unsigned*)(F.lds + MISC_OFF);
    F.wave = __builtin_amdgcn_readfirstlane((int)threadIdx.x >> 6);
    F.G = gridDim.x; { const int bx = blockIdx.x; F.vcu = (F.G % 8 == 0) ? (bx % 8) * (F.G / 8) + bx / 8 : bx; }
    F.ws = args.ws;
    for (int u = threadIdx.x; u < 256; u += NWAVES * 64) ((LAS unsigned*)(F.lds + MISC_OFF))[u] = 0u;
    __syncthreads();
    XcdBarrier bar; bar.bar = (unsigned*)((unsigned*)F.ws + CW_BAR); bar.x = 0; bar.st = nullptr;
    if (!MK_MULTI) bar = xcd_barrier_post((unsigned*)((unsigned*)F.ws + CW_BAR), F.MISC + 0);
    const int lo = args.ph_lo, hi = args.ph_hi;
#define IN(k) (lo <= (k) && (k) < hi)
#define NREP(k) ((((unsigned long long)(MK_REP_MASK) >> (k)) & 1ull) ? (1 + MK_REP_N) : 1)
#define SEAM(k) do { if (!MK_MULTI && IN((k) + 1)) xcd_barrier(bar, F.wave); } while (0)
    unsigned char* ws = F.ws;
    bf16_t* XA = (bf16_t*)(ws + WS_XA); bf16_t* Y = (bf16_t*)(ws + WS_Y); bf16_t* ACT = (bf16_t*)(ws + WS_ACT);
    bf16_t* Qb = (bf16_t*)(ws + WS_Q); bf16_t* Kb = (bf16_t*)(ws + WS_K); bf16_t* Vb = (bf16_t*)(ws + WS_V); bf16_t* Ob = (bf16_t*)(ws + WS_O);

    if (IN(0)) { for (int rep = 0; rep < NREP(0); ++rep) { p0_prologue(F); if (rep + 1 < NREP(0)) xcd_or_nothing(bar, F.wave); } SEAM(0); }
    if (IN(1)) { for (int rep = 0; rep < NREP(1); ++rep) { for (int d2 = 0; d2 < DUPF(1); ++d2) { phase_r0(F); } if (rep + 1 < NREP(1)) xcd_or_nothing(bar, F.wave); } SEAM(1); }
    if (IN(2)) { for (int rep = 0; rep < NREP(2); ++rep) { gemm_plain_bf16(F, XA, (const bf16_t*)(ws + WS_WA_IN), A_IN, DM, (bf16_t*)(ws + WS_Z), A_IN, DUPF(2)); if (rep + 1 < NREP(2)) xcd_or_nothing(bar, F.wave); } SEAM(2); }
    if (IN(3)) { for (int rep = 0; rep < NREP(3); ++rep) { if ((int)blockIdx.x < NBATCH * 8 * 2) { for (int d2 = 0; d2 < DUPF(3); ++d2) { const int ln = fresh_lane(); scan::scan_unit(ws, F.lds, (int)blockIdx.x, F.wave, ln, F.wave * 64 + ln); __syncthreads(); } }
        else if (rep == 0) { const int nidle = F.G - NBATCH * 8 * 2; p0_convert(F, p0_split_item(), g_mats.item0[NMAT], ((int)blockIdx.x - NBATCH * 8 * 2) * NWAVES + F.wave, nidle * NWAVES, fresh_lane()); } if (rep + 1 < NREP(3)) xcd_or_nothing(bar, F.wave); } SEAM(3); }
    if (IN(4)) { for (int rep = 0; rep < NREP(4); ++rep) { for (int d2 = 0; d2 < DUPF(4); ++d2) { phase_a_readout(F); } if (rep + 1 < NREP(4)) xcd_or_nothing(bar, F.wave); } SEAM(4); }
    if (IN(5)) { for (int rep = 0; rep < NREP(5); ++rep) { gemm_n1024<4>(F, XA, (const bf16_t*)(ws + WS_WA_OUT), DM, false, DUPF(5)); if (rep + 1 < NREP(5)) xcd_or_nothing(bar, F.wave); } SEAM(5); }
    if (IN(6)) { for (int rep = 0; rep < NREP(6); ++rep) { phase_r1<false>(F, 0); if (rep + 1 < NREP(6)) xcd_or_nothing(bar, F.wave); } SEAM(6); }
    if (IN(7)) { for (int rep = 0; rep < NREP(7); ++rep) { gemm_swiglu(F, XA, (const bf16_t*)(ws + WS_FFN_GU), ACT, DUPF(7)); if (rep + 1 < NREP(7)) xcd_or_nothing(bar, F.wave); } SEAM(7); }
    if (IN(8)) { for (int rep = 0; rep < NREP(8); ++rep) { gemm_n1024<4>(F, ACT, (const bf16_t*)(ws + WS_FFN_DN), FF, false, DUPF(8)); if (rep + 1 < NREP(8)) xcd_or_nothing(bar, F.wave); } SEAM(8); }
    if (IN(9)) { for (int rep = 0; rep < NREP(9); ++rep) { phase_r2<false>(F, 0); if (rep + 1 < NREP(9)) xcd_or_nothing(bar, F.wave); } SEAM(9); }
    if (IN(10)) { for (int rep = 0; rep < NREP(10); ++rep) { gemm_plain_bf16(F, XA, (const bf16_t*)(ws + WS_WB_IN), B_INP, DM, (bf16_t*)(ws + WS_Z), B_INP, DUPF(10)); if (rep + 1 < NREP(10)) xcd_or_nothing(bar, F.wave); } SEAM(10); }
    if (IN(11)) { for (int rep = 0; rep < NREP(11); ++rep) { for (int d2 = 0; d2 < DUPF(11); ++d2) { phase_b_row1(F); } if (rep + 1 < NREP(11)) xcd_or_nothing(bar, F.wave); } SEAM(11); }
    if (IN(12)) {
        { pg8::Gemm g{Ob, (const bf16_t*)(ws + WS_WB_QB), 384 / 64, 1536, 384, 0, nullptr, 0, nullptr}; pg8::StaticOrder S; S.init(T / 256, 1536 / 256, F.G, (int)blockIdx.x); pg8::EpiRopeB E{Qb, (const float*)(ws + WS_ROPE), MK_PRE(96) ? 0.10206207261596575f * 1.4426950408889634f : 1.0f};
          pg8::gemm_phase<pg8::EpiRopeB, pg8::StaticOrder, false>(F.lds, g, S, E, F.wave); }
        { pg8::Gemm g{Ob + (size_t)T * 384, (const bf16_t*)(ws + WS_WB_KVB), 256 / 64, 2048, 256, 0, nullptr, 0, nullptr}; pg8::StaticOrder S; S.init(T / 256, 2048 / 256, F.G, (int)blockIdx.x); pg8::EpiKV E{Kb, 1536, Vb, 1024};
          pg8::gemm_phase<pg8::EpiKV, pg8::StaticOrder, false>(F.lds, g, S, E, F.wave); }
        SEAM(12); }
    if (IN(13)) { for (int rep = 0; rep < NREP(13); ++rep) { attn_phase<96, 64, 1536, 1536, 1024, DM, 16, 1, 1>(F, Qb, Kb, Vb, XA, 0.10206207261596575f, false, DUPF(13)); if (rep + 1 < NREP(13)) xcd_or_nothing(bar, F.wave); } SEAM(13); }
    if (IN(14)) { for (int rep = 0; rep < NREP(14); ++rep) { gemm_n1024<4>(F, XA, (const bf16_t*)(ws + WS_WB_OUT), DM, false, DUPF(14)); if (rep + 1 < NREP(14)) xcd_or_nothing(bar, F.wave); } SEAM(14); }
    if (IN(15)) { for (int rep = 0; rep < NREP(15); ++rep) { phase_r1<true>(F, 1); if (rep + 1 < NREP(15)) xcd_or_nothing(bar, F.wave); } SEAM(15); }
    if (IN(16)) { moe_build(F); SEAM(16); }
    if (IN(17)) { for (int rep = 0; rep < NREP(17); ++rep) { gemm_moe_gu(F, 0, DUPF(17)); if (rep + 1 < NREP(17)) xcd_or_nothing(bar, F.wave); } SEAM(17); }
    if (IN(18)) { for (int rep = 0; rep < NREP(18); ++rep) { gemm_moe_down(F, 0, DUPF(18)); if (rep + 1 < NREP(18)) xcd_or_nothing(bar, F.wave); } SEAM(18); }
    if (IN(19)) { for (int rep = 0; rep < NREP(19); ++rep) { moe_tables(F, 1); phase_r2<true>(F, 1); if (rep + 1 < NREP(19)) xcd_or_nothing(bar, F.wave); } SEAM(19); }
    if (IN(20)) { { pg8::Gemm g{XA, (const bf16_t*)(ws + WS_WC_IN), DM / 64, C_IN, DM, 0, nullptr, 0, nullptr}; pg8::StaticOrder S; S.init(T / 256, C_IN / 256, F.G, (int)blockIdx.x, DUPF(20));
          pg8::EpiNormRopeC E{Qb, Kb, Vb, in_ptr(F, I_C_QNORM), in_ptr(F, I_C_KNORM), (const float*)(ws + WS_ROPE) + (size_t)2 * 64 * 32 * 2, (LAS float*)(F.lds + pg8::STAGE_BYTES + 2048), MK_PRE(128) ? 0.08838834764831845f * 1.4426950408889634f : 1.0f};
          pg8::gemm_phase<pg8::EpiNormRopeC, pg8::StaticOrder, false>(F.lds, g, S, E, F.wave); } }
    if (IN(21)) { SEAM(21); }
    if (IN(22)) { for (int rep = 0; rep < NREP(22); ++rep) { attn_phase<128, 128, 1024, 256, 256, DM, 8, 4, 4>(F, Qb, Kb, Vb, XA, 0.08838834764831845f, false, DUPF(22)); if (rep + 1 < NREP(22)) xcd_or_nothing(bar, F.wave); } SEAM(22); }
    if (IN(23)) { for (int rep = 0; rep < NREP(23); ++rep) { gemm_n1024<4>(F, XA, (const bf16_t*)(ws + WS_WC_OUT), DM, false, DUPF(23)); if (rep + 1 < NREP(23)) xcd_or_nothing(bar, F.wave); } SEAM(23); }
    if (IN(24)) { for (int rep = 0; rep < NREP(24); ++rep) { phase_r1<false>(F, 2); if (rep + 1 < NREP(24)) xcd_or_nothing(bar, F.wave); } SEAM(24); }
    if (IN(25)) { for (int rep = 0; rep < NREP(25); ++rep) { gemm_swiglu(F, XA, (const bf16_t*)(ws + WS_FFN_GU + SZ_GU), ACT, DUPF(25)); if (rep + 1 < NREP(25)) xcd_or_nothing(bar, F.wave); } SEAM(25); }
    if (IN(26)) { for (int rep = 0; rep < NREP(26); ++rep) { gemm_n1024<4>(F, ACT, (const bf16_t*)(ws + WS_FFN_DN + SZ_DN), FF, false, DUPF(26)); if (rep + 1 < NREP(26)) xcd_or_nothing(bar, F.wave); } SEAM(26); }
    if (IN(27)) { for (int rep = 0; rep < NREP(27); ++rep) { phase_r2<false>(F, 2); if (rep + 1 < NREP(27)) xcd_or_nothing(bar, F.wave); } SEAM(27); }
    if (IN(28)) { { pg8::Gemm g{XA, (const bf16_t*)(ws + WS_WD_IN), DM / 64, D_IN, DM, 0, nullptr, 0, nullptr}; pg8::StaticOrder S; S.init(T / 256, D_IN / 256, F.G, (int)blockIdx.x, DUPF(28));
          pg8::EpiRopeD E{Qb, Kb, Vb, (const float*)(ws + WS_ROPE) + (size_t)1 * 64 * 32 * 2, MK_PRE(64) ? 0.125f * 1.4426950408889634f : 1.0f};
          pg8::gemm_phase<pg8::EpiRopeD, pg8::StaticOrder, false>(F.lds, g, S, E, F.wave); } SEAM(28); }
    if (IN(29)) { for (int rep = 0; rep < NREP(29); ++rep) { attn_phase<64, 128, 1024, 1024, 1024, 2048, 16, 1, 2>(F, Qb, Kb, Vb, Ob, 0.125f, true, DUPF(29)); if (rep + 1 < NREP(29)) xcd_or_nothing(bar, F.wave); } SEAM(29); }
    if (IN(30)) { for (int rep = 0; rep < NREP(30); ++rep) { for (int d2 = 0; d2 < DUPF(30); ++d2) { phase_d_row2(F); } if (rep + 1 < NREP(30)) xcd_or_nothing(bar, F.wave); } SEAM(30); }
    if (IN(31)) { for (int rep = 0; rep < NREP(31); ++rep) { gemm_n1024<4>(F, XA, (const bf16_t*)(ws + WS_WD_OUT), DM, true, DUPF(31)); if (rep + 1 < NREP(31)) xcd_or_nothing(bar, F.wave); } SEAM(31); }
    if (IN(32)) { for (int rep = 0; rep < NREP(32); ++rep) { phase_r1<true>(F, 3); if (rep + 1 < NREP(32)) xcd_or_nothing(bar, F.wave); } SEAM(32); }
    if (IN(33)) { moe_build(F); SEAM(33); }
    if (IN(34)) { for (int rep = 0; rep < NREP(34); ++rep) { gemm_moe_gu(F, 1, DUPF(34)); if (rep + 1 < NREP(34)) xcd_or_nothing(bar, F.wave); } SEAM(34); }
    if (IN(35)) { for (int rep = 0; rep < NREP(35); ++rep) { gemm_moe_down(F, 1, DUPF(35)); if (rep + 1 < NREP(35)) xcd_or_nothing(bar, F.wave); } SEAM(35); }
    if (IN(36)) { moe_tables(F, 3); phase_r2<true>(F, 3); }
#if MK_LIMIT < 37
    {
        xcd_barrier(bar, F.wave);
        float* outp = out_ptr(); const int tid = F.wave * 64 + fresh_lane();
#if MK_LIMIT == 34 || MK_LIMIT == 35 || MK_LIMIT == 36
        moe_tables(F, 3);
        int RBM, trb, S; pg8::moe_tail_params((int)F.MISC[24], RBM, trb, S);
#endif
        for (int r = (int)blockIdx.x; r < NBATCH * SEQ; r += F.G) { const int b = r / SEQ, l = r % SEQ; const size_t m = (size_t)b * TPB + CTXL + l;
#if MK_LIMIT == 34
            const int* route = (const int*)(ws + WS_ROUTE); const int* list = (const int*)(ws + WS_LIST);
            const int e1 = route[m * 8], s1 = route[m * 8 + 1], e2 = route[m * 8 + 2], s2 = route[m * 8 + 3];
            const unsigned char* xa8 = (const unsigned char*)(ws + WS_XA) + m * DM;
            for (int c = tid; c < DM; c += NWAVES * 64) { float v = 0.f;
                if (c >= 512) v = (float)((unsigned)xa8[2 * (c - 512)] + 256u * (unsigned)xa8[2 * (c - 512) + 1]); else
                if (c < 4) v = (float)route[m * 8 + c]; else if (c < 6) v = ((const float*)route)[m * 8 + c]; else if (c == 6) v = (float)(list[(size_t)e1 * T + s1] - (int)m); else if (c == 7) v = (float)(list[(size_t)e2 * T + s2] - (int)m);
                else if (c < 16) v = (float)F.MISC[16 + (c - 8)]; else if (c < 24) v = (float)F.MISC[32 + (c - 16)]; else if (c == 24) v = (float)F.MISC[24];
                outp[(size_t)r * DM + c] = v; }
#elif MK_LIMIT == 35
            const int* route = (const int*)(ws + WS_ROUTE); const bf16_t* act = (const bf16_t*)(ws + WS_ACT);
            const size_t r1 = (size_t)F.MISC[16 + route[m * 8]] * 256 + route[m * 8 + 1], r2 = (size_t)F.MISC[16 + route[m * 8 + 2]] * 256 + route[m * 8 + 3];
            for (int c = tid; c < DM; c += NWAVES * 64) { float v = 0.f;
                for (int q = 0; q < 4; ++q) { const int cc = c + q * DM; if (cc < FF) v += bf2f((unsigned)act[r1 * FF + cc]) + 2.0f * bf2f((unsigned)act[r2 * FF + cc]); }
                outp[(size_t)r * DM + c] = v; }
#elif MK_LIMIT == 36
            const int* route = (const int*)(ws + WS_ROUTE);
            const size_t r1 = (size_t)F.MISC[16 + route[m * 8]] * 256 + route[m * 8 + 1], r2 = (size_t)F.MISC[16 + route[m * 8 + 2]] * 256 + route[m * 8 + 3];
            for (int c = tid; c < DM; c += NWAVES * 64) { float v = 0.f;
                for (int k = 0; k < 2; ++k) { const size_t rr = k ? r2 : r1; const int rb = (int)(rr >> 8); float a = 0.f;
                    if (rb >= RBM) { const float* ys = (const float*)(ws + WS_YS) + ((size_t)(rb - RBM) * 256 + (rr & 255)) * DM; for (int s2 = 0; s2 < S; ++s2) a += ys[(size_t)s2 * trb * 256 * DM + c]; }
                    else a = bf2f((unsigned)((const bf16_t*)(ws + WS_YP))[rr * DM + c]);
                    v += (k ? 2.0f : 1.0f) * a; }
                outp[(size_t)r * DM + c] = v; }
#else
            const bf16_t* hh = (const bf16_t*)(ws + WS_H); const size_t src = m * DM;
            for (int c = tid; c < DM; c += NWAVES * 64) outp[(size_t)r * DM + c] = bf2f((unsigned)hh[src + c]);
#endif
        }
    }
#endif
#undef IN
#undef SEAM
}

extern "C" void kernel_launch(void* const* d_in, const int* in_sizes, int n_in, void* d_out, int out_size, void* d_ws, size_t ws_size, hipStream_t stream) {
    static int grid = 0;
    if (grid == 0) {
        if (n_in != N_IN || out_size != NBATCH * SEQ * DM || ws_size < WS_END) { fprintf(stderr, "kernel_launch: unexpected shapes: n_in %d out %d ws %zu (need %zu)\n", n_in, out_size, ws_size, (size_t)WS_END); grid = -1; return; }
        int dev = 0, cus = 0, per_cu = 0;
        if (hipGetDevice(&dev) != hipSuccess || hipDeviceGetAttribute(&cus, hipDeviceAttributeMultiprocessorCount, dev) != hipSuccess) { grid = -1; return; }
        if (hipFuncSetAttribute((const void*)fwd_kernel, hipFuncAttributeMaxDynamicSharedMemorySize, LDS_BYTES) != hipSuccess) { fprintf(stderr, "kernel_launch: hipFuncSetAttribute failed\n"); grid = -1; return; }
        if (hipOccupancyMaxActiveBlocksPerMultiprocessor(&per_cu, (const void*)fwd_kernel, NWAVES * 64, LDS_BYTES) != hipSuccess || per_cu < 1) fprintf(stderr, "kernel_launch: occupancy query reports %d\n", per_cu);
        (void)hipGetLastError();
        grid = cus;
    }
    if (grid < 0) return;
    (void)hipMemsetAsync((char*)d_ws + WS_CTL, 0, CTL_BYTES, stream);
    Args a{};
    for (int i = 0; i < N_IN; ++i) a.in[i] = (const float*)d_in[i];
    a.out = (float*)d_out; a.ws = (unsigned char*)d_ws;
#if MK_MULTI
    for (int p = 0; p < MK_LIMIT; ++p) { a.ph_lo = p; a.ph_hi = p + 1; hipLaunchKernelGGL(fwd_kernel, dim3(grid), dim3(NWAVES * 64), LDS_BYTES, stream, a); }
#else
    a.ph_lo = 0; a.ph_hi = MK_LIMIT; hipLaunchKernelGGL(fwd_kernel, dim3(grid), dim3(NWAVES * 64), LDS_BYTES, stream, a);
#endif
    const hipError_t le = hipPeekAtLastError();
    if (le != hipSuccess) fprintf(stderr, "kernel_launch: launch failed: %s\n", hipGetErrorName(le));
}
```

```cpp
#include <hip/hip_runtime.h>
#include <cstdio>
#include <cstdint>

#define GAS __attribute__((address_space(1)))
#define LAS __attribute__((address_space(3)))
typedef unsigned short bf16_t;
typedef short bf16x8 __attribute__((ext_vector_type(8)));
typedef short s16x4 __attribute__((ext_vector_type(4)));
typedef float f32x2 __attribute__((ext_vector_type(2)));
typedef float f32x4 __attribute__((ext_vector_type(4)));
typedef float f32x16 __attribute__((ext_vector_type(16)));
typedef unsigned u32x2 __attribute__((ext_vector_type(2)));
typedef unsigned u32x4 __attribute__((ext_vector_type(4)));

__device__ __forceinline__ float bf2f(unsigned b) { return __uint_as_float(b << 16); }
__device__ __forceinline__ unsigned f2bf(float f) { unsigned u = __float_as_uint(f); return (u + 0x7fffu + ((u >> 16) & 1u)) >> 16; }
__device__ __forceinline__ unsigned pk2(float lo, float hi) { return f2bf(lo) | (f2bf(hi) << 16); }
__device__ __forceinline__ unsigned cvt_pk_bf16(float lo, float hi) { unsigned r; asm volatile("v_cvt_pk_bf16_f32 %0, %1, %2" : "=v"(r) : "v"(lo), "v"(hi)); return r; }
typedef int v8i32 __attribute__((ext_vector_type(8)));
__device__ __forceinline__ unsigned pk4_fp8(float a, float b, float c, float d) { int w = 0; w = __builtin_amdgcn_cvt_pk_fp8_f32(a, b, w, false); w = __builtin_amdgcn_cvt_pk_fp8_f32(c, d, w, true); asm volatile("s_nop 1" : "+v"(w)); return (unsigned)w; }
__device__ __forceinline__ float wave_sum(float v) {
#pragma unroll
    for (int o = 1; o < 64; o <<= 1) v += __shfl_xor(v, o);
    return v;
}
__device__ __forceinline__ int fresh_lane() { int l; asm volatile("v_mbcnt_lo_u32_b32 %0, -1, 0\n\tv_mbcnt_hi_u32_b32 %0, -1, %0" : "=v"(l)); return l; }
__device__ __forceinline__ float fast_exp(float x) { return __builtin_amdgcn_exp2f(x * 1.4426950408889634f); }
__device__ __forceinline__ float fast_rcp(float x) { return __builtin_amdgcn_rcpf(x); }
__device__ __forceinline__ float silu_f(float x) { return x * fast_rcp(1.0f + fast_exp(-x)); }

#ifndef MK_WT
#define MK_WT 0
#endif
__device__ __forceinline__ void st16(void* p, u32x4 v) {
#if MK_WT
    asm volatile("global_store_dwordx4 %0, %1, off sc1\n\ts_nop 1" :: "v"(p), "v"(v) : "memory");
#else
    *(u32x4*)p = v;
#endif
}
__device__ __forceinline__ void st16f(void* p, f32x4 v) { st16(p, __builtin_bit_cast(u32x4, v)); }

namespace pg8 {
constexpr int BM = 256, BK = 64, HALF = 128, HTB = HALF * BK * 2, STAGE_BYTES = 8 * HTB, NXCD = 8, WGM = 8;
__host__ __device__ __forceinline__ int lds_byte(int r, int c) { const int st = (r >> 4) * 2 + (c >> 5), rr = r & 15, cc = c & 31, ob = rr * 64 + cc * 2; return st * 1024 + (ob ^ (((ob >> 9) & 1) << 5)); }
__host__ __device__ __forceinline__ void stage_rc(int b, int& R, int& C) { const int st = b / 1024, sb = b % 1024, swz = sb ^ (((sb >> 9) & 1) << 5); R = (st >> 1) * 16 + swz / 64; C = (st & 1) * 32 + (swz % 64) / 2; }
__host__ __device__ __forceinline__ int perm32(int rho) { const int n = rho >> 4, i = rho & 15; return 8 * (i >> 2) + 4 * n + (i & 3); }

struct Unit { int pm, pn, e, pl, po, kt0; };
struct Gemm { const bf16_t* A; const bf16_t* Bt; int nt  , N, K  ; size_t bstride; const int* list; int list_stride; const LAS int* cnt; };

struct StaticOrder {
    int nM, nN, nwg, G, c, dup;
    __device__ __forceinline__ void init(int nM_, int nN_, int G_, int c_, int dup_ = 1) { nM = nM_; nN = nN_; nwg = nM * nN; G = G_; c = c_; dup = dup_; }
    __device__ __forceinline__ bool next(int i, Unit& u) const {
        const long L = (long)i * G + c; if (L >= (long)nwg * dup) return false;
        int wgid = (int)L; if (dup > 1) wgid = (int)((unsigned)wgid % (unsigned)nwg); { const int q = nwg / NXCD, r = nwg % NXCD, xcd = wgid % NXCD, off = wgid / NXCD; wgid = (xcd < r ? xcd * (q + 1) : r * (q + 1) + (xcd - r) * q) + off; }
        const int nig = WGM * nN, gid = wgid / nig, fm = gid * WGM, gsz = (nM - fm) < WGM ? (nM - fm) : WGM;
        u.pm = fm + ((wgid % nig) % gsz); u.pn = (wgid % nig) / gsz; u.e = 0; u.pl = 0; u.po = u.pm; u.kt0 = 0; return true;
    }
};
struct MoeOrder {
    StaticOrder so; const LAS int* rb0;
    __device__ __forceinline__ bool next(int i, Unit& u) const {
        if (!so.next(i, u)) return false;
        int e = 0;
#pragma unroll
        for (int j = 1; j < 8; ++j) e = (u.pm >= rb0[j]) ? j : e;
        u.e = e; u.pl = u.pm - rb0[e]; u.po = u.pm; u.kt0 = 0; return true;
    }
};

__device__ __forceinline__ void moe_tail_params(int NRB, int& RBM, int& trb, int& S) { RBM = (NRB >> 6) << 6; trb = NRB - RBM; S = trb <= 16 ? 4 : trb <= 32 ? 2 : 1; }
struct MoeTailOrder {
    int RBM, trb, S, ntsub, G, c0, dup; const LAS int* rb0;
    __device__ __forceinline__ bool next(int i, Unit& u) const { int L = i * G + c0; const int n = trb * 4 * S; if (L >= n * dup) return false; if (dup > 1) L %= n;
        const int s = L % S, r = L / S; u.pn = r & 3; const int tb = r >> 2; u.pm = RBM + tb; u.po = s * trb + tb; u.kt0 = s * ntsub; u.pl = 0;
        int e = 0;
#pragma unroll
        for (int j = 1; j < 8; ++j) e = (u.pm >= rb0[j]) ? j : e;
        u.e = e; return true; }
};
struct LatOrder {
    StaticOrder so;
    __device__ __forceinline__ bool next(int i, Unit& u) const { if (!so.next(i, u)) return false; u.pm = (u.pm >> 4) * 17 + 1 + (u.pm & 15); u.po = u.pm; return true; }
};
struct CtxSplitOrder {
    int nN, S, ntsub, G, c0, dup;
    __device__ __forceinline__ bool next(int i, Unit& u) const { int L = i * G + c0; if (L >= 8 * nN * S * dup) return false; if (dup > 1) L %= 8 * nN * S;
        const int s = L % S, r = L / S; u.pn = r % nN; const int c = r / nN; u.pm = 17 * c; u.po = s * 8 + c; u.kt0 = s * ntsub; u.e = 0; u.pl = 0; return true; }
};

struct EpiF32 {
    static constexpr bool PERM = false;
    float* C; int ldc;
    __device__ __forceinline__ void operator()(const f32x4 (&acc)[2][2][4][2], const Unit& u, int wr, int wc, int fr, int fq) const {
        const int row0 = u.po * BM + wr * 64 + fr, col0 = u.pn * BM + wc * 32 + 4 * fq;
#pragma unroll
        for (int ai = 0; ai < 2; ++ai)
#pragma unroll
            for (int m = 0; m < 4; ++m) { float* rowp = C + (size_t)(row0 + ai * HALF + m * 16) * ldc + col0;
#pragma unroll
                for (int bj = 0; bj < 2; ++bj)
#pragma unroll
                    for (int n = 0; n < 2; ++n) st16f(rowp + bj * HALF + n * 16, acc[ai][bj][m][n]); }
    }
};
struct EpiBf16 {
    static constexpr bool PERM = true;
    bf16_t* O; int ldc;
    __device__ __forceinline__ void operator()(const f32x4 (&acc)[2][2][4][2], const Unit& u, int wr, int wc, int fr, int fq) const {
        const int row0 = u.po * BM + wr * 64 + fr, col0 = u.pn * BM + wc * 32 + 8 * fq;
#pragma unroll
        for (int ai = 0; ai < 2; ++ai)
#pragma unroll
            for (int m = 0; m < 4; ++m) { bf16_t* rowp = O + (size_t)(row0 + ai * HALF + m * 16) * ldc + col0;
#pragma unroll
                for (int bj = 0; bj < 2; ++bj) { const f32x4 v0 = acc[ai][bj][m][0], v1 = acc[ai][bj][m][1];
                    u32x4 w; w.x = cvt_pk_bf16(v0[0], v0[1]); w.y = cvt_pk_bf16(v0[2], v0[3]); w.z = cvt_pk_bf16(v1[0], v1[1]); w.w = cvt_pk_bf16(v1[2], v1[3]);
                    st16(rowp + bj * HALF, w); } }
    }
};
struct EpiSwiglu {
    static constexpr bool PERM = true;
    bf16_t* O; int ldc; float sc;
    __device__ __forceinline__ void operator()(const f32x4 (&acc)[2][2][4][2], const Unit& u, int wr, int wc, int fr, int fq) const {
        const int row0 = u.po * BM + wr * 64 + fr, col0 = u.pn * HALF + wc * 32 + 8 * fq;
        const float k1 = -1.4426950408889634f * sc, c2 = 1.0f / (sc * sc);
#pragma unroll
        for (int ai = 0; ai < 2; ++ai)
#pragma unroll
            for (int m = 0; m < 4; ++m) { bf16_t* rowp = O + (size_t)(row0 + ai * HALF + m * 16) * ldc + col0;
                float r[8];
#pragma unroll
                for (int n = 0; n < 2; ++n)
#pragma unroll
                    for (int j = 0; j < 4; ++j) { const float ag = acc[ai][0][m][n][j], au = acc[ai][1][m][n][j];
                        const float e = __builtin_amdgcn_exp2f(ag * k1); r[n * 4 + j] = (ag * au) * __builtin_amdgcn_rcpf(fmaf(e, c2, c2)); }
                u32x4 w; w.x = cvt_pk_bf16(r[0], r[1]); w.y = cvt_pk_bf16(r[2], r[3]); w.z = cvt_pk_bf16(r[4], r[5]); w.w = cvt_pk_bf16(r[6], r[7]);
                st16(rowp, w); }
    }
};
constexpr int HM_TPB = 4352;
struct EpiKV {
    static constexpr bool PERM = true;
    bf16_t* Kp; int ldk; bf16_t* Vp; int ldv;
    __device__ __forceinline__ void operator()(const f32x4 (&acc)[2][2][4][2], const Unit& u, int wr, int wc, int fr, int fq) const {
        const int row0 = u.po * BM + wr * 64 + fr, within = wc * 32 + 8 * fq, bb = u.po / 17;
#pragma unroll
        for (int ai = 0; ai < 2; ++ai)
#pragma unroll
            for (int m = 0; m < 4; ++m) { const size_t row = (size_t)(row0 + ai * HALF + m * 16);
#pragma unroll
                for (int bj = 0; bj < 2; ++bj) { const int head = u.pn * 2 + bj; const f32x4 v0 = acc[ai][bj][m][0], v1 = acc[ai][bj][m][1];
                    u32x4 w; w.x = cvt_pk_bf16(v0[0], v0[1]); w.y = cvt_pk_bf16(v0[2], v0[3]); w.z = cvt_pk_bf16(v1[0], v1[1]); w.w = cvt_pk_bf16(v1[2], v1[3]);
                    const size_t hrow = (size_t)(bb * 16 + head) * HM_TPB + (row - (size_t)bb * HM_TPB);
                    bf16_t* dst = (within < 64) ? (Kp + hrow * 96 + within) : (Vp + hrow * 64 + (within - 64));
                    st16(dst, w); } }
    }
};

struct EpiRopeD {
    static constexpr bool PERM = true;
    bf16_t* Qp; bf16_t* Kp; bf16_t* Vp; const float* rt; float qs;
    __device__ __forceinline__ void operator()(const f32x4 (&acc)[2][2][4][2], const Unit& u, int wr, int wc, int fr, int fq) const {
        const int row0 = u.po * BM + wr * 64 + fr, cw = wc * 32 + 8 * fq, bb = u.po / 17;
        if (u.pn >= 8) {
#pragma unroll
            for (int ai = 0; ai < 2; ++ai)
#pragma unroll
                for (int m = 0; m < 4; ++m) { const size_t prow = (size_t)(row0 + ai * HALF + m * 16) - (size_t)bb * HM_TPB;
#pragma unroll
                    for (int bj = 0; bj < 2; ++bj) { const f32x4 v0 = acc[ai][bj][m][0], v1 = acc[ai][bj][m][1];
                        u32x4 w; w.x = cvt_pk_bf16(v0[0], v0[1]); w.y = cvt_pk_bf16(v0[2], v0[3]); w.z = cvt_pk_bf16(v1[0], v1[1]); w.w = cvt_pk_bf16(v1[2], v1[3]);
                        const int vh = (u.pn - 8) * 2 + bj;
                        st16(Vp + ((size_t)(bb * 8 + vh) * HM_TPB + prow) * 128 + cw, w); } }
            return; }
        const bool isq = u.pn < 4; const float osc = isq ? qs : 1.0f;
        const int tb = u.pm % 17; const bool isctx = (tb == 0), colpart = (wc & 1) != 0, x2 = (fq & 2) != 0;
        const int f0 = 8 * (fq & 1);
#pragma unroll
        for (int ai = 0; ai < 2; ++ai)
#pragma unroll
            for (int m = 0; m < 4; ++m) {
                const int pos = colpart ? (16 * m + fr) : ((tb - 1) * 4 + 2 * ai + wr);
                f32x4 cs[4];
#pragma unroll
                for (int q = 0; q < 4; ++q) cs[q] = isctx ? (f32x4){1.f, 0.f, 1.f, 0.f} : *(const f32x4*)(rt + ((size_t)(isctx ? 0 : pos) * 32 + f0 + 2 * q) * 2);
                const size_t grow = (size_t)(row0 + ai * HALF + m * 16), prow = grow - (size_t)bb * HM_TPB;
#pragma unroll
                for (int bj = 0; bj < 2; ++bj) { float r[8];
#pragma unroll
                    for (int e = 0; e < 8; ++e) { const float x = acc[ai][bj][m][e >> 2][e & 3] * osc; const float xp = __shfl_xor(x, 32);
                        const float c = cs[e >> 1][2 * (e & 1)], sn = cs[e >> 1][2 * (e & 1) + 1];
                        r[e] = x2 ? (x * c + xp * sn) : (x * c - xp * sn); }
                    u32x4 w; w.x = cvt_pk_bf16(r[0], r[1]); w.y = cvt_pk_bf16(r[2], r[3]); w.z = cvt_pk_bf16(r[4], r[5]); w.w = cvt_pk_bf16(r[6], r[7]);
                    const int cc = cw + bj * HALF;
                    bf16_t* dst = isq ? Qp + grow * 1024 + u.pn * BM + cc : Kp + ((size_t)(bb * 16 + (u.pn - 4) * 4 + (cc >> 6)) * HM_TPB + prow) * 64 + (cc & 63);
                    st16(dst, w); } }
    }
};

struct EpiRopeB {
    static constexpr bool PERM = true;
    bf16_t* O; const float* rt; float qs;
    __device__ __forceinline__ void operator()(const f32x4 (&acc)[2][2][4][2], const Unit& u, int wr, int wc, int fr, int fq) const {
        const int row0 = u.po * BM + wr * 64 + fr, col0 = u.pn * BM + wc * 32 + 8 * fq;
        const int tb = u.pm % 17; const bool isctx = (tb == 0), colpart = (fq & 2) != 0, x2 = (fq & 1) != 0;
#pragma unroll
        for (int ai = 0; ai < 2; ++ai)
#pragma unroll
            for (int m = 0; m < 4; ++m) {
                const int pos = colpart ? (16 * m + fr) : ((tb - 1) * 4 + 2 * ai + wr);
                f32x4 cs[4];
#pragma unroll
                for (int q = 0; q < 4; ++q) cs[q] = isctx ? (f32x4){1.f, 0.f, 1.f, 0.f} : *(const f32x4*)(rt + ((size_t)(isctx ? 0 : pos) * 32 + 2 * q) * 2);
                bf16_t* rowp = O + (size_t)(row0 + ai * HALF + m * 16) * 1536 + col0;
#pragma unroll
                for (int bj = 0; bj < 2; ++bj) { const bool rope = ((u.pn * 8 + bj * 4 + wc) % 3) == 2;
                    float r[8];
#pragma unroll
                    for (int e = 0; e < 8; ++e) { const float x = acc[ai][bj][m][e >> 2][e & 3] * qs; const float xp = __shfl_xor(x, 16);
                        const float c = cs[e >> 1][2 * (e & 1)], sn = cs[e >> 1][2 * (e & 1) + 1];
                        r[e] = rope ? (x2 ? (x * c + xp * sn) : (x * c - xp * sn)) : x; }
                    u32x4 w; w.x = cvt_pk_bf16(r[0], r[1]); w.y = cvt_pk_bf16(r[2], r[3]); w.z = cvt_pk_bf16(r[4], r[5]); w.w = cvt_pk_bf16(r[6], r[7]);
                    st16(rowp + bj * HALF, w); } }
    }
};

struct EpiNormRopeC {
    static constexpr bool PERM = true;
    bf16_t* Qp; bf16_t* Kp; bf16_t* Vp; const float* qg; const float* kg; const float* rt; LAS float* xch; float qs;
    __device__ __forceinline__ void operator()(const f32x4 (&acc)[2][2][4][2], const Unit& u, int wr, int wc, int fr, int fq) const {
        const int row0 = u.po * BM + wr * 64 + fr, bb = u.po / 17;
        if (u.pn == 5) {
#pragma unroll
            for (int ai = 0; ai < 2; ++ai)
#pragma unroll
                for (int m = 0; m < 4; ++m) { const size_t prow = (size_t)(row0 + ai * HALF + m * 16) - (size_t)bb * HM_TPB;
#pragma unroll
                    for (int bj = 0; bj < 2; ++bj) { const f32x4 v0 = acc[ai][bj][m][0], v1 = acc[ai][bj][m][1];
                        u32x4 w; w.x = cvt_pk_bf16(v0[0], v0[1]); w.y = cvt_pk_bf16(v0[2], v0[3]); w.z = cvt_pk_bf16(v1[0], v1[1]); w.w = cvt_pk_bf16(v1[2], v1[3]);
                        st16(Vp + ((size_t)(bb * 2 + bj) * HM_TPB + prow) * 128 + wc * 32 + 8 * fq, w); } }
            asm volatile("s_waitcnt lgkmcnt(0)" ::: "memory"); __builtin_amdgcn_s_barrier(); asm volatile("" ::: "memory");
            return; }
#pragma unroll
        for (int ai = 0; ai < 2; ++ai)
#pragma unroll
            for (int m = 0; m < 4; ++m)
#pragma unroll
                for (int bj = 0; bj < 2; ++bj) { const f32x4 v0 = acc[ai][bj][m][0], v1 = acc[ai][bj][m][1];
                    float sq = (v0[0] * v0[0] + v0[1] * v0[1]) + (v0[2] * v0[2] + v0[3] * v0[3]) + (v1[0] * v1[0] + v1[1] * v1[1]) + (v1[2] * v1[2] + v1[3] * v1[3]);
                    sq += __shfl_xor(sq, 16); sq += __shfl_xor(sq, 32);
                    if (fq == 0) xch[((ai * HALF + wr * 64 + m * 16 + fr) * 2 + bj) * 4 + wc] = sq; }
        asm volatile("s_waitcnt lgkmcnt(0)" ::: "memory"); __builtin_amdgcn_s_barrier(); asm volatile("" ::: "memory");
        const bool isq = u.pn < 4; const float* gv = isq ? qg : kg;
        const int d0 = 64 * (wc >> 1) + 32 * (fq >> 1) + 16 * (wc & 1) + 8 * (fq & 1);
        const f32x4 ga = *(const f32x4*)(gv + d0), gb = *(const f32x4*)(gv + d0 + 4);
        const int tb = u.pm % 17; const bool isctx = (tb == 0), colpart = (wc >> 1) != 0, x2 = (fq >> 1) != 0;
        const int f0 = d0 & 31;
#pragma unroll
        for (int ai = 0; ai < 2; ++ai)
#pragma unroll
            for (int m = 0; m < 4; ++m) {
                const int pos = colpart ? (16 * m + fr) : ((tb - 1) * 4 + 2 * ai + wr);
                f32x4 cs[4];
#pragma unroll
                for (int q = 0; q < 4; ++q) cs[q] = isctx ? (f32x4){1.f, 0.f, 1.f, 0.f} : *(const f32x4*)(rt + ((size_t)(isctx ? 0 : pos) * 32 + f0 + 2 * q) * 2);
                const int rl = ai * HALF + wr * 64 + m * 16 + fr; const size_t row = (size_t)(row0 + ai * HALF + m * 16);
#pragma unroll
                for (int bj = 0; bj < 2; ++bj) { const f32x4 ps = *(const LAS f32x4*)(xch + (rl * 2 + bj) * 4);
                    const float rstd = rsqrtf(((ps[0] + ps[1]) + (ps[2] + ps[3])) * (1.0f / 128.0f) + 1e-6f) * (isq ? qs : 1.0f);
                    const int head = 2 * u.pn + bj; float r[8];
#pragma unroll
                    for (int e = 0; e < 8; ++e) { const float y = acc[ai][bj][m][e >> 2][e & 3] * rstd * (e < 4 ? ga[e] : gb[e - 4]); const float yp = __shfl_xor(y, 32);
                        const float c = cs[e >> 1][2 * (e & 1)], sn = cs[e >> 1][2 * (e & 1) + 1];
                        r[e] = x2 ? (y * c + yp * sn) : (y * c - yp * sn); }
                    u32x4 w; w.x = cvt_pk_bf16(r[0], r[1]); w.y = cvt_pk_bf16(r[2], r[3]); w.z = cvt_pk_bf16(r[4], r[5]); w.w = cvt_pk_bf16(r[6], r[7]);
                    bf16_t* dst = isq ? Qp + row * 1024 + head * 128 + d0 : Kp + ((size_t)(bb * 2 + (head - 8)) * HM_TPB + (row - (size_t)bb * HM_TPB)) * 128 + d0;
                    st16(dst, w); } }
    }
};

template <class Epi, class Sched, bool GATHER, bool FP8 = false>
__device__ __forceinline__ void gemm_phase(LAS unsigned char* lds, const Gemm g, const Sched& S, const Epi& E, const int wid) {
    const int lane = fresh_lane(), tid = wid * 64 + lane, wr = wid >> 2, wc = wid & 3, fr = lane & 15, fq = lane >> 4;
    const int K = g.K, nt = g.nt;
    unsigned voffA[2], voffB[2];
#pragma unroll
    for (int i = 0; i < 2; ++i) { int R, C; stage_rc(tid * 16 + i * 8192, R, C); const int Rb = Epi::PERM ? ((R & ~31) + perm32(R & 31)) : R;
        voffA[i] = (unsigned)(R * K + C) * 2u; voffB[i] = (unsigned)(Rb * K + C) * 2u; }
    const size_t kstep = (size_t)(BK * 2);
    const size_t hstep = (size_t)HALF * K * 2;
    const size_t tstep = 2 * hstep;
    const unsigned ldsw = (unsigned)wid * 1024u;
    const int aoff = lds_byte(wr * 64 + fr, fq * 8), boff = lds_byte(wc * 32 + fr, fq * 8);
#define PG8_SA(b, h) (((b) * 2 + (h)) * HTB)
#define PG8_SB(b, h) ((4 + (b) * 2 + (h)) * HTB)
#define PG8_STAGE(bufoff, gbase, voff) do { _Pragma("unroll") for (int _i = 0; _i < 2; ++_i) \
        __builtin_amdgcn_global_load_lds((const unsigned*)((const char*)(gbase) + (voff)[_i]), (LAS unsigned*)(lds + (bufoff) + ldsw + _i * 8192), 16, 0, 0); } while (0)
#define PG8_STAGE_A(bufoff, Ap, G, h, kb) do { if constexpr (GATHER) { PG8_STAGE(bufoff, (const char*)g.A + (kb), (G)[h]); } else { PG8_STAGE(bufoff, (Ap) + (size_t)(h) * hstep + (kb), voffA); } } while (0)
#define PG8_LD16(off) (*(const LAS u32x4*)(lds + (off)))
#define PG8_LDA(dst, b, h) do { _Pragma("unroll") for (int m = 0; m < 4; ++m) { if constexpr (FP8) { dst##8[m] = __builtin_bit_cast(v8i32, __builtin_shufflevector(PG8_LD16(PG8_SA(b, h) + aoff + m * 2048), PG8_LD16(PG8_SA(b, h) + aoff + m * 2048 + 1024), 0, 1, 2, 3, 4, 5, 6, 7)); } \
        else { _Pragma("unroll") for (int k = 0; k < 2; ++k) dst[m][k] = *(const LAS bf16x8*)(lds + PG8_SA(b, h) + aoff + m * 2048 + k * 1024); } } } while (0)
#define PG8_LDB(dst, b, h) do { _Pragma("unroll") for (int n = 0; n < 2; ++n) { if constexpr (FP8) { dst##8[n] = __builtin_bit_cast(v8i32, __builtin_shufflevector(PG8_LD16(PG8_SB(b, h) + boff + n * 2048), PG8_LD16(PG8_SB(b, h) + boff + n * 2048 + 1024), 0, 1, 2, 3, 4, 5, 6, 7)); } \
        else { _Pragma("unroll") for (int k = 0; k < 2; ++k) dst[n][k] = *(const LAS bf16x8*)(lds + PG8_SB(b, h) + boff + n * 2048 + k * 1024); } } } while (0)
#define PG8_MMA(ai, bj, At, Bt) do { __builtin_amdgcn_s_setprio(1); _Pragma("unroll") for (int m = 0; m < 4; ++m) _Pragma("unroll") for (int n = 0; n < 2; ++n) { \
        if constexpr (FP8) { asm volatile("v_mfma_scale_f32_16x16x128_f8f6f4 %0, %1, %2, %0, %3, %3 op_sel_hi:[0,0,0]" : "+v"(acc[ai][bj][m][n]) : "v"(Bt##8[n]), "v"(At##8[m]), "v"(sc7f)); } \
        else { _Pragma("unroll") for (int k = 0; k < 2; ++k) acc[ai][bj][m][n] = __builtin_amdgcn_mfma_f32_16x16x32_bf16(Bt[n][k], At[m][k], acc[ai][bj][m][n], 0, 0, 0); } } \
        __builtin_amdgcn_s_setprio(0); } while (0)
#define PG8_WAIT_V(n) asm volatile("s_waitcnt vmcnt(" #n ")" ::: "memory")
#define PG8_WAIT_L(n) asm volatile("s_waitcnt lgkmcnt(" #n ")" ::: "memory")
#define PG8_BAR __builtin_amdgcn_s_barrier()
#define PG8_SCHED __builtin_amdgcn_sched_barrier(0)
    LAS unsigned char* tokt = lds + STAGE_BYTES;
#define PG8_TOKDMA(u, slot) do { if constexpr (GATHER) { if (wid < 4) { const unsigned _cn = (unsigned)g.cnt[(u).e]; const unsigned _s = (unsigned)((u).pl * BM + tid); \
        __builtin_amdgcn_global_load_lds((const unsigned*)(g.list + (size_t)(u).e * g.list_stride + (_s < _cn ? _s : _cn - 1u)), (LAS unsigned*)(tokt + (slot) * 1024 + wid * 256), 4, 0, 0); } } } while (0)
#define PG8_GOFFS(go, slot) do { if constexpr (GATHER) { \
        _Pragma("unroll") for (int _h = 0; _h < 2; ++_h) _Pragma("unroll") for (int _i = 0; _i < 2; ++_i) { int _R, _C; stage_rc(tid * 16 + _i * 8192, _R, _C); \
            const unsigned _t = *(const LAS unsigned*)(tokt + (slot) * 1024 + (_h * HALF + _R) * 4); (go)[_h][_i] = (_t * (unsigned)K + (unsigned)_C) * 2u; } } } while (0)
    Unit cur, nxt; int ui = 0;
    if (!S.next(0, cur)) return;
    f32x4 acc[2][2][4][2];
#pragma unroll
    for (int a = 0; a < 2; ++a)
#pragma unroll
        for (int b = 0; b < 2; ++b)
#pragma unroll
            for (int m = 0; m < 4; ++m)
#pragma unroll
                for (int n = 0; n < 2; ++n) acc[a][b][m][n] = (f32x4){0.f, 0.f, 0.f, 0.f};
    const unsigned sc7f = 0x7F7F7F7Fu;
    bf16x8 At[4][2], B0[2][2], B1[2][2]; v8i32 At8[4], B08[2], B18[2];
    unsigned gcur[2][2] = {{0u, 0u}, {0u, 0u}};
    const char* cA = (const char*)g.A + (size_t)cur.pm * tstep + (size_t)cur.kt0 * kstep; const char* cB = (const char*)g.Bt + ((size_t)cur.e * g.bstride) * 2 + (size_t)cur.pn * tstep + (size_t)cur.kt0 * kstep;
    if constexpr (GATHER) { PG8_TOKDMA(cur, 0); asm volatile("s_waitcnt vmcnt(0)" ::: "memory"); __builtin_amdgcn_s_barrier(); asm volatile("" ::: "memory"); }
    PG8_GOFFS(gcur, 0);
    PG8_STAGE(PG8_SB(0, 0), cB, voffB); PG8_STAGE(PG8_SB(0, 1), cB + hstep, voffB); PG8_STAGE_A(PG8_SA(0, 0), cA, gcur, 0, 0); PG8_STAGE_A(PG8_SA(0, 1), cA, gcur, 1, 0);
    if (wr == 1) PG8_BAR;
    PG8_WAIT_V(2); PG8_BAR;
    PG8_STAGE(PG8_SB(1, 0), cB + kstep, voffB); PG8_STAGE_A(PG8_SA(1, 0), cA, gcur, 0, kstep); PG8_STAGE(PG8_SB(1, 1), cB + hstep + kstep, voffB);
    PG8_WAIT_V(6); PG8_BAR;
    for (;;) {
        const bool has_next = S.next(ui + 1, nxt);
        if constexpr (GATHER) { if (has_next) PG8_TOKDMA(nxt, (ui + 1) & 1); }
        const char* nA = has_next ? (const char*)g.A + (size_t)nxt.pm * tstep + (size_t)nxt.kt0 * kstep : cA; const char* nB = has_next ? (const char*)g.Bt + ((size_t)nxt.e * g.bstride) * 2 + (size_t)nxt.pn * tstep + (size_t)nxt.kt0 * kstep : cB;
#pragma unroll 1
        for (int t = 0; t < nt; t += 2) {
            const bool last = (t == nt - 2);
            const size_t kb1 = (size_t)(t + 1) * kstep;
            const char* a2p = last ? nA : cA; const size_t kb2 = last ? (size_t)0 : (size_t)(t + 2) * kstep;
            const char* b2 = last ? nB : cB + (size_t)(t + 2) * kstep;
            const size_t kb3 = kb2 + kstep; const char* b3 = b2 + kstep;
            PG8_LDB(B0, 0, 0); PG8_LDB(B1, 0, 1); PG8_SCHED; PG8_LDA(At, 0, 0); PG8_STAGE_A(PG8_SA(1, 1), cA, gcur, 1, kb1);
            if constexpr (GATHER) { if (last && has_next) { PG8_GOFFS(gcur, (ui + 1) & 1); } }
            PG8_WAIT_V(8); PG8_WAIT_L(0); PG8_BAR; PG8_MMA(0, 0, At, B0); PG8_MMA(0, 1, At, B1); PG8_BAR; PG8_SCHED;
            PG8_LDA(At, 0, 1); PG8_STAGE(PG8_SB(0, 0), b2, voffB); PG8_STAGE(PG8_SB(0, 1), b2 + hstep, voffB); PG8_STAGE_A(PG8_SA(0, 0), a2p, gcur, 0, kb2);
            PG8_WAIT_V(8); PG8_WAIT_L(0); PG8_BAR; PG8_MMA(1, 0, At, B0); PG8_MMA(1, 1, At, B1); PG8_BAR; PG8_SCHED;
            PG8_LDB(B0, 1, 0); PG8_LDB(B1, 1, 1); PG8_SCHED; PG8_LDA(At, 1, 0); PG8_STAGE_A(PG8_SA(0, 1), a2p, gcur, 1, kb2);
            PG8_WAIT_V(8); PG8_WAIT_L(0); PG8_BAR; PG8_MMA(0, 0, At, B0); PG8_MMA(0, 1, At, B1); PG8_BAR; PG8_SCHED;
            PG8_LDA(At, 1, 1); PG8_STAGE(PG8_SB(1, 0), b3, voffB); PG8_STAGE(PG8_SB(1, 1), b3 + hstep, voffB); PG8_STAGE_A(PG8_SA(1, 0), a2p, gcur, 0, kb3);
            PG8_WAIT_V(8); PG8_WAIT_L(0); PG8_BAR; PG8_MMA(1, 0, At, B0); PG8_MMA(1, 1, At, B1); PG8_BAR; PG8_SCHED;
        }
        if (wr == 0) PG8_BAR;
        if constexpr (FP8) asm volatile("s_nop 15\n\ts_nop 15\n\ts_nop 15\n\ts_nop 15" ::: "memory");
        E(acc, cur, wr, wc, fr, fq);
        if (!has_next) break;
#pragma unroll
        for (int a = 0; a < 2; ++a)
#pragma unroll
            for (int b = 0; b < 2; ++b)
#pragma unroll
                for (int m = 0; m < 4; ++m)
#pragma unroll
                    for (int n = 0; n < 2; ++n) acc[a][b][m][n] = (f32x4){0.f, 0.f, 0.f, 0.f};
        cur = nxt; cA = nA; cB = nB; ++ui;
        if (wr == 1) PG8_BAR;
    }
    PG8_WAIT_V(0);
    PG8_BAR;
#undef PG8_SA
#undef PG8_SB
#undef PG8_STAGE
#undef PG8_STAGE_A
#undef PG8_LDA
#undef PG8_LDB
#undef PG8_MMA
#undef PG8_LD16
#undef PG8_WAIT_V
#undef PG8_WAIT_L
#undef PG8_BAR
#undef PG8_SCHED
#undef PG8_GOFFS
#undef PG8_TOKDMA
}
}
namespace att {
constexpr int NW = 8, QBLK = 32, KVBLK = 64;
constexpr float THR = 8.f;
#define ATT_SBAR() __builtin_amdgcn_sched_barrier(0)
template <int DK> __device__ __forceinline__ int kswz(int row, int colB) { return row * (DK * 2 + 16) + colB; }
__device__ __forceinline__ int crow(int r, int hi) { return (r & 3) + 8 * (r >> 2) + 4 * hi; }
__device__ __forceinline__ void partialSM(f32x16& p0, f32x16& p1, float& m_reg, float& mn, float& alpha, const float C, const float thr_raw) {
    float pmax = p0[0];
#pragma unroll
    for (int r = 1; r < 16; ++r) pmax = fmaxf(pmax, p0[r]);
#pragma unroll
    for (int r = 0; r < 16; ++r) pmax = fmaxf(pmax, p1[r]);
    { auto rr = __builtin_amdgcn_permlane32_swap(__float_as_uint(pmax), __float_as_uint(pmax), false, false);
      pmax = fmaxf(__uint_as_float(rr[0]), __uint_as_float(rr[1])); }
    if (__builtin_expect(__all(pmax - m_reg <= thr_raw), 1)) { mn = m_reg; alpha = 1.f; }
    else { mn = fmaxf(m_reg, pmax); alpha = __builtin_amdgcn_exp2f((m_reg - mn) * C); m_reg = mn; }
    const float mnC = -mn * C;
#pragma unroll
    for (int r = 0; r < 16; ++r) p0[r] = fmaf(p0[r], C, mnC);
#pragma unroll
    for (int r = 0; r < 16; ++r) p1[r] = fmaf(p1[r], C, mnC);
#pragma unroll
    for (int r = 0; r < 16; ++r) p0[r] = __builtin_amdgcn_exp2f(p0[r]);
}
__device__ __forceinline__ void finishSM(f32x16& p0, f32x16& p1, float alpha, float& l_reg, bf16x8& pa0, bf16x8& pa1, bf16x8& pa2, bf16x8& pa3) {
#pragma unroll
    for (int r = 0; r < 16; ++r) p1[r] = __builtin_amdgcn_exp2f(p1[r]);
#if MK_PROBE_ATT == 2
    { float dz = 0.f;
#pragma unroll
      for (int r = 0; r < 16; ++r) { dz += __builtin_amdgcn_exp2f(p0[r] - 1.0f); dz += __builtin_amdgcn_exp2f(p1[r] - 2.0f); }
      asm volatile("" :: "v"(dz)); }
#endif
    float ps = 0;
#pragma unroll
    for (int r = 0; r < 16; ++r) ps += p0[r];
#pragma unroll
    for (int r = 0; r < 16; ++r) ps += p1[r];
    { auto rr = __builtin_amdgcn_permlane32_swap(__float_as_uint(ps), __float_as_uint(ps), false, false);
      ps = __uint_as_float(rr[0]) + __uint_as_float(rr[1]); }
    l_reg = l_reg * alpha + ps;
#define ATT_PK4(P, BASE, OUT) do { unsigned a0 = cvt_pk_bf16(P[BASE + 0], P[BASE + 1]), a1 = cvt_pk_bf16(P[BASE + 2], P[BASE + 3]);   \
    unsigned b0 = cvt_pk_bf16(P[BASE + 4], P[BASE + 5]), b1 = cvt_pk_bf16(P[BASE + 6], P[BASE + 7]);                              \
    auto r0 = __builtin_amdgcn_permlane32_swap(a0, b0, false, false); auto r1 = __builtin_amdgcn_permlane32_swap(a1, b1, false, false); \
    u32x4 w = {r0[0], r1[0], r0[1], r1[1]}; OUT = *reinterpret_cast<bf16x8*>(&w); } while (0)
    ATT_PK4(p0, 0, pa0); ATT_PK4(p0, 8, pa1); ATT_PK4(p1, 0, pa2); ATT_PK4(p1, 8, pa3);
#undef ATT_PK4
}
#ifndef MK_PROBE_ATT
#define MK_PROBE_ATT 0
#endif
template <int DK> __device__ __forceinline__ void qkt(f32x16& p0, f32x16& p1, const char* Ks, const bf16x8* qr, int r32, int hi) {
    p0 = f32x16{}; p1 = f32x16{};
#if MK_PROBE_ATT == 1
    f32x16 d0_ = f32x16{}; d0_[0] = 1.0f;
#endif
#pragma unroll
    for (int d0 = 0; d0 < DK / 16; ++d0) { const int cb = (d0 * 16 + hi * 8) * 2;
        const bf16x8 b0 = *reinterpret_cast<const bf16x8*>(Ks + kswz<DK>(r32, cb));
        const bf16x8 b1 = *reinterpret_cast<const bf16x8*>(Ks + kswz<DK>(32 + r32, cb));
        p0 = __builtin_amdgcn_mfma_f32_32x32x16_bf16(b0, qr[d0], p0, 0, 0, 0);
        p1 = __builtin_amdgcn_mfma_f32_32x32x16_bf16(b1, qr[d0], p1, 0, 0, 0);
#if MK_PROBE_ATT == 1
        d0_ = __builtin_amdgcn_mfma_f32_32x32x16_bf16(b0, qr[d0], d0_, 0, 0, 0);
        d0_ = __builtin_amdgcn_mfma_f32_32x32x16_bf16(b1, qr[d0], d0_, 0, 0, 0);
#endif
    }
#if MK_PROBE_ATT == 1
    asm volatile("" :: "v"(d0_));
#endif
}
template <int DV> __device__ __forceinline__ int v_st_nat(int k, int c) { return ((k >> 3) * (DV / 32) + (c >> 5)) * 512 + ((k & 7) * 32 + (c & 31)) * 2; }
template <int DV> __device__ __forceinline__ int v_st(int k, int c) { const int kk = (k & ~0xC) | ((k & 4) << 1) | ((k & 8) >> 1); return ((kk >> 3) * (DV / 32) + (c >> 5)) * 512 + ((kk & 7) * 32 + (c & 31)) * 2; }
__device__ __forceinline__ int v_rd_base(int lane) { return ((lane & 3) << 3) | (((lane >> 2) & 3) << 6) | (((lane >> 4) & 1) << 5) | (((lane >> 5) & 1) << 8); }
template <int DV> constexpr int v_rd_off(int d0, int ks, int half) { return d0 * 512 + ks * (DV / 32) * 1024 + half * (DV / 32) * 512; }
template <int OFF> __device__ __forceinline__ s16x4 tr_read(int vb) {
    s16x4 r; asm volatile("ds_read_b64_tr_b16 %0, %1 offset:%2" : "=&v"(r) : "v"(vb), "i"(OFF) : "memory"); return r;
}
template <int DV, int D0> __device__ __forceinline__ void pv_one(f32x16& od, int vb, bf16x8 pa0, bf16x8 pa1, bf16x8 pa2, bf16x8 pa3) {
    const s16x4 l0 = tr_read<v_rd_off<DV>(D0, 0, 0)>(vb), h0 = tr_read<v_rd_off<DV>(D0, 0, 1)>(vb), l1 = tr_read<v_rd_off<DV>(D0, 1, 0)>(vb), h1 = tr_read<v_rd_off<DV>(D0, 1, 1)>(vb);
    const s16x4 l2 = tr_read<v_rd_off<DV>(D0, 2, 0)>(vb), h2 = tr_read<v_rd_off<DV>(D0, 2, 1)>(vb), l3 = tr_read<v_rd_off<DV>(D0, 3, 0)>(vb), h3 = tr_read<v_rd_off<DV>(D0, 3, 1)>(vb);
    asm volatile("s_waitcnt lgkmcnt(0)" ::: "memory"); ATT_SBAR();
#define ATT_PK(L, H) (bf16x8){L[0], L[1], L[2], L[3], H[0], H[1], H[2], H[3]}
    od = __builtin_amdgcn_mfma_f32_32x32x16_bf16(pa0, ATT_PK(l0, h0), od, 0, 0, 0);
    od = __builtin_amdgcn_mfma_f32_32x32x16_bf16(pa1, ATT_PK(l1, h1), od, 0, 0, 0);
    od = __builtin_amdgcn_mfma_f32_32x32x16_bf16(pa2, ATT_PK(l2, h2), od, 0, 0, 0);
    od = __builtin_amdgcn_mfma_f32_32x32x16_bf16(pa3, ATT_PK(l3, h3), od, 0, 0, 0);
#undef ATT_PK
}
template <int DV, int D0> __device__ __forceinline__ void pv_two(f32x16& oa, f32x16& ob, int vb, bf16x8 pa0, bf16x8 pa1, bf16x8 pa2, bf16x8 pa3) {
    const s16x4 l0 = tr_read<v_rd_off<DV>(D0, 0, 0)>(vb), h0 = tr_read<v_rd_off<DV>(D0, 0, 1)>(vb), l1 = tr_read<v_rd_off<DV>(D0, 1, 0)>(vb), h1 = tr_read<v_rd_off<DV>(D0, 1, 1)>(vb);
    const s16x4 l2 = tr_read<v_rd_off<DV>(D0, 2, 0)>(vb), h2 = tr_read<v_rd_off<DV>(D0, 2, 1)>(vb), l3 = tr_read<v_rd_off<DV>(D0, 3, 0)>(vb), h3 = tr_read<v_rd_off<DV>(D0, 3, 1)>(vb);
    const s16x4 m0 = tr_read<v_rd_off<DV>(D0 + 1, 0, 0)>(vb), n0 = tr_read<v_rd_off<DV>(D0 + 1, 0, 1)>(vb), m1 = tr_read<v_rd_off<DV>(D0 + 1, 1, 0)>(vb), n1 = tr_read<v_rd_off<DV>(D0 + 1, 1, 1)>(vb);
    const s16x4 m2 = tr_read<v_rd_off<DV>(D0 + 1, 2, 0)>(vb), n2 = tr_read<v_rd_off<DV>(D0 + 1, 2, 1)>(vb), m3 = tr_read<v_rd_off<DV>(D0 + 1, 3, 0)>(vb), n3 = tr_read<v_rd_off<DV>(D0 + 1, 3, 1)>(vb);
    asm volatile("s_waitcnt lgkmcnt(0)" ::: "memory"); ATT_SBAR();
#define ATT_PK(L, H) (bf16x8){L[0], L[1], L[2], L[3], H[0], H[1], H[2], H[3]}
    oa = __builtin_amdgcn_mfma_f32_32x32x16_bf16(pa0, ATT_PK(l0, h0), oa, 0, 0, 0);
    ob = __builtin_amdgcn_mfma_f32_32x32x16_bf16(pa0, ATT_PK(m0, n0), ob, 0, 0, 0);
    oa = __builtin_amdgcn_mfma_f32_32x32x16_bf16(pa1, ATT_PK(l1, h1), oa, 0, 0, 0);
    ob = __builtin_amdgcn_mfma_f32_32x32x16_bf16(pa1, ATT_PK(m1, n1), ob, 0, 0, 0);
    oa = __builtin_amdgcn_mfma_f32_32x32x16_bf16(pa2, ATT_PK(l2, h2), oa, 0, 0, 0);
    ob = __builtin_amdgcn_mfma_f32_32x32x16_bf16(pa2, ATT_PK(m2, n2), ob, 0, 0, 0);
    oa = __builtin_amdgcn_mfma_f32_32x32x16_bf16(pa3, ATT_PK(l3, h3), oa, 0, 0, 0);
    ob = __builtin_amdgcn_mfma_f32_32x32x16_bf16(pa3, ATT_PK(m3, n3), ob, 0, 0, 0);
#undef ATT_PK
}
struct VFrag64 { s16x4 l[2][4], h[2][4]; };
template <int DV> __device__ __forceinline__ void pv_issue(VFrag64& f, int vb) {
    f.l[0][0] = tr_read<v_rd_off<DV>(0, 0, 0)>(vb); f.h[0][0] = tr_read<v_rd_off<DV>(0, 0, 1)>(vb); f.l[0][1] = tr_read<v_rd_off<DV>(0, 1, 0)>(vb); f.h[0][1] = tr_read<v_rd_off<DV>(0, 1, 1)>(vb);
    f.l[0][2] = tr_read<v_rd_off<DV>(0, 2, 0)>(vb); f.h[0][2] = tr_read<v_rd_off<DV>(0, 2, 1)>(vb); f.l[0][3] = tr_read<v_rd_off<DV>(0, 3, 0)>(vb); f.h[0][3] = tr_read<v_rd_off<DV>(0, 3, 1)>(vb);
    f.l[1][0] = tr_read<v_rd_off<DV>(1, 0, 0)>(vb); f.h[1][0] = tr_read<v_rd_off<DV>(1, 0, 1)>(vb); f.l[1][1] = tr_read<v_rd_off<DV>(1, 1, 0)>(vb); f.h[1][1] = tr_read<v_rd_off<DV>(1, 1, 1)>(vb);
    f.l[1][2] = tr_read<v_rd_off<DV>(1, 2, 0)>(vb); f.h[1][2] = tr_read<v_rd_off<DV>(1, 2, 1)>(vb); f.l[1][3] = tr_read<v_rd_off<DV>(1, 3, 0)>(vb); f.h[1][3] = tr_read<v_rd_off<DV>(1, 3, 1)>(vb);
}
__device__ __forceinline__ void pv_mma64(f32x16* o, const VFrag64& f, bf16x8 pa0, bf16x8 pa1, bf16x8 pa2, bf16x8 pa3) {
    asm volatile("s_waitcnt lgkmcnt(0)" ::: "memory"); ATT_SBAR();
#define ATT_PK(L, H) (bf16x8){L[0], L[1], L[2], L[3], H[0], H[1], H[2], H[3]}
    o[0] = __builtin_amdgcn_mfma_f32_32x32x16_bf16(pa0, ATT_PK(f.l[0][0], f.h[0][0]), o[0], 0, 0, 0);
    o[1] = __builtin_amdgcn_mfma_f32_32x32x16_bf16(pa0, ATT_PK(f.l[1][0], f.h[1][0]), o[1], 0, 0, 0);
    o[0] = __builtin_amdgcn_mfma_f32_32x32x16_bf16(pa1, ATT_PK(f.l[0][1], f.h[0][1]), o[0], 0, 0, 0);
    o[1] = __builtin_amdgcn_mfma_f32_32x32x16_bf16(pa1, ATT_PK(f.l[1][1], f.h[1][1]), o[1], 0, 0, 0);
    o[0] = __builtin_amdgcn_mfma_f32_32x32x16_bf16(pa2, ATT_PK(f.l[0][2], f.h[0][2]), o[0], 0, 0, 0);
    o[1] = __builtin_amdgcn_mfma_f32_32x32x16_bf16(pa2, ATT_PK(f.l[1][2], f.h[1][2]), o[1], 0, 0, 0);
    o[0] = __builtin_amdgcn_mfma_f32_32x32x16_bf16(pa3, ATT_PK(f.l[0][3], f.h[0][3]), o[0], 0, 0, 0);
    o[1] = __builtin_amdgcn_mfma_f32_32x32x16_bf16(pa3, ATT_PK(f.l[1][3], f.h[1][3]), o[1], 0, 0, 0);
#undef ATT_PK
}
#ifndef MK_PV2
#define MK_PV2 1
#endif
#ifndef MK_VPRE
#define MK_VPRE 0
#endif
#ifndef MK_MBLK
#define MK_MBLK 1
#endif
#ifndef MK_ATT_PRIO
#define MK_ATT_PRIO 1
#endif
template <int DV> __device__ __forceinline__ void pv_d0(f32x16* o, int vb, bf16x8 pa0, bf16x8 pa1, bf16x8 pa2, bf16x8 pa3) {
#if MK_PV2
    pv_two<DV, 0>(o[0], o[1], vb, pa0, pa1, pa2, pa3);
    if constexpr (DV == 128) pv_two<DV, 2>(o[2], o[3], vb, pa0, pa1, pa2, pa3);
#else
    pv_one<DV, 0>(o[0], vb, pa0, pa1, pa2, pa3); pv_one<DV, 1>(o[1], vb, pa0, pa1, pa2, pa3);
    if constexpr (DV == 128) { pv_one<DV, 2>(o[2], vb, pa0, pa1, pa2, pa3); pv_one<DV, 3>(o[3], vb, pa0, pa1, pa2, pa3); }
#endif
}
template <int DK, int DV> constexpr int lds_bytes() { return 3 * KVBLK * DV * 2 + 3 * KVBLK * (DK * 2 + 16) + NW * 64 * 4; }

template <int DK, int DV, int ldq, int ldk, int ldv, int ldo, int SD, int EPI = 0>
__device__ __forceinline__ void attn_unit(const bf16_t* __restrict__ Qb, const bf16_t* __restrict__ Kh, const bf16_t* __restrict__ Vh,
                                          bf16_t* __restrict__ Ob, int seq, const float C, const float thr_raw, char* lds, const int wid, LAS unsigned* stash = nullptr, float lam = 0.f, const float* gvec = nullptr) {
    constexpr int SHM_V = KVBLK * DV * 2, SHM_K = KVBLK * (DK * 2 + 16);
    constexpr int NO = DV / 32, ND = DK / 16;
    const int lane = fresh_lane(), tid = wid * 64 + lane, r32 = lane & 31, hi = lane >> 5;
    char* V_lds = lds; char* K_lds = lds + 3 * SHM_V;
    float* wsf = (float*)(lds + 3 * SHM_V + 3 * SHM_K) + wid * 64; float* li_l = wsf; float* al_l = wsf + 32;
    float m_reg = -1e30f, l_reg = 0; f32x16 o[NO]; bf16x8 qr[ND];
#pragma unroll
    for (int d = 0; d < NO; ++d) o[d] = f32x16{};
    const bf16_t* Qw = Qb + (long)(wid * QBLK + r32) * ldq + hi * 8;
#pragma unroll
    for (int d0 = 0; d0 < ND; ++d0) qr[d0] = *reinterpret_cast<const bf16x8*>(Qw + d0 * 16);
    const int sr = tid >> 4, sc = (tid & 15) * 8; const bool kact = (DK == 128) ? true : (sc < DK), vact = (DV == 128) ? true : (sc < DV);
    const int vst0 = v_st<DV>(sr, vact ? sc : 0), vst1 = v_st<DV>(32 + sr, vact ? sc : 0);
    const int vb0 = (int)(uintptr_t)V_lds + v_rd_base(lane);
    const unsigned koff = (unsigned)(sr * ldk + sc) * 2u, voff = (unsigned)(sr * ldv + sc) * 2u;
    const size_t k32 = (size_t)32 * ldk * 2, v32 = (size_t)32 * ldv * 2;
    struct { bf16x8 vs0, vs1, ks0, ks1; } sr_[SD];
#define ATT_SLOAD(s, k0) do { const char* _kt = (const char*)Kh + (size_t)(k0) * ldk * 2; const char* _vt = (const char*)Vh + (size_t)(k0) * ldv * 2; \
    if (vact) { sr_[s].vs0 = *reinterpret_cast<const bf16x8*>(_vt + voff); sr_[s].vs1 = *reinterpret_cast<const bf16x8*>(_vt + v32 + voff); } \
    if (kact) { sr_[s].ks0 = *reinterpret_cast<const bf16x8*>(_kt + koff); sr_[s].ks1 = *reinterpret_cast<const bf16x8*>(_kt + k32 + koff); } } while (0)
#define ATT_SWRITE(b, s) do { if (vact) { *(bf16x8*)(V_lds + (b) * SHM_V + vst0) = sr_[s].vs0; *(bf16x8*)(V_lds + (b) * SHM_V + vst1) = sr_[s].vs1; } \
    if (kact) { const int kc = sc * 2; *(bf16x8*)(K_lds + (b) * SHM_K + kswz<DK>(sr, kc)) = sr_[s].ks0; *(bf16x8*)(K_lds + (b) * SHM_K + kswz<DK>(32 + sr, kc)) = sr_[s].ks1; } } while (0)
#define ATT_RESC(a) do { if (__any((a) < 1.f)) { if (hi == 0) al_l[r32] = (a); asm volatile("s_waitcnt lgkmcnt(0)" ::: "memory"); \
    _Pragma("unroll") for (int d = 0; d < NO; ++d) _Pragma("unroll") for (int r = 0; r < 16; ++r) o[d][r] *= al_l[crow(r, hi)]; } } while (0)
    f32x16 pA0, pA1, pB0, pB1; float mnA, mnB, alA, alB; bf16x8 pa0, pa1, pa2, pa3; const int NT = seq / KVBLK;
    constexpr int SE = 0, SO = SD - 1;
    constexpr bool VPRE = (DV == 64) && (MK_VPRE != 0); VFrag64 vf;
    __syncthreads();
    ATT_SLOAD(SE, 0); asm volatile("s_waitcnt vmcnt(0)" ::: "memory"); ATT_SWRITE(0, SE); __syncthreads();
    qkt<DK>(pA0, pA1, K_lds, qr, r32, hi); partialSM(pA0, pA1, m_reg, mnA, alA, C, thr_raw);
    ATT_SLOAD(SO, KVBLK); if constexpr (SD == 2) { if (2 < NT) ATT_SLOAD(SE, 2 * KVBLK); }
    ATT_SWRITE(1, SO); __syncthreads();
    int bj = 1;
    for (int j = 1; j + 1 < NT; j += 2) {
        const int bn = (bj == 2) ? 0 : bj + 1, bp = (bj == 0) ? 2 : bj - 1;
        ATT_SBAR(); if constexpr (VPRE) pv_issue<DV>(vf, vb0 + bp * SHM_V);
        qkt<DK>(pB0, pB1, K_lds + bj * SHM_K, qr, r32, hi);
        finishSM(pA0, pA1, alA, l_reg, pa0, pa1, pa2, pa3); ATT_SBAR();
        ATT_SLOAD(SO, (j + SD) * KVBLK); ATT_SBAR();
        if constexpr (VPRE) pv_mma64(o, vf, pa0, pa1, pa2, pa3); else pv_d0<DV>(o, vb0 + bp * SHM_V, pa0, pa1, pa2, pa3);
        partialSM(pB0, pB1, m_reg, mnB, alB, C, thr_raw);
        ATT_SWRITE(bn, SE);
        ATT_RESC(alB); __syncthreads();
        ATT_SBAR(); if constexpr (VPRE) pv_issue<DV>(vf, vb0 + bj * SHM_V);
        qkt<DK>(pA0, pA1, K_lds + bn * SHM_K, qr, r32, hi);
        finishSM(pB0, pB1, alB, l_reg, pa0, pa1, pa2, pa3); ATT_SBAR();
        if (SD == 1 || j + 3 < NT) ATT_SLOAD(SE, (j + 1 + SD) * KVBLK); ATT_SBAR();
        if constexpr (VPRE) pv_mma64(o, vf, pa0, pa1, pa2, pa3); else pv_d0<DV>(o, vb0 + bj * SHM_V, pa0, pa1, pa2, pa3);
        partialSM(pA0, pA1, m_reg, mnA, alA, C, thr_raw);
        ATT_SWRITE(bp, SO);
        ATT_RESC(alA); __syncthreads();
        bj = bp;
    }
    { const int bp = (bj == 0) ? 2 : bj - 1;
      ATT_SBAR(); qkt<DK>(pB0, pB1, K_lds + bj * SHM_K, qr, r32, hi);
      finishSM(pA0, pA1, alA, l_reg, pa0, pa1, pa2, pa3); ATT_SBAR();
      pv_d0<DV>(o, vb0 + bp * SHM_V, pa0, pa1, pa2, pa3); partialSM(pB0, pB1, m_reg, mnB, alB, C, thr_raw);
      ATT_RESC(alB);
      finishSM(pB0, pB1, alB, l_reg, pa0, pa1, pa2, pa3); ATT_SBAR();
      pv_d0<DV>(o, vb0 + bj * SHM_V, pa0, pa1, pa2, pa3); }
    if (hi == 0) li_l[r32] = l_reg; asm volatile("s_waitcnt lgkmcnt(0)" ::: "memory");
    float rli[16];
#pragma unroll
    for (int r = 0; r < 16; ++r) rli[r] = __builtin_amdgcn_rcpf(li_l[crow(r, hi)]);
    if constexpr (EPI == 1) {
#pragma unroll
        for (int r = 0; r < 16; ++r)
#pragma unroll
            for (int p = 0; p < NO / 2; ++p) stash[(r * (NO / 2) + p) * 64 + lane] = pk2(o[2 * p][r] * rli[r], o[2 * p + 1][r] * rli[r]);
    } else if constexpr (EPI == 2) {
        static_assert(EPI != 2 || DV == 128, "differential combine: DV = 128");
        float gl[NO];
#pragma unroll
        for (int d0 = 0; d0 < NO; ++d0) gl[d0] = gvec[d0 * 32 + r32];
        bf16_t* Ow = Ob + (long)(wid * QBLK) * ldo;
#pragma unroll
        for (int r = 0; r < 16; ++r) { float v[NO]; float ss = 0.f;
#pragma unroll
            for (int p = 0; p < NO / 2; ++p) { const unsigned w = stash[(r * (NO / 2) + p) * 64 + lane];
                v[2 * p] = o[2 * p][r] * rli[r] - lam * bf2f(w & 0xffffu); v[2 * p + 1] = o[2 * p + 1][r] * rli[r] - lam * bf2f(w >> 16); ss += v[2 * p] * v[2 * p] + v[2 * p + 1] * v[2 * p + 1]; }
#pragma unroll
            for (int x = 1; x < 32; x <<= 1) ss += __shfl_xor(ss, x);
            const float rstd = rsqrtf(ss * (1.0f / 128.0f) + 1e-6f); const int orow = crow(r, hi);
#pragma unroll
            for (int d0 = 0; d0 < NO; ++d0) Ow[(long)orow * ldo + d0 * 32 + r32] = (bf16_t)f2bf(v[d0] * rstd * gl[d0]); }
    } else {
    bf16_t* Ow = Ob + (long)(wid * QBLK) * ldo;
#pragma unroll
    for (int r = 0; r < 16; ++r) { const int orow = crow(r, hi);
#pragma unroll
        for (int d0 = 0; d0 < NO; ++d0) Ow[(long)orow * ldo + d0 * 32 + r32] = (bf16_t)f2bf(o[d0][r] * rli[r]); }
    }
#undef ATT_SLOAD
#undef ATT_SWRITE
#undef ATT_RESC
}

constexpr float THRL = THR * 1.4426950408889634f;
__device__ __forceinline__ float max3f(float a, float b, float c) { return __builtin_fmaxf(__builtin_fmaxf(a, b), c); }
__device__ __forceinline__ void softmax_rel(f32x16& p0, f32x16& p1, float& m_run, float& alpha, const bool first, f32x16* minit = nullptr) {
    float pm = max3f(p0[0], p0[1], p0[2]);
#pragma unroll
    for (int r = 3; r < 15; r += 2) pm = max3f(pm, p0[r], p0[r + 1]);
    pm = max3f(pm, p0[15], p1[0]);
#pragma unroll
    for (int r = 1; r < 15; r += 2) pm = max3f(pm, p1[r], p1[r + 1]);
    pm = __builtin_fmaxf(pm, p1[15]);
    { auto rr = __builtin_amdgcn_permlane32_swap(__float_as_uint(pm), __float_as_uint(pm), false, false); pm = __builtin_fmaxf(__uint_as_float(rr[0]), __uint_as_float(rr[1])); }
    if (!first && __builtin_expect(__all(pm <= THRL), 1)) alpha = 1.f;
    else { const float d = first ? pm : __builtin_fmaxf(pm, 0.f); alpha = first ? 1.f : __builtin_amdgcn_exp2f(-d); m_run += d;
        if (minit) {
#pragma unroll
            for (int r = 0; r < 16; ++r) (*minit)[r] = -m_run; }
#pragma unroll
        for (int r = 0; r < 16; ++r) { p0[r] -= d; p1[r] -= d; } }
#pragma unroll
    for (int r = 0; r < 16; ++r) { p0[r] = __builtin_amdgcn_exp2f(p0[r]); p1[r] = __builtin_amdgcn_exp2f(p1[r]); }
}
template <int DK> __device__ __forceinline__ void qkt_init(f32x16& p0, f32x16& p1, const char* Ks, const bf16x8* qr, int r32, int hi, float init) {
#pragma unroll
    for (int r = 0; r < 16; ++r) { p0[r] = init; p1[r] = init; }
#pragma unroll
    for (int d0 = 0; d0 < DK / 16; ++d0) { const int cb = (d0 * 16 + hi * 8) * 2;
        const bf16x8 b0 = *reinterpret_cast<const bf16x8*>(Ks + kswz<DK>(r32, cb));
        const bf16x8 b1 = *reinterpret_cast<const bf16x8*>(Ks + kswz<DK>(32 + r32, cb));
        p0 = __builtin_amdgcn_mfma_f32_32x32x16_bf16(b0, qr[d0], p0, 0, 0, 0);
        p1 = __builtin_amdgcn_mfma_f32_32x32x16_bf16(b1, qr[d0], p1, 0, 0, 0); }
}
__device__ __forceinline__ void finish_rel(f32x16& p0, f32x16& p1, float alpha, float& l_reg, bf16x8& pa0, bf16x8& pa1, bf16x8& pa2, bf16x8& pa3) {
    float ps = 0;
#pragma unroll
    for (int r = 0; r < 16; ++r) ps += p0[r];
#pragma unroll
    for (int r = 0; r < 16; ++r) ps += p1[r];
    { auto rr = __builtin_amdgcn_permlane32_swap(__float_as_uint(ps), __float_as_uint(ps), false, false); ps = __uint_as_float(rr[0]) + __uint_as_float(rr[1]); }
    l_reg = l_reg * alpha + ps;
#define ATT_PK4(P, BASE, OUT) do { u32x4 w = {cvt_pk_bf16(P[BASE + 0], P[BASE + 1]), cvt_pk_bf16(P[BASE + 2], P[BASE + 3]), cvt_pk_bf16(P[BASE + 4], P[BASE + 5]), cvt_pk_bf16(P[BASE + 6], P[BASE + 7])}; \
    OUT = *reinterpret_cast<bf16x8*>(&w); } while (0)
    ATT_PK4(p0, 0, pa0); ATT_PK4(p0, 8, pa1); ATT_PK4(p1, 0, pa2); ATT_PK4(p1, 8, pa3);
#undef ATT_PK4
}

template <int OFF> __device__ __forceinline__ bf16x8 k_read(int ka) { bf16x8 r; asm volatile("ds_read_b128 %0, %1 offset:%2" : "=&v"(r) : "v"(ka), "i"(OFF) : "memory"); return r; }
#define ATT_WAITL(n) asm volatile("s_waitcnt lgkmcnt(%0)" :: "n"(n) : "memory")
#define ATT_PKV(L, H) (bf16x8){L[0], L[1], L[2], L[3], H[0], H[1], H[2], H[3]}
template <int DK, int DV, int KBD, bool FINM = false, bool MINIT = false>
__device__ __forceinline__ void mblock(f32x16* o, f32x16& p0, f32x16& p1, const bool pv, const int vb, const int ka, const bf16x8* qr, bf16x8 pa0, bf16x8 pa1, bf16x8 pa2, bf16x8 pa3, const float init, const float al = 1.f, float* l_reg = nullptr, const f32x16* minit = nullptr) {
    constexpr int ND = DK / 16, NB = ND / KBD, PITCH = DK * 2 + 16, KR = 2 * KBD;
    static_assert(ND % KBD == 0 && NB >= 2 && NB <= 4 && (KBD == 2 || KBD == 3), "K batches");
    bf16x8 ka0[2][KBD], ka1[2][KBD];
    s16x4 l[4], h[4], m[4], n[4];
#define ATT_KISSUE(b) do { ka0[(b) & 1][0] = k_read<((b) * KBD + 0) * 32>(ka); ka1[(b) & 1][0] = k_read<((b) * KBD + 0) * 32 + 32 * PITCH>(ka); \
        ka0[(b) & 1][1] = k_read<((b) * KBD + 1) * 32>(ka); ka1[(b) & 1][1] = k_read<((b) * KBD + 1) * 32 + 32 * PITCH>(ka); \
        if constexpr (KBD > 2) { ka0[(b) & 1][KBD - 1] = k_read<((b) * KBD + KBD - 1) * 32>(ka); ka1[(b) & 1][KBD - 1] = k_read<((b) * KBD + KBD - 1) * 32 + 32 * PITCH>(ka); } } while (0)
#define ATT_TRISSUE(D0) do { l[0] = tr_read<v_rd_off<DV>(D0, 0, 0)>(vb); h[0] = tr_read<v_rd_off<DV>(D0, 0, 1)>(vb); l[1] = tr_read<v_rd_off<DV>(D0, 1, 0)>(vb); h[1] = tr_read<v_rd_off<DV>(D0, 1, 1)>(vb); \
        l[2] = tr_read<v_rd_off<DV>(D0, 2, 0)>(vb); h[2] = tr_read<v_rd_off<DV>(D0, 2, 1)>(vb); l[3] = tr_read<v_rd_off<DV>(D0, 3, 0)>(vb); h[3] = tr_read<v_rd_off<DV>(D0, 3, 1)>(vb); \
        m[0] = tr_read<v_rd_off<DV>(D0 + 1, 0, 0)>(vb); n[0] = tr_read<v_rd_off<DV>(D0 + 1, 0, 1)>(vb); m[1] = tr_read<v_rd_off<DV>(D0 + 1, 1, 0)>(vb); n[1] = tr_read<v_rd_off<DV>(D0 + 1, 1, 1)>(vb); \
        m[2] = tr_read<v_rd_off<DV>(D0 + 1, 2, 0)>(vb); n[2] = tr_read<v_rd_off<DV>(D0 + 1, 2, 1)>(vb); m[3] = tr_read<v_rd_off<DV>(D0 + 1, 3, 0)>(vb); n[3] = tr_read<v_rd_off<DV>(D0 + 1, 3, 1)>(vb); } while (0)
#define ATT_PVMMA(OA, OB) do { OA = __builtin_amdgcn_mfma_f32_32x32x16_bf16(pa0, ATT_PKV(l[0], h[0]), OA, 0, 0, 0); OB = __builtin_amdgcn_mfma_f32_32x32x16_bf16(pa0, ATT_PKV(m[0], n[0]), OB, 0, 0, 0); \
        OA = __builtin_amdgcn_mfma_f32_32x32x16_bf16(pa1, ATT_PKV(l[1], h[1]), OA, 0, 0, 0); OB = __builtin_amdgcn_mfma_f32_32x32x16_bf16(pa1, ATT_PKV(m[1], n[1]), OB, 0, 0, 0); \
        OA = __builtin_amdgcn_mfma_f32_32x32x16_bf16(pa2, ATT_PKV(l[2], h[2]), OA, 0, 0, 0); OB = __builtin_amdgcn_mfma_f32_32x32x16_bf16(pa2, ATT_PKV(m[2], n[2]), OB, 0, 0, 0); \
        OA = __builtin_amdgcn_mfma_f32_32x32x16_bf16(pa3, ATT_PKV(l[3], h[3]), OA, 0, 0, 0); OB = __builtin_amdgcn_mfma_f32_32x32x16_bf16(pa3, ATT_PKV(m[3], n[3]), OB, 0, 0, 0); } while (0)
#define ATT_QKMMA(b) do { _Pragma("unroll") for (int q = 0; q < KBD; ++q) { if ((b) == 0 && q == 0) { \
            p1 = __builtin_amdgcn_mfma_f32_32x32x16_bf16(ka1[0][0], qr[0], ini, 0, 0, 0); p0 = __builtin_amdgcn_mfma_f32_32x32x16_bf16(ka0[0][0], qr[0], ini, 0, 0, 0); } else { \
        p0 = __builtin_amdgcn_mfma_f32_32x32x16_bf16(ka0[(b) & 1][q], qr[(b) * KBD + q], p0, 0, 0, 0); \
        p1 = __builtin_amdgcn_mfma_f32_32x32x16_bf16(ka1[(b) & 1][q], qr[(b) * KBD + q], p1, 0, 0, 0); } } } while (0)
#if MK_ATT_PRIO == 1
    __builtin_amdgcn_s_setprio(1);
#endif
    constexpr bool K2 = (DV == 64);
    if (pv) {
        ATT_TRISSUE(0); ATT_KISSUE(0); if constexpr (K2) ATT_KISSUE(1);
        if constexpr (FINM) { ATT_SBAR(); finish_rel(p0, p1, al, *l_reg, pa0, pa1, pa2, pa3); ATT_SBAR(); }
        ATT_WAITL(K2 ? 2 * KR : KR); ATT_SBAR();
        ATT_PVMMA(o[0], o[1]); ATT_SBAR();
        if constexpr (DV == 128) { ATT_TRISSUE(2); ATT_WAITL(0); ATT_SBAR(); ATT_PVMMA(o[2], o[3]); ATT_SBAR(); }
    } else { ATT_KISSUE(0); if constexpr (K2) ATT_KISSUE(1); }
    if constexpr (!K2) ATT_KISSUE(1);
    f32x16 ini;
    if constexpr (MINIT) ini = *minit; else {
#pragma unroll
        for (int r = 0; r < 16; ++r) ini[r] = init; }
    ATT_WAITL(KR); ATT_SBAR(); ATT_QKMMA(0); ATT_SBAR();
    if constexpr (NB > 2) { ATT_KISSUE(2); ATT_WAITL(KR); } else ATT_WAITL(0);
    ATT_SBAR(); ATT_QKMMA(1); ATT_SBAR();
    if constexpr (NB > 2) { if constexpr (NB > 3) { ATT_KISSUE(3); ATT_WAITL(KR); } else ATT_WAITL(0);
        ATT_SBAR(); ATT_QKMMA(2); ATT_SBAR();
        if constexpr (NB > 3) { ATT_WAITL(0); ATT_SBAR(); ATT_QKMMA(3); ATT_SBAR(); } }
#if MK_ATT_PRIO == 1
    __builtin_amdgcn_s_setprio(0);
#endif
    if (MK_PROBE_ATT == 4) { f32x16 dz = f32x16{};
#pragma unroll
        for (int q = 0; q < ND; ++q) { dz = __builtin_amdgcn_mfma_f32_32x32x16_bf16(qr[q], qr[(q + 1) % ND], dz, 0, 0, 0); dz = __builtin_amdgcn_mfma_f32_32x32x16_bf16(qr[(q + 1) % ND], qr[q], dz, 0, 0, 0); }
        asm volatile("" :: "v"(dz)); }
    if (MK_PROBE_ATT == 5) { ATT_KISSUE(0); ATT_KISSUE(1); if constexpr (NB > 2) { ATT_WAITL(0); ATT_KISSUE(2); if constexpr (NB > 3) ATT_KISSUE(3); } ATT_WAITL(0);
        asm volatile("" :: "v"(ka0[0][0]), "v"(ka1[0][0]), "v"(ka0[1][0]), "v"(ka1[1][0])); }
#undef ATT_KISSUE
#undef ATT_TRISSUE
#undef ATT_PVMMA
#undef ATT_QKMMA
}

template <int DK, int DV, int ldq, int ldk, int ldv, int ldo, bool PRE, bool DEEP, bool PART = false>
__device__ __forceinline__ void attn_unit_stag(const bf16_t* __restrict__ Qb, const bf16_t* __restrict__ Kh, const bf16_t* __restrict__ Vh,
                                               bf16_t* __restrict__ Ob, int seq, const float C, const float thr_raw, char* lds, const int wid, float* po = nullptr, float* pml = nullptr) {
    constexpr int SHM_V = KVBLK * DV * 2, SHM_K = KVBLK * (DK * 2 + 16), R = 4;
    constexpr int NO = DV / 32, ND = DK / 16;
    const int lane = fresh_lane(), tid = wid * 64 + lane, r32 = lane & 31, hi = lane >> 5, half = wid >> 2;
    char* V_lds = lds; char* K_lds = lds + R * SHM_V;
    float* wsf = (float*)(lds + R * SHM_V + R * SHM_K) + wid * 64; float* li_l = wsf; float* al_l = wsf + 32;
    float m_reg = 0.f, l_reg = 0; f32x16 o[NO]; bf16x8 qr[ND];
#pragma unroll
    for (int d = 0; d < NO; ++d) o[d] = f32x16{};
    const bf16_t* Qw = Qb + (long)(wid * QBLK + r32) * ldq + hi * 8;
#pragma unroll
    for (int d0 = 0; d0 < ND; ++d0) qr[d0] = *reinterpret_cast<const bf16x8*>(Qw + d0 * 16);
    if constexpr (!PRE) {
#pragma unroll
        for (int d0 = 0; d0 < ND; ++d0) { const u32x4 w = *reinterpret_cast<const u32x4*>(&qr[d0]); u32x4 x;
            x.x = cvt_pk_bf16(bf2f(w.x & 0xffffu) * C, bf2f(w.x >> 16) * C); x.y = cvt_pk_bf16(bf2f(w.y & 0xffffu) * C, bf2f(w.y >> 16) * C);
            x.z = cvt_pk_bf16(bf2f(w.z & 0xffffu) * C, bf2f(w.z >> 16) * C); x.w = cvt_pk_bf16(bf2f(w.w & 0xffffu) * C, bf2f(w.w >> 16) * C);
            qr[d0] = *reinterpret_cast<const bf16x8*>(&x); } }
    const int sr = tid >> 4, sc = (tid & 15) * 8; const bool kact = (DK == 128) ? true : (sc < DK), vact = (DV == 128) ? true : (sc < DV);
    const int vst0 = v_st_nat<DV>(sr, vact ? sc : 0), vst1 = v_st_nat<DV>(32 + sr, vact ? sc : 0);
    const int vb0 = (int)(uintptr_t)V_lds + v_rd_base(lane);
    const int ka0 = (int)(uintptr_t)K_lds + kswz<DK>(r32, hi * 16);
    const unsigned koff = (unsigned)(sr * ldk + sc) * 2u, voff = (unsigned)(sr * ldv + sc) * 2u;
    const unsigned koff2 = koff + 32u * ldk * 2u, voff2 = voff + 32u * ldv * 2u;
    bf16x8 vsA0, vsA1, ksA0, ksA1, vsB0, vsB1, ksB0, ksB1;
#define STG_SLOAD(S, k0) do { const char* _kt = (const char*)Kh + (size_t)(k0) * ldk * 2; const char* _vt = (const char*)Vh + (size_t)(k0) * ldv * 2;        \
    if (vact) { vs##S##0 = *reinterpret_cast<const bf16x8*>(_vt + (size_t)voff); vs##S##1 = *reinterpret_cast<const bf16x8*>(_vt + (size_t)voff2); } \
    if (kact) { ks##S##0 = *reinterpret_cast<const bf16x8*>(_kt + (size_t)koff); ks##S##1 = *reinterpret_cast<const bf16x8*>(_kt + (size_t)koff2); } } while (0)
#define STG_SWRITE(S, b) do { if (vact) { *(bf16x8*)(V_lds + (b) * SHM_V + vst0) = vs##S##0; *(bf16x8*)(V_lds + (b) * SHM_V + vst1) = vs##S##1; } \
    if (kact) { const int kc = sc * 2; *(bf16x8*)(K_lds + (b) * SHM_K + kswz<DK>(sr, kc)) = ks##S##0; *(bf16x8*)(K_lds + (b) * SHM_K + kswz<DK>(32 + sr, kc)) = ks##S##1; } } while (0)
#define STG_BAR() do { ATT_SBAR(); asm volatile("s_waitcnt lgkmcnt(0)" ::: "memory"); __builtin_amdgcn_s_barrier(); asm volatile("" ::: "memory"); ATT_SBAR(); } while (0)
    constexpr bool MINIT = true;
    f32x16 minit = f32x16{};
    constexpr bool FINM = false;
    f32x16 p0, p1; float al = 1.f; bf16x8 pa0, pa1, pa2, pa3; const int NT = seq / KVBLK; (void)thr_raw;
    __syncthreads();
    if constexpr (DEEP) { STG_SLOAD(A, 0); STG_SLOAD(B, KVBLK); asm volatile("s_waitcnt vmcnt(0)" ::: "memory"); STG_SWRITE(A, 0); STG_SWRITE(B, 1);
        if (2 < NT) { STG_SLOAD(A, 2 * KVBLK); STG_SLOAD(B, 3 * KVBLK); } }
    else if constexpr (!(DK == 128 && DV == 128)) {
        STG_SLOAD(A, 0); STG_SLOAD(B, KVBLK); asm volatile("s_waitcnt vmcnt(0)" ::: "memory"); STG_SWRITE(A, 0); STG_SWRITE(B, 1);
        if (2 < NT) STG_SLOAD(A, 2 * KVBLK); }
    else { STG_SLOAD(A, 0); asm volatile("s_waitcnt vmcnt(0)" ::: "memory"); STG_SWRITE(A, 0);
        STG_SLOAD(A, KVBLK); asm volatile("s_waitcnt vmcnt(0)" ::: "memory"); STG_SWRITE(A, 1);
        if (2 < NT) STG_SLOAD(A, 2 * KVBLK); }
    __syncthreads();
    if (half && MK_PROBE_ATT != 8) STG_BAR();
#define STG_TILE(t, S, PV) do { \
        mblock<DK, DV, (DK == 96) ? 3 : 2, FINM, MINIT>(o, p0, p1, PV, vb0 + (((t) - 1) & 3) * SHM_V, ka0 + ((t) & 3) * SHM_K, qr, pa0, pa1, pa2, pa3, -m_reg, al, &l_reg, &minit); \
        STG_BAR(); \
        if (MK_ATT_PRIO == 2) __builtin_amdgcn_s_setprio(1); \
        softmax_rel(p0, p1, m_reg, al, (t) == 0, MINIT ? &minit : nullptr); \
        if (MK_PROBE_ATT == 3) { float dz = 0.f; _Pragma("unroll") for (int r = 0; r < 16; ++r) { dz += __builtin_amdgcn_exp2f(p0[r] - 1.0f); dz += __builtin_amdgcn_exp2f(p1[r] - 2.0f); } asm volatile("" :: "v"(dz)); } \
        if (MK_PROBE_ATT == 6) { STG_BAR(); } \
        if (MK_PROBE_ATT == 9) { float dz = al; _Pragma("unroll") for (int r = 0; r < 48; ++r) asm volatile("v_fma_f32 %0, %0, %0, %0" : "+v"(dz)); asm volatile("" :: "v"(dz)); } \
        if constexpr (!FINM) finish_rel(p0, p1, al, l_reg, pa0, pa1, pa2, pa3); \
        if (__any(al < 1.f)) { if (hi == 0) al_l[r32] = al; asm volatile("s_waitcnt lgkmcnt(0)" ::: "memory"); \
            _Pragma("unroll") for (int d = 0; d < NO; ++d) _Pragma("unroll") for (int r = 0; r < 16; ++r) o[d][r] *= al_l[crow(r, hi)]; } \
        if (MK_ATT_PRIO == 2) __builtin_amdgcn_s_setprio(0); \
        if constexpr (DEEP) { if ((t) + 2 < NT) { STG_SWRITE(S, ((t) + 2) & 3); if ((t) + 4 < NT) STG_SLOAD(S, ((t) + 4) * KVBLK); } } \
        else      { if ((t) + 2 < NT) { STG_SWRITE(A, ((t) + 2) & 3); if ((t) + 3 < NT) { STG_SLOAD(A, ((t) + 3) * KVBLK); \
            if (MK_PROBE_ATT == 7) { STG_SLOAD(B, ((t) + 3) * KVBLK + 32 * ((t) & 1)); asm volatile("" :: "v"(vsB0), "v"(vsB1), "v"(ksB0), "v"(ksB1)); } } } } \
        STG_BAR(); } while (0)
    if constexpr (DEEP) { for (int t = 0; t < NT; t += 2) { STG_TILE(t, A, (t) > 0); STG_TILE(t + 1, B, true); } }
    else { STG_TILE(0, A, false);
        for (int t = 1; t < NT; ++t) STG_TILE(t, A, true); }
#undef STG_TILE
    if constexpr (FINM) finish_rel(p0, p1, al, l_reg, pa0, pa1, pa2, pa3);
    pv_d0<DV>(o, (int)(uintptr_t)V_lds + v_rd_base(fresh_lane()) + ((NT - 1) & 3) * SHM_V, pa0, pa1, pa2, pa3);
    if (!half && MK_PROBE_ATT != 8) STG_BAR();
    if constexpr (PART) { const int ln = fresh_lane(), rr32 = ln & 31, hh = ln >> 5;
      if (hh == 0) { pml[(wid * QBLK + rr32) * 2] = m_reg; pml[(wid * QBLK + rr32) * 2 + 1] = l_reg; }
      float* pw = po + (size_t)(wid * QBLK) * DV;
#pragma unroll
      for (int r = 0; r < 16; ++r) { const int orow = crow(r, hh);
#pragma unroll
          for (int d0 = 0; d0 < NO; ++d0) pw[orow * DV + d0 * 32 + rr32] = o[d0][r]; } }
    else
    { const int ln = fresh_lane(), rr32 = ln & 31, hh = ln >> 5;
      float* wsf2 = (float*)(lds + R * SHM_V + R * SHM_K) + wid * 64;
      if (hh == 0) wsf2[rr32] = l_reg; asm volatile("s_waitcnt lgkmcnt(0)" ::: "memory");
      float rli[16];
#pragma unroll
      for (int r = 0; r < 16; ++r) rli[r] = __builtin_amdgcn_rcpf(wsf2[crow(r, hh)]);
      constexpr int OP = DV * 2 + 16, OSZ = 32 * OP, NV = (3 * SHM_V) / OSZ;
      static_assert((8 - NV) * OSZ <= R * SHM_K, "O staging");
      char* stg = lds + (wid < NV ? wid * OSZ : R * SHM_V + (wid - NV) * OSZ);
#pragma unroll
      for (int r = 0; r < 16; ++r) { const int orow = crow(r, hh);
#pragma unroll
          for (int d0 = 0; d0 < NO; ++d0) *(bf16_t*)(stg + orow * OP + (d0 * 32 + rr32) * 2) = (bf16_t)f2bf(o[d0][r] * rli[r]); }
      asm volatile("s_waitcnt lgkmcnt(0)" ::: "memory");
      bf16_t* Ow = Ob + (long)(wid * QBLK) * ldo;
      constexpr int SEG = DV * 2 / 16;
#pragma unroll
      for (int ps = 0; ps < DV / 16; ++ps) { const int idx = ps * 64 + ln, row = idx / SEG, seg = idx % SEG;
          const u32x4 w = *(const u32x4*)(stg + row * OP + seg * 16);
          *(u32x4*)(Ow + (long)row * ldo + seg * 8) = w; } }
#undef STG_SLOAD
#undef STG_SWRITE
#undef STG_BAR
}
}
constexpr int NWAVES = 8;
constexpr int DM = 1024, NBATCH = 8, SEQ = 4096, CTXL = 256, TPB = CTXL + SEQ  , T = NBATCH * TPB  ;
constexpr int FF = 3584, NEXP = 8, DEPTH = 4;
constexpr int A_IN = 5120, B_IN = 672, B_INP = 768, C_IN = 1536, D_IN = 3072;
constexpr float NORM_EPS = 1e-6f;
constexpr int MOE_ROWS = 2 * T + NEXP * 256;

enum { I_X = 0, I_C, I_CTX, I_CCTX, I_MODW, I_MODB, I_NORMG, I_A_WIN, I_A_LB, I_A_ONORM, I_A_WOUT, I_B_WIN, I_B_QNORM, I_B_KVNORM, I_B_WQB, I_B_WKVB, I_B_WOUT,
       I_C_WIN, I_C_QNORM, I_C_KNORM, I_C_WOUT, I_D_WIN, I_D_LAMBDA, I_D_ONORM, I_D_WOUT, I_FFN_GU, I_FFN_DOWN, I_MOE_ROUTER, I_MOE_GU, I_MOE_DOWN, N_IN };

constexpr size_t al256(size_t x) { return (x + 255) / 256 * 256; }
constexpr size_t WS_CTL = 0, CTL_BYTES = 1u << 20;
constexpr size_t WS_MOD = WS_CTL + CTL_BYTES;
constexpr size_t WS_ROPE = WS_MOD + al256((size_t)DEPTH * 9 * 6 * DM * 4);
constexpr size_t WS_LB = WS_ROPE + al256((size_t)3 * 64 * 32 * 2 * 4);
constexpr size_t WS_W0 = WS_LB + al256((size_t)2 * 1024 * 4);
constexpr size_t WS_WA_IN = WS_W0;                                  constexpr size_t SZ_WA_IN = (size_t)A_IN * DM * 2;
constexpr size_t WS_WA_OUT = WS_WA_IN + SZ_WA_IN;                   constexpr size_t SZ_WOUT = (size_t)DM * DM * 2;
constexpr size_t WS_WB_IN = WS_WA_OUT + SZ_WOUT;                    constexpr size_t SZ_WB_IN = (size_t)B_INP * DM * 2;
constexpr size_t WS_WB_QB = WS_WB_IN + SZ_WB_IN;                    constexpr size_t SZ_WB_QB = (size_t)1536 * 384 * 2;
constexpr size_t WS_WB_KVB = WS_WB_QB + SZ_WB_QB;                   constexpr size_t SZ_WB_KVB = (size_t)2048 * 256 * 2;
constexpr size_t WS_WB_OUT = WS_WB_KVB + SZ_WB_KVB;
constexpr size_t WS_WC_IN = WS_WB_OUT + SZ_WOUT;                    constexpr size_t SZ_WC_IN = (size_t)C_IN * DM * 2;
constexpr size_t WS_WC_OUT = WS_WC_IN + SZ_WC_IN;
constexpr size_t WS_WD_IN = WS_WC_OUT + SZ_WOUT;                    constexpr size_t SZ_WD_IN = (size_t)D_IN * DM * 2;
constexpr size_t WS_WD_OUT = WS_WD_IN + SZ_WD_IN;
constexpr size_t WS_FFN_GU = WS_WD_OUT + SZ_WOUT;                   constexpr size_t SZ_GU = (size_t)2 * FF * DM;
constexpr size_t WS_FFN_DN = WS_FFN_GU + 2 * SZ_GU;                 constexpr size_t SZ_DN = (size_t)DM * FF * 2;
constexpr size_t WS_MOE_GU = WS_FFN_DN + 2 * SZ_DN;
constexpr size_t WS_MOE_DN = WS_MOE_GU + 16 * SZ_GU;
constexpr size_t WS_WEND = WS_MOE_DN + 16 * SZ_DN;
constexpr size_t WS_H = al256(WS_WEND);                              constexpr size_t SZ_H = (size_t)T * DM * 4;
constexpr size_t WS_XA = WS_H + SZ_H;                                constexpr size_t SZ_XA = (size_t)T * DM * 2;
constexpr size_t WS_Y = WS_XA + SZ_XA;                               constexpr size_t SZ_Y = (size_t)T * DM * 4;
constexpr size_t WS_YS = WS_Y + SZ_Y;                              constexpr size_t SZ_YS = (size_t)8 * 2048 * DM * 4;
constexpr size_t WS_ROUTE = WS_YS + SZ_YS;                             constexpr size_t SZ_ROUTE = (size_t)T * 32;
constexpr size_t WS_WCNT = WS_ROUTE + SZ_ROUTE;                      constexpr size_t SZ_WCNT = (size_t)256 * 8 * 4;
constexpr size_t WS_LIST = WS_WCNT + SZ_WCNT;                      constexpr size_t SZ_LIST = (size_t)NEXP * T * 4;
constexpr size_t WS_R0 = al256(WS_LIST + SZ_LIST);
constexpr size_t WS_Z = WS_R0;                                       constexpr size_t SZ_Z = (size_t)T * A_IN * 2;
constexpr size_t WS_Q = WS_Z + SZ_Z;                                 constexpr size_t SZ_Q = (size_t)T * 2048 * 2;
constexpr size_t WS_K = WS_Q + SZ_Q;                                 constexpr size_t SZ_K = (size_t)T * 1536 * 2;
constexpr size_t WS_V = WS_K + SZ_K;                                 constexpr size_t SZ_V = (size_t)T * 1024 * 2;
constexpr size_t WS_O = WS_V + SZ_V;                                 constexpr size_t SZ_O = (size_t)T * 2048 * 2;
constexpr size_t WS_MIX_END = WS_O + SZ_O;
constexpr size_t WS_ACT = WS_R0;                                     constexpr size_t SZ_ACT = (size_t)MOE_ROWS * FF * 2;
constexpr size_t WS_YP = WS_ACT + al256(SZ_ACT);                     constexpr size_t SZ_YP = (size_t)MOE_ROWS * DM * 4;
constexpr size_t WS_FFN_END = WS_YP + SZ_YP;
constexpr size_t WS_END = (WS_MIX_END > WS_FFN_END ? WS_MIX_END : WS_FFN_END);
static_assert((size_t)T * 1536 * 4 <= SZ_Z && (size_t)T * B_INP * 4 <= SZ_Z && (size_t)T * D_IN * 2 <= SZ_Z, "Z region");
static_assert((size_t)T * (384 + 256) * 2 <= SZ_O, "MLA normalised latents fit the O region");

constexpr int CW_BAR = 4096;
constexpr int CW_MOECNT = 16384;
constexpr int RING_BYTES = 131072;
constexpr int MISC_OFF = 163840 - 1024;
constexpr int LDS_BYTES = 163840;
static_assert(RING_BYTES <= MISC_OFF, "LDS map");

#define XB_TMO      128
#define XB_XCNT(j)  (256  + 64 * (j))
#define XB_XSUB(j)  (1280 + 64 * (j))
#define XB_XGEN(j)  (2304 + 64 * (j))
#define XB_TOP      3328
#define XB_TOPGEN   3392
#define XCD_BAR_WORDS 3456
#define XB_SPIN_CAP (1u << 22)
__device__ __forceinline__ unsigned xb_ld(unsigned* p)              { return __hip_atomic_load(p, __ATOMIC_RELAXED, __HIP_MEMORY_SCOPE_AGENT); }
__device__ __forceinline__ unsigned xb_add(unsigned* p, unsigned v) { return __hip_atomic_fetch_add(p, v, __ATOMIC_RELAXED, __HIP_MEMORY_SCOPE_AGENT); }
__device__ __forceinline__ unsigned xb_xcc_id() { return (unsigned)__builtin_amdgcn_s_getreg((3 << 11) | 20) & 0xFu; }
#define XB_SPIN(cond, bar) do { unsigned _sp = 0; while (cond) { __builtin_amdgcn_s_sleep(1); \
    if ((++_sp & 255u) == 0u) { if (xb_ld(&(bar)[XB_TMO])) break; if (_sp > XB_SPIN_CAP) { atomicAdd(&(bar)[XB_TMO], 1u); break; } } } } while (0)
struct XcdBarrier { unsigned* bar; unsigned x; volatile LAS unsigned* st; };
__device__ __forceinline__ XcdBarrier xcd_barrier_post(unsigned* bar, volatile LAS unsigned* st) {
    XcdBarrier b; b.bar = bar; b.x = xb_xcc_id(); b.st = st;
    if (threadIdx.x == 0) (void)xb_add(&bar[XB_XCNT(b.x)], 1u);
    return b;
}
__device__ __forceinline__ void xcd_barrier_complete(unsigned* bar, unsigned x, unsigned& nloc, unsigned& nx) {
    const unsigned G = gridDim.x * gridDim.y * gridDim.z;
    unsigned sum, cnt, mine, sp = 0u;
    for (;;) {
        sum = 0u; cnt = 0u; mine = 0u;
#pragma unroll
        for (unsigned j = 0; j < 16; ++j) { const unsigned c = xb_ld(&bar[XB_XCNT(j)]); sum += c; cnt += (c > 0u) ? 1u : 0u; mine = (j == x) ? c : mine; }
        if (sum == G) break;
        __builtin_amdgcn_s_sleep(1);
        if ((++sp & 255u) == 0u) { if (xb_ld(&bar[XB_TMO])) break; if (sp > XB_SPIN_CAP) { atomicAdd(&bar[XB_TMO], 1u); break; } }
    }
    nloc = mine > 0u ? mine : 1u; nx = cnt > 0u ? cnt : 1u;
}
__device__ __forceinline__ void xcd_barrier(const XcdBarrier& b, const int wave) {
    asm volatile("s_waitcnt vmcnt(0)" ::: "memory");
    __syncthreads();
    if (wave == 0 && fresh_lane() == 0) {
        unsigned* bar = b.bar;
        __builtin_amdgcn_s_waitcnt(0);
        unsigned nloc = b.st[0], nx = b.st[1];
        if (nloc == 0u) { xcd_barrier_complete(bar, b.x, nloc, nx); b.st[0] = nloc; b.st[1] = nx; }
        const unsigned old = xb_add(&bar[XB_XSUB(b.x)], 1u);
        const unsigned gen = old / nloc;
        if (old + 1u == (gen + 1u) * nloc) {
            __builtin_amdgcn_fence(__ATOMIC_RELEASE, "agent");
            asm volatile("s_waitcnt vmcnt(0)" ::: "memory");
            const unsigned og = xb_add(&bar[XB_TOP], 1u);
            const unsigned tg = og / nx;
            if (og + 1u == (tg + 1u) * nx) xb_add(&bar[XB_TOPGEN], 1u);
            else XB_SPIN(xb_ld(&bar[XB_TOPGEN]) == tg, bar);
            __builtin_amdgcn_fence(__ATOMIC_ACQUIRE, "agent");
            xb_add(&bar[XB_XGEN(b.x)], 1u);
            asm volatile("s_waitcnt vmcnt(0)" ::: "memory");
        } else {
            XB_SPIN(xb_ld(&bar[XB_XGEN(b.x)]) == gen, bar);
            __builtin_amdgcn_fence(__ATOMIC_ACQUIRE, "agent");
            asm volatile("s_waitcnt vmcnt(0)" ::: "memory");
        }
    }
    __syncthreads();
}

struct Frame {
    LAS unsigned char* lds; volatile LAS unsigned* MISC; unsigned char* ws;
    int wave, vcu, G;
};
typedef __attribute__((address_space(4))) const unsigned long long* kargp_t;
__device__ __forceinline__ float* out_ptr() { kargp_t ka = (kargp_t)__builtin_amdgcn_kernarg_segment_ptr(); return (float*)(GAS float*)(ka[N_IN]); }
__device__ __forceinline__ const float* in_ptr(const Frame&, int idx) { kargp_t ka = (kargp_t)__builtin_amdgcn_kernarg_segment_ptr(); return (const float*)(const GAS float*)(ka[idx]); }

struct MatDesc { int in_idx; unsigned src_off  ; int K, Nsrc, Ndst, kind  ; unsigned long long dst  ; };
constexpr int NMAT = 10 + 2 + 2 + 16 + 16, NMAT0 = 4;
struct MatTable { MatDesc m[NMAT]; int item0[NMAT + 1]; };
constexpr MatTable make_mats() {
    MatTable t{}; int n = 0;
    auto add = [&](int in_idx, unsigned src_off, int K, int Nsrc, int Ndst, int kind, unsigned long long dst) { t.m[n] = MatDesc{in_idx, src_off, K, Nsrc, Ndst, kind, dst}; ++n; };
    add(I_A_WIN, 0, DM, A_IN, A_IN, 0, WS_WA_IN); add(I_A_WOUT, 0, DM, DM, DM, 0, WS_WA_OUT);
    add(I_FFN_GU, 0, DM, 2 * FF, 2 * FF, 2, WS_FFN_GU); add(I_FFN_DOWN, 0, FF, DM, DM, 0, WS_FFN_DN);
    add(I_B_WIN, 0, DM, B_IN, B_INP, 0, WS_WB_IN); add(I_B_WQB, 0, 384, 1536, 1536, 0, WS_WB_QB); add(I_B_WKVB, 0, 256, 2048, 2048, 0, WS_WB_KVB); add(I_B_WOUT, 0, DM, DM, DM, 0, WS_WB_OUT);
    add(I_C_WIN, 0, DM, C_IN, C_IN, 3, WS_WC_IN); add(I_C_WOUT, 0, DM, DM, DM, 0, WS_WC_OUT);
    add(I_D_WIN, 0, DM, D_IN, D_IN, 0, WS_WD_IN); add(I_D_WOUT, 0, DM, DM, DM, 0, WS_WD_OUT);
    add(I_FFN_GU, (unsigned)1 * DM * 2 * FF, DM, 2 * FF, 2 * FF, 2, WS_FFN_GU + SZ_GU); add(I_FFN_DOWN, (unsigned)1 * FF * DM, FF, DM, DM, 0, WS_FFN_DN + SZ_DN);
    for (int j = 0; j < 16; ++j) add(I_MOE_GU, (unsigned)j * DM * 2 * FF, DM, 2 * FF, 2 * FF, 2, WS_MOE_GU + (size_t)j * SZ_GU);
    for (int j = 0; j < 16; ++j) add(I_MOE_DOWN, (unsigned)j * FF * DM, FF, DM, DM, 0, WS_MOE_DN + (size_t)j * SZ_DN);
    int acc = 0; for (int i = 0; i < NMAT; ++i) { t.item0[i] = acc; acc += (t.m[i].K / 64) * (t.m[i].Ndst / 64); } t.item0[NMAT] = acc;
    return t;
}
__device__ const MatTable g_mats = make_mats();

__host__ __device__ __forceinline__ int gqa_dim(int c) { const int wc = c >> 5, fq = (c >> 3) & 3, e = c & 7; return 64 * (wc >> 1) + 32 * (fq >> 1) + 16 * (wc & 1) + 8 * (fq & 1) + e; }
constexpr int P0_SCR = 64 * 65 * 4;
__device__ __forceinline__ void p0_transpose_item(const float* W, int K, int Nsrc, int kind, bf16_t* WT, LAS float* scr, int item, int Ndst, int lane) {
    const int nblk = Ndst / 64, kb = item / nblk, nb = item % nblk, k0 = 64 * kb, n0 = 64 * nb;
    int s0;
    if (kind == 1 || kind == 2) { const int pn = n0 >> 8, bj = (n0 >> 7) & 1, cc = n0 & 127; s0 = bj * FF + 128 * pn + cc; } else s0 = n0;
    int sl = s0 + lane;
    if (kind == 3) { const int n = n0 + lane; sl = (n < 1280) ? (n & ~127) + gqa_dim(n & 127) : n; }
    const bool ok = (kind >= 1) || (n0 + lane < Nsrc);
    const float* src = W + (size_t)k0 * Nsrc + sl;
    float tv[64];
#pragma unroll
    for (int kk = 0; kk < 64; ++kk) tv[kk] = ok ? src[(size_t)kk * Nsrc] : 0.f;
#pragma unroll
    for (int kk = 0; kk < 64; ++kk) scr[kk * 65 + lane] = tv[kk];
    asm volatile("s_waitcnt lgkmcnt(0)" ::: "memory");
    if (kind == 2) {
        const int c = lane & 3; unsigned char* WT8 = (unsigned char*)WT;
#pragma unroll
        for (int j = 0; j < 4; ++j) { const int n = (lane >> 2) + 16 * j; const LAS float* sp = scr + (16 * c) * 65 + n;
            u32x4 o; o.x = pk4_fp8(32.f * sp[0 * 65], 32.f * sp[1 * 65], 32.f * sp[2 * 65], 32.f * sp[3 * 65]); o.y = pk4_fp8(32.f * sp[4 * 65], 32.f * sp[5 * 65], 32.f * sp[6 * 65], 32.f * sp[7 * 65]);
            o.z = pk4_fp8(32.f * sp[8 * 65], 32.f * sp[9 * 65], 32.f * sp[10 * 65], 32.f * sp[11 * 65]); o.w = pk4_fp8(32.f * sp[12 * 65], 32.f * sp[13 * 65], 32.f * sp[14 * 65], 32.f * sp[15 * 65]);
            *(u32x4*)(WT8 + (size_t)(n0 + n) * K + k0 + 16 * c) = o; }
    } else {
    const int c = lane & 7;
#pragma unroll
    for (int j = 0; j < 8; ++j) { const int n = (lane >> 3) + 8 * j; const LAS float* sp = scr + (8 * c) * 65 + n;
        u32x4 o; o.x = pk2(sp[0 * 65], sp[1 * 65]); o.y = pk2(sp[2 * 65], sp[3 * 65]); o.z = pk2(sp[4 * 65], sp[5 * 65]); o.w = pk2(sp[6 * 65], sp[7 * 65]);
        *(u32x4*)(WT + (size_t)(n0 + n) * K + k0 + 8 * c) = o; }
    }
    asm volatile("s_waitcnt lgkmcnt(0)" ::: "memory");
}

__device__ __forceinline__ void p0_convert(Frame& F, int it0, int it1, int worker, int nworkers, int lane) {
    LAS float* scr = (LAS float*)(F.lds + F.wave * P0_SCR);
    for (int it = it0 + worker; it < it1; it += nworkers) {
        int mi = 0;
#pragma unroll 1
        for (int j = 1; j < NMAT; ++j) mi = (it >= g_mats.item0[j]) ? j : mi;
        const MatDesc d = g_mats.m[mi];
        p0_transpose_item(in_ptr(F, d.in_idx) + d.src_off, d.K, d.Nsrc, d.kind, (bf16_t*)(F.ws + d.dst), scr, it - g_mats.item0[mi], d.Ndst, lane);
    }
}
__device__ __forceinline__ int p0_split_item() { const int i0 = g_mats.item0[NMAT0], i1 = g_mats.item0[NMAT]; return i0 + (int)((long)(i1 - i0) * 0 / 100); }
__device__ __forceinline__ void p0_prologue(Frame& F) {
    const int lane = fresh_lane(), tid = F.wave * 64 + lane; (void)tid;
    const int gw = F.vcu * NWAVES + F.wave, NGW = F.G * NWAVES;
    p0_convert(F, 0, p0_split_item(), gw, NGW, lane);
    __syncthreads();
    {
        LAS float* cond = (LAS float*)F.lds;
        LAS float* part = (LAS float*)(F.lds + 65536);
        const float* cin = in_ptr(F, I_C); const float* cctx = in_ptr(F, I_CCTX);
        for (int i = tid; i < 9 * DM; i += 512) { const int r = i / DM, k = i % DM; const float v = (r < 8) ? cin[r * DM + k] : cctx[k]; cond[i] = silu_f(v); }
        __syncthreads();
        const float* mw = in_ptr(F, I_MODW); const float* mb = in_ptr(F, I_MODB);
        float* modt = (float*)(F.ws + WS_MOD);
        constexpr int NITEM = DEPTH * (6 * DM / 64);
        for (int it = F.vcu; it < NITEM; it += F.G) {
            const int l = it / 96, cb = it % 96, col = cb * 64 + lane;
            float a[9];
#pragma unroll
            for (int r = 0; r < 9; ++r) a[r] = 0.f;
            const float* wp = mw + ((size_t)l * DM + F.wave * 128) * (6 * DM) + col;
#pragma unroll 8
            for (int k = 0; k < 128; ++k) { const float w = wp[(size_t)k * (6 * DM)];
#pragma unroll
                for (int r = 0; r < 9; ++r) a[r] = fmaf(cond[r * DM + F.wave * 128 + k], w, a[r]); }
#pragma unroll
            for (int r = 0; r < 9; ++r) part[(F.wave * 9 + r) * 64 + lane] = a[r];
            __syncthreads();
            for (int i = tid; i < 9 * 64; i += 512) { const int r = i / 64, c = i % 64; float s = mb[(size_t)l * 6 * DM + cb * 64 + c];
#pragma unroll
                for (int w = 0; w < 8; ++w) s += part[(w * 9 + r) * 64 + c];
                modt[((size_t)l * 9 + r) * (6 * DM) + cb * 64 + c] = s; }
            __syncthreads();
        }
    }
    {
        float* rt = (float*)(F.ws + WS_ROPE);
        for (int i = gw * 64 + lane; i < 3 * 64 * 32; i += NGW * 64) { const int kind = i / 2048, pos = (i / 32) % 64, fi = i % 32; const int n = 16 << kind;
            if (fi < n / 2) { const float inv = exp2f(-(float)(2 * fi) / (float)n * 13.287712379549449f);
                const float ang = (float)pos * inv; float s, c;
                {
                  const float rev = ang * 0.15915494309189535f; const float fr = rev - floorf(rev); s = __builtin_amdgcn_sinf(fr); c = __builtin_amdgcn_cosf(fr); }
                rt[(size_t)i * 2] = c; rt[(size_t)i * 2 + 1] = s; } }
    }
    {
        const float* alb = in_ptr(F, I_A_LB); float* lb = (float*)(F.ws + WS_LB);
        for (int i = gw * 64 + lane; i < 2 * 1024; i += NGW * 64) { const int dir = i / 1024, w = i % 1024; float v[5], mx = -1e30f;
#pragma unroll
            for (int j = 0; j < 5; ++j) { v[j] = alb[((size_t)dir * 5 + j) * 1024 + w]; mx = fmaxf(mx, v[j]); }
            float s = 0.f;
#pragma unroll
            for (int j = 0; j < 5; ++j) s += expf(v[j] - mx);
            lb[i] = expf(v[0] - mx) / s; }
    }
}

struct RowPos { int b, p, modrow, prow, pcol; bool isctx; };
__device__ __forceinline__ RowPos row_pos(int m) { RowPos r; r.b = m / TPB; r.p = m % TPB; r.isctx = r.p < CTXL; r.modrow = r.isctx ? 8 : r.b; const int t = r.isctx ? 0 : r.p - CTXL; r.prow = t >> 6; r.pcol = t & 63; return r; }
__device__ __forceinline__ void ld_row(const float* p, int lane, f32x4 (&v)[4]) {
#pragma unroll
    for (int j = 0; j < 4; ++j) v[j] = *(const f32x4*)(p + 256 * j + 4 * lane);
}
__device__ __forceinline__ void ld_row_bf16(const bf16_t* p, int lane, f32x4 (&v)[4]) {
#pragma unroll
    for (int j = 0; j < 4; ++j) { const u32x2 w = *(const u32x2*)(p + 256 * j + 4 * lane); v[j] = (f32x4){bf2f(w.x & 0xffffu), bf2f(w.x >> 16), bf2f(w.y & 0xffffu), bf2f(w.y >> 16)}; }
}
__device__ __forceinline__ void st_row_bf16(bf16_t* p, int lane, const f32x4 (&v)[4]) {
#pragma unroll
    for (int j = 0; j < 4; ++j) { u32x2 w; w.x = pk2(v[j].x, v[j].y); w.y = pk2(v[j].z, v[j].w); *(u32x2*)(p + 256 * j + 4 * lane) = w; }
}
__device__ __forceinline__ float sumsq_row(const f32x4 (&v)[4]) { float s = 0.f;
#pragma unroll
    for (int j = 0; j < 4; ++j) s += (v[j].x * v[j].x + v[j].y * v[j].y) + (v[j].z * v[j].z + v[j].w * v[j].w);
    return wave_sum(s); }
__device__ __forceinline__ void norm_mod_store(const f32x4 (&x)[4], float rstd, const float* g, const float* shift, const float* scale, bf16_t* dst, int lane, f32x4 (&u)[4]) {
#pragma unroll
    for (int j = 0; j < 4; ++j) { const int c = 256 * j + 4 * lane; const f32x4 gg = *(const f32x4*)(g + c), sh = *(const f32x4*)(shift + c), sc = *(const f32x4*)(scale + c);
        u[j] = (x[j] * rstd * gg) * (sc + 1.0f) + sh;
        u32x2 w; w.x = pk2(u[j].x, u[j].y); w.y = pk2(u[j].z, u[j].w); *(u32x2*)(dst + c) = w; }
}

__device__ __forceinline__ void norm_mod_store_fp8(const f32x4 (&x)[4], float rstd, const float* g, const float* shift, const float* scale, unsigned char* dst, int lane, f32x4 (&u)[4]) {
#pragma unroll
    for (int j = 0; j < 4; ++j) { const int c = 256 * j + 4 * lane; const f32x4 gg = *(const f32x4*)(g + c), sh = *(const f32x4*)(shift + c), sc = *(const f32x4*)(scale + c);
        u[j] = (x[j] * rstd * gg) * (sc + 1.0f) + sh;
        *(unsigned*)(dst + c) = pk4_fp8(u[j].x, u[j].y, u[j].z, u[j].w); }
}
__device__ __forceinline__ void ld_y_row(const unsigned char* ws, int m, const RowPos& rp, int S, int lane, f32x4 (&yv)[4]) {
    if (rp.isctx) { const float* ys = (const float*)(ws + WS_YS) + (size_t)(rp.b * CTXL + rp.p) * DM;
        ld_row(ys, lane, yv);
        for (int s = 1; s < S; ++s) { f32x4 t[4]; ld_row(ys + (size_t)s * 2048 * DM, lane, t);
#pragma unroll
            for (int j = 0; j < 4; ++j) yv[j] = yv[j] + t[j]; } }
    else ld_row_bf16((const bf16_t*)(ws + WS_Y) + (size_t)m * DM, lane, yv);
}
__device__ __forceinline__ void ld_yp_row(const unsigned char* ws, size_t r, int RBM, int trb, int S, int lane, f32x4 (&v)[4]) {
    const int rb = (int)(r >> 8);
    if (rb >= RBM) { const float* ys = (const float*)(ws + WS_YS) + ((size_t)(rb - RBM) * 256 + (r & 255)) * DM;
        ld_row(ys, lane, v);
        for (int s = 1; s < S; ++s) { f32x4 t[4]; ld_row(ys + (size_t)s * trb * 256 * DM, lane, t);
#pragma unroll
            for (int j = 0; j < 4; ++j) v[j] = v[j] + t[j]; } }
    else ld_row_bf16((const bf16_t*)(ws + WS_YP) + r * DM, lane, v);
}
__device__ __forceinline__ float half_sum(float v) {
#pragma unroll
    for (int o = 1; o < 32; o <<= 1) v += __shfl_xor(v, o);
    return v;
}
__device__ __forceinline__ void ld_row2(const float* p, int l32, f32x4 (&v)[8]) {
#pragma unroll
    for (int j = 0; j < 8; ++j) v[j] = *(const f32x4*)(p + 128 * j + 4 * l32);
}
__device__ __forceinline__ void ld_row2_bf16(const bf16_t* p, int l32, f32x4 (&v)[8]) {
#pragma unroll
    for (int j = 0; j < 8; ++j) { const u32x2 w = *(const u32x2*)(p + 128 * j + 4 * l32); v[j] = (f32x4){bf2f(w.x & 0xffffu), bf2f(w.x >> 16), bf2f(w.y & 0xffffu), bf2f(w.y >> 16)}; }
}
__device__ __forceinline__ void st_row2_bf16(bf16_t* p, int l32, const f32x4 (&v)[8]) {
#pragma unroll
    for (int j = 0; j < 8; ++j) { u32x2 w; w.x = pk2(v[j].x, v[j].y); w.y = pk2(v[j].z, v[j].w); *(u32x2*)(p + 128 * j + 4 * l32) = w; }
}
__device__ __forceinline__ float sumsq_row2(const f32x4 (&v)[8]) { float s = 0.f;
#pragma unroll
    for (int j = 0; j < 8; ++j) s += (v[j].x * v[j].x + v[j].y * v[j].y) + (v[j].z * v[j].z + v[j].w * v[j].w);
    return half_sum(s); }
template <bool FP8>
__device__ __forceinline__ void norm_mod2(const f32x4 (&x)[8], float rstd, const LAS float* g, const LAS float* shift, const LAS float* scale, void* dst, int l32, bool st, f32x4 (&u)[8]) {
#pragma unroll
    for (int j = 0; j < 8; ++j) { if ((j & 3) == 0) __builtin_amdgcn_sched_barrier(0);
        const int c = 128 * j + 4 * l32; const f32x4 gg = *(const LAS f32x4*)(g + c), sh = *(const LAS f32x4*)(shift + c), sc = *(const LAS f32x4*)(scale + c);
        u[j] = (x[j] * rstd * gg) * (sc + 1.0f) + sh;
        if (st) { if (FP8) *(unsigned*)((unsigned char*)dst + c) = pk4_fp8(u[j].x, u[j].y, u[j].z, u[j].w);
                  else { u32x2 w; w.x = pk2(u[j].x, u[j].y); w.y = pk2(u[j].z, u[j].w); *(u32x2*)((bf16_t*)dst + c) = w; } } }
}
constexpr int PAR_FLOATS = 29 * DM;
__device__ __forceinline__ void fill_params(Frame& F, const float* ga, const float* gb, const float* m0, const float* m1, const float* m2, int tid) {
    LAS float* par = (LAS float*)F.lds;
    for (int i = tid; i < PAR_FLOATS / 4; i += NWAVES * 64) { const int v = i >> 8, c = (i & 255) * 4; const float* src;
        if (v == 0) src = ga; else if (v == 1) src = gb; else { const int r = (v - 2) / 3, k = (v - 2) % 3; src = (k == 0 ? m0 : k == 1 ? m1 : m2) + (size_t)r * (6 * DM); }
        *(LAS f32x4*)(par + v * DM + c) = *(const f32x4*)(src + c); }
    __syncthreads();
}
__device__ __forceinline__ void ld_y_row2(const unsigned char* ws, int m, const RowPos& rp, bool slab, int S, int l32, f32x4 (&yv)[8]) {
    if (slab) { const float* ys = (const float*)(ws + WS_YS) + (size_t)(rp.b * CTXL + rp.p) * DM;
        ld_row2(ys, l32, yv);
#pragma unroll 1
        for (int s = 1; s < S; ++s) { f32x4 t[8]; ld_row2(ys + (size_t)s * 2048 * DM, l32, t);
#pragma unroll
            for (int j = 0; j < 8; ++j) yv[j] = yv[j] + t[j]; } }
    else ld_row2_bf16((const bf16_t*)(ws + WS_Y) + (size_t)m * DM, l32, yv);
}
__device__ __forceinline__ void ld_yp_row2(const unsigned char* ws, size_t r, int RBM, int trb, int S, int l32, f32x4 (&v)[8]) {
    const int rb = (int)(r >> 8);
    if (rb >= RBM) { const float* ys = (const float*)(ws + WS_YS) + ((size_t)(rb - RBM) * 256 + (r & 255)) * DM;
        ld_row2(ys, l32, v);
#pragma unroll 1
        for (int s = 1; s < S; ++s) { f32x4 t[8]; ld_row2(ys + (size_t)s * trb * 256 * DM, l32, t);
#pragma unroll
            for (int j = 0; j < 8; ++j) v[j] = v[j] + t[j]; } }
    else ld_row2_bf16((const bf16_t*)(ws + WS_YP) + r * DM, l32, v);
}

__device__ __forceinline__ void phase_r0(Frame& F) {
    const int lane = fresh_lane(), l32 = lane & 31, half = lane >> 5;
    const int gw = F.vcu * NWAVES + F.wave, NGW = F.G * NWAVES;
    const float* x = in_ptr(F, I_X); const float* ctx = in_ptr(F, I_CTX); const float* ng = in_ptr(F, I_NORMG);
    bf16_t* h = (bf16_t*)(F.ws + WS_H); bf16_t* xa = (bf16_t*)(F.ws + WS_XA); const float* modt = (const float*)(F.ws + WS_MOD);
    fill_params(F, ng + (0 * 4 + 0) * DM, ng + (0 * 4 + 0) * DM, modt + 0 * DM, modt + 1 * DM, modt + 1 * DM, F.wave * 64 + lane);
    const LAS float* par = (const LAS float*)F.lds;
    for (int pi = gw; pi < T / 2; pi += NGW) { const int m = 2 * pi + half; const RowPos rp = row_pos(m);
        const float* src = rp.isctx ? ctx + ((size_t)rp.b * CTXL + rp.p) * DM : x + ((size_t)rp.b * SEQ + (rp.p - CTXL)) * DM;
        f32x4 v[8], u[8]; ld_row2(src, l32, v);
        st_row2_bf16(h + (size_t)m * DM, l32, v);
        const float rstd = rsqrtf(sumsq_row2(v) * (1.0f / DM) + NORM_EPS);
        const LAS float* pm = par + (2 + 3 * rp.modrow) * DM;
        norm_mod2<false>(v, rstd, par, pm + 0 * DM, pm + 1 * DM, xa + (size_t)m * DM, l32, true, u); }
    __syncthreads();
}

template <bool MOE>
__device__ __forceinline__ void phase_r1(Frame& F, int l) {
    const int lane = fresh_lane(), tid = F.wave * 64 + lane, l32 = lane & 31, half = lane >> 5;
    const float* ng = in_ptr(F, I_NORMG); const float* modt = (const float*)(F.ws + WS_MOD);
    bf16_t* h = (bf16_t*)(F.ws + WS_H); unsigned char* xa = (unsigned char*)(F.ws + WS_XA);
    const float* router = MOE ? in_ptr(F, I_MOE_ROUTER) + (size_t)(l >> 1) * DM * NEXP : nullptr;
    constexpr int LB = PAR_FLOATS * 4;
    LAS int* lcnt = (LAS int*)(F.lds + LB);
    LAS int* lbase = (LAS int*)(F.lds + LB + 64);
    LAS int* lrow = (LAS int*)(F.lds + LB + 1024);
    LAS float* lw = (LAS float*)(F.lds + LB + 4096);
    constexpr int RPW = T / 256;
    if (MOE) { if (tid < 8) lcnt[tid] = 0; }
    { const float* ml = modt + (size_t)l * 9 * (6 * DM); fill_params(F, ng + (l * 4 + 1) * DM, ng + (l * 4 + 2) * DM, ml + 2 * DM, ml + 3 * DM, ml + 4 * DM, tid); }
    const LAS float* par = (const LAS float*)F.lds;
    LAS f32x4* rtA = (LAS f32x4*)(F.lds + LB + 8192); LAS f32x4* rtB = rtA + 1024;
    if (MOE) { for (int c = tid; c < DM; c += NWAVES * 64) { const int slot = ((c & 3) * 8 + (c >> 7)) * 32 + ((c & 127) >> 2);
            rtA[slot] = *(const f32x4*)(router + (size_t)c * 8); rtB[slot] = *(const f32x4*)(router + (size_t)c * 8 + 4); }
        __syncthreads(); }
#define R1_ROW(i) ((i) * 256 + F.vcu)
    f32x4 yn[8], hn[8];
    { const int m0 = R1_ROW(2 * F.wave + half); const RowPos r0 = row_pos(m0); ld_y_row2(F.ws, m0, r0, r0.isctx && !(l == DEPTH - 1), 4, l32, yn); ld_row2_bf16(h + (size_t)m0 * DM, l32, hn); }
    for (int i2 = F.wave; i2 < RPW / 2; i2 += NWAVES) { const int i = 2 * i2 + half, m = R1_ROW(i); const RowPos rp = row_pos(m);
        const bool skip = (l == DEPTH - 1) && rp.isctx;
        const LAS float* pm = par + (2 + 3 * rp.modrow) * DM;
        f32x4 yv[8], hv[8], u[8];
#pragma unroll
        for (int j = 0; j < 8; ++j) { yv[j] = yn[j]; hv[j] = hn[j]; }
        if (i2 + NWAVES < RPW / 2) { const int mn = R1_ROW(i + 2 * NWAVES); const RowPos rn = row_pos(mn); ld_y_row2(F.ws, mn, rn, rn.isctx && !(l == DEPTH - 1), 4, l32, yn); ld_row2_bf16(h + (size_t)mn * DM, l32, hn); }
        const float rstd_y = rsqrtf(sumsq_row2(yv) * (1.0f / DM) + NORM_EPS);
#pragma unroll
        for (int j = 0; j < 8; ++j) { if ((j & 3) == 0) __builtin_amdgcn_sched_barrier(0);
            const int c = 128 * j + 4 * l32; const f32x4 g1 = *(const LAS f32x4*)(par + c), gt = *(const LAS f32x4*)(pm + c);
            hv[j] = hv[j] + gt * (yv[j] * rstd_y * g1); }
        if (!skip) st_row2_bf16(h + (size_t)m * DM, l32, hv);
        const float rstd_h = rsqrtf(sumsq_row2(hv) * (1.0f / DM) + NORM_EPS);
        norm_mod2<true>(hv, rstd_h, par + DM, pm + 1 * DM, pm + 2 * DM, xa + (size_t)m * DM, l32, !skip, u);
        if (MOE) {
            float lg[8];
#pragma unroll
            for (int e = 0; e < 8; ++e) lg[e] = 0.f;
#pragma unroll
            for (int j = 0; j < 8; ++j) { __builtin_amdgcn_sched_barrier(0);
#pragma unroll
                for (int q = 0; q < 4; ++q) { const f32x4 r0 = rtA[(q * 8 + j) * 32 + l32], r1 = rtB[(q * 8 + j) * 32 + l32]; const float uv = u[j][q];
                    lg[0] = fmaf(uv, r0.x, lg[0]); lg[1] = fmaf(uv, r0.y, lg[1]); lg[2] = fmaf(uv, r0.z, lg[2]); lg[3] = fmaf(uv, r0.w, lg[3]);
                    lg[4] = fmaf(uv, r1.x, lg[4]); lg[5] = fmaf(uv, r1.y, lg[5]); lg[6] = fmaf(uv, r1.z, lg[6]); lg[7] = fmaf(uv, r1.w, lg[7]); } }
#pragma unroll
            for (int e = 0; e < 8; ++e) lg[e] = half_sum(lg[e]);
            int e1 = 0; float v1 = lg[0];
#pragma unroll
            for (int e = 1; e < 8; ++e) if (lg[e] > v1) { v1 = lg[e]; e1 = e; }
            int e2 = (e1 == 0) ? 1 : 0; float v2 = (e1 == 0) ? lg[1] : lg[0];
#pragma unroll
            for (int e = 1; e < 8; ++e) if (e != e1 && lg[e] > v2) { v2 = lg[e]; e2 = e; }
            const float w2 = fast_rcp(1.0f + expf(v1 - v2)), w1 = 1.0f - w2;
            if (l32 == 0) { if (skip) lrow[i * 4 + 0] = -1;
                else { lrow[i * 4 + 0] = e1; lrow[i * 4 + 2] = e2; lw[i * 2] = w1; lw[i * 2 + 1] = w2; } }
        }
    }
    if (MOE) {
        __syncthreads();
        if (tid < 8) { int c = 0; for (int i = 0; i < RPW; ++i) { const int a = lrow[i * 4], b = lrow[i * 4 + 2]; if (a < 0) continue; if (a == tid) lrow[i * 4 + 1] = c++; else if (b == tid) lrow[i * 4 + 3] = c++; }
            lcnt[tid] = c; ((int*)(F.ws + WS_WCNT))[F.vcu * 8 + tid] = c;
            __hip_atomic_fetch_add((int*)((unsigned*)F.ws + CW_MOECNT + (l >> 1) * 64) + tid, c, __ATOMIC_RELAXED, __HIP_MEMORY_SCOPE_AGENT); }
        __syncthreads();
        int* route = (int*)(F.ws + WS_ROUTE);
        for (int i = tid; i < RPW; i += 512) { const int m = R1_ROW(i); const int e1 = lrow[i * 4], e2 = lrow[i * 4 + 2]; route[(size_t)m * 8 + 0] = e1; if (e1 < 0) continue;
            route[(size_t)m * 8 + 1] = lrow[i * 4 + 1]; route[(size_t)m * 8 + 2] = e2; route[(size_t)m * 8 + 3] = lrow[i * 4 + 3];
            ((float*)route)[(size_t)m * 8 + 4] = lw[i * 2]; ((float*)route)[(size_t)m * 8 + 5] = lw[i * 2 + 1]; }
        __syncthreads();
    }
}
__device__ __forceinline__ void moe_build(Frame& F) {
    const int lane = fresh_lane(), tid = F.wave * 64 + lane;
    LAS int* red = (LAS int*)F.lds;
    const int* wcnt = (const int*)(F.ws + WS_WCNT);
    { const int e = tid & 7; int sacc = 0; for (int v = tid >> 3; v < F.vcu; v += 64) sacc += wcnt[v * 8 + e]; red[tid] = sacc; }
    __syncthreads();
    if (tid < 8) { int sacc = 0; for (int k = 0; k < 64; ++k) sacc += red[k * 8 + tid]; red[512 + tid] = sacc; }
    __syncthreads();
    constexpr int RPW = T / 256;
    int* list = (int*)(F.ws + WS_LIST); int* route = (int*)(F.ws + WS_ROUTE);
    for (int i = tid; i < RPW; i += 512) { const int m = R1_ROW(i); const int e1 = route[(size_t)m * 8]; if (e1 < 0) continue; const int e2 = route[(size_t)m * 8 + 2];
        const int s1 = red[512 + e1] + route[(size_t)m * 8 + 1], s2 = red[512 + e2] + route[(size_t)m * 8 + 3];
        list[(size_t)e1 * T + s1] = m; list[(size_t)e2 * T + s2] = m; route[(size_t)m * 8 + 1] = s1; route[(size_t)m * 8 + 3] = s2; }
}

__device__ __forceinline__ void moe_tables(Frame& F, int l) {
    const int lane = fresh_lane(), tid = F.wave * 64 + lane; (void)tid;
    if (tid == 0) { const int* gcnt = (const int*)((unsigned*)F.ws + CW_MOECNT + (l >> 1) * 64); int acc = 0;
        for (int e = 0; e < 8; ++e) { const int c = __hip_atomic_load(gcnt + e, __ATOMIC_RELAXED, __HIP_MEMORY_SCOPE_AGENT); F.MISC[32 + e] = (unsigned)c; F.MISC[16 + e] = (unsigned)acc; acc += (c + 255) / 256; }
        F.MISC[24] = (unsigned)acc; }
    __syncthreads();
}

template <bool MOE>
__device__ __forceinline__ void phase_r2(Frame& F, int l) {
    const int lane = fresh_lane(), l32 = lane & 31, half = lane >> 5;
    const int gw = F.vcu * NWAVES + F.wave, NGW = F.G * NWAVES;
    const float* ng = in_ptr(F, I_NORMG); const float* modt = (const float*)(F.ws + WS_MOD);
    bf16_t* h = (bf16_t*)(F.ws + WS_H); bf16_t* xa = (bf16_t*)(F.ws + WS_XA);
    const int* route = (const int*)(F.ws + WS_ROUTE);
    int RBM = 0, trb = 0, S = 1; if (MOE) pg8::moe_tail_params((int)F.MISC[24], RBM, trb, S);
    { const int ln = (l < DEPTH - 1) ? l + 1 : l; const float* ml = modt + (size_t)l * 9 * (6 * DM); const float* mn = modt + (size_t)ln * 9 * (6 * DM);
      fill_params(F, ng + (l * 4 + 3) * DM, ng + (ln * 4 + 0) * DM, ml + 5 * DM, mn + 0 * DM, mn + 1 * DM, F.wave * 64 + lane); }
    const LAS float* par = (const LAS float*)F.lds;
    f32x4 an[8], bn[8], hn[8]; float w1n = 0.f, w2n = 0.f;
#define R2_LOAD(mm) do { const RowPos _r = row_pos(mm); const bool _sk = (l == DEPTH - 1) && _r.isctx; \
        if (MOE) { int e1 = 0, s1 = 0, e2 = 0, s2 = 0; w1n = 0.f; w2n = 0.f; \
            if (!_sk) { e1 = route[(size_t)(mm) * 8]; s1 = route[(size_t)(mm) * 8 + 1]; e2 = route[(size_t)(mm) * 8 + 2]; s2 = route[(size_t)(mm) * 8 + 3]; w1n = ((const float*)route)[(size_t)(mm) * 8 + 4]; w2n = ((const float*)route)[(size_t)(mm) * 8 + 5]; } \
            const size_t r1 = (size_t)F.MISC[16 + e1] * 256 + s1, r2 = (size_t)F.MISC[16 + e2] * 256 + s2; \
            ld_yp_row2(F.ws, r1, RBM, trb, S, l32, an); ld_yp_row2(F.ws, r2, RBM, trb, S, l32, bn); } \
        else ld_y_row2(F.ws, (mm), _r, _r.isctx, 4, l32, an); \
        ld_row2_bf16(h + (size_t)(mm) * DM, l32, hn); } while (0)
    if (gw < T / 2) R2_LOAD(2 * gw + half);
    for (int pi = gw; pi < T / 2; pi += NGW) { const int m = 2 * pi + half; const RowPos rp = row_pos(m);
        const bool skip = (l == DEPTH - 1) && rp.isctx;
        const LAS float* pm = par + (2 + 3 * rp.modrow) * DM;
        f32x4 yv[8], hv[8], u[8];
#pragma unroll
        for (int j = 0; j < 8; ++j) { yv[j] = MOE ? (an[j] * w1n + bn[j] * w2n) : an[j]; hv[j] = hn[j]; }
        if (pi + NGW < T / 2) R2_LOAD(m + 2 * NGW);
        const float rstd_y = rsqrtf(sumsq_row2(yv) * (1.0f / DM) + NORM_EPS);
#pragma unroll
        for (int j = 0; j < 8; ++j) { if ((j & 3) == 0) __builtin_amdgcn_sched_barrier(0);
            const int c = 128 * j + 4 * l32; const f32x4 g3 = *(const LAS f32x4*)(par + c), gt = *(const LAS f32x4*)(pm + c);
            hv[j] = hv[j] + gt * (yv[j] * rstd_y * g3); }
        if (l == DEPTH - 1) { if (!skip) { float* dsto = out_ptr() + ((size_t)rp.b * SEQ + (rp.p - CTXL)) * DM;
#pragma unroll
                for (int j = 0; j < 8; ++j) *(f32x4*)(dsto + 128 * j + 4 * l32) = hv[j]; } }
        else st_row2_bf16(h + (size_t)m * DM, l32, hv);
        if (l < DEPTH - 1) { const float rstd_h = rsqrtf(sumsq_row2(hv) * (1.0f / DM) + NORM_EPS);
            norm_mod2<false>(hv, rstd_h, par + DM, pm + 1 * DM, pm + 2 * DM, xa + (size_t)m * DM, l32, true, u); }
    }
}
namespace scan {
constexpr int A_STR = 272, T_STR = 80;
constexpr int A1_OFF = 0, A2_OFF = 32 * A_STR, K2T_OFF = 2 * 32 * A_STR, VT_OFF = K2T_OFF + 128 * T_STR, DEC_OFF = VT_OFF + 128 * T_STR, BUF_BYTES = DEC_OFF + 512;
constexpr int NCH = TPB / 32;
__device__ __forceinline__ int crow(int r, int hi) { return (r & 3) + 8 * (r >> 2) + 4 * hi; }
__device__ __forceinline__ int tok_of(int p, int dir) { return dir == 0 ? p : (p < CTXL ? (CTXL - 1 - p) : (TPB + CTXL - 1 - p)); }

__device__ __forceinline__ int chunk_lowtok(int n, int dir) { return dir == 0 ? 32 * n : (n < CTXL / 32 ? CTXL - 32 - 32 * n : TPB + CTXL - 32 - 32 * n); }
constexpr int RAW_OFF = 2 * BUF_BYTES, RAW_BYTES = 3 * 8192;
__device__ __forceinline__ void prep_dma(const bf16_t* __restrict__ z, int b, int hd, int dir, int n, LAS unsigned char* raw, int pw, int lane) {
    const char* U = (const char*)(z + (size_t)(b * TPB + chunk_lowtok(n, dir)) * A_IN + hd * 128);
#pragma unroll
    for (int k = 0; k < 2; ++k) { const int c = 8 * pw + 4 * k + (lane >> 4), mr = dir ? 31 - c : c; const unsigned L = (unsigned)(mr * A_IN + (lane & 15) * 8) * 2u;
        __builtin_amdgcn_global_load_lds((const unsigned*)(U + L), (LAS unsigned*)(raw + 0 * 8192 + (2 * pw + k) * 1024), 16, 0, 0);
        __builtin_amdgcn_global_load_lds((const unsigned*)(U + 2048 * (1 + dir) + L), (LAS unsigned*)(raw + 1 * 8192 + (2 * pw + k) * 1024), 16, 0, 0);
        __builtin_amdgcn_global_load_lds((const unsigned*)(U + 6144 + L), (LAS unsigned*)(raw + 2 * 8192 + (2 * pw + k) * 1024), 16, 0, 0); }
}
struct Raw { unsigned short q[16], f[16], v[16]; };
__device__ __forceinline__ void prep_read(Raw& r, const LAS unsigned char* raw, int d, int rh) {
#pragma unroll
    for (int i = 0; i < 16; ++i) { const int o = (16 * rh + i) * 256 + d * 2;
        r.q[i] = *(const LAS unsigned short*)(raw + o); r.f[i] = *(const LAS unsigned short*)(raw + 8192 + o); r.v[i] = *(const LAS unsigned short*)(raw + 16384 + o); }
}
__device__ __forceinline__ void prep_compute(const Raw& r, float lbv, LAS unsigned char* buf, int d, int rh, int lane) {
    float cum[16], kk[16]; float run = 0.f;
#pragma unroll
    for (int i = 0; i < 16; ++i) { const float s = fast_rcp(1.0f + __builtin_amdgcn_exp2f(bf2f(r.f[i]) * -1.4426950408889634f)); const float f = lbv + (1.0f - lbv) * s; kk[i] = 1.0f - f; run += __builtin_amdgcn_logf(f); cum[i] = run; }
    const float tot_lo = __shfl(run, lane & 31);
    if (rh) {
#pragma unroll
        for (int i = 0; i < 16; ++i) cum[i] += tot_lo; }
    const float cend = __shfl(cum[15], (lane & 31) + 32);
    const float dec = __builtin_amdgcn_exp2f(cend);
    unsigned short a1[16], a2[16], k2[16];
#pragma unroll
    for (int i = 0; i < 16; ++i) { const float e1 = __builtin_amdgcn_exp2f(cum[i]), e2 = __builtin_amdgcn_exp2f(-cum[i]); const float A2 = kk[i] * e2;
        const unsigned w12 = cvt_pk_bf16(bf2f(r.q[i]) * 0.08838834764831845f * e1, A2);
        a1[i] = (unsigned short)(w12 & 0xffffu); a2[i] = (unsigned short)(w12 >> 16); k2[i] = (unsigned short)(cvt_pk_bf16(A2 * dec, 0.f) & 0xffffu); }
#pragma unroll
    for (int i = 0; i < 16; ++i) { const int c = 16 * rh + i;
        *(LAS unsigned short*)(buf + A1_OFF + c * A_STR + d * 2) = a1[i]; *(LAS unsigned short*)(buf + A2_OFF + c * A_STR + d * 2) = a2[i]; }
#pragma unroll
    for (int i = 0; i < 16; i += 2) { const int c = 16 * rh + i;
        *(LAS unsigned*)(buf + K2T_OFF + d * T_STR + c * 2) = (unsigned)k2[i] | ((unsigned)k2[i + 1] << 16);
        *(LAS unsigned*)(buf + VT_OFF + d * T_STR + c * 2) = (unsigned)r.v[i] | ((unsigned)r.v[i + 1] << 16); }
    if (rh == 0) *(LAS float*)(buf + DEC_OFF + d * 4) = dec;
}
#define SCAN_BAR() do { asm volatile("s_waitcnt lgkmcnt(0)" ::: "memory"); __builtin_amdgcn_s_barrier(); asm volatile("" ::: "memory"); } while (0)

__device__ __forceinline__ bf16x8 cvt8(const f32x16& x, int base) {
    u32x4 w; w.x = cvt_pk_bf16(x[base + 0], x[base + 1]); w.y = cvt_pk_bf16(x[base + 2], x[base + 3]); w.z = cvt_pk_bf16(x[base + 4], x[base + 5]); w.w = cvt_pk_bf16(x[base + 6], x[base + 7]);
    return *reinterpret_cast<bf16x8*>(&w);
}
__device__ __forceinline__ bf16x8 ld44(const LAS unsigned char* p) {
    const u32x2 a = *(const LAS u32x2*)p, b = *(const LAS u32x2*)(p + 16); u32x4 w = {a.x, a.y, b.x, b.y}; return *reinterpret_cast<bf16x8*>(&w);
}

__device__ __forceinline__ void scan_unit(unsigned char* ws, LAS unsigned char* lds, int unit, int wave, int lane, int tid) {
    static_assert(NCH % 2 == 0, "even chunk count");
    const int b = unit >> 4, hd = (unit >> 1) & 7, dir = unit & 1;
    const bf16_t* z = (const bf16_t*)(ws + WS_Z);
    bf16_t* od = (bf16_t*)(ws + WS_O) + (size_t)dir * T * DM;
    const float* lb = (const float*)(ws + WS_LB) + dir * 1024 + hd * 128;
    const int r32 = lane & 31, hi = lane >> 5;
    if (wave >= 4) {
        const int pw = wave - 4, d = 32 * pw + r32, rh = hi; const float lbv = lb[d];
        asm volatile("s_waitcnt vmcnt(0)" ::: "memory");
        LAS unsigned char* rawb = lds + RAW_OFF; Raw R;
        prep_dma(z, b, hd, dir, 0, rawb, pw, lane); prep_dma(z, b, hd, dir, 1, rawb + RAW_BYTES, pw, lane);
        asm volatile("s_waitcnt vmcnt(6)" ::: "memory"); SCAN_BAR();
        int st = 0;
        for (int n = -1; n < NCH - 1; ++n) {
            prep_read(R, rawb + st * RAW_BYTES, d, rh); prep_compute(R, lbv, lds + ((n + 1) & 1) * BUF_BYTES, d, rh, lane);
            const int st3 = (st == 0) ? 2 : st - 1;
            if (n + 3 < NCH) { prep_dma(z, b, hd, dir, n + 3, rawb + st3 * RAW_BYTES, pw, lane); asm volatile("s_waitcnt vmcnt(6)" ::: "memory"); }
            else asm volatile("s_waitcnt vmcnt(0)" ::: "memory");
            SCAN_BAR();
            st = (st == 2) ? 0 : st + 1;
        }
        SCAN_BAR();
    } else {
        const int sw = wave;
        f32x16 S[4];
#pragma unroll
        for (int t = 0; t < 4; ++t) S[t] = f32x16{};
        SCAN_BAR(); SCAN_BAR();
        for (int n = 0; n < NCH; ++n) {
            const LAS unsigned char* buf = lds + (n & 1) * BUF_BYTES;
            f32x16 X = f32x16{}, Xb = f32x16{};
#pragma unroll
            for (int ks = 0; ks < 8; ++ks) { const bf16x8 a = *(const LAS bf16x8*)(buf + A2_OFF + r32 * A_STR + (16 * ks + 8 * hi) * 2), bb = *(const LAS bf16x8*)(buf + A1_OFF + r32 * A_STR + (16 * ks + 8 * hi) * 2);
                if (ks & 1) Xb = __builtin_amdgcn_mfma_f32_32x32x16_bf16(a, bb, Xb, 0, 0, 0); else X = __builtin_amdgcn_mfma_f32_32x32x16_bf16(a, bb, X, 0, 0, 0); }
#pragma unroll
            for (int r = 0; r < 16; ++r) X[r] = (crow(r, hi) <= r32) ? X[r] + Xb[r] : 0.f;
            f32x16 O = f32x16{};
#pragma unroll
            for (int s0 = 0; s0 < 2; ++s0) { const bf16x8 a = cvt8(X, 8 * s0); const bf16x8 bb = ld44(buf + VT_OFF + (32 * sw + r32) * T_STR + (16 * s0 + 4 * hi) * 2);
                O = __builtin_amdgcn_mfma_f32_32x32x16_bf16(a, bb, O, 0, 0, 0); }
            f32x16 O2 = f32x16{}, O3 = f32x16{};
#pragma unroll
            for (int t = 0; t < 4; ++t)
#pragma unroll
                for (int s0 = 0; s0 < 2; ++s0) { const bf16x8 a = ld44(buf + A1_OFF + r32 * A_STR + (32 * t + 16 * s0 + 4 * hi) * 2); const bf16x8 bb = cvt8(S[t], 8 * s0);
                    if (t & 1) O3 = __builtin_amdgcn_mfma_f32_32x32x16_bf16(a, bb, O3, 0, 0, 0); else O2 = __builtin_amdgcn_mfma_f32_32x32x16_bf16(a, bb, O2, 0, 0, 0); }
#pragma unroll
            for (int r = 0; r < 16; ++r) O[r] += O2[r] + O3[r];
#pragma unroll
            for (int r = 0; r < 16; ++r) { const int p = 32 * n + crow(r, hi); od[(size_t)(b * TPB + tok_of(p, dir)) * DM + hd * 128 + 32 * sw + r32] = (bf16_t)f2bf(O[r]); }
#pragma unroll
            for (int t = 0; t < 4; ++t) {
#pragma unroll
                for (int g4 = 0; g4 < 4; ++g4) { const f32x4 dc = *(const LAS f32x4*)(buf + DEC_OFF + (32 * t + 8 * g4 + 4 * hi) * 4);
                    S[t][4 * g4 + 0] *= dc.x; S[t][4 * g4 + 1] *= dc.y; S[t][4 * g4 + 2] *= dc.z; S[t][4 * g4 + 3] *= dc.w; }
#pragma unroll
                for (int s0 = 0; s0 < 2; ++s0) { const bf16x8 a = *(const LAS bf16x8*)(buf + K2T_OFF + (32 * t + r32) * T_STR + (16 * s0 + 8 * hi) * 2), bb = *(const LAS bf16x8*)(buf + VT_OFF + (32 * sw + r32) * T_STR + (16 * s0 + 8 * hi) * 2);
                    S[t] = __builtin_amdgcn_mfma_f32_32x32x16_bf16(a, bb, S[t], 0, 0, 0); }
            }
            SCAN_BAR();
        }
    }
}
}

__device__ __forceinline__ void phase_a_readout(Frame& F) {
    const int lane = fresh_lane(), l32 = lane & 31, hh = lane >> 5;
    const int gw = F.vcu * NWAVES + F.wave, NGW = F.G * NWAVES;
    const bf16_t* of = (const bf16_t*)(F.ws + WS_O); const bf16_t* ob = of + (size_t)T * DM; const bf16_t* z = (const bf16_t*)(F.ws + WS_Z); bf16_t* xa = (bf16_t*)(F.ws + WS_XA);
    const f32x4 g = *(const f32x4*)(in_ptr(F, I_A_ONORM) + 4 * l32);
    for (int m = gw; m < T; m += NGW) {
        u32x2 a[4], bb[4], gt[4];
#pragma unroll
        for (int it = 0; it < 4; ++it) { const int c = (2 * it + hh) * 128 + 4 * l32;
            a[it] = *(const u32x2*)(of + (size_t)m * DM + c); bb[it] = *(const u32x2*)(ob + (size_t)m * DM + c); gt[it] = *(const u32x2*)(z + (size_t)m * A_IN + 4096 + c); }
#pragma unroll
        for (int it = 0; it < 4; ++it) { const int c = (2 * it + hh) * 128 + 4 * l32;
            const float o0 = bf2f(a[it].x & 0xffffu) + bf2f(bb[it].x & 0xffffu), o1 = bf2f(a[it].x >> 16) + bf2f(bb[it].x >> 16), o2 = bf2f(a[it].y & 0xffffu) + bf2f(bb[it].y & 0xffffu), o3 = bf2f(a[it].y >> 16) + bf2f(bb[it].y >> 16);
            const float rstd = rsqrtf(half_sum((o0 * o0 + o1 * o1) + (o2 * o2 + o3 * o3)) * (1.0f / 128.0f) + NORM_EPS);
            u32x2 w; w.x = pk2(o0 * rstd * g.x * silu_f(bf2f(gt[it].x & 0xffffu)), o1 * rstd * g.y * silu_f(bf2f(gt[it].x >> 16)));
            w.y = pk2(o2 * rstd * g.z * silu_f(bf2f(gt[it].y & 0xffffu)), o3 * rstd * g.w * silu_f(bf2f(gt[it].y >> 16)));
            *(u32x2*)(xa + (size_t)m * DM + c) = w; }
    }
}

__device__ __forceinline__ f32x2 rope_cs(const float* rt, int kind, int pos, int fi) { return *(const f32x2*)(rt + (((size_t)kind * 64 + pos) * 32 + fi) * 2); }

__device__ __forceinline__ void phase_b_row1(Frame& F) {
    const int lane = fresh_lane();
    const int gw = F.vcu * NWAVES + F.wave, NGW = F.G * NWAVES;
    const bf16_t* z = (const bf16_t*)(F.ws + WS_Z); bf16_t* cq = (bf16_t*)(F.ws + WS_O); bf16_t* ckv = cq + (size_t)T * 384; bf16_t* Kb = (bf16_t*)(F.ws + WS_K);
    const float* qg = in_ptr(F, I_B_QNORM); const float* kg = in_ptr(F, I_B_KVNORM); const float* rt = (const float*)(F.ws + WS_ROPE);
    const int ip = lane & 15, hg = lane >> 4;
    f32x2 qgv[3];
#pragma unroll
    for (int j = 0; j < 3; ++j) qgv[j] = *(const f32x2*)(qg + 128 * j + 2 * lane);
    const f32x4 kgv = *(const f32x4*)(kg + 4 * lane);
    for (int m = gw; m < T; m += NGW) { const RowPos rp = row_pos(m); const bf16_t* zr = z + (size_t)m * B_INP;
        float q[6]; float sq = 0.f;
#pragma unroll
        for (int j = 0; j < 3; ++j) { const unsigned w = *(const unsigned*)(zr + 128 * j + 2 * lane); q[2 * j] = bf2f(w & 0xffffu); q[2 * j + 1] = bf2f(w >> 16); sq += q[2 * j] * q[2 * j] + q[2 * j + 1] * q[2 * j + 1]; }
        const u32x2 kw = *(const u32x2*)(zr + 384 + 4 * lane); const float k0 = bf2f(kw.x & 0xffffu), k1 = bf2f(kw.x >> 16), k2 = bf2f(kw.y & 0xffffu), k3 = bf2f(kw.y >> 16);
        const float skv = (k0 * k0 + k1 * k1) + (k2 * k2 + k3 * k3);
        const float rq = rsqrtf(wave_sum(sq) * (1.0f / 384.0f) + NORM_EPS), rkv = rsqrtf(wave_sum(skv) * (1.0f / 256.0f) + NORM_EPS);
#pragma unroll
        for (int j = 0; j < 3; ++j) { const f32x2 g = qgv[j]; *(unsigned*)(cq + (size_t)m * 384 + 128 * j + 2 * lane) = pk2(q[2 * j] * rq * g.x, q[2 * j + 1] * rq * g.y); }
        { const f32x4 g = kgv; u32x2 w; w.x = pk2(k0 * rkv * g.x, k1 * rkv * g.y); w.y = pk2(k2 * rkv * g.z, k3 * rkv * g.w); *(u32x2*)(ckv + (size_t)m * 256 + 4 * lane) = w; }
        const unsigned rw = *(const unsigned*)(zr + 640 + 2 * ip); float x0 = bf2f(rw & 0xffffu), x1 = bf2f(rw >> 16);
        const float p0 = __shfl_xor(x0, 4), p1 = __shfl_xor(x1, 4);
        if (!rp.isctx) { const int pos = (ip < 8) ? rp.prow : rp.pcol; const f32x2 c0 = rope_cs(rt, 0, pos, (2 * ip) & 7), c1 = rope_cs(rt, 0, pos, (2 * ip + 1) & 7);
            if (ip & 4) { x0 = x0 * c0.x + p0 * c0.y; x1 = x1 * c1.x + p1 * c1.y; } else { x0 = x0 * c0.x - p0 * c0.y; x1 = x1 * c1.x - p1 * c1.y; } }
        const unsigned kb = pk2(x0, x1);
#pragma unroll
        for (int hh = 0; hh < 4; ++hh) { const int hd = 4 * hh + hg; *(unsigned*)(Kb + ((size_t)(rp.b * 16 + hd) * TPB + rp.p) * 96 + 64 + 2 * ip) = kb; }
    }
}
__device__ __forceinline__ void phase_b_row2(Frame& F) {
    const int lane = fresh_lane();
    const int gw = F.vcu * NWAVES + F.wave, NGW = F.G * NWAVES;
    bf16_t* Qb = (bf16_t*)(F.ws + WS_Q); const float* rt = (const float*)(F.ws + WS_ROPE);
    const int ip = lane & 15, hg = lane >> 4;
    for (int m = gw; m < T; m += NGW) { const RowPos rp = row_pos(m); if (rp.isctx) continue;
        const int pos = (ip < 8) ? rp.prow : rp.pcol; const f32x2 c0 = rope_cs(rt, 0, pos, (2 * ip) & 7), c1 = rope_cs(rt, 0, pos, (2 * ip + 1) & 7);
        unsigned w[4];
#pragma unroll
        for (int hh = 0; hh < 4; ++hh) w[hh] = *(const unsigned*)(Qb + (size_t)m * 1536 + (4 * hh + hg) * 96 + 64 + 2 * ip);
#pragma unroll
        for (int hh = 0; hh < 4; ++hh) { float x0 = bf2f(w[hh] & 0xffffu), x1 = bf2f(w[hh] >> 16); const float p0 = __shfl_xor(x0, 4), p1 = __shfl_xor(x1, 4);
            if (ip & 4) { x0 = x0 * c0.x + p0 * c0.y; x1 = x1 * c1.x + p1 * c1.y; } else { x0 = x0 * c0.x - p0 * c0.y; x1 = x1 * c1.x - p1 * c1.y; }
            *(unsigned*)(Qb + (size_t)m * 1536 + (4 * hh + hg) * 96 + 64 + 2 * ip) = pk2(x0, x1); }
    }
}
__device__ __forceinline__ void phase_c_row(Frame& F) {
    const int lane = fresh_lane();
    const int gw = F.vcu * NWAVES + F.wave, NGW = F.G * NWAVES;
    const bf16_t* z = (const bf16_t*)(F.ws + WS_Z); bf16_t* Qb = (bf16_t*)(F.ws + WS_Q); bf16_t* Kb = (bf16_t*)(F.ws + WS_K); bf16_t* Vb = (bf16_t*)(F.ws + WS_V);
    const float* qg = in_ptr(F, I_C_QNORM); const float* kg = in_ptr(F, I_C_KNORM); const float* rt = (const float*)(F.ws + WS_ROPE);
    const f32x2 qgv = *(const f32x2*)(qg + 2 * lane), kgv = *(const f32x2*)(kg + 2 * lane);
    const bool up = (lane & 16) != 0;
    for (int m = gw; m < T; m += NGW) { const RowPos rp = row_pos(m); const bf16_t* zr = z + (size_t)m * C_IN;
        f32x2 c0 = (f32x2){1.f, 0.f}, c1 = (f32x2){1.f, 0.f};
        if (!rp.isctx) { const int pos = (lane < 32) ? rp.prow : rp.pcol; c0 = rope_cs(rt, 2, pos, (2 * lane) & 31); c1 = rope_cs(rt, 2, pos, (2 * lane + 1) & 31); }
        unsigned w[10];
#pragma unroll
        for (int hv = 0; hv < 10; ++hv) w[hv] = *(const unsigned*)(zr + hv * 128 + 2 * lane);
#pragma unroll
        for (int hv = 0; hv < 10; ++hv) { float a = bf2f(w[hv] & 0xffffu), bq = bf2f(w[hv] >> 16);
            const float rstd = rsqrtf(wave_sum(a * a + bq * bq) * (1.0f / 128.0f) + NORM_EPS);
            a *= rstd * (hv < 8 ? qgv.x : kgv.x); bq *= rstd * (hv < 8 ? qgv.y : kgv.y);
            const float ap = __shfl_xor(a, 16), bp = __shfl_xor(bq, 16);
            const float ar = up ? (a * c0.x + ap * c0.y) : (a * c0.x - ap * c0.y), br = up ? (bq * c1.x + bp * c1.y) : (bq * c1.x - bp * c1.y);
            bf16_t* dst = (hv < 8) ? Qb + (size_t)m * 1024 + hv * 128 : Kb + (size_t)m * 256 + (hv - 8) * 128;
            *(unsigned*)(dst + 2 * lane) = pk2(ar, br); }
        *(u32x2*)(Vb + (size_t)m * 256 + 4 * lane) = *(const u32x2*)(zr + 1280 + 4 * lane);
    }
}
__device__ __forceinline__ void phase_d_row1(Frame& F) {
    const int lane = fresh_lane();
    const int gw = F.vcu * NWAVES + F.wave, NGW = F.G * NWAVES;
    const bf16_t* z = (const bf16_t*)(F.ws + WS_Z); bf16_t* Qb = (bf16_t*)(F.ws + WS_Q); bf16_t* Kb = (bf16_t*)(F.ws + WS_K); bf16_t* Vb = (bf16_t*)(F.ws + WS_V);
    const float* rt = (const float*)(F.ws + WS_ROPE);
    const int lp = lane & 31; const bool up = (lane & 8) != 0;
    for (int m = gw; m < T; m += NGW) { const RowPos rp = row_pos(m); const bf16_t* zr = z + (size_t)m * D_IN;
        f32x2 c0 = (f32x2){1.f, 0.f}, c1 = (f32x2){1.f, 0.f};
        if (!rp.isctx) { const int pos = (lp < 16) ? rp.prow : rp.pcol; c0 = rope_cs(rt, 1, pos, (2 * lp) & 15); c1 = rope_cs(rt, 1, pos, (2 * lp + 1) & 15); }
        unsigned w[16];
#pragma unroll
        for (int i = 0; i < 16; ++i) w[i] = *(const unsigned*)(zr + 128 * i + 2 * lane);
#pragma unroll
        for (int i = 0; i < 16; ++i) { const float a = bf2f(w[i] & 0xffffu), bq = bf2f(w[i] >> 16); const float ap = __shfl_xor(a, 8), bp = __shfl_xor(bq, 8);
            const float ar = up ? (a * c0.x + ap * c0.y) : (a * c0.x - ap * c0.y), br = up ? (bq * c1.x + bp * c1.y) : (bq * c1.x - bp * c1.y);
            bf16_t* dst = (i < 8) ? Qb + (size_t)m * 1024 + 128 * i : Kb + (size_t)m * 1024 + 128 * (i - 8); *(unsigned*)(dst + 2 * lane) = pk2(ar, br); }
        { const u32x4 a = *(const u32x4*)(zr + 2048 + 16 * lane), bq = *(const u32x4*)(zr + 2048 + 16 * lane + 8); *(u32x4*)(Vb + (size_t)m * 1024 + 16 * lane) = a; *(u32x4*)(Vb + (size_t)m * 1024 + 16 * lane + 8) = bq; }
    }
}
__device__ __forceinline__ void phase_d_row2(Frame& F) {
    const int lane = fresh_lane(), l32 = lane & 31, hh = lane >> 5;
    const int gw = F.vcu * NWAVES + F.wave, NGW = F.G * NWAVES;
    const bf16_t* A = (const bf16_t*)(F.ws + WS_O); bf16_t* xa = (bf16_t*)(F.ws + WS_XA);
    const float* lam = in_ptr(F, I_D_LAMBDA);
    const float lambda_init = 0.8f - 0.6f * 0.40656965974059917f;
    const float s1 = wave_sum(lam[lane] * lam[64 + lane]), s2 = wave_sum(lam[128 + lane] * lam[192 + lane]);
    const float lam_full = expf(s1) - expf(s2) + lambda_init;
    const f32x4 g = *(const f32x4*)(in_ptr(F, I_D_ONORM) + 4 * l32) * (1.0f - lambda_init);
    for (int m = gw; m < T; m += NGW) { if ((m % TPB) < CTXL) continue;
        u32x2 a[4], bb[4];
#pragma unroll
        for (int it = 0; it < 4; ++it) { const int hd = 2 * it + hh; a[it] = *(const u32x2*)(A + (size_t)m * 2048 + (2 * hd) * 128 + 4 * l32); bb[it] = *(const u32x2*)(A + (size_t)m * 2048 + (2 * hd + 1) * 128 + 4 * l32); }
#pragma unroll
        for (int it = 0; it < 4; ++it) { const int hd = 2 * it + hh;
            const float o0 = bf2f(a[it].x & 0xffffu) - lam_full * bf2f(bb[it].x & 0xffffu), o1 = bf2f(a[it].x >> 16) - lam_full * bf2f(bb[it].x >> 16);
            const float o2 = bf2f(a[it].y & 0xffffu) - lam_full * bf2f(bb[it].y & 0xffffu), o3 = bf2f(a[it].y >> 16) - lam_full * bf2f(bb[it].y >> 16);
            const float rstd = rsqrtf(half_sum((o0 * o0 + o1 * o1) + (o2 * o2 + o3 * o3)) * (1.0f / 128.0f) + NORM_EPS);
            u32x2 w; w.x = pk2(o0 * rstd * g.x, o1 * rstd * g.y); w.y = pk2(o2 * rstd * g.z, o3 * rstd * g.w);
            *(u32x2*)(xa + (size_t)m * DM + hd * 128 + 4 * l32) = w; }
    }
}

#ifndef MK_STAG
#define MK_STAG 1
#endif
#define MK_SPLITKV 0
#define MK_PRE_B 1
#define MK_PRE_C 1
#define MK_PRE_D 1
#define MK_PRE(DK) (MK_STAG && ((DK) == 96 ? MK_PRE_B : (DK) == 128 ? MK_PRE_C : MK_PRE_D))
template <int DK, int DV, int ldq, int ldk, int ldv, int ldo, int H, int GK, int GV>
__device__ __forceinline__ void attn_phase(Frame& F, const bf16_t* Q, const bf16_t* K, const bf16_t* V, bf16_t* O, float scale, bool skip_ctx, int dup = 1) {
    const float C = scale * 1.4426950408889634f, thr_raw = att::THR / scale;
    const int NHV = NBATCH * H * 16, NCTX = skip_ctx ? 0 : NBATCH * H;
    const int LO = NHV % F.G, NFULL = NHV - LO; int SF = 1;
    if (MK_SPLITKV && dup == 1 && LO > 0 && F.G % LO == 0) { const int q = F.G / LO; if (q == 2 || q == 4) SF = q; }
    const int NPART = (SF > 1) ? LO * SF : 0, NLAT = (SF > 1) ? NFULL : NHV, NTOT = NLAT + NPART + NCTX;
    float* PO = (float*)(F.ws + WS_YS); float* PML = PO + (size_t)256 * 256 * 128;
    for (int L0 = F.vcu; L0 < NTOT * dup; L0 += F.G) { const int L = (dup > 1) ? L0 % NTOT : L0;
        int b, hd, qb, part = -1, U = L;
        if (L >= NLAT && L < NLAT + NPART) { const int j = L - NLAT; U = NFULL + j / SF; part = j % SF; }
        if (L < NLAT + NPART) { const int grp = U >> 4; b = grp / H; hd = grp % H; qb = 1 + (U & 15); } else { const int L2 = L - NLAT - NPART; b = L2 / H; hd = L2 % H; qb = 0; }
        const size_t row0 = (size_t)b * TPB + (size_t)qb * 256; const bf16_t* Kh = K + (size_t)(b * (H / GK) + hd / GK) * TPB * DK; const bf16_t* Vh = V + (size_t)(b * (H / GV) + hd / GV) * TPB * DV;
        if (part >= 0) { const int klen = TPB / SF, j = L - NLAT;
            att::attn_unit_stag<DK, DV, ldq, DK, DV, ldo, MK_PRE(DK) != 0, false, true>(Q + row0 * ldq + hd * DK, Kh + (size_t)part * klen * DK, Vh + (size_t)part * klen * DV, nullptr,
                               klen, C, thr_raw, (char*)F.lds, F.wave, PO + (size_t)j * 256 * DV, PML + (size_t)j * 256 * 2); }
        else
        att::attn_unit_stag<DK, DV, ldq, DK, DV, ldo, MK_PRE(DK) != 0, false>(Q + row0 * ldq + hd * DK, Kh, Vh, O + row0 * ldo + hd * DV,
                               qb == 0 ? CTXL : TPB, C, thr_raw, (char*)F.lds, F.wave);
    }
    __syncthreads();
}
template <int DV, int ldo, int H>
__device__ __forceinline__ void attn_merge(Frame& F, bf16_t* O) {
    const int NHV = NBATCH * H * 16, LO = NHV % F.G, NFULL = NHV - LO; int SF = 1;
    if (LO > 0 && F.G % LO == 0) { const int q = F.G / LO; if (q == 2 || q == 4) SF = q; }
    if (SF == 1) return;
    const float* PO = (const float*)(F.ws + WS_YS); const float* PML = PO + (size_t)256 * 256 * 128;
    const int lane = fresh_lane(), gw = F.vcu * NWAVES + F.wave, NGW = F.G * NWAVES;
    for (int it = gw; it < LO * 256; it += NGW) { const int u = it >> 8, r = it & 255, U = NFULL + u;
        const int grp = U >> 4, b = grp / H, hd = grp % H, qb = 1 + (U & 15);
        float mi[4], li[4], m = -3.0e38f;
#pragma unroll
        for (int i = 0; i < 4; ++i) { if (i < SF) { const f32x2 ml = *(const f32x2*)(PML + ((size_t)(u * SF + i) * 256 + r) * 2); mi[i] = ml.x; li[i] = ml.y; m = fmaxf(m, ml.x); } else { mi[i] = 0.f; li[i] = 0.f; } }
        float l = 0.f, w[4];
#pragma unroll
        for (int i = 0; i < 4; ++i) { w[i] = (i < SF) ? __builtin_amdgcn_exp2f(mi[i] - m) : 0.f; l += w[i] * li[i]; }
        const float rl = 1.0f / l;
        bf16_t* orow = O + ((size_t)b * TPB + (size_t)qb * 256 + r) * ldo + hd * DV;
#pragma unroll
        for (int c0 = 0; c0 < DV; c0 += 64) { float acc = 0.f;
#pragma unroll
            for (int i = 0; i < 4; ++i) if (i < SF) acc += w[i] * PO[((size_t)(u * SF + i) * 256 + r) * DV + c0 + lane];
            orow[c0 + lane] = (bf16_t)f2bf(acc * rl); } }
}
#ifndef MK_MULTI
#define MK_MULTI 0
#endif
constexpr int NPHASE = 37;
#ifndef MK_REP_MASK
#define MK_REP_MASK 0ull
#endif
#ifndef MK_REP_N
#define MK_REP_N 1
#endif
#ifndef MK_DUP
#define MK_DUP -1
#endif
#define DUPF(k) ((k) == MK_DUP ? 2 : 1)
#ifndef MK_LIMIT
#define MK_LIMIT 37
#endif
struct Args { const float* in[N_IN]; float* out; unsigned char* ws; int ph_lo, ph_hi; };

__device__ __forceinline__ void gemm_plain_f32(Frame& F, const bf16_t* A, const bf16_t* Bt, int N, int K, float* C, int ldc, int dup = 1) {
    pg8::Gemm g{A, Bt, K / 64, N, K, 0, nullptr, 0, nullptr}; pg8::StaticOrder S; S.init(T / 256, N / 256, F.G, (int)blockIdx.x, dup); pg8::EpiF32 E{C, ldc};
    pg8::gemm_phase<pg8::EpiF32, pg8::StaticOrder, false>(F.lds, g, S, E, F.wave);
}
__device__ __forceinline__ void gemm_plain_bf16(Frame& F, const bf16_t* A, const bf16_t* Bt, int N, int K, bf16_t* C, int ldc, int dup = 1) {
    pg8::Gemm g{A, Bt, K / 64, N, K, 0, nullptr, 0, nullptr}; pg8::StaticOrder S; S.init(T / 256, N / 256, F.G, (int)blockIdx.x, dup); pg8::EpiBf16 E{C, ldc};
    pg8::gemm_phase<pg8::EpiBf16, pg8::StaticOrder, false>(F.lds, g, S, E, F.wave);
}
template <int S>
__device__ __forceinline__ void gemm_n1024(Frame& F, const bf16_t* A, const bf16_t* Bt, int K, bool skip_ctx, int dup = 1) {
    { pg8::Gemm g{A, Bt, K / 64, DM, K, 0, nullptr, 0, nullptr}; pg8::LatOrder S1; S1.so.init(128, DM / 256, F.G, (int)blockIdx.x, dup); pg8::EpiBf16 E{(bf16_t*)(F.ws + WS_Y), DM};
      pg8::gemm_phase<pg8::EpiBf16, pg8::LatOrder, false>(F.lds, g, S1, E, F.wave); }
    if (!skip_ctx) { pg8::Gemm g{A, Bt, K / 64 / S, DM, K, 0, nullptr, 0, nullptr}; pg8::CtxSplitOrder S2{DM / 256, S, K / 64 / S, F.G, (int)blockIdx.x, dup}; pg8::EpiF32 E{(float*)(F.ws + WS_YS), DM};
      pg8::gemm_phase<pg8::EpiF32, pg8::CtxSplitOrder, false>(F.lds, g, S2, E, F.wave); }
}
__device__ __forceinline__ void gemm_swiglu(Frame& F, const bf16_t* A, const bf16_t* Bt, bf16_t* C, int dup = 1) {
    pg8::Gemm g{A, Bt, DM / 128, 2 * FF, DM / 2, 0, nullptr, 0, nullptr}; pg8::StaticOrder S; S.init(T / 256, 2 * FF / 256, F.G, (int)blockIdx.x, dup); pg8::EpiSwiglu E{C, FF, 1.0f / 32.0f};
    pg8::gemm_phase<pg8::EpiSwiglu, pg8::StaticOrder, false, true>(F.lds, g, S, E, F.wave);
}
__device__ __forceinline__ void gemm_moe_gu(Frame& F, int lm, int dup = 1) {
    moe_tables(F, 2 * lm + 1);
    pg8::Gemm g{(const bf16_t*)(F.ws + WS_XA), (const bf16_t*)(F.ws + WS_MOE_GU + (size_t)lm * 8 * SZ_GU), DM / 128, 2 * FF, DM / 2, (size_t)2 * FF * DM / 2, (const int*)(F.ws + WS_LIST), T, (const LAS int*)(F.MISC + 32)};
    pg8::MoeOrder S; S.so.init((int)F.MISC[24], 2 * FF / 256, F.G, (int)blockIdx.x, dup); S.rb0 = (const LAS int*)(F.MISC + 16); pg8::EpiSwiglu E{(bf16_t*)(F.ws + WS_ACT), FF, 1.0f / 32.0f};
    pg8::gemm_phase<pg8::EpiSwiglu, pg8::MoeOrder, true, true>(F.lds, g, S, E, F.wave);
}
__device__ __forceinline__ void gemm_moe_down(Frame& F, int lm, int dup = 1) {
    moe_tables(F, 2 * lm + 1);
    int RBM, trb, S; pg8::moe_tail_params((int)F.MISC[24], RBM, trb, S);
    const bf16_t* A = (const bf16_t*)(F.ws + WS_ACT); const bf16_t* Bt = (const bf16_t*)(F.ws + WS_MOE_DN + (size_t)lm * 8 * SZ_DN);
    { pg8::Gemm g{A, Bt, FF / 64, DM, FF, (size_t)DM * FF, nullptr, 0, nullptr};
      pg8::MoeOrder S1; S1.so.init(RBM, DM / 256, F.G, (int)blockIdx.x, dup); S1.rb0 = (const LAS int*)(F.MISC + 16); pg8::EpiBf16 E{(bf16_t*)(F.ws + WS_YP), DM};
      pg8::gemm_phase<pg8::EpiBf16, pg8::MoeOrder, false>(F.lds, g, S1, E, F.wave); }
    if (trb > 0) { pg8::Gemm g{A, Bt, FF / 64 / S, DM, FF, (size_t)DM * FF, nullptr, 0, nullptr};
      pg8::MoeTailOrder S2{RBM, trb, S, FF / 64 / S, F.G, (int)blockIdx.x, dup, (const LAS int*)(F.MISC + 16)}; pg8::EpiF32 E{(float*)(F.ws + WS_YS), DM};
      pg8::gemm_phase<pg8::EpiF32, pg8::MoeTailOrder, false>(F.lds, g, S2, E, F.wave); }
}
__device__ __forceinline__ void xcd_or_nothing(const XcdBarrier& b, int wave) { if (!MK_MULTI) xcd_barrier(b, wave); }
__global__ void __launch_bounds__(NWAVES * 64, 2) fwd_kernel(Args args) {
    extern __shared__ __attribute__((aligned(16))) unsigned char lds_raw[];
    Frame F;
    F.lds = (LAS unsigned char*)lds_raw; F.MISC = (volatile LAS unsigned*)(F.lds + MISC_OFF);
    F.wave = __builtin_amdgcn_readfirstlane((int)threadIdx.x >> 6);
    F.G = gridDim.x; { const int bx = blockIdx.x; F.vcu = (F.G % 8 == 0) ? (bx % 8) * (F.G / 8) + bx / 8 : bx; }
    F.ws = args.ws;
    for (int u = threadIdx.x; u < 256; u += NWAVES * 64) ((LAS unsigned*)(F.lds + MISC_OFF))[u] = 0u;
    __syncthreads();
    XcdBarrier bar; bar.bar = (unsigned*)((unsigned*)F.ws + CW_BAR); bar.x = 0; bar.st = nullptr;
    if (!MK_MULTI) bar = xcd_barrier_post((unsigned*)((unsigned*)F.ws + CW_BAR), F.MISC + 0);
    const int lo = args.ph_lo, hi = args.ph_hi;
#define IN(k) (lo <= (k) && (k) < hi)
#define NREP(k) ((((unsigned long long)(MK_REP_MASK) >> (k)) & 1ull) ? (1 + MK_REP_N) : 1)
#define SEAM(k) do { if (!MK_MULTI && IN((k) + 1)) xcd_barrier(bar, F.wave); } while (0)
    unsigned char* ws = F.ws;
    bf16_t* XA = (bf16_t*)(ws + WS_XA); bf16_t* Y = (bf16_t*)(ws + WS_Y); bf16_t* ACT = (bf16_t*)(ws + WS_ACT);
    bf16_t* Qb = (bf16_t*)(ws + WS_Q); bf16_t* Kb = (bf16_t*)(ws + WS_K); bf16_t* Vb = (bf16_t*)(ws + WS_V); bf16_t* Ob = (bf16_t*)(ws + WS_O);

    if (IN(0)) { for (int rep = 0; rep < NREP(0); ++rep) { p0_prologue(F); if (rep + 1 < NREP(0)) xcd_or_nothing(bar, F.wave); } SEAM(0); }
    if (IN(1)) { for (int rep = 0; rep < NREP(1); ++rep) { for (int d2 = 0; d2 < DUPF(1); ++d2) { phase_r0(F); } if (rep + 1 < NREP(1)) xcd_or_nothing(bar, F.wave); } SEAM(1); }
    if (IN(2)) { for (int rep = 0; rep < NREP(2); ++rep) { gemm_plain_bf16(F, XA, (const bf16_t*)(ws + WS_WA_IN), A_IN, DM, (bf16_t*)(ws + WS_Z), A_IN, DUPF(2)); if (rep + 1 < NREP(2)) xcd_or_nothing(bar, F.wave); } SEAM(2); }
    if (IN(3)) { for (int rep = 0; rep < NREP(3); ++rep) { if ((int)blockIdx.x < NBATCH * 8 * 2) { for (int d2 = 0; d2 < DUPF(3); ++d2) { const int ln = fresh_lane(); scan::scan_unit(ws, F.lds, (int)blockIdx.x, F.wave, ln, F.wave * 64 + ln); __syncthreads(); } }
        else if (rep == 0) { const int nidle = F.G - NBATCH * 8 * 2; p0_convert(F, p0_split_item(), g_mats.item0[NMAT], ((int)blockIdx.x - NBATCH * 8 * 2) * NWAVES + F.wave, nidle * NWAVES, fresh_lane()); } if (rep + 1 < NREP(3)) xcd_or_nothing(bar, F.wave); } SEAM(3); }
    if (IN(4)) { for (int rep = 0; rep < NREP(4); ++rep) { for (int d2 = 0; d2 < DUPF(4); ++d2) { phase_a_readout(F); } if (rep + 1 < NREP(4)) xcd_or_nothing(bar, F.wave); } SEAM(4); }
    if (IN(5)) { for (int rep = 0; rep < NREP(5); ++rep) { gemm_n1024<4>(F, XA, (const bf16_t*)(ws + WS_WA_OUT), DM, false, DUPF(5)); if (rep + 1 < NREP(5)) xcd_or_nothing(bar, F.wave); } SEAM(5); }
    if (IN(6)) { for (int rep = 0; rep < NREP(6); ++rep) { phase_r1<false>(F, 0); if (rep + 1 < NREP(6)) xcd_or_nothing(bar, F.wave); } SEAM(6); }
    if (IN(7)) { for (int rep = 0; rep < NREP(7); ++rep) { gemm_swiglu(F, XA, (const bf16_t*)(ws + WS_FFN_GU), ACT, DUPF(7)); if (rep + 1 < NREP(7)) xcd_or_nothing(bar, F.wave); } SEAM(7); }
    if (IN(8)) { for (int rep = 0; rep < NREP(8); ++rep) { gemm_n1024<4>(F, ACT, (const bf16_t*)(ws + WS_FFN_DN), FF, false, DUPF(8)); if (rep + 1 < NREP(8)) xcd_or_nothing(bar, F.wave); } SEAM(8); }
    if (IN(9)) { for (int rep = 0; rep < NREP(9); ++rep) { phase_r2<false>(F, 0); if (rep + 1 < NREP(9)) xcd_or_nothing(bar, F.wave); } SEAM(9); }
    if (IN(10)) { for (int rep = 0; rep < NREP(10); ++rep) { gemm_plain_bf16(F, XA, (const bf16_t*)(ws + WS_WB_IN), B_INP, DM, (bf16_t*)(ws + WS_Z), B_INP, DUPF(10)); if (rep + 1 < NREP(10)) xcd_or_nothing(bar, F.wave); } SEAM(10); }
    if (IN(11)) { for (int rep = 0; rep < NREP(11); ++rep) { for (int d2 = 0; d2 < DUPF(11); ++d2) { phase_b_row1(F); } if (rep + 1 < NREP(11)) xcd_or_nothing(bar, F.wave); } SEAM(11); }
    if (IN(12)) {
        { pg8::Gemm g{Ob, (const bf16_t*)(ws + WS_WB_QB), 384 / 64, 1536, 384, 0, nullptr, 0, nullptr}; pg8::StaticOrder S; S.init(T / 256, 1536 / 256, F.G, (int)blockIdx.x); pg8::EpiRopeB E{Qb, (const float*)(ws + WS_ROPE), MK_PRE(96) ? 0.10206207261596575f * 1.4426950408889634f : 1.0f};
          pg8::gemm_phase<pg8::EpiRopeB, pg8::StaticOrder, false>(F.lds, g, S, E, F.wave); }
        { pg8::Gemm g{Ob + (size_t)T * 384, (const bf16_t*)(ws + WS_WB_KVB), 256 / 64, 2048, 256, 0, nullptr, 0, nullptr}; pg8::StaticOrder S; S.init(T / 256, 2048 / 256, F.G, (int)blockIdx.x); pg8::EpiKV E{Kb, 1536, Vb, 1024};
          pg8::gemm_phase<pg8::EpiKV, pg8::StaticOrder, false>(F.lds, g, S, E, F.wave); }
        SEAM(12); }
    if (IN(13)) { for (int rep = 0; rep < NREP(13); ++rep) { attn_phase<96, 64, 1536, 1536, 1024, DM, 16, 1, 1>(F, Qb, Kb, Vb, XA, 0.10206207261596575f, false, DUPF(13)); if (rep + 1 < NREP(13)) xcd_or_nothing(bar, F.wave); } SEAM(13); }
    if (IN(14)) { for (int rep = 0; rep < NREP(14); ++rep) { gemm_n1024<4>(F, XA, (const bf16_t*)(ws + WS_WB_OUT), DM, false, DUPF(14)); if (rep + 1 < NREP(14)) xcd_or_nothing(bar, F.wave); } SEAM(14); }
    if (IN(15)) { for (int rep = 0; rep < NREP(15); ++rep) { phase_r1<true>(F, 1); if (rep + 1 < NREP(15)) xcd_or_nothing(bar, F.wave); } SEAM(15); }
    if (IN(16)) { moe_build(F); SEAM(16); }
    if (IN(17)) { for (int rep = 0; rep < NREP(17); ++rep) { gemm_moe_gu(F, 0, DUPF(17)); if (rep + 1 < NREP(17)) xcd_or_nothing(bar, F.wave); } SEAM(17); }
    if (IN(18)) { for (int rep = 0; rep < NREP(18); ++rep) { gemm_moe_down(F, 0, DUPF(18)); if (rep + 1 < NREP(18)) xcd_or_nothing(bar, F.wave); } SEAM(18); }
    if (IN(19)) { for (int rep = 0; rep < NREP(19); ++rep) { moe_tables(F, 1); phase_r2<true>(F, 1); if (rep + 1 < NREP(19)) xcd_or_nothing(bar, F.wave); } SEAM(19); }
    if (IN(20)) { { pg8::Gemm g{XA, (const bf16_t*)(ws + WS_WC_IN), DM / 64, C_IN, DM, 0, nullptr, 0, nullptr}; pg8::StaticOrder S; S.init(T / 256, C_IN / 256, F.G, (int)blockIdx.x, DUPF(20));
          pg8::EpiNormRopeC E{Qb, Kb, Vb, in_ptr(F, I_C_QNORM), in_ptr(F, I_C_KNORM), (const float*)(ws + WS_ROPE) + (size_t)2 * 64 * 32 * 2, (LAS float*)(F.lds + pg8::STAGE_BYTES + 2048), MK_PRE(128) ? 0.08838834764831845f * 1.4426950408889634f : 1.0f};
          pg8::gemm_phase<pg8::EpiNormRopeC, pg8::StaticOrder, false>(F.lds, g, S, E, F.wave); } }
    if (IN(21)) { SEAM(21); }
    if (IN(22)) { for (int rep = 0; rep < NREP(22); ++rep) { attn_phase<128, 128, 1024, 256, 256, DM, 8, 4, 4>(F, Qb, Kb, Vb, XA, 0.08838834764831845f, false, DUPF(22)); if (rep + 1 < NREP(22)) xcd_or_nothing(bar, F.wave); } SEAM(22); }
    if (IN(23)) { for (int rep = 0; rep < NREP(23); ++rep) { gemm_n1024<4>(F, XA, (const bf16_t*)(ws + WS_WC_OUT), DM, false, DUPF(23)); if (rep + 1 < NREP(23)) xcd_or_nothing(bar, F.wave); } SEAM(23); }
    if (IN(24)) { for (int rep = 0; rep < NREP(24); ++rep) { phase_r1<false>(F, 2); if (rep + 1 < NREP(24)) xcd_or_nothing(bar, F.wave); } SEAM(24); }
    if (IN(25)) { for (int rep = 0; rep < NREP(25); ++rep) { gemm_swiglu(F, XA, (const bf16_t*)(ws + WS_FFN_GU + SZ_GU), ACT, DUPF(25)); if (rep + 1 < NREP(25)) xcd_or_nothing(bar, F.wave); } SEAM(25); }
    if (IN(26)) { for (int rep = 0; rep < NREP(26); ++rep) { gemm_n1024<4>(F, ACT, (const bf16_t*)(ws + WS_FFN_DN + SZ_DN), FF, false, DUPF(26)); if (rep + 1 < NREP(26)) xcd_or_nothing(bar, F.wave); } SEAM(26); }
    if (IN(27)) { for (int rep = 0; rep < NREP(27); ++rep) { phase_r2<false>(F, 2); if (rep + 1 < NREP(27)) xcd_or_nothing(bar, F.wave); } SEAM(27); }
    if (IN(28)) { { pg8::Gemm g{XA, (const bf16_t*)(ws + WS_WD_IN), DM / 64, D_IN, DM, 0, nullptr, 0, nullptr}; pg8::StaticOrder S; S.init(T / 256, D_IN / 256, F.G, (int)blockIdx.x, DUPF(28));
          pg8::EpiRopeD E{Qb, Kb, Vb, (const float*)(ws + WS_ROPE) + (size_t)1 * 64 * 32 * 2, MK_PRE(64) ? 0.125f * 1.4426950408889634f : 1.0f};
          pg8::gemm_phase<pg8::EpiRopeD, pg8::StaticOrder, false>(F.lds, g, S, E, F.wave); } SEAM(28); }
    if (IN(29)) { for (int rep = 0; rep < NREP(29); ++rep) { attn_phase<64, 128, 1024, 1024, 1024, 2048, 16, 1, 2>(F, Qb, Kb, Vb, Ob, 0.125f, true, DUPF(29)); if (rep + 1 < NREP(29)) xcd_or_nothing(bar, F.wave); } SEAM(29); }
    if (IN(30)) { for (int rep = 0; rep < NREP(30); ++rep) { for (int d2 = 0; d2 < DUPF(30); ++d2) { phase_d_row2(F); } if (rep + 1 < NREP(30)) xcd_or_nothing(bar, F.wave); } SEAM(30); }
    if (IN(31)) { for (int rep = 0; rep < NREP(31); ++rep) { gemm_n1024<4>(F, XA, (const bf16_t*)(ws + WS_WD_OUT), DM, true, DUPF(31)); if (rep + 1 < NREP(31)) xcd_or_nothing(bar, F.wave); } SEAM(31); }
    if (IN(32)) { for (int rep = 0; rep < NREP(32); ++rep) { phase_r1<true>(F, 3); if (rep + 1 < NREP(32)) xcd_or_nothing(bar, F.wave); } SEAM(32); }
    if (IN(33)) { moe_build(F); SEAM(33); }
    if (IN(34)) { for (int rep = 0; rep < NREP(34); ++rep) { gemm_moe_gu(F, 1, DUPF(34)); if (rep + 1 < NREP(34)) xcd_or_nothing(bar, F.wave); } SEAM(34); }
    if (IN(35)) { for (int rep = 0; rep < NREP(35); ++rep) { gemm_moe_down(F, 1, DUPF(35)); if (rep + 1 < NREP(35)) xcd_or_nothing(bar, F.wave); } SEAM(35); }
    if (IN(36)) { moe_tables(F, 3); phase_r2<true>(F, 3); }
#if MK_LIMIT < 37
    {
        xcd_barrier(bar, F.wave);
        float* outp = out_ptr(); const int tid = F.wave * 64 + fresh_lane();
#if MK_LIMIT == 34 || MK_LIMIT == 35 || MK_LIMIT == 36
        moe_tables(F, 3);
        int RBM, trb, S; pg8::moe_tail_params((int)F.MISC[24], RBM, trb, S);
#endif
        for (int r = (int)blockIdx.x; r < NBATCH * SEQ; r += F.G) { const int b = r / SEQ, l = r % SEQ; const size_t m = (size_t)b * TPB + CTXL + l;
#if MK_LIMIT == 34
            const int* route = (const int*)(ws + WS_ROUTE); const int* list = (const int*)(ws + WS_LIST);
            const int e1 = route[m * 8], s1 = route[m * 8 + 1], e2 = route[m * 8 + 2], s2 = route[m * 8 + 3];
            const unsigned char* xa8 = (const unsigned char*)(ws + WS_XA) + m * DM;
            for (int c = tid; c < DM; c += NWAVES * 64) { float v = 0.f;
                if (c >= 512) v = (float)((unsigned)xa8[2 * (c - 512)] + 256u * (unsigned)xa8[2 * (c - 512) + 1]); else
                if (c < 4) v = (float)route[m * 8 + c]; else if (c < 6) v = ((const float*)route)[m * 8 + c]; else if (c == 6) v = (float)(list[(size_t)e1 * T + s1] - (int)m); else if (c == 7) v = (float)(list[(size_t)e2 * T + s2] - (int)m);
                else if (c < 16) v = (float)F.MISC[16 + (c - 8)]; else if (c < 24) v = (float)F.MISC[32 + (c - 16)]; else if (c == 24) v = (float)F.MISC[24];
                outp[(size_t)r * DM + c] = v; }
#elif MK_LIMIT == 35
            const int* route = (const int*)(ws + WS_ROUTE); const bf16_t* act = (const bf16_t*)(ws + WS_ACT);
            const size_t r1 = (size_t)F.MISC[16 + route[m * 8]] * 256 + route[m * 8 + 1], r2 = (size_t)F.MISC[16 + route[m * 8 + 2]] * 256 + route[m * 8 + 3];
            for (int c = tid; c < DM; c += NWAVES * 64) { float v = 0.f;
                for (int q = 0; q < 4; ++q) { const int cc = c + q * DM; if (cc < FF) v += bf2f((unsigned)act[r1 * FF + cc]) + 2.0f * bf2f((unsigned)act[r2 * FF + cc]); }
                outp[(size_t)r * DM + c] = v; }
#elif MK_LIMIT == 36
            const int* route = (const int*)(ws + WS_ROUTE);
            const size_t r1 = (size_t)F.MISC[16 + route[m * 8]] * 256 + route[m * 8 + 1], r2 = (size_t)F.MISC[16 + route[m * 8 + 2]] * 256 + route[m * 8 + 3];
            for (int c = tid; c < DM; c += NWAVES * 64) { float v = 0.f;
                for (int k = 0; k < 2; ++k) { const size_t rr = k ? r2 : r1; const int rb = (int)(rr >> 8); float a = 0.f;
                    if (rb >= RBM) { const float* ys = (const float*)(ws + WS_YS) + ((size_t)(rb - RBM) * 256 + (rr & 255)) * DM; for (int s2 = 0; s2 < S; ++s2) a += ys[(size_t)s2 * trb * 256 * DM + c]; }
                    else a = bf2f((unsigned)((const bf16_t*)(ws + WS_YP))[rr * DM + c]);
                    v += (k ? 2.0f : 1.0f) * a; }
                outp[(size_t)r * DM + c] = v; }
#else
            const bf16_t* hh = (const bf16_t*)(ws + WS_H); const size_t src = m * DM;
            for (int c = tid; c < DM; c += NWAVES * 64) outp[(size_t)r * DM + c] = bf2f((unsigned)hh[src + c]);
#endif
        }
    }
#endif
#undef IN
#undef SEAM
}

extern "C" void kernel_launch(void* const* d_in, const int* in_sizes, int n_in, void* d_out, int out_size, void* d_ws, size_t ws_size, hipStream_t stream) {
    static int grid = 0;
    if (grid == 0) {
        if (n_in != N_IN || out_size != NBATCH * SEQ * DM || ws_size < WS_END) { fprintf(stderr, "kernel_launch: unexpected shapes: n_in %d out %d ws %zu (need %zu)\n", n_in, out_size, ws_size, (size_t)WS_END); grid = -1; return; }
        int dev = 0, cus = 0, per_cu = 0;
        if (hipGetDevice(&dev) != hipSuccess || hipDeviceGetAttribute(&cus, hipDeviceAttributeMultiprocessorCount, dev) != hipSuccess) { grid = -1; return; }
        if (hipFuncSetAttribute((const void*)fwd_kernel, hipFuncAttributeMaxDynamicSharedMemorySize, LDS_BYTES) != hipSuccess) { fprintf(stderr, "kernel_launch: hipFuncSetAttribute failed\n"); grid = -1; return; }
        if (hipOccupancyMaxActiveBlocksPerMultiprocessor(&per_cu, (const void*)fwd_kernel, NWAVES * 64, LDS_BYTES) != hipSuccess || per_cu < 1) fprintf(stderr, "kernel_launch: occupancy query reports %d\n", per_cu);
        (void)hipGetLastError();
        grid = cus;
    }
    if (grid < 0) return;
    (void)hipMemsetAsync((char*)d_ws + WS_CTL, 0, CTL_BYTES, stream);
    Args a{};
    for (int i = 0; i < N_IN; ++i) a.in[i] = (const float*)d_in[i];
    a.out = (float*)d_out; a.ws = (unsigned char*)d_ws;
#if MK_MULTI
    for (int p = 0; p < MK_LIMIT; ++p) { a.ph_lo = p; a.ph_hi = p + 1; hipLaunchKernelGGL(fwd_kernel, dim3(grid), dim3(NWAVES * 64), LDS_BYTES, stream, a); }
#else
    a.ph_lo = 0; a.ph_hi = MK_LIMIT; hipLaunchKernelGGL(fwd_kernel, dim3(grid), dim3(NWAVES * 64), LDS_BYTES, stream, a);
#endif
    const hipError_t le = hipPeekAtLastError();
    if (le != hipSuccess) fprintf(stderr, "kernel_launch: launch failed: %s\n", hipGetErrorName(le));
}
```

```cpp
#include <hip/hip_runtime.h>
#include <cstdio>
#include <cstdint>

#define GAS __attribute__((address_space(1)))
#define LAS __attribute__((address_space(3)))
typedef unsigned short bf16_t;
typedef short bf16x8 __attribute__((ext_vector_type(8)));
typedef short s16x4 __attribute__((ext_vector_type(4)));
typedef float f32x2 __attribute__((ext_vector_type(2)));
typedef float f32x4 __attribute__((ext_vector_type(4)));
typedef float f32x16 __attribute__((ext_vector_type(16)));
typedef unsigned u32x2 __attribute__((ext_vector_type(2)));
typedef unsigned u32x4 __attribute__((ext_vector_type(4)));

__device__ __forceinline__ float bf2f(unsigned b) { return __uint_as_float(b << 16); }
__device__ __forceinline__ unsigned f2bf(float f) { unsigned u = __float_as_uint(f); return (u + 0x7fffu + ((u >> 16) & 1u)) >> 16; }
__device__ __forceinline__ unsigned pk2(float lo, float hi) { return f2bf(lo) | (f2bf(hi) << 16); }
__device__ __forceinline__ unsigned cvt_pk_bf16(float lo, float hi) { unsigned r; asm volatile("v_cvt_pk_bf16_f32 %0, %1, %2" : "=v"(r) : "v"(lo), "v"(hi)); return r; }
typedef int v8i32 __attribute__((ext_vector_type(8)));
__device__ __forceinline__ unsigned pk4_fp8(float a, float b, float c, float d) { int w = 0; w = __builtin_amdgcn_cvt_pk_fp8_f32(a, b, w, false); w = __builtin_amdgcn_cvt_pk_fp8_f32(c, d, w, true); asm volatile("s_nop 1" : "+v"(w)); return (unsigned)w; }
__device__ __forceinline__ float wave_sum(float v) {
#pragma unroll
    for (int o = 1; o < 64; o <<= 1) v += __shfl_xor(v, o);
    return v;
}
__device__ __forceinline__ int fresh_lane() { int l; asm volatile("v_mbcnt_lo_u32_b32 %0, -1, 0\n\tv_mbcnt_hi_u32_b32 %0, -1, %0" : "=v"(l)); return l; }
__device__ __forceinline__ float fast_exp(float x) { return __builtin_amdgcn_exp2f(x * 1.4426950408889634f); }
__device__ __forceinline__ float fast_rcp(float x) { return __builtin_amdgcn_rcpf(x); }
__device__ __forceinline__ float silu_f(float x) { return x * fast_rcp(1.0f + fast_exp(-x)); }

#ifndef MK_WT
#define MK_WT 0
#endif
__device__ __forceinline__ void st16(void* p, u32x4 v) {
#if MK_WT
    asm volatile("global_store_dwordx4 %0, %1, off sc1\n\ts_nop 1" :: "v"(p), "v"(v) : "memory");
#else
    *(u32x4*)p = v;
#endif
}
__device__ __forceinline__ void st16f(void* p, f32x4 v) { st16(p, __builtin_bit_cast(u32x4, v)); }

namespace pg8 {
constexpr int BM = 256, BK = 64, HALF = 128, HTB = HALF * BK * 2, STAGE_BYTES = 8 * HTB, NXCD = 8, WGM = 8;
__host__ __device__ __forceinline__ int lds_byte(int r, int c) { const int st = (r >> 4) * 2 + (c >> 5), rr = r & 15, cc = c & 31, ob = rr * 64 + cc * 2; return st * 1024 + (ob ^ (((ob >> 9) & 1) << 5)); }
__host__ __device__ __forceinline__ void stage_rc(int b, int& R, int& C) { const int st = b / 1024, sb = b % 1024, swz = sb ^ (((sb >> 9) & 1) << 5); R = (st >> 1) * 16 + swz / 64; C = (st & 1) * 32 + (swz % 64) / 2; }
__host__ __device__ __forceinline__ int perm32(int rho) { const int n = rho >> 4, i = rho & 15; return 8 * (i >> 2) + 4 * n + (i & 3); }

struct Unit { int pm, pn, e, pl, po, kt0; };
struct Gemm { const bf16_t* A; const bf16_t* Bt; int nt  , N, K  ; size_t bstride; const int* list; int list_stride; const LAS int* cnt; };

struct StaticOrder {
    int nM, nN, nwg, G, c, dup;
    __device__ __forceinline__ void init(int nM_, int nN_, int G_, int c_, int dup_ = 1) { nM = nM_; nN = nN_; nwg = nM * nN; G = G_; c = c_; dup = dup_; }
    __device__ __forceinline__ bool next(int i, Unit& u) const {
        const long L = (long)i * G + c; if (L >= (long)nwg * dup) return false;
        int wgid = (int)L; if (dup > 1) wgid = (int)((unsigned)wgid % (unsigned)nwg); { const int q = nwg / NXCD, r = nwg % NXCD, xcd = wgid % NXCD, off = wgid / NXCD; wgid = (xcd < r ? xcd * (q + 1) : r * (q + 1) + (xcd - r) * q) + off; }
        const int nig = WGM * nN, gid = wgid / nig, fm = gid * WGM, gsz = (nM - fm) < WGM ? (nM - fm) : WGM;
        u.pm = fm + ((wgid % nig) % gsz); u.pn = (wgid % nig) / gsz; u.e = 0; u.pl = 0; u.po = u.pm; u.kt0 = 0; return true;
    }
};
struct MoeOrder {
    StaticOrder so; const LAS int* rb0;
    __device__ __forceinline__ bool next(int i, Unit& u) const {
        if (!so.next(i, u)) return false;
        int e = 0;
#pragma unroll
        for (int j = 1; j < 8; ++j) e = (u.pm >= rb0[j]) ? j : e;
        u.e = e; u.pl = u.pm - rb0[e]; u.po = u.pm; u.kt0 = 0; return true;
    }
};

__device__ __forceinline__ void moe_tail_params(int NRB, int& RBM, int& trb, int& S) { RBM = (NRB >> 6) << 6; trb = NRB - RBM; S = trb <= 16 ? 4 : trb <= 32 ? 2 : 1; }
struct MoeTailOrder {
    int RBM, trb, S, ntsub, G, c0, dup; const LAS int* rb0;
    __device__ __forceinline__ bool next(int i, Unit& u) const { int L = i * G + c0; const int n = trb * 4 * S; if (L >= n * dup) return false; if (dup > 1) L %= n;
        const int s = L % S, r = L / S; u.pn = r & 3; const int tb = r >> 2; u.pm = RBM + tb; u.po = s * trb + tb; u.kt0 = s * ntsub; u.pl = 0;
        int e = 0;
#pragma unroll
        for (int j = 1; j < 8; ++j) e = (u.pm >= rb0[j]) ? j : e;
        u.e = e; return true; }
};
struct LatOrder {
    StaticOrder so;
    __device__ __forceinline__ bool next(int i, Unit& u) const { if (!so.next(i, u)) return false; u.pm = (u.pm >> 4) * 17 + 1 + (u.pm & 15); u.po = u.pm; return true; }
};
struct CtxSplitOrder {
    int nN, S, ntsub, G, c0, dup;
    __device__ __forceinline__ bool next(int i, Unit& u) const { int L = i * G + c0; if (L >= 8 * nN * S * dup) return false; if (dup > 1) L %= 8 * nN * S;
        const int s = L % S, r = L / S; u.pn = r % nN; const int c = r / nN; u.pm = 17 * c; u.po = s * 8 + c; u.kt0 = s * ntsub; u.e = 0; u.pl = 0; return true; }
};

struct EpiF32 {
    static constexpr bool PERM = false;
    float* C; int ldc;
    __device__ __forceinline__ void operator()(const f32x4 (&acc)[2][2][4][2], const Unit& u, int wr, int wc, int fr, int fq) const {
        const int row0 = u.po * BM + wr * 64 + fr, col0 = u.pn * BM + wc * 32 + 4 * fq;
#pragma unroll
        for (int ai = 0; ai < 2; ++ai)
#pragma unroll
            for (int m = 0; m < 4; ++m) { float* rowp = C + (size_t)(row0 + ai * HALF + m * 16) * ldc + col0;
#pragma unroll
                for (int bj = 0; bj < 2; ++bj)
#pragma unroll
                    for (int n = 0; n < 2; ++n) st16f(rowp + bj * HALF + n * 16, acc[ai][bj][m][n]); }
    }
};
struct EpiBf16 {
    static constexpr bool PERM = true;
    bf16_t* O; int ldc;
    __device__ __forceinline__ void operator()(const f32x4 (&acc)[2][2][4][2], const Unit& u, int wr, int wc, int fr, int fq) const {
        const int row0 = u.po * BM + wr * 64 + fr, col0 = u.pn * BM + wc * 32 + 8 * fq;
#pragma unroll
        for (int ai = 0; ai < 2; ++ai)
#pragma unroll
            for (int m = 0; m < 4; ++m) { bf16_t* rowp = O + (size_t)(row0 + ai * HALF + m * 16) * ldc + col0;
#pragma unroll
                for (int bj = 0; bj < 2; ++bj) { const f32x4 v0 = acc[ai][bj][m][0], v1 = acc[ai][bj][m][1];
                    u32x4 w; w.x = cvt_pk_bf16(v0[0], v0[1]); w.y = cvt_pk_bf16(v0[2], v0[3]); w.z = cvt_pk_bf16(v1[0], v1[1]); w.w = cvt_pk_bf16(v1[2], v1[3]);
                    st16(rowp + bj * HALF, w); } }
    }
};
struct EpiSwiglu {
    static constexpr bool PERM = true;
    bf16_t* O; int ldc; float sc;
    __device__ __forceinline__ void operator()(const f32x4 (&acc)[2][2][4][2], const Unit& u, int wr, int wc, int fr, int fq) const {
        const int row0 = u.po * BM + wr * 64 + fr, col0 = u.pn * HALF + wc * 32 + 8 * fq;
        const float k1 = -1.4426950408889634f * sc, c2 = 1.0f / (sc * sc);
#pragma unroll
        for (int ai = 0; ai < 2; ++ai)
#pragma unroll
            for (int m = 0; m < 4; ++m) { bf16_t* rowp = O + (size_t)(row0 + ai * HALF + m * 16) * ldc + col0;
                float r[8];
#pragma unroll
                for (int n = 0; n < 2; ++n)
#pragma unroll
                    for (int j = 0; j < 4; ++j) { const float ag = acc[ai][0][m][n][j], au = acc[ai][1][m][n][j];
                        const float e = __builtin_amdgcn_exp2f(ag * k1); r[n * 4 + j] = (ag * au) * __builtin_amdgcn_rcpf(fmaf(e, c2, c2)); }
                u32x4 w; w.x = cvt_pk_bf16(r[0], r[1]); w.y = cvt_pk_bf16(r[2], r[3]); w.z = cvt_pk_bf16(r[4], r[5]); w.w = cvt_pk_bf16(r[6], r[7]);
                st16(rowp, w); }
    }
};
constexpr int HM_TPB = 4352;
struct EpiKV {
    static constexpr bool PERM = true;
    bf16_t* Kp; int ldk; bf16_t* Vp; int ldv;
    __device__ __forceinline__ void operator()(const f32x4 (&acc)[2][2][4][2], const Unit& u, int wr, int wc, int fr, int fq) const {
        const int row0 = u.po * BM + wr * 64 + fr, within = wc * 32 + 8 * fq, bb = u.po / 17;
#pragma unroll
        for (int ai = 0; ai < 2; ++ai)
#pragma unroll
            for (int m = 0; m < 4; ++m) { const size_t row = (size_t)(row0 + ai * HALF + m * 16);
#pragma unroll
                for (int bj = 0; bj < 2; ++bj) { const int head = u.pn * 2 + bj; const f32x4 v0 = acc[ai][bj][m][0], v1 = acc[ai][bj][m][1];
                    u32x4 w; w.x = cvt_pk_bf16(v0[0], v0[1]); w.y = cvt_pk_bf16(v0[2], v0[3]); w.z = cvt_pk_bf16(v1[0], v1[1]); w.w = cvt_pk_bf16(v1[2], v1[3]);
                    const size_t hrow = (size_t)(bb * 16 + head) * HM_TPB + (row - (size_t)bb * HM_TPB);
                    bf16_t* dst = (within < 64) ? (Kp + hrow * 96 + within) : (Vp + hrow * 64 + (within - 64));
                    st16(dst, w); } }
    }
};

struct EpiRopeD {
    static constexpr bool PERM = true;
    bf16_t* Qp; bf16_t* Kp; bf16_t* Vp; const float* rt; float qs;
    __device__ __forceinline__ void operator()(const f32x4 (&acc)[2][2][4][2], const Unit& u, int wr, int wc, int fr, int fq) const {
        const int row0 = u.po * BM + wr * 64 + fr, cw = wc * 32 + 8 * fq, bb = u.po / 17;
        if (u.pn >= 8) {
#pragma unroll
            for (int ai = 0; ai < 2; ++ai)
#pragma unroll
                for (int m = 0; m < 4; ++m) { const size_t prow = (size_t)(row0 + ai * HALF + m * 16) - (size_t)bb * HM_TPB;
#pragma unroll
                    for (int bj = 0; bj < 2; ++bj) { const f32x4 v0 = acc[ai][bj][m][0], v1 = acc[ai][bj][m][1];
                        u32x4 w; w.x = cvt_pk_bf16(v0[0], v0[1]); w.y = cvt_pk_bf16(v0[2], v0[3]); w.z = cvt_pk_bf16(v1[0], v1[1]); w.w = cvt_pk_bf16(v1[2], v1[3]);
                        const int vh = (u.pn - 8) * 2 + bj;
                        st16(Vp + ((size_t)(bb * 8 + vh) * HM_TPB + prow) * 128 + cw, w); } }
            return; }
        const bool isq = u.pn < 4; const float osc = isq ? qs : 1.0f;
        const int tb = u.pm % 17; const bool isctx = (tb == 0), colpart = (wc & 1) != 0, x2 = (fq & 2) != 0;
        const int f0 = 8 * (fq & 1);
#pragma unroll
        for (int ai = 0; ai < 2; ++ai)
#pragma unroll
            for (int m = 0; m < 4; ++m) {
                const int pos = colpart ? (16 * m + fr) : ((tb - 1) * 4 + 2 * ai + wr);
                f32x4 cs[4];
#pragma unroll
                for (int q = 0; q < 4; ++q) cs[q] = isctx ? (f32x4){1.f, 0.f, 1.f, 0.f} : *(const f32x4*)(rt + ((size_t)(isctx ? 0 : pos) * 32 + f0 + 2 * q) * 2);
                const size_t grow = (size_t)(row0 + ai * HALF + m * 16), prow = grow - (size_t)bb * HM_TPB;
#pragma unroll
                for (int bj = 0; bj < 2; ++bj) { float r[8];
#pragma unroll
                    for (int e = 0; e < 8; ++e) { const float x = acc[ai][bj][m][e >> 2][e & 3] * osc; const float xp = __shfl_xor(x, 32);
                        const float c = cs[e >> 1][2 * (e & 1)], sn = cs[e >> 1][2 * (e & 1) + 1];
                        r[e] = x2 ? (x * c + xp * sn) : (x * c - xp * sn); }
                    u32x4 w; w.x = cvt_pk_bf16(r[0], r[1]); w.y = cvt_pk_bf16(r[2], r[3]); w.z = cvt_pk_bf16(r[4], r[5]); w.w = cvt_pk_bf16(r[6], r[7]);
                    const int cc = cw + bj * HALF;
                    bf16_t* dst = isq ? Qp + grow * 1024 + u.pn * BM + cc : Kp + ((size_t)(bb * 16 + (u.pn - 4) * 4 + (cc >> 6)) * HM_TPB + prow) * 64 + (cc & 63);
                    st16(dst, w); } }
    }
};

struct EpiRopeB {
    static constexpr bool PERM = true;
    bf16_t* O; const float* rt; float qs;
    __device__ __forceinline__ void operator()(const f32x4 (&acc)[2][2][4][2], const Unit& u, int wr, int wc, int fr, int fq) const {
        const int row0 = u.po * BM + wr * 64 + fr, col0 = u.pn * BM + wc * 32 + 8 * fq;
        const int tb = u.pm % 17; const bool isctx = (tb == 0), colpart = (fq & 2) != 0, x2 = (fq & 1) != 0;
#pragma unroll
        for (int ai = 0; ai < 2; ++ai)
#pragma unroll
            for (int m = 0; m < 4; ++m) {
                const int pos = colpart ? (16 * m + fr) : ((tb - 1) * 4 + 2 * ai + wr);
                f32x4 cs[4];
#pragma unroll
                for (int q = 0; q < 4; ++q) cs[q] = isctx ? (f32x4){1.f, 0.f, 1.f, 0.f} : *(const f32x4*)(rt + ((size_t)(isctx ? 0 : pos) * 32 + 2 * q) * 2);
                bf16_t* rowp = O + (size_t)(row0 + ai * HALF + m * 16) * 1536 + col0;
#pragma unroll
                for (int bj = 0; bj < 2; ++bj) { const bool rope = ((u.pn * 8 + bj * 4 + wc) % 3) == 2;
                    float r[8];
#pragma unroll
                    for (int e = 0; e < 8; ++e) { const float x = acc[ai][bj][m][e >> 2][e & 3] * qs; const float xp = __shfl_xor(x, 16);
                        const float c = cs[e >> 1][2 * (e & 1)], sn = cs[e >> 1][2 * (e & 1) + 1];
                        r[e] = rope ? (x2 ? (x * c + xp * sn) : (x * c - xp * sn)) : x; }
                    u32x4 w; w.x = cvt_pk_bf16(r[0], r[1]); w.y = cvt_pk_bf16(r[2], r[3]); w.z = cvt_pk_bf16(r[4], r[5]); w.w = cvt_pk_bf16(r[6], r[7]);
                    st16(rowp + bj * HALF, w); } }
    }
};

struct EpiNormRopeC {
    static constexpr bool PERM = true;
    bf16_t* Qp; bf16_t* Kp; bf16_t* Vp; const float* qg; const float* kg; const float* rt; LAS float* xch; float qs;
    __device__ __forceinline__ void operator()(const f32x4 (&acc)[2][2][4][2], const Unit& u, int wr, int wc, int fr, int fq) const {
        const int row0 = u.po * BM + wr * 64 + fr, bb = u.po / 17;
        if (u.pn == 5) {
#pragma unroll
            for (int ai = 0; ai < 2; ++ai)
#pragma unroll
                for (int m = 0; m < 4; ++m) { const size_t prow = (size_t)(row0 + ai * HALF + m * 16) - (size_t)bb * HM_TPB;
#pragma unroll
                    for (int bj = 0; bj < 2; ++bj) { const f32x4 v0 = acc[ai][bj][m][0], v1 = acc[ai][bj][m][1];
                        u32x4 w; w.x = cvt_pk_bf16(v0[0], v0[1]); w.y = cvt_pk_bf16(v0[2], v0[3]); w.z = cvt_pk_bf16(v1[0], v1[1]); w.w = cvt_pk_bf16(v1[2], v1[3]);
                        st16(Vp + ((size_t)(bb * 2 + bj) * HM_TPB + prow) * 128 + wc * 32 + 8 * fq, w); } }
            asm volatile("s_waitcnt lgkmcnt(0)" ::: "memory"); __builtin_amdgcn_s_barrier(); asm volatile("" ::: "memory");
            return; }
#pragma unroll
        for (int ai = 0; ai < 2; ++ai)
#pragma unroll
            for (int m = 0; m < 4; ++m)
#pragma unroll
                for (int bj = 0; bj < 2; ++bj) { const f32x4 v0 = acc[ai][bj][m][0], v1 = acc[ai][bj][m][1];
                    float sq = (v0[0] * v0[0] + v0[1] * v0[1]) + (v0[2] * v0[2] + v0[3] * v0[3]) + (v1[0] * v1[0] + v1[1] * v1[1]) + (v1[2] * v1[2] + v1[3] * v1[3]);
                    sq += __shfl_xor(sq, 16); sq += __shfl_xor(sq, 32);
                    if (fq == 0) xch[((ai * HALF + wr * 64 + m * 16 + fr) * 2 + bj) * 4 + wc] = sq; }
        asm volatile("s_waitcnt lgkmcnt(0)" ::: "memory"); __builtin_amdgcn_s_barrier(); asm volatile("" ::: "memory");
        const bool isq = u.pn < 4; const float* gv = isq ? qg : kg;
        const int d0 = 64 * (wc >> 1) + 32 * (fq >> 1) + 16 * (wc & 1) + 8 * (fq & 1);
        const f32x4 ga = *(const f32x4*)(gv + d0), gb = *(const f32x4*)(gv + d0 + 4);
        const int tb = u.pm % 17; const bool isctx = (tb == 0), colpart = (wc >> 1) != 0, x2 = (fq >> 1) != 0;
        const int f0 = d0 & 31;
#pragma unroll
        for (int ai = 0; ai < 2; ++ai)
#pragma unroll
            for (int m = 0; m < 4; ++m) {
                const int pos = colpart ? (16 * m + fr) : ((tb - 1) * 4 + 2 * ai + wr);
                f32x4 cs[4];
#pragma unroll
                for (int q = 0; q < 4; ++q) cs[q] = isctx ? (f32x4){1.f, 0.f, 1.f, 0.f} : *(const f32x4*)(rt + ((size_t)(isctx ? 0 : pos) * 32 + f0 + 2 * q) * 2);
                const int rl = ai * HALF + wr * 64 + m * 16 + fr; const size_t row = (size_t)(row0 + ai * HALF + m * 16);
#pragma unroll
                for (int bj = 0; bj < 2; ++bj) { const f32x4 ps = *(const LAS f32x4*)(xch + (rl * 2 + bj) * 4);
                    const float rstd = rsqrtf(((ps[0] + ps[1]) + (ps[2] + ps[3])) * (1.0f / 128.0f) + 1e-6f) * (isq ? qs : 1.0f);
                    const int head = 2 * u.pn + bj; float r[8];
#pragma unroll
                    for (int e = 0; e < 8; ++e) { const float y = acc[ai][bj][m][e >> 2][e & 3] * rstd * (e < 4 ? ga[e] : gb[e - 4]); const float yp = __shfl_xor(y, 32);
                        const float c = cs[e >> 1][2 * (e & 1)], sn = cs[e >> 1][2 * (e & 1) + 1];
                        r[e] = x2 ? (y * c + yp * sn) : (y * c - yp * sn); }
                    u32x4 w; w.x = cvt_pk_bf16(r[0], r[1]); w.y = cvt_pk_bf16(r[2], r[3]); w.z = cvt_pk_bf16(r[4], r[5]); w.w = cvt_pk_bf16(r[6], r[7]);
                    bf16_t* dst = isq ? Qp + row * 1024 + head * 128 + d0 : Kp + ((size_t)(bb * 2 + (head - 8)) * HM_TPB + (row - (size_t)bb * HM_TPB)) * 128 + d0;
                    st16(dst, w); } }
    }
};

template <class Epi, class Sched, bool GATHER, bool FP8 = false>
__device__ __forceinline__ void gemm_phase(LAS unsigned char* lds, const Gemm g, const Sched& S, const Epi& E, const int wid) {
    const int lane = fresh_lane(), tid = wid * 64 + lane, wr = wid >> 2, wc = wid & 3, fr = lane & 15, fq = lane >> 4;
    const int K = g.K, nt = g.nt;
    unsigned voffA[2], voffB[2];
#pragma unroll
    for (int i = 0; i < 2; ++i) { int R, C; stage_rc(tid * 16 + i * 8192, R, C); const int Rb = Epi::PERM ? ((R & ~31) + perm32(R & 31)) : R;
        voffA[i] = (unsigned)(R * K + C) * 2u; voffB[i] = (unsigned)(Rb * K + C) * 2u; }
    const size_t kstep = (size_t)(BK * 2);
    const size_t hstep = (size_t)HALF * K * 2;
    const size_t tstep = 2 * hstep;
    const unsigned ldsw = (unsigned)wid * 1024u;
    const int aoff = lds_byte(wr * 64 + fr, fq * 8), boff = lds_byte(wc * 32 + fr, fq * 8);
#define PG8_SA(b, h) (((b) * 2 + (h)) * HTB)
#define PG8_SB(b, h) ((4 + (b) * 2 + (h)) * HTB)
#define PG8_STAGE(bufoff, gbase, voff) do { _Pragma("unroll") for (int _i = 0; _i < 2; ++_i) \
        __builtin_amdgcn_global_load_lds((const unsigned*)((const char*)(gbase) + (voff)[_i]), (LAS unsigned*)(lds + (bufoff) + ldsw + _i * 8192), 16, 0, 0); } while (0)
#define PG8_STAGE_A(bufoff, Ap, G, h, kb) do { if constexpr (GATHER) { PG8_STAGE(bufoff, (const char*)g.A + (kb), (G)[h]); } else { PG8_STAGE(bufoff, (Ap) + (size_t)(h) * hstep + (kb), voffA); } } while (0)
#define PG8_LD16(off) (*(const LAS u32x4*)(lds + (off)))
#define PG8_LDA(dst, b, h) do { _Pragma("unroll") for (int m = 0; m < 4; ++m) { if constexpr (FP8) { dst##8[m] = __builtin_bit_cast(v8i32, __builtin_shufflevector(PG8_LD16(PG8_SA(b, h) + aoff + m * 2048), PG8_LD16(PG8_SA(b, h) + aoff + m * 2048 + 1024), 0, 1, 2, 3, 4, 5, 6, 7)); } \
        else { _Pragma("unroll") for (int k = 0; k < 2; ++k) dst[m][k] = *(const LAS bf16x8*)(lds + PG8_SA(b, h) + aoff + m * 2048 + k * 1024); } } } while (0)
#define PG8_LDB(dst, b, h) do { _Pragma("unroll") for (int n = 0; n < 2; ++n) { if constexpr (FP8) { dst##8[n] = __builtin_bit_cast(v8i32, __builtin_shufflevector(PG8_LD16(PG8_SB(b, h) + boff + n * 2048), PG8_LD16(PG8_SB(b, h) + boff + n * 2048 + 1024), 0, 1, 2, 3, 4, 5, 6, 7)); } \
        else { _Pragma("unroll") for (int k = 0; k < 2; ++k) dst[n][k] = *(const LAS bf16x8*)(lds + PG8_SB(b, h) + boff + n * 2048 + k * 1024); } } } while (0)
#define PG8_MMA(ai, bj, At, Bt) do { __builtin_amdgcn_s_setprio(1); _Pragma("unroll") for (int m = 0; m < 4; ++m) _Pragma("unroll") for (int n = 0; n < 2; ++n) { \
        if constexpr (FP8) { asm volatile("v_mfma_scale_f32_16x16x128_f8f6f4 %0, %1, %2, %0, %3, %3 op_sel_hi:[0,0,0]" : "+v"(acc[ai][bj][m][n]) : "v"(Bt##8[n]), "v"(At##8[m]), "v"(sc7f)); } \
        else { _Pragma("unroll") for (int k = 0; k < 2; ++k) acc[ai][bj][m][n] = __builtin_amdgcn_mfma_f32_16x16x32_bf16(Bt[n][k], At[m][k], acc[ai][bj][m][n], 0, 0, 0); } } \
        __builtin_amdgcn_s_setprio(0); } while (0)
#define PG8_WAIT_V(n) asm volatile("s_waitcnt vmcnt(" #n ")" ::: "memory")
#define PG8_WAIT_L(n) asm volatile("s_waitcnt lgkmcnt(" #n ")" ::: "memory")
#define PG8_BAR __builtin_amdgcn_s_barrier()
#define PG8_SCHED __builtin_amdgcn_sched_barrier(0)
    LAS unsigned char* tokt = lds + STAGE_BYTES;
#define PG8_TOKDMA(u, slot) do { if constexpr (GATHER) { if (wid < 4) { const unsigned _cn = (unsigned)g.cnt[(u).e]; const unsigned _s = (unsigned)((u).pl * BM + tid); \
        __builtin_amdgcn_global_load_lds((const unsigned*)(g.list + (size_t)(u).e * g.list_stride + (_s < _cn ? _s : _cn - 1u)), (LAS unsigned*)(tokt + (slot) * 1024 + wid * 256), 4, 0, 0); } } } while (0)
#define PG8_GOFFS(go, slot) do { if constexpr (GATHER) { \
        _Pragma("unroll") for (int _h = 0; _h < 2; ++_h) _Pragma("unroll") for (int _i = 0; _i < 2; ++_i) { int _R, _C; stage_rc(tid * 16 + _i * 8192, _R, _C); \
            const unsigned _t = *(const LAS unsigned*)(tokt + (slot) * 1024 + (_h * HALF + _R) * 4); (go)[_h][_i] = (_t * (unsigned)K + (unsigned)_C) * 2u; } } } while (0)
    Unit cur, nxt; int ui = 0;
    if (!S.next(0, cur)) return;
    f32x4 acc[2][2][4][2];
#pragma unroll
    for (int a = 0; a < 2; ++a)
#pragma unroll
        for (int b = 0; b < 2; ++b)
#pragma unroll
            for (int m = 0; m < 4; ++m)
#pragma unroll
                for (int n = 0; n < 2; ++n) acc[a][b][m][n] = (f32x4){0.f, 0.f, 0.f, 0.f};
    const unsigned sc7f = 0x7F7F7F7Fu;
    bf16x8 At[4][2], B0[2][2], B1[2][2]; v8i32 At8[4], B08[2], B18[2];
    unsigned gcur[2][2] = {{0u, 0u}, {0u, 0u}};
    const char* cA = (const char*)g.A + (size_t)cur.pm * tstep + (size_t)cur.kt0 * kstep; const char* cB = (const char*)g.Bt + ((size_t)cur.e * g.bstride) * 2 + (size_t)cur.pn * tstep + (size_t)cur.kt0 * kstep;
    if constexpr (GATHER) { PG8_TOKDMA(cur, 0); asm volatile("s_waitcnt vmcnt(0)" ::: "memory"); __builtin_amdgcn_s_barrier(); asm volatile("" ::: "memory"); }
    PG8_GOFFS(gcur, 0);
    PG8_STAGE(PG8_SB(0, 0), cB, voffB); PG8_STAGE(PG8_SB(0, 1), cB + hstep, voffB); PG8_STAGE_A(PG8_SA(0, 0), cA, gcur, 0, 0); PG8_STAGE_A(PG8_SA(0, 1), cA, gcur, 1, 0);
    if (wr == 1) PG8_BAR;
    PG8_WAIT_V(2); PG8_BAR;
    PG8_STAGE(PG8_SB(1, 0), cB + kstep, voffB); PG8_STAGE_A(PG8_SA(1, 0), cA, gcur, 0, kstep); PG8_STAGE(PG8_SB(1, 1), cB + hstep + kstep, voffB);
    PG8_WAIT_V(6); PG8_BAR;
    for (;;) {
        const bool has_next = S.next(ui + 1, nxt);
        if constexpr (GATHER) { if (has_next) PG8_TOKDMA(nxt, (ui + 1) & 1); }
        const char* nA = has_next ? (const char*)g.A + (size_t)nxt.pm * tstep + (size_t)nxt.kt0 * kstep : cA; const char* nB = has_next ? (const char*)g.Bt + ((size_t)nxt.e * g.bstride) * 2 + (size_t)nxt.pn * tstep + (size_t)nxt.kt0 * kstep : cB;
#pragma unroll 1
        for (int t = 0; t < nt; t += 2) {
            const bool last = (t == nt - 2);
            const size_t kb1 = (size_t)(t + 1) * kstep;
            const char* a2p = last ? nA : cA; const size_t kb2 = last ? (size_t)0 : (size_t)(t + 2) * kstep;
            const char* b2 = last ? nB : cB + (size_t)(t + 2) * kstep;
            const size_t kb3 = kb2 + kstep; const char* b3 = b2 + kstep;
            PG8_LDB(B0, 0, 0); PG8_LDB(B1, 0, 1); PG8_SCHED; PG8_LDA(At, 0, 0); PG8_STAGE_A(PG8_SA(1, 1), cA, gcur, 1, kb1);
            if constexpr (GATHER) { if (last && has_next) { PG8_GOFFS(gcur, (ui + 1) & 1); } }
            PG8_WAIT_V(8); PG8_WAIT_L(0); PG8_BAR; PG8_MMA(0, 0, At, B0); PG8_MMA(0, 1, At, B1); PG8_BAR; PG8_SCHED;
            PG8_LDA(At, 0, 1); PG8_STAGE(PG8_SB(0, 0), b2, voffB); PG8_STAGE(PG8_SB(0, 1), b2 + hstep, voffB); PG8_STAGE_A(PG8_SA(0, 0), a2p, gcur, 0, kb2);
            PG8_WAIT_V(8); PG8_WAIT_L(0); PG8_BAR; PG8_MMA(1, 0, At, B0); PG8_MMA(1, 1, At, B1); PG8_BAR; PG8_SCHED;
            PG8_LDB(B0, 1, 0); PG8_LDB(B1, 1, 1); PG8_SCHED; PG8_LDA(At, 1, 0); PG8_STAGE_A(PG8_SA(0, 1), a2p, gcur, 1, kb2);
            PG8_WAIT_V(8); PG8_WAIT_L(0); PG8_BAR; PG8_MMA(0, 0, At, B0); PG8_MMA(0, 1, At, B1); PG8_BAR; PG8_SCHED;
            PG8_LDA(At, 1, 1); PG8_STAGE(PG8_SB(1, 0), b3, voffB); PG8_STAGE(PG8_SB(1, 1), b3 + hstep, voffB); PG8_STAGE_A(PG8_SA(1, 0), a2p, gcur, 0, kb3);
            PG8_WAIT_V(8); PG8_WAIT_L(0); PG8_BAR; PG8_MMA(1, 0, At, B0); PG8_MMA(1, 1, At, B1); PG8_BAR; PG8_SCHED;
        }
        if (wr == 0) PG8_BAR;
        if constexpr (FP8) asm volatile("s_nop 15\n\ts_nop 15\n\ts_nop 15\n\ts_nop 15" ::: "memory");
        E(acc, cur, wr, wc, fr, fq);
        if (!has_next) break;
#pragma unroll
        for (int a = 0; a < 2; ++a)
#pragma unroll
            for (int b = 0; b < 2; ++b)
#pragma unroll
                for (int m = 0; m < 4; ++m)
#pragma unroll
                    for (int n = 0; n < 2; ++n) acc[a][b][m][n] = (f32x4){0.f, 0.f, 0.f, 0.f};
        cur = nxt; cA = nA; cB = nB; ++ui;
        if (wr == 1) PG8_BAR;
    }
    PG8_WAIT_V(0);
    PG8_BAR;
#undef PG8_SA
#undef PG8_SB
#undef PG8_STAGE
#undef PG8_STAGE_A
#undef PG8_LDA
#undef PG8_LDB
#undef PG8_MMA
#undef PG8_LD16
#undef PG8_WAIT_V
#undef PG8_WAIT_L
#undef PG8_BAR
#undef PG8_SCHED
#undef PG8_GOFFS
#undef PG8_TOKDMA
}
}
namespace att {
constexpr int NW = 8, QBLK = 32, KVBLK = 64;
constexpr float THR = 8.f;
#define ATT_SBAR() __builtin_amdgcn_sched_barrier(0)
template <int DK> __device__ __forceinline__ int kswz(int row, int colB) { return row * (DK * 2 + 16) + colB; }
__device__ __forceinline__ int crow(int r, int hi) { return (r & 3) + 8 * (r >> 2) + 4 * hi; }
__device__ __forceinline__ void partialSM(f32x16& p0, f32x16& p1, float& m_reg, float& mn, float& alpha, const float C, const float thr_raw) {
    float pmax = p0[0];
#pragma unroll
    for (int r = 1; r < 16; ++r) pmax = fmaxf(pmax, p0[r]);
#pragma unroll
    for (int r = 0; r < 16; ++r) pmax = fmaxf(pmax, p1[r]);
    { auto rr = __builtin_amdgcn_permlane32_swap(__float_as_uint(pmax), __float_as_uint(pmax), false, false);
      pmax = fmaxf(__uint_as_float(rr[0]), __uint_as_float(rr[1])); }
    if (__builtin_expect(__all(pmax - m_reg <= thr_raw), 1)) { mn = m_reg; alpha = 1.f; }
    else { mn = fmaxf(m_reg, pmax); alpha = __builtin_amdgcn_exp2f((m_reg - mn) * C); m_reg = mn; }
    const float mnC = -mn * C;
#pragma unroll
    for (int r = 0; r < 16; ++r) p0[r] = fmaf(p0[r], C, mnC);
#pragma unroll
    for (int r = 0; r < 16; ++r) p1[r] = fmaf(p1[r], C, mnC);
#pragma unroll
    for (int r = 0; r < 16; ++r) p0[r] = __builtin_amdgcn_exp2f(p0[r]);
}
__device__ __forceinline__ void finishSM(f32x16& p0, f32x16& p1, float alpha, float& l_reg, bf16x8& pa0, bf16x8& pa1, bf16x8& pa2, bf16x8& pa3) {
#pragma unroll
    for (int r = 0; r < 16; ++r) p1[r] = __builtin_amdgcn_exp2f(p1[r]);
#if MK_PROBE_ATT == 2
    { float dz = 0.f;
#pragma unroll
      for (int r = 0; r < 16; ++r) { dz += __builtin_amdgcn_exp2f(p0[r] - 1.0f); dz += __builtin_amdgcn_exp2f(p1[r] - 2.0f); }
      asm volatile("" :: "v"(dz)); }
#endif
    float ps = 0;
#pragma unroll
    for (int r = 0; r < 16; ++r) ps += p0[r];
#pragma unroll
    for (int r = 0; r < 16; ++r) ps += p1[r];
    { auto rr = __builtin_amdgcn_permlane32_swap(__float_as_uint(ps), __float_as_uint(ps), false, false);
      ps = __uint_as_float(rr[0]) + __uint_as_float(rr[1]); }
    l_reg = l_reg * alpha + ps;
#define ATT_PK4(P, BASE, OUT) do { unsigned a0 = cvt_pk_bf16(P[BASE + 0], P[BASE + 1]), a1 = cvt_pk_bf16(P[BASE + 2], P[BASE + 3]);   \
    unsigned b0 = cvt_pk_bf16(P[BASE + 4], P[BASE + 5]), b1 = cvt_pk_bf16(P[BASE + 6], P[BASE + 7]);                              \
    auto r0 = __builtin_amdgcn_permlane32_swap(a0, b0, false, false); auto r1 = __builtin_amdgcn_permlane32_swap(a1, b1, false, false); \
    u32x4 w = {r0[0], r1[0], r0[1], r1[1]}; OUT = *reinterpret_cast<bf16x8*>(&w); } while (0)
    ATT_PK4(p0, 0, pa0); ATT_PK4(p0, 8, pa1); ATT_PK4(p1, 0, pa2); ATT_PK4(p1, 8, pa3);
#undef ATT_PK4
}
#ifndef MK_PROBE_ATT
#define MK_PROBE_ATT 0
#endif
template <int DK> __device__ __forceinline__ void qkt(f32x16& p0, f32x16& p1, const char* Ks, const bf16x8* qr, int r32, int hi) {
    p0 = f32x16{}; p1 = f32x16{};
#if MK_PROBE_ATT == 1
    f32x16 d0_ = f32x16{}; d0_[0] = 1.0f;
#endif
#pragma unroll
    for (int d0 = 0; d0 < DK / 16; ++d0) { const int cb = (d0 * 16 + hi * 8) * 2;
        const bf16x8 b0 = *reinterpret_cast<const bf16x8*>(Ks + kswz<DK>(r32, cb));
        const bf16x8 b1 = *reinterpret_cast<const bf16x8*>(Ks + kswz<DK>(32 + r32, cb));
        p0 = __builtin_amdgcn_mfma_f32_32x32x16_bf16(b0, qr[d0], p0, 0, 0, 0);
        p1 = __builtin_amdgcn_mfma_f32_32x32x16_bf16(b1, qr[d0], p1, 0, 0, 0);
#if MK_PROBE_ATT == 1
        d0_ = __builtin_amdgcn_mfma_f32_32x32x16_bf16(b0, qr[d0], d0_, 0, 0, 0);
        d0_ = __builtin_amdgcn_mfma_f32_32x32x16_bf16(b1, qr[d0], d0_, 0, 0, 0);
#endif
    }
#if MK_PROBE_ATT == 1
    asm volatile("" :: "v"(d0_));
#endif
}
template <int DV> __device__ __forceinline__ int v_st_nat(int k, int c) { return ((k >> 3) * (DV / 32) + (c >> 5)) * 512 + ((k & 7) * 32 + (c & 31)) * 2; }
template <int DV> __device__ __forceinline__ int v_st(int k, int c) { const int kk = (k & ~0xC) | ((k & 4) << 1) | ((k & 8) >> 1); return ((kk >> 3) * (DV / 32) + (c >> 5)) * 512 + ((kk & 7) * 32 + (c & 31)) * 2; }
__device__ __forceinline__ int v_rd_base(int lane) { return ((lane & 3) << 3) | (((lane >> 2) & 3) << 6) | (((lane >> 4) & 1) << 5) | (((lane >> 5) & 1) << 8); }
template <int DV> constexpr int v_rd_off(int d0, int ks, int half) { return d0 * 512 + ks * (DV / 32) * 1024 + half * (DV / 32) * 512; }
template <int OFF> __device__ __forceinline__ s16x4 tr_read(int vb) {
    s16x4 r; asm volatile("ds_read_b64_tr_b16 %0, %1 offset:%2" : "=&v"(r) : "v"(vb), "i"(OFF) : "memory"); return r;
}
template <int DV, int D0> __device__ __forceinline__ void pv_one(f32x16& od, int vb, bf16x8 pa0, bf16x8 pa1, bf16x8 pa2, bf16x8 pa3) {
    const s16x4 l0 = tr_read<v_rd_off<DV>(D0, 0, 0)>(vb), h0 = tr_read<v_rd_off<DV>(D0, 0, 1)>(vb), l1 = tr_read<v_rd_off<DV>(D0, 1, 0)>(vb), h1 = tr_read<v_rd_off<DV>(D0, 1, 1)>(vb);
    const s16x4 l2 = tr_read<v_rd_off<DV>(D0, 2, 0)>(vb), h2 = tr_read<v_rd_off<DV>(D0, 2, 1)>(vb), l3 = tr_read<v_rd_off<DV>(D0, 3, 0)>(vb), h3 = tr_read<v_rd_off<DV>(D0, 3, 1)>(vb);
    asm volatile("s_waitcnt lgkmcnt(0)" ::: "memory"); ATT_SBAR();
#define ATT_PK(L, H) (bf16x8){L[0], L[1], L[2], L[3], H[0], H[1], H[2], H[3]}
    od = __builtin_amdgcn_mfma_f32_32x32x16_bf16(pa0, ATT_PK(l0, h0), od, 0, 0, 0);
    od = __builtin_amdgcn_mfma_f32_32x32x16_bf16(pa1, ATT_PK(l1, h1), od, 0, 0, 0);
    od = __builtin_amdgcn_mfma_f32_32x32x16_bf16(pa2, ATT_PK(l2, h2), od, 0, 0, 0);
    od = __builtin_amdgcn_mfma_f32_32x32x16_bf16(pa3, ATT_PK(l3, h3), od, 0, 0, 0);
#undef ATT_PK
}
template <int DV, int D0> __device__ __forceinline__ void pv_two(f32x16& oa, f32x16& ob, int vb, bf16x8 pa0, bf16x8 pa1, bf16x8 pa2, bf16x8 pa3) {
    const s16x4 l0 = tr_read<v_rd_off<DV>(D0, 0, 0)>(vb), h0 = tr_read<v_rd_off<DV>(D0, 0, 1)>(vb), l1 = tr_read<v_rd_off<DV>(D0, 1, 0)>(vb), h1 = tr_read<v_rd_off<DV>(D0, 1, 1)>(vb);
    const s16x4 l2 = tr_read<v_rd_off<DV>(D0, 2, 0)>(vb), h2 = tr_read<v_rd_off<DV>(D0, 2, 1)>(vb), l3 = tr_read<v_rd_off<DV>(D0, 3, 0)>(vb), h3 = tr_read<v_rd_off<DV>(D0, 3, 1)>(vb);
    const s16x4 m0 = tr_read<v_rd_off<DV>(D0 + 1, 0, 0)>(vb), n0 = tr_read<v_rd_off<DV>(D0 + 1, 0, 1)>(vb), m1 = tr_read<v_rd_off<DV>(D0 + 1, 1, 0)>(vb), n1 = tr_read<v_rd_off<DV>(D0 + 1, 1, 1)>(vb);
    const s16x4 m2 = tr_read<v_rd_off<DV>(D0 + 1, 2, 0)>(vb), n2 = tr_read<v_rd_off<DV>(D0 + 1, 2, 1)>(vb), m3 = tr_read<v_rd_off<DV>(D0 + 1, 3, 0)>(vb), n3 = tr_read<v_rd_off<DV>(D0 + 1, 3, 1)>(vb);
    asm volatile("s_waitcnt lgkmcnt(0)" ::: "memory"); ATT_SBAR();
#define ATT_PK(L, H) (bf16x8){L[0], L[1], L[2], L[3], H[0], H[1], H[2], H[3]}
    oa = __builtin_amdgcn_mfma_f32_32x32x16_bf16(pa0, ATT_PK(l0, h0), oa, 0, 0, 0);
    ob = __builtin_amdgcn_mfma_f32_32x32x16_bf16(pa0, ATT_PK(m0, n0), ob, 0, 0, 0);
    oa = __builtin_amdgcn_mfma_f32_32x32x16_bf16(pa1, ATT_PK(l1, h1), oa, 0, 0, 0);
    ob = __builtin_amdgcn_mfma_f32_32x32x16_bf16(pa1, ATT_PK(m1, n1), ob, 0, 0, 0);
    oa = __builtin_amdgcn_mfma_f32_32x32x16_bf16(pa2, ATT_PK(l2, h2), oa, 0, 0, 0);
    ob = __builtin_amdgcn_mfma_f32_32x32x16_bf16(pa2, ATT_PK(m2, n2), ob, 0, 0, 0);
    oa = __builtin_amdgcn_mfma_f32_32x32x16_bf16(pa3, ATT_PK(l3, h3), oa, 0, 0, 0);
    ob = __builtin_amdgcn_mfma_f32_32x32x16_bf16(pa3, ATT_PK(m3, n3), ob, 0, 0, 0);
#undef ATT_PK
}
struct VFrag64 { s16x4 l[2][4], h[2][4]; };
template <int DV> __device__ __forceinline__ void pv_issue(VFrag64& f, int vb) {
    f.l[0][0] = tr_read<v_rd_off<DV>(0, 0, 0)>(vb); f.h[0][0] = tr_read<v_rd_off<DV>(0, 0, 1)>(vb); f.l[0][1] = tr_read<v_rd_off<DV>(0, 1, 0)>(vb); f.h[0][1] = tr_read<v_rd_off<DV>(0, 1, 1)>(vb);
    f.l[0][2] = tr_read<v_rd_off<DV>(0, 2, 0)>(vb); f.h[0][2] = tr_read<v_rd_off<DV>(0, 2, 1)>(vb); f.l[0][3] = tr_read<v_rd_off<DV>(0, 3, 0)>(vb); f.h[0][3] = tr_read<v_rd_off<DV>(0, 3, 1)>(vb);
    f.l[1][0] = tr_read<v_rd_off<DV>(1, 0, 0)>(vb); f.h[1][0] = tr_read<v_rd_off<DV>(1, 0, 1)>(vb); f.l[1][1] = tr_read<v_rd_off<DV>(1, 1, 0)>(vb); f.h[1][1] = tr_read<v_rd_off<DV>(1, 1, 1)>(vb);
    f.l[1][2] = tr_read<v_rd_off<DV>(1, 2, 0)>(vb); f.h[1][2] = tr_read<v_rd_off<DV>(1, 2, 1)>(vb); f.l[1][3] = tr_read<v_rd_off<DV>(1, 3, 0)>(vb); f.h[1][3] = tr_read<v_rd_off<DV>(1, 3, 1)>(vb);
}
__device__ __forceinline__ void pv_mma64(f32x16* o, const VFrag64& f, bf16x8 pa0, bf16x8 pa1, bf16x8 pa2, bf16x8 pa3) {
    asm volatile("s_waitcnt lgkmcnt(0)" ::: "memory"); ATT_SBAR();
#define ATT_PK(L, H) (bf16x8){L[0], L[1], L[2], L[3], H[0], H[1], H[2], H[3]}
    o[0] = __builtin_amdgcn_mfma_f32_32x32x16_bf16(pa0, ATT_PK(f.l[0][0], f.h[0][0]), o[0], 0, 0, 0);
    o[1] = __builtin_amdgcn_mfma_f32_32x32x16_bf16(pa0, ATT_PK(f.l[1][0], f.h[1][0]), o[1], 0, 0, 0);
    o[0] = __builtin_amdgcn_mfma_f32_32x32x16_bf16(pa1, ATT_PK(f.l[0][1], f.h[0][1]), o[0], 0, 0, 0);
    o[1] = __builtin_amdgcn_mfma_f32_32x32x16_bf16(pa1, ATT_PK(f.l[1][1], f.h[1][1]), o[1], 0, 0, 0);
    o[0] = __builtin_amdgcn_mfma_f32_32x32x16_bf16(pa2, ATT_PK(f.l[0][2], f.h[0][2]), o[0], 0, 0, 0);
    o[1] = __builtin_amdgcn_mfma_f32_32x32x16_bf16(pa2, ATT_PK(f.l[1][2], f.h[1][2]), o[1], 0, 0, 0);
    o[0] = __builtin_amdgcn_mfma_f32_32x32x16_bf16(pa3, ATT_PK(f.l[0][3], f.h[0][3]), o[0], 0, 0, 0);
    o[1] = __builtin_amdgcn_mfma_f32_32x32x16_bf16(pa3, ATT_PK(f.l[1][3], f.h[1][3]), o[1], 0, 0, 0);
#undef ATT_PK
}
#ifndef MK_PV2
#define MK_PV2 1
#endif
#ifndef MK_VPRE
#define MK_VPRE 0
#endif
#ifndef MK_MBLK
#define MK_MBLK 1
#endif
#ifndef MK_ATT_PRIO
#define MK_ATT_PRIO 1
#endif
template <int DV> __device__ __forceinline__ void pv_d0(f32x16* o, int vb, bf16x8 pa0, bf16x8 pa1, bf16x8 pa2, bf16x8 pa3) {
#if MK_PV2
    pv_two<DV, 0>(o[0], o[1], vb, pa0, pa1, pa2, pa3);
    if constexpr (DV == 128) pv_two<DV, 2>(o[2], o[3], vb, pa0, pa1, pa2, pa3);
#else
    pv_one<DV, 0>(o[0], vb, pa0, pa1, pa2, pa3); pv_one<DV, 1>(o[1], vb, pa0, pa1, pa2, pa3);
    if constexpr (DV == 128) { pv_one<DV, 2>(o[2], vb, pa0, pa1, pa2, pa3); pv_one<DV, 3>(o[3], vb, pa0, pa1, pa2, pa3); }
#endif
}
template <int DK, int DV> constexpr int lds_bytes() { return 3 * KVBLK * DV * 2 + 3 * KVBLK * (DK * 2 + 16) + NW * 64 * 4; }

template <int DK, int DV, int ldq, int ldk, int ldv, int ldo, int SD, int EPI = 0>
__device__ __forceinline__ void attn_unit(const bf16_t* __restrict__ Qb, const bf16_t* __restrict__ Kh, const bf16_t* __restrict__ Vh,
                                          bf16_t* __restrict__ Ob, int seq, const float C, const float thr_raw, char* lds, const int wid, LAS unsigned* stash = nullptr, float lam = 0.f, const float* gvec = nullptr) {
    constexpr int SHM_V = KVBLK * DV * 2, SHM_K = KVBLK * (DK * 2 + 16);
    constexpr int NO = DV / 32, ND = DK / 16;
    const int lane = fresh_lane(), tid = wid * 64 + lane, r32 = lane & 31, hi = lane >> 5;
    char* V_lds = lds; char* K_lds = lds + 3 * SHM_V;
    float* wsf = (float*)(lds + 3 * SHM_V + 3 * SHM_K) + wid * 64; float* li_l = wsf; float* al_l = wsf + 32;
    float m_reg = -1e30f, l_reg = 0; f32x16 o[NO]; bf16x8 qr[ND];
#pragma unroll
    for (int d = 0; d < NO; ++d) o[d] = f32x16{};
    const bf16_t* Qw = Qb + (long)(wid * QBLK + r32) * ldq + hi * 8;
#pragma unroll
    for (int d0 = 0; d0 < ND; ++d0) qr[d0] = *reinterpret_cast<const bf16x8*>(Qw + d0 * 16);
    const int sr = tid >> 4, sc = (tid & 15) * 8; const bool kact = (DK == 128) ? true : (sc < DK), vact = (DV == 128) ? true : (sc < DV);
    const int vst0 = v_st<DV>(sr, vact ? sc : 0), vst1 = v_st<DV>(32 + sr, vact ? sc : 0);
    const int vb0 = (int)(uintptr_t)V_lds + v_rd_base(lane);
    const unsigned koff = (unsigned)(sr * ldk + sc) * 2u, voff = (unsigned)(sr * ldv + sc) * 2u;
    const size_t k32 = (size_t)32 * ldk * 2, v32 = (size_t)32 * ldv * 2;
    struct { bf16x8 vs0, vs1, ks0, ks1; } sr_[SD];
#define ATT_SLOAD(s, k0) do { const char* _kt = (const char*)Kh + (size_t)(k0) * ldk * 2; const char* _vt = (const char*)Vh + (size_t)(k0) * ldv * 2; \
    if (vact) { sr_[s].vs0 = *reinterpret_cast<const bf16x8*>(_vt + voff); sr_[s].vs1 = *reinterpret_cast<const bf16x8*>(_vt + v32 + voff); } \
    if (kact) { sr_[s].ks0 = *reinterpret_cast<const bf16x8*>(_kt + koff); sr_[s].ks1 = *reinterpret_cast<const bf16x8*>(_kt + k32 + koff); } } while (0)
#define ATT_SWRITE(b, s) do { if (vact) { *(bf16x8*)(V_lds + (b) * SHM_V + vst0) = sr_[s].vs0; *(bf16x8*)(V_lds + (b) * SHM_V + vst1) = sr_[s].vs1; } \
    if (kact) { const int kc = sc * 2; *(bf16x8*)(K_lds + (b) * SHM_K + kswz<DK>(sr, kc)) = sr_[s].ks0; *(bf16x8*)(K_lds + (b) * SHM_K + kswz<DK>(32 + sr, kc)) = sr_[s].ks1; } } while (0)
#define ATT_RESC(a) do { if (__any((a) < 1.f)) { if (hi == 0) al_l[r32] = (a); asm volatile("s_waitcnt lgkmcnt(0)" ::: "memory"); \
    _Pragma("unroll") for (int d = 0; d < NO; ++d) _Pragma("unroll") for (int r = 0; r < 16; ++r) o[d][r] *= al_l[crow(r, hi)]; } } while (0)
    f32x16 pA0, pA1, pB0, pB1; float mnA, mnB, alA, alB; bf16x8 pa0, pa1, pa2, pa3; const int NT = seq / KVBLK;
    constexpr int SE = 0, SO = SD - 1;
    constexpr bool VPRE = (DV == 64) && (MK_VPRE != 0); VFrag64 vf;
    __syncthreads();
    ATT_SLOAD(SE, 0); asm volatile("s_waitcnt vmcnt(0)" ::: "memory"); ATT_SWRITE(0, SE); __syncthreads();
    qkt<DK>(pA0, pA1, K_lds, qr, r32, hi); partialSM(pA0, pA1, m_reg, mnA, alA, C, thr_raw);
    ATT_SLOAD(SO, KVBLK); if constexpr (SD == 2) { if (2 < NT) ATT_SLOAD(SE, 2 * KVBLK); }
    ATT_SWRITE(1, SO); __syncthreads();
    int bj = 1;
    for (int j = 1; j + 1 < NT; j += 2) {
        const int bn = (bj == 2) ? 0 : bj + 1, bp = (bj == 0) ? 2 : bj - 1;
        ATT_SBAR(); if constexpr (VPRE) pv_issue<DV>(vf, vb0 + bp * SHM_V);
        qkt<DK>(pB0, pB1, K_lds + bj * SHM_K, qr, r32, hi);
        finishSM(pA0, pA1, alA, l_reg, pa0, pa1, pa2, pa3); ATT_SBAR();
        ATT_SLOAD(SO, (j + SD) * KVBLK); ATT_SBAR();
        if constexpr (VPRE) pv_mma64(o, vf, pa0, pa1, pa2, pa3); else pv_d0<DV>(o, vb0 + bp * SHM_V, pa0, pa1, pa2, pa3);
        partialSM(pB0, pB1, m_reg, mnB, alB, C, thr_raw);
        ATT_SWRITE(bn, SE);
        ATT_RESC(alB); __syncthreads();
        ATT_SBAR(); if constexpr (VPRE) pv_issue<DV>(vf, vb0 + bj * SHM_V);
        qkt<DK>(pA0, pA1, K_lds + bn * SHM_K, qr, r32, hi);
        finishSM(pB0, pB1, alB, l_reg, pa0, pa1, pa2, pa3); ATT_SBAR();
        if (SD == 1 || j + 3 < NT) ATT_SLOAD(SE, (j + 1 + SD) * KVBLK); ATT_SBAR();
        if constexpr (VPRE) pv_mma64(o, vf, pa0, pa1, pa2, pa3); else pv_d0<DV>(o, vb0 + bj * SHM_V, pa0, pa1, pa2, pa3);
        partialSM(pA0, pA1, m_reg, mnA, alA, C, thr_raw);
        ATT_SWRITE(bp, SO);
        ATT_RESC(alA); __syncthreads();
        bj = bp;
    }
    { const int bp = (bj == 0) ? 2 : bj - 1;
      ATT_SBAR(); qkt<DK>(pB0, pB1, K_lds + bj * SHM_K, qr, r32, hi);
      finishSM(pA0, pA1, alA, l_reg, pa0, pa1, pa2, pa3); ATT_SBAR();
      pv_d0<DV>(o, vb0 + bp * SHM_V, pa0, pa1, pa2, pa3); partialSM(pB0, pB1, m_reg, mnB, alB, C, thr_raw);
      ATT_RESC(alB);
      finishSM(pB0, pB1, alB, l_reg, pa0, pa1, pa2, pa3); ATT_SBAR();
      pv_d0<DV>(o, vb0 + bj * SHM_V, pa0, pa1, pa2, pa3); }
    if (hi == 0) li_l[r32] = l_reg; asm volatile("s_waitcnt lgkmcnt(0)" ::: "memory");
    float rli[16];
#pragma unroll
    for (int r = 0; r < 16; ++r) rli[r] = __builtin_amdgcn_rcpf(li_l[crow(r, hi)]);
    if constexpr (EPI == 1) {
#pragma unroll
        for (int r = 0; r < 16; ++r)
#pragma unroll
            for (int p = 0; p < NO / 2; ++p) stash[(r * (NO / 2) + p) * 64 + lane] = pk2(o[2 * p][r] * rli[r], o[2 * p + 1][r] * rli[r]);
    } else if constexpr (EPI == 2) {
        static_assert(EPI != 2 || DV == 128, "differential combine: DV = 128");
        float gl[NO];
#pragma unroll
        for (int d0 = 0; d0 < NO; ++d0) gl[d0] = gvec[d0 * 32 + r32];
        bf16_t* Ow = Ob + (long)(wid * QBLK) * ldo;
#pragma unroll
        for (int r = 0; r < 16; ++r) { float v[NO]; float ss = 0.f;
#pragma unroll
            for (int p = 0; p < NO / 2; ++p) { const unsigned w = stash[(r * (NO / 2) + p) * 64 + lane];
                v[2 * p] = o[2 * p][r] * rli[r] - lam * bf2f(w & 0xffffu); v[2 * p + 1] = o[2 * p + 1][r] * rli[r] - lam * bf2f(w >> 16); ss += v[2 * p] * v[2 * p] + v[2 * p + 1] * v[2 * p + 1]; }
#pragma unroll
            for (int x = 1; x < 32; x <<= 1) ss += __shfl_xor(ss, x);
            const float rstd = rsqrtf(ss * (1.0f / 128.0f) + 1e-6f); const int orow = crow(r, hi);
#pragma unroll
            for (int d0 = 0; d0 < NO; ++d0) Ow[(long)orow * ldo + d0 * 32 + r32] = (bf16_t)f2bf(v[d0] * rstd * gl[d0]); }
    } else {
    bf16_t* Ow = Ob + (long)(wid * QBLK) * ldo;
#pragma unroll
    for (int r = 0; r < 16; ++r) { const int orow = crow(r, hi);
#pragma unroll
        for (int d0 = 0; d0 < NO; ++d0) Ow[(long)orow * ldo + d0 * 32 + r32] = (bf16_t)f2bf(o[d0][r] * rli[r]); }
    }
#undef ATT_SLOAD
#undef ATT_SWRITE
#undef ATT_RESC
}

constexpr float THRL = THR * 1.4426950408889634f;
__device__ __forceinline__ float max3f(float a, float b, float c) { return __builtin_fmaxf(__builtin_fmaxf(a, b), c); }
__device__ __forceinline__ void softmax_rel(f32x16& p0, f32x16& p1, float& m_run, float& alpha, const bool first, f32x16* minit = nullptr) {
    float pm = max3f(p0[0], p0[1], p0[2]);
#pragma unroll
    for (int r = 3; r < 15; r += 2) pm = max3f(pm, p0[r], p0[r + 1]);
    pm = max3f(pm, p0[15], p1[0]);
#pragma unroll
    for (int r = 1; r < 15; r += 2) pm = max3f(pm, p1[r], p1[r + 1]);
    pm = __builtin_fmaxf(pm, p1[15]);
    { auto rr = __builtin_amdgcn_permlane32_swap(__float_as_uint(pm), __float_as_uint(pm), false, false); pm = __builtin_fmaxf(__uint_as_float(rr[0]), __uint_as_float(rr[1])); }
    if (!first && __builtin_expect(__all(pm <= THRL), 1)) alpha = 1.f;
    else { const float d = first ? pm : __builtin_fmaxf(pm, 0.f); alpha = first ? 1.f : __builtin_amdgcn_exp2f(-d); m_run += d;
        if (minit) {
#pragma unroll
            for (int r = 0; r < 16; ++r) (*minit)[r] = -m_run; }
#pragma unroll
        for (int r = 0; r < 16; ++r) { p0[r] -= d; p1[r] -= d; } }
#pragma unroll
    for (int r = 0; r < 16; ++r) { p0[r] = __builtin_amdgcn_exp2f(p0[r]); p1[r] = __builtin_amdgcn_exp2f(p1[r]); }
}
template <int DK> __device__ __forceinline__ void qkt_init(f32x16& p0, f32x16& p1, const char* Ks, const bf16x8* qr, int r32, int hi, float init) {
#pragma unroll
    for (int r = 0; r < 16; ++r) { p0[r] = init; p1[r] = init; }
#pragma unroll
    for (int d0 = 0; d0 < DK / 16; ++d0) { const int cb = (d0 * 16 + hi * 8) * 2;
        const bf16x8 b0 = *reinterpret_cast<const bf16x8*>(Ks + kswz<DK>(r32, cb));
        const bf16x8 b1 = *reinterpret_cast<const bf16x8*>(Ks + kswz<DK>(32 + r32, cb));
        p0 = __builtin_amdgcn_mfma_f32_32x32x16_bf16(b0, qr[d0], p0, 0, 0, 0);
        p1 = __builtin_amdgcn_mfma_f32_32x32x16_bf16(b1, qr[d0], p1, 0, 0, 0); }
}
__device__ __forceinline__ void finish_rel(f32x16& p0, f32x16& p1, float alpha, float& l_reg, bf16x8& pa0, bf16x8& pa1, bf16x8& pa2, bf16x8& pa3) {
    float ps = 0;
#pragma unroll
    for (int r = 0; r < 16; ++r) ps += p0[r];
#pragma unroll
    for (int r = 0; r < 16; ++r) ps += p1[r];
    { auto rr = __builtin_amdgcn_permlane32_swap(__float_as_uint(ps), __float_as_uint(ps), false, false); ps = __uint_as_float(rr[0]) + __uint_as_float(rr[1]); }
    l_reg = l_reg * alpha + ps;
#define ATT_PK4(P, BASE, OUT) do { u32x4 w = {cvt_pk_bf16(P[BASE + 0], P[BASE + 1]), cvt_pk_bf16(P[BASE + 2], P[BASE + 3]), cvt_pk_bf16(P[BASE + 4], P[BASE + 5]), cvt_pk_bf16(P[BASE + 6], P[BASE + 7])}; \
    OUT = *reinterpret_cast<bf16x8*>(&w); } while (0)
    ATT_PK4(p0, 0, pa0); ATT_PK4(p0, 8, pa1); ATT_PK4(p1, 0, pa2); ATT_PK4(p1, 8, pa3);
#undef ATT_PK4
}

template <int OFF> __device__ __forceinline__ bf16x8 k_read(int ka) { bf16x8 r; asm volatile("ds_read_b128 %0, %1 offset:%2" : "=&v"(r) : "v"(ka), "i"(OFF) : "memory"); return r; }
#define ATT_WAITL(n) asm volatile("s_waitcnt lgkmcnt(%0)" :: "n"(n) : "memory")
#define ATT_PKV(L, H) (bf16x8){L[0], L[1], L[2], L[3], H[0], H[1], H[2], H[3]}
template <int DK, int DV, int KBD, bool FINM = false, bool MINIT = false>
__device__ __forceinline__ void mblock(f32x16* o, f32x16& p0, f32x16& p1, const bool pv, const int vb, const int ka, const bf16x8* qr, bf16x8 pa0, bf16x8 pa1, bf16x8 pa2, bf16x8 pa3, const float init, const float al = 1.f, float* l_reg = nullptr, const f32x16* minit = nullptr) {
    constexpr int ND = DK / 16, NB = ND / KBD, PITCH = DK * 2 + 16, KR = 2 * KBD;
    static_assert(ND % KBD == 0 && NB >= 2 && NB <= 4 && (KBD == 2 || KBD == 3), "K batches");
    bf16x8 ka0[2][KBD], ka1[2][KBD];
    s16x4 l[4], h[4], m[4], n[4];
#define ATT_KISSUE(b) do { ka0[(b) & 1][0] = k_read<((b) * KBD + 0) * 32>(ka); ka1[(b) & 1][0] = k_read<((b) * KBD + 0) * 32 + 32 * PITCH>(ka); \
        ka0[(b) & 1][1] = k_read<((b) * KBD + 1) * 32>(ka); ka1[(b) & 1][1] = k_read<((b) * KBD + 1) * 32 + 32 * PITCH>(ka); \
        if constexpr (KBD > 2) { ka0[(b) & 1][KBD - 1] = k_read<((b) * KBD + KBD - 1) * 32>(ka); ka1[(b) & 1][KBD - 1] = k_read<((b) * KBD + KBD - 1) * 32 + 32 * PITCH>(ka); } } while (0)
#define ATT_TRISSUE(D0) do { l[0] = tr_read<v_rd_off<DV>(D0, 0, 0)>(vb); h[0] = tr_read<v_rd_off<DV>(D0, 0, 1)>(vb); l[1] = tr_read<v_rd_off<DV>(D0, 1, 0)>(vb); h[1] = tr_read<v_rd_off<DV>(D0, 1, 1)>(vb); \
        l[2] = tr_read<v_rd_off<DV>(D0, 2, 0)>(vb); h[2] = tr_read<v_rd_off<DV>(D0, 2, 1)>(vb); l[3] = tr_read<v_rd_off<DV>(D0, 3, 0)>(vb); h[3] = tr_read<v_rd_off<DV>(D0, 3, 1)>(vb); \
        m[0] = tr_read<v_rd_off<DV>(D0 + 1, 0, 0)>(vb); n[0] = tr_read<v_rd_off<DV>(D0 + 1, 0, 1)>(vb); m[1] = tr_read<v_rd_off<DV>(D0 + 1, 1, 0)>(vb); n[1] = tr_read<v_rd_off<DV>(D0 + 1, 1, 1)>(vb); \
        m[2] = tr_read<v_rd_off<DV>(D0 + 1, 2, 0)>(vb); n[2] = tr_read<v_rd_off<DV>(D0 + 1, 2, 1)>(vb); m[3] = tr_read<v_rd_off<DV>(D0 + 1, 3, 0)>(vb); n[3] = tr_read<v_rd_off<DV>(D0 + 1, 3, 1)>(vb); } while (0)
#define ATT_PVMMA(OA, OB) do { OA = __builtin_amdgcn_mfma_f32_32x32x16_bf16(pa0, ATT_PKV(l[0], h[0]), OA, 0, 0, 0); OB = __builtin_amdgcn_mfma_f32_32x32x16_bf16(pa0, ATT_PKV(m[0], n[0]), OB, 0, 0, 0); \
        OA = __builtin_amdgcn_mfma_f32_32x32x16_bf16(pa1, ATT_PKV(l[1], h[1]), OA, 0, 0, 0); OB = __builtin_amdgcn_mfma_f32_32x32x16_bf16(pa1, ATT_PKV(m[1], n[1]), OB, 0, 0, 0); \
        OA = __builtin_amdgcn_mfma_f32_32x32x16_bf16(pa2, ATT_PKV(l[2], h[2]), OA, 0, 0, 0); OB = __builtin_amdgcn_mfma_f32_32x32x16_bf16(pa2, ATT_PKV(m[2], n[2]), OB, 0, 0, 0); \
        OA = __builtin_amdgcn_mfma_f32_32x32x16_bf16(pa3, ATT_PKV(l[3], h[3]), OA, 0, 0, 0); OB = __builtin_amdgcn_mfma_f32_32x32x16_bf16(pa3, ATT_PKV(m[3], n[3]), OB, 0, 0, 0); } while (0)
#define ATT_QKMMA(b) do { _Pragma("unroll") for (int q = 0; q < KBD; ++q) { if ((b) == 0 && q == 0) { \
            p1 = __builtin_amdgcn_mfma_f32_32x32x16_bf16(ka1[0][0], qr[0], ini, 0, 0, 0); p0 = __builtin_amdgcn_mfma_f32_32x32x16_bf16(ka0[0][0], qr[0], ini, 0, 0, 0); } else { \
        p0 = __builtin_amdgcn_mfma_f32_32x32x16_bf16(ka0[(b) & 1][q], qr[(b) * KBD + q], p0, 0, 0, 0); \
        p1 = __builtin_amdgcn_mfma_f32_32x32x16_bf16(ka1[(b) & 1][q], qr[(b) * KBD + q], p1, 0, 0, 0); } } } while (0)
#if MK_ATT_PRIO == 1
    __builtin_amdgcn_s_setprio(1);
#endif
    constexpr bool K2 = true;
    if (pv) {
        ATT_TRISSUE(0); ATT_KISSUE(0); if constexpr (K2) ATT_KISSUE(1);
        if constexpr (FINM) { ATT_SBAR(); finish_rel(p0, p1, al, *l_reg, pa0, pa1, pa2, pa3); ATT_SBAR(); }
        ATT_WAITL(K2 ? 2 * KR : KR); ATT_SBAR();
        ATT_PVMMA(o[0], o[1]); ATT_SBAR();
        if constexpr (DV == 128) { ATT_TRISSUE(2); ATT_WAITL(0); ATT_SBAR(); ATT_PVMMA(o[2], o[3]); ATT_SBAR(); }
    } else { ATT_KISSUE(0); if constexpr (K2) ATT_KISSUE(1); }
    if constexpr (!K2) ATT_KISSUE(1);
    f32x16 ini;
    if constexpr (MINIT) ini = *minit; else {
#pragma unroll
        for (int r = 0; r < 16; ++r) ini[r] = init; }
    ATT_WAITL(KR); ATT_SBAR(); ATT_QKMMA(0); ATT_SBAR();
    if constexpr (NB > 2) { ATT_KISSUE(2); ATT_WAITL(KR); } else ATT_WAITL(0);
    ATT_SBAR(); ATT_QKMMA(1); ATT_SBAR();
    if constexpr (NB > 2) { if constexpr (NB > 3) { ATT_KISSUE(3); ATT_WAITL(KR); } else ATT_WAITL(0);
        ATT_SBAR(); ATT_QKMMA(2); ATT_SBAR();
        if constexpr (NB > 3) { ATT_WAITL(0); ATT_SBAR(); ATT_QKMMA(3); ATT_SBAR(); } }
#if MK_ATT_PRIO == 1
    __builtin_amdgcn_s_setprio(0);
#endif
    if (MK_PROBE_ATT == 4) { f32x16 dz = f32x16{};
#pragma unroll
        for (int q = 0; q < ND; ++q) { dz = __builtin_amdgcn_mfma_f32_32x32x16_bf16(qr[q], qr[(q + 1) % ND], dz, 0, 0, 0); dz = __builtin_amdgcn_mfma_f32_32x32x16_bf16(qr[(q + 1) % ND], qr[q], dz, 0, 0, 0); }
        asm volatile("" :: "v"(dz)); }
    if (MK_PROBE_ATT == 5) { ATT_KISSUE(0); ATT_KISSUE(1); if constexpr (NB > 2) { ATT_WAITL(0); ATT_KISSUE(2); if constexpr (NB > 3) ATT_KISSUE(3); } ATT_WAITL(0);
        asm volatile("" :: "v"(ka0[0][0]), "v"(ka1[0][0]), "v"(ka0[1][0]), "v"(ka1[1][0])); }
#undef ATT_KISSUE
#undef ATT_TRISSUE
#undef ATT_PVMMA
#undef ATT_QKMMA
}

template <int DK, int DV, int ldq, int ldk, int ldv, int ldo, bool PRE, bool DEEP, bool PART = false>
__device__ __forceinline__ void attn_unit_stag(const bf16_t* __restrict__ Qb, const bf16_t* __restrict__ Kh, const bf16_t* __restrict__ Vh,
                                               bf16_t* __restrict__ Ob, int seq, const float C, const float thr_raw, char* lds, const int wid, float* po = nullptr, float* pml = nullptr) {
    constexpr int SHM_V = KVBLK * DV * 2, SHM_K = KVBLK * (DK * 2 + 16), R = 4;
    constexpr int NO = DV / 32, ND = DK / 16;
    const int lane = fresh_lane(), tid = wid * 64 + lane, r32 = lane & 31, hi = lane >> 5, half = wid >> 2;
    char* V_lds = lds; char* K_lds = lds + R * SHM_V;
    float* wsf = (float*)(lds + R * SHM_V + R * SHM_K) + wid * 64; float* li_l = wsf; float* al_l = wsf + 32;
    float m_reg = 0.f, l_reg = 0; f32x16 o[NO]; bf16x8 qr[ND];
#pragma unroll
    for (int d = 0; d < NO; ++d) o[d] = f32x16{};
    const bf16_t* Qw = Qb + (long)(wid * QBLK + r32) * ldq + hi * 8;
#pragma unroll
    for (int d0 = 0; d0 < ND; ++d0) qr[d0] = *reinterpret_cast<const bf16x8*>(Qw + d0 * 16);
    if constexpr (!PRE) {
#pragma unroll
        for (int d0 = 0; d0 < ND; ++d0) { const u32x4 w = *reinterpret_cast<const u32x4*>(&qr[d0]); u32x4 x;
            x.x = cvt_pk_bf16(bf2f(w.x & 0xffffu) * C, bf2f(w.x >> 16) * C); x.y = cvt_pk_bf16(bf2f(w.y & 0xffffu) * C, bf2f(w.y >> 16) * C);
            x.z = cvt_pk_bf16(bf2f(w.z & 0xffffu) * C, bf2f(w.z >> 16) * C); x.w = cvt_pk_bf16(bf2f(w.w & 0xffffu) * C, bf2f(w.w >> 16) * C);
            qr[d0] = *reinterpret_cast<const bf16x8*>(&x); } }
    const int sr = tid >> 4, sc = (tid & 15) * 8; const bool kact = (DK == 128) ? true : (sc < DK), vact = (DV == 128) ? true : (sc < DV);
    const int vst0 = v_st_nat<DV>(sr, vact ? sc : 0), vst1 = v_st_nat<DV>(32 + sr, vact ? sc : 0);
    const int vb0 = (int)(uintptr_t)V_lds + v_rd_base(lane);
    const int ka0 = (int)(uintptr_t)K_lds + kswz<DK>(r32, hi * 16);
    const unsigned koff = (unsigned)(sr * ldk + sc) * 2u, voff = (unsigned)(sr * ldv + sc) * 2u;
    const unsigned koff2 = koff + 32u * ldk * 2u, voff2 = voff + 32u * ldv * 2u;
    bf16x8 vsA0, vsA1, ksA0, ksA1, vsB0, vsB1, ksB0, ksB1;
#define STG_SLOAD(S, k0) do { const char* _kt = (const char*)Kh + (size_t)(k0) * ldk * 2; const char* _vt = (const char*)Vh + (size_t)(k0) * ldv * 2;        \
    if (vact) { vs##S##0 = *reinterpret_cast<const bf16x8*>(_vt + (size_t)voff); vs##S##1 = *reinterpret_cast<const bf16x8*>(_vt + (size_t)voff2); } \
    if (kact) { ks##S##0 = *reinterpret_cast<const bf16x8*>(_kt + (size_t)koff); ks##S##1 = *reinterpret_cast<const bf16x8*>(_kt + (size_t)koff2); } } while (0)
#define STG_SWRITE(S, b) do { if (vact) { *(bf16x8*)(V_lds + (b) * SHM_V + vst0) = vs##S##0; *(bf16x8*)(V_lds + (b) * SHM_V + vst1) = vs##S##1; } \
    if (kact) { const int kc = sc * 2; *(bf16x8*)(K_lds + (b) * SHM_K + kswz<DK>(sr, kc)) = ks##S##0; *(bf16x8*)(K_lds + (b) * SHM_K + kswz<DK>(32 + sr, kc)) = ks##S##1; } } while (0)
#define STG_BAR() do { ATT_SBAR(); asm volatile("s_waitcnt lgkmcnt(0)" ::: "memory"); __builtin_amdgcn_s_barrier(); asm volatile("" ::: "memory"); ATT_SBAR(); } while (0)
    constexpr bool MINIT = true;
    f32x16 minit = f32x16{};
    constexpr bool FINM = false;
    f32x16 p0, p1; float al = 1.f; bf16x8 pa0, pa1, pa2, pa3; const int NT = seq / KVBLK; (void)thr_raw;
    __syncthreads();
    if constexpr (DEEP) { STG_SLOAD(A, 0); STG_SLOAD(B, KVBLK); asm volatile("s_waitcnt vmcnt(0)" ::: "memory"); STG_SWRITE(A, 0); STG_SWRITE(B, 1);
        if (2 < NT) { STG_SLOAD(A, 2 * KVBLK); STG_SLOAD(B, 3 * KVBLK); } }
    else if constexpr (!(DK == 128 && DV == 128)) {
        STG_SLOAD(A, 0); STG_SLOAD(B, KVBLK); asm volatile("s_waitcnt vmcnt(0)" ::: "memory"); STG_SWRITE(A, 0); STG_SWRITE(B, 1);
        if (2 < NT) STG_SLOAD(A, 2 * KVBLK); }
    else { STG_SLOAD(A, 0); asm volatile("s_waitcnt vmcnt(0)" ::: "memory"); STG_SWRITE(A, 0);
        STG_SLOAD(A, KVBLK); asm volatile("s_waitcnt vmcnt(0)" ::: "memory"); STG_SWRITE(A, 1);
        if (2 < NT) STG_SLOAD(A, 2 * KVBLK); }
    __syncthreads();
    if (half && MK_PROBE_ATT != 8) STG_BAR();
#define STG_TILE(t, S, PV) do { \
        mblock<DK, DV, (DK == 96) ? 3 : 2, FINM, MINIT>(o, p0, p1, PV, vb0 + (((t) - 1) & 3) * SHM_V, ka0 + ((t) & 3) * SHM_K, qr, pa0, pa1, pa2, pa3, -m_reg, al, &l_reg, &minit); \
        STG_BAR(); \
        if (MK_ATT_PRIO == 2) __builtin_amdgcn_s_setprio(1); \
        softmax_rel(p0, p1, m_reg, al, (t) == 0, MINIT ? &minit : nullptr); \
        if (MK_PROBE_ATT == 3) { float dz = 0.f; _Pragma("unroll") for (int r = 0; r < 16; ++r) { dz += __builtin_amdgcn_exp2f(p0[r] - 1.0f); dz += __builtin_amdgcn_exp2f(p1[r] - 2.0f); } asm volatile("" :: "v"(dz)); } \
        if (MK_PROBE_ATT == 6) { STG_BAR(); } \
        if (MK_PROBE_ATT == 9) { float dz = al; _Pragma("unroll") for (int r = 0; r < 48; ++r) asm volatile("v_fma_f32 %0, %0, %0, %0" : "+v"(dz)); asm volatile("" :: "v"(dz)); } \
        if constexpr (!FINM) finish_rel(p0, p1, al, l_reg, pa0, pa1, pa2, pa3); \
        if (__any(al < 1.f)) { if (hi == 0) al_l[r32] = al; asm volatile("s_waitcnt lgkmcnt(0)" ::: "memory"); \
            _Pragma("unroll") for (int d = 0; d < NO; ++d) _Pragma("unroll") for (int r = 0; r < 16; ++r) o[d][r] *= al_l[crow(r, hi)]; } \
        if (MK_ATT_PRIO == 2) __builtin_amdgcn_s_setprio(0); \
        if constexpr (DEEP) { if ((t) + 2 < NT) { STG_SWRITE(S, ((t) + 2) & 3); if ((t) + 4 < NT) STG_SLOAD(S, ((t) + 4) * KVBLK); } } \
        else      { if ((t) + 2 < NT) { STG_SWRITE(A, ((t) + 2) & 3); if ((t) + 3 < NT) { STG_SLOAD(A, ((t) + 3) * KVBLK); \
            if (MK_PROBE_ATT == 7) { STG_SLOAD(B, ((t) + 3) * KVBLK + 32 * ((t) & 1)); asm volatile("" :: "v"(vsB0), "v"(vsB1), "v"(ksB0), "v"(ksB1)); } } } } \
        STG_BAR(); } while (0)
    if constexpr (DEEP) { for (int t = 0; t < NT; t += 2) { STG_TILE(t, A, (t) > 0); STG_TILE(t + 1, B, true); } }
    else { STG_TILE(0, A, false);
        for (int t = 1; t < NT; ++t) STG_TILE(t, A, true); }
#undef STG_TILE
    if constexpr (FINM) finish_rel(p0, p1, al, l_reg, pa0, pa1, pa2, pa3);
    pv_d0<DV>(o, (int)(uintptr_t)V_lds + v_rd_base(fresh_lane()) + ((NT - 1) & 3) * SHM_V, pa0, pa1, pa2, pa3);
    if (!half && MK_PROBE_ATT != 8) STG_BAR();
    if constexpr (PART) { const int ln = fresh_lane(), rr32 = ln & 31, hh = ln >> 5;
      if (hh == 0) { pml[(wid * QBLK + rr32) * 2] = m_reg; pml[(wid * QBLK + rr32) * 2 + 1] = l_reg; }
      float* pw = po + (size_t)(wid * QBLK) * DV;
#pragma unroll
      for (int r = 0; r < 16; ++r) { const int orow = crow(r, hh);
#pragma unroll
          for (int d0 = 0; d0 < NO; ++d0) pw[orow * DV + d0 * 32 + rr32] = o[d0][r]; } }
    else
    { const int ln = fresh_lane(), rr32 = ln & 31, hh = ln >> 5;
      float* wsf2 = (float*)(lds + R * SHM_V + R * SHM_K) + wid * 64;
      if (hh == 0) wsf2[rr32] = l_reg; asm volatile("s_waitcnt lgkmcnt(0)" ::: "memory");
      float rli[16];
#pragma unroll
      for (int r = 0; r < 16; ++r) rli[r] = __builtin_amdgcn_rcpf(wsf2[crow(r, hh)]);
      constexpr int OP = DV * 2 + 16, OSZ = 32 * OP, NV = (3 * SHM_V) / OSZ;
      static_assert((8 - NV) * OSZ <= R * SHM_K, "O staging");
      char* stg = lds + (wid < NV ? wid * OSZ : R * SHM_V + (wid - NV) * OSZ);
#pragma unroll
      for (int r = 0; r < 16; ++r) { const int orow = crow(r, hh);
#pragma unroll
          for (int d0 = 0; d0 < NO; ++d0) *(bf16_t*)(stg + orow * OP + (d0 * 32 + rr32) * 2) = (bf16_t)f2bf(o[d0][r] * rli[r]); }
      asm volatile("s_waitcnt lgkmcnt(0)" ::: "memory");
      bf16_t* Ow = Ob + (long)(wid * QBLK) * ldo;
      constexpr int SEG = DV * 2 / 16;
#pragma unroll
      for (int ps = 0; ps < DV / 16; ++ps) { const int idx = ps * 64 + ln, row = idx / SEG, seg = idx % SEG;
          const u32x4 w = *(const u32x4*)(stg + row * OP + seg * 16);
          *(u32x4*)(Ow + (long)row * ldo + seg * 8) = w; } }
#undef STG_SLOAD
#undef STG_SWRITE
#undef STG_BAR
}
}
constexpr int NWAVES = 8;
constexpr int DM = 1024, NBATCH = 8, SEQ = 4096, CTXL = 256, TPB = CTXL + SEQ  , T = NBATCH * TPB  ;
constexpr int FF = 3584, NEXP = 8, DEPTH = 4;
constexpr int A_IN = 5120, B_IN = 672, B_INP = 768, C_IN = 1536, D_IN = 3072;
constexpr float NORM_EPS = 1e-6f;
constexpr int MOE_ROWS = 2 * T + NEXP * 256;

enum { I_X = 0, I_C, I_CTX, I_CCTX, I_MODW, I_MODB, I_NORMG, I_A_WIN, I_A_LB, I_A_ONORM, I_A_WOUT, I_B_WIN, I_B_QNORM, I_B_KVNORM, I_B_WQB, I_B_WKVB, I_B_WOUT,
       I_C_WIN, I_C_QNORM, I_C_KNORM, I_C_WOUT, I_D_WIN, I_D_LAMBDA, I_D_ONORM, I_D_WOUT, I_FFN_GU, I_FFN_DOWN, I_MOE_ROUTER, I_MOE_GU, I_MOE_DOWN, N_IN };

constexpr size_t al256(size_t x) { return (x + 255) / 256 * 256; }
constexpr size_t WS_CTL = 0, CTL_BYTES = 1u << 20;
constexpr size_t WS_MOD = WS_CTL + CTL_BYTES;
constexpr size_t WS_ROPE = WS_MOD + al256((size_t)DEPTH * 9 * 6 * DM * 4);
constexpr size_t WS_LB = WS_ROPE + al256((size_t)3 * 64 * 32 * 2 * 4);
constexpr size_t WS_W0 = WS_LB + al256((size_t)2 * 1024 * 4);
constexpr size_t WS_WA_IN = WS_W0;                                  constexpr size_t SZ_WA_IN = (size_t)A_IN * DM * 2;
constexpr size_t WS_WA_OUT = WS_WA_IN + SZ_WA_IN;                   constexpr size_t SZ_WOUT = (size_t)DM * DM * 2;
constexpr size_t WS_WB_IN = WS_WA_OUT + SZ_WOUT;                    constexpr size_t SZ_WB_IN = (size_t)B_INP * DM * 2;
constexpr size_t WS_WB_QB = WS_WB_IN + SZ_WB_IN;                    constexpr size_t SZ_WB_QB = (size_t)1536 * 384 * 2;
constexpr size_t WS_WB_KVB = WS_WB_QB + SZ_WB_QB;                   constexpr size_t SZ_WB_KVB = (size_t)2048 * 256 * 2;
constexpr size_t WS_WB_OUT = WS_WB_KVB + SZ_WB_KVB;
constexpr size_t WS_WC_IN = WS_WB_OUT + SZ_WOUT;                    constexpr size_t SZ_WC_IN = (size_t)C_IN * DM * 2;
constexpr size_t WS_WC_OUT = WS_WC_IN + SZ_WC_IN;
constexpr size_t WS_WD_IN = WS_WC_OUT + SZ_WOUT;                    constexpr size_t SZ_WD_IN = (size_t)D_IN * DM * 2;
constexpr size_t WS_WD_OUT = WS_WD_IN + SZ_WD_IN;
constexpr size_t WS_FFN_GU = WS_WD_OUT + SZ_WOUT;                   constexpr size_t SZ_GU = (size_t)2 * FF * DM;
constexpr size_t WS_FFN_DN = WS_FFN_GU + 2 * SZ_GU;                 constexpr size_t SZ_DN = (size_t)DM * FF * 2;
constexpr size_t WS_MOE_GU = WS_FFN_DN + 2 * SZ_DN;
constexpr size_t WS_MOE_DN = WS_MOE_GU + 16 * SZ_GU;
constexpr size_t WS_WEND = WS_MOE_DN + 16 * SZ_DN;
constexpr size_t WS_H = al256(WS_WEND);                              constexpr size_t SZ_H = (size_t)T * DM * 4;
constexpr size_t WS_XA = WS_H + SZ_H;                                constexpr size_t SZ_XA = (size_t)T * DM * 2;
constexpr size_t WS_Y = WS_XA + SZ_XA;                               constexpr size_t SZ_Y = (size_t)T * DM * 4;
constexpr size_t WS_YS = WS_Y + SZ_Y;                              constexpr size_t SZ_YS = (size_t)8 * 2048 * DM * 4;
constexpr size_t WS_ROUTE = WS_YS + SZ_YS;                             constexpr size_t SZ_ROUTE = (size_t)T * 32;
constexpr size_t WS_WCNT = WS_ROUTE + SZ_ROUTE;                      constexpr size_t SZ_WCNT = (size_t)256 * 8 * 4;
constexpr size_t WS_LIST = WS_WCNT + SZ_WCNT;                      constexpr size_t SZ_LIST = (size_t)NEXP * T * 4;
constexpr size_t WS_R0 = al256(WS_LIST + SZ_LIST);
constexpr size_t WS_Z = WS_R0;                                       constexpr size_t SZ_Z = (size_t)T * A_IN * 2;
constexpr size_t WS_Q = WS_Z + SZ_Z;                                 constexpr size_t SZ_Q = (size_t)T * 2048 * 2;
constexpr size_t WS_K = WS_Q + SZ_Q;                                 constexpr size_t SZ_K = (size_t)T * 1536 * 2;
constexpr size_t WS_V = WS_K + SZ_K;                                 constexpr size_t SZ_V = (size_t)T * 1024 * 2;
constexpr size_t WS_O = WS_V + SZ_V;                                 constexpr size_t SZ_O = (size_t)T * 2048 * 2;
constexpr size_t WS_MIX_END = WS_O + SZ_O;
constexpr size_t WS_ACT = WS_R0;                                     constexpr size_t SZ_ACT = (size_t)MOE_ROWS * FF * 2;
constexpr size_t WS_YP = WS_ACT + al256(SZ_ACT);                     constexpr size_t SZ_YP = (size_t)MOE_ROWS * DM * 4;
constexpr size_t WS_FFN_END = WS_YP + SZ_YP;
constexpr size_t WS_END = (WS_MIX_END > WS_FFN_END ? WS_MIX_END : WS_FFN_END);
static_assert((size_t)T * 1536 * 4 <= SZ_Z && (size_t)T * B_INP * 4 <= SZ_Z && (size_t)T * D_IN * 2 <= SZ_Z, "Z region");
static_assert((size_t)T * (384 + 256) * 2 <= SZ_O, "MLA normalised latents fit the O region");

constexpr int CW_BAR = 4096;
constexpr int CW_MOECNT = 16384;
constexpr int RING_BYTES = 131072;
constexpr int MISC_OFF = 163840 - 1024;
constexpr int LDS_BYTES = 163840;
static_assert(RING_BYTES <= MISC_OFF, "LDS map");

#define XB_TMO      128
#define XB_XCNT(j)  (256  + 64 * (j))
#define XB_XSUB(j)  (1280 + 64 * (j))
#define XB_XGEN(j)  (2304 + 64 * (j))
#define XB_TOP      3328
#define XB_TOPGEN   3392
#define XCD_BAR_WORDS 3456
#define XB_SPIN_CAP (1u << 22)
__device__ __forceinline__ unsigned xb_ld(unsigned* p)              { return __hip_atomic_load(p, __ATOMIC_RELAXED, __HIP_MEMORY_SCOPE_AGENT); }
__device__ __forceinline__ unsigned xb_add(unsigned* p, unsigned v) { return __hip_atomic_fetch_add(p, v, __ATOMIC_RELAXED, __HIP_MEMORY_SCOPE_AGENT); }
__device__ __forceinline__ unsigned xb_xcc_id() { return (unsigned)__builtin_amdgcn_s_getreg((3 << 11) | 20) & 0xFu; }
#define XB_SPIN(cond, bar) do { unsigned _sp = 0; while (cond) { __builtin_amdgcn_s_sleep(1); \
    if ((++_sp & 255u) == 0u) { if (xb_ld(&(bar)[XB_TMO])) break; if (_sp > XB_SPIN_CAP) { atomicAdd(&(bar)[XB_TMO], 1u); break; } } } } while (0)
struct XcdBarrier { unsigned* bar; unsigned x; volatile LAS unsigned* st; };
__device__ __forceinline__ XcdBarrier xcd_barrier_post(unsigned* bar, volatile LAS unsigned* st) {
    XcdBarrier b; b.bar = bar; b.x = xb_xcc_id(); b.st = st;
    if (threadIdx.x == 0) (void)xb_add(&bar[XB_XCNT(b.x)], 1u);
    return b;
}
__device__ __forceinline__ void xcd_barrier_complete(unsigned* bar, unsigned x, unsigned& nloc, unsigned& nx) {
    const unsigned G = gridDim.x * gridDim.y * gridDim.z;
    unsigned sum, cnt, mine, sp = 0u;
    for (;;) {
        sum = 0u; cnt = 0u; mine = 0u;
#pragma unroll
        for (unsigned j = 0; j < 16; ++j) { const unsigned c = xb_ld(&bar[XB_XCNT(j)]); sum += c; cnt += (c > 0u) ? 1u : 0u; mine = (j == x) ? c : mine; }
        if (sum == G) break;
        __builtin_amdgcn_s_sleep(1);
        if ((++sp & 255u) == 0u) { if (xb_ld(&bar[XB_TMO])) break; if (sp > XB_SPIN_CAP) { atomicAdd(&bar[XB_TMO], 1u); break; } }
    }
    nloc = mine > 0u ? mine : 1u; nx = cnt > 0u ? cnt : 1u;
}
__device__ __forceinline__ void xcd_barrier(const XcdBarrier& b, const int wave) {
    asm volatile("s_waitcnt vmcnt(0)" ::: "memory");
    __syncthreads();
    if (wave == 0 && fresh_lane() == 0) {
        unsigned* bar = b.bar;
        __builtin_amdgcn_s_waitcnt(0);
        unsigned nloc = b.st[0], nx = b.st[1];
        if (nloc == 0u) { xcd_barrier_complete(bar, b.x, nloc, nx); b.st[0] = nloc; b.st[1] = nx; }
        const unsigned old = xb_add(&bar[XB_XSUB(b.x)], 1u);
        const unsigned gen = old / nloc;
        if (old + 1u == (gen + 1u) * nloc) {
            __builtin_amdgcn_fence(__ATOMIC_RELEASE, "agent");
            asm volatile("s_waitcnt vmcnt(0)" ::: "memory");
            const unsigned og = xb_add(&bar[XB_TOP], 1u);
            const unsigned tg = og / nx;
            if (og + 1u == (tg + 1u) * nx) xb_add(&bar[XB_TOPGEN], 1u);
            else XB_SPIN(xb_ld(&bar[XB_TOPGEN]) == tg, bar);
            __builtin_amdgcn_fence(__ATOMIC_ACQUIRE, "agent");
            xb_add(&bar[XB_XGEN(b.x)], 1u);
            asm volatile("s_waitcnt vmcnt(0)" ::: "memory");
        } else {
            XB_SPIN(xb_ld(&bar[XB_XGEN(b.x)]) == gen, bar);
            __builtin_amdgcn_fence(__ATOMIC_ACQUIRE, "agent");
            asm volatile("s_waitcnt vmcnt(0)" ::: "memory");
        }
    }
    __syncthreads();
}

struct Frame {
    LAS unsigned char* lds; volatile LAS unsigned* MISC; unsigned char* ws;
    int wave, vcu, G;
};
typedef __attribute__((address_space(4))) const unsigned long long* kargp_t;
__device__ __forceinline__ float* out_ptr() { kargp_t ka = (kargp_t)__builtin_amdgcn_kernarg_segment_ptr(); return (float*)(GAS float*)(ka[N_IN]); }
__device__ __forceinline__ const float* in_ptr(const Frame&, int idx) { kargp_t ka = (kargp_t)__builtin_amdgcn_kernarg_segment_ptr(); return (const float*)(const GAS float*)(ka[idx]); }

struct MatDesc { int in_idx; unsigned src_off  ; int K, Nsrc, Ndst, kind  ; unsigned long long dst  ; };
constexpr int NMAT = 10 + 2 + 2 + 16 + 16, NMAT0 = 4;
struct MatTable { MatDesc m[NMAT]; int item0[NMAT + 1]; };
constexpr MatTable make_mats() {
    MatTable t{}; int n = 0;
    auto add = [&](int in_idx, unsigned src_off, int K, int Nsrc, int Ndst, int kind, unsigned long long dst) { t.m[n] = MatDesc{in_idx, src_off, K, Nsrc, Ndst, kind, dst}; ++n; };
    add(I_A_WIN, 0, DM, A_IN, A_IN, 0, WS_WA_IN); add(I_A_WOUT, 0, DM, DM, DM, 0, WS_WA_OUT);
    add(I_FFN_GU, 0, DM, 2 * FF, 2 * FF, 2, WS_FFN_GU); add(I_FFN_DOWN, 0, FF, DM, DM, 0, WS_FFN_DN);
    add(I_B_WIN, 0, DM, B_IN, B_INP, 0, WS_WB_IN); add(I_B_WQB, 0, 384, 1536, 1536, 0, WS_WB_QB); add(I_B_WKVB, 0, 256, 2048, 2048, 0, WS_WB_KVB); add(I_B_WOUT, 0, DM, DM, DM, 0, WS_WB_OUT);
    add(I_C_WIN, 0, DM, C_IN, C_IN, 3, WS_WC_IN); add(I_C_WOUT, 0, DM, DM, DM, 0, WS_WC_OUT);
    add(I_D_WIN, 0, DM, D_IN, D_IN, 0, WS_WD_IN); add(I_D_WOUT, 0, DM, DM, DM, 0, WS_WD_OUT);
    add(I_FFN_GU, (unsigned)1 * DM * 2 * FF, DM, 2 * FF, 2 * FF, 2, WS_FFN_GU + SZ_GU); add(I_FFN_DOWN, (unsigned)1 * FF * DM, FF, DM, DM, 0, WS_FFN_DN + SZ_DN);
    for (int j = 0; j < 16; ++j) add(I_MOE_GU, (unsigned)j * DM * 2 * FF, DM, 2 * FF, 2 * FF, 2, WS_MOE_GU + (size_t)j * SZ_GU);
    for (int j = 0; j < 16; ++j) add(I_MOE_DOWN, (unsigned)j * FF * DM, FF, DM, DM, 0, WS_MOE_DN + (size_t)j * SZ_DN);
    int acc = 0; for (int i = 0; i < NMAT; ++i) { t.item0[i] = acc; acc += (t.m[i].K / 64) * (t.m[i].Ndst / 64); } t.item0[NMAT] = acc;
    return t;
}
__device__ const MatTable g_mats = make_mats();

__host__ __device__ __forceinline__ int gqa_dim(int c) { const int wc = c >> 5, fq = (c >> 3) & 3, e = c & 7; return 64 * (wc >> 1) + 32 * (fq >> 1) + 16 * (wc & 1) + 8 * (fq & 1) + e; }
constexpr int P0_SCR = 64 * 65 * 4;
__device__ __forceinline__ void p0_transpose_item(const float* W, int K, int Nsrc, int kind, bf16_t* WT, LAS float* scr, int item, int Ndst, int lane) {
    const int nblk = Ndst / 64, kb = item / nblk, nb = item % nblk, k0 = 64 * kb, n0 = 64 * nb;
    int s0;
    if (kind == 1 || kind == 2) { const int pn = n0 >> 8, bj = (n0 >> 7) & 1, cc = n0 & 127; s0 = bj * FF + 128 * pn + cc; } else s0 = n0;
    int sl = s0 + lane;
    if (kind == 3) { const int n = n0 + lane; sl = (n < 1280) ? (n & ~127) + gqa_dim(n & 127) : n; }
    const bool ok = (kind >= 1) || (n0 + lane < Nsrc);
    const float* src = W + (size_t)k0 * Nsrc + sl;
    float tv[64];
#pragma unroll
    for (int kk = 0; kk < 64; ++kk) tv[kk] = ok ? src[(size_t)kk * Nsrc] : 0.f;
#pragma unroll
    for (int kk = 0; kk < 64; ++kk) scr[kk * 65 + lane] = tv[kk];
    asm volatile("s_waitcnt lgkmcnt(0)" ::: "memory");
    if (kind == 2) {
        const int c = lane & 3; unsigned char* WT8 = (unsigned char*)WT;
#pragma unroll
        for (int j = 0; j < 4; ++j) { const int n = (lane >> 2) + 16 * j; const LAS float* sp = scr + (16 * c) * 65 + n;
            u32x4 o; o.x = pk4_fp8(32.f * sp[0 * 65], 32.f * sp[1 * 65], 32.f * sp[2 * 65], 32.f * sp[3 * 65]); o.y = pk4_fp8(32.f * sp[4 * 65], 32.f * sp[5 * 65], 32.f * sp[6 * 65], 32.f * sp[7 * 65]);
            o.z = pk4_fp8(32.f * sp[8 * 65], 32.f * sp[9 * 65], 32.f * sp[10 * 65], 32.f * sp[11 * 65]); o.w = pk4_fp8(32.f * sp[12 * 65], 32.f * sp[13 * 65], 32.f * sp[14 * 65], 32.f * sp[15 * 65]);
            *(u32x4*)(WT8 + (size_t)(n0 + n) * K + k0 + 16 * c) = o; }
    } else {
    const int c = lane & 7;
#pragma unroll
    for (int j = 0; j < 8; ++j) { const int n = (lane >> 3) + 8 * j; const LAS float* sp = scr + (8 * c) * 65 + n;
        u32x4 o; o.x = pk2(sp[0 * 65], sp[1 * 65]); o.y = pk2(sp[2 * 65], sp[3 * 65]); o.z = pk2(sp[4 * 65], sp[5 * 65]); o.w = pk2(sp[6 * 65], sp[7 * 65]);
        *(u32x4*)(WT + (size_t)(n0 + n) * K + k0 + 8 * c) = o; }
    }
    asm volatile("s_waitcnt lgkmcnt(0)" ::: "memory");
}

__device__ __forceinline__ void p0_convert(Frame& F, int it0, int it1, int worker, int nworkers, int lane) {
    LAS float* scr = (LAS float*)(F.lds + F.wave * P0_SCR);
    for (int it = it0 + worker; it < it1; it += nworkers) {
        int mi = 0;
#pragma unroll 1
        for (int j = 1; j < NMAT; ++j) mi = (it >= g_mats.item0[j]) ? j : mi;
        const MatDesc d = g_mats.m[mi];
        p0_transpose_item(in_ptr(F, d.in_idx) + d.src_off, d.K, d.Nsrc, d.kind, (bf16_t*)(F.ws + d.dst), scr, it - g_mats.item0[mi], d.Ndst, lane);
    }
}
__device__ __forceinline__ int p0_split_item() { const int i0 = g_mats.item0[NMAT0], i1 = g_mats.item0[NMAT]; return i0 + (int)((long)(i1 - i0) * 0 / 100); }
__device__ __forceinline__ void p0_prologue(Frame& F) {
    const int lane = fresh_lane(), tid = F.wave * 64 + lane; (void)tid;
    const int gw = F.vcu * NWAVES + F.wave, NGW = F.G * NWAVES;
    p0_convert(F, 0, p0_split_item(), gw, NGW, lane);
    __syncthreads();
    {
        LAS float* cond = (LAS float*)F.lds;
        LAS float* part = (LAS float*)(F.lds + 65536);
        const float* cin = in_ptr(F, I_C); const float* cctx = in_ptr(F, I_CCTX);
        for (int i = tid; i < 9 * DM; i += 512) { const int r = i / DM, k = i % DM; const float v = (r < 8) ? cin[r * DM + k] : cctx[k]; cond[i] = silu_f(v); }
        __syncthreads();
        const float* mw = in_ptr(F, I_MODW); const float* mb = in_ptr(F, I_MODB);
        float* modt = (float*)(F.ws + WS_MOD);
        constexpr int NITEM = DEPTH * (6 * DM / 64);
        for (int it = F.vcu; it < NITEM; it += F.G) {
            const int l = it / 96, cb = it % 96, col = cb * 64 + lane;
            float a[9];
#pragma unroll
            for (int r = 0; r < 9; ++r) a[r] = 0.f;
            const float* wp = mw + ((size_t)l * DM + F.wave * 128) * (6 * DM) + col;
#pragma unroll 8
            for (int k = 0; k < 128; ++k) { const float w = wp[(size_t)k * (6 * DM)];
#pragma unroll
                for (int r = 0; r < 9; ++r) a[r] = fmaf(cond[r * DM + F.wave * 128 + k], w, a[r]); }
#pragma unroll
            for (int r = 0; r < 9; ++r) part[(F.wave * 9 + r) * 64 + lane] = a[r];
            __syncthreads();
            for (int i = tid; i < 9 * 64; i += 512) { const int r = i / 64, c = i % 64; float s = mb[(size_t)l * 6 * DM + cb * 64 + c];
#pragma unroll
                for (int w = 0; w < 8; ++w) s += part[(w * 9 + r) * 64 + c];
                modt[((size_t)l * 9 + r) * (6 * DM) + cb * 64 + c] = s; }
            __syncthreads();
        }
    }
    {
        float* rt = (float*)(F.ws + WS_ROPE);
        for (int i = gw * 64 + lane; i < 3 * 64 * 32; i += NGW * 64) { const int kind = i / 2048, pos = (i / 32) % 64, fi = i % 32; const int n = 16 << kind;
            if (fi < n / 2) { const float inv = exp2f(-(float)(2 * fi) / (float)n * 13.287712379549449f);
                const float ang = (float)pos * inv; float s, c;
                {
                  const float rev = ang * 0.15915494309189535f; const float fr = rev - floorf(rev); s = __builtin_amdgcn_sinf(fr); c = __builtin_amdgcn_cosf(fr); }
                rt[(size_t)i * 2] = c; rt[(size_t)i * 2 + 1] = s; } }
    }
    {
        const float* alb = in_ptr(F, I_A_LB); float* lb = (float*)(F.ws + WS_LB);
        for (int i = gw * 64 + lane; i < 2 * 1024; i += NGW * 64) { const int dir = i / 1024, w = i % 1024; float v[5], mx = -1e30f;
#pragma unroll
            for (int j = 0; j < 5; ++j) { v[j] = alb[((size_t)dir * 5 + j) * 1024 + w]; mx = fmaxf(mx, v[j]); }
            float s = 0.f;
#pragma unroll
            for (int j = 0; j < 5; ++j) s += expf(v[j] - mx);
            lb[i] = expf(v[0] - mx) / s; }
    }
}

struct RowPos { int b, p, modrow, prow, pcol; bool isctx; };
__device__ __forceinline__ RowPos row_pos(int m) { RowPos r; r.b = m / TPB; r.p = m % TPB; r.isctx = r.p < CTXL; r.modrow = r.isctx ? 8 : r.b; const int t = r.isctx ? 0 : r.p - CTXL; r.prow = t >> 6; r.pcol = t & 63; return r; }
__device__ __forceinline__ void ld_row(const float* p, int lane, f32x4 (&v)[4]) {
#pragma unroll
    for (int j = 0; j < 4; ++j) v[j] = *(const f32x4*)(p + 256 * j + 4 * lane);
}
__device__ __forceinline__ void ld_row_bf16(const bf16_t* p, int lane, f32x4 (&v)[4]) {
#pragma unroll
    for (int j = 0; j < 4; ++j) { const u32x2 w = *(const u32x2*)(p + 256 * j + 4 * lane); v[j] = (f32x4){bf2f(w.x & 0xffffu), bf2f(w.x >> 16), bf2f(w.y & 0xffffu), bf2f(w.y >> 16)}; }
}
__device__ __forceinline__ void st_row_bf16(bf16_t* p, int lane, const f32x4 (&v)[4]) {
#pragma unroll
    for (int j = 0; j < 4; ++j) { u32x2 w; w.x = pk2(v[j].x, v[j].y); w.y = pk2(v[j].z, v[j].w); *(u32x2*)(p + 256 * j + 4 * lane) = w; }
}
__device__ __forceinline__ float sumsq_row(const f32x4 (&v)[4]) { float s = 0.f;
#pragma unroll
    for (int j = 0; j < 4; ++j) s += (v[j].x * v[j].x + v[j].y * v[j].y) + (v[j].z * v[j].z + v[j].w * v[j].w);
    return wave_sum(s); }
__device__ __forceinline__ void norm_mod_store(const f32x4 (&x)[4], float rstd, const float* g, const float* shift, const float* scale, bf16_t* dst, int lane, f32x4 (&u)[4]) {
#pragma unroll
    for (int j = 0; j < 4; ++j) { const int c = 256 * j + 4 * lane; const f32x4 gg = *(const f32x4*)(g + c), sh = *(const f32x4*)(shift + c), sc = *(const f32x4*)(scale + c);
        u[j] = (x[j] * rstd * gg) * (sc + 1.0f) + sh;
        u32x2 w; w.x = pk2(u[j].x, u[j].y); w.y = pk2(u[j].z, u[j].w); *(u32x2*)(dst + c) = w; }
}

__device__ __forceinline__ void norm_mod_store_fp8(const f32x4 (&x)[4], float rstd, const float* g, const float* shift, const float* scale, unsigned char* dst, int lane, f32x4 (&u)[4]) {
#pragma unroll
    for (int j = 0; j < 4; ++j) { const int c = 256 * j + 4 * lane; const f32x4 gg = *(const f32x4*)(g + c), sh = *(const f32x4*)(shift + c), sc = *(const f32x4*)(scale + c);
        u[j] = (x[j] * rstd * gg) * (sc + 1.0f) + sh;
        *(unsigned*)(dst + c) = pk4_fp8(u[j].x, u[j].y, u[j].z, u[j].w); }
}
__device__ __forceinline__ void ld_y_row(const unsigned char* ws, int m, const RowPos& rp, int S, int lane, f32x4 (&yv)[4]) {
    if (rp.isctx) { const float* ys = (const float*)(ws + WS_YS) + (size_t)(rp.b * CTXL + rp.p) * DM;
        ld_row(ys, lane, yv);
        for (int s = 1; s < S; ++s) { f32x4 t[4]; ld_row(ys + (size_t)s * 2048 * DM, lane, t);
#pragma unroll
            for (int j = 0; j < 4; ++j) yv[j] = yv[j] + t[j]; } }
    else ld_row_bf16((const bf16_t*)(ws + WS_Y) + (size_t)m * DM, lane, yv);
}
__device__ __forceinline__ void ld_yp_row(const unsigned char* ws, size_t r, int RBM, int trb, int S, int lane, f32x4 (&v)[4]) {
    const int rb = (int)(r >> 8);
    if (rb >= RBM) { const float* ys = (const float*)(ws + WS_YS) + ((size_t)(rb - RBM) * 256 + (r & 255)) * DM;
        ld_row(ys, lane, v);
        for (int s = 1; s < S; ++s) { f32x4 t[4]; ld_row(ys + (size_t)s * trb * 256 * DM, lane, t);
#pragma unroll
            for (int j = 0; j < 4; ++j) v[j] = v[j] + t[j]; } }
    else ld_row_bf16((const bf16_t*)(ws + WS_YP) + r * DM, lane, v);
}
__device__ __forceinline__ float half_sum(float v) {
#pragma unroll
    for (int o = 1; o < 32; o <<= 1) v += __shfl_xor(v, o);
    return v;
}
__device__ __forceinline__ void ld_row2(const float* p, int l32, f32x4 (&v)[8]) {
#pragma unroll
    for (int j = 0; j < 8; ++j) v[j] = *(const f32x4*)(p + 128 * j + 4 * l32);
}
__device__ __forceinline__ void ld_row2_bf16(const bf16_t* p, int l32, f32x4 (&v)[8]) {
#pragma unroll
    for (int j = 0; j < 8; ++j) { const u32x2 w = *(const u32x2*)(p + 128 * j + 4 * l32); v[j] = (f32x4){bf2f(w.x & 0xffffu), bf2f(w.x >> 16), bf2f(w.y & 0xffffu), bf2f(w.y >> 16)}; }
}
__device__ __forceinline__ void st_row2_bf16(bf16_t* p, int l32, const f32x4 (&v)[8]) {
#pragma unroll
    for (int j = 0; j < 8; ++j) { u32x2 w; w.x = pk2(v[j].x, v[j].y); w.y = pk2(v[j].z, v[j].w); *(u32x2*)(p + 128 * j + 4 * l32) = w; }
}
__device__ __forceinline__ float sumsq_row2(const f32x4 (&v)[8]) { float s = 0.f;
#pragma unroll
    for (int j = 0; j < 8; ++j) s += (v[j].x * v[j].x + v[j].y * v[j].y) + (v[j].z * v[j].z + v[j].w * v[j].w);
    return half_sum(s); }
template <bool FP8>
__device__ __forceinline__ void norm_mod2(const f32x4 (&x)[8], float rstd, const LAS float* g, const LAS float* shift, const LAS float* scale, void* dst, int l32, bool st, f32x4 (&u)[8]) {
#pragma unroll
    for (int j = 0; j < 8; ++j) { if ((j & 3) == 0) __builtin_amdgcn_sched_barrier(0);
        const int c = 128 * j + 4 * l32; const f32x4 gg = *(const LAS f32x4*)(g + c), sh = *(const LAS f32x4*)(shift + c), sc = *(const LAS f32x4*)(scale + c);
        u[j] = (x[j] * rstd * gg) * (sc + 1.0f) + sh;
        if (st) { if (FP8) *(unsigned*)((unsigned char*)dst + c) = pk4_fp8(u[j].x, u[j].y, u[j].z, u[j].w);
                  else { u32x2 w; w.x = pk2(u[j].x, u[j].y); w.y = pk2(u[j].z, u[j].w); *(u32x2*)((bf16_t*)dst + c) = w; } } }
}
constexpr int PAR_FLOATS = 29 * DM;
__device__ __forceinline__ void fill_params(Frame& F, const float* ga, const float* gb, const float* m0, const float* m1, const float* m2, int tid) {
    LAS float* par = (LAS float*)F.lds;
    for (int i = tid; i < PAR_FLOATS / 4; i += NWAVES * 64) { const int v = i >> 8, c = (i & 255) * 4; const float* src;
        if (v == 0) src = ga; else if (v == 1) src = gb; else { const int r = (v - 2) / 3, k = (v - 2) % 3; src = (k == 0 ? m0 : k == 1 ? m1 : m2) + (size_t)r * (6 * DM); }
        *(LAS f32x4*)(par + v * DM + c) = *(const f32x4*)(src + c); }
    __syncthreads();
}
__device__ __forceinline__ void ld_y_row2(const unsigned char* ws, int m, const RowPos& rp, bool slab, int S, int l32, f32x4 (&yv)[8]) {
    if (slab) { const float* ys = (const float*)(ws + WS_YS) + (size_t)(rp.b * CTXL + rp.p) * DM;
        ld_row2(ys, l32, yv);
#pragma unroll 1
        for (int s = 1; s < S; ++s) { f32x4 t[8]; ld_row2(ys + (size_t)s * 2048 * DM, l32, t);
#pragma unroll
            for (int j = 0; j < 8; ++j) yv[j] = yv[j] + t[j]; } }
    else ld_row2_bf16((const bf16_t*)(ws + WS_Y) + (size_t)m * DM, l32, yv);
}
__device__ __forceinline__ void ld_yp_row2(const unsigned char* ws, size_t r, int RBM, int trb, int S, int l32, f32x4 (&v)[8]) {
    const int rb = (int)(r >> 8);
    if (rb >= RBM) { const float* ys = (const float*)(ws + WS_YS) + ((size_t)(rb - RBM) * 256 + (r & 255)) * DM;
        ld_row2(ys, l32, v);
#pragma unroll 1
        for (int s = 1; s < S; ++s) { f32x4 t[8]; ld_row2(ys + (size_t)s * trb * 256 * DM, l32, t);
#pragma unroll
            for (int j = 0; j < 8; ++j) v[j] = v[j] + t[j]; } }
    else ld_row2_bf16((const bf16_t*)(ws + WS_YP) + r * DM, l32, v);
}

__device__ __forceinline__ void phase_r0(Frame& F) {
    const int lane = fresh_lane(), l32 = lane & 31, half = lane >> 5;
    const int gw = F.vcu * NWAVES + F.wave, NGW = F.G * NWAVES;
    const float* x = in_ptr(F, I_X); const float* ctx = in_ptr(F, I_CTX); const float* ng = in_ptr(F, I_NORMG);
    bf16_t* h = (bf16_t*)(F.ws + WS_H); bf16_t* xa = (bf16_t*)(F.ws + WS_XA); const float* modt = (const float*)(F.ws + WS_MOD);
    fill_params(F, ng + (0 * 4 + 0) * DM, ng + (0 * 4 + 0) * DM, modt + 0 * DM, modt + 1 * DM, modt + 1 * DM, F.wave * 64 + lane);
    const LAS float* par = (const LAS float*)F.lds;
    for (int pi = gw; pi < T / 2; pi += NGW) { const int m = 2 * pi + half; const RowPos rp = row_pos(m);
        const float* src = rp.isctx ? ctx + ((size_t)rp.b * CTXL + rp.p) * DM : x + ((size_t)rp.b * SEQ + (rp.p - CTXL)) * DM;
        f32x4 v[8], u[8]; ld_row2(src, l32, v);
        st_row2_bf16(h + (size_t)m * DM, l32, v);
        const float rstd = rsqrtf(sumsq_row2(v) * (1.0f / DM) + NORM_EPS);
        const LAS float* pm = par + (2 + 3 * rp.modrow) * DM;
        norm_mod2<false>(v, rstd, par, pm + 0 * DM, pm + 1 * DM, xa + (size_t)m * DM, l32, true, u); }
    __syncthreads();
}

template <bool MOE>
__device__ __forceinline__ void phase_r1(Frame& F, int l) {
    const int lane = fresh_lane(), tid = F.wave * 64 + lane, l32 = lane & 31, half = lane >> 5;
    const float* ng = in_ptr(F, I_NORMG); const float* modt = (const float*)(F.ws + WS_MOD);
    bf16_t* h = (bf16_t*)(F.ws + WS_H); unsigned char* xa = (unsigned char*)(F.ws + WS_XA);
    const float* router = MOE ? in_ptr(F, I_MOE_ROUTER) + (size_t)(l >> 1) * DM * NEXP : nullptr;
    constexpr int LB = PAR_FLOATS * 4;
    LAS int* lcnt = (LAS int*)(F.lds + LB);
    LAS int* lbase = (LAS int*)(F.lds + LB + 64);
    LAS int* lrow = (LAS int*)(F.lds + LB + 1024);
    LAS float* lw = (LAS float*)(F.lds + LB + 4096);
    constexpr int RPW = T / 256;
    if (MOE) { if (tid < 8) lcnt[tid] = 0; }
    { const float* ml = modt + (size_t)l * 9 * (6 * DM); fill_params(F, ng + (l * 4 + 1) * DM, ng + (l * 4 + 2) * DM, ml + 2 * DM, ml + 3 * DM, ml + 4 * DM, tid); }
    const LAS float* par = (const LAS float*)F.lds;
    LAS f32x4* rtA = (LAS f32x4*)(F.lds + LB + 8192); LAS f32x4* rtB = rtA + 1024;
    if (MOE) { for (int c = tid; c < DM; c += NWAVES * 64) { const int slot = ((c & 3) * 8 + (c >> 7)) * 32 + ((c & 127) >> 2);
            rtA[slot] = *(const f32x4*)(router + (size_t)c * 8); rtB[slot] = *(const f32x4*)(router + (size_t)c * 8 + 4); }
        __syncthreads(); }
#define R1_ROW(i) ((i) * 256 + F.vcu)
    f32x4 yn[8], hn[8];
    { const int m0 = R1_ROW(2 * F.wave + half); const RowPos r0 = row_pos(m0); ld_y_row2(F.ws, m0, r0, r0.isctx && !(l == DEPTH - 1), 4, l32, yn); ld_row2_bf16(h + (size_t)m0 * DM, l32, hn); }
    for (int i2 = F.wave; i2 < RPW / 2; i2 += NWAVES) { const int i = 2 * i2 + half, m = R1_ROW(i); const RowPos rp = row_pos(m);
        const bool skip = (l == DEPTH - 1) && rp.isctx;
        const LAS float* pm = par + (2 + 3 * rp.modrow) * DM;
        f32x4 yv[8], hv[8], u[8];
#pragma unroll
        for (int j = 0; j < 8; ++j) { yv[j] = yn[j]; hv[j] = hn[j]; }
        if (i2 + NWAVES < RPW / 2) { const int mn = R1_ROW(i + 2 * NWAVES); const RowPos rn = row_pos(mn); ld_y_row2(F.ws, mn, rn, rn.isctx && !(l == DEPTH - 1), 4, l32, yn); ld_row2_bf16(h + (size_t)mn * DM, l32, hn); }
        const float rstd_y = rsqrtf(sumsq_row2(yv) * (1.0f / DM) + NORM_EPS);
#pragma unroll
        for (int j = 0; j < 8; ++j) { if ((j & 3) == 0) __builtin_amdgcn_sched_barrier(0);
            const int c = 128 * j + 4 * l32; const f32x4 g1 = *(const LAS f32x4*)(par + c), gt = *(const LAS f32x4*)(pm + c);
            hv[j] = hv[j] + gt * (yv[j] * rstd_y * g1); }
        if (!skip) st_row2_bf16(h + (size_t)m * DM, l32, hv);
        const float rstd_h = rsqrtf(sumsq_row2(hv) * (1.0f / DM) + NORM_EPS);
        norm_mod2<true>(hv, rstd_h, par + DM, pm + 1 * DM, pm + 2 * DM, xa + (size_t)m * DM, l32, !skip, u);
        if (MOE) {
            float lg[8];
#pragma unroll
            for (int e = 0; e < 8; ++e) lg[e] = 0.f;
#pragma unroll
            for (int j = 0; j < 8; ++j) { __builtin_amdgcn_sched_barrier(0);
#pragma unroll
                for (int q = 0; q < 4; ++q) { const f32x4 r0 = rtA[(q * 8 + j) * 32 + l32], r1 = rtB[(q * 8 + j) * 32 + l32]; const float uv = u[j][q];
                    lg[0] = fmaf(uv, r0.x, lg[0]); lg[1] = fmaf(uv, r0.y, lg[1]); lg[2] = fmaf(uv, r0.z, lg[2]); lg[3] = fmaf(uv, r0.w, lg[3]);
                    lg[4] = fmaf(uv, r1.x, lg[4]); lg[5] = fmaf(uv, r1.y, lg[5]); lg[6] = fmaf(uv, r1.z, lg[6]); lg[7] = fmaf(uv, r1.w, lg[7]); } }
#pragma unroll
            for (int e = 0; e < 8; ++e) lg[e] = half_sum(lg[e]);
            int e1 = 0; float v1 = lg[0];
#pragma unroll
            for (int e = 1; e < 8; ++e) if (lg[e] > v1) { v1 = lg[e]; e1 = e; }
            int e2 = (e1 == 0) ? 1 : 0; float v2 = (e1 == 0) ? lg[1] : lg[0];
#pragma unroll
            for (int e = 1; e < 8; ++e) if (e != e1 && lg[e] > v2) { v2 = lg[e]; e2 = e; }
            const float w2 = fast_rcp(1.0f + expf(v1 - v2)), w1 = 1.0f - w2;
            if (l32 == 0) { if (skip) lrow[i * 4 + 0] = -1;
                else { lrow[i * 4 + 0] = e1; lrow[i * 4 + 2] = e2; lw[i * 2] = w1; lw[i * 2 + 1] = w2; } }
        }
    }
    if (MOE) {
        __syncthreads();
        if (tid < 8) { int c = 0; for (int i = 0; i < RPW; ++i) { const int a = lrow[i * 4], b = lrow[i * 4 + 2]; if (a < 0) continue; if (a == tid) lrow[i * 4 + 1] = c++; else if (b == tid) lrow[i * 4 + 3] = c++; }
            lcnt[tid] = c; ((int*)(F.ws + WS_WCNT))[F.vcu * 8 + tid] = c;
            __hip_atomic_fetch_add((int*)((unsigned*)F.ws + CW_MOECNT + (l >> 1) * 64) + tid, c, __ATOMIC_RELAXED, __HIP_MEMORY_SCOPE_AGENT); }
        __syncthreads();
        int* route = (int*)(F.ws + WS_ROUTE);
        for (int i = tid; i < RPW; i += 512) { const int m = R1_ROW(i); const int e1 = lrow[i * 4], e2 = lrow[i * 4 + 2]; route[(size_t)m * 8 + 0] = e1; if (e1 < 0) continue;
            route[(size_t)m * 8 + 1] = lrow[i * 4 + 1]; route[(size_t)m * 8 + 2] = e2; route[(size_t)m * 8 + 3] = lrow[i * 4 + 3];
            ((float*)route)[(size_t)m * 8 + 4] = lw[i * 2]; ((float*)route)[(size_t)m * 8 + 5] = lw[i * 2 + 1]; }
        __syncthreads();
    }
}
__device__ __forceinline__ void moe_build(Frame& F) {
    const int lane = fresh_lane(), tid = F.wave * 64 + lane;
    LAS int* red = (LAS int*)F.lds;
    const int* wcnt = (const int*)(F.ws + WS_WCNT);
    { const int e = tid & 7; int sacc = 0; for (int v = tid >> 3; v < F.vcu; v += 64) sacc += wcnt[v * 8 + e]; red[tid] = sacc; }
    __syncthreads();
    if (tid < 8) { int sacc = 0; for (int k = 0; k < 64; ++k) sacc += red[k * 8 + tid]; red[512 + tid] = sacc; }
    __syncthreads();
    constexpr int RPW = T / 256;
    int* list = (int*)(F.ws + WS_LIST); int* route = (int*)(F.ws + WS_ROUTE);
    for (int i = tid; i < RPW; i += 512) { const int m = R1_ROW(i); const int e1 = route[(size_t)m * 8]; if (e1 < 0) continue; const int e2 = route[(size_t)m * 8 + 2];
        const int s1 = red[512 + e1] + route[(size_t)m * 8 + 1], s2 = red[512 + e2] + route[(size_t)m * 8 + 3];
        list[(size_t)e1 * T + s1] = m; list[(size_t)e2 * T + s2] = m; route[(size_t)m * 8 + 1] = s1; route[(size_t)m * 8 + 3] = s2; }
}

__device__ __forceinline__ void moe_tables(Frame& F, int l) {
    const int lane = fresh_lane(), tid = F.wave * 64 + lane; (void)tid;
    if (tid == 0) { const int* gcnt = (const int*)((unsigned*)F.ws + CW_MOECNT + (l >> 1) * 64); int acc = 0;
        for (int e = 0; e < 8; ++e) { const int c = __hip_atomic_load(gcnt + e, __ATOMIC_RELAXED, __HIP_MEMORY_SCOPE_AGENT); F.MISC[32 + e] = (unsigned)c; F.MISC[16 + e] = (unsigned)acc; acc += (c + 255) / 256; }
        F.MISC[24] = (unsigned)acc; }
    __syncthreads();
}

template <bool MOE>
__device__ __forceinline__ void phase_r2(Frame& F, int l) {
    const int lane = fresh_lane(), l32 = lane & 31, half = lane >> 5;
    const int gw = F.vcu * NWAVES + F.wave, NGW = F.G * NWAVES;
    const float* ng = in_ptr(F, I_NORMG); const float* modt = (const float*)(F.ws + WS_MOD);
    bf16_t* h = (bf16_t*)(F.ws + WS_H); bf16_t* xa = (bf16_t*)(F.ws + WS_XA);
    const int* route = (const int*)(F.ws + WS_ROUTE);
    int RBM = 0, trb = 0, S = 1; if (MOE) pg8::moe_tail_params((int)F.MISC[24], RBM, trb, S);
    { const int ln = (l < DEPTH - 1) ? l + 1 : l; const float* ml = modt + (size_t)l * 9 * (6 * DM); const float* mn = modt + (size_t)ln * 9 * (6 * DM);
      fill_params(F, ng + (l * 4 + 3) * DM, ng + (ln * 4 + 0) * DM, ml + 5 * DM, mn + 0 * DM, mn + 1 * DM, F.wave * 64 + lane); }
    const LAS float* par = (const LAS float*)F.lds;
    f32x4 an[8], bn[8], hn[8]; float w1n = 0.f, w2n = 0.f;
#define R2_LOAD(mm) do { const RowPos _r = row_pos(mm); const bool _sk = (l == DEPTH - 1) && _r.isctx; \
        if (MOE) { int e1 = 0, s1 = 0, e2 = 0, s2 = 0; w1n = 0.f; w2n = 0.f; \
            if (!_sk) { e1 = route[(size_t)(mm) * 8]; s1 = route[(size_t)(mm) * 8 + 1]; e2 = route[(size_t)(mm) * 8 + 2]; s2 = route[(size_t)(mm) * 8 + 3]; w1n = ((const float*)route)[(size_t)(mm) * 8 + 4]; w2n = ((const float*)route)[(size_t)(mm) * 8 + 5]; } \
            const size_t r1 = (size_t)F.MISC[16 + e1] * 256 + s1, r2 = (size_t)F.MISC[16 + e2] * 256 + s2; \
            ld_yp_row2(F.ws, r1, RBM, trb, S, l32, an); ld_yp_row2(F.ws, r2, RBM, trb, S, l32, bn); } \
        else ld_y_row2(F.ws, (mm), _r, _r.isctx, 4, l32, an); \
        ld_row2_bf16(h + (size_t)(mm) * DM, l32, hn); } while (0)
    if (gw < T / 2) R2_LOAD(2 * gw + half);
    for (int pi = gw; pi < T / 2; pi += NGW) { const int m = 2 * pi + half; const RowPos rp = row_pos(m);
        const bool skip = (l == DEPTH - 1) && rp.isctx;
        const LAS float* pm = par + (2 + 3 * rp.modrow) * DM;
        f32x4 yv[8], hv[8], u[8];
#pragma unroll
        for (int j = 0; j < 8; ++j) { yv[j] = MOE ? (an[j] * w1n + bn[j] * w2n) : an[j]; hv[j] = hn[j]; }
        if (pi + NGW < T / 2) R2_LOAD(m + 2 * NGW);
        const float rstd_y = rsqrtf(sumsq_row2(yv) * (1.0f / DM) + NORM_EPS);
#pragma unroll
        for (int j = 0; j < 8; ++j) { if ((j & 3) == 0) __builtin_amdgcn_sched_barrier(0);
            const int c = 128 * j + 4 * l32; const f32x4 g3 = *(const LAS f32x4*)(par + c), gt = *(const LAS f32x4*)(pm + c);
            hv[j] = hv[j] + gt * (yv[j] * rstd_y * g3); }
        if (l == DEPTH - 1) { if (!skip) { float* dsto = out_ptr() + ((size_t)rp.b * SEQ + (rp.p - CTXL)) * DM;
#pragma unroll
                for (int j = 0; j < 8; ++j) *(f32x4*)(dsto + 128 * j + 4 * l32) = hv[j]; } }
        else st_row2_bf16(h + (size_t)m * DM, l32, hv);
        if (l < DEPTH - 1) { const float rstd_h = rsqrtf(sumsq_row2(hv) * (1.0f / DM) + NORM_EPS);
            norm_mod2<false>(hv, rstd_h, par + DM, pm + 1 * DM, pm + 2 * DM, xa + (size_t)m * DM, l32, true, u); }
    }
}
namespace scan {
constexpr int A_STR = 272, T_STR = 80;
constexpr int A1_OFF = 0, A2_OFF = 32 * A_STR, K2T_OFF = 2 * 32 * A_STR, VT_OFF = K2T_OFF + 128 * T_STR, DEC_OFF = VT_OFF + 128 * T_STR, BUF_BYTES = DEC_OFF + 512;
constexpr int NCH = TPB / 32;
__device__ __forceinline__ int crow(int r, int hi) { return (r & 3) + 8 * (r >> 2) + 4 * hi; }
__device__ __forceinline__ int tok_of(int p, int dir) { return dir == 0 ? p : (p < CTXL ? (CTXL - 1 - p) : (TPB + CTXL - 1 - p)); }

__device__ __forceinline__ int chunk_lowtok(int n, int dir) { return dir == 0 ? 32 * n : (n < CTXL / 32 ? CTXL - 32 - 32 * n : TPB + CTXL - 32 - 32 * n); }
constexpr int RAW_OFF = 2 * BUF_BYTES, RAW_BYTES = 3 * 8192;
__device__ __forceinline__ void prep_dma(const bf16_t* __restrict__ z, int b, int hd, int dir, int n, LAS unsigned char* raw, int pw, int lane) {
    const char* U = (const char*)(z + (size_t)(b * TPB + chunk_lowtok(n, dir)) * A_IN + hd * 128);
#pragma unroll
    for (int k = 0; k < 2; ++k) { const int c = 8 * pw + 4 * k + (lane >> 4), mr = dir ? 31 - c : c; const unsigned L = (unsigned)(mr * A_IN + (lane & 15) * 8) * 2u;
        __builtin_amdgcn_global_load_lds((const unsigned*)(U + L), (LAS unsigned*)(raw + 0 * 8192 + (2 * pw + k) * 1024), 16, 0, 0);
        __builtin_amdgcn_global_load_lds((const unsigned*)(U + 2048 * (1 + dir) + L), (LAS unsigned*)(raw + 1 * 8192 + (2 * pw + k) * 1024), 16, 0, 0);
        __builtin_amdgcn_global_load_lds((const unsigned*)(U + 6144 + L), (LAS unsigned*)(raw + 2 * 8192 + (2 * pw + k) * 1024), 16, 0, 0); }
}
struct Raw { unsigned short q[16], f[16], v[16]; };
__device__ __forceinline__ void prep_read(Raw& r, const LAS unsigned char* raw, int d, int rh) {
#pragma unroll
    for (int i = 0; i < 16; ++i) { const int o = (16 * rh + i) * 256 + d * 2;
        r.q[i] = *(const LAS unsigned short*)(raw + o); r.f[i] = *(const LAS unsigned short*)(raw + 8192 + o); r.v[i] = *(const LAS unsigned short*)(raw + 16384 + o); }
}
__device__ __forceinline__ void prep_compute(const Raw& r, float lbv, LAS unsigned char* buf, int d, int rh, int lane) {
    float cum[16], kk[16]; float run = 0.f;
#pragma unroll
    for (int i = 0; i < 16; ++i) { const float s = fast_rcp(1.0f + __builtin_amdgcn_exp2f(bf2f(r.f[i]) * -1.4426950408889634f)); const float f = lbv + (1.0f - lbv) * s; kk[i] = 1.0f - f; run += __builtin_amdgcn_logf(f); cum[i] = run; }
    const float tot_lo = __shfl(run, lane & 31);
    if (rh) {
#pragma unroll
        for (int i = 0; i < 16; ++i) cum[i] += tot_lo; }
    const float cend = __shfl(cum[15], (lane & 31) + 32);
    const float dec = __builtin_amdgcn_exp2f(cend);
    unsigned short a1[16], a2[16], k2[16];
#pragma unroll
    for (int i = 0; i < 16; ++i) { const float e1 = __builtin_amdgcn_exp2f(cum[i]), e2 = __builtin_amdgcn_exp2f(-cum[i]); const float A2 = kk[i] * e2;
        const unsigned w12 = cvt_pk_bf16(bf2f(r.q[i]) * 0.08838834764831845f * e1, A2);
        a1[i] = (unsigned short)(w12 & 0xffffu); a2[i] = (unsigned short)(w12 >> 16); k2[i] = (unsigned short)(cvt_pk_bf16(A2 * dec, 0.f) & 0xffffu); }
#pragma unroll
    for (int i = 0; i < 16; ++i) { const int c = 16 * rh + i;
        *(LAS unsigned short*)(buf + A1_OFF + c * A_STR + d * 2) = a1[i]; *(LAS unsigned short*)(buf + A2_OFF + c * A_STR + d * 2) = a2[i]; }
#pragma unroll
    for (int i = 0; i < 16; i += 2) { const int c = 16 * rh + i;
        *(LAS unsigned*)(buf + K2T_OFF + d * T_STR + c * 2) = (unsigned)k2[i] | ((unsigned)k2[i + 1] << 16);
        *(LAS unsigned*)(buf + VT_OFF + d * T_STR + c * 2) = (unsigned)r.v[i] | ((unsigned)r.v[i + 1] << 16); }
    if (rh == 0) *(LAS float*)(buf + DEC_OFF + d * 4) = dec;
}
#define SCAN_BAR() do { asm volatile("s_waitcnt lgkmcnt(0)" ::: "memory"); __builtin_amdgcn_s_barrier(); asm volatile("" ::: "memory"); } while (0)

__device__ __forceinline__ bf16x8 cvt8(const f32x16& x, int base) {
    u32x4 w; w.x = cvt_pk_bf16(x[base + 0], x[base + 1]); w.y = cvt_pk_bf16(x[base + 2], x[base + 3]); w.z = cvt_pk_bf16(x[base + 4], x[base + 5]); w.w = cvt_pk_bf16(x[base + 6], x[base + 7]);
    return *reinterpret_cast<bf16x8*>(&w);
}
__device__ __forceinline__ bf16x8 ld44(const LAS unsigned char* p) {
    const u32x2 a = *(const LAS u32x2*)p, b = *(const LAS u32x2*)(p + 16); u32x4 w = {a.x, a.y, b.x, b.y}; return *reinterpret_cast<bf16x8*>(&w);
}

__device__ __forceinline__ void scan_unit(unsigned char* ws, LAS unsigned char* lds, int unit, int wave, int lane, int tid) {
    static_assert(NCH % 2 == 0, "even chunk count");
    const int b = unit >> 4, hd = (unit >> 1) & 7, dir = unit & 1;
    const bf16_t* z = (const bf16_t*)(ws + WS_Z);
    bf16_t* od = (bf16_t*)(ws + WS_O) + (size_t)dir * T * DM;
    const float* lb = (const float*)(ws + WS_LB) + dir * 1024 + hd * 128;
    const int r32 = lane & 31, hi = lane >> 5;
    if (wave >= 4) {
        const int pw = wave - 4, d = 32 * pw + r32, rh = hi; const float lbv = lb[d];
        asm volatile("s_waitcnt vmcnt(0)" ::: "memory");
        LAS unsigned char* rawb = lds + RAW_OFF; Raw R;
        prep_dma(z, b, hd, dir, 0, rawb, pw, lane); prep_dma(z, b, hd, dir, 1, rawb + RAW_BYTES, pw, lane);
        asm volatile("s_waitcnt vmcnt(6)" ::: "memory"); SCAN_BAR();
        int st = 0;
        for (int n = -1; n < NCH - 1; ++n) {
            prep_read(R, rawb + st * RAW_BYTES, d, rh); prep_compute(R, lbv, lds + ((n + 1) & 1) * BUF_BYTES, d, rh, lane);
            const int st3 = (st == 0) ? 2 : st - 1;
            if (n + 3 < NCH) { prep_dma(z, b, hd, dir, n + 3, rawb + st3 * RAW_BYTES, pw, lane); asm volatile("s_waitcnt vmcnt(6)" ::: "memory"); }
            else asm volatile("s_waitcnt vmcnt(0)" ::: "memory");
            SCAN_BAR();
            st = (st == 2) ? 0 : st + 1;
        }
        SCAN_BAR();
    } else {
        const int sw = wave;
        f32x16 S[4];
#pragma unroll
        for (int t = 0; t < 4; ++t) S[t] = f32x16{};
        SCAN_BAR(); SCAN_BAR();
        for (int n = 0; n < NCH; ++n) {
            const LAS unsigned char* buf = lds + (n & 1) * BUF_BYTES;
            f32x16 X = f32x16{}, Xb = f32x16{};
#pragma unroll
            for (int ks = 0; ks < 8; ++ks) { const bf16x8 a = *(const LAS bf16x8*)(buf + A2_OFF + r32 * A_STR + (16 * ks + 8 * hi) * 2), bb = *(const LAS bf16x8*)(buf + A1_OFF + r32 * A_STR + (16 * ks + 8 * hi) * 2);
                if (ks & 1) Xb = __builtin_amdgcn_mfma_f32_32x32x16_bf16(a, bb, Xb, 0, 0, 0); else X = __builtin_amdgcn_mfma_f32_32x32x16_bf16(a, bb, X, 0, 0, 0); }
#pragma unroll
            for (int r = 0; r < 16; ++r) X[r] = (crow(r, hi) <= r32) ? X[r] + Xb[r] : 0.f;
            f32x16 O = f32x16{};
#pragma unroll
            for (int s0 = 0; s0 < 2; ++s0) { const bf16x8 a = cvt8(X, 8 * s0); const bf16x8 bb = ld44(buf + VT_OFF + (32 * sw + r32) * T_STR + (16 * s0 + 4 * hi) * 2);
                O = __builtin_amdgcn_mfma_f32_32x32x16_bf16(a, bb, O, 0, 0, 0); }
            f32x16 O2 = f32x16{}, O3 = f32x16{};
#pragma unroll
            for (int t = 0; t < 4; ++t)
#pragma unroll
                for (int s0 = 0; s0 < 2; ++s0) { const bf16x8 a = ld44(buf + A1_OFF + r32 * A_STR + (32 * t + 16 * s0 + 4 * hi) * 2); const bf16x8 bb = cvt8(S[t], 8 * s0);
                    if (t & 1) O3 = __builtin_amdgcn_mfma_f32_32x32x16_bf16(a, bb, O3, 0, 0, 0); else O2 = __builtin_amdgcn_mfma_f32_32x32x16_bf16(a, bb, O2, 0, 0, 0); }
#pragma unroll
            for (int r = 0; r < 16; ++r) O[r] += O2[r] + O3[r];
#pragma unroll
            for (int r = 0; r < 16; ++r) { const int p = 32 * n + crow(r, hi); od[(size_t)(b * TPB + tok_of(p, dir)) * DM + hd * 128 + 32 * sw + r32] = (bf16_t)f2bf(O[r]); }
#pragma unroll
            for (int t = 0; t < 4; ++t) {
#pragma unroll
                for (int g4 = 0; g4 < 4; ++g4) { const f32x4 dc = *(const LAS f32x4*)(buf + DEC_OFF + (32 * t + 8 * g4 + 4 * hi) * 4);
                    S[t][4 * g4 + 0] *= dc.x; S[t][4 * g4 + 1] *= dc.y; S[t][4 * g4 + 2] *= dc.z; S[t][4 * g4 + 3] *= dc.w; }
#pragma unroll
                for (int s0 = 0; s0 < 2; ++s0) { const bf16x8 a = *(const LAS bf16x8*)(buf + K2T_OFF + (32 * t + r32) * T_STR + (16 * s0 + 8 * hi) * 2), bb = *(const LAS bf16x8*)(buf + VT_OFF + (32 * sw + r32) * T_STR + (16 * s0 + 8 * hi) * 2);
                    S[t] = __builtin_amdgcn_mfma_f32_32x32x16_bf16(a, bb, S[t], 0, 0, 0); }
            }
            SCAN_BAR();
        }
    }
}
}

__device__ __forceinline__ void phase_a_readout(Frame& F) {
    const int lane = fresh_lane(), l32 = lane & 31, hh = lane >> 5;
    const int gw = F.vcu * NWAVES + F.wave, NGW = F.G * NWAVES;
    const bf16_t* of = (const bf16_t*)(F.ws + WS_O); const bf16_t* ob = of + (size_t)T * DM; const bf16_t* z = (const bf16_t*)(F.ws + WS_Z); bf16_t* xa = (bf16_t*)(F.ws + WS_XA);
    const f32x4 g = *(const f32x4*)(in_ptr(F, I_A_ONORM) + 4 * l32);
    for (int m = gw; m < T; m += NGW) {
        u32x2 a[4], bb[4], gt[4];
#pragma unroll
        for (int it = 0; it < 4; ++it) { const int c = (2 * it + hh) * 128 + 4 * l32;
            a[it] = *(const u32x2*)(of + (size_t)m * DM + c); bb[it] = *(const u32x2*)(ob + (size_t)m * DM + c); gt[it] = *(const u32x2*)(z + (size_t)m * A_IN + 4096 + c); }
#pragma unroll
        for (int it = 0; it < 4; ++it) { const int c = (2 * it + hh) * 128 + 4 * l32;
            const float o0 = bf2f(a[it].x & 0xffffu) + bf2f(bb[it].x & 0xffffu), o1 = bf2f(a[it].x >> 16) + bf2f(bb[it].x >> 16), o2 = bf2f(a[it].y & 0xffffu) + bf2f(bb[it].y & 0xffffu), o3 = bf2f(a[it].y >> 16) + bf2f(bb[it].y >> 16);
            const float rstd = rsqrtf(half_sum((o0 * o0 + o1 * o1) + (o2 * o2 + o3 * o3)) * (1.0f / 128.0f) + NORM_EPS);
            u32x2 w; w.x = pk2(o0 * rstd * g.x * silu_f(bf2f(gt[it].x & 0xffffu)), o1 * rstd * g.y * silu_f(bf2f(gt[it].x >> 16)));
            w.y = pk2(o2 * rstd * g.z * silu_f(bf2f(gt[it].y & 0xffffu)), o3 * rstd * g.w * silu_f(bf2f(gt[it].y >> 16)));
            *(u32x2*)(xa + (size_t)m * DM + c) = w; }
    }
}

__device__ __forceinline__ f32x2 rope_cs(const float* rt, int kind, int pos, int fi) { return *(const f32x2*)(rt + (((size_t)kind * 64 + pos) * 32 + fi) * 2); }

__device__ __forceinline__ void phase_b_row1(Frame& F) {
    const int lane = fresh_lane();
    const int gw = F.vcu * NWAVES + F.wave, NGW = F.G * NWAVES;
    const bf16_t* z = (const bf16_t*)(F.ws + WS_Z); bf16_t* cq = (bf16_t*)(F.ws + WS_O); bf16_t* ckv = cq + (size_t)T * 384; bf16_t* Kb = (bf16_t*)(F.ws + WS_K);
    const float* qg = in_ptr(F, I_B_QNORM); const float* kg = in_ptr(F, I_B_KVNORM); const float* rt = (const float*)(F.ws + WS_ROPE);
    const int ip = lane & 15, hg = lane >> 4;
    f32x2 qgv[3];
#pragma unroll
    for (int j = 0; j < 3; ++j) qgv[j] = *(const f32x2*)(qg + 128 * j + 2 * lane);
    const f32x4 kgv = *(const f32x4*)(kg + 4 * lane);
    for (int m = gw; m < T; m += NGW) { const RowPos rp = row_pos(m); const bf16_t* zr = z + (size_t)m * B_INP;
        float q[6]; float sq = 0.f;
#pragma unroll
        for (int j = 0; j < 3; ++j) { const unsigned w = *(const unsigned*)(zr + 128 * j + 2 * lane); q[2 * j] = bf2f(w & 0xffffu); q[2 * j + 1] = bf2f(w >> 16); sq += q[2 * j] * q[2 * j] + q[2 * j + 1] * q[2 * j + 1]; }
        const u32x2 kw = *(const u32x2*)(zr + 384 + 4 * lane); const float k0 = bf2f(kw.x & 0xffffu), k1 = bf2f(kw.x >> 16), k2 = bf2f(kw.y & 0xffffu), k3 = bf2f(kw.y >> 16);
        const float skv = (k0 * k0 + k1 * k1) + (k2 * k2 + k3 * k3);
        const float rq = rsqrtf(wave_sum(sq) * (1.0f / 384.0f) + NORM_EPS), rkv = rsqrtf(wave_sum(skv) * (1.0f / 256.0f) + NORM_EPS);
#pragma unroll
        for (int j = 0; j < 3; ++j) { const f32x2 g = qgv[j]; *(unsigned*)(cq + (size_t)m * 384 + 128 * j + 2 * lane) = pk2(q[2 * j] * rq * g.x, q[2 * j + 1] * rq * g.y); }
        { const f32x4 g = kgv; u32x2 w; w.x = pk2(k0 * rkv * g.x, k1 * rkv * g.y); w.y = pk2(k2 * rkv * g.z, k3 * rkv * g.w); *(u32x2*)(ckv + (size_t)m * 256 + 4 * lane) = w; }
        const unsigned rw = *(const unsigned*)(zr + 640 + 2 * ip); float x0 = bf2f(rw & 0xffffu), x1 = bf2f(rw >> 16);
        const float p0 = __shfl_xor(x0, 4), p1 = __shfl_xor(x1, 4);
        if (!rp.isctx) { const int pos = (ip < 8) ? rp.prow : rp.pcol; const f32x2 c0 = rope_cs(rt, 0, pos, (2 * ip) & 7), c1 = rope_cs(rt, 0, pos, (2 * ip + 1) & 7);
            if (ip & 4) { x0 = x0 * c0.x + p0 * c0.y; x1 = x1 * c1.x + p1 * c1.y; } else { x0 = x0 * c0.x - p0 * c0.y; x1 = x1 * c1.x - p1 * c1.y; } }
        const unsigned kb = pk2(x0, x1);
#pragma unroll
        for (int hh = 0; hh < 4; ++hh) { const int hd = 4 * hh + hg; *(unsigned*)(Kb + ((size_t)(rp.b * 16 + hd) * TPB + rp.p) * 96 + 64 + 2 * ip) = kb; }
    }
}
__device__ __forceinline__ void phase_b_row2(Frame& F) {
    const int lane = fresh_lane();
    const int gw = F.vcu * NWAVES + F.wave, NGW = F.G * NWAVES;
    bf16_t* Qb = (bf16_t*)(F.ws + WS_Q); const float* rt = (const float*)(F.ws + WS_ROPE);
    const int ip = lane & 15, hg = lane >> 4;
    for (int m = gw; m < T; m += NGW) { const RowPos rp = row_pos(m); if (rp.isctx) continue;
        const int pos = (ip < 8) ? rp.prow : rp.pcol; const f32x2 c0 = rope_cs(rt, 0, pos, (2 * ip) & 7), c1 = rope_cs(rt, 0, pos, (2 * ip + 1) & 7);
        unsigned w[4];
#pragma unroll
        for (int hh = 0; hh < 4; ++hh) w[hh] = *(const unsigned*)(Qb + (size_t)m * 1536 + (4 * hh + hg) * 96 + 64 + 2 * ip);
#pragma unroll
        for (int hh = 0; hh < 4; ++hh) { float x0 = bf2f(w[hh] & 0xffffu), x1 = bf2f(w[hh] >> 16); const float p0 = __shfl_xor(x0, 4), p1 = __shfl_xor(x1, 4);
            if (ip & 4) { x0 = x0 * c0.x + p0 * c0.y; x1 = x1 * c1.x + p1 * c1.y; } else { x0 = x0 * c0.x - p0 * c0.y; x1 = x1 * c1.x - p1 * c1.y; }
            *(unsigned*)(Qb + (size_t)m * 1536 + (4 * hh + hg) * 96 + 64 + 2 * ip) = pk2(x0, x1); }
    }
}
__device__ __forceinline__ void phase_c_row(Frame& F) {
    const int lane = fresh_lane();
    const int gw = F.vcu * NWAVES + F.wave, NGW = F.G * NWAVES;
    const bf16_t* z = (const bf16_t*)(F.ws + WS_Z); bf16_t* Qb = (bf16_t*)(F.ws + WS_Q); bf16_t* Kb = (bf16_t*)(F.ws + WS_K); bf16_t* Vb = (bf16_t*)(F.ws + WS_V);
    const float* qg = in_ptr(F, I_C_QNORM); const float* kg = in_ptr(F, I_C_KNORM); const float* rt = (const float*)(F.ws + WS_ROPE);
    const f32x2 qgv = *(const f32x2*)(qg + 2 * lane), kgv = *(const f32x2*)(kg + 2 * lane);
    const bool up = (lane & 16) != 0;
    for (int m = gw; m < T; m += NGW) { const RowPos rp = row_pos(m); const bf16_t* zr = z + (size_t)m * C_IN;
        f32x2 c0 = (f32x2){1.f, 0.f}, c1 = (f32x2){1.f, 0.f};
        if (!rp.isctx) { const int pos = (lane < 32) ? rp.prow : rp.pcol; c0 = rope_cs(rt, 2, pos, (2 * lane) & 31); c1 = rope_cs(rt, 2, pos, (2 * lane + 1) & 31); }
        unsigned w[10];
#pragma unroll
        for (int hv = 0; hv < 10; ++hv) w[hv] = *(const unsigned*)(zr + hv * 128 + 2 * lane);
#pragma unroll
        for (int hv = 0; hv < 10; ++hv) { float a = bf2f(w[hv] & 0xffffu), bq = bf2f(w[hv] >> 16);
            const float rstd = rsqrtf(wave_sum(a * a + bq * bq) * (1.0f / 128.0f) + NORM_EPS);
            a *= rstd * (hv < 8 ? qgv.x : kgv.x); bq *= rstd * (hv < 8 ? qgv.y : kgv.y);
            const float ap = __shfl_xor(a, 16), bp = __shfl_xor(bq, 16);
            const float ar = up ? (a * c0.x + ap * c0.y) : (a * c0.x - ap * c0.y), br = up ? (bq * c1.x + bp * c1.y) : (bq * c1.x - bp * c1.y);
            bf16_t* dst = (hv < 8) ? Qb + (size_t)m * 1024 + hv * 128 : Kb + (size_t)m * 256 + (hv - 8) * 128;
            *(unsigned*)(dst + 2 * lane) = pk2(ar, br); }
        *(u32x2*)(Vb + (size_t)m * 256 + 4 * lane) = *(const u32x2*)(zr + 1280 + 4 * lane);
    }
}
__device__ __forceinline__ void phase_d_row1(Frame& F) {
    const int lane = fresh_lane();
    const int gw = F.vcu * NWAVES + F.wave, NGW = F.G * NWAVES;
    const bf16_t* z = (const bf16_t*)(F.ws + WS_Z); bf16_t* Qb = (bf16_t*)(F.ws + WS_Q); bf16_t* Kb = (bf16_t*)(F.ws + WS_K); bf16_t* Vb = (bf16_t*)(F.ws + WS_V);
    const float* rt = (const float*)(F.ws + WS_ROPE);
    const int lp = lane & 31; const bool up = (lane & 8) != 0;
    for (int m = gw; m < T; m += NGW) { const RowPos rp = row_pos(m); const bf16_t* zr = z + (size_t)m * D_IN;
        f32x2 c0 = (f32x2){1.f, 0.f}, c1 = (f32x2){1.f, 0.f};
        if (!rp.isctx) { const int pos = (lp < 16) ? rp.prow : rp.pcol; c0 = rope_cs(rt, 1, pos, (2 * lp) & 15); c1 = rope_cs(rt, 1, pos, (2 * lp + 1) & 15); }
        unsigned w[16];
#pragma unroll
        for (int i = 0; i < 16; ++i) w[i] = *(const unsigned*)(zr + 128 * i + 2 * lane);
#pragma unroll
        for (int i = 0; i < 16; ++i) { const float a = bf2f(w[i] & 0xffffu), bq = bf2f(w[i] >> 16); const float ap = __shfl_xor(a, 8), bp = __shfl_xor(bq, 8);
            const float ar = up ? (a * c0.x + ap * c0.y) : (a * c0.x - ap * c0.y), br = up ? (bq * c1.x + bp * c1.y) : (bq * c1.x - bp * c1.y);
            bf16_t* dst = (i < 8) ? Qb + (size_t)m * 1024 + 128 * i : Kb + (size_t)m * 1024 + 128 * (i - 8); *(unsigned*)(dst + 2 * lane) = pk2(ar, br); }
        { const u32x4 a = *(const u32x4*)(zr + 2048 + 16 * lane), bq = *(const u32x4*)(zr + 2048 + 16 * lane + 8); *(u32x4*)(Vb + (size_t)m * 1024 + 16 * lane) = a; *(u32x4*)(Vb + (size_t)m * 1024 + 16 * lane + 8) = bq; }
    }
}
__device__ __forceinline__ void phase_d_row2(Frame& F) {
    const int lane = fresh_lane(), l32 = lane & 31, hh = lane >> 5;
    const int gw = F.vcu * NWAVES + F.wave, NGW = F.G * NWAVES;
    const bf16_t* A = (const bf16_t*)(F.ws + WS_O); bf16_t* xa = (bf16_t*)(F.ws + WS_XA);
    const float* lam = in_ptr(F, I_D_LAMBDA);
    const float lambda_init = 0.8f - 0.6f * 0.40656965974059917f;
    const float s1 = wave_sum(lam[lane] * lam[64 + lane]), s2 = wave_sum(lam[128 + lane] * lam[192 + lane]);
    const float lam_full = expf(s1) - expf(s2) + lambda_init;
    const f32x4 g = *(const f32x4*)(in_ptr(F, I_D_ONORM) + 4 * l32) * (1.0f - lambda_init);
    for (int m = gw; m < T; m += NGW) { if ((m % TPB) < CTXL) continue;
        u32x2 a[4], bb[4];
#pragma unroll
        for (int it = 0; it < 4; ++it) { const int hd = 2 * it + hh; a[it] = *(const u32x2*)(A + (size_t)m * 2048 + (2 * hd) * 128 + 4 * l32); bb[it] = *(const u32x2*)(A + (size_t)m * 2048 + (2 * hd + 1) * 128 + 4 * l32); }
#pragma unroll
        for (int it = 0; it < 4; ++it) { const int hd = 2 * it + hh;
            const float o0 = bf2f(a[it].x & 0xffffu) - lam_full * bf2f(bb[it].x & 0xffffu), o1 = bf2f(a[it].x >> 16) - lam_full * bf2f(bb[it].x >> 16);
            const float o2 = bf2f(a[it].y & 0xffffu) - lam_full * bf2f(bb[it].y & 0xffffu), o3 = bf2f(a[it].y >> 16) - lam_full * bf2f(bb[it].y >> 16);
            const float rstd = rsqrtf(half_sum((o0 * o0 + o1 * o1) + (o2 * o2 + o3 * o3)) * (1.0f / 128.0f) + NORM_EPS);
            u32x2 w; w.x = pk2(o0 * rstd * g.x, o1 * rstd * g.y); w.y = pk2(o2 * rstd * g.z, o3 * rstd * g.w);
            *(u32x2*)(xa + (size_t)m * DM + hd * 128 + 4 * l32) = w; }
    }
}

#ifndef MK_STAG
#define MK_STAG 1
#endif
#define MK_SPLITKV 0
#define MK_PRE_B 1
#define MK_PRE_C 1
#define MK_PRE_D 1
#define MK_PRE(DK) (MK_STAG && ((DK) == 96 ? MK_PRE_B : (DK) == 128 ? MK_PRE_C : MK_PRE_D))
template <int DK, int DV, int ldq, int ldk, int ldv, int ldo, int H, int GK, int GV>
__device__ __forceinline__ void attn_phase(Frame& F, const bf16_t* Q, const bf16_t* K, const bf16_t* V, bf16_t* O, float scale, bool skip_ctx, int dup = 1) {
    const float C = scale * 1.4426950408889634f, thr_raw = att::THR / scale;
    const int NHV = NBATCH * H * 16, NCTX = skip_ctx ? 0 : NBATCH * H;
    const int LO = NHV % F.G, NFULL = NHV - LO; int SF = 1;
    if (MK_SPLITKV && dup == 1 && LO > 0 && F.G % LO == 0) { const int q = F.G / LO; if (q == 2 || q == 4) SF = q; }
    const int NPART = (SF > 1) ? LO * SF : 0, NLAT = (SF > 1) ? NFULL : NHV, NTOT = NLAT + NPART + NCTX;
    float* PO = (float*)(F.ws + WS_YS); float* PML = PO + (size_t)256 * 256 * 128;
    for (int L0 = F.vcu; L0 < NTOT * dup; L0 += F.G) { const int L = (dup > 1) ? L0 % NTOT : L0;
        int b, hd, qb, part = -1, U = L;
        if (L >= NLAT && L < NLAT + NPART) { const int j = L - NLAT; U = NFULL + j / SF; part = j % SF; }
        if (L < NLAT + NPART) { const int grp = U >> 4; b = grp / H; hd = grp % H; qb = 1 + (U & 15); } else { const int L2 = L - NLAT - NPART; b = L2 / H; hd = L2 % H; qb = 0; }
        const size_t row0 = (size_t)b * TPB + (size_t)qb * 256; const bf16_t* Kh = K + (size_t)(b * (H / GK) + hd / GK) * TPB * DK; const bf16_t* Vh = V + (size_t)(b * (H / GV) + hd / GV) * TPB * DV;
        if (part >= 0) { const int klen = TPB / SF, j = L - NLAT;
            att::attn_unit_stag<DK, DV, ldq, DK, DV, ldo, MK_PRE(DK) != 0, false, true>(Q + row0 * ldq + hd * DK, Kh + (size_t)part * klen * DK, Vh + (size_t)part * klen * DV, nullptr,
                               klen, C, thr_raw, (char*)F.lds, F.wave, PO + (size_t)j * 256 * DV, PML + (size_t)j * 256 * 2); }
        else
        att::attn_unit_stag<DK, DV, ldq, DK, DV, ldo, MK_PRE(DK) != 0, false>(Q + row0 * ldq + hd * DK, Kh, Vh, O + row0 * ldo + hd * DV,
                               qb == 0 ? CTXL : TPB, C, thr_raw, (char*)F.lds, F.wave);
    }
    __syncthreads();
}
template <int DV, int ldo, int H>
__device__ __forceinline__ void attn_merge(Frame& F, bf16_t* O) {
    const int NHV = NBATCH * H * 16, LO = NHV % F.G, NFULL = NHV - LO; int SF = 1;
    if (LO > 0 && F.G % LO == 0) { const int q = F.G / LO; if (q == 2 || q == 4) SF = q; }
    if (SF == 1) return;
    const float* PO = (const float*)(F.ws + WS_YS); const float* PML = PO + (size_t)256 * 256 * 128;
    const int lane = fresh_lane(), gw = F.vcu * NWAVES + F.wave, NGW = F.G * NWAVES;
    for (int it = gw; it < LO * 256; it += NGW) { const int u = it >> 8, r = it & 255, U = NFULL + u;
        const int grp = U >> 4, b = grp / H, hd = grp % H, qb = 1 + (U & 15);
        float mi[4], li[4], m = -3.0e38f;
#pragma unroll
        for (int i = 0; i < 4; ++i) { if (i < SF) { const f32x2 ml = *(const f32x2*)(PML + ((size_t)(u * SF + i) * 256 + r) * 2); mi[i] = ml.x; li[i] = ml.y; m = fmaxf(m, ml.x); } else { mi[i] = 0.f; li[i] = 0.f; } }
        float l = 0.f, w[4];
#pragma unroll
        for (int i = 0; i < 4; ++i) { w[i] = (i < SF) ? __builtin_amdgcn_exp2f(mi[i] - m) : 0.f; l += w[i] * li[i]; }
        const float rl = 1.0f / l;
        bf16_t* orow = O + ((size_t)b * TPB + (size_t)qb * 256 + r) * ldo + hd * DV;
#pragma unroll
        for (int c0 = 0; c0 < DV; c0 += 64) { float acc = 0.f;
#pragma unroll
            for (int i = 0; i < 4; ++i) if (i < SF) acc += w[i] * PO[((size_t)(u * SF + i) * 256 + r) * DV + c0 + lane];
            orow[c0 + lane] = (bf16_t)f2bf(acc * rl); } }
}
#ifndef MK_MULTI
#define MK_MULTI 0
#endif
constexpr int NPHASE = 37;
#ifndef MK_REP_MASK
#define MK_REP_MASK 0ull
#endif
#ifndef MK_REP_N
#define MK_REP_N 1
#endif
#ifndef MK_DUP
#define MK_DUP -1
#endif
#define DUPF(k) ((k) == MK_DUP ? 2 : 1)
#ifndef MK_LIMIT
#define MK_LIMIT 37
#endif
struct Args { const float* in[N_IN]; float* out; unsigned char* ws; int ph_lo, ph_hi; };

__device__ __forceinline__ void gemm_plain_f32(Frame& F, const bf16_t* A, const bf16_t* Bt, int N, int K, float* C, int ldc, int dup = 1) {
    pg8::Gemm g{A, Bt, K / 64, N, K, 0, nullptr, 0, nullptr}; pg8::StaticOrder S; S.init(T / 256, N / 256, F.G, (int)blockIdx.x, dup); pg8::EpiF32 E{C, ldc};
    pg8::gemm_phase<pg8::EpiF32, pg8::StaticOrder, false>(F.lds, g, S, E, F.wave);
}
__device__ __forceinline__ void gemm_plain_bf16(Frame& F, const bf16_t* A, const bf16_t* Bt, int N, int K, bf16_t* C, int ldc, int dup = 1) {
    pg8::Gemm g{A, Bt, K / 64, N, K, 0, nullptr, 0, nullptr}; pg8::StaticOrder S; S.init(T / 256, N / 256, F.G, (int)blockIdx.x, dup); pg8::EpiBf16 E{C, ldc};
    pg8::gemm_phase<pg8::EpiBf16, pg8::StaticOrder, false>(F.lds, g, S, E, F.wave);
}
template <int S>
__device__ __forceinline__ void gemm_n1024(Frame& F, const bf16_t* A, const bf16_t* Bt, int K, bool skip_ctx, int dup = 1) {
    { pg8::Gemm g{A, Bt, K / 64, DM, K, 0, nullptr, 0, nullptr}; pg8::LatOrder S1; S1.so.init(128, DM / 256, F.G, (int)blockIdx.x, dup); pg8::EpiBf16 E{(bf16_t*)(F.ws + WS_Y), DM};
      pg8::gemm_phase<pg8::EpiBf16, pg8::LatOrder, false>(F.lds, g, S1, E, F.wave); }
    if (!skip_ctx) { pg8::Gemm g{A, Bt, K / 64 / S, DM, K, 0, nullptr, 0, nullptr}; pg8::CtxSplitOrder S2{DM / 256, S, K / 64 / S, F.G, (int)blockIdx.x, dup}; pg8::EpiF32 E{(float*)(F.ws + WS_YS), DM};
      pg8::gemm_phase<pg8::EpiF32, pg8::CtxSplitOrder, false>(F.lds, g, S2, E, F.wave); }
}
__device__ __forceinline__ void gemm_swiglu(Frame& F, const bf16_t* A, const bf16_t* Bt, bf16_t* C, int dup = 1) {
    pg8::Gemm g{A, Bt, DM / 128, 2 * FF, DM / 2, 0, nullptr, 0, nullptr}; pg8::StaticOrder S; S.init(T / 256, 2 * FF / 256, F.G, (int)blockIdx.x, dup); pg8::EpiSwiglu E{C, FF, 1.0f / 32.0f};
    pg8::gemm_phase<pg8::EpiSwiglu, pg8::StaticOrder, false, true>(F.lds, g, S, E, F.wave);
}
__device__ __forceinline__ void gemm_moe_gu(Frame& F, int lm, int dup = 1) {
    moe_tables(F, 2 * lm + 1);
    pg8::Gemm g{(const bf16_t*)(F.ws + WS_XA), (const bf16_t*)(F.ws + WS_MOE_GU + (size_t)lm * 8 * SZ_GU), DM / 128, 2 * FF, DM / 2, (size_t)2 * FF * DM / 2, (const int*)(F.ws + WS_LIST), T, (const LAS int*)(F.MISC + 32)};
    pg8::MoeOrder S; S.so.init((int)F.MISC[24], 2 * FF / 256, F.G, (int)blockIdx.x, dup); S.rb0 = (const LAS int*)(F.MISC + 16); pg8::EpiSwiglu E{(bf16_t*)(F.ws + WS_ACT), FF, 1.0f / 32.0f};
    pg8::gemm_phase<pg8::EpiSwiglu, pg8::MoeOrder, true, true>(F.lds, g, S, E, F.wave);
}
__device__ __forceinline__ void gemm_moe_down(Frame& F, int lm, int dup = 1) {
    moe_tables(F, 2 * lm + 1);
    int RBM, trb, S; pg8::moe_tail_params((int)F.MISC[24], RBM, trb, S);
    const bf16_t* A = (const bf16_t*)(F.ws + WS_ACT); const bf16_t* Bt = (const bf16_t*)(F.ws + WS_MOE_DN + (size_t)lm * 8 * SZ_DN);
    { pg8::Gemm g{A, Bt, FF / 64, DM, FF, (size_t)DM * FF, nullptr, 0, nullptr};
      pg8::MoeOrder S1; S1.so.init(RBM, DM / 256, F.G, (int)blockIdx.x, dup); S1.rb0 = (const LAS int*)(F.MISC + 16); pg8::EpiBf16 E{(bf16_t*)(F.ws + WS_YP), DM};
      pg8::gemm_phase<pg8::EpiBf16, pg8::MoeOrder, false>(F.lds, g, S1, E, F.wave); }
    if (trb > 0) { pg8::Gemm g{A, Bt, FF / 64 / S, DM, FF, (size_t)DM * FF, nullptr, 0, nullptr};
      pg8::MoeTailOrder S2{RBM, trb, S, FF / 64 / S, F.G, (int)blockIdx.x, dup, (const LAS int*)(F.MISC + 16)}; pg8::EpiF32 E{(float*)(F.ws + WS_YS), DM};
      pg8::gemm_phase<pg8::EpiF32, pg8::MoeTailOrder, false>(F.lds, g, S2, E, F.wave); }
}
__device__ __forceinline__ void xcd_or_nothing(const XcdBarrier& b, int wave) { if (!MK_MULTI) xcd_barrier(b, wave); }
__global__ void __launch_bounds__(NWAVES * 64, 2) fwd_kernel(Args args) {
    extern __shared__ __attribute__((aligned(16))) unsigned char lds_raw[];
    Frame F;
    F.lds = (LAS unsigned char*)lds_raw; F.MISC = (volatile LAS unsigned*)(F.lds + MISC_OFF);
    F.wave = __builtin_amdgcn_readfirstlane((int)threadIdx.x >> 6);
    F.G = gridDim.x; { const int bx = blockIdx.x; F.vcu = (F.G % 8 == 0) ? (bx % 8) * (F.G / 8) + bx / 8 : bx; }
    F.ws = args.ws;
    for (int u = threadIdx.x; u < 256; u += NWAVES * 64) ((LAS unsigned*)(F.lds + MISC_OFF))[u] = 0u;
    __syncthreads();
    XcdBarrier bar; bar.bar = (unsigned*)((unsigned*)F.ws + CW_BAR); bar.x = 0; bar.st = nullptr;
    if (!MK_MULTI) bar = xcd_barrier_post((unsigned*)((unsigned*)F.ws + CW_BAR), F.MISC + 0);
    const int lo = args.ph_lo, hi = args.ph_hi;
#define IN(k) (lo <= (k) && (k) < hi)
#define NREP(k) ((((unsigned long long)(MK_REP_MASK) >> (k)) & 1ull) ? (1 + MK_REP_N) : 1)
#define SEAM(k) do { if (!MK_MULTI && IN((k) + 1)) xcd_barrier(bar, F.wave); } while (0)
    unsigned char* ws = F.ws;
    bf16_t* XA = (bf16_t*)(ws + WS_XA); bf16_t* Y = (bf16_t*)(ws + WS_Y); bf16_t* ACT = (bf16_t*)(ws + WS_ACT);
    bf16_t* Qb = (bf16_t*)(ws + WS_Q); bf16_t* Kb = (bf16_t*)(ws + WS_K); bf16_t* Vb = (bf16_t*)(ws + WS_V); bf16_t* Ob = (bf16_t*)(ws + WS_O);

    if (IN(0)) { for (int rep = 0; rep < NREP(0); ++rep) { p0_prologue(F); if (rep + 1 < NREP(0)) xcd_or_nothing(bar, F.wave); } SEAM(0); }
    if (IN(1)) { for (int rep = 0; rep < NREP(1); ++rep) { for (int d2 = 0; d2 < DUPF(1); ++d2) { phase_r0(F); } if (rep + 1 < NREP(1)) xcd_or_nothing(bar, F.wave); } SEAM(1); }
    if (IN(2)) { for (int rep = 0; rep < NREP(2); ++rep) { gemm_plain_bf16(F, XA, (const bf16_t*)(ws + WS_WA_IN), A_IN, DM, (bf16_t*)(ws + WS_Z), A_IN, DUPF(2)); if (rep + 1 < NREP(2)) xcd_or_nothing(bar, F.wave); } SEAM(2); }
    if (IN(3)) { for (int rep = 0; rep < NREP(3); ++rep) { if ((int)blockIdx.x < NBATCH * 8 * 2) { for (int d2 = 0; d2 < DUPF(3); ++d2) { const int ln = fresh_lane(); scan::scan_unit(ws, F.lds, (int)blockIdx.x, F.wave, ln, F.wave * 64 + ln); __syncthreads(); } }
        else if (rep == 0) { const int nidle = F.G - NBATCH * 8 * 2; p0_convert(F, p0_split_item(), g_mats.item0[NMAT], ((int)blockIdx.x - NBATCH * 8 * 2) * NWAVES + F.wave, nidle * NWAVES, fresh_lane()); } if (rep + 1 < NREP(3)) xcd_or_nothing(bar, F.wave); } SEAM(3); }
    if (IN(4)) { for (int rep = 0; rep < NREP(4); ++rep) { for (int d2 = 0; d2 < DUPF(4); ++d2) { phase_a_readout(F); } if (rep + 1 < NREP(4)) xcd_or_nothing(bar, F.wave); } SEAM(4); }
    if (IN(5)) { for (int rep = 0; rep < NREP(5); ++rep) { gemm_n1024<4>(F, XA, (const bf16_t*)(ws + WS_WA_OUT), DM, false, DUPF(5)); if (rep + 1 < NREP(5)) xcd_or_nothing(bar, F.wave); } SEAM(5); }
    if (IN(6)) { for (int rep = 0; rep < NREP(6); ++rep) { phase_r1<false>(F, 0); if (rep + 1 < NREP(6)) xcd_or_nothing(bar, F.wave); } SEAM(6); }
    if (IN(7)) { for (int rep = 0; rep < NREP(7); ++rep) { gemm_swiglu(F, XA, (const bf16_t*)(ws + WS_FFN_GU), ACT, DUPF(7)); if (rep + 1 < NREP(7)) xcd_or_nothing(bar, F.wave); } SEAM(7); }
    if (IN(8)) { for (int rep = 0; rep < NREP(8); ++rep) { gemm_n1024<4>(F, ACT, (const bf16_t*)(ws + WS_FFN_DN), FF, false, DUPF(8)); if (rep + 1 < NREP(8)) xcd_or_nothing(bar, F.wave); } SEAM(8); }
    if (IN(9)) { for (int rep = 0; rep < NREP(9); ++rep) { phase_r2<false>(F, 0); if (rep + 1 < NREP(9)) xcd_or_nothing(bar, F.wave); } SEAM(9); }
    if (IN(10)) { for (int rep = 0; rep < NREP(10); ++rep) { gemm_plain_bf16(F, XA, (const bf16_t*)(ws + WS_WB_IN), B_INP, DM, (bf16_t*)(ws + WS_Z), B_INP, DUPF(10)); if (rep + 1 < NREP(10)) xcd_or_nothing(bar, F.wave); } SEAM(10); }
    if (IN(11)) { for (int rep = 0; rep < NREP(11); ++rep) { for (int d2 = 0; d2 < DUPF(11); ++d2) { phase_b_row1(F); } if (rep + 1 < NREP(11)) xcd_or_nothing(bar, F.wave); } SEAM(11); }
    if (IN(12)) {
        { pg8::Gemm g{Ob, (const bf16_t*)(ws + WS_WB_QB), 384 / 64, 1536, 384, 0, nullptr, 0, nullptr}; pg8::StaticOrder S; S.init(T / 256, 1536 / 256, F.G, (int)blockIdx.x); pg8::EpiRopeB E{Qb, (const float*)(ws + WS_ROPE), MK_PRE(96) ? 0.10206207261596575f * 1.4426950408889634f : 1.0f};
          pg8::gemm_phase<pg8::EpiRopeB, pg8::StaticOrder, false>(F.lds, g, S, E, F.wave); }
        { pg8::Gemm g{Ob + (size_t)T * 384, (const bf16_t*)(ws + WS_WB_KVB), 256 / 64, 2048, 256, 0, nullptr, 0, nullptr}; pg8::StaticOrder S; S.init(T / 256, 2048 / 256, F.G, (int)blockIdx.x); pg8::EpiKV E{Kb, 1536, Vb, 1024};
          pg8::gemm_phase<pg8::EpiKV, pg8::StaticOrder, false>(F.lds, g, S, E, F.wave); }
        SEAM(12); }
    if (IN(13)) { for (int rep = 0; rep < NREP(13); ++rep) { attn_phase<96, 64, 1536, 1536, 1024, DM, 16, 1, 1>(F, Qb, Kb, Vb, XA, 0.10206207261596575f, false, DUPF(13)); if (rep + 1 < NREP(13)) xcd_or_nothing(bar, F.wave); } SEAM(13); }
    if (IN(14)) { for (int rep = 0; rep < NREP(14); ++rep) { gemm_n1024<4>(F, XA, (const bf16_t*)(ws + WS_WB_OUT), DM, false, DUPF(14)); if (rep + 1 < NREP(14)) xcd_or_nothing(bar, F.wave); } SEAM(14); }
    if (IN(15)) { for (int rep = 0; rep < NREP(15); ++rep) { phase_r1<true>(F, 1); if (rep + 1 < NREP(15)) xcd_or_nothing(bar, F.wave); } SEAM(15); }
    if (IN(16)) { moe_build(F); SEAM(16); }
    if (IN(17)) { for (int rep = 0; rep < NREP(17); ++rep) { gemm_moe_gu(F, 0, DUPF(17)); if (rep + 1 < NREP(17)) xcd_or_nothing(bar, F.wave); } SEAM(17); }
    if (IN(18)) { for (int rep = 0; rep < NREP(18); ++rep) { gemm_moe_down(F, 0, DUPF(18)); if (rep + 1 < NREP(18)) xcd_or_nothing(bar, F.wave); } SEAM(18); }
    if (IN(19)) { for (int rep = 0; rep < NREP(19); ++rep) { moe_tables(F, 1); phase_r2<true>(F, 1); if (rep + 1 < NREP(19)) xcd_or_nothing(bar, F.wave); } SEAM(19); }
    if (IN(20)) { { pg8::Gemm g{XA, (const bf16_t*)(ws + WS_WC_IN), DM / 64, C_IN, DM, 0, nullptr, 0, nullptr}; pg8::StaticOrder S; S.init(T / 256, C_IN / 256, F.G, (int)blockIdx.x, DUPF(20));
          pg8::EpiNormRopeC E{Qb, Kb, Vb, in_ptr(F, I_C_QNORM), in_ptr(F, I_C_KNORM), (const float*)(ws + WS_ROPE) + (size_t)2 * 64 * 32 * 2, (LAS float*)(F.lds + pg8::STAGE_BYTES + 2048), MK_PRE(128) ? 0.08838834764831845f * 1.4426950408889634f : 1.0f};
          pg8::gemm_phase<pg8::EpiNormRopeC, pg8::StaticOrder, false>(F.lds, g, S, E, F.wave); } }
    if (IN(21)) { SEAM(21); }
    if (IN(22)) { for (int rep = 0; rep < NREP(22); ++rep) { attn_phase<128, 128, 1024, 256, 256, DM, 8, 4, 4>(F, Qb, Kb, Vb, XA, 0.08838834764831845f, false, DUPF(22)); if (rep + 1 < NREP(22)) xcd_or_nothing(bar, F.wave); } SEAM(22); }
    if (IN(23)) { for (int rep = 0; rep < NREP(23); ++rep) { gemm_n1024<4>(F, XA, (const bf16_t*)(ws + WS_WC_OUT), DM, false, DUPF(23)); if (rep + 1 < NREP(23)) xcd_or_nothing(bar, F.wave); } SEAM(23); }
    if (IN(24)) { for (int rep = 0; rep < NREP(24); ++rep) { phase_r1<false>(F, 2); if (rep + 1 < NREP(24)) xcd_or_nothing(bar, F.wave); } SEAM(24); }
    if (IN(25)) { for (int rep = 0; rep < NREP(25); ++rep) { gemm_swiglu(F, XA, (const bf16_t*)(ws + WS_FFN_GU + SZ_GU), ACT, DUPF(25)); if (rep + 1 < NREP(25)) xcd_or_nothing(bar, F.wave); } SEAM(25); }
    if (IN(26)) { for (int rep = 0; rep < NREP(26); ++rep) { gemm_n1024<4>(F, ACT, (const bf16_t*)(ws + WS_FFN_DN + SZ_DN), FF, false, DUPF(26)); if (rep + 1 < NREP(26)) xcd_or_nothing(bar, F.wave); } SEAM(26); }
    if (IN(27)) { for (int rep = 0; rep < NREP(27); ++rep) { phase_r2<false>(F, 2); if (rep + 1 < NREP(27)) xcd_or_nothing(bar, F.wave); } SEAM(27); }
    if (IN(28)) { { pg8::Gemm g{XA, (const bf16_t*)(ws + WS_WD_IN), DM / 64, D_IN, DM, 0, nullptr, 0, nullptr}; pg8::StaticOrder S; S.init(T / 256, D_IN / 256, F.G, (int)blockIdx.x, DUPF(28));
          pg8::EpiRopeD E{Qb, Kb, Vb, (const float*)(ws + WS_ROPE) + (size_t)1 * 64 * 32 * 2, MK_PRE(64) ? 0.125f * 1.4426950408889634f : 1.0f};
          pg8::gemm_phase<pg8::EpiRopeD, pg8::StaticOrder, false>(F.lds, g, S, E, F.wave); } SEAM(28); }
    if (IN(29)) { for (int rep = 0; rep < NREP(29); ++rep) { attn_phase<64, 128, 1024, 1024, 1024, 2048, 16, 1, 2>(F, Qb, Kb, Vb, Ob, 0.125f, true, DUPF(29)); if (rep + 1 < NREP(29)) xcd_or_nothing(bar, F.wave); } SEAM(29); }
    if (IN(30)) { for (int rep = 0; rep < NREP(30); ++rep) { for (int d2 = 0; d2 < DUPF(30); ++d2) { phase_d_row2(F); } if (rep + 1 < NREP(30)) xcd_or_nothing(bar, F.wave); } SEAM(30); }
    if (IN(31)) { for (int rep = 0; rep < NREP(31); ++rep) { gemm_n1024<4>(F, XA, (const bf16_t*)(ws + WS_WD_OUT), DM, true, DUPF(31)); if (rep + 1 < NREP(31)) xcd_or_nothing(bar, F.wave); } SEAM(31); }
    if (IN(32)) { for (int rep = 0; rep < NREP(32); ++rep) { phase_r1<true>(F, 3); if (rep + 1 < NREP(32)) xcd_or_nothing(bar, F.wave); } SEAM(32); }
    if (IN(33)) { moe_build(F); SEAM(33); }
    if (IN(34)) { for (int rep = 0; rep < NREP(34); ++rep) { gemm_moe_gu(F, 1, DUPF(34)); if (rep + 1 < NREP(34)) xcd_or_nothing(bar, F.wave); } SEAM(34); }
    if (IN(35)) { for (int rep = 0; rep < NREP(35); ++rep) { gemm_moe_down(F, 1, DUPF(35)); if (rep + 1 < NREP(35)) xcd_or_nothing(bar, F.wave); } SEAM(35); }
    if (IN(36)) { moe_tables(F, 3); phase_r2<true>(F, 3); }
#if MK_LIMIT < 37
    {
        xcd_barrier(bar, F.wave);
        float* outp = out_ptr(); const int tid = F.wave * 64 + fresh_lane();
#if MK_LIMIT == 34 || MK_LIMIT == 35 || MK_LIMIT == 36
        moe_tables(F, 3);
        int RBM, trb, S; pg8::moe_tail_params((int)F.MISC[24], RBM, trb, S);
#endif
        for (int r = (int)blockIdx.x; r < NBATCH * SEQ; r += F.G) { const int b = r / SEQ, l = r % SEQ; const size_t m = (size_t)b * TPB + CTXL + l;
#if MK_LIMIT == 34
            const int* route = (const int*)(ws + WS_ROUTE); const int* list = (const int*)(ws + WS_LIST);
            const int e1 = route[m * 8], s1 = route[m * 8 + 1], e2 = route[m * 8 + 2], s2 = route[m * 8 + 3];
            const unsigned char* xa8 = (const unsigned char*)(ws + WS_XA) + m * DM;
            for (int c = tid; c < DM; c += NWAVES * 64) { float v = 0.f;
                if (c >= 512) v = (float)((unsigned)xa8[2 * (c - 512)] + 256u * (unsigned)xa8[2 * (c - 512) + 1]); else
                if (c < 4) v = (float)route[m * 8 + c]; else if (c < 6) v = ((const float*)route)[m * 8 + c]; else if (c == 6) v = (float)(list[(size_t)e1 * T + s1] - (int)m); else if (c == 7) v = (float)(list[(size_t)e2 * T + s2] - (int)m);
                else if (c < 16) v = (float)F.MISC[16 + (c - 8)]; else if (c < 24) v = (float)F.MISC[32 + (c - 16)]; else if (c == 24) v = (float)F.MISC[24];
                outp[(size_t)r * DM + c] = v; }
#elif MK_LIMIT == 35
            const int* route = (const int*)(ws + WS_ROUTE); const bf16_t* act = (const bf16_t*)(ws + WS_ACT);
            const size_t r1 = (size_t)F.MISC[16 + route[m * 8]] * 256 + route[m * 8 + 1], r2 = (size_t)F.MISC[16 + route[m * 8 + 2]] * 256 + route[m * 8 + 3];
            for (int c = tid; c < DM; c += NWAVES * 64) { float v = 0.f;
                for (int q = 0; q < 4; ++q) { const int cc = c + q * DM; if (cc < FF) v += bf2f((unsigned)act[r1 * FF + cc]) + 2.0f * bf2f((unsigned)act[r2 * FF + cc]); }
                outp[(size_t)r * DM + c] = v; }
#elif MK_LIMIT == 36
            const int* route = (const int*)(ws + WS_ROUTE);
            const size_t r1 = (size_t)F.MISC[16 + route[m * 8]] * 256 + route[m * 8 + 1], r2 = (size_t)F.MISC[16 + route[m * 8 + 2]] * 256 + route[m * 8 + 3];
            for (int c = tid; c < DM; c += NWAVES * 64) { float v = 0.f;
                for (int k = 0; k < 2; ++k) { const size_t rr = k ? r2 : r1; const int rb = (int)(rr >> 8); float a = 0.f;
                    if (rb >= RBM) { const float* ys = (const float*)(ws + WS_YS) + ((size_t)(rb - RBM) * 256 + (rr & 255)) * DM; for (int s2 = 0; s2 < S; ++s2) a += ys[(size_t)s2 * trb * 256 * DM + c]; }
                    else a = bf2f((unsigned)((const bf16_t*)(ws + WS_YP))[rr * DM + c]);
                    v += (k ? 2.0f : 1.0f) * a; }
                outp[(size_t)r * DM + c] = v; }
#else
            const bf16_t* hh = (const bf16_t*)(ws + WS_H); const size_t src = m * DM;
            for (int c = tid; c < DM; c += NWAVES * 64) outp[(size_t)r * DM + c] = bf2f((unsigned)hh[src + c]);
#endif
        }
    }
#endif
#undef IN
#undef SEAM
}

extern "C" void kernel_launch(void* const* d_in, const int* in_sizes, int n_in, void* d_out, int out_size, void* d_ws, size_t ws_size, hipStream_t stream) {
    static int grid = 0;
    if (grid == 0) {
        if (n_in != N_IN || out_size != NBATCH * SEQ * DM || ws_size < WS_END) { fprintf(stderr, "kernel_launch: unexpected shapes: n_in %d out %d ws %zu (need %zu)\n", n_in, out_size, ws_size, (size_t)WS_END); grid = -1; return; }
        int dev = 0, cus = 0, per_cu = 0;
        if (hipGetDevice(&dev) != hipSuccess || hipDeviceGetAttribute(&cus, hipDeviceAttributeMultiprocessorCount, dev) != hipSuccess) { grid = -1; return; }
        if (hipFuncSetAttribute((const void*)fwd_kernel, hipFuncAttributeMaxDynamicSharedMemorySize, LDS_BYTES) != hipSuccess) { fprintf(stderr, "kernel_launch: hipFuncSetAttribute failed\n"); grid = -1; return; }
        if (hipOccupancyMaxActiveBlocksPerMultiprocessor(&per_cu, (const void*)fwd_kernel, NWAVES * 64, LDS_BYTES) != hipSuccess || per_cu < 1) fprintf(stderr, "kernel_launch: occupancy query reports %d\n", per_cu);
        (void)hipGetLastError();
        grid = cus;
    }
    if (grid < 0) return;
    (void)hipMemsetAsync((char*)d_ws + WS_CTL, 0, CTL_BYTES, stream);
    Args a{};
    for (int i = 0; i < N_IN; ++i) a.in[i] = (const float*)d_in[i];
    a.out = (float*)d_out; a.ws = (unsigned char*)d_ws;
#if MK_MULTI
    for (int p = 0; p < MK_LIMIT; ++p) { a.ph_lo = p; a.ph_hi = p + 1; hipLaunchKernelGGL(fwd_kernel, dim3(grid), dim3(NWAVES * 64), LDS_BYTES, stream, a); }
#else
    a.ph_lo = 0; a.ph_hi = MK_LIMIT; hipLaunchKernelGGL(fwd_kernel, dim3(grid), dim3(NWAVES * 64), LDS_BYTES, stream, a);
#endif
    const hipError_t le = hipPeekAtLastError();
    if (le != hipSuccess) fprintf(stderr, "kernel_launch: launch failed: %s\n", hipGetErrorName(le));
}
```

```cpp
#include <hip/hip_runtime.h>
#include <cstdio>
#include <cstdint>

#define GAS __attribute__((address_space(1)))
#define LAS __attribute__((address_space(3)))
typedef unsigned short bf16_t;
typedef short bf16x8 __attribute__((ext_vector_type(8)));
typedef short s16x4 __attribute__((ext_vector_type(4)));
typedef float f32x2 __attribute__((ext_vector_type(2)));
typedef float f32x4 __attribute__((ext_vector_type(4)));
typedef float f32x16 __attribute__((ext_vector_type(16)));
typedef unsigned u32x2 __attribute__((ext_vector_type(2)));
typedef unsigned u32x4 __attribute__((ext_vector_type(4)));

__device__ __forceinline__ float bf2f(unsigned b) { return __uint_as_float(b << 16); }
__device__ __forceinline__ unsigned f2bf(float f) { unsigned u = __float_as_uint(f); return (u + 0x7fffu + ((u >> 16) & 1u)) >> 16; }
__device__ __forceinline__ unsigned pk2(float lo, float hi) { return f2bf(lo) | (f2bf(hi) << 16); }
__device__ __forceinline__ unsigned cvt_pk_bf16(float lo, float hi) { unsigned r; asm volatile("v_cvt_pk_bf16_f32 %0, %1, %2" : "=v"(r) : "v"(lo), "v"(hi)); return r; }
typedef int v8i32 __attribute__((ext_vector_type(8)));
__device__ __forceinline__ unsigned pk4_fp8(float a, float b, float c, float d) { int w = 0; w = __builtin_amdgcn_cvt_pk_fp8_f32(a, b, w, false); w = __builtin_amdgcn_cvt_pk_fp8_f32(c, d, w, true); asm volatile("s_nop 1" : "+v"(w)); return (unsigned)w; }
__device__ __forceinline__ float wave_sum(float v) {
#pragma unroll
    for (int o = 1; o < 64; o <<= 1) v += __shfl_xor(v, o);
    return v;
}
__device__ __forceinline__ int fresh_lane() { int l; asm volatile("v_mbcnt_lo_u32_b32 %0, -1, 0\n\tv_mbcnt_hi_u32_b32 %0, -1, %0" : "=v"(l)); return l; }
__device__ __forceinline__ float fast_exp(float x) { return __builtin_amdgcn_exp2f(x * 1.4426950408889634f); }
__device__ __forceinline__ float fast_rcp(float x) { return __builtin_amdgcn_rcpf(x); }
__device__ __forceinline__ float silu_f(float x) { return x * fast_rcp(1.0f + fast_exp(-x)); }

#ifndef MK_WT
#define MK_WT 0
#endif
__device__ __forceinline__ void st16(void* p, u32x4 v) {
#if MK_WT
    asm volatile("global_store_dwordx4 %0, %1, off sc1\n\ts_nop 1" :: "v"(p), "v"(v) : "memory");
#else
    *(u32x4*)p = v;
#endif
}
__device__ __forceinline__ void st16f(void* p, f32x4 v) { st16(p, __builtin_bit_cast(u32x4, v)); }

namespace pg8 {
constexpr int BM = 256, BK = 64, HALF = 128, HTB = HALF * BK * 2, STAGE_BYTES = 8 * HTB, NXCD = 8, WGM = 8;
__host__ __device__ __forceinline__ int lds_byte(int r, int c) { const int st = (r >> 4) * 2 + (c >> 5), rr = r & 15, cc = c & 31, ob = rr * 64 + cc * 2; return st * 1024 + (ob ^ (((ob >> 9) & 1) << 5)); }
__host__ __device__ __forceinline__ void stage_rc(int b, int& R, int& C) { const int st = b / 1024, sb = b % 1024, swz = sb ^ (((sb >> 9) & 1) << 5); R = (st >> 1) * 16 + swz / 64; C = (st & 1) * 32 + (swz % 64) / 2; }
__host__ __device__ __forceinline__ int perm32(int rho) { const int n = rho >> 4, i = rho & 15; return 8 * (i >> 2) + 4 * n + (i & 3); }

struct Unit { int pm, pn, e, pl, po, kt0; };
struct Gemm { const bf16_t* A; const bf16_t* Bt; int nt  , N, K  ; size_t bstride; const int* list; int list_stride; const LAS int* cnt; };

struct StaticOrder {
    int nM, nN, nwg, G, c, dup;
    __device__ __forceinline__ void init(int nM_, int nN_, int G_, int c_, int dup_ = 1) { nM = nM_; nN = nN_; nwg = nM * nN; G = G_; c = c_; dup = dup_; }
    __device__ __forceinline__ bool next(int i, Unit& u) const {
        const long L = (long)i * G + c; if (L >= (long)nwg * dup) return false;
        int wgid = (int)L; if (dup > 1) wgid = (int)((unsigned)wgid % (unsigned)nwg); { const int q = nwg / NXCD, r = nwg % NXCD, xcd = wgid % NXCD, off = wgid / NXCD; wgid = (xcd < r ? xcd * (q + 1) : r * (q + 1) + (xcd - r) * q) + off; }
        const int nig = WGM * nN, gid = wgid / nig, fm = gid * WGM, gsz = (nM - fm) < WGM ? (nM - fm) : WGM;
        u.pm = fm + ((wgid % nig) % gsz); u.pn = (wgid % nig) / gsz; u.e = 0; u.pl = 0; u.po = u.pm; u.kt0 = 0; return true;
    }
};
struct MoeOrder {
    StaticOrder so; const LAS int* rb0;
    __device__ __forceinline__ bool next(int i, Unit& u) const {
        if (!so.next(i, u)) return false;
        int e = 0;
#pragma unroll
        for (int j = 1; j < 8; ++j) e = (u.pm >= rb0[j]) ? j : e;
        u.e = e; u.pl = u.pm - rb0[e]; u.po = u.pm; u.kt0 = 0; return true;
    }
};

__device__ __forceinline__ void moe_tail_params(int NRB, int& RBM, int& trb, int& S) { RBM = (NRB >> 6) << 6; trb = NRB - RBM; S = trb <= 16 ? 4 : trb <= 32 ? 2 : 1; }
struct MoeTailOrder {
    int RBM, trb, S, ntsub, G, c0, dup; const LAS int* rb0;
    __device__ __forceinline__ bool next(int i, Unit& u) const { int L = i * G + c0; const int n = trb * 4 * S; if (L >= n * dup) return false; if (dup > 1) L %= n;
        const int s = L % S, r = L / S; u.pn = r & 3; const int tb = r >> 2; u.pm = RBM + tb; u.po = s * trb + tb; u.kt0 = s * ntsub; u.pl = 0;
        int e = 0;
#pragma unroll
        for (int j = 1; j < 8; ++j) e = (u.pm >= rb0[j]) ? j : e;
        u.e = e; return true; }
};
struct LatOrder {
    StaticOrder so;
    __device__ __forceinline__ bool next(int i, Unit& u) const { if (!so.next(i, u)) return false; u.pm = (u.pm >> 4) * 17 + 1 + (u.pm & 15); u.po = u.pm; return true; }
};
struct CtxSplitOrder {
    int nN, S, ntsub, G, c0, dup;
    __device__ __forceinline__ bool next(int i, Unit& u) const { int L = i * G + c0; if (L >= 8 * nN * S * dup) return false; if (dup > 1) L %= 8 * nN * S;
        const int s = L % S, r = L / S; u.pn = r % nN; const int c = r / nN; u.pm = 17 * c; u.po = s * 8 + c; u.kt0 = s * ntsub; u.e = 0; u.pl = 0; return true; }
};

struct EpiF32 {
    static constexpr bool PERM = false;
    float* C; int ldc;
    __device__ __forceinline__ void operator()(const f32x4 (&acc)[2][2][4][2], const Unit& u, int wr, int wc, int fr, int fq) const {
        const int row0 = u.po * BM + wr * 64 + fr, col0 = u.pn * BM + wc * 32 + 4 * fq;
#pragma unroll
        for (int ai = 0; ai < 2; ++ai)
#pragma unroll
            for (int m = 0; m < 4; ++m) { float* rowp = C + (size_t)(row0 + ai * HALF + m * 16) * ldc + col0;
#pragma unroll
                for (int bj = 0; bj < 2; ++bj)
#pragma unroll
                    for (int n = 0; n < 2; ++n) st16f(rowp + bj * HALF + n * 16, acc[ai][bj][m][n]); }
    }
};
struct EpiBf16 {
    static constexpr bool PERM = true;
    bf16_t* O; int ldc;
    __device__ __forceinline__ void operator()(const f32x4 (&acc)[2][2][4][2], const Unit& u, int wr, int wc, int fr, int fq) const {
        const int row0 = u.po * BM + wr * 64 + fr, col0 = u.pn * BM + wc * 32 + 8 * fq;
#pragma unroll
        for (int ai = 0; ai < 2; ++ai)
#pragma unroll
            for (int m = 0; m < 4; ++m) { bf16_t* rowp = O + (size_t)(row0 + ai * HALF + m * 16) * ldc + col0;
#pragma unroll
                for (int bj = 0; bj < 2; ++bj) { const f32x4 v0 = acc[ai][bj][m][0], v1 = acc[ai][bj][m][1];
                    u32x4 w; w.x = cvt_pk_bf16(v0[0], v0[1]); w.y = cvt_pk_bf16(v0[2], v0[3]); w.z = cvt_pk_bf16(v1[0], v1[1]); w.w = cvt_pk_bf16(v1[2], v1[3]);
                    st16(rowp + bj * HALF, w); } }
    }
};
struct EpiSwiglu {
    static constexpr bool PERM = true;
    bf16_t* O; int ldc; float sc;
    __device__ __forceinline__ void operator()(const f32x4 (&acc)[2][2][4][2], const Unit& u, int wr, int wc, int fr, int fq) const {
        const int row0 = u.po * BM + wr * 64 + fr, col0 = u.pn * HALF + wc * 32 + 8 * fq;
        const float c2 = -1.4426950408889634f; (void)sc;
#pragma unroll
        for (int ai = 0; ai < 2; ++ai)
#pragma unroll
            for (int m = 0; m < 4; ++m) { bf16_t* rowp = O + (size_t)(row0 + ai * HALF + m * 16) * ldc + col0;
                float r[8];
#pragma unroll
                for (int n = 0; n < 2; ++n)
#pragma unroll
                    for (int j = 0; j < 4; ++j) { const float ag = acc[ai][0][m][n][j], au = acc[ai][1][m][n][j];
                        const float e = __builtin_amdgcn_exp2f(ag); r[n * 4 + j] = (ag * au) * __builtin_amdgcn_rcpf(fmaf(e, c2, c2)); }
                u32x4 w; w.x = cvt_pk_bf16(r[0], r[1]); w.y = cvt_pk_bf16(r[2], r[3]); w.z = cvt_pk_bf16(r[4], r[5]); w.w = cvt_pk_bf16(r[6], r[7]);
                st16(rowp, w); }
    }
};
constexpr int HM_TPB = 4352;
struct EpiKV {
    static constexpr bool PERM = true;
    bf16_t* Kp; int ldk; bf16_t* Vp; int ldv;
    __device__ __forceinline__ void operator()(const f32x4 (&acc)[2][2][4][2], const Unit& u, int wr, int wc, int fr, int fq) const {
        const int row0 = u.po * BM + wr * 64 + fr, within = wc * 32 + 8 * fq, bb = u.po / 17;
#pragma unroll
        for (int ai = 0; ai < 2; ++ai)
#pragma unroll
            for (int m = 0; m < 4; ++m) { const size_t row = (size_t)(row0 + ai * HALF + m * 16);
#pragma unroll
                for (int bj = 0; bj < 2; ++bj) { const int head = u.pn * 2 + bj; const f32x4 v0 = acc[ai][bj][m][0], v1 = acc[ai][bj][m][1];
                    u32x4 w; w.x = cvt_pk_bf16(v0[0], v0[1]); w.y = cvt_pk_bf16(v0[2], v0[3]); w.z = cvt_pk_bf16(v1[0], v1[1]); w.w = cvt_pk_bf16(v1[2], v1[3]);
                    const size_t hrow = (size_t)(bb * 16 + head) * HM_TPB + (row - (size_t)bb * HM_TPB);
                    bf16_t* dst = (within < 64) ? (Kp + hrow * 96 + within) : (Vp + hrow * 64 + (within - 64));
                    st16(dst, w); } }
    }
};

struct EpiRopeD {
    static constexpr bool PERM = true;
    bf16_t* Qp; bf16_t* Kp; bf16_t* Vp; const float* rt; float qs;
    __device__ __forceinline__ void operator()(const f32x4 (&acc)[2][2][4][2], const Unit& u, int wr, int wc, int fr, int fq) const {
        const int row0 = u.po * BM + wr * 64 + fr, cw = wc * 32 + 8 * fq, bb = u.po / 17;
        if (u.pn >= 8) {
#pragma unroll
            for (int ai = 0; ai < 2; ++ai)
#pragma unroll
                for (int m = 0; m < 4; ++m) { const size_t prow = (size_t)(row0 + ai * HALF + m * 16) - (size_t)bb * HM_TPB;
#pragma unroll
                    for (int bj = 0; bj < 2; ++bj) { const f32x4 v0 = acc[ai][bj][m][0], v1 = acc[ai][bj][m][1];
                        u32x4 w; w.x = cvt_pk_bf16(v0[0], v0[1]); w.y = cvt_pk_bf16(v0[2], v0[3]); w.z = cvt_pk_bf16(v1[0], v1[1]); w.w = cvt_pk_bf16(v1[2], v1[3]);
                        const int vh = (u.pn - 8) * 2 + bj;
                        st16(Vp + ((size_t)(bb * 8 + vh) * HM_TPB + prow) * 128 + cw, w); } }
            return; }
        const bool isq = u.pn < 4; const float osc = isq ? qs : 1.0f;
        const int tb = u.pm % 17; const bool isctx = (tb == 0), colpart = (wc & 1) != 0, x2 = (fq & 2) != 0;
        const int f0 = 8 * (fq & 1);
#pragma unroll
        for (int ai = 0; ai < 2; ++ai)
#pragma unroll
            for (int m = 0; m < 4; ++m) {
                const int pos = colpart ? (16 * m + fr) : ((tb - 1) * 4 + 2 * ai + wr);
                f32x4 cs[4];
#pragma unroll
                for (int q = 0; q < 4; ++q) cs[q] = isctx ? (f32x4){1.f, 0.f, 1.f, 0.f} : *(const f32x4*)(rt + ((size_t)(isctx ? 0 : pos) * 32 + f0 + 2 * q) * 2);
                const size_t grow = (size_t)(row0 + ai * HALF + m * 16), prow = grow - (size_t)bb * HM_TPB;
#pragma unroll
                for (int bj = 0; bj < 2; ++bj) { float r[8];
#pragma unroll
                    for (int e = 0; e < 8; ++e) { const float x = acc[ai][bj][m][e >> 2][e & 3] * osc; const float xp = __shfl_xor(x, 32);
                        const float c = cs[e >> 1][2 * (e & 1)], sn = cs[e >> 1][2 * (e & 1) + 1];
                        r[e] = x2 ? (x * c + xp * sn) : (x * c - xp * sn); }
                    u32x4 w; w.x = cvt_pk_bf16(r[0], r[1]); w.y = cvt_pk_bf16(r[2], r[3]); w.z = cvt_pk_bf16(r[4], r[5]); w.w = cvt_pk_bf16(r[6], r[7]);
                    const int cc = cw + bj * HALF;
                    bf16_t* dst = isq ? Qp + grow * 1024 + u.pn * BM + cc : Kp + ((size_t)(bb * 16 + (u.pn - 4) * 4 + (cc >> 6)) * HM_TPB + prow) * 64 + (cc & 63);
                    st16(dst, w); } }
    }
};

struct EpiRopeB {
    static constexpr bool PERM = true;
    bf16_t* O; const float* rt; float qs;
    __device__ __forceinline__ void operator()(const f32x4 (&acc)[2][2][4][2], const Unit& u, int wr, int wc, int fr, int fq) const {
        const int row0 = u.po * BM + wr * 64 + fr, col0 = u.pn * BM + wc * 32 + 8 * fq;
        const int tb = u.pm % 17; const bool isctx = (tb == 0), colpart = (fq & 2) != 0, x2 = (fq & 1) != 0;
#pragma unroll
        for (int ai = 0; ai < 2; ++ai)
#pragma unroll
            for (int m = 0; m < 4; ++m) {
                const int pos = colpart ? (16 * m + fr) : ((tb - 1) * 4 + 2 * ai + wr);
                f32x4 cs[4];
#pragma unroll
                for (int q = 0; q < 4; ++q) cs[q] = isctx ? (f32x4){1.f, 0.f, 1.f, 0.f} : *(const f32x4*)(rt + ((size_t)(isctx ? 0 : pos) * 32 + 2 * q) * 2);
                bf16_t* rowp = O + (size_t)(row0 + ai * HALF + m * 16) * 1536 + col0;
#pragma unroll
                for (int bj = 0; bj < 2; ++bj) { const bool rope = ((u.pn * 8 + bj * 4 + wc) % 3) == 2;
                    float r[8];
#pragma unroll
                    for (int e = 0; e < 8; ++e) { const float x = acc[ai][bj][m][e >> 2][e & 3] * qs; const float xp = __shfl_xor(x, 16);
                        const float c = cs[e >> 1][2 * (e & 1)], sn = cs[e >> 1][2 * (e & 1) + 1];
                        r[e] = rope ? (x2 ? (x * c + xp * sn) : (x * c - xp * sn)) : x; }
                    u32x4 w; w.x = cvt_pk_bf16(r[0], r[1]); w.y = cvt_pk_bf16(r[2], r[3]); w.z = cvt_pk_bf16(r[4], r[5]); w.w = cvt_pk_bf16(r[6], r[7]);
                    st16(rowp + bj * HALF, w); } }
    }
};

struct EpiNormRopeC {
    static constexpr bool PERM = true;
    bf16_t* Qp; bf16_t* Kp; bf16_t* Vp; const float* qg; const float* kg; const float* rt; LAS float* xch; float qs;
    __device__ __forceinline__ void operator()(const f32x4 (&acc)[2][2][4][2], const Unit& u, int wr, int wc, int fr, int fq) const {
        const int row0 = u.po * BM + wr * 64 + fr, bb = u.po / 17;
        if (u.pn == 5) {
#pragma unroll
            for (int ai = 0; ai < 2; ++ai)
#pragma unroll
                for (int m = 0; m < 4; ++m) { const size_t prow = (size_t)(row0 + ai * HALF + m * 16) - (size_t)bb * HM_TPB;
#pragma unroll
                    for (int bj = 0; bj < 2; ++bj) { const f32x4 v0 = acc[ai][bj][m][0], v1 = acc[ai][bj][m][1];
                        u32x4 w; w.x = cvt_pk_bf16(v0[0], v0[1]); w.y = cvt_pk_bf16(v0[2], v0[3]); w.z = cvt_pk_bf16(v1[0], v1[1]); w.w = cvt_pk_bf16(v1[2], v1[3]);
                        st16(Vp + ((size_t)(bb * 2 + bj) * HM_TPB + prow) * 128 + wc * 32 + 8 * fq, w); } }
            asm volatile("s_waitcnt lgkmcnt(0)" ::: "memory"); __builtin_amdgcn_s_barrier(); asm volatile("" ::: "memory");
            return; }
#pragma unroll
        for (int ai = 0; ai < 2; ++ai)
#pragma unroll
            for (int m = 0; m < 4; ++m)
#pragma unroll
                for (int bj = 0; bj < 2; ++bj) { const f32x4 v0 = acc[ai][bj][m][0], v1 = acc[ai][bj][m][1];
                    float sq = (v0[0] * v0[0] + v0[1] * v0[1]) + (v0[2] * v0[2] + v0[3] * v0[3]) + (v1[0] * v1[0] + v1[1] * v1[1]) + (v1[2] * v1[2] + v1[3] * v1[3]);
                    sq += __shfl_xor(sq, 16); sq += __shfl_xor(sq, 32);
                    if (fq == 0) xch[((ai * HALF + wr * 64 + m * 16 + fr) * 2 + bj) * 4 + wc] = sq; }
        asm volatile("s_waitcnt lgkmcnt(0)" ::: "memory"); __builtin_amdgcn_s_barrier(); asm volatile("" ::: "memory");
        const bool isq = u.pn < 4; const float* gv = isq ? qg : kg;
        const int d0 = 64 * (wc >> 1) + 32 * (fq >> 1) + 16 * (wc & 1) + 8 * (fq & 1);
        const f32x4 ga = *(const f32x4*)(gv + d0), gb = *(const f32x4*)(gv + d0 + 4);
        const int tb = u.pm % 17; const bool isctx = (tb == 0), colpart = (wc >> 1) != 0, x2 = (fq >> 1) != 0;
        const int f0 = d0 & 31;
#pragma unroll
        for (int ai = 0; ai < 2; ++ai)
#pragma unroll
            for (int m = 0; m < 4; ++m) {
                const int pos = colpart ? (16 * m + fr) : ((tb - 1) * 4 + 2 * ai + wr);
                f32x4 cs[4];
#pragma unroll
                for (int q = 0; q < 4; ++q) cs[q] = isctx ? (f32x4){1.f, 0.f, 1.f, 0.f} : *(const f32x4*)(rt + ((size_t)(isctx ? 0 : pos) * 32 + f0 + 2 * q) * 2);
                const int rl = ai * HALF + wr * 64 + m * 16 + fr; const size_t row = (size_t)(row0 + ai * HALF + m * 16);
#pragma unroll
                for (int bj = 0; bj < 2; ++bj) { const f32x4 ps = *(const LAS f32x4*)(xch + (rl * 2 + bj) * 4);
                    const float rstd = rsqrtf(((ps[0] + ps[1]) + (ps[2] + ps[3])) * (1.0f / 128.0f) + 1e-6f) * (isq ? qs : 1.0f);
                    const int head = 2 * u.pn + bj; float r[8];
#pragma unroll
                    for (int e = 0; e < 8; ++e) { const float y = acc[ai][bj][m][e >> 2][e & 3] * rstd * (e < 4 ? ga[e] : gb[e - 4]); const float yp = __shfl_xor(y, 32);
                        const float c = cs[e >> 1][2 * (e & 1)], sn = cs[e >> 1][2 * (e & 1) + 1];
                        r[e] = x2 ? (y * c + yp * sn) : (y * c - yp * sn); }
                    u32x4 w; w.x = cvt_pk_bf16(r[0], r[1]); w.y = cvt_pk_bf16(r[2], r[3]); w.z = cvt_pk_bf16(r[4], r[5]); w.w = cvt_pk_bf16(r[6], r[7]);
                    bf16_t* dst = isq ? Qp + row * 1024 + head * 128 + d0 : Kp + ((size_t)(bb * 2 + (head - 8)) * HM_TPB + (row - (size_t)bb * HM_TPB)) * 128 + d0;
                    st16(dst, w); } }
    }
};

template <class Epi, class Sched, bool GATHER, bool FP8 = false>
__device__ __forceinline__ void gemm_phase(LAS unsigned char* lds, const Gemm g, const Sched& S, const Epi& E, const int wid) {
    const int lane = fresh_lane(), tid = wid * 64 + lane, wr = wid >> 2, wc = wid & 3, fr = lane & 15, fq = lane >> 4;
    const int K = g.K, nt = g.nt;
    unsigned voffA[2], voffB[2];
#pragma unroll
    for (int i = 0; i < 2; ++i) { int R, C; stage_rc(tid * 16 + i * 8192, R, C); const int Rb = Epi::PERM ? ((R & ~31) + perm32(R & 31)) : R;
        voffA[i] = (unsigned)(R * K + C) * 2u; voffB[i] = (unsigned)(Rb * K + C) * 2u; }
    const size_t kstep = (size_t)(BK * 2);
    const size_t hstep = (size_t)HALF * K * 2;
    const size_t tstep = 2 * hstep;
    const unsigned ldsw = (unsigned)wid * 1024u;
    const int aoff = lds_byte(wr * 64 + fr, fq * 8), boff = lds_byte(wc * 32 + fr, fq * 8);
#define PG8_SA(b, h) (((b) * 2 + (h)) * HTB)
#define PG8_SB(b, h) ((4 + (b) * 2 + (h)) * HTB)
#define PG8_STAGE(bufoff, gbase, voff) do { _Pragma("unroll") for (int _i = 0; _i < 2; ++_i) \
        __builtin_amdgcn_global_load_lds((const unsigned*)((const char*)(gbase) + (voff)[_i]), (LAS unsigned*)(lds + (bufoff) + ldsw + _i * 8192), 16, 0, 0); } while (0)
#define PG8_STAGE_A(bufoff, Ap, G, h, kb) do { if constexpr (GATHER) { PG8_STAGE(bufoff, (const char*)g.A + (kb), (G)[h]); } else { PG8_STAGE(bufoff, (Ap) + (size_t)(h) * hstep + (kb), voffA); } } while (0)
#define PG8_LD16(off) (*(const LAS u32x4*)(lds + (off)))
#define PG8_LDA(dst, b, h) do { _Pragma("unroll") for (int m = 0; m < 4; ++m) { if constexpr (FP8) { dst##8[m] = __builtin_bit_cast(v8i32, __builtin_shufflevector(PG8_LD16(PG8_SA(b, h) + aoff + m * 2048), PG8_LD16(PG8_SA(b, h) + aoff + m * 2048 + 1024), 0, 1, 2, 3, 4, 5, 6, 7)); } \
        else { _Pragma("unroll") for (int k = 0; k < 2; ++k) dst[m][k] = *(const LAS bf16x8*)(lds + PG8_SA(b, h) + aoff + m * 2048 + k * 1024); } } } while (0)
#define PG8_LDB(dst, b, h) do { _Pragma("unroll") for (int n = 0; n < 2; ++n) { if constexpr (FP8) { dst##8[n] = __builtin_bit_cast(v8i32, __builtin_shufflevector(PG8_LD16(PG8_SB(b, h) + boff + n * 2048), PG8_LD16(PG8_SB(b, h) + boff + n * 2048 + 1024), 0, 1, 2, 3, 4, 5, 6, 7)); } \
        else { _Pragma("unroll") for (int k = 0; k < 2; ++k) dst[n][k] = *(const LAS bf16x8*)(lds + PG8_SB(b, h) + boff + n * 2048 + k * 1024); } } } while (0)
#define PG8_MMA(ai, bj, At, Bt) do { __builtin_amdgcn_s_setprio(1); _Pragma("unroll") for (int m = 0; m < 4; ++m) _Pragma("unroll") for (int n = 0; n < 2; ++n) { \
        if constexpr (FP8) { asm volatile("v_mfma_scale_f32_16x16x128_f8f6f4 %0, %1, %2, %0, %3, %4 op_sel_hi:[0,0,0]" : "+v"(acc[ai][bj][m][n]) : "v"(Bt##8[n]), "v"(At##8[m]), "v"(sc7f), "v"(sc7a)); } \
        else { _Pragma("unroll") for (int k = 0; k < 2; ++k) acc[ai][bj][m][n] = __builtin_amdgcn_mfma_f32_16x16x32_bf16(Bt[n][k], At[m][k], acc[ai][bj][m][n], 0, 0, 0); } } \
        __builtin_amdgcn_s_setprio(0); } while (0)
#define PG8_WAIT_V(n) asm volatile("s_waitcnt vmcnt(" #n ")" ::: "memory")
#define PG8_WAIT_L(n) asm volatile("s_waitcnt lgkmcnt(" #n ")" ::: "memory")
#define PG8_BAR __builtin_amdgcn_s_barrier()
#define PG8_SCHED __builtin_amdgcn_sched_barrier(0)
    LAS unsigned char* tokt = lds + STAGE_BYTES;
#define PG8_TOKDMA(u, slot) do { if constexpr (GATHER) { if (wid < 4) { const unsigned _cn = (unsigned)g.cnt[(u).e]; const unsigned _s = (unsigned)((u).pl * BM + tid); \
        __builtin_amdgcn_global_load_lds((const unsigned*)(g.list + (size_t)(u).e * g.list_stride + (_s < _cn ? _s : _cn - 1u)), (LAS unsigned*)(tokt + (slot) * 1024 + wid * 256), 4, 0, 0); } } } while (0)
#define PG8_GOFFS(go, slot) do { if constexpr (GATHER) { \
        _Pragma("unroll") for (int _h = 0; _h < 2; ++_h) _Pragma("unroll") for (int _i = 0; _i < 2; ++_i) { int _R, _C; stage_rc(tid * 16 + _i * 8192, _R, _C); \
            const unsigned _t = *(const LAS unsigned*)(tokt + (slot) * 1024 + (_h * HALF + _R) * 4); (go)[_h][_i] = (_t * (unsigned)K + (unsigned)_C) * 2u; } } } while (0)
    Unit cur, nxt; int ui = 0;
    if (!S.next(0, cur)) return;
    f32x4 acc[2][2][4][2];
#pragma unroll
    for (int a = 0; a < 2; ++a)
#pragma unroll
        for (int b = 0; b < 2; ++b)
#pragma unroll
            for (int m = 0; m < 4; ++m)
#pragma unroll
                for (int n = 0; n < 2; ++n) acc[a][b][m][n] = (f32x4){0.f, 0.f, 0.f, 0.f};
    const unsigned sc7f = 0x7F7F7F7Fu, sc7a = 0x7A7A7A7Au;
    bf16x8 At[4][2], B0[2][2], B1[2][2]; v8i32 At8[4], B08[2], B18[2];
    unsigned gcur[2][2] = {{0u, 0u}, {0u, 0u}};
    const char* cA = (const char*)g.A + (size_t)cur.pm * tstep + (size_t)cur.kt0 * kstep; const char* cB = (const char*)g.Bt + ((size_t)cur.e * g.bstride) * 2 + (size_t)cur.pn * tstep + (size_t)cur.kt0 * kstep;
    if constexpr (GATHER) { PG8_TOKDMA(cur, 0); asm volatile("s_waitcnt vmcnt(0)" ::: "memory"); __builtin_amdgcn_s_barrier(); asm volatile("" ::: "memory"); }
    PG8_GOFFS(gcur, 0);
    PG8_STAGE(PG8_SB(0, 0), cB, voffB); PG8_STAGE(PG8_SB(0, 1), cB + hstep, voffB); PG8_STAGE_A(PG8_SA(0, 0), cA, gcur, 0, 0); PG8_STAGE_A(PG8_SA(0, 1), cA, gcur, 1, 0);
    if (wr == 1) PG8_BAR;
    PG8_WAIT_V(2); PG8_BAR;
    PG8_STAGE(PG8_SB(1, 0), cB + kstep, voffB); PG8_STAGE_A(PG8_SA(1, 0), cA, gcur, 0, kstep); PG8_STAGE(PG8_SB(1, 1), cB + hstep + kstep, voffB);
    PG8_WAIT_V(6); PG8_BAR;
    for (;;) {
        const bool has_next = S.next(ui + 1, nxt);
        if constexpr (GATHER) { if (has_next) PG8_TOKDMA(nxt, (ui + 1) & 1); }
        const char* nA = has_next ? (const char*)g.A + (size_t)nxt.pm * tstep + (size_t)nxt.kt0 * kstep : cA; const char* nB = has_next ? (const char*)g.Bt + ((size_t)nxt.e * g.bstride) * 2 + (size_t)nxt.pn * tstep + (size_t)nxt.kt0 * kstep : cB;
#pragma unroll 1
        for (int t = 0; t < nt; t += 2) {
            const bool last = (t == nt - 2);
            const size_t kb1 = (size_t)(t + 1) * kstep;
            const char* a2p = last ? nA : cA; const size_t kb2 = last ? (size_t)0 : (size_t)(t + 2) * kstep;
            const char* b2 = last ? nB : cB + (size_t)(t + 2) * kstep;
            const size_t kb3 = kb2 + kstep; const char* b3 = b2 + kstep;
            PG8_LDB(B0, 0, 0); PG8_LDB(B1, 0, 1); PG8_SCHED; PG8_LDA(At, 0, 0); PG8_STAGE_A(PG8_SA(1, 1), cA, gcur, 1, kb1);
            if constexpr (GATHER) { if (last && has_next) { PG8_GOFFS(gcur, (ui + 1) & 1); } }
            PG8_WAIT_V(8); PG8_WAIT_L(0); PG8_BAR; PG8_MMA(0, 0, At, B0); PG8_MMA(0, 1, At, B1); PG8_BAR; PG8_SCHED;
            PG8_LDA(At, 0, 1); PG8_STAGE(PG8_SB(0, 0), b2, voffB); PG8_STAGE(PG8_SB(0, 1), b2 + hstep, voffB); PG8_STAGE_A(PG8_SA(0, 0), a2p, gcur, 0, kb2);
            PG8_WAIT_V(8); PG8_WAIT_L(0); PG8_BAR; PG8_MMA(1, 0, At, B0); PG8_MMA(1, 1, At, B1); PG8_BAR; PG8_SCHED;
            PG8_LDB(B0, 1, 0); PG8_LDB(B1, 1, 1); PG8_SCHED; PG8_LDA(At, 1, 0); PG8_STAGE_A(PG8_SA(0, 1), a2p, gcur, 1, kb2);
            PG8_WAIT_V(8); PG8_WAIT_L(0); PG8_BAR; PG8_MMA(0, 0, At, B0); PG8_MMA(0, 1, At, B1); PG8_BAR; PG8_SCHED;
            PG8_LDA(At, 1, 1); PG8_STAGE(PG8_SB(1, 0), b3, voffB); PG8_STAGE(PG8_SB(1, 1), b3 + hstep, voffB); PG8_STAGE_A(PG8_SA(1, 0), a2p, gcur, 0, kb3);
            PG8_WAIT_V(8); PG8_WAIT_L(0); PG8_BAR; PG8_MMA(1, 0, At, B0); PG8_MMA(1, 1, At, B1); PG8_BAR; PG8_SCHED;
        }
        if (wr == 0) PG8_BAR;
        if constexpr (FP8) asm volatile("s_nop 15\n\ts_nop 15\n\ts_nop 15\n\ts_nop 15" ::: "memory");
        E(acc, cur, wr, wc, fr, fq);
        if (!has_next) break;
#pragma unroll
        for (int a = 0; a < 2; ++a)
#pragma unroll
            for (int b = 0; b < 2; ++b)
#pragma unroll
                for (int m = 0; m < 4; ++m)
#pragma unroll
                    for (int n = 0; n < 2; ++n) acc[a][b][m][n] = (f32x4){0.f, 0.f, 0.f, 0.f};
        cur = nxt; cA = nA; cB = nB; ++ui;
        if (wr == 1) PG8_BAR;
    }
    PG8_WAIT_V(0);
    PG8_BAR;
#undef PG8_SA
#undef PG8_SB
#undef PG8_STAGE
#undef PG8_STAGE_A
#undef PG8_LDA
#undef PG8_LDB
#undef PG8_MMA
#undef PG8_LD16
#undef PG8_WAIT_V
#undef PG8_WAIT_L
#undef PG8_BAR
#undef PG8_SCHED
#undef PG8_GOFFS
#undef PG8_TOKDMA
}
}
namespace att {
constexpr int NW = 8, QBLK = 32, KVBLK = 64;
constexpr float THR = 8.f;
#define ATT_SBAR() __builtin_amdgcn_sched_barrier(0)
template <int DK> __device__ __forceinline__ int kswz(int row, int colB) { return row * (DK * 2 + 16) + colB; }
__device__ __forceinline__ int crow(int r, int hi) { return (r & 3) + 8 * (r >> 2) + 4 * hi; }
__device__ __forceinline__ void partialSM(f32x16& p0, f32x16& p1, float& m_reg, float& mn, float& alpha, const float C, const float thr_raw) {
    float pmax = p0[0];
#pragma unroll
    for (int r = 1; r < 16; ++r) pmax = fmaxf(pmax, p0[r]);
#pragma unroll
    for (int r = 0; r < 16; ++r) pmax = fmaxf(pmax, p1[r]);
    { auto rr = __builtin_amdgcn_permlane32_swap(__float_as_uint(pmax), __float_as_uint(pmax), false, false);
      pmax = fmaxf(__uint_as_float(rr[0]), __uint_as_float(rr[1])); }
    if (__builtin_expect(__all(pmax - m_reg <= thr_raw), 1)) { mn = m_reg; alpha = 1.f; }
    else { mn = fmaxf(m_reg, pmax); alpha = __builtin_amdgcn_exp2f((m_reg - mn) * C); m_reg = mn; }
    const float mnC = -mn * C;
#pragma unroll
    for (int r = 0; r < 16; ++r) p0[r] = fmaf(p0[r], C, mnC);
#pragma unroll
    for (int r = 0; r < 16; ++r) p1[r] = fmaf(p1[r], C, mnC);
#pragma unroll
    for (int r = 0; r < 16; ++r) p0[r] = __builtin_amdgcn_exp2f(p0[r]);
}
__device__ __forceinline__ void finishSM(f32x16& p0, f32x16& p1, float alpha, float& l_reg, bf16x8& pa0, bf16x8& pa1, bf16x8& pa2, bf16x8& pa3) {
#pragma unroll
    for (int r = 0; r < 16; ++r) p1[r] = __builtin_amdgcn_exp2f(p1[r]);
#if MK_PROBE_ATT == 2
    { float dz = 0.f;
#pragma unroll
      for (int r = 0; r < 16; ++r) { dz += __builtin_amdgcn_exp2f(p0[r] - 1.0f); dz += __builtin_amdgcn_exp2f(p1[r] - 2.0f); }
      asm volatile("" :: "v"(dz)); }
#endif
    float ps = 0;
#pragma unroll
    for (int r = 0; r < 16; ++r) ps += p0[r];
#pragma unroll
    for (int r = 0; r < 16; ++r) ps += p1[r];
    { auto rr = __builtin_amdgcn_permlane32_swap(__float_as_uint(ps), __float_as_uint(ps), false, false);
      ps = __uint_as_float(rr[0]) + __uint_as_float(rr[1]); }
    l_reg = l_reg * alpha + ps;
#define ATT_PK4(P, BASE, OUT) do { unsigned a0 = cvt_pk_bf16(P[BASE + 0], P[BASE + 1]), a1 = cvt_pk_bf16(P[BASE + 2], P[BASE + 3]);   \
    unsigned b0 = cvt_pk_bf16(P[BASE + 4], P[BASE + 5]), b1 = cvt_pk_bf16(P[BASE + 6], P[BASE + 7]);                              \
    auto r0 = __builtin_amdgcn_permlane32_swap(a0, b0, false, false); auto r1 = __builtin_amdgcn_permlane32_swap(a1, b1, false, false); \
    u32x4 w = {r0[0], r1[0], r0[1], r1[1]}; OUT = *reinterpret_cast<bf16x8*>(&w); } while (0)
    ATT_PK4(p0, 0, pa0); ATT_PK4(p0, 8, pa1); ATT_PK4(p1, 0, pa2); ATT_PK4(p1, 8, pa3);
#undef ATT_PK4
}
#ifndef MK_PROBE_ATT
#define MK_PROBE_ATT 0
#endif
template <int DK> __device__ __forceinline__ void qkt(f32x16& p0, f32x16& p1, const char* Ks, const bf16x8* qr, int r32, int hi) {
    p0 = f32x16{}; p1 = f32x16{};
#if MK_PROBE_ATT == 1
    f32x16 d0_ = f32x16{}; d0_[0] = 1.0f;
#endif
#pragma unroll
    for (int d0 = 0; d0 < DK / 16; ++d0) { const int cb = (d0 * 16 + hi * 8) * 2;
        const bf16x8 b0 = *reinterpret_cast<const bf16x8*>(Ks + kswz<DK>(r32, cb));
        const bf16x8 b1 = *reinterpret_cast<const bf16x8*>(Ks + kswz<DK>(32 + r32, cb));
        p0 = __builtin_amdgcn_mfma_f32_32x32x16_bf16(b0, qr[d0], p0, 0, 0, 0);
        p1 = __builtin_amdgcn_mfma_f32_32x32x16_bf16(b1, qr[d0], p1, 0, 0, 0);
#if MK_PROBE_ATT == 1
        d0_ = __builtin_amdgcn_mfma_f32_32x32x16_bf16(b0, qr[d0], d0_, 0, 0, 0);
        d0_ = __builtin_amdgcn_mfma_f32_32x32x16_bf16(b1, qr[d0], d0_, 0, 0, 0);
#endif
    }
#if MK_PROBE_ATT == 1
    asm volatile("" :: "v"(d0_));
#endif
}
template <int DV> __device__ __forceinline__ int v_st_nat(int k, int c) { return ((k >> 3) * (DV / 32) + (c >> 5)) * 512 + ((k & 7) * 32 + (c & 31)) * 2; }
template <int DV> __device__ __forceinline__ int v_st(int k, int c) { const int kk = (k & ~0xC) | ((k & 4) << 1) | ((k & 8) >> 1); return ((kk >> 3) * (DV / 32) + (c >> 5)) * 512 + ((kk & 7) * 32 + (c & 31)) * 2; }
__device__ __forceinline__ int v_rd_base(int lane) { return ((lane & 3) << 3) | (((lane >> 2) & 3) << 6) | (((lane >> 4) & 1) << 5) | (((lane >> 5) & 1) << 8); }
template <int DV> constexpr int v_rd_off(int d0, int ks, int half) { return d0 * 512 + ks * (DV / 32) * 1024 + half * (DV / 32) * 512; }
template <int OFF> __device__ __forceinline__ s16x4 tr_read(int vb) {
    s16x4 r; asm volatile("ds_read_b64_tr_b16 %0, %1 offset:%2" : "=&v"(r) : "v"(vb), "i"(OFF) : "memory"); return r;
}
template <int DV, int D0> __device__ __forceinline__ void pv_one(f32x16& od, int vb, bf16x8 pa0, bf16x8 pa1, bf16x8 pa2, bf16x8 pa3) {
    const s16x4 l0 = tr_read<v_rd_off<DV>(D0, 0, 0)>(vb), h0 = tr_read<v_rd_off<DV>(D0, 0, 1)>(vb), l1 = tr_read<v_rd_off<DV>(D0, 1, 0)>(vb), h1 = tr_read<v_rd_off<DV>(D0, 1, 1)>(vb);
    const s16x4 l2 = tr_read<v_rd_off<DV>(D0, 2, 0)>(vb), h2 = tr_read<v_rd_off<DV>(D0, 2, 1)>(vb), l3 = tr_read<v_rd_off<DV>(D0, 3, 0)>(vb), h3 = tr_read<v_rd_off<DV>(D0, 3, 1)>(vb);
    asm volatile("s_waitcnt lgkmcnt(0)" ::: "memory"); ATT_SBAR();
#define ATT_PK(L, H) (bf16x8){L[0], L[1], L[2], L[3], H[0], H[1], H[2], H[3]}
    od = __builtin_amdgcn_mfma_f32_32x32x16_bf16(pa0, ATT_PK(l0, h0), od, 0, 0, 0);
    od = __builtin_amdgcn_mfma_f32_32x32x16_bf16(pa1, ATT_PK(l1, h1), od, 0, 0, 0);
    od = __builtin_amdgcn_mfma_f32_32x32x16_bf16(pa2, ATT_PK(l2, h2), od, 0, 0, 0);
    od = __builtin_amdgcn_mfma_f32_32x32x16_bf16(pa3, ATT_PK(l3, h3), od, 0, 0, 0);
#undef ATT_PK
}
template <int DV, int D0> __device__ __forceinline__ void pv_two(f32x16& oa, f32x16& ob, int vb, bf16x8 pa0, bf16x8 pa1, bf16x8 pa2, bf16x8 pa3) {
    const s16x4 l0 = tr_read<v_rd_off<DV>(D0, 0, 0)>(vb), h0 = tr_read<v_rd_off<DV>(D0, 0, 1)>(vb), l1 = tr_read<v_rd_off<DV>(D0, 1, 0)>(vb), h1 = tr_read<v_rd_off<DV>(D0, 1, 1)>(vb);
    const s16x4 l2 = tr_read<v_rd_off<DV>(D0, 2, 0)>(vb), h2 = tr_read<v_rd_off<DV>(D0, 2, 1)>(vb), l3 = tr_read<v_rd_off<DV>(D0, 3, 0)>(vb), h3 = tr_read<v_rd_off<DV>(D0, 3, 1)>(vb);
    const s16x4 m0 = tr_read<v_rd_off<DV>(D0 + 1, 0, 0)>(vb), n0 = tr_read<v_rd_off<DV>(D0 + 1, 0, 1)>(vb), m1 = tr_read<v_rd_off<DV>(D0 + 1, 1, 0)>(vb), n1 = tr_read<v_rd_off<DV>(D0 + 1, 1, 1)>(vb);
    const s16x4 m2 = tr_read<v_rd_off<DV>(D0 + 1, 2, 0)>(vb), n2 = tr_read<v_rd_off<DV>(D0 + 1, 2, 1)>(vb), m3 = tr_read<v_rd_off<DV>(D0 + 1, 3, 0)>(vb), n3 = tr_read<v_rd_off<DV>(D0 + 1, 3, 1)>(vb);
    asm volatile("s_waitcnt lgkmcnt(0)" ::: "memory"); ATT_SBAR();
#define ATT_PK(L, H) (bf16x8){L[0], L[1], L[2], L[3], H[0], H[1], H[2], H[3]}
    oa = __builtin_amdgcn_mfma_f32_32x32x16_bf16(pa0, ATT_PK(l0, h0), oa, 0, 0, 0);
    ob = __builtin_amdgcn_mfma_f32_32x32x16_bf16(pa0, ATT_PK(m0, n0), ob, 0, 0, 0);
    oa = __builtin_amdgcn_mfma_f32_32x32x16_bf16(pa1, ATT_PK(l1, h1), oa, 0, 0, 0);
    ob = __builtin_amdgcn_mfma_f32_32x32x16_bf16(pa1, ATT_PK(m1, n1), ob, 0, 0, 0);
    oa = __builtin_amdgcn_mfma_f32_32x32x16_bf16(pa2, ATT_PK(l2, h2), oa, 0, 0, 0);
    ob = __builtin_amdgcn_mfma_f32_32x32x16_bf16(pa2, ATT_PK(m2, n2), ob, 0, 0, 0);
    oa = __builtin_amdgcn_mfma_f32_32x32x16_bf16(pa3, ATT_PK(l3, h3), oa, 0, 0, 0);
    ob = __builtin_amdgcn_mfma_f32_32x32x16_bf16(pa3, ATT_PK(m3, n3), ob, 0, 0, 0);
#undef ATT_PK
}
struct VFrag64 { s16x4 l[2][4], h[2][4]; };
template <int DV> __device__ __forceinline__ void pv_issue(VFrag64& f, int vb) {
    f.l[0][0] = tr_read<v_rd_off<DV>(0, 0, 0)>(vb); f.h[0][0] = tr_read<v_rd_off<DV>(0, 0, 1)>(vb); f.l[0][1] = tr_read<v_rd_off<DV>(0, 1, 0)>(vb); f.h[0][1] = tr_read<v_rd_off<DV>(0, 1, 1)>(vb);
    f.l[0][2] = tr_read<v_rd_off<DV>(0, 2, 0)>(vb); f.h[0][2] = tr_read<v_rd_off<DV>(0, 2, 1)>(vb); f.l[0][3] = tr_read<v_rd_off<DV>(0, 3, 0)>(vb); f.h[0][3] = tr_read<v_rd_off<DV>(0, 3, 1)>(vb);
    f.l[1][0] = tr_read<v_rd_off<DV>(1, 0, 0)>(vb); f.h[1][0] = tr_read<v_rd_off<DV>(1, 0, 1)>(vb); f.l[1][1] = tr_read<v_rd_off<DV>(1, 1, 0)>(vb); f.h[1][1] = tr_read<v_rd_off<DV>(1, 1, 1)>(vb);
    f.l[1][2] = tr_read<v_rd_off<DV>(1, 2, 0)>(vb); f.h[1][2] = tr_read<v_rd_off<DV>(1, 2, 1)>(vb); f.l[1][3] = tr_read<v_rd_off<DV>(1, 3, 0)>(vb); f.h[1][3] = tr_read<v_rd_off<DV>(1, 3, 1)>(vb);
}
__device__ __forceinline__ void pv_mma64(f32x16* o, const VFrag64& f, bf16x8 pa0, bf16x8 pa1, bf16x8 pa2, bf16x8 pa3) {
    asm volatile("s_waitcnt lgkmcnt(0)" ::: "memory"); ATT_SBAR();
#define ATT_PK(L, H) (bf16x8){L[0], L[1], L[2], L[3], H[0], H[1], H[2], H[3]}
    o[0] = __builtin_amdgcn_mfma_f32_32x32x16_bf16(pa0, ATT_PK(f.l[0][0], f.h[0][0]), o[0], 0, 0, 0);
    o[1] = __builtin_amdgcn_mfma_f32_32x32x16_bf16(pa0, ATT_PK(f.l[1][0], f.h[1][0]), o[1], 0, 0, 0);
    o[0] = __builtin_amdgcn_mfma_f32_32x32x16_bf16(pa1, ATT_PK(f.l[0][1], f.h[0][1]), o[0], 0, 0, 0);
    o[1] = __builtin_amdgcn_mfma_f32_32x32x16_bf16(pa1, ATT_PK(f.l[1][1], f.h[1][1]), o[1], 0, 0, 0);
    o[0] = __builtin_amdgcn_mfma_f32_32x32x16_bf16(pa2, ATT_PK(f.l[0][2], f.h[0][2]), o[0], 0, 0, 0);
    o[1] = __builtin_amdgcn_mfma_f32_32x32x16_bf16(pa2, ATT_PK(f.l[1][2], f.h[1][2]), o[1], 0, 0, 0);
    o[0] = __builtin_amdgcn_mfma_f32_32x32x16_bf16(pa3, ATT_PK(f.l[0][3], f.h[0][3]), o[0], 0, 0, 0);
    o[1] = __builtin_amdgcn_mfma_f32_32x32x16_bf16(pa3, ATT_PK(f.l[1][3], f.h[1][3]), o[1], 0, 0, 0);
#undef ATT_PK
}
#ifndef MK_PV2
#define MK_PV2 1
#endif
#ifndef MK_VPRE
#define MK_VPRE 0
#endif
#ifndef MK_MBLK
#define MK_MBLK 1
#endif
#ifndef MK_ATT_PRIO
#define MK_ATT_PRIO 1
#endif
template <int DV> __device__ __forceinline__ void pv_d0(f32x16* o, int vb, bf16x8 pa0, bf16x8 pa1, bf16x8 pa2, bf16x8 pa3) {
#if MK_PV2
    pv_two<DV, 0>(o[0], o[1], vb, pa0, pa1, pa2, pa3);
    if constexpr (DV == 128) pv_two<DV, 2>(o[2], o[3], vb, pa0, pa1, pa2, pa3);
#else
    pv_one<DV, 0>(o[0], vb, pa0, pa1, pa2, pa3); pv_one<DV, 1>(o[1], vb, pa0, pa1, pa2, pa3);
    if constexpr (DV == 128) { pv_one<DV, 2>(o[2], vb, pa0, pa1, pa2, pa3); pv_one<DV, 3>(o[3], vb, pa0, pa1, pa2, pa3); }
#endif
}
template <int DK, int DV> constexpr int lds_bytes() { return 3 * KVBLK * DV * 2 + 3 * KVBLK * (DK * 2 + 16) + NW * 64 * 4; }

template <int DK, int DV, int ldq, int ldk, int ldv, int ldo, int SD, int EPI = 0>
__device__ __forceinline__ void attn_unit(const bf16_t* __restrict__ Qb, const bf16_t* __restrict__ Kh, const bf16_t* __restrict__ Vh,
                                          bf16_t* __restrict__ Ob, int seq, const float C, const float thr_raw, char* lds, const int wid, LAS unsigned* stash = nullptr, float lam = 0.f, const float* gvec = nullptr) {
    constexpr int SHM_V = KVBLK * DV * 2, SHM_K = KVBLK * (DK * 2 + 16);
    constexpr int NO = DV / 32, ND = DK / 16;
    const int lane = fresh_lane(), tid = wid * 64 + lane, r32 = lane & 31, hi = lane >> 5;
    char* V_lds = lds; char* K_lds = lds + 3 * SHM_V;
    float* wsf = (float*)(lds + 3 * SHM_V + 3 * SHM_K) + wid * 64; float* li_l = wsf; float* al_l = wsf + 32;
    float m_reg = -1e30f, l_reg = 0; f32x16 o[NO]; bf16x8 qr[ND];
#pragma unroll
    for (int d = 0; d < NO; ++d) o[d] = f32x16{};
    const bf16_t* Qw = Qb + (long)(wid * QBLK + r32) * ldq + hi * 8;
#pragma unroll
    for (int d0 = 0; d0 < ND; ++d0) qr[d0] = *reinterpret_cast<const bf16x8*>(Qw + d0 * 16);
    const int sr = tid >> 4, sc = (tid & 15) * 8; const bool kact = (DK == 128) ? true : (sc < DK), vact = (DV == 128) ? true : (sc < DV);
    const int vst0 = v_st<DV>(sr, vact ? sc : 0), vst1 = v_st<DV>(32 + sr, vact ? sc : 0);
    const int vb0 = (int)(uintptr_t)V_lds + v_rd_base(lane);
    const unsigned koff = (unsigned)(sr * ldk + sc) * 2u, voff = (unsigned)(sr * ldv + sc) * 2u;
    const size_t k32 = (size_t)32 * ldk * 2, v32 = (size_t)32 * ldv * 2;
    struct { bf16x8 vs0, vs1, ks0, ks1; } sr_[SD];
#define ATT_SLOAD(s, k0) do { const char* _kt = (const char*)Kh + (size_t)(k0) * ldk * 2; const char* _vt = (const char*)Vh + (size_t)(k0) * ldv * 2; \
    if (vact) { sr_[s].vs0 = *reinterpret_cast<const bf16x8*>(_vt + voff); sr_[s].vs1 = *reinterpret_cast<const bf16x8*>(_vt + v32 + voff); } \
    if (kact) { sr_[s].ks0 = *reinterpret_cast<const bf16x8*>(_kt + koff); sr_[s].ks1 = *reinterpret_cast<const bf16x8*>(_kt + k32 + koff); } } while (0)
#define ATT_SWRITE(b, s) do { if (vact) { *(bf16x8*)(V_lds + (b) * SHM_V + vst0) = sr_[s].vs0; *(bf16x8*)(V_lds + (b) * SHM_V + vst1) = sr_[s].vs1; } \
    if (kact) { const int kc = sc * 2; *(bf16x8*)(K_lds + (b) * SHM_K + kswz<DK>(sr, kc)) = sr_[s].ks0; *(bf16x8*)(K_lds + (b) * SHM_K + kswz<DK>(32 + sr, kc)) = sr_[s].ks1; } } while (0)
#define ATT_RESC(a) do { if (__any((a) < 1.f)) { if (hi == 0) al_l[r32] = (a); asm volatile("s_waitcnt lgkmcnt(0)" ::: "memory"); \
    _Pragma("unroll") for (int d = 0; d < NO; ++d) _Pragma("unroll") for (int r = 0; r < 16; ++r) o[d][r] *= al_l[crow(r, hi)]; } } while (0)
    f32x16 pA0, pA1, pB0, pB1; float mnA, mnB, alA, alB; bf16x8 pa0, pa1, pa2, pa3; const int NT = seq / KVBLK;
    constexpr int SE = 0, SO = SD - 1;
    constexpr bool VPRE = (DV == 64) && (MK_VPRE != 0); VFrag64 vf;
    __syncthreads();
    ATT_SLOAD(SE, 0); asm volatile("s_waitcnt vmcnt(0)" ::: "memory"); ATT_SWRITE(0, SE); __syncthreads();
    qkt<DK>(pA0, pA1, K_lds, qr, r32, hi); partialSM(pA0, pA1, m_reg, mnA, alA, C, thr_raw);
    ATT_SLOAD(SO, KVBLK); if constexpr (SD == 2) { if (2 < NT) ATT_SLOAD(SE, 2 * KVBLK); }
    ATT_SWRITE(1, SO); __syncthreads();
    int bj = 1;
    for (int j = 1; j + 1 < NT; j += 2) {
        const int bn = (bj == 2) ? 0 : bj + 1, bp = (bj == 0) ? 2 : bj - 1;
        ATT_SBAR(); if constexpr (VPRE) pv_issue<DV>(vf, vb0 + bp * SHM_V);
        qkt<DK>(pB0, pB1, K_lds + bj * SHM_K, qr, r32, hi);
        finishSM(pA0, pA1, alA, l_reg, pa0, pa1, pa2, pa3); ATT_SBAR();
        ATT_SLOAD(SO, (j + SD) * KVBLK); ATT_SBAR();
        if constexpr (VPRE) pv_mma64(o, vf, pa0, pa1, pa2, pa3); else pv_d0<DV>(o, vb0 + bp * SHM_V, pa0, pa1, pa2, pa3);
        partialSM(pB0, pB1, m_reg, mnB, alB, C, thr_raw);
        ATT_SWRITE(bn, SE);
        ATT_RESC(alB); __syncthreads();
        ATT_SBAR(); if constexpr (VPRE) pv_issue<DV>(vf, vb0 + bj * SHM_V);
        qkt<DK>(pA0, pA1, K_lds + bn * SHM_K, qr, r32, hi);
        finishSM(pB0, pB1, alB, l_reg, pa0, pa1, pa2, pa3); ATT_SBAR();
        if (SD == 1 || j + 3 < NT) ATT_SLOAD(SE, (j + 1 + SD) * KVBLK); ATT_SBAR();
        if constexpr (VPRE) pv_mma64(o, vf, pa0, pa1, pa2, pa3); else pv_d0<DV>(o, vb0 + bj * SHM_V, pa0, pa1, pa2, pa3);
        partialSM(pA0, pA1, m_reg, mnA, alA, C, thr_raw);
        ATT_SWRITE(bp, SO);
        ATT_RESC(alA); __syncthreads();
        bj = bp;
    }
    { const int bp = (bj == 0) ? 2 : bj - 1;
      ATT_SBAR(); qkt<DK>(pB0, pB1, K_lds + bj * SHM_K, qr, r32, hi);
      finishSM(pA0, pA1, alA, l_reg, pa0, pa1, pa2, pa3); ATT_SBAR();
      pv_d0<DV>(o, vb0 + bp * SHM_V, pa0, pa1, pa2, pa3); partialSM(pB0, pB1, m_reg, mnB, alB, C, thr_raw);
      ATT_RESC(alB);
      finishSM(pB0, pB1, alB, l_reg, pa0, pa1, pa2, pa3); ATT_SBAR();
      pv_d0<DV>(o, vb0 + bj * SHM_V, pa0, pa1, pa2, pa3); }
    if (hi == 0) li_l[r32] = l_reg; asm volatile("s_waitcnt lgkmcnt(0)" ::: "memory");
    float rli[16];
#pragma unroll
    for (int r = 0; r < 16; ++r) rli[r] = __builtin_amdgcn_rcpf(li_l[crow(r, hi)]);
    if constexpr (EPI == 1) {
#pragma unroll
        for (int r = 0; r < 16; ++r)
#pragma unroll
            for (int p = 0; p < NO / 2; ++p) stash[(r * (NO / 2) + p) * 64 + lane] = pk2(o[2 * p][r] * rli[r], o[2 * p + 1][r] * rli[r]);
    } else if constexpr (EPI == 2) {
        static_assert(EPI != 2 || DV == 128, "differential combine: DV = 128");
        float gl[NO];
#pragma unroll
        for (int d0 = 0; d0 < NO; ++d0) gl[d0] = gvec[d0 * 32 + r32];
        bf16_t* Ow = Ob + (long)(wid * QBLK) * ldo;
#pragma unroll
        for (int r = 0; r < 16; ++r) { float v[NO]; float ss = 0.f;
#pragma unroll
            for (int p = 0; p < NO / 2; ++p) { const unsigned w = stash[(r * (NO / 2) + p) * 64 + lane];
                v[2 * p] = o[2 * p][r] * rli[r] - lam * bf2f(w & 0xffffu); v[2 * p + 1] = o[2 * p + 1][r] * rli[r] - lam * bf2f(w >> 16); ss += v[2 * p] * v[2 * p] + v[2 * p + 1] * v[2 * p + 1]; }
#pragma unroll
            for (int x = 1; x < 32; x <<= 1) ss += __shfl_xor(ss, x);
            const float rstd = rsqrtf(ss * (1.0f / 128.0f) + 1e-6f); const int orow = crow(r, hi);
#pragma unroll
            for (int d0 = 0; d0 < NO; ++d0) Ow[(long)orow * ldo + d0 * 32 + r32] = (bf16_t)f2bf(v[d0] * rstd * gl[d0]); }
    } else {
    bf16_t* Ow = Ob + (long)(wid * QBLK) * ldo;
#pragma unroll
    for (int r = 0; r < 16; ++r) { const int orow = crow(r, hi);
#pragma unroll
        for (int d0 = 0; d0 < NO; ++d0) Ow[(long)orow * ldo + d0 * 32 + r32] = (bf16_t)f2bf(o[d0][r] * rli[r]); }
    }
#undef ATT_SLOAD
#undef ATT_SWRITE
#undef ATT_RESC
}

constexpr float THRL = THR * 1.4426950408889634f;
__device__ __forceinline__ float max3f(float a, float b, float c) { return __builtin_fmaxf(__builtin_fmaxf(a, b), c); }
constexpr float BIGS = 2980.9579870417283f;
__device__ __forceinline__ void softmax_rel(f32x16& p0, f32x16& p1, float& m_run, float& alpha, const bool first, f32x16* minit, float& ps) {
#define ATT_MAXCH(pm) do { pm = max3f(p0[0], p0[1], p0[2]); \
    _Pragma("unroll") for (int r = 3; r < 15; r += 2) pm = max3f(pm, p0[r], p0[r + 1]); \
    pm = max3f(pm, p0[15], p1[0]); \
    _Pragma("unroll") for (int r = 1; r < 15; r += 2) pm = max3f(pm, p1[r], p1[r + 1]); \
    pm = __builtin_fmaxf(pm, p1[15]); \
    { auto rr = __builtin_amdgcn_permlane32_swap(__float_as_uint(pm), __float_as_uint(pm), false, false); pm = __builtin_fmaxf(__uint_as_float(rr[0]), __uint_as_float(rr[1])); } } while (0)
    alpha = 1.f;
    if (first) { float pm; ATT_MAXCH(pm); m_run += pm;
        if (minit) {
#pragma unroll
            for (int r = 0; r < 16; ++r) (*minit)[r] = -m_run; }
#pragma unroll
        for (int r = 0; r < 16; ++r) { p0[r] -= pm; p1[r] -= pm; } }
#pragma unroll
    for (int r = 0; r < 16; ++r) { p0[r] = __builtin_amdgcn_exp2f(p0[r]); p1[r] = __builtin_amdgcn_exp2f(p1[r]); }
    ps = 0.f;
#pragma unroll
    for (int r = 0; r < 16; ++r) ps += p0[r];
#pragma unroll
    for (int r = 0; r < 16; ++r) ps += p1[r];
    if (!first && !__builtin_expect(__all(ps <= BIGS), 1)) {
        float pm; ATT_MAXCH(pm); const float d = __builtin_fmaxf(__builtin_amdgcn_logf(pm), 0.f); alpha = __builtin_amdgcn_exp2f(-d); m_run += d;
        if (minit) {
#pragma unroll
            for (int r = 0; r < 16; ++r) (*minit)[r] = -m_run; }
#pragma unroll
        for (int r = 0; r < 16; ++r) { p0[r] *= alpha; p1[r] *= alpha; }
        ps *= alpha; }
#undef ATT_MAXCH
}
template <int DK> __device__ __forceinline__ void qkt_init(f32x16& p0, f32x16& p1, const char* Ks, const bf16x8* qr, int r32, int hi, float init) {
#pragma unroll
    for (int r = 0; r < 16; ++r) { p0[r] = init; p1[r] = init; }
#pragma unroll
    for (int d0 = 0; d0 < DK / 16; ++d0) { const int cb = (d0 * 16 + hi * 8) * 2;
        const bf16x8 b0 = *reinterpret_cast<const bf16x8*>(Ks + kswz<DK>(r32, cb));
        const bf16x8 b1 = *reinterpret_cast<const bf16x8*>(Ks + kswz<DK>(32 + r32, cb));
        p0 = __builtin_amdgcn_mfma_f32_32x32x16_bf16(b0, qr[d0], p0, 0, 0, 0);
        p1 = __builtin_amdgcn_mfma_f32_32x32x16_bf16(b1, qr[d0], p1, 0, 0, 0); }
}
__device__ __forceinline__ void finish_rel(f32x16& p0, f32x16& p1, float alpha, float& l_reg, bf16x8& pa0, bf16x8& pa1, bf16x8& pa2, bf16x8& pa3, float ps) {
    { auto rr = __builtin_amdgcn_permlane32_swap(__float_as_uint(ps), __float_as_uint(ps), false, false); ps = __uint_as_float(rr[0]) + __uint_as_float(rr[1]); }
    l_reg = l_reg * alpha + ps;
#define ATT_PK4(P, BASE, OUT) do { u32x4 w = {cvt_pk_bf16(P[BASE + 0], P[BASE + 1]), cvt_pk_bf16(P[BASE + 2], P[BASE + 3]), cvt_pk_bf16(P[BASE + 4], P[BASE + 5]), cvt_pk_bf16(P[BASE + 6], P[BASE + 7])}; \
    OUT = *reinterpret_cast<bf16x8*>(&w); } while (0)
    ATT_PK4(p0, 0, pa0); ATT_PK4(p0, 8, pa1); ATT_PK4(p1, 0, pa2); ATT_PK4(p1, 8, pa3);
#undef ATT_PK4
}

template <int OFF> __device__ __forceinline__ bf16x8 k_read(int ka) { bf16x8 r; asm volatile("ds_read_b128 %0, %1 offset:%2" : "=&v"(r) : "v"(ka), "i"(OFF) : "memory"); return r; }
#define ATT_WAITL(n) asm volatile("s_waitcnt lgkmcnt(%0)" :: "n"(n) : "memory")
#define ATT_PKV(L, H) (bf16x8){L[0], L[1], L[2], L[3], H[0], H[1], H[2], H[3]}
template <int DK, int DV, int KBD, bool FINM = false, bool MINIT = false>
__device__ __forceinline__ void mblock(f32x16* o, f32x16& p0, f32x16& p1, const bool pv, const int vb, const int ka, const bf16x8* qr, bf16x8 pa0, bf16x8 pa1, bf16x8 pa2, bf16x8 pa3, const float init, const float al = 1.f, float* l_reg = nullptr, const f32x16* minit = nullptr) {
    constexpr int ND = DK / 16, NB = ND / KBD, PITCH = DK * 2 + 16, KR = 2 * KBD;
    static_assert(ND % KBD == 0 && NB >= 2 && NB <= 4 && (KBD == 2 || KBD == 3), "K batches");
    bf16x8 ka0[2][KBD], ka1[2][KBD];
    s16x4 l[4], h[4], m[4], n[4];
#define ATT_KISSUE(b) do { ka0[(b) & 1][0] = k_read<((b) * KBD + 0) * 32>(ka); ka1[(b) & 1][0] = k_read<((b) * KBD + 0) * 32 + 32 * PITCH>(ka); \
        ka0[(b) & 1][1] = k_read<((b) * KBD + 1) * 32>(ka); ka1[(b) & 1][1] = k_read<((b) * KBD + 1) * 32 + 32 * PITCH>(ka); \
        if constexpr (KBD > 2) { ka0[(b) & 1][KBD - 1] = k_read<((b) * KBD + KBD - 1) * 32>(ka); ka1[(b) & 1][KBD - 1] = k_read<((b) * KBD + KBD - 1) * 32 + 32 * PITCH>(ka); } } while (0)
#define ATT_TRISSUE(D0) do { l[0] = tr_read<v_rd_off<DV>(D0, 0, 0)>(vb); h[0] = tr_read<v_rd_off<DV>(D0, 0, 1)>(vb); l[1] = tr_read<v_rd_off<DV>(D0, 1, 0)>(vb); h[1] = tr_read<v_rd_off<DV>(D0, 1, 1)>(vb); \
        l[2] = tr_read<v_rd_off<DV>(D0, 2, 0)>(vb); h[2] = tr_read<v_rd_off<DV>(D0, 2, 1)>(vb); l[3] = tr_read<v_rd_off<DV>(D0, 3, 0)>(vb); h[3] = tr_read<v_rd_off<DV>(D0, 3, 1)>(vb); \
        m[0] = tr_read<v_rd_off<DV>(D0 + 1, 0, 0)>(vb); n[0] = tr_read<v_rd_off<DV>(D0 + 1, 0, 1)>(vb); m[1] = tr_read<v_rd_off<DV>(D0 + 1, 1, 0)>(vb); n[1] = tr_read<v_rd_off<DV>(D0 + 1, 1, 1)>(vb); \
        m[2] = tr_read<v_rd_off<DV>(D0 + 1, 2, 0)>(vb); n[2] = tr_read<v_rd_off<DV>(D0 + 1, 2, 1)>(vb); m[3] = tr_read<v_rd_off<DV>(D0 + 1, 3, 0)>(vb); n[3] = tr_read<v_rd_off<DV>(D0 + 1, 3, 1)>(vb); } while (0)
#define ATT_PVMMA(OA, OB) do { OA = __builtin_amdgcn_mfma_f32_32x32x16_bf16(pa0, ATT_PKV(l[0], h[0]), OA, 0, 0, 0); OB = __builtin_amdgcn_mfma_f32_32x32x16_bf16(pa0, ATT_PKV(m[0], n[0]), OB, 0, 0, 0); \
        OA = __builtin_amdgcn_mfma_f32_32x32x16_bf16(pa1, ATT_PKV(l[1], h[1]), OA, 0, 0, 0); OB = __builtin_amdgcn_mfma_f32_32x32x16_bf16(pa1, ATT_PKV(m[1], n[1]), OB, 0, 0, 0); \
        OA = __builtin_amdgcn_mfma_f32_32x32x16_bf16(pa2, ATT_PKV(l[2], h[2]), OA, 0, 0, 0); OB = __builtin_amdgcn_mfma_f32_32x32x16_bf16(pa2, ATT_PKV(m[2], n[2]), OB, 0, 0, 0); \
        OA = __builtin_amdgcn_mfma_f32_32x32x16_bf16(pa3, ATT_PKV(l[3], h[3]), OA, 0, 0, 0); OB = __builtin_amdgcn_mfma_f32_32x32x16_bf16(pa3, ATT_PKV(m[3], n[3]), OB, 0, 0, 0); } while (0)
#define ATT_QKMMA(b) do { _Pragma("unroll") for (int q = 0; q < KBD; ++q) { if ((b) == 0 && q == 0) { \
            p1 = __builtin_amdgcn_mfma_f32_32x32x16_bf16(ka1[0][0], qr[0], ini, 0, 0, 0); p0 = __builtin_amdgcn_mfma_f32_32x32x16_bf16(ka0[0][0], qr[0], ini, 0, 0, 0); } else { \
        p0 = __builtin_amdgcn_mfma_f32_32x32x16_bf16(ka0[(b) & 1][q], qr[(b) * KBD + q], p0, 0, 0, 0); \
        p1 = __builtin_amdgcn_mfma_f32_32x32x16_bf16(ka1[(b) & 1][q], qr[(b) * KBD + q], p1, 0, 0, 0); } } } while (0)
#if MK_ATT_PRIO == 1
    __builtin_amdgcn_s_setprio(1);
#endif
    constexpr bool K2 = true;
    if (pv) {
        ATT_TRISSUE(0); ATT_KISSUE(0); if constexpr (K2) ATT_KISSUE(1);
        if constexpr (FINM) { ATT_SBAR(); finish_rel(p0, p1, al, *l_reg, pa0, pa1, pa2, pa3, 0.f); ATT_SBAR(); }
        ATT_WAITL(K2 ? 2 * KR : KR); ATT_SBAR();
        ATT_PVMMA(o[0], o[1]); ATT_SBAR();
        if constexpr (DV == 128) { ATT_TRISSUE(2); ATT_WAITL(0); ATT_SBAR(); ATT_PVMMA(o[2], o[3]); ATT_SBAR(); }
    } else { ATT_KISSUE(0); if constexpr (K2) ATT_KISSUE(1); }
    if constexpr (!K2) ATT_KISSUE(1);
    f32x16 ini;
    if constexpr (MINIT) ini = *minit; else {
#pragma unroll
        for (int r = 0; r < 16; ++r) ini[r] = init; }
    ATT_WAITL(KR); ATT_SBAR(); ATT_QKMMA(0); ATT_SBAR();
    if constexpr (NB > 2) { ATT_KISSUE(2); ATT_WAITL(KR); } else ATT_WAITL(0);
    ATT_SBAR(); ATT_QKMMA(1); ATT_SBAR();
    if constexpr (NB > 2) { if constexpr (NB > 3) { ATT_KISSUE(3); ATT_WAITL(KR); } else ATT_WAITL(0);
        ATT_SBAR(); ATT_QKMMA(2); ATT_SBAR();
        if constexpr (NB > 3) { ATT_WAITL(0); ATT_SBAR(); ATT_QKMMA(3); ATT_SBAR(); } }
#if MK_ATT_PRIO == 1
    __builtin_amdgcn_s_setprio(0);
#endif
    if (MK_PROBE_ATT == 4) { f32x16 dz = f32x16{};
#pragma unroll
        for (int q = 0; q < ND; ++q) { dz = __builtin_amdgcn_mfma_f32_32x32x16_bf16(qr[q], qr[(q + 1) % ND], dz, 0, 0, 0); dz = __builtin_amdgcn_mfma_f32_32x32x16_bf16(qr[(q + 1) % ND], qr[q], dz, 0, 0, 0); }
        asm volatile("" :: "v"(dz)); }
    if (MK_PROBE_ATT == 5) { ATT_KISSUE(0); ATT_KISSUE(1); if constexpr (NB > 2) { ATT_WAITL(0); ATT_KISSUE(2); if constexpr (NB > 3) ATT_KISSUE(3); } ATT_WAITL(0);
        asm volatile("" :: "v"(ka0[0][0]), "v"(ka1[0][0]), "v"(ka0[1][0]), "v"(ka1[1][0])); }
#undef ATT_KISSUE
#undef ATT_TRISSUE
#undef ATT_PVMMA
#undef ATT_QKMMA
}

template <int DK, int DV, int ldq, int ldk, int ldv, int ldo, bool PRE, bool DEEP, bool PART = false>
__device__ __forceinline__ void attn_unit_stag(const bf16_t* __restrict__ Qb, const bf16_t* __restrict__ Kh, const bf16_t* __restrict__ Vh,
                                               bf16_t* __restrict__ Ob, int seq, const float C, const float thr_raw, char* lds, const int wid, float* po = nullptr, float* pml = nullptr) {
    constexpr int SHM_V = KVBLK * DV * 2, SHM_K = KVBLK * (DK * 2 + 16), R = 4;
    constexpr int NO = DV / 32, ND = DK / 16;
    const int lane = fresh_lane(), tid = wid * 64 + lane, r32 = lane & 31, hi = lane >> 5, half = wid >> 2;
    char* V_lds = lds; char* K_lds = lds + R * SHM_V;
    float* wsf = (float*)(lds + R * SHM_V + R * SHM_K) + wid * 64; float* li_l = wsf; float* al_l = wsf + 32;
    float m_reg = 0.f, l_reg = 0; f32x16 o[NO]; bf16x8 qr[ND];
#pragma unroll
    for (int d = 0; d < NO; ++d) o[d] = f32x16{};
    const bf16_t* Qw = Qb + (long)(wid * QBLK + r32) * ldq + hi * 8;
#pragma unroll
    for (int d0 = 0; d0 < ND; ++d0) qr[d0] = *reinterpret_cast<const bf16x8*>(Qw + d0 * 16);
    if constexpr (!PRE) {
#pragma unroll
        for (int d0 = 0; d0 < ND; ++d0) { const u32x4 w = *reinterpret_cast<const u32x4*>(&qr[d0]); u32x4 x;
            x.x = cvt_pk_bf16(bf2f(w.x & 0xffffu) * C, bf2f(w.x >> 16) * C); x.y = cvt_pk_bf16(bf2f(w.y & 0xffffu) * C, bf2f(w.y >> 16) * C);
            x.z = cvt_pk_bf16(bf2f(w.z & 0xffffu) * C, bf2f(w.z >> 16) * C); x.w = cvt_pk_bf16(bf2f(w.w & 0xffffu) * C, bf2f(w.w >> 16) * C);
            qr[d0] = *reinterpret_cast<const bf16x8*>(&x); } }
    const int sr = tid >> 4, sc = (tid & 15) * 8; const bool kact = (DK == 128) ? true : (sc < DK), vact = (DV == 128) ? true : (sc < DV);
    const int vst0 = v_st_nat<DV>(sr, vact ? sc : 0), vst1 = v_st_nat<DV>(32 + sr, vact ? sc : 0);
    const int vb0 = (int)(uintptr_t)V_lds + v_rd_base(lane);
    const int ka0 = (int)(uintptr_t)K_lds + kswz<DK>(r32, hi * 16);
    const unsigned koff = (unsigned)(sr * ldk + sc) * 2u, voff = (unsigned)(sr * ldv + sc) * 2u;
    const unsigned koff2 = koff + 32u * ldk * 2u, voff2 = voff + 32u * ldv * 2u;
    bf16x8 vsA0, vsA1, ksA0, ksA1, vsB0, vsB1, ksB0, ksB1;
#define STG_SLOAD(S, k0) do { const char* _kt = (const char*)Kh + (size_t)(k0) * ldk * 2; const char* _vt = (const char*)Vh + (size_t)(k0) * ldv * 2;        \
    if (vact) { vs##S##0 = *reinterpret_cast<const bf16x8*>(_vt + (size_t)voff); vs##S##1 = *reinterpret_cast<const bf16x8*>(_vt + (size_t)voff2); } \
    if (kact) { ks##S##0 = *reinterpret_cast<const bf16x8*>(_kt + (size_t)koff); ks##S##1 = *reinterpret_cast<const bf16x8*>(_kt + (size_t)koff2); } } while (0)
#define STG_SWRITE(S, b) do { if (vact) { *(bf16x8*)(V_lds + (b) * SHM_V + vst0) = vs##S##0; *(bf16x8*)(V_lds + (b) * SHM_V + vst1) = vs##S##1; } \
    if (kact) { const int kc = sc * 2; *(bf16x8*)(K_lds + (b) * SHM_K + kswz<DK>(sr, kc)) = ks##S##0; *(bf16x8*)(K_lds + (b) * SHM_K + kswz<DK>(32 + sr, kc)) = ks##S##1; } } while (0)
#define STG_BAR() do { ATT_SBAR(); asm volatile("s_waitcnt lgkmcnt(0)" ::: "memory"); __builtin_amdgcn_s_barrier(); asm volatile("" ::: "memory"); ATT_SBAR(); } while (0)
    constexpr bool MINIT = true;
    f32x16 minit = f32x16{};
    constexpr bool FINM = false;
    f32x16 p0, p1; float al = 1.f; bf16x8 pa0, pa1, pa2, pa3; const int NT = seq / KVBLK; (void)thr_raw;
    __syncthreads();
    if constexpr (DEEP) { STG_SLOAD(A, 0); STG_SLOAD(B, KVBLK); asm volatile("s_waitcnt vmcnt(0)" ::: "memory"); STG_SWRITE(A, 0); STG_SWRITE(B, 1);
        if (2 < NT) { STG_SLOAD(A, 2 * KVBLK); STG_SLOAD(B, 3 * KVBLK); } }
    else if constexpr (!(DK == 128 && DV == 128)) {
        STG_SLOAD(A, 0); STG_SLOAD(B, KVBLK); asm volatile("s_waitcnt vmcnt(0)" ::: "memory"); STG_SWRITE(A, 0); STG_SWRITE(B, 1);
        if (2 < NT) STG_SLOAD(A, 2 * KVBLK); }
    else { STG_SLOAD(A, 0); asm volatile("s_waitcnt vmcnt(0)" ::: "memory"); STG_SWRITE(A, 0);
        STG_SLOAD(A, KVBLK); asm volatile("s_waitcnt vmcnt(0)" ::: "memory"); STG_SWRITE(A, 1);
        if (2 < NT) STG_SLOAD(A, 2 * KVBLK); }
    __syncthreads();
    if (half && MK_PROBE_ATT != 8) STG_BAR();
#define STG_TILE(t, S, PV) do { \
        mblock<DK, DV, (DK == 96) ? 3 : 2, FINM, MINIT>(o, p0, p1, PV, vb0 + (((t) - 1) & 3) * SHM_V, ka0 + ((t) & 3) * SHM_K, qr, pa0, pa1, pa2, pa3, -m_reg, al, &l_reg, &minit); \
        STG_BAR(); \
        if (MK_ATT_PRIO == 2) __builtin_amdgcn_s_setprio(1); \
        float ps_; softmax_rel(p0, p1, m_reg, al, !(PV), MINIT ? &minit : nullptr, ps_); \
        if (MK_PROBE_ATT == 3) { float dz = 0.f; _Pragma("unroll") for (int r = 0; r < 16; ++r) { dz += __builtin_amdgcn_exp2f(p0[r] - 1.0f); dz += __builtin_amdgcn_exp2f(p1[r] - 2.0f); } asm volatile("" :: "v"(dz)); } \
        if (MK_PROBE_ATT == 6) { STG_BAR(); } \
        if (MK_PROBE_ATT == 9) { float dz = al; _Pragma("unroll") for (int r = 0; r < 48; ++r) asm volatile("v_fma_f32 %0, %0, %0, %0" : "+v"(dz)); asm volatile("" :: "v"(dz)); } \
        if constexpr (!FINM) finish_rel(p0, p1, al, l_reg, pa0, pa1, pa2, pa3, ps_); \
        if (__any(al < 1.f)) { if (hi == 0) al_l[r32] = al; asm volatile("s_waitcnt lgkmcnt(0)" ::: "memory"); \
            _Pragma("unroll") for (int d = 0; d < NO; ++d) _Pragma("unroll") for (int r = 0; r < 16; ++r) o[d][r] *= al_l[crow(r, hi)]; } \
        if (MK_ATT_PRIO == 2) __builtin_amdgcn_s_setprio(0); \
        if constexpr (DEEP) { if ((t) + 2 < NT) { STG_SWRITE(S, ((t) + 2) & 3); if ((t) + 4 < NT) STG_SLOAD(S, ((t) + 4) * KVBLK); } } \
        else      { if ((t) + 2 < NT) { STG_SWRITE(A, ((t) + 2) & 3); if ((t) + 3 < NT) { STG_SLOAD(A, ((t) + 3) * KVBLK); \
            if (MK_PROBE_ATT == 7) { STG_SLOAD(B, ((t) + 3) * KVBLK + 32 * ((t) & 1)); asm volatile("" :: "v"(vsB0), "v"(vsB1), "v"(ksB0), "v"(ksB1)); } } } } \
        STG_BAR(); } while (0)
    if constexpr (DEEP) { for (int t = 0; t < NT; t += 2) { STG_TILE(t, A, (t) > 0); STG_TILE(t + 1, B, true); } }
    else { STG_TILE(0, A, false);
        for (int t = 1; t < NT; ++t) STG_TILE(t, A, true); }
#undef STG_TILE
    if constexpr (FINM) finish_rel(p0, p1, al, l_reg, pa0, pa1, pa2, pa3, 0.f);
    pv_d0<DV>(o, (int)(uintptr_t)V_lds + v_rd_base(fresh_lane()) + ((NT - 1) & 3) * SHM_V, pa0, pa1, pa2, pa3);
    if (!half && MK_PROBE_ATT != 8) STG_BAR();
    if constexpr (PART) { const int ln = fresh_lane(), rr32 = ln & 31, hh = ln >> 5;
      if (hh == 0) { pml[(wid * QBLK + rr32) * 2] = m_reg; pml[(wid * QBLK + rr32) * 2 + 1] = l_reg; }
      float* pw = po + (size_t)(wid * QBLK) * DV;
#pragma unroll
      for (int r = 0; r < 16; ++r) { const int orow = crow(r, hh);
#pragma unroll
          for (int d0 = 0; d0 < NO; ++d0) pw[orow * DV + d0 * 32 + rr32] = o[d0][r]; } }
    else
    { const int ln = fresh_lane(), rr32 = ln & 31, hh = ln >> 5;
      float* wsf2 = (float*)(lds + R * SHM_V + R * SHM_K) + wid * 64;
      if (hh == 0) wsf2[rr32] = l_reg; asm volatile("s_waitcnt lgkmcnt(0)" ::: "memory");
      float rli[16];
#pragma unroll
      for (int r = 0; r < 16; ++r) rli[r] = __builtin_amdgcn_rcpf(wsf2[crow(r, hh)]);
      constexpr int OP = DV * 2 + 16, OSZ = 32 * OP, NV = (3 * SHM_V) / OSZ;
      static_assert((8 - NV) * OSZ <= R * SHM_K, "O staging");
      char* stg = lds + (wid < NV ? wid * OSZ : R * SHM_V + (wid - NV) * OSZ);
#pragma unroll
      for (int r = 0; r < 16; ++r) { const int orow = crow(r, hh);
#pragma unroll
          for (int d0 = 0; d0 < NO; ++d0) *(bf16_t*)(stg + orow * OP + (d0 * 32 + rr32) * 2) = (bf16_t)f2bf(o[d0][r] * rli[r]); }
      asm volatile("s_waitcnt lgkmcnt(0)" ::: "memory");
      bf16_t* Ow = Ob + (long)(wid * QBLK) * ldo;
      constexpr int SEG = DV * 2 / 16;
#pragma unroll
      for (int ps = 0; ps < DV / 16; ++ps) { const int idx = ps * 64 + ln, row = idx / SEG, seg = idx % SEG;
          const u32x4 w = *(const u32x4*)(stg + row * OP + seg * 16);
          *(u32x4*)(Ow + (long)row * ldo + seg * 8) = w; } }
#undef STG_SLOAD
#undef STG_SWRITE
#undef STG_BAR
}
}
constexpr int NWAVES = 8;
constexpr int DM = 1024, NBATCH = 8, SEQ = 4096, CTXL = 256, TPB = CTXL + SEQ  , T = NBATCH * TPB  ;
constexpr int FF = 3584, NEXP = 8, DEPTH = 4;
constexpr int A_IN = 5120, B_IN = 672, B_INP = 768, C_IN = 1536, D_IN = 3072;
constexpr float NORM_EPS = 1e-6f;
constexpr int MOE_ROWS = 2 * T + NEXP * 256;

enum { I_X = 0, I_C, I_CTX, I_CCTX, I_MODW, I_MODB, I_NORMG, I_A_WIN, I_A_LB, I_A_ONORM, I_A_WOUT, I_B_WIN, I_B_QNORM, I_B_KVNORM, I_B_WQB, I_B_WKVB, I_B_WOUT,
       I_C_WIN, I_C_QNORM, I_C_KNORM, I_C_WOUT, I_D_WIN, I_D_LAMBDA, I_D_ONORM, I_D_WOUT, I_FFN_GU, I_FFN_DOWN, I_MOE_ROUTER, I_MOE_GU, I_MOE_DOWN, N_IN };

constexpr size_t al256(size_t x) { return (x + 255) / 256 * 256; }
constexpr size_t WS_CTL = 0, CTL_BYTES = 1u << 20;
constexpr size_t WS_MOD = WS_CTL + CTL_BYTES;
constexpr size_t WS_ROPE = WS_MOD + al256((size_t)DEPTH * 9 * 6 * DM * 4);
constexpr size_t WS_LB = WS_ROPE + al256((size_t)3 * 64 * 32 * 2 * 4);
constexpr size_t WS_W0 = WS_LB + al256((size_t)2 * 1024 * 4);
constexpr size_t WS_WA_IN = WS_W0;                                  constexpr size_t SZ_WA_IN = (size_t)A_IN * DM * 2;
constexpr size_t WS_WA_OUT = WS_WA_IN + SZ_WA_IN;                   constexpr size_t SZ_WOUT = (size_t)DM * DM * 2;
constexpr size_t WS_WB_IN = WS_WA_OUT + SZ_WOUT;                    constexpr size_t SZ_WB_IN = (size_t)B_INP * DM * 2;
constexpr size_t WS_WB_QB = WS_WB_IN + SZ_WB_IN;                    constexpr size_t SZ_WB_QB = (size_t)1536 * 384 * 2;
constexpr size_t WS_WB_KVB = WS_WB_QB + SZ_WB_QB;                   constexpr size_t SZ_WB_KVB = (size_t)2048 * 256 * 2;
constexpr size_t WS_WB_OUT = WS_WB_KVB + SZ_WB_KVB;
constexpr size_t WS_WC_IN = WS_WB_OUT + SZ_WOUT;                    constexpr size_t SZ_WC_IN = (size_t)C_IN * DM * 2;
constexpr size_t WS_WC_OUT = WS_WC_IN + SZ_WC_IN;
constexpr size_t WS_WD_IN = WS_WC_OUT + SZ_WOUT;                    constexpr size_t SZ_WD_IN = (size_t)D_IN * DM * 2;
constexpr size_t WS_WD_OUT = WS_WD_IN + SZ_WD_IN;
constexpr size_t WS_FFN_GU = WS_WD_OUT + SZ_WOUT;                   constexpr size_t SZ_GU = (size_t)2 * FF * DM;
constexpr size_t WS_FFN_DN = WS_FFN_GU + 2 * SZ_GU;                 constexpr size_t SZ_DN = (size_t)DM * FF * 2;
constexpr size_t WS_MOE_GU = WS_FFN_DN + 2 * SZ_DN;
constexpr size_t WS_MOE_DN = WS_MOE_GU + 16 * SZ_GU;
constexpr size_t WS_WEND = WS_MOE_DN + 16 * SZ_DN;
constexpr size_t WS_H = al256(WS_WEND);                              constexpr size_t SZ_H = (size_t)T * DM * 4;
constexpr size_t WS_XA = WS_H + SZ_H;                                constexpr size_t SZ_XA = (size_t)T * DM * 2;
constexpr size_t WS_Y = WS_XA + SZ_XA;                               constexpr size_t SZ_Y = (size_t)T * DM * 4;
constexpr size_t WS_YS = WS_Y + SZ_Y;                              constexpr size_t SZ_YS = (size_t)8 * 2048 * DM * 4;
constexpr size_t WS_ROUTE = WS_YS + SZ_YS;                             constexpr size_t SZ_ROUTE = (size_t)T * 32;
constexpr size_t WS_WCNT = WS_ROUTE + SZ_ROUTE;                      constexpr size_t SZ_WCNT = (size_t)256 * 8 * 4;
constexpr size_t WS_LIST = WS_WCNT + SZ_WCNT;                      constexpr size_t SZ_LIST = (size_t)NEXP * T * 4;
constexpr size_t WS_R0 = al256(WS_LIST + SZ_LIST);
constexpr size_t WS_Z = WS_R0;                                       constexpr size_t SZ_Z = (size_t)T * A_IN * 2;
constexpr size_t WS_Q = WS_Z + SZ_Z;                                 constexpr size_t SZ_Q = (size_t)T * 2048 * 2;
constexpr size_t WS_K = WS_Q + SZ_Q;                                 constexpr size_t SZ_K = (size_t)T * 1536 * 2;
constexpr size_t WS_V = WS_K + SZ_K;                                 constexpr size_t SZ_V = (size_t)T * 1024 * 2;
constexpr size_t WS_O = WS_V + SZ_V;                                 constexpr size_t SZ_O = (size_t)T * 2048 * 2;
constexpr size_t WS_MIX_END = WS_O + SZ_O;
constexpr size_t WS_ACT = WS_R0;                                     constexpr size_t SZ_ACT = (size_t)MOE_ROWS * FF * 2;
constexpr size_t WS_YP = WS_ACT + al256(SZ_ACT);                     constexpr size_t SZ_YP = (size_t)MOE_ROWS * DM * 4;
constexpr size_t WS_FFN_END = WS_YP + SZ_YP;
constexpr size_t WS_END = (WS_MIX_END > WS_FFN_END ? WS_MIX_END : WS_FFN_END);
static_assert((size_t)T * 1536 * 4 <= SZ_Z && (size_t)T * B_INP * 4 <= SZ_Z && (size_t)T * D_IN * 2 <= SZ_Z, "Z region");
static_assert((size_t)T * (384 + 256) * 2 <= SZ_O, "MLA normalised latents fit the O region");

constexpr int CW_BAR = 4096;
constexpr int CW_MOECNT = 16384;
constexpr int RING_BYTES = 131072;
constexpr int MISC_OFF = 163840 - 1024;
constexpr int LDS_BYTES = 163840;
static_assert(RING_BYTES <= MISC_OFF, "LDS map");

#define XB_TMO      128
#define XB_XCNT(j)  (256  + 64 * (j))
#define XB_XSUB(j)  (1280 + 64 * (j))
#define XB_XGEN(j)  (2304 + 64 * (j))
#define XB_TOP      3328
#define XB_TOPGEN   3392
#define XCD_BAR_WORDS 3456
#define XB_SPIN_CAP (1u << 22)
__device__ __forceinline__ unsigned xb_ld(unsigned* p)              { return __hip_atomic_load(p, __ATOMIC_RELAXED, __HIP_MEMORY_SCOPE_AGENT); }
__device__ __forceinline__ unsigned xb_add(unsigned* p, unsigned v) { return __hip_atomic_fetch_add(p, v, __ATOMIC_RELAXED, __HIP_MEMORY_SCOPE_AGENT); }
__device__ __forceinline__ unsigned xb_xcc_id() { return (unsigned)__builtin_amdgcn_s_getreg((3 << 11) | 20) & 0xFu; }
#define XB_SPIN(cond, bar) do { unsigned _sp = 0; while (cond) { __builtin_amdgcn_s_sleep(1); \
    if ((++_sp & 255u) == 0u) { if (xb_ld(&(bar)[XB_TMO])) break; if (_sp > XB_SPIN_CAP) { atomicAdd(&(bar)[XB_TMO], 1u); break; } } } } while (0)
struct XcdBarrier { unsigned* bar; unsigned x; volatile LAS unsigned* st; };
__device__ __forceinline__ XcdBarrier xcd_barrier_post(unsigned* bar, volatile LAS unsigned* st) {
    XcdBarrier b; b.bar = bar; b.x = xb_xcc_id(); b.st = st;
    if (threadIdx.x == 0) (void)xb_add(&bar[XB_XCNT(b.x)], 1u);
    return b;
}
__device__ __forceinline__ void xcd_barrier_complete(unsigned* bar, unsigned x, unsigned& nloc, unsigned& nx) {
    const unsigned G = gridDim.x * gridDim.y * gridDim.z;
    unsigned sum, cnt, mine, sp = 0u;
    for (;;) {
        sum = 0u; cnt = 0u; mine = 0u;
#pragma unroll
        for (unsigned j = 0; j < 16; ++j) { const unsigned c = xb_ld(&bar[XB_XCNT(j)]); sum += c; cnt += (c > 0u) ? 1u : 0u; mine = (j == x) ? c : mine; }
        if (sum == G) break;
        __builtin_amdgcn_s_sleep(1);
        if ((++sp & 255u) == 0u) { if (xb_ld(&bar[XB_TMO])) break; if (sp > XB_SPIN_CAP) { atomicAdd(&bar[XB_TMO], 1u); break; } }
    }
    nloc = mine > 0u ? mine : 1u; nx = cnt > 0u ? cnt : 1u;
}
__device__ __forceinline__ void xcd_barrier(const XcdBarrier& b, const int wave) {
    asm volatile("s_waitcnt vmcnt(0)" ::: "memory");
    __syncthreads();
    if (wave == 0 && fresh_lane() == 0) {
        unsigned* bar = b.bar;
        __builtin_amdgcn_s_waitcnt(0);
        unsigned nloc = b.st[0], nx = b.st[1];
        if (nloc == 0u) { xcd_barrier_complete(bar, b.x, nloc, nx); b.st[0] = nloc; b.st[1] = nx; }
        const unsigned old = xb_add(&bar[XB_XSUB(b.x)], 1u);
        const unsigned gen = old / nloc;
        if (old + 1u == (gen + 1u) * nloc) {
            __builtin_amdgcn_fence(__ATOMIC_RELEASE, "agent");
            asm volatile("s_waitcnt vmcnt(0)" ::: "memory");
            const unsigned og = xb_add(&bar[XB_TOP], 1u);
            const unsigned tg = og / nx;
            if (og + 1u == (tg + 1u) * nx) xb_add(&bar[XB_TOPGEN], 1u);
            else XB_SPIN(xb_ld(&bar[XB_TOPGEN]) == tg, bar);
            __builtin_amdgcn_fence(__ATOMIC_ACQUIRE, "agent");
            xb_add(&bar[XB_XGEN(b.x)], 1u);
            asm volatile("s_waitcnt vmcnt(0)" ::: "memory");
        } else {
            XB_SPIN(xb_ld(&bar[XB_XGEN(b.x)]) == gen, bar);
            __builtin_amdgcn_fence(__ATOMIC_ACQUIRE, "agent");
            asm volatile("s_waitcnt vmcnt(0)" ::: "memory");
        }
    }
    __syncthreads();
}

struct Frame {
    LAS unsigned char* lds; volatile LAS unsigned* MISC; unsigned char* ws;
    int wave, vcu, G;
};
typedef __attribute__((address_space(4))) const unsigned long long* kargp_t;
__device__ __forceinline__ float* out_ptr() { kargp_t ka = (kargp_t)__builtin_amdgcn_kernarg_segment_ptr(); return (float*)(GAS float*)(ka[N_IN]); }
__device__ __forceinline__ const float* in_ptr(const Frame&, int idx) { kargp_t ka = (kargp_t)__builtin_amdgcn_kernarg_segment_ptr(); return (const float*)(const GAS float*)(ka[idx]); }

struct MatDesc { int in_idx; unsigned src_off  ; int K, Nsrc, Ndst, kind  ; unsigned long long dst  ; };
constexpr int NMAT = 10 + 2 + 2 + 16 + 16, NMAT0 = 4;
struct MatTable { MatDesc m[NMAT]; int item0[NMAT + 1]; };
constexpr MatTable make_mats() {
    MatTable t{}; int n = 0;
    auto add = [&](int in_idx, unsigned src_off, int K, int Nsrc, int Ndst, int kind, unsigned long long dst) { t.m[n] = MatDesc{in_idx, src_off, K, Nsrc, Ndst, kind, dst}; ++n; };
    add(I_A_WIN, 0, DM, A_IN, A_IN, 0, WS_WA_IN); add(I_A_WOUT, 0, DM, DM, DM, 0, WS_WA_OUT);
    add(I_FFN_GU, 0, DM, 2 * FF, 2 * FF, 2, WS_FFN_GU); add(I_FFN_DOWN, 0, FF, DM, DM, 0, WS_FFN_DN);
    add(I_B_WIN, 0, DM, B_IN, B_INP, 0, WS_WB_IN); add(I_B_WQB, 0, 384, 1536, 1536, 0, WS_WB_QB); add(I_B_WKVB, 0, 256, 2048, 2048, 0, WS_WB_KVB); add(I_B_WOUT, 0, DM, DM, DM, 0, WS_WB_OUT);
    add(I_C_WIN, 0, DM, C_IN, C_IN, 3, WS_WC_IN); add(I_C_WOUT, 0, DM, DM, DM, 0, WS_WC_OUT);
    add(I_D_WIN, 0, DM, D_IN, D_IN, 0, WS_WD_IN); add(I_D_WOUT, 0, DM, DM, DM, 0, WS_WD_OUT);
    add(I_FFN_GU, (unsigned)1 * DM * 2 * FF, DM, 2 * FF, 2 * FF, 2, WS_FFN_GU + SZ_GU); add(I_FFN_DOWN, (unsigned)1 * FF * DM, FF, DM, DM, 0, WS_FFN_DN + SZ_DN);
    for (int j = 0; j < 16; ++j) add(I_MOE_GU, (unsigned)j * DM * 2 * FF, DM, 2 * FF, 2 * FF, 2, WS_MOE_GU + (size_t)j * SZ_GU);
    for (int j = 0; j < 16; ++j) add(I_MOE_DOWN, (unsigned)j * FF * DM, FF, DM, DM, 0, WS_MOE_DN + (size_t)j * SZ_DN);
    int acc = 0; for (int i = 0; i < NMAT; ++i) { t.item0[i] = acc; acc += (t.m[i].K / 64) * (t.m[i].Ndst / 64); } t.item0[NMAT] = acc;
    return t;
}
__device__ const MatTable g_mats = make_mats();

__host__ __device__ __forceinline__ int gqa_dim(int c) { const int wc = c >> 5, fq = (c >> 3) & 3, e = c & 7; return 64 * (wc >> 1) + 32 * (fq >> 1) + 16 * (wc & 1) + 8 * (fq & 1) + e; }
constexpr int P0_SCR = 64 * 65 * 4;
__device__ __forceinline__ void p0_transpose_item(const float* W, int K, int Nsrc, int kind, bf16_t* WT, LAS float* scr, int item, int Ndst, int lane) {
    const int nblk = Ndst / 64, kb = item / nblk, nb = item % nblk, k0 = 64 * kb, n0 = 64 * nb;
    int s0;
    if (kind == 1 || kind == 2) { const int pn = n0 >> 8, bj = (n0 >> 7) & 1, cc = n0 & 127; s0 = bj * FF + 128 * pn + cc; } else s0 = n0;
    int sl = s0 + lane;
    if (kind == 3) { const int n = n0 + lane; sl = (n < 1280) ? (n & ~127) + gqa_dim(n & 127) : n; }
    const bool ok = (kind >= 1) || (n0 + lane < Nsrc);
    const float* src = W + (size_t)k0 * Nsrc + sl;
    float tv[64];
#pragma unroll
    for (int kk = 0; kk < 64; ++kk) tv[kk] = ok ? __builtin_nontemporal_load(src + (size_t)kk * Nsrc) : 0.f;
#pragma unroll
    for (int kk = 0; kk < 64; ++kk) scr[kk * 65 + lane] = tv[kk];
    asm volatile("s_waitcnt lgkmcnt(0)" ::: "memory");
    if (kind == 2) {
        const int c = lane & 3; unsigned char* WT8 = (unsigned char*)WT;
        const float fs = ((n0 >> 7) & 1) ? 32.f : -32.f * 1.4426950408889634f;
#pragma unroll
        for (int j = 0; j < 4; ++j) { const int n = (lane >> 2) + 16 * j; const LAS float* sp = scr + (16 * c) * 65 + n;
            u32x4 o; o.x = pk4_fp8(fs * sp[0 * 65], fs * sp[1 * 65], fs * sp[2 * 65], fs * sp[3 * 65]); o.y = pk4_fp8(fs * sp[4 * 65], fs * sp[5 * 65], fs * sp[6 * 65], fs * sp[7 * 65]);
            o.z = pk4_fp8(fs * sp[8 * 65], fs * sp[9 * 65], fs * sp[10 * 65], fs * sp[11 * 65]); o.w = pk4_fp8(fs * sp[12 * 65], fs * sp[13 * 65], fs * sp[14 * 65], fs * sp[15 * 65]);
            *(u32x4*)(WT8 + (size_t)(n0 + n) * K + k0 + 16 * c) = o; }
    } else {
    const int c = lane & 7;
#pragma unroll
    for (int j = 0; j < 8; ++j) { const int n = (lane >> 3) + 8 * j; const LAS float* sp = scr + (8 * c) * 65 + n;
        u32x4 o; o.x = pk2(sp[0 * 65], sp[1 * 65]); o.y = pk2(sp[2 * 65], sp[3 * 65]); o.z = pk2(sp[4 * 65], sp[5 * 65]); o.w = pk2(sp[6 * 65], sp[7 * 65]);
        *(u32x4*)(WT + (size_t)(n0 + n) * K + k0 + 8 * c) = o; }
    }
    asm volatile("s_waitcnt lgkmcnt(0)" ::: "memory");
}

__device__ __forceinline__ void p0_convert(Frame& F, int it0, int it1, int worker, int nworkers, int lane) {
    LAS float* scr = (LAS float*)(F.lds + F.wave * P0_SCR);
    for (int it = it0 + worker; it < it1; it += nworkers) {
        int mi = 0;
#pragma unroll 1
        for (int j = 1; j < NMAT; ++j) mi = (it >= g_mats.item0[j]) ? j : mi;
        const MatDesc d = g_mats.m[mi];
        p0_transpose_item(in_ptr(F, d.in_idx) + d.src_off, d.K, d.Nsrc, d.kind, (bf16_t*)(F.ws + d.dst), scr, it - g_mats.item0[mi], d.Ndst, lane);
    }
}
__device__ __forceinline__ int p0_split_item() { const int i0 = g_mats.item0[NMAT0], i1 = g_mats.item0[NMAT]; return i0 + (int)((long)(i1 - i0) * 0 / 100); }
__device__ __forceinline__ void p0_prologue(Frame& F) {
    const int lane = fresh_lane(), tid = F.wave * 64 + lane; (void)tid;
    const int gw = F.vcu * NWAVES + F.wave, NGW = F.G * NWAVES;
    p0_convert(F, 0, p0_split_item(), gw, NGW, lane);
    __syncthreads();
    {
        LAS float* cond = (LAS float*)F.lds;
        LAS float* part = (LAS float*)(F.lds + 65536);
        const float* cin = in_ptr(F, I_C); const float* cctx = in_ptr(F, I_CCTX);
        for (int i = tid; i < 9 * DM; i += 512) { const int r = i / DM, k = i % DM; const float v = (r < 8) ? cin[r * DM + k] : cctx[k]; cond[i] = silu_f(v); }
        __syncthreads();
        const float* mw = in_ptr(F, I_MODW); const float* mb = in_ptr(F, I_MODB);
        float* modt = (float*)(F.ws + WS_MOD);
        constexpr int NITEM = DEPTH * (6 * DM / 64);
        for (int it = F.vcu; it < NITEM; it += F.G) {
            const int l = it / 96, cb = it % 96, col = cb * 64 + lane;
            float a[9];
#pragma unroll
            for (int r = 0; r < 9; ++r) a[r] = 0.f;
            const float* wp = mw + ((size_t)l * DM + F.wave * 128) * (6 * DM) + col;
#pragma unroll 8
            for (int k = 0; k < 128; ++k) { const float w = wp[(size_t)k * (6 * DM)];
#pragma unroll
                for (int r = 0; r < 9; ++r) a[r] = fmaf(cond[r * DM + F.wave * 128 + k], w, a[r]); }
#pragma unroll
            for (int r = 0; r < 9; ++r) part[(F.wave * 9 + r) * 64 + lane] = a[r];
            __syncthreads();
            for (int i = tid; i < 9 * 64; i += 512) { const int r = i / 64, c = i % 64; float s = mb[(size_t)l * 6 * DM + cb * 64 + c];
#pragma unroll
                for (int w = 0; w < 8; ++w) s += part[(w * 9 + r) * 64 + c];
                modt[((size_t)l * 9 + r) * (6 * DM) + cb * 64 + c] = s; }
            __syncthreads();
        }
    }
    {
        float* rt = (float*)(F.ws + WS_ROPE);
        for (int i = gw * 64 + lane; i < 3 * 64 * 32; i += NGW * 64) { const int kind = i / 2048, pos = (i / 32) % 64, fi = i % 32; const int n = 16 << kind;
            if (fi < n / 2) { const float inv = exp2f(-(float)(2 * fi) / (float)n * 13.287712379549449f);
                const float ang = (float)pos * inv; float s, c;
                {
                  const float rev = ang * 0.15915494309189535f; const float fr = rev - floorf(rev); s = __builtin_amdgcn_sinf(fr); c = __builtin_amdgcn_cosf(fr); }
                rt[(size_t)i * 2] = c; rt[(size_t)i * 2 + 1] = s; } }
    }
    {
        const float* alb = in_ptr(F, I_A_LB); float* lb = (float*)(F.ws + WS_LB);
        for (int i = gw * 64 + lane; i < 2 * 1024; i += NGW * 64) { const int dir = i / 1024, w = i % 1024; float v[5], mx = -1e30f;
#pragma unroll
            for (int j = 0; j < 5; ++j) { v[j] = alb[((size_t)dir * 5 + j) * 1024 + w]; mx = fmaxf(mx, v[j]); }
            float s = 0.f;
#pragma unroll
            for (int j = 0; j < 5; ++j) s += expf(v[j] - mx);
            lb[i] = expf(v[0] - mx) / s; }
    }
}

struct RowPos { int b, p, modrow, prow, pcol; bool isctx; };
__device__ __forceinline__ RowPos row_pos(int m) { RowPos r; r.b = m / TPB; r.p = m % TPB; r.isctx = r.p < CTXL; r.modrow = r.isctx ? 8 : r.b; const int t = r.isctx ? 0 : r.p - CTXL; r.prow = t >> 6; r.pcol = t & 63; return r; }
__device__ __forceinline__ void ld_row(const float* p, int lane, f32x4 (&v)[4]) {
#pragma unroll
    for (int j = 0; j < 4; ++j) v[j] = *(const f32x4*)(p + 256 * j + 4 * lane);
}
__device__ __forceinline__ void ld_row_bf16(const bf16_t* p, int lane, f32x4 (&v)[4]) {
#pragma unroll
    for (int j = 0; j < 4; ++j) { const u32x2 w = *(const u32x2*)(p + 256 * j + 4 * lane); v[j] = (f32x4){bf2f(w.x & 0xffffu), bf2f(w.x >> 16), bf2f(w.y & 0xffffu), bf2f(w.y >> 16)}; }
}
__device__ __forceinline__ void st_row_bf16(bf16_t* p, int lane, const f32x4 (&v)[4]) {
#pragma unroll
    for (int j = 0; j < 4; ++j) { u32x2 w; w.x = pk2(v[j].x, v[j].y); w.y = pk2(v[j].z, v[j].w); *(u32x2*)(p + 256 * j + 4 * lane) = w; }
}
__device__ __forceinline__ float sumsq_row(const f32x4 (&v)[4]) { float s = 0.f;
#pragma unroll
    for (int j = 0; j < 4; ++j) s += (v[j].x * v[j].x + v[j].y * v[j].y) + (v[j].z * v[j].z + v[j].w * v[j].w);
    return wave_sum(s); }
__device__ __forceinline__ void norm_mod_store(const f32x4 (&x)[4], float rstd, const float* g, const float* shift, const float* scale, bf16_t* dst, int lane, f32x4 (&u)[4]) {
#pragma unroll
    for (int j = 0; j < 4; ++j) { const int c = 256 * j + 4 * lane; const f32x4 gg = *(const f32x4*)(g + c), sh = *(const f32x4*)(shift + c), sc = *(const f32x4*)(scale + c);
        u[j] = (x[j] * rstd * gg) * (sc + 1.0f) + sh;
        u32x2 w; w.x = pk2(u[j].x, u[j].y); w.y = pk2(u[j].z, u[j].w); *(u32x2*)(dst + c) = w; }
}

__device__ __forceinline__ void norm_mod_store_fp8(const f32x4 (&x)[4], float rstd, const float* g, const float* shift, const float* scale, unsigned char* dst, int lane, f32x4 (&u)[4]) {
#pragma unroll
    for (int j = 0; j < 4; ++j) { const int c = 256 * j + 4 * lane; const f32x4 gg = *(const f32x4*)(g + c), sh = *(const f32x4*)(shift + c), sc = *(const f32x4*)(scale + c);
        u[j] = (x[j] * rstd * gg) * (sc + 1.0f) + sh;
        *(unsigned*)(dst + c) = pk4_fp8(u[j].x, u[j].y, u[j].z, u[j].w); }
}
__device__ __forceinline__ void ld_y_row(const unsigned char* ws, int m, const RowPos& rp, int S, int lane, f32x4 (&yv)[4]) {
    if (rp.isctx) { const float* ys = (const float*)(ws + WS_YS) + (size_t)(rp.b * CTXL + rp.p) * DM;
        ld_row(ys, lane, yv);
        for (int s = 1; s < S; ++s) { f32x4 t[4]; ld_row(ys + (size_t)s * 2048 * DM, lane, t);
#pragma unroll
            for (int j = 0; j < 4; ++j) yv[j] = yv[j] + t[j]; } }
    else ld_row_bf16((const bf16_t*)(ws + WS_Y) + (size_t)m * DM, lane, yv);
}
__device__ __forceinline__ void ld_yp_row(const unsigned char* ws, size_t r, int RBM, int trb, int S, int lane, f32x4 (&v)[4]) {
    const int rb = (int)(r >> 8);
    if (rb >= RBM) { const float* ys = (const float*)(ws + WS_YS) + ((size_t)(rb - RBM) * 256 + (r & 255)) * DM;
        ld_row(ys, lane, v);
        for (int s = 1; s < S; ++s) { f32x4 t[4]; ld_row(ys + (size_t)s * trb * 256 * DM, lane, t);
#pragma unroll
            for (int j = 0; j < 4; ++j) v[j] = v[j] + t[j]; } }
    else ld_row_bf16((const bf16_t*)(ws + WS_YP) + r * DM, lane, v);
}
__device__ __forceinline__ float half_sum(float v) {
#pragma unroll
    for (int o = 1; o < 32; o <<= 1) v += __shfl_xor(v, o);
    return v;
}
__device__ __forceinline__ void ld_row2(const float* p, int l32, f32x4 (&v)[8]) {
#pragma unroll
    for (int j = 0; j < 8; ++j) v[j] = __builtin_nontemporal_load((const f32x4*)(p + 128 * j + 4 * l32));
}
__device__ __forceinline__ void ld_row2_bf16(const bf16_t* p, int l32, f32x4 (&v)[8]) {
#pragma unroll
    for (int j = 0; j < 8; ++j) { const u32x2 w = __builtin_nontemporal_load((const u32x2*)(p + 128 * j + 4 * l32)); v[j] = (f32x4){bf2f(w.x & 0xffffu), bf2f(w.x >> 16), bf2f(w.y & 0xffffu), bf2f(w.y >> 16)}; }
}
__device__ __forceinline__ void st_row2_bf16(bf16_t* p, int l32, const f32x4 (&v)[8]) {
#pragma unroll
    for (int j = 0; j < 8; ++j) { u32x2 w; w.x = pk2(v[j].x, v[j].y); w.y = pk2(v[j].z, v[j].w); __builtin_nontemporal_store(w, (u32x2*)(p + 128 * j + 4 * l32)); }
}
__device__ __forceinline__ float sumsq_row2(const f32x4 (&v)[8]) { float s = 0.f;
#pragma unroll
    for (int j = 0; j < 8; ++j) s += (v[j].x * v[j].x + v[j].y * v[j].y) + (v[j].z * v[j].z + v[j].w * v[j].w);
    return half_sum(s); }
template <bool FP8>
__device__ __forceinline__ void norm_mod2(const f32x4 (&x)[8], float rstd, const LAS float* g, const LAS float* shift, const LAS float* scale, void* dst, int l32, bool st, f32x4 (&u)[8]) {
#pragma unroll
    for (int j = 0; j < 8; ++j) { if ((j & 3) == 0) __builtin_amdgcn_sched_barrier(0);
        const int c = 128 * j + 4 * l32; const f32x4 gg = *(const LAS f32x4*)(g + c), sh = *(const LAS f32x4*)(shift + c), sc = *(const LAS f32x4*)(scale + c);
        u[j] = (x[j] * rstd * gg) * (sc + 1.0f) + sh;
        if (st) { if (FP8) *(unsigned*)((unsigned char*)dst + c) = pk4_fp8(u[j].x, u[j].y, u[j].z, u[j].w);
                  else { u32x2 w; w.x = pk2(u[j].x, u[j].y); w.y = pk2(u[j].z, u[j].w); *(u32x2*)((bf16_t*)dst + c) = w; } } }
}
constexpr int PAR_FLOATS = 29 * DM;
__device__ __forceinline__ void fill_params(Frame& F, const float* ga, const float* gb, const float* m0, const float* m1, const float* m2, int tid) {
    LAS float* par = (LAS float*)F.lds;
    for (int i = tid; i < PAR_FLOATS / 4; i += NWAVES * 64) { const int v = i >> 8, c = (i & 255) * 4; const float* src;
        if (v == 0) src = ga; else if (v == 1) src = gb; else { const int r = (v - 2) / 3, k = (v - 2) % 3; src = (k == 0 ? m0 : k == 1 ? m1 : m2) + (size_t)r * (6 * DM); }
        *(LAS f32x4*)(par + v * DM + c) = *(const f32x4*)(src + c); }
    __syncthreads();
}
__device__ __forceinline__ void ld_y_row2(const unsigned char* ws, int m, const RowPos& rp, bool slab, int S, int l32, f32x4 (&yv)[8]) {
    if (slab) { const float* ys = (const float*)(ws + WS_YS) + (size_t)(rp.b * CTXL + rp.p) * DM;
        ld_row2(ys, l32, yv);
#pragma unroll 1
        for (int s = 1; s < S; ++s) { f32x4 t[8]; ld_row2(ys + (size_t)s * 2048 * DM, l32, t);
#pragma unroll
            for (int j = 0; j < 8; ++j) yv[j] = yv[j] + t[j]; } }
    else ld_row2_bf16((const bf16_t*)(ws + WS_Y) + (size_t)m * DM, l32, yv);
}
__device__ __forceinline__ void ld_yp_row2(const unsigned char* ws, size_t r, int RBM, int trb, int S, int l32, f32x4 (&v)[8]) {
    const int rb = (int)(r >> 8);
    if (rb >= RBM) { const float* ys = (const float*)(ws + WS_YS) + ((size_t)(rb - RBM) * 256 + (r & 255)) * DM;
        ld_row2(ys, l32, v);
#pragma unroll 1
        for (int s = 1; s < S; ++s) { f32x4 t[8]; ld_row2(ys + (size_t)s * trb * 256 * DM, l32, t);
#pragma unroll
            for (int j = 0; j < 8; ++j) v[j] = v[j] + t[j]; } }
    else ld_row2_bf16((const bf16_t*)(ws + WS_YP) + r * DM, l32, v);
}

__device__ __forceinline__ void phase_r0(Frame& F) {
    const int lane = fresh_lane(), l32 = lane & 31, half = lane >> 5;
    const int gw = F.vcu * NWAVES + F.wave, NGW = F.G * NWAVES;
    const float* x = in_ptr(F, I_X); const float* ctx = in_ptr(F, I_CTX); const float* ng = in_ptr(F, I_NORMG);
    bf16_t* h = (bf16_t*)(F.ws + WS_H); bf16_t* xa = (bf16_t*)(F.ws + WS_XA); const float* modt = (const float*)(F.ws + WS_MOD);
    fill_params(F, ng + (0 * 4 + 0) * DM, ng + (0 * 4 + 0) * DM, modt + 0 * DM, modt + 1 * DM, modt + 1 * DM, F.wave * 64 + lane);
    const LAS float* par = (const LAS float*)F.lds;
    for (int pi = gw; pi < T / 2; pi += NGW) { const int m = 2 * pi + half; const RowPos rp = row_pos(m);
        const float* src = rp.isctx ? ctx + ((size_t)rp.b * CTXL + rp.p) * DM : x + ((size_t)rp.b * SEQ + (rp.p - CTXL)) * DM;
        f32x4 v[8], u[8]; ld_row2(src, l32, v);
        st_row2_bf16(h + (size_t)m * DM, l32, v);
        const float rstd = rsqrtf(sumsq_row2(v) * (1.0f / DM) + NORM_EPS);
        const LAS float* pm = par + (2 + 3 * rp.modrow) * DM;
        norm_mod2<false>(v, rstd, par, pm + 0 * DM, pm + 1 * DM, xa + (size_t)m * DM, l32, true, u); }
    __syncthreads();
}

template <bool MOE>
__device__ __forceinline__ void phase_r1(Frame& F, int l) {
    const int lane = fresh_lane(), tid = F.wave * 64 + lane, l32 = lane & 31, half = lane >> 5;
    const float* ng = in_ptr(F, I_NORMG); const float* modt = (const float*)(F.ws + WS_MOD);
    bf16_t* h = (bf16_t*)(F.ws + WS_H); unsigned char* xa = (unsigned char*)(F.ws + WS_XA);
    const float* router = MOE ? in_ptr(F, I_MOE_ROUTER) + (size_t)(l >> 1) * DM * NEXP : nullptr;
    constexpr int LB = PAR_FLOATS * 4;
    LAS int* lcnt = (LAS int*)(F.lds + LB);
    LAS int* lbase = (LAS int*)(F.lds + LB + 64);
    LAS int* lrow = (LAS int*)(F.lds + LB + 1024);
    LAS float* lw = (LAS float*)(F.lds + LB + 4096);
    constexpr int RPW = T / 256;
    if (MOE) { if (tid < 8) lcnt[tid] = 0; }
    { const float* ml = modt + (size_t)l * 9 * (6 * DM); fill_params(F, ng + (l * 4 + 1) * DM, ng + (l * 4 + 2) * DM, ml + 2 * DM, ml + 3 * DM, ml + 4 * DM, tid); }
    const LAS float* par = (const LAS float*)F.lds;
    LAS f32x4* rtA = (LAS f32x4*)(F.lds + LB + 8192); LAS f32x4* rtB = rtA + 1024;
    if (MOE) { for (int c = tid; c < DM; c += NWAVES * 64) { const int slot = ((c & 3) * 8 + (c >> 7)) * 32 + ((c & 127) >> 2);
            rtA[slot] = *(const f32x4*)(router + (size_t)c * 8); rtB[slot] = *(const f32x4*)(router + (size_t)c * 8 + 4); }
        __syncthreads(); }
#define R1_ROW(i) ((i) * 256 + F.vcu)
    f32x4 yn[8], hn[8];
    { const int m0 = R1_ROW(2 * F.wave + half); const RowPos r0 = row_pos(m0); ld_y_row2(F.ws, m0, r0, r0.isctx && !(l == DEPTH - 1), 4, l32, yn); ld_row2_bf16(h + (size_t)m0 * DM, l32, hn); }
    for (int i2 = F.wave; i2 < RPW / 2; i2 += NWAVES) { const int i = 2 * i2 + half, m = R1_ROW(i); const RowPos rp = row_pos(m);
        const bool skip = (l == DEPTH - 1) && rp.isctx;
        const LAS float* pm = par + (2 + 3 * rp.modrow) * DM;
        f32x4 yv[8], hv[8], u[8];
#pragma unroll
        for (int j = 0; j < 8; ++j) { yv[j] = yn[j]; hv[j] = hn[j]; }
        if (i2 + NWAVES < RPW / 2) { const int mn = R1_ROW(i + 2 * NWAVES); const RowPos rn = row_pos(mn); ld_y_row2(F.ws, mn, rn, rn.isctx && !(l == DEPTH - 1), 4, l32, yn); ld_row2_bf16(h + (size_t)mn * DM, l32, hn); }
        const float rstd_y = rsqrtf(sumsq_row2(yv) * (1.0f / DM) + NORM_EPS);
#pragma unroll
        for (int j = 0; j < 8; ++j) { if ((j & 3) == 0) __builtin_amdgcn_sched_barrier(0);
            const int c = 128 * j + 4 * l32; const f32x4 g1 = *(const LAS f32x4*)(par + c), gt = *(const LAS f32x4*)(pm + c);
            hv[j] = hv[j] + gt * (yv[j] * rstd_y * g1); }
        if (!skip) st_row2_bf16(h + (size_t)m * DM, l32, hv);
        const float rstd_h = rsqrtf(sumsq_row2(hv) * (1.0f / DM) + NORM_EPS);
        norm_mod2<true>(hv, rstd_h, par + DM, pm + 1 * DM, pm + 2 * DM, xa + (size_t)m * DM, l32, !skip, u);
        if (MOE) {
            float lg[8];
#pragma unroll
            for (int e = 0; e < 8; ++e) lg[e] = 0.f;
#pragma unroll
            for (int j = 0; j < 8; ++j) { __builtin_amdgcn_sched_barrier(0);
#pragma unroll
                for (int q = 0; q < 4; ++q) { const f32x4 r0 = rtA[(q * 8 + j) * 32 + l32], r1 = rtB[(q * 8 + j) * 32 + l32]; const float uv = u[j][q];
                    lg[0] = fmaf(uv, r0.x, lg[0]); lg[1] = fmaf(uv, r0.y, lg[1]); lg[2] = fmaf(uv, r0.z, lg[2]); lg[3] = fmaf(uv, r0.w, lg[3]);
                    lg[4] = fmaf(uv, r1.x, lg[4]); lg[5] = fmaf(uv, r1.y, lg[5]); lg[6] = fmaf(uv, r1.z, lg[6]); lg[7] = fmaf(uv, r1.w, lg[7]); } }
#pragma unroll
            for (int e = 0; e < 8; ++e) lg[e] = half_sum(lg[e]);
            int e1 = 0; float v1 = lg[0];
#pragma unroll
            for (int e = 1; e < 8; ++e) if (lg[e] > v1) { v1 = lg[e]; e1 = e; }
            int e2 = (e1 == 0) ? 1 : 0; float v2 = (e1 == 0) ? lg[1] : lg[0];
#pragma unroll
            for (int e = 1; e < 8; ++e) if (e != e1 && lg[e] > v2) { v2 = lg[e]; e2 = e; }
            const float w2 = fast_rcp(1.0f + expf(v1 - v2)), w1 = 1.0f - w2;
            if (l32 == 0) { if (skip) lrow[i * 4 + 0] = -1;
                else { lrow[i * 4 + 0] = e1; lrow[i * 4 + 2] = e2; lw[i * 2] = w1; lw[i * 2 + 1] = w2; } }
        }
    }
    if (MOE) {
        __syncthreads();
        if (F.wave == 0) { int cnt[8];
#pragma unroll
            for (int e = 0; e < 8; ++e) cnt[e] = 0;
#pragma unroll
            for (int c0 = 0; c0 < RPW; c0 += 64) { const int i = c0 + lane; const bool in = i < RPW; const int a = in ? lrow[i * 4] : -1, b = in ? lrow[i * 4 + 2] : -1;
#pragma unroll
                for (int e = 0; e < 8; ++e) { const bool hit = (a >= 0) && (a == e || b == e); const unsigned long long mk = __ballot(hit);
                    const int rank = (int)__builtin_amdgcn_mbcnt_hi((unsigned)(mk >> 32), __builtin_amdgcn_mbcnt_lo((unsigned)mk, 0u));
                    if (hit) lrow[i * 4 + (a == e ? 1 : 3)] = cnt[e] + rank;
                    cnt[e] += __popcll(mk); } }
            int myc = 0;
#pragma unroll
            for (int e = 0; e < 8; ++e) myc = (lane == e) ? cnt[e] : myc;
            if (lane < 8) { lcnt[lane] = myc; ((int*)(F.ws + WS_WCNT))[F.vcu * 8 + lane] = myc;
                __hip_atomic_fetch_add((int*)((unsigned*)F.ws + CW_MOECNT + (l >> 1) * 64) + lane, myc, __ATOMIC_RELAXED, __HIP_MEMORY_SCOPE_AGENT); } }
        __syncthreads();
        int* route = (int*)(F.ws + WS_ROUTE);
        for (int i = tid; i < RPW; i += 512) { const int m = R1_ROW(i); const int e1 = lrow[i * 4], e2 = lrow[i * 4 + 2]; route[(size_t)m * 8 + 0] = e1; if (e1 < 0) continue;
            route[(size_t)m * 8 + 1] = lrow[i * 4 + 1]; route[(size_t)m * 8 + 2] = e2; route[(size_t)m * 8 + 3] = lrow[i * 4 + 3];
            ((float*)route)[(size_t)m * 8 + 4] = lw[i * 2]; ((float*)route)[(size_t)m * 8 + 5] = lw[i * 2 + 1]; }
        __syncthreads();
    }
}
__device__ __forceinline__ void moe_build(Frame& F) {
    const int lane = fresh_lane(), tid = F.wave * 64 + lane;
    LAS int* red = (LAS int*)F.lds;
    const int* wcnt = (const int*)(F.ws + WS_WCNT);
    { const int e = tid & 7; int sacc = 0; for (int v = tid >> 3; v < F.vcu; v += 64) sacc += wcnt[v * 8 + e]; red[tid] = sacc; }
    __syncthreads();
    if (F.wave == 0) { const int e = lane & 7, part = lane >> 3; int sacc = 0;
#pragma unroll
        for (int k = 0; k < 8; ++k) sacc += red[(part * 8 + k) * 8 + e];
        sacc += __shfl_xor(sacc, 8); sacc += __shfl_xor(sacc, 16); sacc += __shfl_xor(sacc, 32);
        if (lane < 8) red[512 + lane] = sacc; }
    __syncthreads();
    constexpr int RPW = T / 256;
    int* list = (int*)(F.ws + WS_LIST); int* route = (int*)(F.ws + WS_ROUTE);
    for (int i = tid; i < RPW; i += 512) { const int m = R1_ROW(i); const int e1 = route[(size_t)m * 8]; if (e1 < 0) continue; const int e2 = route[(size_t)m * 8 + 2];
        const int s1 = red[512 + e1] + route[(size_t)m * 8 + 1], s2 = red[512 + e2] + route[(size_t)m * 8 + 3];
        list[(size_t)e1 * T + s1] = m; list[(size_t)e2 * T + s2] = m; route[(size_t)m * 8 + 1] = s1; route[(size_t)m * 8 + 3] = s2; }
}

__device__ __forceinline__ void moe_tables(Frame& F, int l) {
    const int lane = fresh_lane(), tid = F.wave * 64 + lane; (void)tid;
    if (tid == 0) { const int* gcnt = (const int*)((unsigned*)F.ws + CW_MOECNT + (l >> 1) * 64); int acc = 0;
        for (int e = 0; e < 8; ++e) { const int c = __hip_atomic_load(gcnt + e, __ATOMIC_RELAXED, __HIP_MEMORY_SCOPE_AGENT); F.MISC[32 + e] = (unsigned)c; F.MISC[16 + e] = (unsigned)acc; acc += (c + 255) / 256; }
        F.MISC[24] = (unsigned)acc; }
    __syncthreads();
}

template <bool MOE>
__device__ __forceinline__ void phase_r2(Frame& F, int l) {
    const int lane = fresh_lane(), l32 = lane & 31, half = lane >> 5;
    const int gw = F.vcu * NWAVES + F.wave, NGW = F.G * NWAVES;
    const float* ng = in_ptr(F, I_NORMG); const float* modt = (const float*)(F.ws + WS_MOD);
    bf16_t* h = (bf16_t*)(F.ws + WS_H); bf16_t* xa = (bf16_t*)(F.ws + WS_XA);
    const int* route = (const int*)(F.ws + WS_ROUTE);
    int RBM = 0, trb = 0, S = 1; if (MOE) pg8::moe_tail_params((int)F.MISC[24], RBM, trb, S);
    { const int ln = (l < DEPTH - 1) ? l + 1 : l; const float* ml = modt + (size_t)l * 9 * (6 * DM); const float* mn = modt + (size_t)ln * 9 * (6 * DM);
      fill_params(F, ng + (l * 4 + 3) * DM, ng + (ln * 4 + 0) * DM, ml + 5 * DM, mn + 0 * DM, mn + 1 * DM, F.wave * 64 + lane); }
    const LAS float* par = (const LAS float*)F.lds;
    f32x4 an[8], bn[8], hn[8]; float w1n = 0.f, w2n = 0.f;
#define R2_LOAD(mm) do { const RowPos _r = row_pos(mm); const bool _sk = (l == DEPTH - 1) && _r.isctx; \
        if (MOE) { int e1 = 0, s1 = 0, e2 = 0, s2 = 0; w1n = 0.f; w2n = 0.f; \
            if (!_sk) { e1 = route[(size_t)(mm) * 8]; s1 = route[(size_t)(mm) * 8 + 1]; e2 = route[(size_t)(mm) * 8 + 2]; s2 = route[(size_t)(mm) * 8 + 3]; w1n = ((const float*)route)[(size_t)(mm) * 8 + 4]; w2n = ((const float*)route)[(size_t)(mm) * 8 + 5]; } \
            const size_t r1 = (size_t)F.MISC[16 + e1] * 256 + s1, r2 = (size_t)F.MISC[16 + e2] * 256 + s2; \
            ld_yp_row2(F.ws, r1, RBM, trb, S, l32, an); ld_yp_row2(F.ws, r2, RBM, trb, S, l32, bn); } \
        else ld_y_row2(F.ws, (mm), _r, _r.isctx, 4, l32, an); \
        ld_row2_bf16(h + (size_t)(mm) * DM, l32, hn); } while (0)
    if (gw < T / 2) R2_LOAD(2 * gw + half);
    for (int pi = gw; pi < T / 2; pi += NGW) { const int m = 2 * pi + half; const RowPos rp = row_pos(m);
        const bool skip = (l == DEPTH - 1) && rp.isctx;
        const LAS float* pm = par + (2 + 3 * rp.modrow) * DM;
        f32x4 yv[8], hv[8], u[8];
#pragma unroll
        for (int j = 0; j < 8; ++j) { yv[j] = MOE ? (an[j] * w1n + bn[j] * w2n) : an[j]; hv[j] = hn[j]; }
        if (pi + NGW < T / 2) R2_LOAD(m + 2 * NGW);
        const float rstd_y = rsqrtf(sumsq_row2(yv) * (1.0f / DM) + NORM_EPS);
#pragma unroll
        for (int j = 0; j < 8; ++j) { if ((j & 3) == 0) __builtin_amdgcn_sched_barrier(0);
            const int c = 128 * j + 4 * l32; const f32x4 g3 = *(const LAS f32x4*)(par + c), gt = *(const LAS f32x4*)(pm + c);
            hv[j] = hv[j] + gt * (yv[j] * rstd_y * g3); }
        if (l == DEPTH - 1) { if (!skip) { float* dsto = out_ptr() + ((size_t)rp.b * SEQ + (rp.p - CTXL)) * DM;
#pragma unroll
                for (int j = 0; j < 8; ++j) __builtin_nontemporal_store(hv[j], (f32x4*)(dsto + 128 * j + 4 * l32)); } }
        else st_row2_bf16(h + (size_t)m * DM, l32, hv);
        if (l < DEPTH - 1) { const float rstd_h = rsqrtf(sumsq_row2(hv) * (1.0f / DM) + NORM_EPS);
            norm_mod2<false>(hv, rstd_h, par + DM, pm + 1 * DM, pm + 2 * DM, xa + (size_t)m * DM, l32, true, u); }
    }
}
namespace scan {
constexpr int A_STR = 272, T_STR = 80;
constexpr int A1_OFF = 0, A2_OFF = 32 * A_STR, K2T_OFF = 2 * 32 * A_STR, VT_OFF = K2T_OFF + 128 * T_STR, DEC_OFF = VT_OFF + 128 * T_STR, BUF_BYTES = DEC_OFF + 512;
constexpr int NCH = TPB / 32;
__device__ __forceinline__ int crow(int r, int hi) { return (r & 3) + 8 * (r >> 2) + 4 * hi; }
__device__ __forceinline__ int tok_of(int p, int dir) { return dir == 0 ? p : (p < CTXL ? (CTXL - 1 - p) : (TPB + CTXL - 1 - p)); }

__device__ __forceinline__ int chunk_lowtok(int n, int dir) { return dir == 0 ? 32 * n : (n < CTXL / 32 ? CTXL - 32 - 32 * n : TPB + CTXL - 32 - 32 * n); }
constexpr int RAW_OFF = 2 * BUF_BYTES, RAW_BYTES = 3 * 8192;
__device__ __forceinline__ void prep_dma(const bf16_t* __restrict__ z, int b, int hd, int dir, int n, LAS unsigned char* raw, int pw, int lane) {
    const char* U = (const char*)(z + (size_t)(b * TPB + chunk_lowtok(n, dir)) * A_IN + hd * 128);
#pragma unroll
    for (int k = 0; k < 2; ++k) { const int c = 8 * pw + 4 * k + (lane >> 4), mr = dir ? 31 - c : c; const unsigned L = (unsigned)(mr * A_IN + (lane & 15) * 8) * 2u;
        __builtin_amdgcn_global_load_lds((const unsigned*)(U + L), (LAS unsigned*)(raw + 0 * 8192 + (2 * pw + k) * 1024), 16, 0, 0);
        __builtin_amdgcn_global_load_lds((const unsigned*)(U + 2048 * (1 + dir) + L), (LAS unsigned*)(raw + 1 * 8192 + (2 * pw + k) * 1024), 16, 0, 0);
        __builtin_amdgcn_global_load_lds((const unsigned*)(U + 6144 + L), (LAS unsigned*)(raw + 2 * 8192 + (2 * pw + k) * 1024), 16, 0, 0); }
}
struct Raw { unsigned short q[16], f[16], v[16]; };
__device__ __forceinline__ void prep_read(Raw& r, const LAS unsigned char* raw, int d, int rh) {
#pragma unroll
    for (int i = 0; i < 16; ++i) { const int o = (16 * rh + i) * 256 + d * 2;
        r.q[i] = *(const LAS unsigned short*)(raw + o); r.f[i] = *(const LAS unsigned short*)(raw + 8192 + o); r.v[i] = *(const LAS unsigned short*)(raw + 16384 + o); }
}
__device__ __forceinline__ void prep_compute(const Raw& r, float lbv, LAS unsigned char* buf, int d, int rh, int lane) {
    float cum[16], kk[16]; float run = 0.f;
#pragma unroll
    for (int i = 0; i < 16; ++i) { const float s = fast_rcp(1.0f + __builtin_amdgcn_exp2f(bf2f(r.f[i]) * -1.4426950408889634f)); const float f = lbv + (1.0f - lbv) * s; kk[i] = 1.0f - f; run += __builtin_amdgcn_logf(f); cum[i] = run; }
    const float tot_lo = __shfl(run, lane & 31);
    if (rh) {
#pragma unroll
        for (int i = 0; i < 16; ++i) cum[i] += tot_lo; }
    const float cend = __shfl(cum[15], (lane & 31) + 32);
    const float dec = __builtin_amdgcn_exp2f(cend);
    unsigned short a1[16], a2[16], k2[16];
#pragma unroll
    for (int i = 0; i < 16; ++i) { const float e1 = __builtin_amdgcn_exp2f(cum[i]), e2 = __builtin_amdgcn_exp2f(-cum[i]); const float A2 = kk[i] * e2;
        const unsigned w12 = cvt_pk_bf16(bf2f(r.q[i]) * 0.08838834764831845f * e1, A2);
        a1[i] = (unsigned short)(w12 & 0xffffu); a2[i] = (unsigned short)(w12 >> 16); k2[i] = (unsigned short)(cvt_pk_bf16(A2 * dec, 0.f) & 0xffffu); }
#pragma unroll
    for (int i = 0; i < 16; ++i) { const int c = 16 * rh + i;
        *(LAS unsigned short*)(buf + A1_OFF + c * A_STR + d * 2) = a1[i]; *(LAS unsigned short*)(buf + A2_OFF + c * A_STR + d * 2) = a2[i]; }
#pragma unroll
    for (int i = 0; i < 16; i += 2) { const int c = 16 * rh + i;
        *(LAS unsigned*)(buf + K2T_OFF + d * T_STR + c * 2) = (unsigned)k2[i] | ((unsigned)k2[i + 1] << 16);
        *(LAS unsigned*)(buf + VT_OFF + d * T_STR + c * 2) = (unsigned)r.v[i] | ((unsigned)r.v[i + 1] << 16); }
    if (rh == 0) *(LAS float*)(buf + DEC_OFF + d * 4) = dec;
}
#define SCAN_BAR() do { asm volatile("s_waitcnt lgkmcnt(0)" ::: "memory"); __builtin_amdgcn_s_barrier(); asm volatile("" ::: "memory"); } while (0)

__device__ __forceinline__ bf16x8 cvt8(const f32x16& x, int base) {
    u32x4 w; w.x = cvt_pk_bf16(x[base + 0], x[base + 1]); w.y = cvt_pk_bf16(x[base + 2], x[base + 3]); w.z = cvt_pk_bf16(x[base + 4], x[base + 5]); w.w = cvt_pk_bf16(x[base + 6], x[base + 7]);
    return *reinterpret_cast<bf16x8*>(&w);
}
__device__ __forceinline__ bf16x8 ld44(const LAS unsigned char* p) {
    const u32x2 a = *(const LAS u32x2*)p, b = *(const LAS u32x2*)(p + 16); u32x4 w = {a.x, a.y, b.x, b.y}; return *reinterpret_cast<bf16x8*>(&w);
}

__device__ __forceinline__ void scan_unit(unsigned char* ws, LAS unsigned char* lds, int unit, int wave, int lane, int tid) {
    static_assert(NCH % 2 == 0, "even chunk count");
    const int b = unit >> 4, hd = (unit >> 1) & 7, dir = unit & 1;
    const bf16_t* z = (const bf16_t*)(ws + WS_Z);
    bf16_t* od = (bf16_t*)(ws + WS_O) + (size_t)dir * T * DM;
    const float* lb = (const float*)(ws + WS_LB) + dir * 1024 + hd * 128;
    const int r32 = lane & 31, hi = lane >> 5;
    if (wave >= 4) {
        const int pw = wave - 4, d = 32 * pw + r32, rh = hi; const float lbv = lb[d];
        asm volatile("s_waitcnt vmcnt(0)" ::: "memory");
        LAS unsigned char* rawb = lds + RAW_OFF; Raw R;
        prep_dma(z, b, hd, dir, 0, rawb, pw, lane); prep_dma(z, b, hd, dir, 1, rawb + RAW_BYTES, pw, lane);
        asm volatile("s_waitcnt vmcnt(6)" ::: "memory"); SCAN_BAR();
        int st = 0;
        for (int n = -1; n < NCH - 1; ++n) {
            prep_read(R, rawb + st * RAW_BYTES, d, rh); prep_compute(R, lbv, lds + ((n + 1) & 1) * BUF_BYTES, d, rh, lane);
            const int st3 = (st == 0) ? 2 : st - 1;
            if (n + 3 < NCH) { prep_dma(z, b, hd, dir, n + 3, rawb + st3 * RAW_BYTES, pw, lane); asm volatile("s_waitcnt vmcnt(6)" ::: "memory"); }
            else asm volatile("s_waitcnt vmcnt(0)" ::: "memory");
            SCAN_BAR();
            st = (st == 2) ? 0 : st + 1;
        }
        SCAN_BAR();
    } else {
        const int sw = wave;
        f32x16 S[4];
#pragma unroll
        for (int t = 0; t < 4; ++t) S[t] = f32x16{};
        SCAN_BAR(); SCAN_BAR();
        for (int n = 0; n < NCH; ++n) {
            const LAS unsigned char* buf = lds + (n & 1) * BUF_BYTES;
            f32x16 X = f32x16{}, Xb = f32x16{};
#pragma unroll
            for (int ks = 0; ks < 8; ++ks) { const bf16x8 a = *(const LAS bf16x8*)(buf + A2_OFF + r32 * A_STR + (16 * ks + 8 * hi) * 2), bb = *(const LAS bf16x8*)(buf + A1_OFF + r32 * A_STR + (16 * ks + 8 * hi) * 2);
                if (ks & 1) Xb = __builtin_amdgcn_mfma_f32_32x32x16_bf16(a, bb, Xb, 0, 0, 0); else X = __builtin_amdgcn_mfma_f32_32x32x16_bf16(a, bb, X, 0, 0, 0); }
#pragma unroll
            for (int r = 0; r < 16; ++r) X[r] = (crow(r, hi) <= r32) ? X[r] + Xb[r] : 0.f;
            f32x16 O = f32x16{};
#pragma unroll
            for (int s0 = 0; s0 < 2; ++s0) { const bf16x8 a = cvt8(X, 8 * s0); const bf16x8 bb = ld44(buf + VT_OFF + (32 * sw + r32) * T_STR + (16 * s0 + 4 * hi) * 2);
                O = __builtin_amdgcn_mfma_f32_32x32x16_bf16(a, bb, O, 0, 0, 0); }
            f32x16 O2 = f32x16{}, O3 = f32x16{};
#pragma unroll
            for (int t = 0; t < 4; ++t)
#pragma unroll
                for (int s0 = 0; s0 < 2; ++s0) { const bf16x8 a = ld44(buf + A1_OFF + r32 * A_STR + (32 * t + 16 * s0 + 4 * hi) * 2); const bf16x8 bb = cvt8(S[t], 8 * s0);
                    if (t & 1) O3 = __builtin_amdgcn_mfma_f32_32x32x16_bf16(a, bb, O3, 0, 0, 0); else O2 = __builtin_amdgcn_mfma_f32_32x32x16_bf16(a, bb, O2, 0, 0, 0); }
#pragma unroll
            for (int r = 0; r < 16; ++r) O[r] += O2[r] + O3[r];
#pragma unroll
            for (int r = 0; r < 16; ++r) { const int p = 32 * n + crow(r, hi); od[(size_t)(b * TPB + tok_of(p, dir)) * DM + hd * 128 + 32 * sw + r32] = (bf16_t)f2bf(O[r]); }
#pragma unroll
            for (int t = 0; t < 4; ++t) {
#pragma unroll
                for (int g4 = 0; g4 < 4; ++g4) { const f32x4 dc = *(const LAS f32x4*)(buf + DEC_OFF + (32 * t + 8 * g4 + 4 * hi) * 4);
                    S[t][4 * g4 + 0] *= dc.x; S[t][4 * g4 + 1] *= dc.y; S[t][4 * g4 + 2] *= dc.z; S[t][4 * g4 + 3] *= dc.w; }
#pragma unroll
                for (int s0 = 0; s0 < 2; ++s0) { const bf16x8 a = *(const LAS bf16x8*)(buf + K2T_OFF + (32 * t + r32) * T_STR + (16 * s0 + 8 * hi) * 2), bb = *(const LAS bf16x8*)(buf + VT_OFF + (32 * sw + r32) * T_STR + (16 * s0 + 8 * hi) * 2);
                    S[t] = __builtin_amdgcn_mfma_f32_32x32x16_bf16(a, bb, S[t], 0, 0, 0); }
            }
            SCAN_BAR();
        }
    }
}
}

__device__ __forceinline__ void phase_a_readout(Frame& F) {
    const int lane = fresh_lane(), l32 = lane & 31, hh = lane >> 5;
    const int gw = F.vcu * NWAVES + F.wave, NGW = F.G * NWAVES;
    const bf16_t* of = (const bf16_t*)(F.ws + WS_O); const bf16_t* ob = of + (size_t)T * DM; const bf16_t* z = (const bf16_t*)(F.ws + WS_Z); bf16_t* xa = (bf16_t*)(F.ws + WS_XA);
    const f32x4 g = *(const f32x4*)(in_ptr(F, I_A_ONORM) + 4 * l32);
    for (int m = gw; m < T; m += NGW) {
        u32x2 a[4], bb[4], gt[4];
#pragma unroll
        for (int it = 0; it < 4; ++it) { const int c = (2 * it + hh) * 128 + 4 * l32;
            a[it] = __builtin_nontemporal_load((const u32x2*)(of + (size_t)m * DM + c)); bb[it] = __builtin_nontemporal_load((const u32x2*)(ob + (size_t)m * DM + c)); gt[it] = __builtin_nontemporal_load((const u32x2*)(z + (size_t)m * A_IN + 4096 + c)); }
#pragma unroll
        for (int it = 0; it < 4; ++it) { const int c = (2 * it + hh) * 128 + 4 * l32;
            const float o0 = bf2f(a[it].x & 0xffffu) + bf2f(bb[it].x & 0xffffu), o1 = bf2f(a[it].x >> 16) + bf2f(bb[it].x >> 16), o2 = bf2f(a[it].y & 0xffffu) + bf2f(bb[it].y & 0xffffu), o3 = bf2f(a[it].y >> 16) + bf2f(bb[it].y >> 16);
            const float rstd = rsqrtf(half_sum((o0 * o0 + o1 * o1) + (o2 * o2 + o3 * o3)) * (1.0f / 128.0f) + NORM_EPS);
            u32x2 w; w.x = pk2(o0 * rstd * g.x * silu_f(bf2f(gt[it].x & 0xffffu)), o1 * rstd * g.y * silu_f(bf2f(gt[it].x >> 16)));
            w.y = pk2(o2 * rstd * g.z * silu_f(bf2f(gt[it].y & 0xffffu)), o3 * rstd * g.w * silu_f(bf2f(gt[it].y >> 16)));
            *(u32x2*)(xa + (size_t)m * DM + c) = w; }
    }
}

__device__ __forceinline__ f32x2 rope_cs(const float* rt, int kind, int pos, int fi) { return *(const f32x2*)(rt + (((size_t)kind * 64 + pos) * 32 + fi) * 2); }

__device__ __forceinline__ void phase_b_row1(Frame& F) {
    const int lane = fresh_lane();
    const int gw = F.vcu * NWAVES + F.wave, NGW = F.G * NWAVES;
    const bf16_t* z = (const bf16_t*)(F.ws + WS_Z); bf16_t* cq = (bf16_t*)(F.ws + WS_O); bf16_t* ckv = cq + (size_t)T * 384; bf16_t* Kb = (bf16_t*)(F.ws + WS_K);
    const float* qg = in_ptr(F, I_B_QNORM); const float* kg = in_ptr(F, I_B_KVNORM); const float* rt = (const float*)(F.ws + WS_ROPE);
    const int ip = lane & 15, hg = lane >> 4;
    f32x2 qgv[3];
#pragma unroll
    for (int j = 0; j < 3; ++j) qgv[j] = *(const f32x2*)(qg + 128 * j + 2 * lane);
    const f32x4 kgv = *(const f32x4*)(kg + 4 * lane);
    for (int m = gw; m < T; m += NGW) { const RowPos rp = row_pos(m); const bf16_t* zr = z + (size_t)m * B_INP;
        float q[6]; float sq = 0.f;
#pragma unroll
        for (int j = 0; j < 3; ++j) { const unsigned w = __builtin_nontemporal_load((const unsigned*)(zr + 128 * j + 2 * lane)); q[2 * j] = bf2f(w & 0xffffu); q[2 * j + 1] = bf2f(w >> 16); sq += q[2 * j] * q[2 * j] + q[2 * j + 1] * q[2 * j + 1]; }
        const u32x2 kw = __builtin_nontemporal_load((const u32x2*)(zr + 384 + 4 * lane)); const float k0 = bf2f(kw.x & 0xffffu), k1 = bf2f(kw.x >> 16), k2 = bf2f(kw.y & 0xffffu), k3 = bf2f(kw.y >> 16);
        const float skv = (k0 * k0 + k1 * k1) + (k2 * k2 + k3 * k3);
        const float rq = rsqrtf(wave_sum(sq) * (1.0f / 384.0f) + NORM_EPS), rkv = rsqrtf(wave_sum(skv) * (1.0f / 256.0f) + NORM_EPS);
#pragma unroll
        for (int j = 0; j < 3; ++j) { const f32x2 g = qgv[j]; *(unsigned*)(cq + (size_t)m * 384 + 128 * j + 2 * lane) = pk2(q[2 * j] * rq * g.x, q[2 * j + 1] * rq * g.y); }
        { const f32x4 g = kgv; u32x2 w; w.x = pk2(k0 * rkv * g.x, k1 * rkv * g.y); w.y = pk2(k2 * rkv * g.z, k3 * rkv * g.w); *(u32x2*)(ckv + (size_t)m * 256 + 4 * lane) = w; }
        const unsigned rw = *(const unsigned*)(zr + 640 + 2 * ip); float x0 = bf2f(rw & 0xffffu), x1 = bf2f(rw >> 16);
        const float p0 = __shfl_xor(x0, 4), p1 = __shfl_xor(x1, 4);
        if (!rp.isctx) { const int pos = (ip < 8) ? rp.prow : rp.pcol; const f32x2 c0 = rope_cs(rt, 0, pos, (2 * ip) & 7), c1 = rope_cs(rt, 0, pos, (2 * ip + 1) & 7);
            if (ip & 4) { x0 = x0 * c0.x + p0 * c0.y; x1 = x1 * c1.x + p1 * c1.y; } else { x0 = x0 * c0.x - p0 * c0.y; x1 = x1 * c1.x - p1 * c1.y; } }
        const unsigned kb = pk2(x0, x1);
#pragma unroll
        for (int hh = 0; hh < 4; ++hh) { const int hd = 4 * hh + hg; *(unsigned*)(Kb + ((size_t)(rp.b * 16 + hd) * TPB + rp.p) * 96 + 64 + 2 * ip) = kb; }
    }
}
__device__ __forceinline__ void phase_b_row2(Frame& F) {
    const int lane = fresh_lane();
    const int gw = F.vcu * NWAVES + F.wave, NGW = F.G * NWAVES;
    bf16_t* Qb = (bf16_t*)(F.ws + WS_Q); const float* rt = (const float*)(F.ws + WS_ROPE);
    const int ip = lane & 15, hg = lane >> 4;
    for (int m = gw; m < T; m += NGW) { const RowPos rp = row_pos(m); if (rp.isctx) continue;
        const int pos = (ip < 8) ? rp.prow : rp.pcol; const f32x2 c0 = rope_cs(rt, 0, pos, (2 * ip) & 7), c1 = rope_cs(rt, 0, pos, (2 * ip + 1) & 7);
        unsigned w[4];
#pragma unroll
        for (int hh = 0; hh < 4; ++hh) w[hh] = *(const unsigned*)(Qb + (size_t)m * 1536 + (4 * hh + hg) * 96 + 64 + 2 * ip);
#pragma unroll
        for (int hh = 0; hh < 4; ++hh) { float x0 = bf2f(w[hh] & 0xffffu), x1 = bf2f(w[hh] >> 16); const float p0 = __shfl_xor(x0, 4), p1 = __shfl_xor(x1, 4);
            if (ip & 4) { x0 = x0 * c0.x + p0 * c0.y; x1 = x1 * c1.x + p1 * c1.y; } else { x0 = x0 * c0.x - p0 * c0.y; x1 = x1 * c1.x - p1 * c1.y; }
            *(unsigned*)(Qb + (size_t)m * 1536 + (4 * hh + hg) * 96 + 64 + 2 * ip) = pk2(x0, x1); }
    }
}
__device__ __forceinline__ void phase_c_row(Frame& F) {
    const int lane = fresh_lane();
    const int gw = F.vcu * NWAVES + F.wave, NGW = F.G * NWAVES;
    const bf16_t* z = (const bf16_t*)(F.ws + WS_Z); bf16_t* Qb = (bf16_t*)(F.ws + WS_Q); bf16_t* Kb = (bf16_t*)(F.ws + WS_K); bf16_t* Vb = (bf16_t*)(F.ws + WS_V);
    const float* qg = in_ptr(F, I_C_QNORM); const float* kg = in_ptr(F, I_C_KNORM); const float* rt = (const float*)(F.ws + WS_ROPE);
    const f32x2 qgv = *(const f32x2*)(qg + 2 * lane), kgv = *(const f32x2*)(kg + 2 * lane);
    const bool up = (lane & 16) != 0;
    for (int m = gw; m < T; m += NGW) { const RowPos rp = row_pos(m); const bf16_t* zr = z + (size_t)m * C_IN;
        f32x2 c0 = (f32x2){1.f, 0.f}, c1 = (f32x2){1.f, 0.f};
        if (!rp.isctx) { const int pos = (lane < 32) ? rp.prow : rp.pcol; c0 = rope_cs(rt, 2, pos, (2 * lane) & 31); c1 = rope_cs(rt, 2, pos, (2 * lane + 1) & 31); }
        unsigned w[10];
#pragma unroll
        for (int hv = 0; hv < 10; ++hv) w[hv] = *(const unsigned*)(zr + hv * 128 + 2 * lane);
#pragma unroll
        for (int hv = 0; hv < 10; ++hv) { float a = bf2f(w[hv] & 0xffffu), bq = bf2f(w[hv] >> 16);
            const float rstd = rsqrtf(wave_sum(a * a + bq * bq) * (1.0f / 128.0f) + NORM_EPS);
            a *= rstd * (hv < 8 ? qgv.x : kgv.x); bq *= rstd * (hv < 8 ? qgv.y : kgv.y);
            const float ap = __shfl_xor(a, 16), bp = __shfl_xor(bq, 16);
            const float ar = up ? (a * c0.x + ap * c0.y) : (a * c0.x - ap * c0.y), br = up ? (bq * c1.x + bp * c1.y) : (bq * c1.x - bp * c1.y);
            bf16_t* dst = (hv < 8) ? Qb + (size_t)m * 1024 + hv * 128 : Kb + (size_t)m * 256 + (hv - 8) * 128;
            *(unsigned*)(dst + 2 * lane) = pk2(ar, br); }
        *(u32x2*)(Vb + (size_t)m * 256 + 4 * lane) = *(const u32x2*)(zr + 1280 + 4 * lane);
    }
}
__device__ __forceinline__ void phase_d_row1(Frame& F) {
    const int lane = fresh_lane();
    const int gw = F.vcu * NWAVES + F.wave, NGW = F.G * NWAVES;
    const bf16_t* z = (const bf16_t*)(F.ws + WS_Z); bf16_t* Qb = (bf16_t*)(F.ws + WS_Q); bf16_t* Kb = (bf16_t*)(F.ws + WS_K); bf16_t* Vb = (bf16_t*)(F.ws + WS_V);
    const float* rt = (const float*)(F.ws + WS_ROPE);
    const int lp = lane & 31; const bool up = (lane & 8) != 0;
    for (int m = gw; m < T; m += NGW) { const RowPos rp = row_pos(m); const bf16_t* zr = z + (size_t)m * D_IN;
        f32x2 c0 = (f32x2){1.f, 0.f}, c1 = (f32x2){1.f, 0.f};
        if (!rp.isctx) { const int pos = (lp < 16) ? rp.prow : rp.pcol; c0 = rope_cs(rt, 1, pos, (2 * lp) & 15); c1 = rope_cs(rt, 1, pos, (2 * lp + 1) & 15); }
        unsigned w[16];
#pragma unroll
        for (int i = 0; i < 16; ++i) w[i] = *(const unsigned*)(zr + 128 * i + 2 * lane);
#pragma unroll
        for (int i = 0; i < 16; ++i) { const float a = bf2f(w[i] & 0xffffu), bq = bf2f(w[i] >> 16); const float ap = __shfl_xor(a, 8), bp = __shfl_xor(bq, 8);
            const float ar = up ? (a * c0.x + ap * c0.y) : (a * c0.x - ap * c0.y), br = up ? (bq * c1.x + bp * c1.y) : (bq * c1.x - bp * c1.y);
            bf16_t* dst = (i < 8) ? Qb + (size_t)m * 1024 + 128 * i : Kb + (size_t)m * 1024 + 128 * (i - 8); *(unsigned*)(dst + 2 * lane) = pk2(ar, br); }
        { const u32x4 a = *(const u32x4*)(zr + 2048 + 16 * lane), bq = *(const u32x4*)(zr + 2048 + 16 * lane + 8); *(u32x4*)(Vb + (size_t)m * 1024 + 16 * lane) = a; *(u32x4*)(Vb + (size_t)m * 1024 + 16 * lane + 8) = bq; }
    }
}
__device__ __forceinline__ void phase_d_row2(Frame& F) {
    const int lane = fresh_lane(), l32 = lane & 31, hh = lane >> 5;
    const int gw = F.vcu * NWAVES + F.wave, NGW = F.G * NWAVES;
    const bf16_t* A = (const bf16_t*)(F.ws + WS_O); bf16_t* xa = (bf16_t*)(F.ws + WS_XA);
    const float* lam = in_ptr(F, I_D_LAMBDA);
    const float lambda_init = 0.8f - 0.6f * 0.40656965974059917f;
    const float s1 = wave_sum(lam[lane] * lam[64 + lane]), s2 = wave_sum(lam[128 + lane] * lam[192 + lane]);
    const float lam_full = expf(s1) - expf(s2) + lambda_init;
    const f32x4 g = *(const f32x4*)(in_ptr(F, I_D_ONORM) + 4 * l32) * (1.0f - lambda_init);
    for (int m = gw; m < T; m += NGW) { if ((m % TPB) < CTXL) continue;
        u32x2 a[4], bb[4];
#pragma unroll
        for (int it = 0; it < 4; ++it) { const int hd = 2 * it + hh; a[it] = __builtin_nontemporal_load((const u32x2*)(A + (size_t)m * 2048 + (2 * hd) * 128 + 4 * l32)); bb[it] = __builtin_nontemporal_load((const u32x2*)(A + (size_t)m * 2048 + (2 * hd + 1) * 128 + 4 * l32)); }
#pragma unroll
        for (int it = 0; it < 4; ++it) { const int hd = 2 * it + hh;
            const float o0 = bf2f(a[it].x & 0xffffu) - lam_full * bf2f(bb[it].x & 0xffffu), o1 = bf2f(a[it].x >> 16) - lam_full * bf2f(bb[it].x >> 16);
            const float o2 = bf2f(a[it].y & 0xffffu) - lam_full * bf2f(bb[it].y & 0xffffu), o3 = bf2f(a[it].y >> 16) - lam_full * bf2f(bb[it].y >> 16);
            const float rstd = rsqrtf(half_sum((o0 * o0 + o1 * o1) + (o2 * o2 + o3 * o3)) * (1.0f / 128.0f) + NORM_EPS);
            u32x2 w; w.x = pk2(o0 * rstd * g.x, o1 * rstd * g.y); w.y = pk2(o2 * rstd * g.z, o3 * rstd * g.w);
            *(u32x2*)(xa + (size_t)m * DM + hd * 128 + 4 * l32) = w; }
    }
}

#ifndef MK_STAG
#define MK_STAG 1
#endif
#define MK_SPLITKV 0
#define MK_PRE_B 1
#define MK_PRE_C 1
#define MK_PRE_D 1
#define MK_PRE(DK) (MK_STAG && ((DK) == 96 ? MK_PRE_B : (DK) == 128 ? MK_PRE_C : MK_PRE_D))
template <int DK, int DV, int ldq, int ldk, int ldv, int ldo, int H, int GK, int GV>
__device__ __forceinline__ void attn_phase(Frame& F, const bf16_t* Q, const bf16_t* K, const bf16_t* V, bf16_t* O, float scale, bool skip_ctx, int dup = 1) {
    const float C = scale * 1.4426950408889634f, thr_raw = att::THR / scale;
    const int NHV = NBATCH * H * 16, NCTX = skip_ctx ? 0 : NBATCH * H;
    const int LO = NHV % F.G, NFULL = NHV - LO; int SF = 1;
    if (MK_SPLITKV && dup == 1 && LO > 0 && F.G % LO == 0) { const int q = F.G / LO; if (q == 2 || q == 4) SF = q; }
    const int NPART = (SF > 1) ? LO * SF : 0, NLAT = (SF > 1) ? NFULL : NHV, NTOT = NLAT + NPART + NCTX;
    float* PO = (float*)(F.ws + WS_YS); float* PML = PO + (size_t)256 * 256 * 128;
    for (int L0 = F.vcu; L0 < NTOT * dup; L0 += F.G) { const int L = (dup > 1) ? L0 % NTOT : L0;
        int b, hd, qb, part = -1, U = L;
        if (L >= NLAT && L < NLAT + NPART) { const int j = L - NLAT; U = NFULL + j / SF; part = j % SF; }
        if (L < NLAT + NPART) { const int grp = U >> 4; b = grp / H; hd = grp % H; qb = 1 + (U & 15); } else { const int L2 = L - NLAT - NPART; b = L2 / H; hd = L2 % H; qb = 0; }
        const size_t row0 = (size_t)b * TPB + (size_t)qb * 256; const bf16_t* Kh = K + (size_t)(b * (H / GK) + hd / GK) * TPB * DK; const bf16_t* Vh = V + (size_t)(b * (H / GV) + hd / GV) * TPB * DV;
        if (part >= 0) { const int klen = TPB / SF, j = L - NLAT;
            att::attn_unit_stag<DK, DV, ldq, DK, DV, ldo, MK_PRE(DK) != 0, false, true>(Q + row0 * ldq + hd * DK, Kh + (size_t)part * klen * DK, Vh + (size_t)part * klen * DV, nullptr,
                               klen, C, thr_raw, (char*)F.lds, F.wave, PO + (size_t)j * 256 * DV, PML + (size_t)j * 256 * 2); }
        else
        att::attn_unit_stag<DK, DV, ldq, DK, DV, ldo, MK_PRE(DK) != 0, false>(Q + row0 * ldq + hd * DK, Kh, Vh, O + row0 * ldo + hd * DV,
                               qb == 0 ? CTXL : TPB, C, thr_raw, (char*)F.lds, F.wave);
    }
    __syncthreads();
}
template <int DV, int ldo, int H>
__device__ __forceinline__ void attn_merge(Frame& F, bf16_t* O) {
    const int NHV = NBATCH * H * 16, LO = NHV % F.G, NFULL = NHV - LO; int SF = 1;
    if (LO > 0 && F.G % LO == 0) { const int q = F.G / LO; if (q == 2 || q == 4) SF = q; }
    if (SF == 1) return;
    const float* PO = (const float*)(F.ws + WS_YS); const float* PML = PO + (size_t)256 * 256 * 128;
    const int lane = fresh_lane(), gw = F.vcu * NWAVES + F.wave, NGW = F.G * NWAVES;
    for (int it = gw; it < LO * 256; it += NGW) { const int u = it >> 8, r = it & 255, U = NFULL + u;
        const int grp = U >> 4, b = grp / H, hd = grp % H, qb = 1 + (U & 15);
        float mi[4], li[4], m = -3.0e38f;
#pragma unroll
        for (int i = 0; i < 4; ++i) { if (i < SF) { const f32x2 ml = *(const f32x2*)(PML + ((size_t)(u * SF + i) * 256 + r) * 2); mi[i] = ml.x; li[i] = ml.y; m = fmaxf(m, ml.x); } else { mi[i] = 0.f; li[i] = 0.f; } }
        float l = 0.f, w[4];
#pragma unroll
        for (int i = 0; i < 4; ++i) { w[i] = (i < SF) ? __builtin_amdgcn_exp2f(mi[i] - m) : 0.f; l += w[i] * li[i]; }
        const float rl = 1.0f / l;
        bf16_t* orow = O + ((size_t)b * TPB + (size_t)qb * 256 + r) * ldo + hd * DV;
#pragma unroll
        for (int c0 = 0; c0 < DV; c0 += 64) { float acc = 0.f;
#pragma unroll
            for (int i = 0; i < 4; ++i) if (i < SF) acc += w[i] * PO[((size_t)(u * SF + i) * 256 + r) * DV + c0 + lane];
            orow[c0 + lane] = (bf16_t)f2bf(acc * rl); } }
}
#ifndef MK_MULTI
#define MK_MULTI 0
#endif
constexpr int NPHASE = 37;
#ifndef MK_REP_MASK
#define MK_REP_MASK 0ull
#endif
#ifndef MK_REP_N
#define MK_REP_N 1
#endif
#ifndef MK_DUP
#define MK_DUP -1
#endif
#define DUPF(k) ((k) == MK_DUP ? 2 : 1)
#ifndef MK_LIMIT
#define MK_LIMIT 37
#endif
struct Args { const float* in[N_IN]; float* out; unsigned char* ws; int ph_lo, ph_hi; };

__device__ __forceinline__ void gemm_plain_f32(Frame& F, const bf16_t* A, const bf16_t* Bt, int N, int K, float* C, int ldc, int dup = 1) {
    pg8::Gemm g{A, Bt, K / 64, N, K, 0, nullptr, 0, nullptr}; pg8::StaticOrder S; S.init(T / 256, N / 256, F.G, (int)blockIdx.x, dup); pg8::EpiF32 E{C, ldc};
    pg8::gemm_phase<pg8::EpiF32, pg8::StaticOrder, false>(F.lds, g, S, E, F.wave);
}
__device__ __forceinline__ void gemm_plain_bf16(Frame& F, const bf16_t* A, const bf16_t* Bt, int N, int K, bf16_t* C, int ldc, int dup = 1) {
    pg8::Gemm g{A, Bt, K / 64, N, K, 0, nullptr, 0, nullptr}; pg8::StaticOrder S; S.init(T / 256, N / 256, F.G, (int)blockIdx.x, dup); pg8::EpiBf16 E{C, ldc};
    pg8::gemm_phase<pg8::EpiBf16, pg8::StaticOrder, false>(F.lds, g, S, E, F.wave);
}
template <int S>
__device__ __forceinline__ void gemm_n1024(Frame& F, const bf16_t* A, const bf16_t* Bt, int K, bool skip_ctx, int dup = 1) {
    { pg8::Gemm g{A, Bt, K / 64, DM, K, 0, nullptr, 0, nullptr}; pg8::LatOrder S1; S1.so.init(128, DM / 256, F.G, (int)blockIdx.x, dup); pg8::EpiBf16 E{(bf16_t*)(F.ws + WS_Y), DM};
      pg8::gemm_phase<pg8::EpiBf16, pg8::LatOrder, false>(F.lds, g, S1, E, F.wave); }
    if (!skip_ctx) { pg8::Gemm g{A, Bt, K / 64 / S, DM, K, 0, nullptr, 0, nullptr}; pg8::CtxSplitOrder S2{DM / 256, S, K / 64 / S, F.G, (int)blockIdx.x, dup}; pg8::EpiF32 E{(float*)(F.ws + WS_YS), DM};
      pg8::gemm_phase<pg8::EpiF32, pg8::CtxSplitOrder, false>(F.lds, g, S2, E, F.wave); }
}
__device__ __forceinline__ void gemm_swiglu(Frame& F, const bf16_t* A, const bf16_t* Bt, bf16_t* C, int dup = 1) {
    pg8::Gemm g{A, Bt, DM / 128, 2 * FF, DM / 2, 0, nullptr, 0, nullptr}; pg8::StaticOrder S; S.init(T / 256, 2 * FF / 256, F.G, (int)blockIdx.x, dup); pg8::EpiSwiglu E{C, FF, 1.0f / 32.0f};
    pg8::gemm_phase<pg8::EpiSwiglu, pg8::StaticOrder, false, true>(F.lds, g, S, E, F.wave);
}
__device__ __forceinline__ void gemm_moe_gu(Frame& F, int lm, int dup = 1) {
    moe_tables(F, 2 * lm + 1);
    pg8::Gemm g{(const bf16_t*)(F.ws + WS_XA), (const bf16_t*)(F.ws + WS_MOE_GU + (size_t)lm * 8 * SZ_GU), DM / 128, 2 * FF, DM / 2, (size_t)2 * FF * DM / 2, (const int*)(F.ws + WS_LIST), T, (const LAS int*)(F.MISC + 32)};
    pg8::MoeOrder S; S.so.init((int)F.MISC[24], 2 * FF / 256, F.G, (int)blockIdx.x, dup); S.rb0 = (const LAS int*)(F.MISC + 16); pg8::EpiSwiglu E{(bf16_t*)(F.ws + WS_ACT), FF, 1.0f / 32.0f};
    pg8::gemm_phase<pg8::EpiSwiglu, pg8::MoeOrder, true, true>(F.lds, g, S, E, F.wave);
}
__device__ __forceinline__ void gemm_moe_down(Frame& F, int lm, int dup = 1) {
    moe_tables(F, 2 * lm + 1);
    int RBM, trb, S; pg8::moe_tail_params((int)F.MISC[24], RBM, trb, S);
    const bf16_t* A = (const bf16_t*)(F.ws + WS_ACT); const bf16_t* Bt = (const bf16_t*)(F.ws + WS_MOE_DN + (size_t)lm * 8 * SZ_DN);
    { pg8::Gemm g{A, Bt, FF / 64, DM, FF, (size_t)DM * FF, nullptr, 0, nullptr};
      pg8::MoeOrder S1; S1.so.init(RBM, DM / 256, F.G, (int)blockIdx.x, dup); S1.rb0 = (const LAS int*)(F.MISC + 16); pg8::EpiBf16 E{(bf16_t*)(F.ws + WS_YP), DM};
      pg8::gemm_phase<pg8::EpiBf16, pg8::MoeOrder, false>(F.lds, g, S1, E, F.wave); }
    if (trb > 0) { pg8::Gemm g{A, Bt, FF / 64 / S, DM, FF, (size_t)DM * FF, nullptr, 0, nullptr};
      pg8::MoeTailOrder S2{RBM, trb, S, FF / 64 / S, F.G, (int)blockIdx.x, dup, (const LAS int*)(F.MISC + 16)}; pg8::EpiF32 E{(float*)(F.ws + WS_YS), DM};
      pg8::gemm_phase<pg8::EpiF32, pg8::MoeTailOrder, false>(F.lds, g, S2, E, F.wave); }
}
__device__ __forceinline__ void xcd_or_nothing(const XcdBarrier& b, int wave) { if (!MK_MULTI) xcd_barrier(b, wave); }
__global__ void __launch_bounds__(NWAVES * 64, 2) fwd_kernel(Args args) {
    extern __shared__ __attribute__((aligned(16))) unsigned char lds_raw[];
    Frame F;
    F.lds = (LAS unsigned char*)lds_raw; F.MISC = (volatile LAS unsigned*)(F.lds + MISC_OFF);
    F.wave = __builtin_amdgcn_readfirstlane((int)threadIdx.x >> 6);
    F.G = gridDim.x; { const int bx = blockIdx.x; F.vcu = (F.G % 8 == 0) ? (bx % 8) * (F.G / 8) + bx / 8 : bx; }
    F.ws = args.ws;
    for (int u = threadIdx.x; u < 256; u += NWAVES * 64) ((LAS unsigned*)(F.lds + MISC_OFF))[u] = 0u;
    __syncthreads();
    XcdBarrier bar; bar.bar = (unsigned*)((unsigned*)F.ws + CW_BAR); bar.x = 0; bar.st = nullptr;
    if (!MK_MULTI) bar = xcd_barrier_post((unsigned*)((unsigned*)F.ws + CW_BAR), F.MISC + 0);
    const int lo = args.ph_lo, hi = args.ph_hi;
#define IN(k) (lo <= (k) && (k) < hi)
#define NREP(k) ((((unsigned long long)(MK_REP_MASK) >> (k)) & 1ull) ? (1 + MK_REP_N) : 1)
#define SEAM(k) do { if (!MK_MULTI && IN((k) + 1)) xcd_barrier(bar, F.wave); } while (0)
    unsigned char* ws = F.ws;
    bf16_t* XA = (bf16_t*)(ws + WS_XA); bf16_t* Y = (bf16_t*)(ws + WS_Y); bf16_t* ACT = (bf16_t*)(ws + WS_ACT);
    bf16_t* Qb = (bf16_t*)(ws + WS_Q); bf16_t* Kb = (bf16_t*)(ws + WS_K); bf16_t* Vb = (bf16_t*)(ws + WS_V); bf16_t* Ob = (bf16_t*)(ws + WS_O);

    if (IN(0)) { for (int rep = 0; rep < NREP(0); ++rep) { p0_prologue(F); if (rep + 1 < NREP(0)) xcd_or_nothing(bar, F.wave); } SEAM(0); }
    if (IN(1)) { for (int rep = 0; rep < NREP(1); ++rep) { for (int d2 = 0; d2 < DUPF(1); ++d2) { phase_r0(F); } if (rep + 1 < NREP(1)) xcd_or_nothing(bar, F.wave); } SEAM(1); }
    if (IN(2)) { for (int rep = 0; rep < NREP(2); ++rep) { gemm_plain_bf16(F, XA, (const bf16_t*)(ws + WS_WA_IN), A_IN, DM, (bf16_t*)(ws + WS_Z), A_IN, DUPF(2)); if (rep + 1 < NREP(2)) xcd_or_nothing(bar, F.wave); } SEAM(2); }
    if (IN(3)) { for (int rep = 0; rep < NREP(3); ++rep) { if ((int)blockIdx.x < NBATCH * 8 * 2) { for (int d2 = 0; d2 < DUPF(3); ++d2) { const int ln = fresh_lane(); scan::scan_unit(ws, F.lds, (int)blockIdx.x, F.wave, ln, F.wave * 64 + ln); __syncthreads(); } }
        else if (rep == 0) { const int nidle = F.G - NBATCH * 8 * 2; p0_convert(F, p0_split_item(), g_mats.item0[NMAT], ((int)blockIdx.x - NBATCH * 8 * 2) * NWAVES + F.wave, nidle * NWAVES, fresh_lane()); } if (rep + 1 < NREP(3)) xcd_or_nothing(bar, F.wave); } SEAM(3); }
    if (IN(4)) { for (int rep = 0; rep < NREP(4); ++rep) { for (int d2 = 0; d2 < DUPF(4); ++d2) { phase_a_readout(F); } if (rep + 1 < NREP(4)) xcd_or_nothing(bar, F.wave); } SEAM(4); }
    if (IN(5)) { for (int rep = 0; rep < NREP(5); ++rep) { gemm_n1024<4>(F, XA, (const bf16_t*)(ws + WS_WA_OUT), DM, false, DUPF(5)); if (rep + 1 < NREP(5)) xcd_or_nothing(bar, F.wave); } SEAM(5); }
    if (IN(6)) { for (int rep = 0; rep < NREP(6); ++rep) { phase_r1<false>(F, 0); if (rep + 1 < NREP(6)) xcd_or_nothing(bar, F.wave); } SEAM(6); }
    if (IN(7)) { for (int rep = 0; rep < NREP(7); ++rep) { gemm_swiglu(F, XA, (const bf16_t*)(ws + WS_FFN_GU), ACT, DUPF(7)); if (rep + 1 < NREP(7)) xcd_or_nothing(bar, F.wave); } SEAM(7); }
    if (IN(8)) { for (int rep = 0; rep < NREP(8); ++rep) { gemm_n1024<4>(F, ACT, (const bf16_t*)(ws + WS_FFN_DN), FF, false, DUPF(8)); if (rep + 1 < NREP(8)) xcd_or_nothing(bar, F.wave); } SEAM(8); }
    if (IN(9)) { for (int rep = 0; rep < NREP(9); ++rep) { phase_r2<false>(F, 0); if (rep + 1 < NREP(9)) xcd_or_nothing(bar, F.wave); } SEAM(9); }
    if (IN(10)) { for (int rep = 0; rep < NREP(10); ++rep) { gemm_plain_bf16(F, XA, (const bf16_t*)(ws + WS_WB_IN), B_INP, DM, (bf16_t*)(ws + WS_Z), B_INP, DUPF(10)); if (rep + 1 < NREP(10)) xcd_or_nothing(bar, F.wave); } SEAM(10); }
    if (IN(11)) { for (int rep = 0; rep < NREP(11); ++rep) { for (int d2 = 0; d2 < DUPF(11); ++d2) { phase_b_row1(F); } if (rep + 1 < NREP(11)) xcd_or_nothing(bar, F.wave); } SEAM(11); }
    if (IN(12)) {
        { pg8::Gemm g{Ob, (const bf16_t*)(ws + WS_WB_QB), 384 / 64, 1536, 384, 0, nullptr, 0, nullptr}; pg8::StaticOrder S; S.init(T / 256, 1536 / 256, F.G, (int)blockIdx.x); pg8::EpiRopeB E{Qb, (const float*)(ws + WS_ROPE), MK_PRE(96) ? 0.10206207261596575f * 1.4426950408889634f : 1.0f};
          pg8::gemm_phase<pg8::EpiRopeB, pg8::StaticOrder, false>(F.lds, g, S, E, F.wave); }
        { pg8::Gemm g{Ob + (size_t)T * 384, (const bf16_t*)(ws + WS_WB_KVB), 256 / 64, 2048, 256, 0, nullptr, 0, nullptr}; pg8::StaticOrder S; S.init(T / 256, 2048 / 256, F.G, (int)blockIdx.x); pg8::EpiKV E{Kb, 1536, Vb, 1024};
          pg8::gemm_phase<pg8::EpiKV, pg8::StaticOrder, false>(F.lds, g, S, E, F.wave); }
        SEAM(12); }
    if (IN(13)) { for (int rep = 0; rep < NREP(13); ++rep) { attn_phase<96, 64, 1536, 1536, 1024, DM, 16, 1, 1>(F, Qb, Kb, Vb, XA, 0.10206207261596575f, false, DUPF(13)); if (rep + 1 < NREP(13)) xcd_or_nothing(bar, F.wave); } SEAM(13); }
    if (IN(14)) { for (int rep = 0; rep < NREP(14); ++rep) { gemm_n1024<4>(F, XA, (const bf16_t*)(ws + WS_WB_OUT), DM, false, DUPF(14)); if (rep + 1 < NREP(14)) xcd_or_nothing(bar, F.wave); } SEAM(14); }
    if (IN(15)) { for (int rep = 0; rep < NREP(15); ++rep) { phase_r1<true>(F, 1); if (rep + 1 < NREP(15)) xcd_or_nothing(bar, F.wave); } SEAM(15); }
    if (IN(16)) { moe_build(F); SEAM(16); }
    if (IN(17)) { for (int rep = 0; rep < NREP(17); ++rep) { gemm_moe_gu(F, 0, DUPF(17)); if (rep + 1 < NREP(17)) xcd_or_nothing(bar, F.wave); } SEAM(17); }
    if (IN(18)) { for (int rep = 0; rep < NREP(18); ++rep) { gemm_moe_down(F, 0, DUPF(18)); if (rep + 1 < NREP(18)) xcd_or_nothing(bar, F.wave); } SEAM(18); }
    if (IN(19)) { for (int rep = 0; rep < NREP(19); ++rep) { moe_tables(F, 1); phase_r2<true>(F, 1); if (rep + 1 < NREP(19)) xcd_or_nothing(bar, F.wave); } SEAM(19); }
    if (IN(20)) { { pg8::Gemm g{XA, (const bf16_t*)(ws + WS_WC_IN), DM / 64, C_IN, DM, 0, nullptr, 0, nullptr}; pg8::StaticOrder S; S.init(T / 256, C_IN / 256, F.G, (int)blockIdx.x, DUPF(20));
          pg8::EpiNormRopeC E{Qb, Kb, Vb, in_ptr(F, I_C_QNORM), in_ptr(F, I_C_KNORM), (const float*)(ws + WS_ROPE) + (size_t)2 * 64 * 32 * 2, (LAS float*)(F.lds + pg8::STAGE_BYTES + 2048), MK_PRE(128) ? 0.08838834764831845f * 1.4426950408889634f : 1.0f};
          pg8::gemm_phase<pg8::EpiNormRopeC, pg8::StaticOrder, false>(F.lds, g, S, E, F.wave); } }
    if (IN(21)) { SEAM(21); }
    if (IN(22)) { for (int rep = 0; rep < NREP(22); ++rep) { attn_phase<128, 128, 1024, 256, 256, DM, 8, 4, 4>(F, Qb, Kb, Vb, XA, 0.08838834764831845f, false, DUPF(22)); if (rep + 1 < NREP(22)) xcd_or_nothing(bar, F.wave); } SEAM(22); }
    if (IN(23)) { for (int rep = 0; rep < NREP(23); ++rep) { gemm_n1024<4>(F, XA, (const bf16_t*)(ws + WS_WC_OUT), DM, false, DUPF(23)); if (rep + 1 < NREP(23)) xcd_or_nothing(bar, F.wave); } SEAM(23); }
    if (IN(24)) { for (int rep = 0; rep < NREP(24); ++rep) { phase_r1<false>(F, 2); if (rep + 1 < NREP(24)) xcd_or_nothing(bar, F.wave); } SEAM(24); }
    if (IN(25)) { for (int rep = 0; rep < NREP(25); ++rep) { gemm_swiglu(F, XA, (const bf16_t*)(ws + WS_FFN_GU + SZ_GU), ACT, DUPF(25)); if (rep + 1 < NREP(25)) xcd_or_nothing(bar, F.wave); } SEAM(25); }
    if (IN(26)) { for (int rep = 0; rep < NREP(26); ++rep) { gemm_n1024<4>(F, ACT, (const bf16_t*)(ws + WS_FFN_DN + SZ_DN), FF, false, DUPF(26)); if (rep + 1 < NREP(26)) xcd_or_nothing(bar, F.wave); } SEAM(26); }
    if (IN(27)) { for (int rep = 0; rep < NREP(27); ++rep) { phase_r2<false>(F, 2); if (rep + 1 < NREP(27)) xcd_or_nothing(bar, F.wave); } SEAM(27); }
    if (IN(28)) { { pg8::Gemm g{XA, (const bf16_t*)(ws + WS_WD_IN), DM / 64, D_IN, DM, 0, nullptr, 0, nullptr}; pg8::StaticOrder S; S.init(T / 256, D_IN / 256, F.G, (int)blockIdx.x, DUPF(28));
          pg8::EpiRopeD E{Qb, Kb, Vb, (const float*)(ws + WS_ROPE) + (size_t)1 * 64 * 32 * 2, MK_PRE(64) ? 0.125f * 1.4426950408889634f : 1.0f};
          pg8::gemm_phase<pg8::EpiRopeD, pg8::StaticOrder, false>(F.lds, g, S, E, F.wave); } SEAM(28); }
    if (IN(29)) { for (int rep = 0; rep < NREP(29); ++rep) { attn_phase<64, 128, 1024, 1024, 1024, 2048, 16, 1, 2>(F, Qb, Kb, Vb, Ob, 0.125f, true, DUPF(29)); if (rep + 1 < NREP(29)) xcd_or_nothing(bar, F.wave); } SEAM(29); }
    if (IN(30)) { for (int rep = 0; rep < NREP(30); ++rep) { for (int d2 = 0; d2 < DUPF(30); ++d2) { phase_d_row2(F); } if (rep + 1 < NREP(30)) xcd_or_nothing(bar, F.wave); } SEAM(30); }
    if (IN(31)) { for (int rep = 0; rep < NREP(31); ++rep) { gemm_n1024<4>(F, XA, (const bf16_t*)(ws + WS_WD_OUT), DM, true, DUPF(31)); if (rep + 1 < NREP(31)) xcd_or_nothing(bar, F.wave); } SEAM(31); }
    if (IN(32)) { for (int rep = 0; rep < NREP(32); ++rep) { phase_r1<true>(F, 3); if (rep + 1 < NREP(32)) xcd_or_nothing(bar, F.wave); } SEAM(32); }
    if (IN(33)) { moe_build(F); SEAM(33); }
    if (IN(34)) { for (int rep = 0; rep < NREP(34); ++rep) { gemm_moe_gu(F, 1, DUPF(34)); if (rep + 1 < NREP(34)) xcd_or_nothing(bar, F.wave); } SEAM(34); }
    if (IN(35)) { for (int rep = 0; rep < NREP(35); ++rep) { gemm_moe_down(F, 1, DUPF(35)); if (rep + 1 < NREP(35)) xcd_or_nothing(bar, F.wave); } SEAM(35); }
    if (IN(36)) { moe_tables(F, 3); phase_r2<true>(F, 3); }
#if MK_LIMIT < 37
    {
        xcd_barrier(bar, F.wave);
        float* outp = out_ptr(); const int tid = F.wave * 64 + fresh_lane();
#if MK_LIMIT == 34 || MK_LIMIT == 35 || MK_LIMIT == 36
        moe_tables(F, 3);
        int RBM, trb, S; pg8::moe_tail_params((int)F.MISC[24], RBM, trb, S);
#endif
        for (int r = (int)blockIdx.x; r < NBATCH * SEQ; r += F.G) { const int b = r / SEQ, l = r % SEQ; const size_t m = (size_t)b * TPB + CTXL + l;
#if MK_LIMIT == 34
            const int* route = (const int*)(ws + WS_ROUTE); const int* list = (const int*)(ws + WS_LIST);
            const int e1 = route[m * 8], s1 = route[m * 8 + 1], e2 = route[m * 8 + 2], s2 = route[m * 8 + 3];
            const unsigned char* xa8 = (const unsigned char*)(ws + WS_XA) + m * DM;
            for (int c = tid; c < DM; c += NWAVES * 64) { float v = 0.f;
                if (c >= 512) v = (float)((unsigned)xa8[2 * (c - 512)] + 256u * (unsigned)xa8[2 * (c - 512) + 1]); else
                if (c < 4) v = (float)route[m * 8 + c]; else if (c < 6) v = ((const float*)route)[m * 8 + c]; else if (c == 6) v = (float)(list[(size_t)e1 * T + s1] - (int)m); else if (c == 7) v = (float)(list[(size_t)e2 * T + s2] - (int)m);
                else if (c < 16) v = (float)F.MISC[16 + (c - 8)]; else if (c < 24) v = (float)F.MISC[32 + (c - 16)]; else if (c == 24) v = (float)F.MISC[24];
                outp[(size_t)r * DM + c] = v; }
#elif MK_LIMIT == 35
            const int* route = (const int*)(ws + WS_ROUTE); const bf16_t* act = (const bf16_t*)(ws + WS_ACT);
            const size_t r1 = (size_t)F.MISC[16 + route[m * 8]] * 256 + route[m * 8 + 1], r2 = (size_t)F.MISC[16 + route[m * 8 + 2]] * 256 + route[m * 8 + 3];
            for (int c = tid; c < DM; c += NWAVES * 64) { float v = 0.f;
                for (int q = 0; q < 4; ++q) { const int cc = c + q * DM; if (cc < FF) v += bf2f((unsigned)act[r1 * FF + cc]) + 2.0f * bf2f((unsigned)act[r2 * FF + cc]); }
                outp[(size_t)r * DM + c] = v; }
#elif MK_LIMIT == 36
            const int* route = (const int*)(ws + WS_ROUTE);
            const size_t r1 = (size_t)F.MISC[16 + route[m * 8]] * 256 + route[m * 8 + 1], r2 = (size_t)F.MISC[16 + route[m * 8 + 2]] * 256 + route[m * 8 + 3];
            for (int c = tid; c < DM; c += NWAVES * 64) { float v = 0.f;
                for (int k = 0; k < 2; ++k) { const size_t rr = k ? r2 : r1; const int rb = (int)(rr >> 8); float a = 0.f;
                    if (rb >= RBM) { const float* ys = (const float*)(ws + WS_YS) + ((size_t)(rb - RBM) * 256 + (rr & 255)) * DM; for (int s2 = 0; s2 < S; ++s2) a += ys[(size_t)s2 * trb * 256 * DM + c]; }
                    else a = bf2f((unsigned)((const bf16_t*)(ws + WS_YP))[rr * DM + c]);
                    v += (k ? 2.0f : 1.0f) * a; }
                outp[(size_t)r * DM + c] = v; }
#else
            const bf16_t* hh = (const bf16_t*)(ws + WS_H); const size_t src = m * DM;
            for (int c = tid; c < DM; c += NWAVES * 64) outp[(size_t)r * DM + c] = bf2f((unsigned)hh[src + c]);
#endif
        }
    }
#endif
#undef IN
#undef SEAM
}

extern "C" void kernel_launch(void* const* d_in, const int* in_sizes, int n_in, void* d_out, int out_size, void* d_ws, size_t ws_size, hipStream_t stream) {
    static int grid = 0;
    if (grid == 0) {
        if (n_in != N_IN || out_size != NBATCH * SEQ * DM || ws_size < WS_END) { fprintf(stderr, "kernel_launch: unexpected shapes: n_in %d out %d ws %zu (need %zu)\n", n_in, out_size, ws_size, (size_t)WS_END); grid = -1; return; }
        int dev = 0, cus = 0, per_cu = 0;
        if (hipGetDevice(&dev) != hipSuccess || hipDeviceGetAttribute(&cus, hipDeviceAttributeMultiprocessorCount, dev) != hipSuccess) { grid = -1; return; }
        if (hipFuncSetAttribute((const void*)fwd_kernel, hipFuncAttributeMaxDynamicSharedMemorySize, LDS_BYTES) != hipSuccess) { fprintf(stderr, "kernel_launch: hipFuncSetAttribute failed\n"); grid = -1; return; }
        if (hipOccupancyMaxActiveBlocksPerMultiprocessor(&per_cu, (const void*)fwd_kernel, NWAVES * 64, LDS_BYTES) != hipSuccess || per_cu < 1) fprintf(stderr, "kernel_launch: occupancy query reports %d\n", per_cu);
        (void)hipGetLastError();
        grid = cus;
    }
    if (grid < 0) return;
    (void)hipMemsetAsync((char*)d_ws + WS_CTL, 0, CTL_BYTES, stream);
    Args a{};
    for (int i = 0; i < N_IN; ++i) a.in[i] = (const float*)d_in[i];
    a.out = (float*)d_out; a.ws = (unsigned char*)d_ws;
#if MK_MULTI
    for (int p = 0; p < MK_LIMIT; ++p) { a.ph_lo = p; a.ph_hi = p + 1; hipLaunchKernelGGL(fwd_kernel, dim3(grid), dim3(NWAVES * 64), LDS_BYTES, stream, a); }
#else
    a.ph_lo = 0; a.ph_hi = MK_LIMIT; hipLaunchKernelGGL(fwd_kernel, dim3(grid), dim3(NWAVES * 64), LDS_BYTES, stream, a);
#endif
    const hipError_t le = hipPeekAtLastError();
    if (le != hipSuccess) fprintf(stderr, "kernel_launch: launch failed: %s\n", hipGetErrorName(le));
}
```
